# Optimizing an MI355X kernel written in HIP

```python
import jax, jax.numpy as jnp
from jax import lax
import numpy as np

D_MODEL = 2048
BATCH = 4
SEQ = 4096
DEPTH = 1

CHUNK = 64
QBLOCK = 128
FOX_HEADS = 8
FOX_HEAD_DIM = D_MODEL // 16
FOX_WIDTH = FOX_HEADS * FOX_HEAD_DIM
MLSTM_HEADS = 4
MLSTM_V_DIM = D_MODEL // 8
MLSTM_QK_DIM = MLSTM_V_DIM // 2
MLSTM_WIDTH = MLSTM_HEADS * MLSTM_V_DIM
MLSTM_QK_WIDTH = MLSTM_HEADS * MLSTM_QK_DIM
CONV_WIDTH = 4
N_MEM = 256
XATTN_HEADS = 4
XATTN_HEAD_DIM = D_MODEL // XATTN_HEADS
D_FF = 4 * D_MODEL
EPS = 1e-6

IN_SPLITS = (FOX_WIDTH, FOX_WIDTH, FOX_WIDTH, FOX_HEADS,
             2 * MLSTM_QK_WIDTH, MLSTM_WIDTH, MLSTM_HEADS, MLSTM_HEADS,
             MLSTM_WIDTH)
IN_WIDTH = sum(IN_SPLITS)

kernel_name = "fox_mlstm_hybrid_streaming_block"


def _rms(x, g):
    x32 = x.astype(jnp.float32)
    y = x32 * lax.rsqrt(jnp.mean(x32 * x32, axis=-1, keepdims=True) + EPS)
    return (y * g.astype(jnp.float32)).astype(x.dtype)


def _to_heads(t, h):
    b, s, w = t.shape
    return t.reshape(b, s, h, w // h).transpose(0, 2, 1, 3)


def _from_heads(t):
    b, h, s, d = t.shape
    return t.transpose(0, 2, 1, 3)


def _causal_dwconv(u, w, b):
    c = u.shape[-1]
    y = lax.conv_general_dilated(u, w.astype(u.dtype)[:, None, :], window_strides=(1,),
                                 padding=[(CONV_WIDTH - 1, 0)],
                                 dimension_numbers=("NWC", "WIO", "NWC"),
                                 feature_group_count=c)
    return y + b.astype(u.dtype)


def _fox_attention(q, k, v, logf):
    s_len, d = q.shape[2], q.shape[3]
    scale = d ** -0.5
    c = lax.cumsum(logf, axis=2)
    outs = []
    for blk in range(s_len // QBLOCK):
        q0, q1 = blk * QBLOCK, (blk + 1) * QBLOCK
        qb, kb, vb = q[:, :, q0:q1], k[:, :, :q1], v[:, :, :q1]
        sc = jnp.einsum("bhqd,bhkd->bhqk", qb, kb).astype(jnp.float32) * scale
        sc = sc + c[:, :, q0:q1, None] - c[:, :, None, :q1]
        qpos = q0 + jnp.arange(QBLOCK)
        kpos = jnp.arange(q1)
        sc = jnp.where(qpos[:, None] >= kpos[None, :], sc, -jnp.inf)
        p = jax.nn.softmax(sc, axis=-1).astype(v.dtype)
        outs.append(jnp.einsum("bhqk,bhkd->bhqd", p, vb))
    return jnp.concatenate(outs, axis=2)


def _mlstm_chunkwise(q, k, v, ig, lf):
    bsz, nh, s_len, dk = q.shape
    dv = v.shape[-1]
    nc = s_len // CHUNK
    f32 = jnp.float32
    q = q.astype(f32)
    k = k.astype(f32) * (dk ** -0.5)
    v = v.astype(f32)

    def chunks(t):
        return jnp.moveaxis(t.reshape(bsz, nh, nc, CHUNK, *t.shape[3:]), 2, 0)

    tril = jnp.tril(jnp.ones((CHUNK, CHUNK), dtype=bool))

    def step(carry, inp):
        C, n, m = carry
        qc, kc, vc, ic, fc = inp
        b = jnp.cumsum(fc, axis=-1)
        dmat = b[..., :, None] - b[..., None, :] + ic[..., None, :]
        dmat = jnp.where(tril, dmat, -jnp.inf)
        inter = b + m[..., None]
        m_t = jnp.maximum(inter, jnp.max(dmat, axis=-1))
        w = jnp.exp(dmat - m_t[..., None])
        g = jnp.exp(inter - m_t)
        sqk = jnp.einsum("bhtd,bhsd->bhts", qc, kc) * w
        num = jnp.einsum("bhts,bhsv->bhtv", sqk, vc) + g[..., None] * jnp.einsum("bhvd,bhtd->bhtv", C, qc)
        den = jnp.sum(sqk, axis=-1) + g * jnp.einsum("bhd,bhtd->bht", n, qc)
        h = num / jnp.maximum(jnp.abs(den), jnp.exp(-m_t))[..., None]
        a = b[..., -1:] - b + ic
        m_new = jnp.maximum(b[..., -1] + m, jnp.max(a, axis=-1))
        wa = jnp.exp(a - m_new[..., None])
        decay = jnp.exp(b[..., -1] + m - m_new)
        C_new = decay[..., None, None] * C + jnp.einsum("bhs,bhsv,bhsd->bhvd", wa, vc, kc)
        n_new = decay[..., None] * n + jnp.einsum("bhs,bhsd->bhd", wa, kc)
        return (C_new, n_new, m_new), h

    init = (jnp.zeros((bsz, nh, dv, dk), f32), jnp.zeros((bsz, nh, dk), f32), jnp.zeros((bsz, nh), f32))
    _, hs = lax.scan(step, init, (chunks(q), chunks(k), chunks(v), chunks(ig), chunks(lf)))
    return jnp.moveaxis(hs, 0, 2).reshape(bsz, nh, s_len, dv)


def setup_inputs(seed: int = 0) -> dict:
    key = jax.random.key(seed)
    ks = jax.random.split(key, 24)
    nrm = jax.random.normal
    def gain(k, shape):
        return 1.0 + 0.02 * nrm(k, shape, jnp.float32)
    return {
        "x": nrm(ks[0], (BATCH, SEQ, D_MODEL), jnp.float32),
        "mem": nrm(ks[1], (BATCH, N_MEM, D_MODEL), jnp.float32),
        "mixer_norm": gain(ks[2], (DEPTH, D_MODEL)),
        "w_in": nrm(ks[3], (DEPTH, D_MODEL, IN_WIDTH), jnp.float32) * D_MODEL ** -0.5,
        "fox_f_bias": jax.random.uniform(ks[4], (DEPTH, FOX_HEADS), jnp.float32, 1.0, 6.0),
        "mlstm_i_bias": 0.1 * nrm(ks[5], (DEPTH, MLSTM_HEADS), jnp.float32),
        "mlstm_f_bias": jax.random.uniform(ks[6], (DEPTH, MLSTM_HEADS), jnp.float32, 3.0, 6.0),
        "conv_w": nrm(ks[7], (DEPTH, CONV_WIDTH, 2 * MLSTM_QK_WIDTH), jnp.float32) * CONV_WIDTH ** -0.5,
        "conv_b": 0.02 * nrm(ks[8], (DEPTH, 2 * MLSTM_QK_WIDTH), jnp.float32),
        "fox_q_norm": gain(ks[9], (DEPTH, FOX_HEAD_DIM)),
        "fox_k_norm": gain(ks[10], (DEPTH, FOX_HEAD_DIM)),
        "fox_out_norm": gain(ks[11], (DEPTH, FOX_WIDTH)),
        "mlstm_out_norm": gain(ks[12], (DEPTH, MLSTM_WIDTH)),
        "w_out": nrm(ks[13], (DEPTH, FOX_WIDTH + MLSTM_WIDTH, D_MODEL), jnp.float32) * (FOX_WIDTH + MLSTM_WIDTH) ** -0.5,
        "xattn_norm": gain(ks[14], (DEPTH, D_MODEL)),
        "mem_norm": gain(ks[15], (DEPTH, D_MODEL)),
        "w_xq": nrm(ks[16], (DEPTH, D_MODEL, D_MODEL), jnp.float32) * D_MODEL ** -0.5,
        "w_xkv": nrm(ks[17], (DEPTH, D_MODEL, 2 * D_MODEL), jnp.float32) * D_MODEL ** -0.5,
        "xq_norm": gain(ks[18], (DEPTH, XATTN_HEAD_DIM)),
        "xk_norm": gain(ks[19], (DEPTH, XATTN_HEAD_DIM)),
        "w_xo": nrm(ks[20], (DEPTH, D_MODEL, D_MODEL), jnp.float32) * D_MODEL ** -0.5,
        "mlp_norm": gain(ks[21], (DEPTH, D_MODEL)),
        "w_up": nrm(ks[22], (DEPTH, D_MODEL, D_FF), jnp.float32) * D_MODEL ** -0.5,
        "w_down": nrm(ks[23], (DEPTH, D_FF, D_MODEL), jnp.float32) * D_FF ** -0.5,
    }


def reference(x, mem, mixer_norm, w_in, fox_f_bias, mlstm_i_bias, mlstm_f_bias, conv_w, conv_b,
              fox_q_norm, fox_k_norm, fox_out_norm, mlstm_out_norm, w_out, xattn_norm, mem_norm,
              w_xq, w_xkv, xq_norm, xk_norm, w_xo, mlp_norm, w_up, w_down):
    bsz, s_len, _ = x.shape
    f32 = jnp.float32
    split_idx = list(np.cumsum(IN_SPLITS)[:-1])
    for l in range(DEPTH):
        xn = _rms(x, mixer_norm[l])
        proj = xn @ w_in[l]
        fq, fk, fv, ff, mqk, mv, mi, mf, mo = jnp.split(proj, split_idx, axis=-1)

        fq = _rms(_to_heads(fq, FOX_HEADS), fox_q_norm[l])
        fk = _rms(_to_heads(fk, FOX_HEADS), fox_k_norm[l])
        fv = _to_heads(fv, FOX_HEADS)
        logf = jax.nn.log_sigmoid(ff.astype(f32) + fox_f_bias[l].astype(f32)).transpose(0, 2, 1)
        fo = _from_heads(_fox_attention(fq, fk, fv, logf))
        fo = _rms(fo, fox_out_norm[l].reshape(FOX_HEADS, FOX_HEAD_DIM)).reshape(bsz, s_len, FOX_WIDTH)

        mqk = jax.nn.silu(_causal_dwconv(mqk, conv_w[l], conv_b[l]))
        mq, mk = jnp.split(mqk, 2, axis=-1)
        ig = (mi.astype(f32) + mlstm_i_bias[l].astype(f32)).transpose(0, 2, 1)
        lf = jax.nn.log_sigmoid(mf.astype(f32) + mlstm_f_bias[l].astype(f32)).transpose(0, 2, 1)
        mh = _mlstm_chunkwise(_to_heads(mq, MLSTM_HEADS), _to_heads(mk, MLSTM_HEADS),
                              _to_heads(mv, MLSTM_HEADS), ig, lf).astype(x.dtype)
        mh = _rms(_from_heads(mh), mlstm_out_norm[l].reshape(MLSTM_HEADS, MLSTM_V_DIM))
        mh = mh.reshape(bsz, s_len, MLSTM_WIDTH) * jax.nn.sigmoid(mo)

        x = x + jnp.concatenate([fo, mh], axis=-1) @ w_out[l]

        xn = _rms(x, xattn_norm[l])
        mn = _rms(mem, mem_norm[l])
        q = _rms(_to_heads(xn @ w_xq[l], XATTN_HEADS), xq_norm[l])
        mk_, mv_ = jnp.split(mn @ w_xkv[l], 2, axis=-1)
        k = _rms(_to_heads(mk_, XATTN_HEADS), xk_norm[l])
        v = _to_heads(mv_, XATTN_HEADS)
        sc = jnp.einsum("bhqd,bhkd->bhqk", q, k).astype(f32) * XATTN_HEAD_DIM ** -0.5
        p = jax.nn.softmax(sc, axis=-1).astype(v.dtype)
        co = _from_heads(jnp.einsum("bhqk,bhkd->bhqd", p, v)).reshape(bsz, s_len, D_MODEL)
        x = x + co @ w_xo[l]

        xn = _rms(x, mlp_norm[l])
        x = x + jnp.square(jax.nn.relu(xn @ w_up[l])) @ w_down[l]
    return x
```

```cpp
#include <hip/hip_runtime.h>
#include <hip/hip_cooperative_groups.h>
#include <cstdio>
#include <cstdint>
namespace cg = cooperative_groups;

constexpr int BATCH = 4, SEQ = 4096, DM = 2048, MTOK = BATCH * SEQ;
constexpr int NMEM = 256, MROWS = BATCH * NMEM;
constexpr int FOXH = 8, FOXD = 128, MLH = 4, MLDV = 256, MLDK = 128, XH = 4, XD = 512, DFF = 8192;
constexpr int IN_WIDTH = 6160, NPROJ = 6144, NCHUNK = SEQ / 64;
constexpr float EPS = 1e-6f;
constexpr float LOG2E = 1.4426950408889634f;

constexpr size_t MiB = (size_t)1 << 20;
constexpr size_t WS_WIN = 0, WS_WOUT = 24 * MiB, WS_WXQ = 32 * MiB, WS_WXKV = 40 * MiB, WS_WXO = 56 * MiB, WS_WUP = 64 * MiB, WS_WDN = 96 * MiB;
constexpr size_t WS_PROJ = 128 * MiB;
constexpr size_t WS_FQ = 128 * MiB, WS_FK = 160 * MiB, WS_FV = 192 * MiB, WS_MQK = 224 * MiB, WS_MV = 256 * MiB, WS_MO = 288 * MiB;
constexpr size_t WS_XN = 320 * MiB;
constexpr size_t WS_QP = 384 * MiB, WS_KPP = 400 * MiB;
constexpr size_t WS_KT = 416 * MiB;
constexpr size_t WS_VT = 432 * MiB;
constexpr size_t WS_MISC = 464 * MiB;
constexpr size_t WS_CTL = WS_MISC, CTL_BYTES = 1 * MiB;
constexpr size_t CTL_SSQ1 = 64 * 1024, CTL_SSQ2 = 128 * 1024, CTL_SSQQ = 192 * 1024;
constexpr size_t WS_GATES = WS_MISC + 1 * MiB;
constexpr size_t WS_RINV = WS_MISC + 2 * MiB;
constexpr size_t WS_CFOX = WS_MISC + 3 * MiB;
constexpr size_t WS_EB = WS_MISC + 4 * MiB;
constexpr size_t WS_KSUM = WS_MISC + 5 * MiB;
constexpr size_t WS_NST = WS_MISC + 6 * MiB;
constexpr size_t WS_MN = WS_MISC + 8 * MiB;
constexpr size_t WS_KHAT = WS_MISC + 12 * MiB;
constexpr size_t WS_VTM = WS_MISC + 16 * MiB;
constexpr size_t WS_END = 512 * MiB;
constexpr size_t WS_CONCAT = 224 * MiB;
constexpr size_t WS_X1B = 128 * MiB;
constexpr size_t WS_Q = 192 * MiB;
constexpr size_t WS_CO = 256 * MiB;
constexpr size_t WS_P = 320 * MiB;
constexpr size_t WS_X2B = 128 * MiB;
constexpr size_t WS_H = 192 * MiB;
constexpr size_t OUT_SLAB = 0, OUT_CST = 64 * MiB;

constexpr int LDS_BYTES = 147456;
constexpr int NTHREADS = 512;

#define GAS __attribute__((address_space(1)))
#define LAS __attribute__((address_space(3)))
typedef unsigned short bf16;
typedef unsigned v4u __attribute__((ext_vector_type(4)));
typedef unsigned v2u __attribute__((ext_vector_type(2)));
typedef float v4f __attribute__((ext_vector_type(4)));
typedef short v8s __attribute__((ext_vector_type(8)));
typedef short v4s __attribute__((ext_vector_type(4)));
#define LDS_WAIT() asm volatile("s_waitcnt lgkmcnt(0)" ::: "memory")
#define VM_WAIT() asm volatile("s_waitcnt vmcnt(0)" ::: "memory")
__device__ __forceinline__ unsigned f2bf(float f) { unsigned u = __builtin_bit_cast(unsigned, f); return (u + 0x7fffu + ((u >> 16) & 1u)) >> 16; }
__device__ __forceinline__ unsigned pk2(float lo, float hi) { return f2bf(lo) | (f2bf(hi) << 16); }
__device__ __forceinline__ float bf2f(unsigned h) { return __builtin_bit_cast(float, h << 16); }
__device__ __forceinline__ float bflo(unsigned w) { return __builtin_bit_cast(float, w << 16); }
__device__ __forceinline__ float bfhi(unsigned w) { return __builtin_bit_cast(float, w & 0xffff0000u); }
__device__ __forceinline__ float wave_sum(float v) {
#pragma unroll
    for (int o = 1; o < 64; o <<= 1) v += __shfl_xor(v, o);
    return v;
}
__device__ __forceinline__ float logsigmoidf(float x) { return x >= 0.f ? -log1pf(__expf(-x)) : x - log1pf(__expf(x)); }
__device__ __forceinline__ float sigmoidf_(float x) { return 1.f / (1.f + __expf(-x)); }
#define MK_PER_PHASE 1
namespace pg8 {
#define PG8_LAS __attribute__((address_space(3)))
typedef unsigned short bf16_t;
typedef short bf16x8 __attribute__((ext_vector_type(8)));
typedef float f32x4 __attribute__((ext_vector_type(4)));
typedef float f32x2 __attribute__((ext_vector_type(2)));
typedef unsigned u32x4 __attribute__((ext_vector_type(4)));
typedef unsigned u32x2 __attribute__((ext_vector_type(2)));
constexpr int BM = 256, BK = 64, HALF = 128, HTB = HALF * BK * 2, STAGE_BYTES = 8 * HTB, NXCD = 8, WGM = 8;

__host__ __device__ __forceinline__ int lds_byte(int r, int c) { const int st = (r >> 4) * 2 + (c >> 5), rr = r & 15, cc = c & 31, ob = rr * 64 + cc * 2; return st * 1024 + (ob ^ (((ob >> 9) & 1) << 5)); }
__host__ __device__ __forceinline__ void stage_rc(int b, int& R, int& C) { const int st = b / 1024, sb = b % 1024, swz = sb ^ (((sb >> 9) & 1) << 5); R = (st >> 1) * 16 + swz / 64; C = (st & 1) * 32 + (swz % 64) / 2; }
__host__ __device__ __forceinline__ int perm32(int rho) { const int n = rho >> 4, i = rho & 15; return 8 * (i >> 2) + 4 * n + (i & 3); }

struct Unit { int row0, col0; long aoff, boff; int aux; };
struct Gemm { const bf16_t* A; const bf16_t* Bt; int lda, ldb, K; };

struct StdOrder {
    int nM, nN, nwg, G, c, lda, ldb;
    __device__ void init(int M, int N, int lda_, int ldb_, int G_, int c_) { nM = M / BM; nN = N / BM; nwg = nM * nN; G = G_; c = c_; lda = lda_; ldb = ldb_; }
    __device__ bool next(int i, Unit& u) const {
        const long L = (long)i * G + c; if (L >= nwg) return false;
        int wgid = (int)L; { const int q = nwg / NXCD, r = nwg % NXCD, xcd = wgid % NXCD, off = wgid / NXCD; wgid = (xcd < r ? xcd * (q + 1) : r * (q + 1) + (xcd - r) * q) + off; }
        const int nig = WGM * nN, gid = wgid / nig, fm = gid * WGM, gsz = (nM - fm) < WGM ? (nM - fm) : WGM;
        const int pm = fm + ((wgid % nig) % gsz), pn = (wgid % nig) / gsz;
        u.row0 = pm * BM; u.col0 = pn * BM; u.aoff = (long)pm * BM * lda; u.boff = (long)pn * BM * ldb; u.aux = 0; return true;
    }
};

__device__ __forceinline__ unsigned cvt_pk_bf16(float lo, float hi) { unsigned r; asm volatile("v_cvt_pk_bf16_f32 %0, %1, %2" : "=v"(r) : "v"(lo), "v"(hi)); return r; }

template <class Epi, class Sched, bool ALIGN_EPI>
__device__ __forceinline__ void gemm_phase(PG8_LAS unsigned char* lds, const Gemm g, const Sched& S, const Epi& E) {
    const int tid = threadIdx.x, wid = __builtin_amdgcn_readfirstlane(tid >> 6), lane = tid & 63, wr = wid >> 2, wc = wid & 3, fr = lane & 15, fq = lane >> 4;
    const int K = g.K, nt = K / BK;
    unsigned voffA[2], voffB[2];
#pragma unroll
    for (int i = 0; i < 2; ++i) { int R, C; stage_rc(tid * 16 + i * 8192, R, C); const int Rb = Epi::PERM ? ((R & ~31) + perm32(R & 31)) : R;
        voffA[i] = (unsigned)(R * g.lda + C) * 2u; voffB[i] = (unsigned)(Rb * g.ldb + C) * 2u; }
    const size_t kstep = (size_t)(BK * 2);
    const size_t hA = (size_t)HALF * g.lda * 2, hB = (size_t)HALF * g.ldb * 2;
    const unsigned ldsw = (unsigned)wid * 1024u;
    const int aoff = lds_byte(wr * 64 + fr, fq * 8), boff = lds_byte(wc * 32 + fr, fq * 8);
#define PG8_SA(b, h) (((b) * 2 + (h)) * HTB)
#define PG8_SB(b, h) ((4 + (b) * 2 + (h)) * HTB)
#define PG8_STAGE(bufoff, gbase, voff) do { _Pragma("unroll") for (int _i = 0; _i < 2; ++_i) \
        __builtin_amdgcn_global_load_lds((const unsigned*)((const char*)(gbase) + (voff)[_i]), (PG8_LAS unsigned*)(lds + (bufoff) + ldsw + _i * 8192), 16, 0, 0); } while (0)
#define PG8_LDA(dst, b, h) do { _Pragma("unroll") for (int m = 0; m < 4; ++m) _Pragma("unroll") for (int k = 0; k < 2; ++k) dst[m][k] = *(const PG8_LAS bf16x8*)(lds + PG8_SA(b, h) + aoff + m * 2048 + k * 1024); } while (0)
#define PG8_LDB(dst, b, h) do { _Pragma("unroll") for (int n = 0; n < 2; ++n) _Pragma("unroll") for (int k = 0; k < 2; ++k) dst[n][k] = *(const PG8_LAS bf16x8*)(lds + PG8_SB(b, h) + boff + n * 2048 + k * 1024); } while (0)
#define PG8_MMA(ai, bj, At, Bt) do { __builtin_amdgcn_s_setprio(1); _Pragma("unroll") for (int m = 0; m < 4; ++m) _Pragma("unroll") for (int n = 0; n < 2; ++n) _Pragma("unroll") for (int k = 0; k < 2; ++k) \
        acc[ai][bj][m][n] = __builtin_amdgcn_mfma_f32_16x16x32_bf16(Bt[n][k], At[m][k], acc[ai][bj][m][n], 0, 0, 0); __builtin_amdgcn_s_setprio(0); } while (0)
#define PG8_WAIT_V(n) asm volatile("s_waitcnt vmcnt(" #n ")" ::: "memory")
#define PG8_WAIT_L(n) asm volatile("s_waitcnt lgkmcnt(" #n ")" ::: "memory")
#define PG8_BAR __builtin_amdgcn_s_barrier()
#define PG8_SCHED __builtin_amdgcn_sched_barrier(0)
    Unit cur, nxt; int ui = 0;
    if (!S.next(0, cur)) return;
    f32x4 acc[2][2][4][2];
#pragma unroll
    for (int a = 0; a < 2; ++a)
#pragma unroll
        for (int b = 0; b < 2; ++b)
#pragma unroll
            for (int m = 0; m < 4; ++m)
#pragma unroll
                for (int n = 0; n < 2; ++n) acc[a][b][m][n] = (f32x4){0.f, 0.f, 0.f, 0.f};
    bf16x8 At[4][2], B0[2][2], B1[2][2];
    const char* cA = (const char*)g.A + (size_t)cur.aoff * 2; const char* cB = (const char*)g.Bt + (size_t)cur.boff * 2;
    PG8_STAGE(PG8_SB(0, 0), cB, voffB); PG8_STAGE(PG8_SB(0, 1), cB + hB, voffB); PG8_STAGE(PG8_SA(0, 0), cA, voffA); PG8_STAGE(PG8_SA(0, 1), cA + hA, voffA);
    if (wr == 1) PG8_BAR;
    PG8_WAIT_V(2); PG8_BAR;
    PG8_STAGE(PG8_SB(1, 0), cB + kstep, voffB); PG8_STAGE(PG8_SA(1, 0), cA + kstep, voffA); PG8_STAGE(PG8_SB(1, 1), cB + hB + kstep, voffB);
    PG8_WAIT_V(6); PG8_BAR;
    for (;;) {
        const bool has_next = S.next(ui + 1, nxt);
        const char* nA = has_next ? (const char*)g.A + (size_t)nxt.aoff * 2 : cA; const char* nB = has_next ? (const char*)g.Bt + (size_t)nxt.boff * 2 : cB;
        for (int t = 0; t < nt; t += 2) {
            const bool last = (t == nt - 2);
            const char* a1 = cA + (size_t)(t + 1) * kstep;
            const char* a2 = last ? nA : cA + (size_t)(t + 2) * kstep; const char* b2 = last ? nB : cB + (size_t)(t + 2) * kstep;
            const char* a3 = a2 + kstep; const char* b3 = b2 + kstep;
            PG8_LDB(B0, 0, 0); PG8_LDB(B1, 0, 1); PG8_SCHED; PG8_LDA(At, 0, 0); PG8_STAGE(PG8_SA(1, 1), a1 + hA, voffA);
            PG8_WAIT_V(8); PG8_WAIT_L(0); PG8_BAR; PG8_MMA(0, 0, At, B0); PG8_MMA(0, 1, At, B1); PG8_BAR; PG8_SCHED;
            PG8_LDA(At, 0, 1); PG8_STAGE(PG8_SB(0, 0), b2, voffB); PG8_STAGE(PG8_SB(0, 1), b2 + hB, voffB); PG8_STAGE(PG8_SA(0, 0), a2, voffA);
            PG8_WAIT_V(8); PG8_WAIT_L(0); PG8_BAR; PG8_MMA(1, 0, At, B0); PG8_MMA(1, 1, At, B1); PG8_BAR; PG8_SCHED;
            PG8_LDB(B0, 1, 0); PG8_LDB(B1, 1, 1); PG8_SCHED; PG8_LDA(At, 1, 0); PG8_STAGE(PG8_SA(0, 1), a2 + hA, voffA);
            PG8_WAIT_V(8); PG8_WAIT_L(0); PG8_BAR; PG8_MMA(0, 0, At, B0); PG8_MMA(0, 1, At, B1); PG8_BAR; PG8_SCHED;
            PG8_LDA(At, 1, 1); PG8_STAGE(PG8_SB(1, 0), b3, voffB); PG8_STAGE(PG8_SB(1, 1), b3 + hB, voffB); PG8_STAGE(PG8_SA(1, 0), a3, voffA);
            PG8_WAIT_V(8); PG8_WAIT_L(0); PG8_BAR; PG8_MMA(1, 0, At, B0); PG8_MMA(1, 1, At, B1); PG8_BAR; PG8_SCHED;
        }
        if constexpr (ALIGN_EPI) { if (wr == 0) PG8_BAR; }
        if constexpr (!Epi::AFTER_DRAIN) { E(acc, cur, wr, wc, fr, fq); }
        if (!has_next) break;
#pragma unroll
        for (int a = 0; a < 2; ++a)
#pragma unroll
            for (int b = 0; b < 2; ++b)
#pragma unroll
                for (int m = 0; m < 4; ++m)
#pragma unroll
                    for (int n = 0; n < 2; ++n) acc[a][b][m][n] = (f32x4){0.f, 0.f, 0.f, 0.f};
        cur = nxt; cA = nA; cB = nB; ++ui;
        if constexpr (ALIGN_EPI) { if (wr == 1) PG8_BAR; }
    }
    PG8_WAIT_V(0);
    if constexpr (!ALIGN_EPI) { if (wr == 0) PG8_BAR; }
    PG8_BAR;
    if constexpr (Epi::AFTER_DRAIN) { E.fused(acc, cur, wr, wc, fr, fq, lds, wid, lane); }
#undef PG8_SA
#undef PG8_SB
#undef PG8_STAGE
#undef PG8_LDA
#undef PG8_LDB
#undef PG8_MMA
#undef PG8_WAIT_V
#undef PG8_WAIT_L
#undef PG8_BAR
#undef PG8_SCHED
}
}
namespace pg8 {
struct XkvOrder {
    int G, c;
    __device__ bool next(int i, Unit& u) const {
        const int L = i * G + c; if (L >= 256) return false;
        const int kq = L & 3, tile = L >> 2, pm = tile & 3, pn = tile >> 2;
        u.row0 = pm * 256; u.col0 = pn * 256; u.aoff = (long)pm * 256 * DM + kq * 512; u.boff = (long)pn * 256 * DM + kq * 512; u.aux = kq; return true;
    }
};
struct ScoreOrder {
    int G, c;
    __device__ bool next(int i, Unit& u) const {
        const int L = i * G + c; if (L >= 256) return false;
        const int b = L >> 6, h = (L >> 4) & 3, mt = L & 15;
        u.row0 = b * SEQ + mt * 256; u.col0 = h * 256; u.aoff = (long)u.row0 * DM + h * XD; u.boff = (long)(b * NMEM) * DM + h * XD; u.aux = h; return true;
    }
};
struct PvOrder {
    int G, c;
    __device__ bool next(int i, Unit& u) const {
        const int L = i * G + c; if (L >= 512) return false;
        const int nt = L & 1, mt = (L >> 1) & 15, h = (L >> 5) & 3, b = L >> 7;
        u.row0 = b * SEQ + mt * 256; u.col0 = h * XD + nt * 256; u.aoff = (long)u.row0 * 1024 + h * 256; u.boff = ((long)(b * XH + h) * XD + nt * 256) * NMEM; u.aux = 0; return true;
    }
};

struct EpiStoreBf16 {
    static constexpr bool PERM = true, AFTER_DRAIN = false;
    bf16_t* O; int ldc; int split_cols; size_t split_stride;
    __device__ __forceinline__ void operator()(const f32x4 (&acc)[2][2][4][2], const Unit& u, int wr, int wc, int fr, int fq) const {
        int colt = u.col0; bf16_t* base = O;
        if (split_cols) { const int t = colt / split_cols; base += (size_t)t * split_stride; colt -= t * split_cols; }
        const int row0 = u.row0 + wr * 64 + fr, col0 = colt + wc * 32 + 8 * fq;
#pragma unroll
        for (int ai = 0; ai < 2; ++ai)
#pragma unroll
            for (int m = 0; m < 4; ++m) { bf16_t* rowp = base + (size_t)(row0 + ai * HALF + m * 16) * ldc + col0;
#pragma unroll
                for (int bj = 0; bj < 2; ++bj) { const f32x4 v0 = acc[ai][bj][m][0], v1 = acc[ai][bj][m][1];
                    u32x4 w; w.x = cvt_pk_bf16(v0[0], v0[1]); w.y = cvt_pk_bf16(v0[2], v0[3]); w.z = cvt_pk_bf16(v1[0], v1[1]); w.w = cvt_pk_bf16(v1[2], v1[3]);
                    *(u32x4*)(rowp + bj * HALF) = w; } }
    }
};
struct EpiSlab {
    static constexpr bool PERM = false, AFTER_DRAIN = false;
    float* slab; int ldc; size_t slab_stride;
    __device__ __forceinline__ void operator()(const f32x4 (&acc)[2][2][4][2], const Unit& u, int wr, int wc, int fr, int fq) const {
        float* base = slab + (size_t)u.aux * slab_stride; const int col0 = u.col0 + wc * 32 + 4 * fq;
#pragma unroll
        for (int ai = 0; ai < 2; ++ai)
#pragma unroll
            for (int m = 0; m < 4; ++m) { float* rowp = base + (size_t)(u.row0 + ai * HALF + wr * 64 + m * 16 + fr) * ldc + col0;
#pragma unroll
                for (int bj = 0; bj < 2; ++bj)
#pragma unroll
                    for (int n = 0; n < 2; ++n) *(f32x4*)(rowp + bj * HALF + n * 16) = acc[ai][bj][m][n]; }
    }
};
struct EpiResid {
    static constexpr bool PERM = false, AFTER_DRAIN = false;
    const float* base; float* out; bf16_t* outb; float* ssq; int ldc;
    __device__ __forceinline__ void operator()(const f32x4 (&acc)[2][2][4][2], const Unit& u, int wr, int wc, int fr, int fq) const {
        const int col0 = u.col0 + wc * 32 + 4 * fq;
        float ssum[2][4];
#pragma unroll
        for (int ai = 0; ai < 2; ++ai)
#pragma unroll
            for (int m = 0; m < 4; ++m) { const size_t off = (size_t)(u.row0 + ai * HALF + wr * 64 + m * 16 + fr) * ldc + col0; float s = 0.f;
#pragma unroll
                for (int bj = 0; bj < 2; ++bj)
#pragma unroll
                    for (int n = 0; n < 2; ++n) { const f32x4 bs = *(const f32x4*)(base + off + bj * HALF + n * 16); const f32x4 v = bs + acc[ai][bj][m][n];
                        *(f32x4*)(out + off + bj * HALF + n * 16) = v;
                        if (outb) { u32x2 w; w.x = cvt_pk_bf16(v[0], v[1]); w.y = cvt_pk_bf16(v[2], v[3]); *(u32x2*)(outb + off + bj * HALF + n * 16) = w; }
                        s += (v[0] * v[0] + v[1] * v[1]) + (v[2] * v[2] + v[3] * v[3]); }
                s += __shfl_xor(s, 16); s += __shfl_xor(s, 32); ssum[ai][m] = s; }
        if (ssq) {
#pragma unroll
            for (int ai = 0; ai < 2; ++ai) { const float v = fq == 0 ? ssum[ai][0] : fq == 1 ? ssum[ai][1] : fq == 2 ? ssum[ai][2] : ssum[ai][3];
                atomicAdd(ssq + u.row0 + ai * HALF + wr * 64 + fq * 16 + fr, v); }
        }
    }
};
struct EpiQ {
    static constexpr bool PERM = true, AFTER_DRAIN = false;
    bf16_t* O; const float* ssq_in; float* ssq_out;
    __device__ __forceinline__ void operator()(const f32x4 (&acc)[2][2][4][2], const Unit& u, int wr, int wc, int fr, int fq) const {
        const int col0 = u.col0 + wc * 32 + 8 * fq; float* so = ssq_out + (size_t)(u.col0 / XD) * MTOK;
        float ssum[2][4];
#pragma unroll
        for (int ai = 0; ai < 2; ++ai)
#pragma unroll
            for (int m = 0; m < 4; ++m) { const int row = u.row0 + ai * HALF + wr * 64 + m * 16 + fr; const float ri = __builtin_amdgcn_rsqf(ssq_in[row] * (1.0f / DM) + EPS);
                bf16_t* rowp = O + (size_t)row * DM + col0; float s = 0.f;
#pragma unroll
                for (int bj = 0; bj < 2; ++bj) { const f32x4 v0 = acc[ai][bj][m][0] * ri, v1 = acc[ai][bj][m][1] * ri;
                    u32x4 w; w.x = cvt_pk_bf16(v0[0], v0[1]); w.y = cvt_pk_bf16(v0[2], v0[3]); w.z = cvt_pk_bf16(v1[0], v1[1]); w.w = cvt_pk_bf16(v1[2], v1[3]);
                    *(u32x4*)(rowp + bj * HALF) = w;
                    s += (v0[0] * v0[0] + v0[1] * v0[1]) + (v0[2] * v0[2] + v0[3] * v0[3]) + (v1[0] * v1[0] + v1[1] * v1[1]) + (v1[2] * v1[2] + v1[3] * v1[3]); }
                s += __shfl_xor(s, 16); s += __shfl_xor(s, 32); ssum[ai][m] = s; }
#pragma unroll
        for (int ai = 0; ai < 2; ++ai) { const float v = fq == 0 ? ssum[ai][0] : fq == 1 ? ssum[ai][1] : fq == 2 ? ssum[ai][2] : ssum[ai][3];
            atomicAdd(so + u.row0 + ai * HALF + wr * 64 + fq * 16 + fr, v); }
    }
};
struct EpiUp {
    static constexpr bool PERM = true, AFTER_DRAIN = false;
    bf16_t* O; const float* ssq_in;
    __device__ __forceinline__ void operator()(const f32x4 (&acc)[2][2][4][2], const Unit& u, int wr, int wc, int fr, int fq) const {
        const int col0 = u.col0 + wc * 32 + 8 * fq;
#pragma unroll
        for (int ai = 0; ai < 2; ++ai)
#pragma unroll
            for (int m = 0; m < 4; ++m) { const int row = u.row0 + ai * HALF + wr * 64 + m * 16 + fr; const float ri = __builtin_amdgcn_rsqf(ssq_in[row] * (1.0f / DM) + EPS);
                bf16_t* rowp = O + (size_t)row * DFF + col0;
#pragma unroll
                for (int bj = 0; bj < 2; ++bj) { f32x4 v0 = acc[ai][bj][m][0] * ri, v1 = acc[ai][bj][m][1] * ri;
#pragma unroll
                    for (int e = 0; e < 4; ++e) { const float a = fmaxf(v0[e], 0.f), b = fmaxf(v1[e], 0.f); v0[e] = a * a; v1[e] = b * b; }
                    u32x4 w; w.x = cvt_pk_bf16(v0[0], v0[1]); w.y = cvt_pk_bf16(v0[2], v0[3]); w.z = cvt_pk_bf16(v1[0], v1[1]); w.w = cvt_pk_bf16(v1[2], v1[3]);
                    *(u32x4*)(rowp + bj * HALF) = w; } }
    }
};
struct EpiSoftmax {
    static constexpr bool PERM = true, AFTER_DRAIN = true;
    bf16_t* P; const float* ssqq;
    __device__ __forceinline__ void fused(f32x4 (&acc)[2][2][4][2], const Unit& u, int wr, int wc, int fr, int fq, PG8_LAS unsigned char* lds, int wid, int lane) const {
        PG8_LAS float* RM = (PG8_LAS float*)lds;
        PG8_LAS float* RS = (PG8_LAS float*)(lds + 4096);
        const float* sq = ssqq + (size_t)u.aux * MTOK;
        float mx[2][4];
#pragma unroll
        for (int ai = 0; ai < 2; ++ai)
#pragma unroll
            for (int m = 0; m < 4; ++m) { const int rl = ai * HALF + wr * 64 + m * 16 + fr; const int row = u.row0 + rl;
                const float sc = __builtin_amdgcn_rsqf(sq[row] * (1.0f / XD) + EPS) * (0.044194173824159216f * LOG2E);
                float mxx = -3.0e38f;
#pragma unroll
                for (int bj = 0; bj < 2; ++bj)
#pragma unroll
                    for (int n = 0; n < 2; ++n) { f32x4 v = acc[ai][bj][m][n] * sc; acc[ai][bj][m][n] = v; mxx = fmaxf(mxx, fmaxf(fmaxf(v[0], v[1]), fmaxf(v[2], v[3]))); }
                mxx = fmaxf(mxx, __shfl_xor(mxx, 16)); mxx = fmaxf(mxx, __shfl_xor(mxx, 32));
                if (fq == 0) RM[rl * 4 + wc] = mxx; }
        asm volatile("s_waitcnt lgkmcnt(0)" ::: "memory"); __builtin_amdgcn_s_barrier(); asm volatile("" ::: "memory");
#pragma unroll
        for (int ai = 0; ai < 2; ++ai)
#pragma unroll
            for (int m = 0; m < 4; ++m) { const int rl = ai * HALF + wr * 64 + m * 16 + fr;
                const f32x4 r4 = *(const PG8_LAS f32x4*)(RM + rl * 4); const float mxx = fmaxf(fmaxf(r4[0], r4[1]), fmaxf(r4[2], r4[3])); mx[ai][m] = mxx; float s = 0.f;
#pragma unroll
                for (int bj = 0; bj < 2; ++bj)
#pragma unroll
                    for (int n = 0; n < 2; ++n) { f32x4 v = acc[ai][bj][m][n];
#pragma unroll
                        for (int e = 0; e < 4; ++e) { v[e] = __builtin_amdgcn_exp2f(v[e] - mxx); s += v[e]; }
                        acc[ai][bj][m][n] = v; }
                s += __shfl_xor(s, 16); s += __shfl_xor(s, 32);
                if (fq == 0) RS[rl * 4 + wc] = s; }
        asm volatile("s_waitcnt lgkmcnt(0)" ::: "memory"); __builtin_amdgcn_s_barrier(); asm volatile("" ::: "memory");
        const int col0 = u.col0 + wc * 32 + 8 * fq;
#pragma unroll
        for (int ai = 0; ai < 2; ++ai)
#pragma unroll
            for (int m = 0; m < 4; ++m) { const int rl = ai * HALF + wr * 64 + m * 16 + fr;
                const f32x4 r4 = *(const PG8_LAS f32x4*)(RS + rl * 4); const float inv = 1.0f / ((r4[0] + r4[1]) + (r4[2] + r4[3]));
                bf16_t* rowp = P + (size_t)(u.row0 + rl) * 1024 + col0;
#pragma unroll
                for (int bj = 0; bj < 2; ++bj) { const f32x4 v0 = acc[ai][bj][m][0] * inv, v1 = acc[ai][bj][m][1] * inv;
                    u32x4 w; w.x = cvt_pk_bf16(v0[0], v0[1]); w.y = cvt_pk_bf16(v0[2], v0[3]); w.z = cvt_pk_bf16(v1[0], v1[1]); w.w = cvt_pk_bf16(v1[2], v1[3]);
                    *(u32x4*)(rowp + bj * HALF) = w; } }
        (void)mx; (void)wid; (void)lane;
    }
};
}
namespace fox {
typedef short bf16x8 __attribute__((ext_vector_type(8)));
typedef short s16x4 __attribute__((ext_vector_type(4)));
typedef float f32x16 __attribute__((ext_vector_type(16)));
typedef float f32x4 __attribute__((ext_vector_type(4)));
typedef unsigned u32x4 __attribute__((ext_vector_type(4)));
constexpr int D = 128, PITCH = 1024, OPITCH = 2048;
constexpr int NW = 8, QBLK = 32, KVBLK = 64, QB = NW * QBLK;
constexpr int SHM_V = KVBLK * D * 2, SHM_K = KVBLK * D * 2;
constexpr int LDS_BIAS = 0, LDS_WS = 512, LDS_V = 4096, LDS_K = LDS_V + 2 * SHM_V, LDS_Q = LDS_K + 2 * SHM_K, LDS_BYTES = LDS_Q + NW * 8192;
constexpr float SCALE = 0.08838834764831845f, C2 = LOG2E * SCALE, THR = 8.f;

#define KSWZ(row, colB) ((row) * 256 + ((colB) ^ (((row) & 7) << 4)))
#define SBAR() __builtin_amdgcn_sched_barrier(0)
__device__ __forceinline__ int v_st(int k, int c) { const int kk = (k & ~0xC) | ((k & 4) << 1) | ((k & 8) >> 1); return ((kk >> 3) * 4 + (c >> 5)) * 512 + ((kk & 7) * 32 + (c & 31)) * 2; }
__device__ __forceinline__ int v_rd_base(int lane) { return ((lane & 3) << 3) | (((lane >> 2) & 3) << 6) | (((lane >> 4) & 1) << 5) | (((lane >> 5) & 1) << 8); }
constexpr int v_rd_off(int d0, int ks, int half) { return d0 * 512 + ks * 4096 + half * 2048; }
__device__ __forceinline__ int crow(int r, int hi) { return (r & 3) + 8 * (r >> 2) + 4 * hi; }
__device__ __forceinline__ unsigned cvtpk(float lo, float hi) { unsigned r; asm volatile("v_cvt_pk_bf16_f32 %0, %1, %2" : "=v"(r) : "v"(lo), "v"(hi)); return r; }
__device__ __forceinline__ bf16x8 load8(const bf16* p) { return *reinterpret_cast<const bf16x8*>(p); }

__device__ __forceinline__ void mask_tile(f32x16& p0, f32x16& p1, int dq) {
    const float NEG = -__builtin_inff();
#pragma unroll
    for (int r = 0; r < 16; ++r) { const int c = (r & 3) + 8 * (r >> 2);
        if (dq - c < 0) p0[r] = NEG;
        if (dq - c - 32 < 0) p1[r] = NEG; }
}
__device__ __forceinline__ void partialSM(f32x16& p0, f32x16& p1, float& m_reg, float& mn, float& alpha) {
    float pmax = p0[0];
#pragma unroll
    for (int r = 1; r < 16; ++r) pmax = fmaxf(pmax, p0[r]);
#pragma unroll
    for (int r = 0; r < 16; ++r) pmax = fmaxf(pmax, p1[r]);
    { auto rr = __builtin_amdgcn_permlane32_swap(__float_as_uint(pmax), __float_as_uint(pmax), false, false);
      pmax = fmaxf(__uint_as_float(rr[0]), __uint_as_float(rr[1])); }
    if (__builtin_expect(__all((pmax - m_reg) * SCALE <= THR), 1)) { mn = m_reg; alpha = 1.f; }
    else { mn = fmaxf(m_reg, pmax); alpha = __builtin_amdgcn_exp2f((m_reg - mn) * C2); m_reg = mn; }
    const float mnL = -mn * C2;
#pragma unroll
    for (int r = 0; r < 16; ++r) p0[r] = fmaf(p0[r], C2, mnL);
#pragma unroll
    for (int r = 0; r < 16; ++r) p1[r] = fmaf(p1[r], C2, mnL);
#pragma unroll
    for (int r = 0; r < 16; ++r) p0[r] = __builtin_amdgcn_exp2f(p0[r]);
}
__device__ __forceinline__ void finishSM(f32x16& p0, f32x16& p1, float alpha, float& l_reg, bf16x8& pa0, bf16x8& pa1, bf16x8& pa2, bf16x8& pa3) {
#pragma unroll
    for (int r = 0; r < 16; ++r) p1[r] = __builtin_amdgcn_exp2f(p1[r]);
    float ps = 0;
#pragma unroll
    for (int r = 0; r < 16; ++r) ps += p0[r];
#pragma unroll
    for (int r = 0; r < 16; ++r) ps += p1[r];
    { auto rr = __builtin_amdgcn_permlane32_swap(__float_as_uint(ps), __float_as_uint(ps), false, false);
      ps = __uint_as_float(rr[0]) + __uint_as_float(rr[1]); }
    l_reg = l_reg * alpha + ps;
#define PK4(P, B_, OUT) do { unsigned a0 = cvtpk(P[B_+0], P[B_+1]), a1 = cvtpk(P[B_+2], P[B_+3]);                          \
        unsigned b0 = cvtpk(P[B_+4], P[B_+5]), b1 = cvtpk(P[B_+6], P[B_+7]);                                             \
        auto r0 = __builtin_amdgcn_permlane32_swap(a0, b0, false, false); auto r1 = __builtin_amdgcn_permlane32_swap(a1, b1, false, false); \
        u32x4 w = {r0[0], r1[0], r0[1], r1[1]}; OUT = *reinterpret_cast<bf16x8*>(&w); } while (0)
    PK4(p0, 0, pa0); PK4(p0, 8, pa1); PK4(p1, 0, pa2); PK4(p1, 8, pa3);
#undef PK4
}
template <int KB>
__device__ __forceinline__ void qkt(f32x16& p0, f32x16& p1, const char* K_lds, const float* bl, int r32, int hi, const char* qw) {
#pragma unroll
    for (int g = 0; g < 4; ++g) { const f32x4 b0 = *(const f32x4*)(bl + KB * 64 + 8 * g + 4 * hi), b1 = *(const f32x4*)(bl + KB * 64 + 32 + 8 * g + 4 * hi);
#pragma unroll
        for (int i = 0; i < 4; ++i) { p0[4 * g + i] = b0[i]; p1[4 * g + i] = b1[i]; } }
    const char* kb[4];
#pragma unroll
    for (int dd = 0; dd < 4; ++dd) kb[dd] = K_lds + KB * SHM_K + KSWZ(r32, (dd * 16 + hi * 8) * 2);
#pragma unroll
    for (int d0 = 0; d0 < 8; ++d0) { const char* a = kb[d0 & 3] + (d0 >> 2) * 128;
        bf16x8 b0 = *reinterpret_cast<const bf16x8*>(a);
        bf16x8 b1 = *reinterpret_cast<const bf16x8*>(a + 32 * 256);
        const bf16x8 qf = *reinterpret_cast<const bf16x8*>(qw + d0 * 1024);
        p0 = __builtin_amdgcn_mfma_f32_32x32x16_bf16(b0, qf, p0, 0, 0, 0);
        p1 = __builtin_amdgcn_mfma_f32_32x32x16_bf16(b1, qf, p1, 0, 0, 0); }
}
template <int VB>
__device__ __forceinline__ void pv_tile(f32x16* o, int vb0, bf16x8 pa0, bf16x8 pa1, bf16x8 pa2, bf16x8 pa3) {
#define TRRD(dst, off) asm volatile("ds_read_b64_tr_b16 %0, %1 offset:%2" : "=&v"(dst) : "v"(vb0), "i"(off) : "memory")
#define PV_D0(d0) do { s16x4 l0, l1, l2, l3, h0, h1, h2, h3; constexpr int b_ = VB * SHM_V + v_rd_off(d0, 0, 0); \
        TRRD(l0, b_); TRRD(h0, b_ + 2048); TRRD(l1, b_ + 4096); TRRD(h1, b_ + 6144); TRRD(l2, b_ + 8192); TRRD(h2, b_ + 10240); TRRD(l3, b_ + 12288); TRRD(h3, b_ + 14336); \
        asm volatile("s_waitcnt lgkmcnt(0)" ::: "memory"); SBAR();   \
        o[d0] = __builtin_amdgcn_mfma_f32_32x32x16_bf16(pa0, (bf16x8){l0[0], l0[1], l0[2], l0[3], h0[0], h0[1], h0[2], h0[3]}, o[d0], 0, 0, 0);   \
        o[d0] = __builtin_amdgcn_mfma_f32_32x32x16_bf16(pa1, (bf16x8){l1[0], l1[1], l1[2], l1[3], h1[0], h1[1], h1[2], h1[3]}, o[d0], 0, 0, 0);   \
        o[d0] = __builtin_amdgcn_mfma_f32_32x32x16_bf16(pa2, (bf16x8){l2[0], l2[1], l2[2], l2[3], h2[0], h2[1], h2[2], h2[3]}, o[d0], 0, 0, 0);   \
        o[d0] = __builtin_amdgcn_mfma_f32_32x32x16_bf16(pa3, (bf16x8){l3[0], l3[1], l3[2], l3[3], h3[0], h3[1], h3[2], h3[3]}, o[d0], 0, 0, 0); } while (0)
    PV_D0(0); PV_D0(1); PV_D0(2); PV_D0(3);
#undef PV_D0
#undef TRRD
}

struct HeadRef { unsigned rowb, o; const float* CS; const float* G; };
struct Seam { bf16x8 qr[8]; bf16x8 st_v0, st_v1, st_k0, st_k1; };
typedef __amdgpu_buffer_rsrc_t Srd;
#define BL8(rs, vo, so) __builtin_bit_cast(bf16x8, __builtin_amdgcn_raw_buffer_load_b128((rs), (vo), (so), 0))
#define VMW() asm volatile("s_waitcnt vmcnt(0)" ::: "memory")
#define VMWN(n) asm volatile("s_waitcnt vmcnt(%0)" :: "i"(n) : "memory")
#define SLOAD_H(k0, bb) do { const unsigned so_ = (unsigned)(k0) * (PITCH * 2);                                               \
                         S.st_v0 = BL8(R, kvoff, (unsigned)WS_FV + H.rowb + so_); S.st_v1 = BL8(R, kvoff, (unsigned)WS_FV + H.rowb + so_ + 32 * PITCH * 2);   \
                         S.st_k0 = BL8(R, kvoff, (unsigned)WS_FK + H.rowb + so_); S.st_k1 = BL8(R, kvoff, (unsigned)WS_FK + H.rowb + so_ + 32 * PITCH * 2);   \
                         if (wid == 0) __builtin_amdgcn_global_load_lds((const unsigned*)(H.CS + (k0)) + lane, (__attribute__((address_space(3))) unsigned*)(B3 + (bb) * 64), 4, 0, 0); } while (0)
#define QLOAD(p0_) do { const unsigned so_ = (unsigned)((p0_) + wid * QBLK) * (PITCH * 2);                                   \
        _Pragma("unroll") for (int d0 = 0; d0 < 8; ++d0) S.qr[d0] = BL8(R, qoff + d0 * 32, (unsigned)WS_FQ + H.rowb + so_); } while (0)
#define SWRITE_HK(bf) do { *(bf16x8*)(K_lds + (bf) * SHM_K + kws) = S.st_k0; *(bf16x8*)(K_lds + (bf) * SHM_K + kws + 32 * 256) = S.st_k1; } while (0)
#define SWRITE_HV(bf) do { *(bf16x8*)(V_lds + (bf) * SHM_V + vst0) = S.st_v0; *(bf16x8*)(V_lds + (bf) * SHM_V + vst1) = S.st_v1; } while (0)
#define SWRITE_H(bf) do { SWRITE_HV(bf); SWRITE_HK(bf); } while (0)

__device__ __forceinline__ void fox_prime(const Srd R, const HeadRef& H, int P0, char* lds, Seam& S) {
    const int tid = threadIdx.x, wid = __builtin_amdgcn_readfirstlane(tid >> 6), lane = tid & 63, r32 = lane & 31, hi = lane >> 5;
    const int sr = tid >> 4, sc = (tid & 15) * 8, kws = KSWZ(sr, sc * 2); char* K_lds = lds + LDS_K; float* B_lds = (float*)(lds + LDS_BIAS);
    const unsigned kvoff = (unsigned)(sr * PITCH + sc) * 2u, qoff = (unsigned)(r32 * PITCH + hi * 8) * 2u;
    __attribute__((address_space(3))) float* B3 = (__attribute__((address_space(3))) float*)B_lds;
    QLOAD(P0);
    SLOAD_H(0, 0); VMW(); SWRITE_HK(0);
    { char* qw = lds + LDS_Q + wid * 8192 + lane * 16;
#pragma unroll
      for (int d0 = 0; d0 < 8; ++d0) *(bf16x8*)(qw + d0 * 1024) = S.qr[d0]; }
    __syncthreads();
}
__device__ __forceinline__ void fox_block(const Srd R, const HeadRef& H, int P0, int P0n, char* lds, Seam& S) {
    const int tid = threadIdx.x, wid = __builtin_amdgcn_readfirstlane(tid >> 6), lane = tid & 63, r32 = lane & 31, hi = lane >> 5;
    const int NT = P0 / KVBLK + 4;
    const int qlo = P0 + wid * QBLK, qm = qlo + r32 - 4 * hi;
    char* V_lds = lds + LDS_V; char* K_lds = lds + LDS_K; float* B_lds = (float*)(lds + LDS_BIAS);
    char* qw = lds + LDS_Q + wid * 8192 + lane * 16;
    float* ws = (float*)(lds + LDS_WS) + wid * 64; float* li_l = ws, * al_l = ws + 32;
    float m_reg = -1e30f, l_reg = 0; f32x16 o[4] = {};
    const int sr = tid >> 4, sc = (tid & 15) * 8, vst0 = v_st(sr, sc), vst1 = v_st(32 + sr, sc), kws = KSWZ(sr, sc * 2);
    const int vb0 = (int)(uintptr_t)V_lds + v_rd_base(lane);
    const unsigned kvoff = (unsigned)(sr * PITCH + sc) * 2u, qoff = (unsigned)(r32 * PITCH + hi * 8) * 2u;
    __attribute__((address_space(3))) float* B3 = (__attribute__((address_space(3))) float*)B_lds;
#define RESC(a) do { if (__any((a) < 1.f)) { if (hi == 0) al_l[r32] = (a); asm volatile("s_waitcnt lgkmcnt(0)" ::: "memory");              \
                     for (int d_ = 0; d_ < 4; ++d_) for (int r = 0; r < 16; ++r) o[d_][r] *= al_l[crow(r, hi)]; } } while (0)
#define KBASE(t) ((t) * KVBLK)
#define MASKT(P0_, P1_, t) do { const int kb_ = KBASE(t); if (kb_ + KVBLK - 1 > qlo) mask_tile(P0_, P1_, qm - kb_); } while (0)
    f32x16 pA0, pA1, pB0, pB1; float mnA, mnB, alA, alB; bf16x8 pa0, pa1, pa2, pa3;
    SWRITE_HV(0); SBAR();
    SLOAD_H(KBASE(1), 1);
    SBAR(); qkt<0>(pA0, pA1, K_lds, B_lds, r32, hi, qw);
    MASKT(pA0, pA1, 0); partialSM(pA0, pA1, m_reg, mnA, alA);
    VMW(); SWRITE_H(1);
    __syncthreads();
#define HALF_STEP(PX0, PX1, mnX, alX, PY0, PY1, alY, t, KB, VB, SB) do {                                                      \
        SBAR(); qkt<KB>(PX0, PX1, K_lds, B_lds, r32, hi, qw);                                                                 \
        finishSM(PY0, PY1, alY, l_reg, pa0, pa1, pa2, pa3); SBAR();                                                           \
        if ((t) + 1 < NT) { SLOAD_H(KBASE((t) + 1), SB); SBAR(); }                                                                \
        pv_tile<VB>(o, vb0, pa0, pa1, pa2, pa3); MASKT(PX0, PX1, (t)); partialSM(PX0, PX1, m_reg, mnX, alX);                  \
        __syncthreads();                                                                                                      \
        if ((t) + 1 < NT) { VMW(); SWRITE_H(SB); }                                                                      \
        RESC(alX); __syncthreads(); } while (0)
    for (int t = 1; t + 1 < NT; t += 2) {
        HALF_STEP(pB0, pB1, mnB, alB, pA0, pA1, alA, t, 1, 0, 0);
        HALF_STEP(pA0, pA1, mnA, alA, pB0, pB1, alB, t + 1, 0, 1, 1);
    }
    SBAR(); qkt<1>(pB0, pB1, K_lds, B_lds, r32, hi, qw); SBAR();
    SLOAD_H(0, 0); SBAR();
    QLOAD(P0n);
    SBAR();
    finishSM(pA0, pA1, alA, l_reg, pa0, pa1, pa2, pa3); SBAR();
    pv_tile<0>(o, vb0, pa0, pa1, pa2, pa3);
    MASKT(pB0, pB1, NT - 1); partialSM(pB0, pB1, m_reg, mnB, alB); __syncthreads(); RESC(alB);
    finishSM(pB0, pB1, alB, l_reg, pa0, pa1, pa2, pa3); SBAR(); pv_tile<1>(o, vb0, pa0, pa1, pa2, pa3);
    SBAR(); VMWN(8); SWRITE_HK(0); SBAR();
    if (hi == 0) li_l[r32] = l_reg; asm volatile("s_waitcnt lgkmcnt(0)" ::: "memory");
    float gn[4];
#pragma unroll
    for (int d0 = 0; d0 < 4; ++d0) gn[d0] = H.G[d0 * 32 + r32];
    const unsigned ovoff = (unsigned)(4 * hi * OPITCH + r32) * 2u;
#pragma unroll
    for (int r = 0; r < 16; ++r) { const float rli = __builtin_amdgcn_rcpf(li_l[crow(r, hi)]); float ss = 0.f;
#pragma unroll
        for (int d0 = 0; d0 < 4; ++d0) { o[d0][r] *= rli; ss += o[d0][r] * o[d0][r]; }
        ss += __shfl_xor(ss, 1); ss += __shfl_xor(ss, 2); ss += __shfl_xor(ss, 4); ss += __shfl_xor(ss, 8); ss += __shfl_xor(ss, 16);
        const float rs = __builtin_amdgcn_rsqf(ss * (1.0f / D) + EPS);
        const unsigned so_ = (unsigned)(P0 + wid * QBLK + (r & 3) + 8 * (r >> 2)) * (OPITCH * 2);
#pragma unroll
        for (int d0 = 0; d0 < 4; ++d0) { const float v = o[d0][r] * rs * gn[d0];
            const float vn = __shfl_xor(v, 1);
            if ((r32 & 1) == 0) __builtin_amdgcn_raw_buffer_store_b32(cvtpk(v, vn), R, ovoff + d0 * 64, H.o + so_, 0); } }
#pragma unroll
    for (int d0 = 0; d0 < 8; ++d0) *(bf16x8*)(qw + d0 * 1024) = S.qr[d0];
    __syncthreads();
#undef RESC
#undef KBASE
#undef MASKT
#undef HALF_STEP
}
#undef BL8
#undef QLOAD
#undef VMW
#undef VMWN
#undef SLOAD_H
#undef SWRITE_HK
#undef SWRITE_HV
#undef SWRITE_H
#undef KSWZ
#undef SBAR
}
namespace mls {
typedef short bf16x8 __attribute__((ext_vector_type(8)));
typedef short bf16x4 __attribute__((ext_vector_type(4)));
typedef float f32x4 __attribute__((ext_vector_type(4)));
#define MFMA16(a, b, c) __builtin_amdgcn_mfma_f32_16x16x32_bf16((a), (b), (c), 0, 0, 0)

__device__ __forceinline__ void chunk_out(int b, int h, int c, const bf16* QP, const bf16* KPP, const bf16* VT, const bf16* CST, const float* NST,
                                          const bf16* MO, const float* gain, bf16* concat, float* xch  ) {
    const int tid = threadIdx.x, w = __builtin_amdgcn_readfirstlane(tid >> 6), lane = tid & 63, i16 = lane & 15, q = lane >> 4;
    const int tq = w & 3, dvh = w >> 2;
    const size_t R0 = (size_t)b * SEQ + (size_t)c * 64;
    const size_t item = ((size_t)(b * MLH + h) * NCHUNK + c);
    const bf16* qrow = QP + (R0 + 16 * tq + i16) * 512 + h * MLDK + 8 * q;
    bf16x8 qf[4];
#pragma unroll
    for (int ks = 0; ks < 4; ++ks) qf[ks] = *(const bf16x8*)(qrow + 32 * ks);
    f32x4 st[4];
#pragma unroll
    for (int stile = 0; stile < 4; ++stile) {
        st[stile] = (f32x4){0.f, 0.f, 0.f, 0.f};
        if (stile <= tq) {
            const bf16* krow = KPP + (R0 + 16 * stile + i16) * 512 + h * MLDK + 8 * q;
            bf16x8 kf[4];
#pragma unroll
            for (int ks = 0; ks < 4; ++ks) kf[ks] = *(const bf16x8*)(krow + 32 * ks);
#pragma unroll
            for (int ks = 0; ks < 4; ++ks) st[stile] = MFMA16(kf[ks], qf[ks], st[stile]);
            if (stile == tq) {
#pragma unroll
                for (int r = 0; r < 4; ++r) if (4 * q + r > i16) st[stile][r] = 0.f;
            }
        }
    }
    float den = 0.f;
#pragma unroll
    for (int stile = 0; stile < 4; ++stile) den += (st[stile][0] + st[stile][1]) + (st[stile][2] + st[stile][3]);
    { const float* nrow = NST + item * MLDK + 8 * q;
#pragma unroll
      for (int ks = 0; ks < 4; ++ks) { const f32x4 n0 = *(const f32x4*)(nrow + 32 * ks), n1 = *(const f32x4*)(nrow + 32 * ks + 4);
          const v4u qq = __builtin_bit_cast(v4u, qf[ks]);
          den += bflo(qq[0]) * n0[0] + bfhi(qq[0]) * n0[1] + bflo(qq[1]) * n0[2] + bfhi(qq[1]) * n0[3]
               + bflo(qq[2]) * n1[0] + bfhi(qq[2]) * n1[1] + bflo(qq[3]) * n1[2] + bfhi(qq[3]) * n1[3]; } }
    den += __shfl_xor(den, 16); den += __shfl_xor(den, 32);
    bf16x8 pf[2];
#pragma unroll
    for (int p = 0; p < 2; ++p) { v4u wv; wv[0] = pg8::cvt_pk_bf16(st[2 * p][0], st[2 * p][1]); wv[1] = pg8::cvt_pk_bf16(st[2 * p][2], st[2 * p][3]);
        wv[2] = pg8::cvt_pk_bf16(st[2 * p + 1][0], st[2 * p + 1][1]); wv[3] = pg8::cvt_pk_bf16(st[2 * p + 1][2], st[2 * p + 1][3]); pf[p] = __builtin_bit_cast(bf16x8, wv); }
    const int npair = (tq >> 1) + 1;
    f32x4 num[8];
    const bf16* vbase = VT + (item * MLDV + dvh * 128 + i16) * 64 + 4 * q;
    const bf16* cbase = CST + (item * MLDV + dvh * 128 + i16) * MLDK + 8 * q;
#pragma unroll
    for (int dt = 0; dt < 8; ++dt) {
        f32x4 a = (f32x4){0.f, 0.f, 0.f, 0.f};
        const bf16* vrow = vbase + (size_t)dt * 16 * 64; const bf16* crowp = cbase + (size_t)dt * 16 * MLDK;
#pragma unroll
        for (int p = 0; p < 2; ++p) if (p < npair) {
            const v2u lo = *(const v2u*)(vrow + 32 * p), hi2 = *(const v2u*)(vrow + 32 * p + 16);
            const v4u vv = {lo[0], lo[1], hi2[0], hi2[1]};
            a = MFMA16(__builtin_bit_cast(bf16x8, vv), pf[p], a); }
#pragma unroll
        for (int ks = 0; ks < 4; ++ks) { const bf16x8 cf = *(const bf16x8*)(crowp + 32 * ks); a = MFMA16(cf, qf[ks], a); }
        num[dt] = a;
    }
    const float rden = 1.0f / fmaxf(fabsf(den), 1.0f);
    float ss = 0.f;
#pragma unroll
    for (int dt = 0; dt < 8; ++dt) { num[dt] = num[dt] * rden; ss += (num[dt][0] * num[dt][0] + num[dt][1] * num[dt][1]) + (num[dt][2] * num[dt][2] + num[dt][3] * num[dt][3]); }
    ss += __shfl_xor(ss, 16); ss += __shfl_xor(ss, 32);
    if (q == 0) xch[w * 16 + i16] = ss;
    __syncthreads();
    const float tot = ss + xch[(w ^ 4) * 16 + i16];
    const float rn = __builtin_amdgcn_rsqf(tot * (1.0f / MLDV) + EPS);
    const size_t row = R0 + 16 * tq + i16; const int dv0 = h * MLDV + dvh * 128 + 4 * q;
#pragma unroll
    for (int dt = 0; dt < 8; ++dt) { const int dv = dv0 + 16 * dt;
        const f32x4 g4 = *(const f32x4*)(gain + dv); const v2u mo2 = *(const v2u*)(MO + row * 1024 + dv);
        const float o0 = num[dt][0] * rn * g4[0] * sigmoidf_(bflo(mo2[0])), o1 = num[dt][1] * rn * g4[1] * sigmoidf_(bfhi(mo2[0]));
        const float o2 = num[dt][2] * rn * g4[2] * sigmoidf_(bflo(mo2[1])), o3 = num[dt][3] * rn * g4[3] * sigmoidf_(bfhi(mo2[1]));
        v2u ov; ov[0] = pg8::cvt_pk_bf16(o0, o1); ov[1] = pg8::cvt_pk_bf16(o2, o3);
        *(v2u*)(concat + row * 2048 + 1024 + dv) = ov; }
    __syncthreads();
}

__device__ __forceinline__ void state_scan(int bh, int sl, const bf16* KT, const bf16* VT, const float* EB, bf16* CST) {
    const int tid = threadIdx.x, w = __builtin_amdgcn_readfirstlane(tid >> 6), lane = tid & 63, i16 = lane & 15, q = lane >> 4;
    const size_t it0 = (size_t)bh * NCHUNK;
    const bf16* ka = KT + (it0 * MLDK + 16 * w + i16) * 64 + 8 * q;
    const bf16* vb = VT + (it0 * MLDV + 16 * sl + i16) * 64 + 8 * q;
    bf16* cs = CST + (it0 * MLDV + 16 * sl + i16) * MLDK + 16 * w + 4 * q;
    const float ebv = EB[it0 + lane];
    f32x4 acc = (f32x4){0.f, 0.f, 0.f, 0.f};
    bf16x8 a0 = *(const bf16x8*)(ka), a1 = *(const bf16x8*)(ka + 32), b0 = *(const bf16x8*)(vb), b1 = *(const bf16x8*)(vb + 32);
    for (int c = 0; c < NCHUNK; ++c) {
        const int cn = c + 1 < NCHUNK ? c + 1 : c;
        const bf16x8 na0 = *(const bf16x8*)(ka + (size_t)cn * MLDK * 64), na1 = *(const bf16x8*)(ka + (size_t)cn * MLDK * 64 + 32);
        const bf16x8 nb0 = *(const bf16x8*)(vb + (size_t)cn * MLDV * 64), nb1 = *(const bf16x8*)(vb + (size_t)cn * MLDV * 64 + 32);
        v2u ov; ov[0] = pg8::cvt_pk_bf16(acc[0], acc[1]); ov[1] = pg8::cvt_pk_bf16(acc[2], acc[3]);
        *(v2u*)(cs + (size_t)c * MLDV * MLDK) = ov;
        acc = MFMA16(a0, b0, acc); acc = MFMA16(a1, b1, acc);
        const float e = __shfl(ebv, c);
        acc = acc * e;
        a0 = na0; a1 = na1; b0 = nb0; b1 = nb1;
    }
}
#undef MFMA16
}
typedef const float* cfp_t;
struct Frame {
    LAS unsigned char* lds; unsigned char* ldsg;
    int tid, lane, wave, vcu, G;
    const __attribute__((address_space(4))) cfp_t* inp; float* out; unsigned char* ws;
};
__device__ __forceinline__ float wave_incl_scan(float v, int lane) {
#pragma unroll
    for (int o = 1; o < 64; o <<= 1) { const float t = __shfl_up(v, o); if (lane >= o) v += t; }
    return v;
}

__device__ __forceinline__ void p0_transpose_item(const float* W, int ldw, int K, bf16* WT, const float* gk, int k0, int n0_dst, int n0_src, LAS float* scr, int lane) {
#pragma unroll 8
    for (int i = 0; i < 32; ++i) { const int kk = 2 * i + (lane >> 5); float v = W[(size_t)(k0 + kk) * ldw + n0_src + (lane & 31)]; if (gk) v *= gk[k0 + kk]; scr[kk * 33 + (lane & 31)] = v; }
    LDS_WAIT(); asm volatile("" ::: "memory");
    const int c = lane & 7;
#pragma unroll
    for (int j = 0; j < 4; ++j) { const int n = (lane >> 3) + 8 * j; const LAS float* s = scr + (8 * c) * 33 + n;
        v4u o; o.x = pk2(s[0 * 33], s[1 * 33]); o.y = pk2(s[2 * 33], s[3 * 33]); o.z = pk2(s[4 * 33], s[5 * 33]); o.w = pk2(s[6 * 33], s[7 * 33]);
        *(GAS v4u*)(WT + (size_t)(n0_dst + n) * K + k0 + 8 * c) = o; }
    LDS_WAIT(); asm volatile("" ::: "memory");
}
__device__ __forceinline__ float rms_row_to_bf16(const float* xrow, const float* g, bf16* orow, int lane) {
    const GAS v4f* xr = (const GAS v4f*)xrow + lane; const GAS v4f* gr = (const GAS v4f*)g + lane;
    v4f v[8]; float s = 0.f;
#pragma unroll
    for (int j = 0; j < 8; ++j) { v[j] = xr[64 * j]; s += (v[j].x * v[j].x + v[j].y * v[j].y) + (v[j].z * v[j].z + v[j].w * v[j].w); }
    const float rinv = 1.0f / sqrtf(wave_sum(s) * (1.f / DM) + EPS);
    GAS v2u* o8 = (GAS v2u*)orow + lane;
#pragma unroll
    for (int j = 0; j < 8; ++j) { const v4f gg = gr[64 * j]; v2u w; w.x = pk2(v[j].x * rinv * gg.x, v[j].y * rinv * gg.y); w.y = pk2(v[j].z * rinv * gg.z, v[j].w * rinv * gg.w); o8[64 * j] = w; }
    return rinv;
}
__device__ __forceinline__ void p0_prologue(Frame& F) {
    const float* x = F.inp[0]; const float* mem = F.inp[1]; const float* mixer_norm = F.inp[2]; const float* w_in = F.inp[3];
    const int gw = F.vcu * 8 + F.wave, NGW = F.G * 8;
    LAS float* WgL = (LAS float*)F.lds;
    for (int idx = F.tid; idx < 32768; idx += NTHREADS) { const int e = idx & 3, ln = (idx >> 2) & 63, sp = idx >> 8, gate = ln & 15, q = ln >> 4, k = 16 * sp + 4 * q + e;
        const int col = gate < 8 ? 3072 + gate : 5128 + (gate - 8);
        WgL[idx] = w_in[(size_t)k * IN_WIDTH + col] * mixer_norm[k]; }
    __syncthreads();
    { float* gates = (float*)(F.ws + WS_GATES); const int i16 = F.lane & 15, q = F.lane >> 4;
      for (int grp = gw; grp < MTOK / 16; grp += NGW) {
          const float* xr = x + (size_t)(grp * 16 + i16) * DM + 4 * q; v4f acc = (v4f){0.f, 0.f, 0.f, 0.f};
#pragma unroll 4
          for (int sp = 0; sp < 128; ++sp) { const v4f x4 = *(const v4f*)(xr + 16 * sp); const v4f w4 = *(const LAS v4f*)(WgL + (sp * 64 + F.lane) * 4);
              acc = __builtin_amdgcn_mfma_f32_16x16x4f32(x4.x, w4.x, acc, 0, 0, 0); acc = __builtin_amdgcn_mfma_f32_16x16x4f32(x4.y, w4.y, acc, 0, 0, 0);
              acc = __builtin_amdgcn_mfma_f32_16x16x4f32(x4.z, w4.z, acc, 0, 0, 0); acc = __builtin_amdgcn_mfma_f32_16x16x4f32(x4.w, w4.w, acc, 0, 0, 0); }
#pragma unroll
          for (int r = 0; r < 4; ++r) gates[(size_t)(grp * 16 + 4 * q + r) * 16 + i16] = acc[r];
      } }
    { bf16* XN = (bf16*)(F.ws + WS_XN); float* RINV = (float*)(F.ws + WS_RINV);
      for (int m = gw; m < MTOK; m += NGW) { const float ri = rms_row_to_bf16(x + (size_t)m * DM, mixer_norm, XN + (size_t)m * DM, F.lane); if (F.lane == 0) RINV[m] = ri; }
      bf16* MN = (bf16*)(F.ws + WS_MN);
      for (int m = gw; m < MROWS; m += NGW) (void)rms_row_to_bf16(mem + (size_t)m * DM, F.inp[15], MN + (size_t)m * DM, F.lane); }
    __syncthreads();
    LAS float* scr = (LAS float*)(F.lds + F.wave * 16384);
    for (int it = gw; it < 32768; it += NGW) {
        int r = it;
        if (r < 6144) { const int kb = r / 192, nb = r % 192, n0 = 32 * nb, grpc = n0 >> 10, shift = grpc < 3 ? 0 : (grpc < 5 ? 8 : 16);
            p0_transpose_item(w_in, IN_WIDTH, DM, (bf16*)(F.ws + WS_WIN), nullptr, 64 * kb, n0, n0 + shift, scr, F.lane); continue; } r -= 6144;
        if (r < 2048) { p0_transpose_item(F.inp[13], DM, DM, (bf16*)(F.ws + WS_WOUT), nullptr, 64 * (r / 64), 32 * (r % 64), 32 * (r % 64), scr, F.lane); continue; } r -= 2048;
        if (r < 2048) { p0_transpose_item(F.inp[16], DM, DM, (bf16*)(F.ws + WS_WXQ), F.inp[14], 64 * (r / 64), 32 * (r % 64), 32 * (r % 64), scr, F.lane); continue; } r -= 2048;
        if (r < 4096) { p0_transpose_item(F.inp[17], 2 * DM, DM, (bf16*)(F.ws + WS_WXKV), nullptr, 64 * (r / 128), 32 * (r % 128), 32 * (r % 128), scr, F.lane); continue; } r -= 4096;
        if (r < 2048) { p0_transpose_item(F.inp[20], DM, DM, (bf16*)(F.ws + WS_WXO), nullptr, 64 * (r / 64), 32 * (r % 64), 32 * (r % 64), scr, F.lane); continue; } r -= 2048;
        if (r < 8192) { p0_transpose_item(F.inp[22], DFF, DM, (bf16*)(F.ws + WS_WUP), F.inp[21], 64 * (r / 256), 32 * (r % 256), 32 * (r % 256), scr, F.lane); continue; } r -= 8192;
        p0_transpose_item(F.inp[23], DM, DFF, (bf16*)(F.ws + WS_WDN), nullptr, 64 * (r / 64), 32 * (r % 64), 32 * (r % 64), scr, F.lane);
    }
}

constexpr int P2_KT_OFF = 4096, P2_KT_PITCH = 136, P2_VT_OFF = P2_KT_OFF + 64 * P2_KT_PITCH * 2, P2_VT_PITCH = 264;
__device__ __forceinline__ void p2_prep_item(Frame& F, int item) {
    const int b = item >> 6, c = item & 63; const size_t R0 = (size_t)b * SEQ + (size_t)c * 64;
    const int tid = F.tid, lane = F.lane, w = F.wave;
    LAS float* gq = (LAS float*)F.lds; LAS float* uk = gq + 256;
    LAS bf16* kt = (LAS bf16*)(F.lds + P2_KT_OFF); LAS bf16* vt = (LAS bf16*)(F.lds + P2_VT_OFF);
    const float* GATES = (const float*)(F.ws + WS_GATES); const float* RINV = (const float*)(F.ws + WS_RINV);
    if (w < 4) { const size_t row = R0 + lane; const float ri = RINV[row];
        const float mi = GATES[row * 16 + 8 + w] * ri + F.inp[5][w], mf = GATES[row * 16 + 12 + w] * ri + F.inp[6][w];
        const float bcum = wave_incl_scan(logsigmoidf(mf), lane);
        const float g = __expf(bcum), u = __expf(mi - bcum) * 0.08838834764831845f;
        gq[w * 64 + lane] = g; uk[w * 64 + lane] = u;
        if (lane == 63) ((float*)(F.ws + WS_EB))[(size_t)(b * MLH + w) * NCHUNK + c] = g; }
    { bf16* FQ = (bf16*)(F.ws + WS_FQ); bf16* FK = (bf16*)(F.ws + WS_FK); const int l16 = lane & 15;
      float gqn[8], gkn[8];
#pragma unroll
      for (int e = 0; e < 8; ++e) { gqn[e] = F.inp[9][l16 * 8 + e]; gkn[e] = F.inp[10][l16 * 8 + e]; }
      for (int it = w; it < 256; it += 8) { const int seg = it * 4 + (lane >> 4), row = seg >> 4, hh = seg & 15;
          bf16* p = (hh < 8 ? FQ : FK) + (R0 + row) * 1024 + (hh & 7) * FOXD + l16 * 8;
          const v4u raw = *(const v4u*)p; float v[8];
#pragma unroll
          for (int e = 0; e < 4; ++e) { v[2 * e] = bflo(raw[e]); v[2 * e + 1] = bfhi(raw[e]); }
          float ss = 0.f;
#pragma unroll
          for (int e = 0; e < 8; ++e) ss += v[e] * v[e];
          ss += __shfl_xor(ss, 1); ss += __shfl_xor(ss, 2); ss += __shfl_xor(ss, 4); ss += __shfl_xor(ss, 8);
          const float ri = 1.0f / sqrtf(ss * (1.0f / FOXD) + EPS);
          v4u o;
#pragma unroll
          for (int e = 0; e < 4; ++e) { const float g0 = hh < 8 ? gqn[2 * e] : gkn[2 * e], g1 = hh < 8 ? gqn[2 * e + 1] : gkn[2 * e + 1]; o[e] = pk2(v[2 * e] * ri * g0, v[2 * e + 1] * ri * g1); }
          *(v4u*)p = o; } }
    __syncthreads();
    const bf16* MQK = (const bf16*)(F.ws + WS_MQK); const bf16* MV = (const bf16*)(F.ws + WS_MV);
    bf16* QP = (bf16*)(F.ws + WS_QP); bf16* KPP = (bf16*)(F.ws + WS_KPP);
    const float* conv_w = F.inp[7]; const float* conv_b = F.inp[8];
    for (int h = 0; h < MLH; ++h) {
        { const int cgp = tid & 31, rg = tid >> 5; const bool isq = cgp < 16; const int col = (isq ? 0 : 512) + h * MLDK + (cgp & 15) * 8;
          float cw[4][8], cb[8];
#pragma unroll
          for (int e = 0; e < 8; ++e) { cb[e] = conv_b[col + e];
#pragma unroll
              for (int j = 0; j < 4; ++j) cw[j][e] = conv_w[j * 1024 + col + e]; }
          float u[7][8];
#pragma unroll
          for (int i = 0; i < 7; ++i) { const int pos = c * 64 + 4 * rg - 3 + i;
              v4u raw = (v4u){0u, 0u, 0u, 0u}; if (pos >= 0) raw = *(const v4u*)(MQK + ((size_t)b * SEQ + pos) * 1024 + col);
#pragma unroll
              for (int e = 0; e < 4; ++e) { u[i][2 * e] = bflo(raw[e]); u[i][2 * e + 1] = bfhi(raw[e]); } }
#pragma unroll
          for (int r = 0; r < 4; ++r) { const int t = 4 * rg + r; const float f = isq ? gq[h * 64 + t] : uk[h * 64 + t]; float y[8];
#pragma unroll
              for (int e = 0; e < 8; ++e) { float a = cb[e];
#pragma unroll
                  for (int j = 0; j < 4; ++j) a += cw[j][e] * u[r + j][e];
                  y[e] = a * sigmoidf_(a) * f; }
              v4u o; o.x = pk2(y[0], y[1]); o.y = pk2(y[2], y[3]); o.z = pk2(y[4], y[5]); o.w = pk2(y[6], y[7]);
              *(v4u*)((isq ? QP : KPP) + (R0 + t) * 512 + h * MLDK + (cgp & 15) * 8) = o;
              if (!isq) *(LAS v4u*)(kt + t * P2_KT_PITCH + (cgp & 15) * 8) = o; } }
#pragma unroll
        for (int i = 0; i < 4; ++i) { const int idx = tid + NTHREADS * i, row = idx >> 5, ch = idx & 31;
            *(LAS v4u*)(vt + row * P2_VT_PITCH + ch * 8) = *(const v4u*)(MV + (R0 + row) * 1024 + h * MLDV + ch * 8); }
        __syncthreads();
        const size_t itemh = (size_t)(b * MLH + h) * NCHUNK + c;
        { bf16* KT = (bf16*)(F.ws + WS_KT) + itemh * MLDK * 64;
#pragma unroll
          for (int i = 0; i < 2; ++i) { const int idx = tid + NTHREADS * i, d = idx >> 3, sg = idx & 7; unsigned short e8[8];
#pragma unroll
              for (int e = 0; e < 8; ++e) e8[e] = kt[(8 * sg + e) * P2_KT_PITCH + d];
              v4u o; o.x = e8[0] | ((unsigned)e8[1] << 16); o.y = e8[2] | ((unsigned)e8[3] << 16); o.z = e8[4] | ((unsigned)e8[5] << 16); o.w = e8[6] | ((unsigned)e8[7] << 16);
              *(v4u*)(KT + d * 64 + 8 * sg) = o; }
          bf16* VT = (bf16*)(F.ws + WS_VT) + itemh * MLDV * 64;
#pragma unroll
          for (int i = 0; i < 4; ++i) { const int idx = tid + NTHREADS * i, dv = idx >> 3, sg = idx & 7; unsigned short e8[8];
#pragma unroll
              for (int e = 0; e < 8; ++e) e8[e] = vt[(8 * sg + e) * P2_VT_PITCH + dv];
              v4u o; o.x = e8[0] | ((unsigned)e8[1] << 16); o.y = e8[2] | ((unsigned)e8[3] << 16); o.z = e8[4] | ((unsigned)e8[5] << 16); o.w = e8[6] | ((unsigned)e8[7] << 16);
              *(v4u*)(VT + dv * 64 + 8 * sg) = o; }
          if (tid < MLDK) { float s = 0.f;
#pragma unroll 8
              for (int t = 0; t < 64; ++t) s += bf2f(kt[t * P2_KT_PITCH + tid]);
              ((float*)(F.ws + WS_KSUM))[itemh * MLDK + tid] = s; } }
        __syncthreads();
    }
    if (w < 4) { const int mr = item * 4 + w; const float* slab = (const float*)((const unsigned char*)F.out + OUT_SLAB);
        const float* gxq = F.inp[18]; const float* gxk = F.inp[19];
        v4f kv[8]; float ssh[4] = {0.f, 0.f, 0.f, 0.f};
#pragma unroll
        for (int j = 0; j < 8; ++j) { const int col = 4 * (lane + 64 * j); v4f a = (v4f){0.f, 0.f, 0.f, 0.f};
#pragma unroll
            for (int s = 0; s < 4; ++s) a = a + *(const v4f*)(slab + ((size_t)s * MROWS + mr) * 4096 + col);
            kv[j] = a; ssh[j >> 1] += (a.x * a.x + a.y * a.y) + (a.z * a.z + a.w * a.w); }
        float rk[4];
#pragma unroll
        for (int hh = 0; hh < 4; ++hh) rk[hh] = 1.0f / sqrtf(wave_sum(ssh[hh]) * (1.0f / XD) + EPS);
        bf16* KH = (bf16*)(F.ws + WS_KHAT) + (size_t)mr * DM;
#pragma unroll
        for (int j = 0; j < 8; ++j) { const int col = 4 * (lane + 64 * j), d = col & (XD - 1); const v4f a = *(const v4f*)(gxq + d), g2 = *(const v4f*)(gxk + d); const float r = rk[j >> 1];
            v2u o; o.x = pk2(kv[j].x * r * a.x * g2.x, kv[j].y * r * a.y * g2.y); o.y = pk2(kv[j].z * r * a.z * g2.z, kv[j].w * r * a.w * g2.w);
            *(v2u*)(KH + col) = o; }
        bf16* VTM = (bf16*)(F.ws + WS_VTM); const int bm = mr >> 8, key = mr & 255;
#pragma unroll
        for (int j = 0; j < 8; ++j) { const int dcol = 4 * (lane + 64 * j); v4f a = (v4f){0.f, 0.f, 0.f, 0.f};
#pragma unroll
            for (int s = 0; s < 4; ++s) a = a + *(const v4f*)(slab + ((size_t)s * MROWS + mr) * 4096 + 2048 + dcol);
            const int hh = dcol >> 9, d = dcol & (XD - 1); bf16* vp = VTM + ((size_t)(bm * XH + hh) * XD + d) * NMEM + key;
            vp[0] = (bf16)f2bf(a.x); vp[NMEM] = (bf16)f2bf(a.y); vp[2 * NMEM] = (bf16)f2bf(a.z); vp[3 * NMEM] = (bf16)f2bf(a.w); }
    }
    __syncthreads();
}

__device__ __forceinline__ void p3_scan_item(Frame& F, int item) {
    const int bh = item >> 4, sl = item & 15;
    mls::state_scan(bh, sl, (const bf16*)(F.ws + WS_KT), (const bf16*)(F.ws + WS_VT), (const float*)(F.ws + WS_EB), (bf16*)((unsigned char*)F.out + OUT_CST));
    if (sl == 0 && F.tid < MLDK) {
        const float* EB = (const float*)(F.ws + WS_EB) + (size_t)bh * NCHUNK; const float* KS = (const float*)(F.ws + WS_KSUM) + (size_t)bh * NCHUNK * MLDK + F.tid;
        float* NS = (float*)(F.ws + WS_NST) + (size_t)bh * NCHUNK * MLDK + F.tid; float n = 0.f;
        for (int c = 0; c < NCHUNK; ++c) { NS[(size_t)c * MLDK] = n; n = EB[c] * (n + KS[(size_t)c * MLDK]); }
    }
    if ((sl == 1 || sl == 2) && F.wave == 0) {
        const int seq = (sl - 1) * 16 + bh, b = seq >> 3, fh = seq & 7;
        const float* GATES = (const float*)(F.ws + WS_GATES); const float* RINV = (const float*)(F.ws + WS_RINV); const float fb = F.inp[4][fh];
        float* C = (float*)(F.ws + WS_CFOX) + (size_t)seq * SEQ + 64 * F.lane; const size_t r0 = (size_t)b * SEQ + 64 * F.lane;
        float tot = 0.f;
        for (int j = 0; j < 64; ++j) tot += logsigmoidf(GATES[(r0 + j) * 16 + fh] * RINV[r0 + j] + fb);
        float run = wave_incl_scan(tot, F.lane) - tot;
        for (int j = 0; j < 64; ++j) { run += logsigmoidf(GATES[(r0 + j) * 16 + fh] * RINV[r0 + j] + fb); C[j] = run * -11.313708498984761f; }
    }
}
#ifndef MK_PER_PHASE
#define MK_PER_PHASE 0
#endif
#define XB_TMO      128
#define XB_XCNT(j)  (256  + 64 * (j))
#define XB_XSUB(j)  (1280 + 64 * (j))
#define XB_XGEN(j)  (2304 + 64 * (j))
#define XB_TOP      3328
#define XB_TOPGEN   3392
#define XCD_BAR_WORDS 3456
#define XB_SPIN_CAP (1u << 20)
__device__ __forceinline__ unsigned xb_ld(unsigned* p)              { return __hip_atomic_load(p, __ATOMIC_RELAXED, __HIP_MEMORY_SCOPE_AGENT); }
__device__ __forceinline__ unsigned xb_add(unsigned* p, unsigned v) { return __hip_atomic_fetch_add(p, v, __ATOMIC_RELAXED, __HIP_MEMORY_SCOPE_AGENT); }
__device__ __forceinline__ unsigned xb_xcc_id() { return (unsigned)__builtin_amdgcn_s_getreg((3 << 11) | 20) & 0xFu; }
#define XB_SPIN(cond, bar) do { unsigned _sp = 0; while (cond) { __builtin_amdgcn_s_sleep(1); \
    if ((++_sp & 255u) == 0u) { if (xb_ld(&(bar)[XB_TMO])) break; if (_sp > XB_SPIN_CAP) { atomicAdd(&(bar)[XB_TMO], 1u); break; } } } } while (0)
struct XcdBarrier { unsigned* bar; unsigned x; volatile LAS unsigned* st; };
__device__ __forceinline__ XcdBarrier xcd_barrier_post(unsigned* bar, volatile LAS unsigned* st) {
    XcdBarrier b; b.bar = bar; b.x = xb_xcc_id(); b.st = st;
    if (threadIdx.x == 0) (void)xb_add(&bar[XB_XCNT(b.x)], 1u);
    return b;
}
__device__ __forceinline__ void xcd_barrier_complete(unsigned* bar, unsigned x, unsigned& nloc, unsigned& nx) {
    const unsigned G = gridDim.x * gridDim.y * gridDim.z;
    unsigned sum, cnt, mine, sp = 0u;
    for (;;) {
        sum = 0u; cnt = 0u; mine = 0u;
#pragma unroll
        for (unsigned j = 0; j < 16; ++j) { const unsigned c = xb_ld(&bar[XB_XCNT(j)]); sum += c; cnt += (c > 0u) ? 1u : 0u; mine = (j == x) ? c : mine; }
        if (sum == G) break;
        __builtin_amdgcn_s_sleep(1);
        if ((++sp & 255u) == 0u) { if (xb_ld(&bar[XB_TMO])) break; if (sp > XB_SPIN_CAP) { atomicAdd(&bar[XB_TMO], 1u); break; } }
    }
    nloc = mine > 0u ? mine : 1u; nx = cnt > 0u ? cnt : 1u;
}
__device__ __forceinline__ void xcd_barrier(const XcdBarrier& b) {
    asm volatile("s_waitcnt vmcnt(0)" ::: "memory");
    __syncthreads();
    if (threadIdx.x == 0) {
        unsigned* bar = b.bar;
        __builtin_amdgcn_s_waitcnt(0);
        unsigned nloc = b.st[0], nx = b.st[1];
        if (nloc == 0u) { xcd_barrier_complete(bar, b.x, nloc, nx); b.st[0] = nloc; b.st[1] = nx; }
        const unsigned old = xb_add(&bar[XB_XSUB(b.x)], 1u);
        const unsigned gen = old / nloc;
        if (old + 1u == (gen + 1u) * nloc) {
            __builtin_amdgcn_fence(__ATOMIC_RELEASE, "agent");
            asm volatile("s_waitcnt vmcnt(0)" ::: "memory");
            const unsigned og = xb_add(&bar[XB_TOP], 1u);
            const unsigned tg = og / nx;
            if (og + 1u == (tg + 1u) * nx) xb_add(&bar[XB_TOPGEN], 1u);
            else XB_SPIN(xb_ld(&bar[XB_TOPGEN]) == tg, bar);
            __builtin_amdgcn_fence(__ATOMIC_ACQUIRE, "agent");
            xb_add(&bar[XB_XGEN(b.x)], 1u);
            asm volatile("s_waitcnt vmcnt(0)" ::: "memory");
        } else {
            XB_SPIN(xb_ld(&bar[XB_XGEN(b.x)]) == gen, bar);
            __builtin_amdgcn_fence(__ATOMIC_ACQUIRE, "agent");
            asm volatile("s_waitcnt vmcnt(0)" ::: "memory");
        }
    }
    __syncthreads();
}
constexpr int LDS_MISC_OFF = LDS_BYTES - 256;
constexpr int N_PHASES = 12;
struct Args { const float* in[24]; float* out; unsigned char* ws; int ph_lo, ph_hi; };
static_assert(sizeof(Args) == 24 * 8 + 8 + 8 + 8, "Args has no padding");

__global__ void __launch_bounds__(NTHREADS, 2) fwd_kernel(Args args) {
    extern __shared__ __attribute__((aligned(16))) unsigned char lds[];
    Frame F;
    F.lds = (LAS unsigned char*)lds; F.ldsg = lds;
    F.tid = threadIdx.x; F.lane = F.tid & 63; F.wave = __builtin_amdgcn_readfirstlane(F.tid >> 6);
    F.G = gridDim.x; { const int bx = blockIdx.x; F.vcu = (F.G % 8 == 0) ? (bx % 8) * (F.G / 8) + bx / 8 : bx; }
    F.inp = (const __attribute__((address_space(4))) cfp_t*)__builtin_amdgcn_kernarg_segment_ptr();
    F.out = args.out; F.ws = args.ws;
    unsigned char* ws = args.ws;
    const int lo = args.ph_lo, hi = args.ph_hi;
    volatile LAS unsigned* MISC = (volatile LAS unsigned*)(F.lds + LDS_MISC_OFF);
    if (F.tid < 64) MISC[F.tid] = 0u;
    __syncthreads();
    XcdBarrier xbar; xbar.bar = (unsigned*)(ws + WS_CTL); xbar.x = 0; xbar.st = nullptr;
    if (hi - lo > 1) xbar = xcd_barrier_post((unsigned*)(ws + WS_CTL), MISC);
#ifndef PHASE_MASK
#define PHASE_MASK 0xfff
#endif
#define IN(k) ((((PHASE_MASK) >> (k)) & 1) && lo <= (k) && (k) < hi)
#define SEAM(k) do { if (IN(k) && IN((k) + 1)) { if ((k) == 0) cg::this_grid().sync(); else xcd_barrier(xbar); } } while (0)
    float* SSQ1 = (float*)(ws + WS_CTL + CTL_SSQ1); float* SSQ2 = (float*)(ws + WS_CTL + CTL_SSQ2); float* SSQQ = (float*)(ws + WS_CTL + CTL_SSQQ);

    if (IN(0)) { p0_prologue(F); }
    SEAM(0);
    if (IN(1)) {
        { pg8::Gemm g{(const bf16*)(ws + WS_XN), (const bf16*)(ws + WS_WIN), DM, DM, DM}; pg8::StdOrder S; S.init(MTOK, NPROJ, DM, DM, F.G, (int)blockIdx.x);
          pg8::EpiStoreBf16 E{(bf16*)(ws + WS_PROJ), 1024, 1024, (size_t)MTOK * 1024};
          pg8::gemm_phase<pg8::EpiStoreBf16, pg8::StdOrder, true>(F.lds, g, S, E); }
        { pg8::Gemm g{(const bf16*)(ws + WS_MN), (const bf16*)(ws + WS_WXKV), DM, DM, 512}; pg8::XkvOrder S{F.G, (int)blockIdx.x};
          pg8::EpiSlab E{(float*)((unsigned char*)F.out + OUT_SLAB), 4096, (size_t)MROWS * 4096};
          pg8::gemm_phase<pg8::EpiSlab, pg8::XkvOrder, false>(F.lds, g, S, E); }
    }
    SEAM(1);
    if (IN(2)) { for (int item = F.vcu; item < BATCH * NCHUNK; item += F.G) p2_prep_item(F, item); }
    SEAM(2);
    if (IN(3)) { for (int item = F.vcu; item < 256; item += F.G) p3_scan_item(F, item); }
    SEAM(3);
    if (IN(4)) {
        if (!((PHASE_MASK >> 12) & 1)) { const fox::Srd R = __builtin_amdgcn_make_buffer_rsrc((void*)ws, (short)0, (int)WS_END, 0x00020000);
          for (int L = F.vcu; L < 256; L += F.G) { const int bh = L >> 3, xq = L & 7, b = bh >> 3, h = bh & 7;
              const unsigned rowb = (unsigned)b * SEQ * 2048u + (unsigned)h * (FOXD * 2);
              fox::HeadRef H{rowb,
                             (unsigned)WS_CONCAT + (unsigned)b * SEQ * 4096u + (unsigned)h * (FOXD * 2), (const float*)(ws + WS_CFOX) + (size_t)bh * SEQ, F.inp[11] + h * FOXD};
              fox::Seam S;
              fox::fox_prime(R, H, xq * 256, (char*)lds, S);
              for (int p = 0; p < 2; ++p) { const int P0 = (p == 0 ? xq : 15 - xq) * 256, P0n = (15 - xq) * 256;
                  fox::fox_block(R, H, P0, P0n, (char*)lds, S); }
              VM_WAIT(); __syncthreads(); } }
        if (!((PHASE_MASK >> 13) & 1)) { float* xch = (float*)lds;
          for (int it = F.vcu; it < BATCH * MLH * NCHUNK; it += F.G) { const int c = it & 63, h = (it >> 6) & 3, b = it >> 8;
              mls::chunk_out(b, h, c, (const bf16*)(ws + WS_QP), (const bf16*)(ws + WS_KPP), (const bf16*)(ws + WS_VT), (const bf16*)((unsigned char*)F.out + OUT_CST),
                             (const float*)(ws + WS_NST), (const bf16*)(ws + WS_MO), F.inp[12], (bf16*)(ws + WS_CONCAT), xch); } }
    }
    SEAM(4);
    if (IN(5)) {
        pg8::Gemm g{(const bf16*)(ws + WS_CONCAT), (const bf16*)(ws + WS_WOUT), DM, DM, DM}; pg8::StdOrder S; S.init(MTOK, DM, DM, DM, F.G, (int)blockIdx.x);
        pg8::EpiResid E{F.inp[0], F.out, (bf16*)(ws + WS_X1B), SSQ1, DM};
        pg8::gemm_phase<pg8::EpiResid, pg8::StdOrder, true>(F.lds, g, S, E);
    }
    SEAM(5);
    if (IN(6)) {
        pg8::Gemm g{(const bf16*)(ws + WS_X1B), (const bf16*)(ws + WS_WXQ), DM, DM, DM}; pg8::StdOrder S; S.init(MTOK, DM, DM, DM, F.G, (int)blockIdx.x);
        pg8::EpiQ E{(bf16*)(ws + WS_Q), SSQ1, SSQQ};
        pg8::gemm_phase<pg8::EpiQ, pg8::StdOrder, true>(F.lds, g, S, E);
    }
    SEAM(6);
    if (IN(7)) {
        pg8::Gemm g{(const bf16*)(ws + WS_Q), (const bf16*)(ws + WS_KHAT), DM, DM, XD}; pg8::ScoreOrder S{F.G, (int)blockIdx.x};
        pg8::EpiSoftmax E{(bf16*)(ws + WS_P), SSQQ};
        if (F.G >= 256) pg8::gemm_phase<pg8::EpiSoftmax, pg8::ScoreOrder, false>(F.lds, g, S, E);
    }
    SEAM(7);
    if (IN(8)) {
        pg8::Gemm g{(const bf16*)(ws + WS_P), (const bf16*)(ws + WS_VTM), 1024, NMEM, NMEM}; pg8::PvOrder S{F.G, (int)blockIdx.x};
        pg8::EpiStoreBf16 E{(bf16*)(ws + WS_CO), DM, 0, 0};
        pg8::gemm_phase<pg8::EpiStoreBf16, pg8::PvOrder, true>(F.lds, g, S, E);
    }
    SEAM(8);
    if (IN(9)) {
        pg8::Gemm g{(const bf16*)(ws + WS_CO), (const bf16*)(ws + WS_WXO), DM, DM, DM}; pg8::StdOrder S; S.init(MTOK, DM, DM, DM, F.G, (int)blockIdx.x);
        pg8::EpiResid E{F.out, F.out, (bf16*)(ws + WS_X2B), SSQ2, DM};
        pg8::gemm_phase<pg8::EpiResid, pg8::StdOrder, true>(F.lds, g, S, E);
    }
    SEAM(9);
    if (IN(10)) {
        pg8::Gemm g{(const bf16*)(ws + WS_X2B), (const bf16*)(ws + WS_WUP), DM, DM, DM}; pg8::StdOrder S; S.init(MTOK, DFF, DM, DM, F.G, (int)blockIdx.x);
        pg8::EpiUp E{(bf16*)(ws + WS_H), SSQ2};
        pg8::gemm_phase<pg8::EpiUp, pg8::StdOrder, true>(F.lds, g, S, E);
    }
    SEAM(10);
    if (IN(11)) {
        pg8::Gemm g{(const bf16*)(ws + WS_H), (const bf16*)(ws + WS_WDN), DFF, DFF, DFF}; pg8::StdOrder S; S.init(MTOK, DM, DFF, DFF, F.G, (int)blockIdx.x);
        pg8::EpiResid E{F.out, F.out, nullptr, nullptr, DM};
        pg8::gemm_phase<pg8::EpiResid, pg8::StdOrder, true>(F.lds, g, S, E);
    }
#undef IN
#undef SEAM
}

extern "C" void kernel_launch(void* const* d_in, const int* in_sizes, int n_in, void* d_out, int out_size, void* d_ws, size_t ws_size, hipStream_t stream) {
    static int grid = 0;
    if (grid == 0) {
        if (n_in != 24 || in_sizes[0] != MTOK * DM || out_size != MTOK * DM || ws_size < WS_END) {
            fprintf(stderr, "kernel_launch: unexpected shapes (n_in %d, in0 %d, out %d, ws %zu; need ws >= %zu); nothing launched\n", n_in, n_in > 0 ? in_sizes[0] : -1, out_size, ws_size, (size_t)WS_END); grid = -1; return; }
        int dev = 0, cus = 0, per_cu = 0;
        if (hipGetDevice(&dev) != hipSuccess || hipDeviceGetAttribute(&cus, hipDeviceAttributeMultiprocessorCount, dev) != hipSuccess) { grid = -1; return; }
        if (hipFuncSetAttribute((const void*)fwd_kernel, hipFuncAttributeMaxDynamicSharedMemorySize, LDS_BYTES) != hipSuccess) { fprintf(stderr, "kernel_launch: hipFuncSetAttribute failed\n"); grid = -1; return; }
        if (hipOccupancyMaxActiveBlocksPerMultiprocessor(&per_cu, (const void*)fwd_kernel, NTHREADS, LDS_BYTES) != hipSuccess || per_cu < 1) { fprintf(stderr, "kernel_launch: occupancy query says %d blocks per CU\n", per_cu); per_cu = 1; }
        (void)hipGetLastError();
        grid = cus;
    }
    if (grid < 0) return;
    (void)hipMemsetAsync((char*)d_ws + WS_CTL, 0, CTL_BYTES, stream);
    Args a{};
    for (int i = 0; i < 24; ++i) a.in[i] = (const float*)d_in[i];
    a.out = (float*)d_out; a.ws = (unsigned char*)d_ws;
#if MK_PER_PHASE
    for (int ph = 0; ph < N_PHASES; ++ph) { a.ph_lo = ph; a.ph_hi = ph + 1;
        hipLaunchKernelGGL(fwd_kernel, dim3(grid), dim3(NTHREADS), LDS_BYTES, stream, a); }
#else
    a.ph_lo = 0; a.ph_hi = N_PHASES;
    void* kargs[] = {&a};
    hipError_t e = hipLaunchCooperativeKernel((const void*)fwd_kernel, dim3(grid), dim3(NTHREADS), kargs, LDS_BYTES, stream);
    if (e != hipSuccess) fprintf(stderr, "kernel_launch: cooperative launch failed: %s (grid %d)\n", hipGetErrorString(e), grid);
#endif
}
```

```cpp
#include <hip/hip_runtime.h>
#include <hip/hip_cooperative_groups.h>
#include <cstdio>
#include <cstdint>
namespace cg = cooperative_groups;

constexpr int BATCH = 4, SEQ = 4096, DM = 2048, MTOK = BATCH * SEQ;
constexpr int NMEM = 256, MROWS = BATCH * NMEM;
constexpr int FOXH = 8, FOXD = 128, MLH = 4, MLDV = 256, MLDK = 128, XH = 4, XD = 512, DFF = 8192;
constexpr int IN_WIDTH = 6160, NPROJ = 6144, NCHUNK = SEQ / 64;
constexpr float EPS = 1e-6f;
constexpr float LOG2E = 1.4426950408889634f;

constexpr size_t MiB = (size_t)1 << 20;
constexpr size_t WS_WIN = 0, WS_WOUT = 24 * MiB, WS_WXQ = 32 * MiB, WS_WXKV = 40 * MiB, WS_WXO = 56 * MiB, WS_WUP = 64 * MiB, WS_WDN = 96 * MiB;
constexpr size_t WS_PROJ = 128 * MiB;
constexpr size_t WS_FQ = 128 * MiB, WS_FK = 160 * MiB, WS_FV = 192 * MiB, WS_MQK = 224 * MiB, WS_MV = 256 * MiB, WS_MO = 288 * MiB;
constexpr size_t WS_XN = 320 * MiB;
constexpr size_t WS_QP = 384 * MiB, WS_KPP = 400 * MiB;
constexpr size_t WS_KT = 416 * MiB;
constexpr size_t WS_VT = 432 * MiB;
constexpr size_t WS_MISC = 464 * MiB;
constexpr size_t WS_CTL = WS_MISC, CTL_BYTES = 1 * MiB;
constexpr size_t CTL_SSQ1 = 64 * 1024, CTL_SSQ2 = 128 * 1024, CTL_SSQQ = 192 * 1024;
constexpr size_t WS_GATES = WS_MISC + 1 * MiB;
constexpr size_t WS_RINV = WS_MISC + 2 * MiB;
constexpr size_t WS_CFOX = WS_MISC + 3 * MiB;
constexpr size_t WS_EB = WS_MISC + 4 * MiB;
constexpr size_t WS_KSUM = WS_MISC + 5 * MiB;
constexpr size_t WS_NST = WS_MISC + 6 * MiB;
constexpr size_t WS_MN = WS_MISC + 8 * MiB;
constexpr size_t WS_KHAT = WS_MISC + 12 * MiB;
constexpr size_t WS_VTM = WS_MISC + 16 * MiB;
constexpr size_t WS_END = 512 * MiB;
constexpr size_t WS_CONCAT = 224 * MiB;
constexpr size_t WS_X1B = 128 * MiB;
constexpr size_t WS_Q = 192 * MiB;
constexpr size_t WS_CO = 256 * MiB;
constexpr size_t WS_P = 320 * MiB;
constexpr size_t WS_X2B = 128 * MiB;
constexpr size_t WS_H = 192 * MiB;
constexpr size_t OUT_SLAB = 0, OUT_CST = 64 * MiB;

constexpr int LDS_BYTES = 147456;
constexpr int NTHREADS = 512;

#define GAS __attribute__((address_space(1)))
#define LAS __attribute__((address_space(3)))
typedef unsigned short bf16;
typedef unsigned v4u __attribute__((ext_vector_type(4)));
typedef unsigned v2u __attribute__((ext_vector_type(2)));
typedef float v4f __attribute__((ext_vector_type(4)));
typedef short v8s __attribute__((ext_vector_type(8)));
typedef short v4s __attribute__((ext_vector_type(4)));
#define LDS_WAIT() asm volatile("s_waitcnt lgkmcnt(0)" ::: "memory")
#define VM_WAIT() asm volatile("s_waitcnt vmcnt(0)" ::: "memory")
__device__ __forceinline__ unsigned f2bf(float f) { unsigned u = __builtin_bit_cast(unsigned, f); return (u + 0x7fffu + ((u >> 16) & 1u)) >> 16; }
__device__ __forceinline__ unsigned pk2(float lo, float hi) { return f2bf(lo) | (f2bf(hi) << 16); }
__device__ __forceinline__ float bf2f(unsigned h) { return __builtin_bit_cast(float, h << 16); }
__device__ __forceinline__ float bflo(unsigned w) { return __builtin_bit_cast(float, w << 16); }
__device__ __forceinline__ float bfhi(unsigned w) { return __builtin_bit_cast(float, w & 0xffff0000u); }
__device__ __forceinline__ float wave_sum(float v) {
#pragma unroll
    for (int o = 1; o < 64; o <<= 1) v += __shfl_xor(v, o);
    return v;
}
__device__ __forceinline__ float logsigmoidf(float x) { return x >= 0.f ? -log1pf(__expf(-x)) : x - log1pf(__expf(x)); }
__device__ __forceinline__ float sigmoidf_(float x) { return 1.f / (1.f + __expf(-x)); }
#define MK_PER_PHASE 0
namespace pg8 {
#define PG8_LAS __attribute__((address_space(3)))
typedef unsigned short bf16_t;
typedef short bf16x8 __attribute__((ext_vector_type(8)));
typedef float f32x4 __attribute__((ext_vector_type(4)));
typedef float f32x2 __attribute__((ext_vector_type(2)));
typedef unsigned u32x4 __attribute__((ext_vector_type(4)));
typedef unsigned u32x2 __attribute__((ext_vector_type(2)));
constexpr int BM = 256, BK = 64, HALF = 128, HTB = HALF * BK * 2, STAGE_BYTES = 8 * HTB, NXCD = 8, WGM = 8;

__host__ __device__ __forceinline__ int lds_byte(int r, int c) { const int st = (r >> 4) * 2 + (c >> 5), rr = r & 15, cc = c & 31, ob = rr * 64 + cc * 2; return st * 1024 + (ob ^ (((ob >> 9) & 1) << 5)); }
__host__ __device__ __forceinline__ void stage_rc(int b, int& R, int& C) { const int st = b / 1024, sb = b % 1024, swz = sb ^ (((sb >> 9) & 1) << 5); R = (st >> 1) * 16 + swz / 64; C = (st & 1) * 32 + (swz % 64) / 2; }
__host__ __device__ __forceinline__ int perm32(int rho) { const int n = rho >> 4, i = rho & 15; return 8 * (i >> 2) + 4 * n + (i & 3); }

struct Unit { int row0, col0; long aoff, boff; int aux; };
struct Gemm { const bf16_t* A; const bf16_t* Bt; int lda, ldb, K; };

struct StdOrder {
    int nM, nN, nwg, G, c, lda, ldb;
    __device__ void init(int M, int N, int lda_, int ldb_, int G_, int c_) { nM = M / BM; nN = N / BM; nwg = nM * nN; G = G_; c = c_; lda = lda_; ldb = ldb_; }
    __device__ bool next(int i, Unit& u) const {
        const long L = (long)i * G + c; if (L >= nwg) return false;
        int wgid = (int)L; { const int q = nwg / NXCD, r = nwg % NXCD, xcd = wgid % NXCD, off = wgid / NXCD; wgid = (xcd < r ? xcd * (q + 1) : r * (q + 1) + (xcd - r) * q) + off; }
        const int nig = WGM * nN, gid = wgid / nig, fm = gid * WGM, gsz = (nM - fm) < WGM ? (nM - fm) : WGM;
        const int pm = fm + ((wgid % nig) % gsz), pn = (wgid % nig) / gsz;
        u.row0 = pm * BM; u.col0 = pn * BM; u.aoff = (long)pm * BM * lda; u.boff = (long)pn * BM * ldb; u.aux = 0; return true;
    }
};

__device__ __forceinline__ unsigned cvt_pk_bf16(float lo, float hi) { unsigned r; asm volatile("v_cvt_pk_bf16_f32 %0, %1, %2" : "=v"(r) : "v"(lo), "v"(hi)); return r; }

template <class Epi, class Sched, bool ALIGN_EPI>
__device__ __forceinline__ void gemm_phase(PG8_LAS unsigned char* lds, const Gemm g, const Sched& S, const Epi& E) {
    const int tid = threadIdx.x, wid = __builtin_amdgcn_readfirstlane(tid >> 6), lane = tid & 63, wr = wid >> 2, wc = wid & 3, fr = lane & 15, fq = lane >> 4;
    const int K = g.K, nt = K / BK;
    unsigned voffA[2], voffB[2];
#pragma unroll
    for (int i = 0; i < 2; ++i) { int R, C; stage_rc(tid * 16 + i * 8192, R, C); const int Rb = Epi::PERM ? ((R & ~31) + perm32(R & 31)) : R;
        voffA[i] = (unsigned)(R * g.lda + C) * 2u; voffB[i] = (unsigned)(Rb * g.ldb + C) * 2u; }
    const size_t kstep = (size_t)(BK * 2);
    const size_t hA = (size_t)HALF * g.lda * 2, hB = (size_t)HALF * g.ldb * 2;
    const unsigned ldsw = (unsigned)wid * 1024u;
    const int aoff = lds_byte(wr * 64 + fr, fq * 8), boff = lds_byte(wc * 32 + fr, fq * 8);
#define PG8_SA(b, h) (((b) * 2 + (h)) * HTB)
#define PG8_SB(b, h) ((4 + (b) * 2 + (h)) * HTB)
#define PG8_STAGE(bufoff, gbase, voff) do { _Pragma("unroll") for (int _i = 0; _i < 2; ++_i) \
        __builtin_amdgcn_global_load_lds((const unsigned*)((const char*)(gbase) + (voff)[_i]), (PG8_LAS unsigned*)(lds + (bufoff) + ldsw + _i * 8192), 16, 0, 0); } while (0)
#define PG8_LDA(dst, b, h) do { _Pragma("unroll") for (int m = 0; m < 4; ++m) _Pragma("unroll") for (int k = 0; k < 2; ++k) dst[m][k] = *(const PG8_LAS bf16x8*)(lds + PG8_SA(b, h) + aoff + m * 2048 + k * 1024); } while (0)
#define PG8_LDB(dst, b, h) do { _Pragma("unroll") for (int n = 0; n < 2; ++n) _Pragma("unroll") for (int k = 0; k < 2; ++k) dst[n][k] = *(const PG8_LAS bf16x8*)(lds + PG8_SB(b, h) + boff + n * 2048 + k * 1024); } while (0)
#define PG8_MMA(ai, bj, At, Bt) do { __builtin_amdgcn_s_setprio(1); _Pragma("unroll") for (int m = 0; m < 4; ++m) _Pragma("unroll") for (int n = 0; n < 2; ++n) _Pragma("unroll") for (int k = 0; k < 2; ++k) \
        acc[ai][bj][m][n] = __builtin_amdgcn_mfma_f32_16x16x32_bf16(Bt[n][k], At[m][k], acc[ai][bj][m][n], 0, 0, 0); __builtin_amdgcn_s_setprio(0); } while (0)
#define PG8_WAIT_V(n) asm volatile("s_waitcnt vmcnt(" #n ")" ::: "memory")
#define PG8_WAIT_L(n) asm volatile("s_waitcnt lgkmcnt(" #n ")" ::: "memory")
#define PG8_BAR __builtin_amdgcn_s_barrier()
#define PG8_SCHED __builtin_amdgcn_sched_barrier(0)
    Unit cur, nxt; int ui = 0;
    if (!S.next(0, cur)) return;
    f32x4 acc[2][2][4][2];
#pragma unroll
    for (int a = 0; a < 2; ++a)
#pragma unroll
        for (int b = 0; b < 2; ++b)
#pragma unroll
            for (int m = 0; m < 4; ++m)
#pragma unroll
                for (int n = 0; n < 2; ++n) acc[a][b][m][n] = (f32x4){0.f, 0.f, 0.f, 0.f};
    bf16x8 At[4][2], B0[2][2], B1[2][2];
    const char* cA = (const char*)g.A + (size_t)cur.aoff * 2; const char* cB = (const char*)g.Bt + (size_t)cur.boff * 2;
    PG8_STAGE(PG8_SB(0, 0), cB, voffB); PG8_STAGE(PG8_SB(0, 1), cB + hB, voffB); PG8_STAGE(PG8_SA(0, 0), cA, voffA); PG8_STAGE(PG8_SA(0, 1), cA + hA, voffA);
    if (wr == 1) PG8_BAR;
    PG8_WAIT_V(2); PG8_BAR;
    PG8_STAGE(PG8_SB(1, 0), cB + kstep, voffB); PG8_STAGE(PG8_SA(1, 0), cA + kstep, voffA); PG8_STAGE(PG8_SB(1, 1), cB + hB + kstep, voffB);
    PG8_WAIT_V(6); PG8_BAR;
    for (;;) {
        const bool has_next = S.next(ui + 1, nxt);
        const char* nA = has_next ? (const char*)g.A + (size_t)nxt.aoff * 2 : cA; const char* nB = has_next ? (const char*)g.Bt + (size_t)nxt.boff * 2 : cB;
        for (int t = 0; t < nt; t += 2) {
            const bool last = (t == nt - 2);
            const char* a1 = cA + (size_t)(t + 1) * kstep;
            const char* a2 = last ? nA : cA + (size_t)(t + 2) * kstep; const char* b2 = last ? nB : cB + (size_t)(t + 2) * kstep;
            const char* a3 = a2 + kstep; const char* b3 = b2 + kstep;
            PG8_LDB(B0, 0, 0); PG8_LDB(B1, 0, 1); PG8_SCHED; PG8_LDA(At, 0, 0); PG8_STAGE(PG8_SA(1, 1), a1 + hA, voffA);
            PG8_WAIT_V(8); PG8_WAIT_L(0); PG8_BAR; PG8_MMA(0, 0, At, B0); PG8_MMA(0, 1, At, B1); PG8_BAR; PG8_SCHED;
            PG8_LDA(At, 0, 1); PG8_STAGE(PG8_SB(0, 0), b2, voffB); PG8_STAGE(PG8_SB(0, 1), b2 + hB, voffB); PG8_STAGE(PG8_SA(0, 0), a2, voffA);
            PG8_WAIT_V(8); PG8_WAIT_L(0); PG8_BAR; PG8_MMA(1, 0, At, B0); PG8_MMA(1, 1, At, B1); PG8_BAR; PG8_SCHED;
            PG8_LDB(B0, 1, 0); PG8_LDB(B1, 1, 1); PG8_SCHED; PG8_LDA(At, 1, 0); PG8_STAGE(PG8_SA(0, 1), a2 + hA, voffA);
            PG8_WAIT_V(8); PG8_WAIT_L(0); PG8_BAR; PG8_MMA(0, 0, At, B0); PG8_MMA(0, 1, At, B1); PG8_BAR; PG8_SCHED;
            PG8_LDA(At, 1, 1); PG8_STAGE(PG8_SB(1, 0), b3, voffB); PG8_STAGE(PG8_SB(1, 1), b3 + hB, voffB); PG8_STAGE(PG8_SA(1, 0), a3, voffA);
            PG8_WAIT_V(8); PG8_WAIT_L(0); PG8_BAR; PG8_MMA(1, 0, At, B0); PG8_MMA(1, 1, At, B1); PG8_BAR; PG8_SCHED;
        }
        if constexpr (ALIGN_EPI) { if (wr == 0) PG8_BAR; }
        if constexpr (!Epi::AFTER_DRAIN) { E(acc, cur, wr, wc, fr, fq); }
        if (!has_next) break;
#pragma unroll
        for (int a = 0; a < 2; ++a)
#pragma unroll
            for (int b = 0; b < 2; ++b)
#pragma unroll
                for (int m = 0; m < 4; ++m)
#pragma unroll
                    for (int n = 0; n < 2; ++n) acc[a][b][m][n] = (f32x4){0.f, 0.f, 0.f, 0.f};
        cur = nxt; cA = nA; cB = nB; ++ui;
        if constexpr (ALIGN_EPI) { if (wr == 1) PG8_BAR; }
    }
    PG8_WAIT_V(0);
    if constexpr (!ALIGN_EPI) { if (wr == 0) PG8_BAR; }
    PG8_BAR;
    if constexpr (Epi::AFTER_DRAIN) { E.fused(acc, cur, wr, wc, fr, fq, lds, wid, lane); }
#undef PG8_SA
#undef PG8_SB
#undef PG8_STAGE
#undef PG8_LDA
#undef PG8_LDB
#undef PG8_MMA
#undef PG8_WAIT_V
#undef PG8_WAIT_L
#undef PG8_BAR
#undef PG8_SCHED
}
}
namespace pg8 {
struct XkvOrder {
    int G, c;
    __device__ bool next(int i, Unit& u) const {
        const int L = i * G + c; if (L >= 256) return false;
        const int kq = L & 3, tile = L >> 2, pm = tile & 3, pn = tile >> 2;
        u.row0 = pm * 256; u.col0 = pn * 256; u.aoff = (long)pm * 256 * DM + kq * 512; u.boff = (long)pn * 256 * DM + kq * 512; u.aux = kq; return true;
    }
};
struct ScoreOrder {
    int G, c;
    __device__ bool next(int i, Unit& u) const {
        const int L = i * G + c; if (L >= 256) return false;
        const int b = L >> 6, h = (L >> 4) & 3, mt = L & 15;
        u.row0 = b * SEQ + mt * 256; u.col0 = h * 256; u.aoff = (long)u.row0 * DM + h * XD; u.boff = (long)(b * NMEM) * DM + h * XD; u.aux = h; return true;
    }
};
struct PvOrder {
    int G, c;
    __device__ bool next(int i, Unit& u) const {
        const int L = i * G + c; if (L >= 512) return false;
        const int nt = L & 1, mt = (L >> 1) & 15, h = (L >> 5) & 3, b = L >> 7;
        u.row0 = b * SEQ + mt * 256; u.col0 = h * XD + nt * 256; u.aoff = (long)u.row0 * 1024 + h * 256; u.boff = ((long)(b * XH + h) * XD + nt * 256) * NMEM; u.aux = 0; return true;
    }
};

struct EpiStoreBf16 {
    static constexpr bool PERM = true, AFTER_DRAIN = false;
    bf16_t* O; int ldc; int split_cols; size_t split_stride;
    __device__ __forceinline__ void operator()(const f32x4 (&acc)[2][2][4][2], const Unit& u, int wr, int wc, int fr, int fq) const {
        int colt = u.col0; bf16_t* base = O;
        if (split_cols) { const int t = colt / split_cols; base += (size_t)t * split_stride; colt -= t * split_cols; }
        const int row0 = u.row0 + wr * 64 + fr, col0 = colt + wc * 32 + 8 * fq;
#pragma unroll
        for (int ai = 0; ai < 2; ++ai)
#pragma unroll
            for (int m = 0; m < 4; ++m) { bf16_t* rowp = base + (size_t)(row0 + ai * HALF + m * 16) * ldc + col0;
#pragma unroll
                for (int bj = 0; bj < 2; ++bj) { const f32x4 v0 = acc[ai][bj][m][0], v1 = acc[ai][bj][m][1];
                    u32x4 w; w.x = cvt_pk_bf16(v0[0], v0[1]); w.y = cvt_pk_bf16(v0[2], v0[3]); w.z = cvt_pk_bf16(v1[0], v1[1]); w.w = cvt_pk_bf16(v1[2], v1[3]);
                    *(u32x4*)(rowp + bj * HALF) = w; } }
    }
};
struct EpiSlab {
    static constexpr bool PERM = false, AFTER_DRAIN = false;
    float* slab; int ldc; size_t slab_stride;
    __device__ __forceinline__ void operator()(const f32x4 (&acc)[2][2][4][2], const Unit& u, int wr, int wc, int fr, int fq) const {
        float* base = slab + (size_t)u.aux * slab_stride; const int col0 = u.col0 + wc * 32 + 4 * fq;
#pragma unroll
        for (int ai = 0; ai < 2; ++ai)
#pragma unroll
            for (int m = 0; m < 4; ++m) { float* rowp = base + (size_t)(u.row0 + ai * HALF + wr * 64 + m * 16 + fr) * ldc + col0;
#pragma unroll
                for (int bj = 0; bj < 2; ++bj)
#pragma unroll
                    for (int n = 0; n < 2; ++n) *(f32x4*)(rowp + bj * HALF + n * 16) = acc[ai][bj][m][n]; }
    }
};
struct EpiResid {
    static constexpr bool PERM = false, AFTER_DRAIN = false;
    const float* base; float* out; bf16_t* outb; float* ssq; int ldc;
    __device__ __forceinline__ void operator()(const f32x4 (&acc)[2][2][4][2], const Unit& u, int wr, int wc, int fr, int fq) const {
        const int col0 = u.col0 + wc * 32 + 4 * fq;
        float ssum[2][4];
#pragma unroll
        for (int ai = 0; ai < 2; ++ai)
#pragma unroll
            for (int m = 0; m < 4; ++m) { const size_t off = (size_t)(u.row0 + ai * HALF + wr * 64 + m * 16 + fr) * ldc + col0; float s = 0.f;
#pragma unroll
                for (int bj = 0; bj < 2; ++bj)
#pragma unroll
                    for (int n = 0; n < 2; ++n) { const f32x4 bs = *(const f32x4*)(base + off + bj * HALF + n * 16); const f32x4 v = bs + acc[ai][bj][m][n];
                        *(f32x4*)(out + off + bj * HALF + n * 16) = v;
                        if (outb) { u32x2 w; w.x = cvt_pk_bf16(v[0], v[1]); w.y = cvt_pk_bf16(v[2], v[3]); *(u32x2*)(outb + off + bj * HALF + n * 16) = w; }
                        s += (v[0] * v[0] + v[1] * v[1]) + (v[2] * v[2] + v[3] * v[3]); }
                s += __shfl_xor(s, 16); s += __shfl_xor(s, 32); ssum[ai][m] = s; }
        if (ssq) {
#pragma unroll
            for (int ai = 0; ai < 2; ++ai) { const float v = fq == 0 ? ssum[ai][0] : fq == 1 ? ssum[ai][1] : fq == 2 ? ssum[ai][2] : ssum[ai][3];
                atomicAdd(ssq + u.row0 + ai * HALF + wr * 64 + fq * 16 + fr, v); }
        }
    }
};
struct EpiQ {
    static constexpr bool PERM = true, AFTER_DRAIN = false;
    bf16_t* O; const float* ssq_in; float* ssq_out;
    __device__ __forceinline__ void operator()(const f32x4 (&acc)[2][2][4][2], const Unit& u, int wr, int wc, int fr, int fq) const {
        const int col0 = u.col0 + wc * 32 + 8 * fq; float* so = ssq_out + (size_t)(u.col0 / XD) * MTOK;
        float ssum[2][4];
#pragma unroll
        for (int ai = 0; ai < 2; ++ai)
#pragma unroll
            for (int m = 0; m < 4; ++m) { const int row = u.row0 + ai * HALF + wr * 64 + m * 16 + fr; const float ri = __builtin_amdgcn_rsqf(ssq_in[row] * (1.0f / DM) + EPS);
                bf16_t* rowp = O + (size_t)row * DM + col0; float s = 0.f;
#pragma unroll
                for (int bj = 0; bj < 2; ++bj) { const f32x4 v0 = acc[ai][bj][m][0] * ri, v1 = acc[ai][bj][m][1] * ri;
                    u32x4 w; w.x = cvt_pk_bf16(v0[0], v0[1]); w.y = cvt_pk_bf16(v0[2], v0[3]); w.z = cvt_pk_bf16(v1[0], v1[1]); w.w = cvt_pk_bf16(v1[2], v1[3]);
                    *(u32x4*)(rowp + bj * HALF) = w;
                    s += (v0[0] * v0[0] + v0[1] * v0[1]) + (v0[2] * v0[2] + v0[3] * v0[3]) + (v1[0] * v1[0] + v1[1] * v1[1]) + (v1[2] * v1[2] + v1[3] * v1[3]); }
                s += __shfl_xor(s, 16); s += __shfl_xor(s, 32); ssum[ai][m] = s; }
#pragma unroll
        for (int ai = 0; ai < 2; ++ai) { const float v = fq == 0 ? ssum[ai][0] : fq == 1 ? ssum[ai][1] : fq == 2 ? ssum[ai][2] : ssum[ai][3];
            atomicAdd(so + u.row0 + ai * HALF + wr * 64 + fq * 16 + fr, v); }
    }
};
struct EpiUp {
    static constexpr bool PERM = true, AFTER_DRAIN = false;
    bf16_t* O; const float* ssq_in;
    __device__ __forceinline__ void operator()(const f32x4 (&acc)[2][2][4][2], const Unit& u, int wr, int wc, int fr, int fq) const {
        const int col0 = u.col0 + wc * 32 + 8 * fq;
#pragma unroll
        for (int ai = 0; ai < 2; ++ai)
#pragma unroll
            for (int m = 0; m < 4; ++m) { const int row = u.row0 + ai * HALF + wr * 64 + m * 16 + fr; const float ri = __builtin_amdgcn_rsqf(ssq_in[row] * (1.0f / DM) + EPS);
                bf16_t* rowp = O + (size_t)row * DFF + col0;
#pragma unroll
                for (int bj = 0; bj < 2; ++bj) { f32x4 v0 = acc[ai][bj][m][0] * ri, v1 = acc[ai][bj][m][1] * ri;
#pragma unroll
                    for (int e = 0; e < 4; ++e) { const float a = fmaxf(v0[e], 0.f), b = fmaxf(v1[e], 0.f); v0[e] = a * a; v1[e] = b * b; }
                    u32x4 w; w.x = cvt_pk_bf16(v0[0], v0[1]); w.y = cvt_pk_bf16(v0[2], v0[3]); w.z = cvt_pk_bf16(v1[0], v1[1]); w.w = cvt_pk_bf16(v1[2], v1[3]);
                    *(u32x4*)(rowp + bj * HALF) = w; } }
    }
};
struct EpiSoftmax {
    static constexpr bool PERM = true, AFTER_DRAIN = true;
    bf16_t* P; const float* ssqq;
    __device__ __forceinline__ void fused(f32x4 (&acc)[2][2][4][2], const Unit& u, int wr, int wc, int fr, int fq, PG8_LAS unsigned char* lds, int wid, int lane) const {
        PG8_LAS float* RM = (PG8_LAS float*)lds;
        PG8_LAS float* RS = (PG8_LAS float*)(lds + 4096);
        const float* sq = ssqq + (size_t)u.aux * MTOK;
        float mx[2][4];
#pragma unroll
        for (int ai = 0; ai < 2; ++ai)
#pragma unroll
            for (int m = 0; m < 4; ++m) { const int rl = ai * HALF + wr * 64 + m * 16 + fr; const int row = u.row0 + rl;
                const float sc = __builtin_amdgcn_rsqf(sq[row] * (1.0f / XD) + EPS) * (0.044194173824159216f * LOG2E);
                float mxx = -3.0e38f;
#pragma unroll
                for (int bj = 0; bj < 2; ++bj)
#pragma unroll
                    for (int n = 0; n < 2; ++n) { f32x4 v = acc[ai][bj][m][n] * sc; acc[ai][bj][m][n] = v; mxx = fmaxf(mxx, fmaxf(fmaxf(v[0], v[1]), fmaxf(v[2], v[3]))); }
                mxx = fmaxf(mxx, __shfl_xor(mxx, 16)); mxx = fmaxf(mxx, __shfl_xor(mxx, 32));
                if (fq == 0) RM[rl * 4 + wc] = mxx; }
        asm volatile("s_waitcnt lgkmcnt(0)" ::: "memory"); __builtin_amdgcn_s_barrier(); asm volatile("" ::: "memory");
#pragma unroll
        for (int ai = 0; ai < 2; ++ai)
#pragma unroll
            for (int m = 0; m < 4; ++m) { const int rl = ai * HALF + wr * 64 + m * 16 + fr;
                const f32x4 r4 = *(const PG8_LAS f32x4*)(RM + rl * 4); const float mxx = fmaxf(fmaxf(r4[0], r4[1]), fmaxf(r4[2], r4[3])); mx[ai][m] = mxx; float s = 0.f;
#pragma unroll
                for (int bj = 0; bj < 2; ++bj)
#pragma unroll
                    for (int n = 0; n < 2; ++n) { f32x4 v = acc[ai][bj][m][n];
#pragma unroll
                        for (int e = 0; e < 4; ++e) { v[e] = __builtin_amdgcn_exp2f(v[e] - mxx); s += v[e]; }
                        acc[ai][bj][m][n] = v; }
                s += __shfl_xor(s, 16); s += __shfl_xor(s, 32);
                if (fq == 0) RS[rl * 4 + wc] = s; }
        asm volatile("s_waitcnt lgkmcnt(0)" ::: "memory"); __builtin_amdgcn_s_barrier(); asm volatile("" ::: "memory");
        const int col0 = u.col0 + wc * 32 + 8 * fq;
#pragma unroll
        for (int ai = 0; ai < 2; ++ai)
#pragma unroll
            for (int m = 0; m < 4; ++m) { const int rl = ai * HALF + wr * 64 + m * 16 + fr;
                const f32x4 r4 = *(const PG8_LAS f32x4*)(RS + rl * 4); const float inv = 1.0f / ((r4[0] + r4[1]) + (r4[2] + r4[3]));
                bf16_t* rowp = P + (size_t)(u.row0 + rl) * 1024 + col0;
#pragma unroll
                for (int bj = 0; bj < 2; ++bj) { const f32x4 v0 = acc[ai][bj][m][0] * inv, v1 = acc[ai][bj][m][1] * inv;
                    u32x4 w; w.x = cvt_pk_bf16(v0[0], v0[1]); w.y = cvt_pk_bf16(v0[2], v0[3]); w.z = cvt_pk_bf16(v1[0], v1[1]); w.w = cvt_pk_bf16(v1[2], v1[3]);
                    *(u32x4*)(rowp + bj * HALF) = w; } }
        (void)mx; (void)wid; (void)lane;
    }
};
}
namespace fox {
typedef short bf16x8 __attribute__((ext_vector_type(8)));
typedef short s16x4 __attribute__((ext_vector_type(4)));
typedef float f32x16 __attribute__((ext_vector_type(16)));
typedef float f32x4 __attribute__((ext_vector_type(4)));
typedef unsigned u32x4 __attribute__((ext_vector_type(4)));
constexpr int D = 128, PITCH = 1024, OPITCH = 2048;
constexpr int NW = 8, QBLK = 32, KVBLK = 64, QB = NW * QBLK;
constexpr int SHM_V = KVBLK * D * 2, SHM_K = KVBLK * D * 2;
constexpr int LDS_BIAS = 0, LDS_WS = 512, LDS_V = 4096, LDS_K = LDS_V + 2 * SHM_V, LDS_Q = LDS_K + 2 * SHM_K, LDS_BYTES = LDS_Q + NW * 8192;
constexpr float SCALE = 0.08838834764831845f, C2 = LOG2E * SCALE, THR = 8.f;

#define KSWZ(row, colB) ((row) * 256 + ((colB) ^ (((row) & 7) << 4)))
#define SBAR() __builtin_amdgcn_sched_barrier(0)
__device__ __forceinline__ int v_st(int k, int c) { const int kk = (k & ~0xC) | ((k & 4) << 1) | ((k & 8) >> 1); return ((kk >> 3) * 4 + (c >> 5)) * 512 + ((kk & 7) * 32 + (c & 31)) * 2; }
__device__ __forceinline__ int v_rd_base(int lane) { return ((lane & 3) << 3) | (((lane >> 2) & 3) << 6) | (((lane >> 4) & 1) << 5) | (((lane >> 5) & 1) << 8); }
constexpr int v_rd_off(int d0, int ks, int half) { return d0 * 512 + ks * 4096 + half * 2048; }
__device__ __forceinline__ int crow(int r, int hi) { return (r & 3) + 8 * (r >> 2) + 4 * hi; }
__device__ __forceinline__ unsigned cvtpk(float lo, float hi) { unsigned r; asm volatile("v_cvt_pk_bf16_f32 %0, %1, %2" : "=v"(r) : "v"(lo), "v"(hi)); return r; }
__device__ __forceinline__ bf16x8 load8(const bf16* p) { return *reinterpret_cast<const bf16x8*>(p); }

__device__ __forceinline__ void mask_tile(f32x16& p0, f32x16& p1, int dq) {
    const float NEG = -__builtin_inff();
#pragma unroll
    for (int r = 0; r < 16; ++r) { const int c = (r & 3) + 8 * (r >> 2);
        if (dq - c < 0) p0[r] = NEG;
        if (dq - c - 32 < 0) p1[r] = NEG; }
}
__device__ __forceinline__ void partialSM(f32x16& p0, f32x16& p1, float& m_reg, float& mn, float& alpha) {
    float pmax = p0[0];
#pragma unroll
    for (int r = 1; r < 16; ++r) pmax = fmaxf(pmax, p0[r]);
#pragma unroll
    for (int r = 0; r < 16; ++r) pmax = fmaxf(pmax, p1[r]);
    { auto rr = __builtin_amdgcn_permlane32_swap(__float_as_uint(pmax), __float_as_uint(pmax), false, false);
      pmax = fmaxf(__uint_as_float(rr[0]), __uint_as_float(rr[1])); }
    if (__builtin_expect(__all((pmax - m_reg) * SCALE <= THR), 1)) { mn = m_reg; alpha = 1.f; }
    else { mn = fmaxf(m_reg, pmax); alpha = __builtin_amdgcn_exp2f((m_reg - mn) * C2); m_reg = mn; }
    const float mnL = -mn * C2;
#pragma unroll
    for (int r = 0; r < 16; ++r) p0[r] = fmaf(p0[r], C2, mnL);
#pragma unroll
    for (int r = 0; r < 16; ++r) p1[r] = fmaf(p1[r], C2, mnL);
#pragma unroll
    for (int r = 0; r < 16; ++r) p0[r] = __builtin_amdgcn_exp2f(p0[r]);
}
__device__ __forceinline__ void finishSM(f32x16& p0, f32x16& p1, float alpha, float& l_reg, bf16x8& pa0, bf16x8& pa1, bf16x8& pa2, bf16x8& pa3) {
#pragma unroll
    for (int r = 0; r < 16; ++r) p1[r] = __builtin_amdgcn_exp2f(p1[r]);
    float ps = 0;
#pragma unroll
    for (int r = 0; r < 16; ++r) ps += p0[r];
#pragma unroll
    for (int r = 0; r < 16; ++r) ps += p1[r];
    { auto rr = __builtin_amdgcn_permlane32_swap(__float_as_uint(ps), __float_as_uint(ps), false, false);
      ps = __uint_as_float(rr[0]) + __uint_as_float(rr[1]); }
    l_reg = l_reg * alpha + ps;
#define PK4(P, B_, OUT) do { unsigned a0 = cvtpk(P[B_+0], P[B_+1]), a1 = cvtpk(P[B_+2], P[B_+3]);                          \
        unsigned b0 = cvtpk(P[B_+4], P[B_+5]), b1 = cvtpk(P[B_+6], P[B_+7]);                                             \
        auto r0 = __builtin_amdgcn_permlane32_swap(a0, b0, false, false); auto r1 = __builtin_amdgcn_permlane32_swap(a1, b1, false, false); \
        u32x4 w = {r0[0], r1[0], r0[1], r1[1]}; OUT = *reinterpret_cast<bf16x8*>(&w); } while (0)
    PK4(p0, 0, pa0); PK4(p0, 8, pa1); PK4(p1, 0, pa2); PK4(p1, 8, pa3);
#undef PK4
}
template <int KB>
__device__ __forceinline__ void qkt(f32x16& p0, f32x16& p1, const char* K_lds, const float* bl, int r32, int hi, const char* qw) {
#pragma unroll
    for (int g = 0; g < 4; ++g) { const f32x4 b0 = *(const f32x4*)(bl + KB * 64 + 8 * g + 4 * hi), b1 = *(const f32x4*)(bl + KB * 64 + 32 + 8 * g + 4 * hi);
#pragma unroll
        for (int i = 0; i < 4; ++i) { p0[4 * g + i] = b0[i]; p1[4 * g + i] = b1[i]; } }
    const char* kb[4];
#pragma unroll
    for (int dd = 0; dd < 4; ++dd) kb[dd] = K_lds + KB * SHM_K + KSWZ(r32, (dd * 16 + hi * 8) * 2);
#pragma unroll
    for (int d0 = 0; d0 < 8; ++d0) { const char* a = kb[d0 & 3] + (d0 >> 2) * 128;
        bf16x8 b0 = *reinterpret_cast<const bf16x8*>(a);
        bf16x8 b1 = *reinterpret_cast<const bf16x8*>(a + 32 * 256);
        const bf16x8 qf = *reinterpret_cast<const bf16x8*>(qw + d0 * 1024);
        p0 = __builtin_amdgcn_mfma_f32_32x32x16_bf16(b0, qf, p0, 0, 0, 0);
        p1 = __builtin_amdgcn_mfma_f32_32x32x16_bf16(b1, qf, p1, 0, 0, 0); }
}
template <int VB>
__device__ __forceinline__ void pv_tile(f32x16* o, int vb0, bf16x8 pa0, bf16x8 pa1, bf16x8 pa2, bf16x8 pa3) {
#define TRRD(dst, off) asm volatile("ds_read_b64_tr_b16 %0, %1 offset:%2" : "=&v"(dst) : "v"(vb0), "i"(off) : "memory")
#define PV_D0(d0) do { s16x4 l0, l1, l2, l3, h0, h1, h2, h3; constexpr int b_ = VB * SHM_V + v_rd_off(d0, 0, 0); \
        TRRD(l0, b_); TRRD(h0, b_ + 2048); TRRD(l1, b_ + 4096); TRRD(h1, b_ + 6144); TRRD(l2, b_ + 8192); TRRD(h2, b_ + 10240); TRRD(l3, b_ + 12288); TRRD(h3, b_ + 14336); \
        asm volatile("s_waitcnt lgkmcnt(0)" ::: "memory"); SBAR();   \
        o[d0] = __builtin_amdgcn_mfma_f32_32x32x16_bf16(pa0, (bf16x8){l0[0], l0[1], l0[2], l0[3], h0[0], h0[1], h0[2], h0[3]}, o[d0], 0, 0, 0);   \
        o[d0] = __builtin_amdgcn_mfma_f32_32x32x16_bf16(pa1, (bf16x8){l1[0], l1[1], l1[2], l1[3], h1[0], h1[1], h1[2], h1[3]}, o[d0], 0, 0, 0);   \
        o[d0] = __builtin_amdgcn_mfma_f32_32x32x16_bf16(pa2, (bf16x8){l2[0], l2[1], l2[2], l2[3], h2[0], h2[1], h2[2], h2[3]}, o[d0], 0, 0, 0);   \
        o[d0] = __builtin_amdgcn_mfma_f32_32x32x16_bf16(pa3, (bf16x8){l3[0], l3[1], l3[2], l3[3], h3[0], h3[1], h3[2], h3[3]}, o[d0], 0, 0, 0); } while (0)
    PV_D0(0); PV_D0(1); PV_D0(2); PV_D0(3);
#undef PV_D0
#undef TRRD
}

struct HeadRef { unsigned rowb, o; const float* CS; const float* G; };
struct Seam { bf16x8 qr[8]; bf16x8 st_v0, st_v1, st_k0, st_k1; };
typedef __amdgpu_buffer_rsrc_t Srd;
#define BL8(rs, vo, so) __builtin_bit_cast(bf16x8, __builtin_amdgcn_raw_buffer_load_b128((rs), (vo), (so), 0))
#define VMW() asm volatile("s_waitcnt vmcnt(0)" ::: "memory")
#define VMWN(n) asm volatile("s_waitcnt vmcnt(%0)" :: "i"(n) : "memory")
#define SLOAD_H(k0, bb) do { const unsigned so_ = (unsigned)(k0) * (PITCH * 2);                                               \
                         S.st_v0 = BL8(R, kvoff, (unsigned)WS_FV + H.rowb + so_); S.st_v1 = BL8(R, kvoff, (unsigned)WS_FV + H.rowb + so_ + 32 * PITCH * 2);   \
                         S.st_k0 = BL8(R, kvoff, (unsigned)WS_FK + H.rowb + so_); S.st_k1 = BL8(R, kvoff, (unsigned)WS_FK + H.rowb + so_ + 32 * PITCH * 2);   \
                         if (wid == 0) __builtin_amdgcn_global_load_lds((const unsigned*)(H.CS + (k0)) + lane, (__attribute__((address_space(3))) unsigned*)(B3 + (bb) * 64), 4, 0, 0); } while (0)
#define QLOAD(p0_) do { const unsigned so_ = (unsigned)((p0_) + wid * QBLK) * (PITCH * 2);                                   \
        _Pragma("unroll") for (int d0 = 0; d0 < 8; ++d0) S.qr[d0] = BL8(R, qoff + d0 * 32, (unsigned)WS_FQ + H.rowb + so_); } while (0)
#define SWRITE_HK(bf) do { *(bf16x8*)(K_lds + (bf) * SHM_K + kws) = S.st_k0; *(bf16x8*)(K_lds + (bf) * SHM_K + kws + 32 * 256) = S.st_k1; } while (0)
#define SWRITE_HV(bf) do { *(bf16x8*)(V_lds + (bf) * SHM_V + vst0) = S.st_v0; *(bf16x8*)(V_lds + (bf) * SHM_V + vst1) = S.st_v1; } while (0)
#define SWRITE_H(bf) do { SWRITE_HV(bf); SWRITE_HK(bf); } while (0)

__device__ __forceinline__ void fox_prime(const Srd R, const HeadRef& H, int P0, char* lds, Seam& S) {
    const int tid = threadIdx.x, wid = __builtin_amdgcn_readfirstlane(tid >> 6), lane = tid & 63, r32 = lane & 31, hi = lane >> 5;
    const int sr = tid >> 4, sc = (tid & 15) * 8, kws = KSWZ(sr, sc * 2); char* K_lds = lds + LDS_K; float* B_lds = (float*)(lds + LDS_BIAS);
    const unsigned kvoff = (unsigned)(sr * PITCH + sc) * 2u, qoff = (unsigned)(r32 * PITCH + hi * 8) * 2u;
    __attribute__((address_space(3))) float* B3 = (__attribute__((address_space(3))) float*)B_lds;
    QLOAD(P0);
    SLOAD_H(0, 0); VMW(); SWRITE_HK(0);
    { char* qw = lds + LDS_Q + wid * 8192 + lane * 16;
#pragma unroll
      for (int d0 = 0; d0 < 8; ++d0) *(bf16x8*)(qw + d0 * 1024) = S.qr[d0]; }
    __syncthreads();
}
__device__ __forceinline__ void fox_block(const Srd R, const HeadRef& H, int P0, int P0n, char* lds, Seam& S) {
    const int tid = threadIdx.x, wid = __builtin_amdgcn_readfirstlane(tid >> 6), lane = tid & 63, r32 = lane & 31, hi = lane >> 5;
    const int NT = P0 / KVBLK + 4;
    const int qlo = P0 + wid * QBLK, qm = qlo + r32 - 4 * hi;
    char* V_lds = lds + LDS_V; char* K_lds = lds + LDS_K; float* B_lds = (float*)(lds + LDS_BIAS);
    char* qw = lds + LDS_Q + wid * 8192 + lane * 16;
    float* ws = (float*)(lds + LDS_WS) + wid * 64; float* li_l = ws, * al_l = ws + 32;
    float m_reg = -1e30f, l_reg = 0; f32x16 o[4] = {};
    const int sr = tid >> 4, sc = (tid & 15) * 8, vst0 = v_st(sr, sc), vst1 = v_st(32 + sr, sc), kws = KSWZ(sr, sc * 2);
    const int vb0 = (int)(uintptr_t)V_lds + v_rd_base(lane);
    const unsigned kvoff = (unsigned)(sr * PITCH + sc) * 2u, qoff = (unsigned)(r32 * PITCH + hi * 8) * 2u;
    __attribute__((address_space(3))) float* B3 = (__attribute__((address_space(3))) float*)B_lds;
#define RESC(a) do { if (__any((a) < 1.f)) { if (hi == 0) al_l[r32] = (a); asm volatile("s_waitcnt lgkmcnt(0)" ::: "memory");              \
                     for (int d_ = 0; d_ < 4; ++d_) for (int r = 0; r < 16; ++r) o[d_][r] *= al_l[crow(r, hi)]; } } while (0)
#define KBASE(t) ((t) * KVBLK)
#define MASKT(P0_, P1_, t) do { const int kb_ = KBASE(t); if (kb_ + KVBLK - 1 > qlo) mask_tile(P0_, P1_, qm - kb_); } while (0)
    f32x16 pA0, pA1, pB0, pB1; float mnA, mnB, alA, alB; bf16x8 pa0, pa1, pa2, pa3;
    SWRITE_HV(0); SBAR();
    SLOAD_H(KBASE(1), 1);
    SBAR(); qkt<0>(pA0, pA1, K_lds, B_lds, r32, hi, qw);
    MASKT(pA0, pA1, 0); partialSM(pA0, pA1, m_reg, mnA, alA);
    VMW(); SWRITE_H(1);
    __syncthreads();
#define HALF_STEP(PX0, PX1, mnX, alX, PY0, PY1, alY, t, KB, VB, SB) do {                                                      \
        SBAR(); qkt<KB>(PX0, PX1, K_lds, B_lds, r32, hi, qw);                                                                 \
        finishSM(PY0, PY1, alY, l_reg, pa0, pa1, pa2, pa3); SBAR();                                                           \
        if ((t) + 1 < NT) { SLOAD_H(KBASE((t) + 1), SB); SBAR(); }                                                                \
        pv_tile<VB>(o, vb0, pa0, pa1, pa2, pa3); MASKT(PX0, PX1, (t)); partialSM(PX0, PX1, m_reg, mnX, alX);                  \
        __syncthreads();                                                                                                      \
        if ((t) + 1 < NT) { VMW(); SWRITE_H(SB); }                                                                      \
        RESC(alX); __syncthreads(); } while (0)
    for (int t = 1; t + 1 < NT; t += 2) {
        HALF_STEP(pB0, pB1, mnB, alB, pA0, pA1, alA, t, 1, 0, 0);
        HALF_STEP(pA0, pA1, mnA, alA, pB0, pB1, alB, t + 1, 0, 1, 1);
    }
    SBAR(); qkt<1>(pB0, pB1, K_lds, B_lds, r32, hi, qw); SBAR();
    SLOAD_H(0, 0); SBAR();
    QLOAD(P0n);
    SBAR();
    finishSM(pA0, pA1, alA, l_reg, pa0, pa1, pa2, pa3); SBAR();
    pv_tile<0>(o, vb0, pa0, pa1, pa2, pa3);
    MASKT(pB0, pB1, NT - 1); partialSM(pB0, pB1, m_reg, mnB, alB); __syncthreads(); RESC(alB);
    finishSM(pB0, pB1, alB, l_reg, pa0, pa1, pa2, pa3); SBAR(); pv_tile<1>(o, vb0, pa0, pa1, pa2, pa3);
    SBAR(); VMWN(8); SWRITE_HK(0); SBAR();
    if (hi == 0) li_l[r32] = l_reg; asm volatile("s_waitcnt lgkmcnt(0)" ::: "memory");
    float gn[4];
#pragma unroll
    for (int d0 = 0; d0 < 4; ++d0) gn[d0] = H.G[d0 * 32 + r32];
    const unsigned ovoff = (unsigned)(4 * hi * OPITCH + r32) * 2u;
#pragma unroll
    for (int r = 0; r < 16; ++r) { const float rli = __builtin_amdgcn_rcpf(li_l[crow(r, hi)]); float ss = 0.f;
#pragma unroll
        for (int d0 = 0; d0 < 4; ++d0) { o[d0][r] *= rli; ss += o[d0][r] * o[d0][r]; }
        ss += __shfl_xor(ss, 1); ss += __shfl_xor(ss, 2); ss += __shfl_xor(ss, 4); ss += __shfl_xor(ss, 8); ss += __shfl_xor(ss, 16);
        const float rs = __builtin_amdgcn_rsqf(ss * (1.0f / D) + EPS);
        const unsigned so_ = (unsigned)(P0 + wid * QBLK + (r & 3) + 8 * (r >> 2)) * (OPITCH * 2);
#pragma unroll
        for (int d0 = 0; d0 < 4; ++d0) { const float v = o[d0][r] * rs * gn[d0];
            const float vn = __shfl_xor(v, 1);
            if ((r32 & 1) == 0) __builtin_amdgcn_raw_buffer_store_b32(cvtpk(v, vn), R, ovoff + d0 * 64, H.o + so_, 0); } }
#pragma unroll
    for (int d0 = 0; d0 < 8; ++d0) *(bf16x8*)(qw + d0 * 1024) = S.qr[d0];
    __syncthreads();
#undef RESC
#undef KBASE
#undef MASKT
#undef HALF_STEP
}
#undef BL8
#undef QLOAD
#undef VMW
#undef VMWN
#undef SLOAD_H
#undef SWRITE_HK
#undef SWRITE_HV
#undef SWRITE_H
#undef KSWZ
#undef SBAR
}
namespace mls {
typedef short bf16x8 __attribute__((ext_vector_type(8)));
typedef short bf16x4 __attribute__((ext_vector_type(4)));
typedef float f32x4 __attribute__((ext_vector_type(4)));
#define MFMA16(a, b, c) __builtin_amdgcn_mfma_f32_16x16x32_bf16((a), (b), (c), 0, 0, 0)

__device__ __forceinline__ void chunk_out(int b, int h, int c, const bf16* QP, const bf16* KPP, const bf16* VT, const bf16* CST, const float* NST,
                                          const bf16* MO, const float* gain, bf16* concat, float* xch  ) {
    const int tid = threadIdx.x, w = __builtin_amdgcn_readfirstlane(tid >> 6), lane = tid & 63, i16 = lane & 15, q = lane >> 4;
    const int tq = w & 3, dvh = w >> 2;
    const size_t R0 = (size_t)b * SEQ + (size_t)c * 64;
    const size_t item = ((size_t)(b * MLH + h) * NCHUNK + c);
    const bf16* qrow = QP + (R0 + 16 * tq + i16) * 512 + h * MLDK + 8 * q;
    bf16x8 qf[4];
#pragma unroll
    for (int ks = 0; ks < 4; ++ks) qf[ks] = *(const bf16x8*)(qrow + 32 * ks);
    f32x4 st[4];
#pragma unroll
    for (int stile = 0; stile < 4; ++stile) {
        st[stile] = (f32x4){0.f, 0.f, 0.f, 0.f};
        if (stile <= tq) {
            const bf16* krow = KPP + (R0 + 16 * stile + i16) * 512 + h * MLDK + 8 * q;
            bf16x8 kf[4];
#pragma unroll
            for (int ks = 0; ks < 4; ++ks) kf[ks] = *(const bf16x8*)(krow + 32 * ks);
#pragma unroll
            for (int ks = 0; ks < 4; ++ks) st[stile] = MFMA16(kf[ks], qf[ks], st[stile]);
            if (stile == tq) {
#pragma unroll
                for (int r = 0; r < 4; ++r) if (4 * q + r > i16) st[stile][r] = 0.f;
            }
        }
    }
    float den = 0.f;
#pragma unroll
    for (int stile = 0; stile < 4; ++stile) den += (st[stile][0] + st[stile][1]) + (st[stile][2] + st[stile][3]);
    { const float* nrow = NST + item * MLDK + 8 * q;
#pragma unroll
      for (int ks = 0; ks < 4; ++ks) { const f32x4 n0 = *(const f32x4*)(nrow + 32 * ks), n1 = *(const f32x4*)(nrow + 32 * ks + 4);
          const v4u qq = __builtin_bit_cast(v4u, qf[ks]);
          den += bflo(qq[0]) * n0[0] + bfhi(qq[0]) * n0[1] + bflo(qq[1]) * n0[2] + bfhi(qq[1]) * n0[3]
               + bflo(qq[2]) * n1[0] + bfhi(qq[2]) * n1[1] + bflo(qq[3]) * n1[2] + bfhi(qq[3]) * n1[3]; } }
    den += __shfl_xor(den, 16); den += __shfl_xor(den, 32);
    bf16x8 pf[2];
#pragma unroll
    for (int p = 0; p < 2; ++p) { v4u wv; wv[0] = pg8::cvt_pk_bf16(st[2 * p][0], st[2 * p][1]); wv[1] = pg8::cvt_pk_bf16(st[2 * p][2], st[2 * p][3]);
        wv[2] = pg8::cvt_pk_bf16(st[2 * p + 1][0], st[2 * p + 1][1]); wv[3] = pg8::cvt_pk_bf16(st[2 * p + 1][2], st[2 * p + 1][3]); pf[p] = __builtin_bit_cast(bf16x8, wv); }
    const int npair = (tq >> 1) + 1;
    f32x4 num[8];
    const bf16* vbase = VT + (item * MLDV + dvh * 128 + i16) * 64 + 4 * q;
    const bf16* cbase = CST + (item * MLDV + dvh * 128 + i16) * MLDK + 8 * q;
#pragma unroll
    for (int dt = 0; dt < 8; ++dt) {
        f32x4 a = (f32x4){0.f, 0.f, 0.f, 0.f};
        const bf16* vrow = vbase + (size_t)dt * 16 * 64; const bf16* crowp = cbase + (size_t)dt * 16 * MLDK;
#pragma unroll
        for (int p = 0; p < 2; ++p) if (p < npair) {
            const v2u lo = *(const v2u*)(vrow + 32 * p), hi2 = *(const v2u*)(vrow + 32 * p + 16);
            const v4u vv = {lo[0], lo[1], hi2[0], hi2[1]};
            a = MFMA16(__builtin_bit_cast(bf16x8, vv), pf[p], a); }
#pragma unroll
        for (int ks = 0; ks < 4; ++ks) { const bf16x8 cf = *(const bf16x8*)(crowp + 32 * ks); a = MFMA16(cf, qf[ks], a); }
        num[dt] = a;
    }
    const float rden = 1.0f / fmaxf(fabsf(den), 1.0f);
    float ss = 0.f;
#pragma unroll
    for (int dt = 0; dt < 8; ++dt) { num[dt] = num[dt] * rden; ss += (num[dt][0] * num[dt][0] + num[dt][1] * num[dt][1]) + (num[dt][2] * num[dt][2] + num[dt][3] * num[dt][3]); }
    ss += __shfl_xor(ss, 16); ss += __shfl_xor(ss, 32);
    if (q == 0) xch[w * 16 + i16] = ss;
    __syncthreads();
    const float tot = ss + xch[(w ^ 4) * 16 + i16];
    const float rn = __builtin_amdgcn_rsqf(tot * (1.0f / MLDV) + EPS);
    const size_t row = R0 + 16 * tq + i16; const int dv0 = h * MLDV + dvh * 128 + 4 * q;
#pragma unroll
    for (int dt = 0; dt < 8; ++dt) { const int dv = dv0 + 16 * dt;
        const f32x4 g4 = *(const f32x4*)(gain + dv); const v2u mo2 = *(const v2u*)(MO + row * 1024 + dv);
        const float o0 = num[dt][0] * rn * g4[0] * sigmoidf_(bflo(mo2[0])), o1 = num[dt][1] * rn * g4[1] * sigmoidf_(bfhi(mo2[0]));
        const float o2 = num[dt][2] * rn * g4[2] * sigmoidf_(bflo(mo2[1])), o3 = num[dt][3] * rn * g4[3] * sigmoidf_(bfhi(mo2[1]));
        v2u ov; ov[0] = pg8::cvt_pk_bf16(o0, o1); ov[1] = pg8::cvt_pk_bf16(o2, o3);
        *(v2u*)(concat + row * 2048 + 1024 + dv) = ov; }
    __syncthreads();
}

__device__ __forceinline__ void state_scan(int bh, int sl, const bf16* KT, const bf16* VT, const float* EB, bf16* CST) {
    const int tid = threadIdx.x, w = __builtin_amdgcn_readfirstlane(tid >> 6), lane = tid & 63, i16 = lane & 15, q = lane >> 4;
    const size_t it0 = (size_t)bh * NCHUNK;
    const bf16* ka = KT + (it0 * MLDK + 16 * w + i16) * 64 + 8 * q;
    const bf16* vb = VT + (it0 * MLDV + 16 * sl + i16) * 64 + 8 * q;
    bf16* cs = CST + (it0 * MLDV + 16 * sl + i16) * MLDK + 16 * w + 4 * q;
    const float ebv = EB[it0 + lane];
    f32x4 acc = (f32x4){0.f, 0.f, 0.f, 0.f};
    bf16x8 a0 = *(const bf16x8*)(ka), a1 = *(const bf16x8*)(ka + 32), b0 = *(const bf16x8*)(vb), b1 = *(const bf16x8*)(vb + 32);
    for (int c = 0; c < NCHUNK; ++c) {
        const int cn = c + 1 < NCHUNK ? c + 1 : c;
        const bf16x8 na0 = *(const bf16x8*)(ka + (size_t)cn * MLDK * 64), na1 = *(const bf16x8*)(ka + (size_t)cn * MLDK * 64 + 32);
        const bf16x8 nb0 = *(const bf16x8*)(vb + (size_t)cn * MLDV * 64), nb1 = *(const bf16x8*)(vb + (size_t)cn * MLDV * 64 + 32);
        v2u ov; ov[0] = pg8::cvt_pk_bf16(acc[0], acc[1]); ov[1] = pg8::cvt_pk_bf16(acc[2], acc[3]);
        *(v2u*)(cs + (size_t)c * MLDV * MLDK) = ov;
        acc = MFMA16(a0, b0, acc); acc = MFMA16(a1, b1, acc);
        const float e = __shfl(ebv, c);
        acc = acc * e;
        a0 = na0; a1 = na1; b0 = nb0; b1 = nb1;
    }
}
#undef MFMA16
}
typedef const float* cfp_t;
struct Frame {
    LAS unsigned char* lds; unsigned char* ldsg;
    int tid, lane, wave, vcu, G;
    const __attribute__((address_space(4))) cfp_t* inp; float* out; unsigned char* ws;
};
__device__ __forceinline__ float wave_incl_scan(float v, int lane) {
#pragma unroll
    for (int o = 1; o < 64; o <<= 1) { const float t = __shfl_up(v, o); if (lane >= o) v += t; }
    return v;
}

__device__ __forceinline__ void p0_transpose_item(const float* W, int ldw, int K, bf16* WT, const float* gk, int k0, int n0_dst, int n0_src, LAS float* scr, int lane) {
#pragma unroll 8
    for (int i = 0; i < 32; ++i) { const int kk = 2 * i + (lane >> 5); float v = W[(size_t)(k0 + kk) * ldw + n0_src + (lane & 31)]; if (gk) v *= gk[k0 + kk]; scr[kk * 33 + (lane & 31)] = v; }
    LDS_WAIT(); asm volatile("" ::: "memory");
    const int c = lane & 7;
#pragma unroll
    for (int j = 0; j < 4; ++j) { const int n = (lane >> 3) + 8 * j; const LAS float* s = scr + (8 * c) * 33 + n;
        v4u o; o.x = pk2(s[0 * 33], s[1 * 33]); o.y = pk2(s[2 * 33], s[3 * 33]); o.z = pk2(s[4 * 33], s[5 * 33]); o.w = pk2(s[6 * 33], s[7 * 33]);
        *(GAS v4u*)(WT + (size_t)(n0_dst + n) * K + k0 + 8 * c) = o; }
    LDS_WAIT(); asm volatile("" ::: "memory");
}
__device__ __forceinline__ float rms_row_to_bf16(const float* xrow, const float* g, bf16* orow, int lane) {
    const GAS v4f* xr = (const GAS v4f*)xrow + lane; const GAS v4f* gr = (const GAS v4f*)g + lane;
    v4f v[8]; float s = 0.f;
#pragma unroll
    for (int j = 0; j < 8; ++j) { v[j] = xr[64 * j]; s += (v[j].x * v[j].x + v[j].y * v[j].y) + (v[j].z * v[j].z + v[j].w * v[j].w); }
    const float rinv = 1.0f / sqrtf(wave_sum(s) * (1.f / DM) + EPS);
    GAS v2u* o8 = (GAS v2u*)orow + lane;
#pragma unroll
    for (int j = 0; j < 8; ++j) { const v4f gg = gr[64 * j]; v2u w; w.x = pk2(v[j].x * rinv * gg.x, v[j].y * rinv * gg.y); w.y = pk2(v[j].z * rinv * gg.z, v[j].w * rinv * gg.w); o8[64 * j] = w; }
    return rinv;
}
__device__ __forceinline__ void p0_prologue(Frame& F) {
    const float* x = F.inp[0]; const float* mem = F.inp[1]; const float* mixer_norm = F.inp[2]; const float* w_in = F.inp[3];
    const int gw = F.vcu * 8 + F.wave, NGW = F.G * 8;
    LAS float* WgL = (LAS float*)F.lds;
    for (int idx = F.tid; idx < 32768; idx += NTHREADS) { const int e = idx & 3, ln = (idx >> 2) & 63, sp = idx >> 8, gate = ln & 15, q = ln >> 4, k = 16 * sp + 4 * q + e;
        const int col = gate < 8 ? 3072 + gate : 5128 + (gate - 8);
        WgL[idx] = w_in[(size_t)k * IN_WIDTH + col] * mixer_norm[k]; }
    __syncthreads();
    { float* gates = (float*)(F.ws + WS_GATES); const int i16 = F.lane & 15, q = F.lane >> 4;
      for (int grp = gw; grp < MTOK / 16; grp += NGW) {
          const float* xr = x + (size_t)(grp * 16 + i16) * DM + 4 * q; v4f acc = (v4f){0.f, 0.f, 0.f, 0.f};
#pragma unroll 4
          for (int sp = 0; sp < 128; ++sp) { const v4f x4 = *(const v4f*)(xr + 16 * sp); const v4f w4 = *(const LAS v4f*)(WgL + (sp * 64 + F.lane) * 4);
              acc = __builtin_amdgcn_mfma_f32_16x16x4f32(x4.x, w4.x, acc, 0, 0, 0); acc = __builtin_amdgcn_mfma_f32_16x16x4f32(x4.y, w4.y, acc, 0, 0, 0);
              acc = __builtin_amdgcn_mfma_f32_16x16x4f32(x4.z, w4.z, acc, 0, 0, 0); acc = __builtin_amdgcn_mfma_f32_16x16x4f32(x4.w, w4.w, acc, 0, 0, 0); }
#pragma unroll
          for (int r = 0; r < 4; ++r) gates[(size_t)(grp * 16 + 4 * q + r) * 16 + i16] = acc[r];
      } }
    { bf16* XN = (bf16*)(F.ws + WS_XN); float* RINV = (float*)(F.ws + WS_RINV);
      for (int m = gw; m < MTOK; m += NGW) { const float ri = rms_row_to_bf16(x + (size_t)m * DM, mixer_norm, XN + (size_t)m * DM, F.lane); if (F.lane == 0) RINV[m] = ri; }
      bf16* MN = (bf16*)(F.ws + WS_MN);
      for (int m = gw; m < MROWS; m += NGW) (void)rms_row_to_bf16(mem + (size_t)m * DM, F.inp[15], MN + (size_t)m * DM, F.lane); }
    __syncthreads();
    LAS float* scr = (LAS float*)(F.lds + F.wave * 16384);
    for (int it = gw; it < 32768; it += NGW) {
        int r = it;
        if (r < 6144) { const int kb = r / 192, nb = r % 192, n0 = 32 * nb, grpc = n0 >> 10, shift = grpc < 3 ? 0 : (grpc < 5 ? 8 : 16);
            p0_transpose_item(w_in, IN_WIDTH, DM, (bf16*)(F.ws + WS_WIN), nullptr, 64 * kb, n0, n0 + shift, scr, F.lane); continue; } r -= 6144;
        if (r < 2048) { p0_transpose_item(F.inp[13], DM, DM, (bf16*)(F.ws + WS_WOUT), nullptr, 64 * (r / 64), 32 * (r % 64), 32 * (r % 64), scr, F.lane); continue; } r -= 2048;
        if (r < 2048) { p0_transpose_item(F.inp[16], DM, DM, (bf16*)(F.ws + WS_WXQ), F.inp[14], 64 * (r / 64), 32 * (r % 64), 32 * (r % 64), scr, F.lane); continue; } r -= 2048;
        if (r < 4096) { p0_transpose_item(F.inp[17], 2 * DM, DM, (bf16*)(F.ws + WS_WXKV), nullptr, 64 * (r / 128), 32 * (r % 128), 32 * (r % 128), scr, F.lane); continue; } r -= 4096;
        if (r < 2048) { p0_transpose_item(F.inp[20], DM, DM, (bf16*)(F.ws + WS_WXO), nullptr, 64 * (r / 64), 32 * (r % 64), 32 * (r % 64), scr, F.lane); continue; } r -= 2048;
        if (r < 8192) { p0_transpose_item(F.inp[22], DFF, DM, (bf16*)(F.ws + WS_WUP), F.inp[21], 64 * (r / 256), 32 * (r % 256), 32 * (r % 256), scr, F.lane); continue; } r -= 8192;
        p0_transpose_item(F.inp[23], DM, DFF, (bf16*)(F.ws + WS_WDN), nullptr, 64 * (r / 64), 32 * (r % 64), 32 * (r % 64), scr, F.lane);
    }
}

constexpr int P2_KT_OFF = 4096, P2_KT_PITCH = 136, P2_VT_OFF = P2_KT_OFF + 64 * P2_KT_PITCH * 2, P2_VT_PITCH = 264;
__device__ __forceinline__ void p2_prep_item(Frame& F, int item) {
    const int b = item >> 6, c = item & 63; const size_t R0 = (size_t)b * SEQ + (size_t)c * 64;
    const int tid = F.tid, lane = F.lane, w = F.wave;
    LAS float* gq = (LAS float*)F.lds; LAS float* uk = gq + 256;
    LAS bf16* kt = (LAS bf16*)(F.lds + P2_KT_OFF); LAS bf16* vt = (LAS bf16*)(F.lds + P2_VT_OFF);
    const float* GATES = (const float*)(F.ws + WS_GATES); const float* RINV = (const float*)(F.ws + WS_RINV);
    if (w < 4) { const size_t row = R0 + lane; const float ri = RINV[row];
        const float mi = GATES[row * 16 + 8 + w] * ri + F.inp[5][w], mf = GATES[row * 16 + 12 + w] * ri + F.inp[6][w];
        const float bcum = wave_incl_scan(logsigmoidf(mf), lane);
        const float g = __expf(bcum), u = __expf(mi - bcum) * 0.08838834764831845f;
        gq[w * 64 + lane] = g; uk[w * 64 + lane] = u;
        if (lane == 63) ((float*)(F.ws + WS_EB))[(size_t)(b * MLH + w) * NCHUNK + c] = g; }
    { bf16* FQ = (bf16*)(F.ws + WS_FQ); bf16* FK = (bf16*)(F.ws + WS_FK); const int l16 = lane & 15;
      float gqn[8], gkn[8];
#pragma unroll
      for (int e = 0; e < 8; ++e) { gqn[e] = F.inp[9][l16 * 8 + e]; gkn[e] = F.inp[10][l16 * 8 + e]; }
      for (int it = w; it < 256; it += 8) { const int seg = it * 4 + (lane >> 4), row = seg >> 4, hh = seg & 15;
          bf16* p = (hh < 8 ? FQ : FK) + (R0 + row) * 1024 + (hh & 7) * FOXD + l16 * 8;
          const v4u raw = *(const v4u*)p; float v[8];
#pragma unroll
          for (int e = 0; e < 4; ++e) { v[2 * e] = bflo(raw[e]); v[2 * e + 1] = bfhi(raw[e]); }
          float ss = 0.f;
#pragma unroll
          for (int e = 0; e < 8; ++e) ss += v[e] * v[e];
          ss += __shfl_xor(ss, 1); ss += __shfl_xor(ss, 2); ss += __shfl_xor(ss, 4); ss += __shfl_xor(ss, 8);
          const float ri = 1.0f / sqrtf(ss * (1.0f / FOXD) + EPS);
          v4u o;
#pragma unroll
          for (int e = 0; e < 4; ++e) { const float g0 = hh < 8 ? gqn[2 * e] : gkn[2 * e], g1 = hh < 8 ? gqn[2 * e + 1] : gkn[2 * e + 1]; o[e] = pk2(v[2 * e] * ri * g0, v[2 * e + 1] * ri * g1); }
          *(v4u*)p = o; } }
    __syncthreads();
    const bf16* MQK = (const bf16*)(F.ws + WS_MQK); const bf16* MV = (const bf16*)(F.ws + WS_MV);
    bf16* QP = (bf16*)(F.ws + WS_QP); bf16* KPP = (bf16*)(F.ws + WS_KPP);
    const float* conv_w = F.inp[7]; const float* conv_b = F.inp[8];
    for (int h = 0; h < MLH; ++h) {
        { const int cgp = tid & 31, rg = tid >> 5; const bool isq = cgp < 16; const int col = (isq ? 0 : 512) + h * MLDK + (cgp & 15) * 8;
          float cw[4][8], cb[8];
#pragma unroll
          for (int e = 0; e < 8; ++e) { cb[e] = conv_b[col + e];
#pragma unroll
              for (int j = 0; j < 4; ++j) cw[j][e] = conv_w[j * 1024 + col + e]; }
          float u[7][8];
#pragma unroll
          for (int i = 0; i < 7; ++i) { const int pos = c * 64 + 4 * rg - 3 + i;
              v4u raw = (v4u){0u, 0u, 0u, 0u}; if (pos >= 0) raw = *(const v4u*)(MQK + ((size_t)b * SEQ + pos) * 1024 + col);
#pragma unroll
              for (int e = 0; e < 4; ++e) { u[i][2 * e] = bflo(raw[e]); u[i][2 * e + 1] = bfhi(raw[e]); } }
#pragma unroll
          for (int r = 0; r < 4; ++r) { const int t = 4 * rg + r; const float f = isq ? gq[h * 64 + t] : uk[h * 64 + t]; float y[8];
#pragma unroll
              for (int e = 0; e < 8; ++e) { float a = cb[e];
#pragma unroll
                  for (int j = 0; j < 4; ++j) a += cw[j][e] * u[r + j][e];
                  y[e] = a * sigmoidf_(a) * f; }
              v4u o; o.x = pk2(y[0], y[1]); o.y = pk2(y[2], y[3]); o.z = pk2(y[4], y[5]); o.w = pk2(y[6], y[7]);
              *(v4u*)((isq ? QP : KPP) + (R0 + t) * 512 + h * MLDK + (cgp & 15) * 8) = o;
              if (!isq) *(LAS v4u*)(kt + t * P2_KT_PITCH + (cgp & 15) * 8) = o; } }
#pragma unroll
        for (int i = 0; i < 4; ++i) { const int idx = tid + NTHREADS * i, row = idx >> 5, ch = idx & 31;
            *(LAS v4u*)(vt + row * P2_VT_PITCH + ch * 8) = *(const v4u*)(MV + (R0 + row) * 1024 + h * MLDV + ch * 8); }
        __syncthreads();
        const size_t itemh = (size_t)(b * MLH + h) * NCHUNK + c;
        { bf16* KT = (bf16*)(F.ws + WS_KT) + itemh * MLDK * 64;
#pragma unroll
          for (int i = 0; i < 2; ++i) { const int idx = tid + NTHREADS * i, d = idx >> 3, sg = idx & 7; unsigned short e8[8];
#pragma unroll
              for (int e = 0; e < 8; ++e) e8[e] = kt[(8 * sg + e) * P2_KT_PITCH + d];
              v4u o; o.x = e8[0] | ((unsigned)e8[1] << 16); o.y = e8[2] | ((unsigned)e8[3] << 16); o.z = e8[4] | ((unsigned)e8[5] << 16); o.w = e8[6] | ((unsigned)e8[7] << 16);
              *(v4u*)(KT + d * 64 + 8 * sg) = o; }
          bf16* VT = (bf16*)(F.ws + WS_VT) + itemh * MLDV * 64;
#pragma unroll
          for (int i = 0; i < 4; ++i) { const int idx = tid + NTHREADS * i, dv = idx >> 3, sg = idx & 7; unsigned short e8[8];
#pragma unroll
              for (int e = 0; e < 8; ++e) e8[e] = vt[(8 * sg + e) * P2_VT_PITCH + dv];
              v4u o; o.x = e8[0] | ((unsigned)e8[1] << 16); o.y = e8[2] | ((unsigned)e8[3] << 16); o.z = e8[4] | ((unsigned)e8[5] << 16); o.w = e8[6] | ((unsigned)e8[7] << 16);
              *(v4u*)(VT + dv * 64 + 8 * sg) = o; }
          if (tid < MLDK) { float s = 0.f;
#pragma unroll 8
              for (int t = 0; t < 64; ++t) s += bf2f(kt[t * P2_KT_PITCH + tid]);
              ((float*)(F.ws + WS_KSUM))[itemh * MLDK + tid] = s; } }
        __syncthreads();
    }
    if (w < 4) { const int mr = item * 4 + w; const float* slab = (const float*)((const unsigned char*)F.out + OUT_SLAB);
        const float* gxq = F.inp[18]; const float* gxk = F.inp[19];
        v4f kv[8]; float ssh[4] = {0.f, 0.f, 0.f, 0.f};
#pragma unroll
        for (int j = 0; j < 8; ++j) { const int col = 4 * (lane + 64 * j); v4f a = (v4f){0.f, 0.f, 0.f, 0.f};
#pragma unroll
            for (int s = 0; s < 4; ++s) a = a + *(const v4f*)(slab + ((size_t)s * MROWS + mr) * 4096 + col);
            kv[j] = a; ssh[j >> 1] += (a.x * a.x + a.y * a.y) + (a.z * a.z + a.w * a.w); }
        float rk[4];
#pragma unroll
        for (int hh = 0; hh < 4; ++hh) rk[hh] = 1.0f / sqrtf(wave_sum(ssh[hh]) * (1.0f / XD) + EPS);
        bf16* KH = (bf16*)(F.ws + WS_KHAT) + (size_t)mr * DM;
#pragma unroll
        for (int j = 0; j < 8; ++j) { const int col = 4 * (lane + 64 * j), d = col & (XD - 1); const v4f a = *(const v4f*)(gxq + d), g2 = *(const v4f*)(gxk + d); const float r = rk[j >> 1];
            v2u o; o.x = pk2(kv[j].x * r * a.x * g2.x, kv[j].y * r * a.y * g2.y); o.y = pk2(kv[j].z * r * a.z * g2.z, kv[j].w * r * a.w * g2.w);
            *(v2u*)(KH + col) = o; }
        bf16* VTM = (bf16*)(F.ws + WS_VTM); const int bm = mr >> 8, key = mr & 255;
#pragma unroll
        for (int j = 0; j < 8; ++j) { const int dcol = 4 * (lane + 64 * j); v4f a = (v4f){0.f, 0.f, 0.f, 0.f};
#pragma unroll
            for (int s = 0; s < 4; ++s) a = a + *(const v4f*)(slab + ((size_t)s * MROWS + mr) * 4096 + 2048 + dcol);
            const int hh = dcol >> 9, d = dcol & (XD - 1); bf16* vp = VTM + ((size_t)(bm * XH + hh) * XD + d) * NMEM + key;
            vp[0] = (bf16)f2bf(a.x); vp[NMEM] = (bf16)f2bf(a.y); vp[2 * NMEM] = (bf16)f2bf(a.z); vp[3 * NMEM] = (bf16)f2bf(a.w); }
    }
    __syncthreads();
}

__device__ __forceinline__ void p3_scan_item(Frame& F, int item) {
    const int bh = item >> 4, sl = item & 15;
    mls::state_scan(bh, sl, (const bf16*)(F.ws + WS_KT), (const bf16*)(F.ws + WS_VT), (const float*)(F.ws + WS_EB), (bf16*)((unsigned char*)F.out + OUT_CST));
    if (sl == 0 && F.tid < MLDK) {
        const float* EB = (const float*)(F.ws + WS_EB) + (size_t)bh * NCHUNK; const float* KS = (const float*)(F.ws + WS_KSUM) + (size_t)bh * NCHUNK * MLDK + F.tid;
        float* NS = (float*)(F.ws + WS_NST) + (size_t)bh * NCHUNK * MLDK + F.tid; float n = 0.f;
        for (int c = 0; c < NCHUNK; ++c) { NS[(size_t)c * MLDK] = n; n = EB[c] * (n + KS[(size_t)c * MLDK]); }
    }
    if ((sl == 1 || sl == 2) && F.wave == 0) {
        const int seq = (sl - 1) * 16 + bh, b = seq >> 3, fh = seq & 7;
        const float* GATES = (const float*)(F.ws + WS_GATES); const float* RINV = (const float*)(F.ws + WS_RINV); const float fb = F.inp[4][fh];
        float* C = (float*)(F.ws + WS_CFOX) + (size_t)seq * SEQ + 64 * F.lane; const size_t r0 = (size_t)b * SEQ + 64 * F.lane;
        float tot = 0.f;
        for (int j = 0; j < 64; ++j) tot += logsigmoidf(GATES[(r0 + j) * 16 + fh] * RINV[r0 + j] + fb);
        float run = wave_incl_scan(tot, F.lane) - tot;
        for (int j = 0; j < 64; ++j) { run += logsigmoidf(GATES[(r0 + j) * 16 + fh] * RINV[r0 + j] + fb); C[j] = run * -11.313708498984761f; }
    }
}
#ifndef MK_PER_PHASE
#define MK_PER_PHASE 0
#endif
#define XB_TMO      128
#define XB_XCNT(j)  (256  + 64 * (j))
#define XB_XSUB(j)  (1280 + 64 * (j))
#define XB_XGEN(j)  (2304 + 64 * (j))
#define XB_TOP      3328
#define XB_TOPGEN   3392
#define XCD_BAR_WORDS 3456
#define XB_SPIN_CAP (1u << 20)
__device__ __forceinline__ unsigned xb_ld(unsigned* p)              { return __hip_atomic_load(p, __ATOMIC_RELAXED, __HIP_MEMORY_SCOPE_AGENT); }
__device__ __forceinline__ unsigned xb_add(unsigned* p, unsigned v) { return __hip_atomic_fetch_add(p, v, __ATOMIC_RELAXED, __HIP_MEMORY_SCOPE_AGENT); }
__device__ __forceinline__ unsigned xb_xcc_id() { return (unsigned)__builtin_amdgcn_s_getreg((3 << 11) | 20) & 0xFu; }
#define XB_SPIN(cond, bar) do { unsigned _sp = 0; while (cond) { __builtin_amdgcn_s_sleep(1); \
    if ((++_sp & 255u) == 0u) { if (xb_ld(&(bar)[XB_TMO])) break; if (_sp > XB_SPIN_CAP) { atomicAdd(&(bar)[XB_TMO], 1u); break; } } } } while (0)
struct XcdBarrier { unsigned* bar; unsigned x; volatile LAS unsigned* st; };
__device__ __forceinline__ XcdBarrier xcd_barrier_post(unsigned* bar, volatile LAS unsigned* st) {
    XcdBarrier b; b.bar = bar; b.x = xb_xcc_id(); b.st = st;
    if (threadIdx.x == 0) (void)xb_add(&bar[XB_XCNT(b.x)], 1u);
    return b;
}
__device__ __forceinline__ void xcd_barrier_complete(unsigned* bar, unsigned x, unsigned& nloc, unsigned& nx) {
    const unsigned G = gridDim.x * gridDim.y * gridDim.z;
    unsigned sum, cnt, mine, sp = 0u;
    for (;;) {
        sum = 0u; cnt = 0u; mine = 0u;
#pragma unroll
        for (unsigned j = 0; j < 16; ++j) { const unsigned c = xb_ld(&bar[XB_XCNT(j)]); sum += c; cnt += (c > 0u) ? 1u : 0u; mine = (j == x) ? c : mine; }
        if (sum == G) break;
        __builtin_amdgcn_s_sleep(1);
        if ((++sp & 255u) == 0u) { if (xb_ld(&bar[XB_TMO])) break; if (sp > XB_SPIN_CAP) { atomicAdd(&bar[XB_TMO], 1u); break; } }
    }
    nloc = mine > 0u ? mine : 1u; nx = cnt > 0u ? cnt : 1u;
}
__device__ __forceinline__ void xcd_barrier(const XcdBarrier& b) {
    asm volatile("s_waitcnt vmcnt(0)" ::: "memory");
    __syncthreads();
    if (threadIdx.x == 0) {
        unsigned* bar = b.bar;
        __builtin_amdgcn_s_waitcnt(0);
        unsigned nloc = b.st[0], nx = b.st[1];
        if (nloc == 0u) { xcd_barrier_complete(bar, b.x, nloc, nx); b.st[0] = nloc; b.st[1] = nx; }
        const unsigned old = xb_add(&bar[XB_XSUB(b.x)], 1u);
        const unsigned gen = old / nloc;
        if (old + 1u == (gen + 1u) * nloc) {
            __builtin_amdgcn_fence(__ATOMIC_RELEASE, "agent");
            asm volatile("s_waitcnt vmcnt(0)" ::: "memory");
            const unsigned og = xb_add(&bar[XB_TOP], 1u);
            const unsigned tg = og / nx;
            if (og + 1u == (tg + 1u) * nx) xb_add(&bar[XB_TOPGEN], 1u);
            else XB_SPIN(xb_ld(&bar[XB_TOPGEN]) == tg, bar);
            __builtin_amdgcn_fence(__ATOMIC_ACQUIRE, "agent");
            xb_add(&bar[XB_XGEN(b.x)], 1u);
            asm volatile("s_waitcnt vmcnt(0)" ::: "memory");
        } else {
            XB_SPIN(xb_ld(&bar[XB_XGEN(b.x)]) == gen, bar);
            __builtin_amdgcn_fence(__ATOMIC_ACQUIRE, "agent");
            asm volatile("s_waitcnt vmcnt(0)" ::: "memory");
        }
    }
    __syncthreads();
}
constexpr int LDS_MISC_OFF = LDS_BYTES - 256;
constexpr int N_PHASES = 12;
struct Args { const float* in[24]; float* out; unsigned char* ws; int ph_lo, ph_hi; };
static_assert(sizeof(Args) == 24 * 8 + 8 + 8 + 8, "Args has no padding");

__global__ void __launch_bounds__(NTHREADS, 2) fwd_kernel(Args args) {
    extern __shared__ __attribute__((aligned(16))) unsigned char lds[];
    Frame F;
    F.lds = (LAS unsigned char*)lds; F.ldsg = lds;
    F.tid = threadIdx.x; F.lane = F.tid & 63; F.wave = __builtin_amdgcn_readfirstlane(F.tid >> 6);
    F.G = gridDim.x; { const int bx = blockIdx.x; F.vcu = (F.G % 8 == 0) ? (bx % 8) * (F.G / 8) + bx / 8 : bx; }
    F.inp = (const __attribute__((address_space(4))) cfp_t*)__builtin_amdgcn_kernarg_segment_ptr();
    F.out = args.out; F.ws = args.ws;
    unsigned char* ws = args.ws;
    const int lo = args.ph_lo, hi = args.ph_hi;
    volatile LAS unsigned* MISC = (volatile LAS unsigned*)(F.lds + LDS_MISC_OFF);
    if (F.tid < 64) MISC[F.tid] = 0u;
    __syncthreads();
    XcdBarrier xbar; xbar.bar = (unsigned*)(ws + WS_CTL); xbar.x = 0; xbar.st = nullptr;
    if (hi - lo > 1) xbar = xcd_barrier_post((unsigned*)(ws + WS_CTL), MISC);
#ifndef PHASE_MASK
#define PHASE_MASK 0xfff
#endif
#define IN(k) ((((PHASE_MASK) >> (k)) & 1) && lo <= (k) && (k) < hi)
#define SEAM(k) do { if (IN(k) && IN((k) + 1)) { if ((k) == 0) cg::this_grid().sync(); else xcd_barrier(xbar); } } while (0)
    float* SSQ1 = (float*)(ws + WS_CTL + CTL_SSQ1); float* SSQ2 = (float*)(ws + WS_CTL + CTL_SSQ2); float* SSQQ = (float*)(ws + WS_CTL + CTL_SSQQ);

    if (IN(0)) { p0_prologue(F); }
    SEAM(0);
    if (IN(1)) {
        { pg8::Gemm g{(const bf16*)(ws + WS_XN), (const bf16*)(ws + WS_WIN), DM, DM, DM}; pg8::StdOrder S; S.init(MTOK, NPROJ, DM, DM, F.G, (int)blockIdx.x);
          pg8::EpiStoreBf16 E{(bf16*)(ws + WS_PROJ), 1024, 1024, (size_t)MTOK * 1024};
          pg8::gemm_phase<pg8::EpiStoreBf16, pg8::StdOrder, true>(F.lds, g, S, E); }
        { pg8::Gemm g{(const bf16*)(ws + WS_MN), (const bf16*)(ws + WS_WXKV), DM, DM, 512}; pg8::XkvOrder S{F.G, (int)blockIdx.x};
          pg8::EpiSlab E{(float*)((unsigned char*)F.out + OUT_SLAB), 4096, (size_t)MROWS * 4096};
          pg8::gemm_phase<pg8::EpiSlab, pg8::XkvOrder, false>(F.lds, g, S, E); }
    }
    SEAM(1);
    if (IN(2)) { for (int item = F.vcu; item < BATCH * NCHUNK; item += F.G) p2_prep_item(F, item); }
    SEAM(2);
    if (IN(3)) { for (int item = F.vcu; item < 256; item += F.G) p3_scan_item(F, item); }
    SEAM(3);
    if (IN(4)) {
        if (!((PHASE_MASK >> 12) & 1)) { const fox::Srd R = __builtin_amdgcn_make_buffer_rsrc((void*)ws, (short)0, (int)WS_END, 0x00020000);
          for (int L = F.vcu; L < 256; L += F.G) { const int bh = L >> 3, xq = L & 7, b = bh >> 3, h = bh & 7;
              const unsigned rowb = (unsigned)b * SEQ * 2048u + (unsigned)h * (FOXD * 2);
              fox::HeadRef H{rowb,
                             (unsigned)WS_CONCAT + (unsigned)b * SEQ * 4096u + (unsigned)h * (FOXD * 2), (const float*)(ws + WS_CFOX) + (size_t)bh * SEQ, F.inp[11] + h * FOXD};
              fox::Seam S;
              fox::fox_prime(R, H, xq * 256, (char*)lds, S);
              for (int p = 0; p < 2; ++p) { const int P0 = (p == 0 ? xq : 15 - xq) * 256, P0n = (15 - xq) * 256;
                  fox::fox_block(R, H, P0, P0n, (char*)lds, S); }
              VM_WAIT(); __syncthreads(); } }
        if (!((PHASE_MASK >> 13) & 1)) { float* xch = (float*)lds;
          for (int it = F.vcu; it < BATCH * MLH * NCHUNK; it += F.G) { const int c = it & 63, h = (it >> 6) & 3, b = it >> 8;
              mls::chunk_out(b, h, c, (const bf16*)(ws + WS_QP), (const bf16*)(ws + WS_KPP), (const bf16*)(ws + WS_VT), (const bf16*)((unsigned char*)F.out + OUT_CST),
                             (const float*)(ws + WS_NST), (const bf16*)(ws + WS_MO), F.inp[12], (bf16*)(ws + WS_CONCAT), xch); } }
    }
    SEAM(4);
    if (IN(5)) {
        pg8::Gemm g{(const bf16*)(ws + WS_CONCAT), (const bf16*)(ws + WS_WOUT), DM, DM, DM}; pg8::StdOrder S; S.init(MTOK, DM, DM, DM, F.G, (int)blockIdx.x);
        pg8::EpiResid E{F.inp[0], F.out, (bf16*)(ws + WS_X1B), SSQ1, DM};
        pg8::gemm_phase<pg8::EpiResid, pg8::StdOrder, true>(F.lds, g, S, E);
    }
    SEAM(5);
    if (IN(6)) {
        pg8::Gemm g{(const bf16*)(ws + WS_X1B), (const bf16*)(ws + WS_WXQ), DM, DM, DM}; pg8::StdOrder S; S.init(MTOK, DM, DM, DM, F.G, (int)blockIdx.x);
        pg8::EpiQ E{(bf16*)(ws + WS_Q), SSQ1, SSQQ};
        pg8::gemm_phase<pg8::EpiQ, pg8::StdOrder, true>(F.lds, g, S, E);
    }
    SEAM(6);
    if (IN(7)) {
        pg8::Gemm g{(const bf16*)(ws + WS_Q), (const bf16*)(ws + WS_KHAT), DM, DM, XD}; pg8::ScoreOrder S{F.G, (int)blockIdx.x};
        pg8::EpiSoftmax E{(bf16*)(ws + WS_P), SSQQ};
        if (F.G >= 256) pg8::gemm_phase<pg8::EpiSoftmax, pg8::ScoreOrder, false>(F.lds, g, S, E);
    }
    SEAM(7);
    if (IN(8)) {
        pg8::Gemm g{(const bf16*)(ws + WS_P), (const bf16*)(ws + WS_VTM), 1024, NMEM, NMEM}; pg8::PvOrder S{F.G, (int)blockIdx.x};
        pg8::EpiStoreBf16 E{(bf16*)(ws + WS_CO), DM, 0, 0};
        pg8::gemm_phase<pg8::EpiStoreBf16, pg8::PvOrder, true>(F.lds, g, S, E);
    }
    SEAM(8);
    if (IN(9)) {
        pg8::Gemm g{(const bf16*)(ws + WS_CO), (const bf16*)(ws + WS_WXO), DM, DM, DM}; pg8::StdOrder S; S.init(MTOK, DM, DM, DM, F.G, (int)blockIdx.x);
        pg8::EpiResid E{F.out, F.out, (bf16*)(ws + WS_X2B), SSQ2, DM};
        pg8::gemm_phase<pg8::EpiResid, pg8::StdOrder, true>(F.lds, g, S, E);
    }
    SEAM(9);
    if (IN(10)) {
        pg8::Gemm g{(const bf16*)(ws + WS_X2B), (const bf16*)(ws + WS_WUP), DM, DM, DM}; pg8::StdOrder S; S.init(MTOK, DFF, DM, DM, F.G, (int)blockIdx.x);
        pg8::EpiUp E{(bf16*)(ws + WS_H), SSQ2};
        pg8::gemm_phase<pg8::EpiUp, pg8::StdOrder, true>(F.lds, g, S, E);
    }
    SEAM(10);
    if (IN(11)) {
        pg8::Gemm g{(const bf16*)(ws + WS_H), (const bf16*)(ws + WS_WDN), DFF, DFF, DFF}; pg8::StdOrder S; S.init(MTOK, DM, DFF, DFF, F.G, (int)blockIdx.x);
        pg8::EpiResid E{F.out, F.out, nullptr, nullptr, DM};
        pg8::gemm_phase<pg8::EpiResid, pg8::StdOrder, true>(F.lds, g, S, E);
    }
#undef IN
#undef SEAM
}

extern "C" void kernel_launch(void* const* d_in, const int* in_sizes, int n_in, void* d_out, int out_size, void* d_ws, size_t ws_size, hipStream_t stream) {
    static int grid = 0;
    if (grid == 0) {
        if (n_in != 24 || in_sizes[0] != MTOK * DM || out_size != MTOK * DM || ws_size < WS_END) {
            fprintf(stderr, "kernel_launch: unexpected shapes (n_in %d, in0 %d, out %d, ws %zu; need ws >= %zu); nothing launched\n", n_in, n_in > 0 ? in_sizes[0] : -1, out_size, ws_size, (size_t)WS_END); grid = -1; return; }
        int dev = 0, cus = 0, per_cu = 0;
        if (hipGetDevice(&dev) != hipSuccess || hipDeviceGetAttribute(&cus, hipDeviceAttributeMultiprocessorCount, dev) != hipSuccess) { grid = -1; return; }
        if (hipFuncSetAttribute((const void*)fwd_kernel, hipFuncAttributeMaxDynamicSharedMemorySize, LDS_BYTES) != hipSuccess) { fprintf(stderr, "kernel_launch: hipFuncSetAttribute failed\n"); grid = -1; return; }
        if (hipOccupancyMaxActiveBlocksPerMultiprocessor(&per_cu, (const void*)fwd_kernel, NTHREADS, LDS_BYTES) != hipSuccess || per_cu < 1) { fprintf(stderr, "kernel_launch: occupancy query says %d blocks per CU\n", per_cu); per_cu = 1; }
        (void)hipGetLastError();
        grid = cus;
    }
    if (grid < 0) return;
    (void)hipMemsetAsync((char*)d_ws + WS_CTL, 0, CTL_BYTES, stream);
    Args a{};
    for (int i = 0; i < 24; ++i) a.in[i] = (const float*)d_in[i];
    a.out = (float*)d_out; a.ws = (unsigned char*)d_ws;
#if MK_PER_PHASE
    for (int ph = 0; ph < N_PHASES; ++ph) { a.ph_lo = ph; a.ph_hi = ph + 1;
        hipLaunchKernelGGL(fwd_kernel, dim3(grid), dim3(NTHREADS), LDS_BYTES, stream, a); }
#else
    a.ph_lo = 0; a.ph_hi = N_PHASES;
    void* kargs[] = {&a};
    hipError_t e = hipLaunchCooperativeKernel((const void*)fwd_kernel, dim3(grid), dim3(NTHREADS), kargs, LDS_BYTES, stream);
    if (e != hipSuccess) fprintf(stderr, "kernel_launch: cooperative launch failed: %s (grid %d)\n", hipGetErrorString(e), grid);
#endif
}
```

```cpp
#include <hip/hip_runtime.h>
#include <hip/hip_cooperative_groups.h>
#include <cstdio>
#include <cstdint>
namespace cg = cooperative_groups;

constexpr int BATCH = 4, SEQ = 4096, DM = 2048, MTOK = BATCH * SEQ;
constexpr int NMEM = 256, MROWS = BATCH * NMEM;
constexpr int FOXH = 8, FOXD = 128, MLH = 4, MLDV = 256, MLDK = 128, XH = 4, XD = 512, DFF = 8192;
constexpr int IN_WIDTH = 6160, NPROJ = 6144, NCHUNK = SEQ / 64;
constexpr float EPS = 1e-6f;
constexpr float LOG2E = 1.4426950408889634f;

constexpr size_t MiB = (size_t)1 << 20;
constexpr size_t WS_WIN = 0, WS_WOUT = 24 * MiB, WS_WXQ = 32 * MiB, WS_WXKV = 40 * MiB, WS_WXO = 56 * MiB, WS_WUP = 64 * MiB, WS_WDN = 96 * MiB;
constexpr size_t WS_PROJ = 128 * MiB;
constexpr size_t WS_FQ = 128 * MiB, WS_FK = 160 * MiB, WS_FV = 192 * MiB, WS_MQK = 224 * MiB, WS_MV = 256 * MiB, WS_MO = 288 * MiB;
constexpr size_t WS_XN = 320 * MiB;
constexpr size_t WS_QP = 384 * MiB, WS_KPP = 400 * MiB;
constexpr size_t WS_KT = 416 * MiB;
constexpr size_t WS_VT = 432 * MiB;
constexpr size_t WS_MISC = 464 * MiB;
constexpr size_t WS_CTL = WS_MISC, CTL_BYTES = 1 * MiB;
constexpr size_t CTL_SSQ1 = 64 * 1024, CTL_SSQ2 = 128 * 1024, CTL_SSQQ = 192 * 1024;
constexpr size_t WS_GATES = WS_MISC + 1 * MiB;
constexpr size_t WS_RINV = WS_MISC + 2 * MiB;
constexpr size_t WS_CFOX = WS_MISC + 3 * MiB;
constexpr size_t WS_EB = WS_MISC + 4 * MiB;
constexpr size_t WS_KSUM = WS_MISC + 5 * MiB;
constexpr size_t WS_NST = WS_MISC + 6 * MiB;
constexpr size_t WS_MN = WS_MISC + 8 * MiB;
constexpr size_t WS_KHAT = WS_MISC + 12 * MiB;
constexpr size_t WS_VTM = WS_MISC + 16 * MiB;
constexpr size_t WS_END = 512 * MiB;
constexpr size_t WS_CONCAT = 224 * MiB;
constexpr size_t WS_X1B = 128 * MiB;
constexpr size_t WS_Q = 192 * MiB;
constexpr size_t WS_CO = 256 * MiB;
constexpr size_t WS_P = 320 * MiB;
constexpr size_t WS_X2B = 128 * MiB;
constexpr size_t WS_H = 192 * MiB;
constexpr size_t OUT_SLAB = 0, OUT_CST = 64 * MiB;

constexpr int LDS_BYTES = 147456;
constexpr int NTHREADS = 512;

#define GAS __attribute__((address_space(1)))
#define LAS __attribute__((address_space(3)))
typedef unsigned short bf16;
typedef unsigned v4u __attribute__((ext_vector_type(4)));
typedef unsigned v2u __attribute__((ext_vector_type(2)));
typedef float v4f __attribute__((ext_vector_type(4)));
typedef short v8s __attribute__((ext_vector_type(8)));
typedef short v4s __attribute__((ext_vector_type(4)));
#define LDS_WAIT() asm volatile("s_waitcnt lgkmcnt(0)" ::: "memory")
#define VM_WAIT() asm volatile("s_waitcnt vmcnt(0)" ::: "memory")
__device__ __forceinline__ unsigned f2bf(float f) { unsigned u = __builtin_bit_cast(unsigned, f); return (u + 0x7fffu + ((u >> 16) & 1u)) >> 16; }
__device__ __forceinline__ unsigned pk2(float lo, float hi) { return f2bf(lo) | (f2bf(hi) << 16); }
__device__ __forceinline__ float bf2f(unsigned h) { return __builtin_bit_cast(float, h << 16); }
__device__ __forceinline__ float bflo(unsigned w) { return __builtin_bit_cast(float, w << 16); }
__device__ __forceinline__ float bfhi(unsigned w) { return __builtin_bit_cast(float, w & 0xffff0000u); }
__device__ __forceinline__ float wave_sum(float v) {
#pragma unroll
    for (int o = 1; o < 64; o <<= 1) v += __shfl_xor(v, o);
    return v;
}
__device__ __forceinline__ float logsigmoidf(float x) { return x >= 0.f ? -log1pf(__expf(-x)) : x - log1pf(__expf(x)); }
__device__ __forceinline__ float sigmoidf_(float x) { return 1.f / (1.f + __expf(-x)); }
#define MK_PER_PHASE 0
namespace pg8 {
#define PG8_LAS __attribute__((address_space(3)))
typedef unsigned short bf16_t;
typedef short bf16x8 __attribute__((ext_vector_type(8)));
typedef float f32x4 __attribute__((ext_vector_type(4)));
typedef float f32x2 __attribute__((ext_vector_type(2)));
typedef unsigned u32x4 __attribute__((ext_vector_type(4)));
typedef unsigned u32x2 __attribute__((ext_vector_type(2)));
constexpr int BM = 256, BK = 64, HALF = 128, HTB = HALF * BK * 2, STAGE_BYTES = 8 * HTB, NXCD = 8, WGM = 8;

__host__ __device__ __forceinline__ int lds_byte(int r, int c) { const int st = (r >> 4) * 2 + (c >> 5), rr = r & 15, cc = c & 31, ob = rr * 64 + cc * 2; return st * 1024 + (ob ^ (((ob >> 9) & 1) << 5)); }
__host__ __device__ __forceinline__ void stage_rc(int b, int& R, int& C) { const int st = b / 1024, sb = b % 1024, swz = sb ^ (((sb >> 9) & 1) << 5); R = (st >> 1) * 16 + swz / 64; C = (st & 1) * 32 + (swz % 64) / 2; }
__host__ __device__ __forceinline__ int perm32(int rho) { const int n = rho >> 4, i = rho & 15; return 8 * (i >> 2) + 4 * n + (i & 3); }

struct Unit { int row0, col0; long aoff, boff; int aux; };
struct Gemm { const bf16_t* A; const bf16_t* Bt; int lda, ldb, K; };

struct StdOrder {
    int nM, nN, nwg, G, c, lda, ldb;
    __device__ void init(int M, int N, int lda_, int ldb_, int G_, int c_) { nM = M / BM; nN = N / BM; nwg = nM * nN; G = G_; c = c_; lda = lda_; ldb = ldb_; }
    __device__ bool next(int i, Unit& u) const {
        const long L = (long)i * G + c; if (L >= nwg) return false;
        int wgid = (int)L; { const int q = nwg / NXCD, r = nwg % NXCD, xcd = wgid % NXCD, off = wgid / NXCD; wgid = (xcd < r ? xcd * (q + 1) : r * (q + 1) + (xcd - r) * q) + off; }
        const int nig = WGM * nN, gid = wgid / nig, fm = gid * WGM, gsz = (nM - fm) < WGM ? (nM - fm) : WGM;
        const int pm = fm + ((wgid % nig) % gsz), pn = (wgid % nig) / gsz;
        u.row0 = pm * BM; u.col0 = pn * BM; u.aoff = (long)pm * BM * lda; u.boff = (long)pn * BM * ldb; u.aux = 0; return true;
    }
};

__device__ __forceinline__ unsigned cvt_pk_bf16(float lo, float hi) { unsigned r; asm volatile("v_cvt_pk_bf16_f32 %0, %1, %2" : "=v"(r) : "v"(lo), "v"(hi)); return r; }

template <class Epi, class Sched, bool ALIGN_EPI>
__device__ __forceinline__ void gemm_phase(PG8_LAS unsigned char* lds, const Gemm g, const Sched& S, const Epi& E) {
    const int tid = threadIdx.x, wid = __builtin_amdgcn_readfirstlane(tid >> 6), lane = tid & 63, wr = wid >> 2, wc = wid & 3, fr = lane & 15, fq = lane >> 4;
    const int K = g.K, nt = K / BK;
    unsigned voffA[2], voffB[2];
#pragma unroll
    for (int i = 0; i < 2; ++i) { int R, C; stage_rc(tid * 16 + i * 8192, R, C); const int Rb = Epi::PERM ? ((R & ~31) + perm32(R & 31)) : R;
        voffA[i] = (unsigned)(R * g.lda + C) * 2u; voffB[i] = (unsigned)(Rb * g.ldb + C) * 2u; }
    const size_t kstep = (size_t)(BK * 2);
    const size_t hA = (size_t)HALF * g.lda * 2, hB = (size_t)HALF * g.ldb * 2;
    const unsigned ldsw = (unsigned)wid * 1024u;
    const int aoff = lds_byte(wr * 64 + fr, fq * 8), boff = lds_byte(wc * 32 + fr, fq * 8);
#define PG8_SA(b, h) (((b) * 2 + (h)) * HTB)
#define PG8_SB(b, h) ((4 + (b) * 2 + (h)) * HTB)
#define PG8_STAGE(bufoff, gbase, voff) do { _Pragma("unroll") for (int _i = 0; _i < 2; ++_i) \
        __builtin_amdgcn_global_load_lds((const unsigned*)((const char*)(gbase) + (voff)[_i]), (PG8_LAS unsigned*)(lds + (bufoff) + ldsw + _i * 8192), 16, 0, 0); } while (0)
#define PG8_LDA(dst, b, h) do { _Pragma("unroll") for (int m = 0; m < 4; ++m) _Pragma("unroll") for (int k = 0; k < 2; ++k) dst[m][k] = *(const PG8_LAS bf16x8*)(lds + PG8_SA(b, h) + aoff + m * 2048 + k * 1024); } while (0)
#define PG8_LDB(dst, b, h) do { _Pragma("unroll") for (int n = 0; n < 2; ++n) _Pragma("unroll") for (int k = 0; k < 2; ++k) dst[n][k] = *(const PG8_LAS bf16x8*)(lds + PG8_SB(b, h) + boff + n * 2048 + k * 1024); } while (0)
#define PG8_MMA(ai, bj, At, Bt) do { __builtin_amdgcn_s_setprio(1); _Pragma("unroll") for (int m = 0; m < 4; ++m) _Pragma("unroll") for (int n = 0; n < 2; ++n) _Pragma("unroll") for (int k = 0; k < 2; ++k) \
        acc[ai][bj][m][n] = __builtin_amdgcn_mfma_f32_16x16x32_bf16(Bt[n][k], At[m][k], acc[ai][bj][m][n], 0, 0, 0); __builtin_amdgcn_s_setprio(0); } while (0)
#define PG8_WAIT_V(n) asm volatile("s_waitcnt vmcnt(" #n ")" ::: "memory")
#define PG8_WAIT_L(n) asm volatile("s_waitcnt lgkmcnt(" #n ")" ::: "memory")
#define PG8_BAR __builtin_amdgcn_s_barrier()
#define PG8_SCHED __builtin_amdgcn_sched_barrier(0)
    Unit cur, nxt; int ui = 0;
    if (!S.next(0, cur)) return;
    f32x4 acc[2][2][4][2];
#pragma unroll
    for (int a = 0; a < 2; ++a)
#pragma unroll
        for (int b = 0; b < 2; ++b)
#pragma unroll
            for (int m = 0; m < 4; ++m)
#pragma unroll
                for (int n = 0; n < 2; ++n) acc[a][b][m][n] = (f32x4){0.f, 0.f, 0.f, 0.f};
    bf16x8 At[4][2], B0[2][2], B1[2][2];
    const char* cA = (const char*)g.A + (size_t)cur.aoff * 2; const char* cB = (const char*)g.Bt + (size_t)cur.boff * 2;
    PG8_STAGE(PG8_SB(0, 0), cB, voffB); PG8_STAGE(PG8_SB(0, 1), cB + hB, voffB); PG8_STAGE(PG8_SA(0, 0), cA, voffA); PG8_STAGE(PG8_SA(0, 1), cA + hA, voffA);
    if (wr == 1) PG8_BAR;
    PG8_WAIT_V(2); PG8_BAR;
    PG8_STAGE(PG8_SB(1, 0), cB + kstep, voffB); PG8_STAGE(PG8_SA(1, 0), cA + kstep, voffA); PG8_STAGE(PG8_SB(1, 1), cB + hB + kstep, voffB);
    PG8_WAIT_V(6); PG8_BAR;
    for (;;) {
        const bool has_next = S.next(ui + 1, nxt);
        const char* nA = has_next ? (const char*)g.A + (size_t)nxt.aoff * 2 : cA; const char* nB = has_next ? (const char*)g.Bt + (size_t)nxt.boff * 2 : cB;
        for (int t = 0; t < nt; t += 2) {
            const bool last = (t == nt - 2);
            const char* a1 = cA + (size_t)(t + 1) * kstep;
            const char* a2 = last ? nA : cA + (size_t)(t + 2) * kstep; const char* b2 = last ? nB : cB + (size_t)(t + 2) * kstep;
            const char* a3 = a2 + kstep; const char* b3 = b2 + kstep;
            PG8_LDB(B0, 0, 0); PG8_LDB(B1, 0, 1); PG8_SCHED; PG8_LDA(At, 0, 0); PG8_STAGE(PG8_SA(1, 1), a1 + hA, voffA);
            PG8_WAIT_V(8); PG8_WAIT_L(0); PG8_BAR; PG8_MMA(0, 0, At, B0); PG8_MMA(0, 1, At, B1); PG8_BAR; PG8_SCHED;
            PG8_LDA(At, 0, 1); PG8_STAGE(PG8_SB(0, 0), b2, voffB); PG8_STAGE(PG8_SB(0, 1), b2 + hB, voffB); PG8_STAGE(PG8_SA(0, 0), a2, voffA);
            PG8_WAIT_V(8); PG8_WAIT_L(0); PG8_BAR; PG8_MMA(1, 0, At, B0); PG8_MMA(1, 1, At, B1); PG8_BAR; PG8_SCHED;
            PG8_LDB(B0, 1, 0); PG8_LDB(B1, 1, 1); PG8_SCHED; PG8_LDA(At, 1, 0); PG8_STAGE(PG8_SA(0, 1), a2 + hA, voffA);
            PG8_WAIT_V(8); PG8_WAIT_L(0); PG8_BAR; PG8_MMA(0, 0, At, B0); PG8_MMA(0, 1, At, B1); PG8_BAR; PG8_SCHED;
            PG8_LDA(At, 1, 1); PG8_STAGE(PG8_SB(1, 0), b3, voffB); PG8_STAGE(PG8_SB(1, 1), b3 + hB, voffB); PG8_STAGE(PG8_SA(1, 0), a3, voffA);
            PG8_WAIT_V(8); PG8_WAIT_L(0); PG8_BAR; PG8_MMA(1, 0, At, B0); PG8_MMA(1, 1, At, B1); PG8_BAR; PG8_SCHED;
        }
        if constexpr (ALIGN_EPI) { if (wr == 0) PG8_BAR; }
        if constexpr (!Epi::AFTER_DRAIN) { E(acc, cur, wr, wc, fr, fq); }
        if (!has_next) break;
#pragma unroll
        for (int a = 0; a < 2; ++a)
#pragma unroll
            for (int b = 0; b < 2; ++b)
#pragma unroll
                for (int m = 0; m < 4; ++m)
#pragma unroll
                    for (int n = 0; n < 2; ++n) acc[a][b][m][n] = (f32x4){0.f, 0.f, 0.f, 0.f};
        cur = nxt; cA = nA; cB = nB; ++ui;
        if constexpr (ALIGN_EPI) { if (wr == 1) PG8_BAR; }
    }
    PG8_WAIT_V(0);
    if constexpr (!ALIGN_EPI) { if (wr == 0) PG8_BAR; }
    PG8_BAR;
    if constexpr (Epi::AFTER_DRAIN) { E.fused(acc, cur, wr, wc, fr, fq, lds, wid, lane); }
#undef PG8_SA
#undef PG8_SB
#undef PG8_STAGE
#undef PG8_LDA
#undef PG8_LDB
#undef PG8_MMA
#undef PG8_WAIT_V
#undef PG8_WAIT_L
#undef PG8_BAR
#undef PG8_SCHED
}
}
namespace pg8 {
struct XkvOrder {
    int G, c;
    __device__ bool next(int i, Unit& u) const {
        const int L = i * G + c; if (L >= 256) return false;
        const int kq = L & 3, tile = L >> 2, pm = tile & 3, pn = tile >> 2;
        u.row0 = pm * 256; u.col0 = pn * 256; u.aoff = (long)pm * 256 * DM + kq * 512; u.boff = (long)pn * 256 * DM + kq * 512; u.aux = kq; return true;
    }
};
struct ScoreOrder {
    int G, c;
    __device__ bool next(int i, Unit& u) const {
        const int L = i * G + c; if (L >= 256) return false;
        const int b = L >> 6, h = (L >> 4) & 3, mt = L & 15;
        u.row0 = b * SEQ + mt * 256; u.col0 = h * 256; u.aoff = (long)u.row0 * DM + h * XD; u.boff = (long)(b * NMEM) * DM + h * XD; u.aux = h; return true;
    }
};
struct PvOrder {
    int G, c;
    __device__ bool next(int i, Unit& u) const {
        const int L = i * G + c; if (L >= 512) return false;
        const int nt = L & 1, mt = (L >> 1) & 15, h = (L >> 5) & 3, b = L >> 7;
        u.row0 = b * SEQ + mt * 256; u.col0 = h * XD + nt * 256; u.aoff = (long)u.row0 * 1024 + h * 256; u.boff = ((long)(b * XH + h) * XD + nt * 256) * NMEM; u.aux = 0; return true;
    }
};

struct EpiStoreBf16 {
    static constexpr bool PERM = true, AFTER_DRAIN = false;
    bf16_t* O; int ldc; int split_cols; size_t split_stride;
    __device__ __forceinline__ void operator()(const f32x4 (&acc)[2][2][4][2], const Unit& u, int wr, int wc, int fr, int fq) const {
        int colt = u.col0; bf16_t* base = O;
        if (split_cols) { const int t = colt / split_cols; base += (size_t)t * split_stride; colt -= t * split_cols; }
        const int row0 = u.row0 + wr * 64 + fr, col0 = colt + wc * 32 + 8 * fq;
#pragma unroll
        for (int ai = 0; ai < 2; ++ai)
#pragma unroll
            for (int m = 0; m < 4; ++m) { bf16_t* rowp = base + (size_t)(row0 + ai * HALF + m * 16) * ldc + col0;
#pragma unroll
                for (int bj = 0; bj < 2; ++bj) { const f32x4 v0 = acc[ai][bj][m][0], v1 = acc[ai][bj][m][1];
                    u32x4 w; w.x = cvt_pk_bf16(v0[0], v0[1]); w.y = cvt_pk_bf16(v0[2], v0[3]); w.z = cvt_pk_bf16(v1[0], v1[1]); w.w = cvt_pk_bf16(v1[2], v1[3]);
                    *(u32x4*)(rowp + bj * HALF) = w; } }
    }
};
struct EpiSlab {
    static constexpr bool PERM = false, AFTER_DRAIN = false;
    float* slab; int ldc; size_t slab_stride;
    __device__ __forceinline__ void operator()(const f32x4 (&acc)[2][2][4][2], const Unit& u, int wr, int wc, int fr, int fq) const {
        float* base = slab + (size_t)u.aux * slab_stride; const int col0 = u.col0 + wc * 32 + 4 * fq;
#pragma unroll
        for (int ai = 0; ai < 2; ++ai)
#pragma unroll
            for (int m = 0; m < 4; ++m) { float* rowp = base + (size_t)(u.row0 + ai * HALF + wr * 64 + m * 16 + fr) * ldc + col0;
#pragma unroll
                for (int bj = 0; bj < 2; ++bj)
#pragma unroll
                    for (int n = 0; n < 2; ++n) *(f32x4*)(rowp + bj * HALF + n * 16) = acc[ai][bj][m][n]; }
    }
};
struct EpiResid {
    static constexpr bool PERM = false, AFTER_DRAIN = false;
    const float* base; float* out; bf16_t* outb; float* ssq; int ldc;
    __device__ __forceinline__ void operator()(const f32x4 (&acc)[2][2][4][2], const Unit& u, int wr, int wc, int fr, int fq) const {
        const int col0 = u.col0 + wc * 32 + 4 * fq;
        float ssum[2][4];
#pragma unroll
        for (int ai = 0; ai < 2; ++ai)
#pragma unroll
            for (int m = 0; m < 4; ++m) { const size_t off = (size_t)(u.row0 + ai * HALF + wr * 64 + m * 16 + fr) * ldc + col0; float s = 0.f;
#pragma unroll
                for (int bj = 0; bj < 2; ++bj)
#pragma unroll
                    for (int n = 0; n < 2; ++n) { const f32x4 bs = *(const f32x4*)(base + off + bj * HALF + n * 16); const f32x4 v = bs + acc[ai][bj][m][n];
                        *(f32x4*)(out + off + bj * HALF + n * 16) = v;
                        if (outb) { u32x2 w; w.x = cvt_pk_bf16(v[0], v[1]); w.y = cvt_pk_bf16(v[2], v[3]); *(u32x2*)(outb + off + bj * HALF + n * 16) = w; }
                        s += (v[0] * v[0] + v[1] * v[1]) + (v[2] * v[2] + v[3] * v[3]); }
                s += __shfl_xor(s, 16); s += __shfl_xor(s, 32); ssum[ai][m] = s; }
        if (ssq) {
#pragma unroll
            for (int ai = 0; ai < 2; ++ai) { const float v = fq == 0 ? ssum[ai][0] : fq == 1 ? ssum[ai][1] : fq == 2 ? ssum[ai][2] : ssum[ai][3];
                atomicAdd(ssq + u.row0 + ai * HALF + wr * 64 + fq * 16 + fr, v); }
        }
    }
};
struct EpiQ {
    static constexpr bool PERM = true, AFTER_DRAIN = false;
    bf16_t* O; const float* ssq_in; float* ssq_out;
    __device__ __forceinline__ void operator()(const f32x4 (&acc)[2][2][4][2], const Unit& u, int wr, int wc, int fr, int fq) const {
        const int col0 = u.col0 + wc * 32 + 8 * fq; float* so = ssq_out + (size_t)(u.col0 / XD) * MTOK;
        float ssum[2][4];
#pragma unroll
        for (int ai = 0; ai < 2; ++ai)
#pragma unroll
            for (int m = 0; m < 4; ++m) { const int row = u.row0 + ai * HALF + wr * 64 + m * 16 + fr; const float ri = __builtin_amdgcn_rsqf(ssq_in[row] * (1.0f / DM) + EPS);
                bf16_t* rowp = O + (size_t)row * DM + col0; float s = 0.f;
#pragma unroll
                for (int bj = 0; bj < 2; ++bj) { const f32x4 v0 = acc[ai][bj][m][0] * ri, v1 = acc[ai][bj][m][1] * ri;
                    u32x4 w; w.x = cvt_pk_bf16(v0[0], v0[1]); w.y = cvt_pk_bf16(v0[2], v0[3]); w.z = cvt_pk_bf16(v1[0], v1[1]); w.w = cvt_pk_bf16(v1[2], v1[3]);
                    *(u32x4*)(rowp + bj * HALF) = w;
                    s += (v0[0] * v0[0] + v0[1] * v0[1]) + (v0[2] * v0[2] + v0[3] * v0[3]) + (v1[0] * v1[0] + v1[1] * v1[1]) + (v1[2] * v1[2] + v1[3] * v1[3]); }
                s += __shfl_xor(s, 16); s += __shfl_xor(s, 32); ssum[ai][m] = s; }
#pragma unroll
        for (int ai = 0; ai < 2; ++ai) { const float v = fq == 0 ? ssum[ai][0] : fq == 1 ? ssum[ai][1] : fq == 2 ? ssum[ai][2] : ssum[ai][3];
            atomicAdd(so + u.row0 + ai * HALF + wr * 64 + fq * 16 + fr, v); }
    }
};
struct EpiUp {
    static constexpr bool PERM = true, AFTER_DRAIN = false;
    bf16_t* O; const float* ssq_in;
    __device__ __forceinline__ void operator()(const f32x4 (&acc)[2][2][4][2], const Unit& u, int wr, int wc, int fr, int fq) const {
        const int col0 = u.col0 + wc * 32 + 8 * fq;
#pragma unroll
        for (int ai = 0; ai < 2; ++ai)
#pragma unroll
            for (int m = 0; m < 4; ++m) { const int row = u.row0 + ai * HALF + wr * 64 + m * 16 + fr; const float ri = __builtin_amdgcn_rsqf(ssq_in[row] * (1.0f / DM) + EPS);
                bf16_t* rowp = O + (size_t)row * DFF + col0;
#pragma unroll
                for (int bj = 0; bj < 2; ++bj) { f32x4 v0 = acc[ai][bj][m][0] * ri, v1 = acc[ai][bj][m][1] * ri;
#pragma unroll
                    for (int e = 0; e < 4; ++e) { const float a = fmaxf(v0[e], 0.f), b = fmaxf(v1[e], 0.f); v0[e] = a * a; v1[e] = b * b; }
                    u32x4 w; w.x = cvt_pk_bf16(v0[0], v0[1]); w.y = cvt_pk_bf16(v0[2], v0[3]); w.z = cvt_pk_bf16(v1[0], v1[1]); w.w = cvt_pk_bf16(v1[2], v1[3]);
                    *(u32x4*)(rowp + bj * HALF) = w; } }
    }
};
struct EpiSoftmax {
    static constexpr bool PERM = true, AFTER_DRAIN = true;
    bf16_t* P; const float* ssqq;
    __device__ __forceinline__ void fused(f32x4 (&acc)[2][2][4][2], const Unit& u, int wr, int wc, int fr, int fq, PG8_LAS unsigned char* lds, int wid, int lane) const {
        PG8_LAS float* RM = (PG8_LAS float*)lds;
        PG8_LAS float* RS = (PG8_LAS float*)(lds + 4096);
        const float* sq = ssqq + (size_t)u.aux * MTOK;
        float mx[2][4];
#pragma unroll
        for (int ai = 0; ai < 2; ++ai)
#pragma unroll
            for (int m = 0; m < 4; ++m) { const int rl = ai * HALF + wr * 64 + m * 16 + fr; const int row = u.row0 + rl;
                const float sc = __builtin_amdgcn_rsqf(sq[row] * (1.0f / XD) + EPS) * (0.044194173824159216f * LOG2E);
                float mxx = -3.0e38f;
#pragma unroll
                for (int bj = 0; bj < 2; ++bj)
#pragma unroll
                    for (int n = 0; n < 2; ++n) { f32x4 v = acc[ai][bj][m][n] * sc; acc[ai][bj][m][n] = v; mxx = fmaxf(mxx, fmaxf(fmaxf(v[0], v[1]), fmaxf(v[2], v[3]))); }
                mxx = fmaxf(mxx, __shfl_xor(mxx, 16)); mxx = fmaxf(mxx, __shfl_xor(mxx, 32));
                if (fq == 0) RM[rl * 4 + wc] = mxx; }
        asm volatile("s_waitcnt lgkmcnt(0)" ::: "memory"); __builtin_amdgcn_s_barrier(); asm volatile("" ::: "memory");
#pragma unroll
        for (int ai = 0; ai < 2; ++ai)
#pragma unroll
            for (int m = 0; m < 4; ++m) { const int rl = ai * HALF + wr * 64 + m * 16 + fr;
                const f32x4 r4 = *(const PG8_LAS f32x4*)(RM + rl * 4); const float mxx = fmaxf(fmaxf(r4[0], r4[1]), fmaxf(r4[2], r4[3])); mx[ai][m] = mxx; float s = 0.f;
#pragma unroll
                for (int bj = 0; bj < 2; ++bj)
#pragma unroll
                    for (int n = 0; n < 2; ++n) { f32x4 v = acc[ai][bj][m][n];
#pragma unroll
                        for (int e = 0; e < 4; ++e) { v[e] = __builtin_amdgcn_exp2f(v[e] - mxx); s += v[e]; }
                        acc[ai][bj][m][n] = v; }
                s += __shfl_xor(s, 16); s += __shfl_xor(s, 32);
                if (fq == 0) RS[rl * 4 + wc] = s; }
        asm volatile("s_waitcnt lgkmcnt(0)" ::: "memory"); __builtin_amdgcn_s_barrier(); asm volatile("" ::: "memory");
        const int col0 = u.col0 + wc * 32 + 8 * fq;
#pragma unroll
        for (int ai = 0; ai < 2; ++ai)
#pragma unroll
            for (int m = 0; m < 4; ++m) { const int rl = ai * HALF + wr * 64 + m * 16 + fr;
                const f32x4 r4 = *(const PG8_LAS f32x4*)(RS + rl * 4); const float inv = 1.0f / ((r4[0] + r4[1]) + (r4[2] + r4[3]));
                bf16_t* rowp = P + (size_t)(u.row0 + rl) * 1024 + col0;
#pragma unroll
                for (int bj = 0; bj < 2; ++bj) { const f32x4 v0 = acc[ai][bj][m][0] * inv, v1 = acc[ai][bj][m][1] * inv;
                    u32x4 w; w.x = cvt_pk_bf16(v0[0], v0[1]); w.y = cvt_pk_bf16(v0[2], v0[3]); w.z = cvt_pk_bf16(v1[0], v1[1]); w.w = cvt_pk_bf16(v1[2], v1[3]);
                    *(u32x4*)(rowp + bj * HALF) = w; } }
        (void)mx; (void)wid; (void)lane;
    }
};
}
namespace fox {
typedef short bf16x8 __attribute__((ext_vector_type(8)));
typedef short s16x4 __attribute__((ext_vector_type(4)));
typedef float f32x16 __attribute__((ext_vector_type(16)));
typedef float f32x4 __attribute__((ext_vector_type(4)));
typedef unsigned u32x4 __attribute__((ext_vector_type(4)));
constexpr int D = 128, PITCH = 1024, OPITCH = 2048;
constexpr int NW = 8, QBLK = 32, KVBLK = 64, QB = NW * QBLK;
constexpr int SHM_V = KVBLK * D * 2, SHM_K = KVBLK * D * 2;
constexpr int LDS_BIAS = 0, LDS_WS = 512, LDS_V = 4096, LDS_K = LDS_V + 2 * SHM_V, LDS_Q = LDS_K + 2 * SHM_K, LDS_BYTES = LDS_Q + NW * 8192;
constexpr float SCALE = 0.08838834764831845f, C2 = LOG2E * SCALE, THR = 8.f;

#define KSWZ(row, colB) ((row) * 256 + ((colB) ^ (((row) & 7) << 4)))
#define SBAR() __builtin_amdgcn_sched_barrier(0)
__device__ __forceinline__ int v_st(int k, int c) { const int kk = (k & ~0xC) | ((k & 4) << 1) | ((k & 8) >> 1); return ((kk >> 3) * 4 + (c >> 5)) * 512 + ((kk & 7) * 32 + (c & 31)) * 2; }
__device__ __forceinline__ int v_rd_base(int lane) { return ((lane & 3) << 3) | (((lane >> 2) & 3) << 6) | (((lane >> 4) & 1) << 5) | (((lane >> 5) & 1) << 8); }
constexpr int v_rd_off(int d0, int ks, int half) { return d0 * 512 + ks * 4096 + half * 2048; }
__device__ __forceinline__ int crow(int r, int hi) { return (r & 3) + 8 * (r >> 2) + 4 * hi; }
__device__ __forceinline__ unsigned cvtpk(float lo, float hi) { unsigned r; asm volatile("v_cvt_pk_bf16_f32 %0, %1, %2" : "=v"(r) : "v"(lo), "v"(hi)); return r; }
__device__ __forceinline__ bf16x8 load8(const bf16* p) { return *reinterpret_cast<const bf16x8*>(p); }

__device__ __forceinline__ void mask_tile(f32x16& p0, f32x16& p1, int dq) {
    const float NEG = -__builtin_inff();
#pragma unroll
    for (int r = 0; r < 16; ++r) { const int c = (r & 3) + 8 * (r >> 2);
        if (dq - c < 0) p0[r] = NEG;
        if (dq - c - 32 < 0) p1[r] = NEG; }
}
__device__ __forceinline__ void partialSM(f32x16& p0, f32x16& p1, float& m_reg, float& mn, float& alpha) {
    float pmax = p0[0];
#pragma unroll
    for (int r = 1; r < 16; ++r) pmax = fmaxf(pmax, p0[r]);
#pragma unroll
    for (int r = 0; r < 16; ++r) pmax = fmaxf(pmax, p1[r]);
    { auto rr = __builtin_amdgcn_permlane32_swap(__float_as_uint(pmax), __float_as_uint(pmax), false, false);
      pmax = fmaxf(__uint_as_float(rr[0]), __uint_as_float(rr[1])); }
    if (__builtin_expect(__all((pmax - m_reg) * SCALE <= THR), 1)) { mn = m_reg; alpha = 1.f; }
    else { mn = fmaxf(m_reg, pmax); alpha = __builtin_amdgcn_exp2f((m_reg - mn) * C2); m_reg = mn; }
    const float mnL = -mn * C2;
#pragma unroll
    for (int r = 0; r < 16; ++r) p0[r] = fmaf(p0[r], C2, mnL);
#pragma unroll
    for (int r = 0; r < 16; ++r) p1[r] = fmaf(p1[r], C2, mnL);
#pragma unroll
    for (int r = 0; r < 16; ++r) p0[r] = __builtin_amdgcn_exp2f(p0[r]);
}
__device__ __forceinline__ void finishSM(f32x16& p0, f32x16& p1, float alpha, float& l_reg, bf16x8& pa0, bf16x8& pa1, bf16x8& pa2, bf16x8& pa3) {
#pragma unroll
    for (int r = 0; r < 16; ++r) p1[r] = __builtin_amdgcn_exp2f(p1[r]);
    float ps = 0;
#pragma unroll
    for (int r = 0; r < 16; ++r) ps += p0[r];
#pragma unroll
    for (int r = 0; r < 16; ++r) ps += p1[r];
    { auto rr = __builtin_amdgcn_permlane32_swap(__float_as_uint(ps), __float_as_uint(ps), false, false);
      ps = __uint_as_float(rr[0]) + __uint_as_float(rr[1]); }
    l_reg = l_reg * alpha + ps;
#define PK4(P, B_, OUT) do { unsigned a0 = cvtpk(P[B_+0], P[B_+1]), a1 = cvtpk(P[B_+2], P[B_+3]);                          \
        unsigned b0 = cvtpk(P[B_+4], P[B_+5]), b1 = cvtpk(P[B_+6], P[B_+7]);                                             \
        auto r0 = __builtin_amdgcn_permlane32_swap(a0, b0, false, false); auto r1 = __builtin_amdgcn_permlane32_swap(a1, b1, false, false); \
        u32x4 w = {r0[0], r1[0], r0[1], r1[1]}; OUT = *reinterpret_cast<bf16x8*>(&w); } while (0)
    PK4(p0, 0, pa0); PK4(p0, 8, pa1); PK4(p1, 0, pa2); PK4(p1, 8, pa3);
#undef PK4
}
template <int KB>
__device__ __forceinline__ void qkt(f32x16& p0, f32x16& p1, const char* K_lds, const float* bl, int r32, int hi, const char* qw) {
#pragma unroll
    for (int g = 0; g < 4; ++g) { const f32x4 b0 = *(const f32x4*)(bl + KB * 64 + 8 * g + 4 * hi), b1 = *(const f32x4*)(bl + KB * 64 + 32 + 8 * g + 4 * hi);
#pragma unroll
        for (int i = 0; i < 4; ++i) { p0[4 * g + i] = b0[i]; p1[4 * g + i] = b1[i]; } }
    const char* kb[4];
#pragma unroll
    for (int dd = 0; dd < 4; ++dd) kb[dd] = K_lds + KB * SHM_K + KSWZ(r32, (dd * 16 + hi * 8) * 2);
#pragma unroll
    for (int d0 = 0; d0 < 8; ++d0) { const char* a = kb[d0 & 3] + (d0 >> 2) * 128;
        bf16x8 b0 = *reinterpret_cast<const bf16x8*>(a);
        bf16x8 b1 = *reinterpret_cast<const bf16x8*>(a + 32 * 256);
        const bf16x8 qf = *reinterpret_cast<const bf16x8*>(qw + d0 * 1024);
        p0 = __builtin_amdgcn_mfma_f32_32x32x16_bf16(b0, qf, p0, 0, 0, 0);
        p1 = __builtin_amdgcn_mfma_f32_32x32x16_bf16(b1, qf, p1, 0, 0, 0); }
}
template <int VB>
__device__ __forceinline__ void pv_tile(f32x16* o, int vb0, bf16x8 pa0, bf16x8 pa1, bf16x8 pa2, bf16x8 pa3) {
#define TRRD(dst, off) asm volatile("ds_read_b64_tr_b16 %0, %1 offset:%2" : "=&v"(dst) : "v"(vb0), "i"(off) : "memory")
#define PV_D0(d0) do { s16x4 l0, l1, l2, l3, h0, h1, h2, h3; constexpr int b_ = VB * SHM_V + v_rd_off(d0, 0, 0); \
        TRRD(l0, b_); TRRD(h0, b_ + 2048); TRRD(l1, b_ + 4096); TRRD(h1, b_ + 6144); TRRD(l2, b_ + 8192); TRRD(h2, b_ + 10240); TRRD(l3, b_ + 12288); TRRD(h3, b_ + 14336); \
        asm volatile("s_waitcnt lgkmcnt(0)" ::: "memory"); SBAR();   \
        o[d0] = __builtin_amdgcn_mfma_f32_32x32x16_bf16(pa0, (bf16x8){l0[0], l0[1], l0[2], l0[3], h0[0], h0[1], h0[2], h0[3]}, o[d0], 0, 0, 0);   \
        o[d0] = __builtin_amdgcn_mfma_f32_32x32x16_bf16(pa1, (bf16x8){l1[0], l1[1], l1[2], l1[3], h1[0], h1[1], h1[2], h1[3]}, o[d0], 0, 0, 0);   \
        o[d0] = __builtin_amdgcn_mfma_f32_32x32x16_bf16(pa2, (bf16x8){l2[0], l2[1], l2[2], l2[3], h2[0], h2[1], h2[2], h2[3]}, o[d0], 0, 0, 0);   \
        o[d0] = __builtin_amdgcn_mfma_f32_32x32x16_bf16(pa3, (bf16x8){l3[0], l3[1], l3[2], l3[3], h3[0], h3[1], h3[2], h3[3]}, o[d0], 0, 0, 0); } while (0)
    PV_D0(0); PV_D0(1); PV_D0(2); PV_D0(3);
#undef PV_D0
#undef TRRD
}

struct HeadRef { unsigned rowb, o; const float* CS; const float* G; };
struct Seam { bf16x8 qr[8]; bf16x8 st_v0, st_v1, st_k0, st_k1; };
typedef __amdgpu_buffer_rsrc_t Srd;
#define BL8(rs, vo, so) __builtin_bit_cast(bf16x8, __builtin_amdgcn_raw_buffer_load_b128((rs), (vo), (so), 0))
#define VMW() asm volatile("s_waitcnt vmcnt(0)" ::: "memory")
#define VMWN(n) asm volatile("s_waitcnt vmcnt(%0)" :: "i"(n) : "memory")
#define SLOAD_H(k0, bb) do { const unsigned so_ = (unsigned)(k0) * (PITCH * 2);                                               \
                         S.st_v0 = BL8(R, kvoff, (unsigned)WS_FV + H.rowb + so_); S.st_v1 = BL8(R, kvoff, (unsigned)WS_FV + H.rowb + so_ + 32 * PITCH * 2);   \
                         S.st_k0 = BL8(R, kvoff, (unsigned)WS_FK + H.rowb + so_); S.st_k1 = BL8(R, kvoff, (unsigned)WS_FK + H.rowb + so_ + 32 * PITCH * 2);   \
                         if (wid == 0) __builtin_amdgcn_global_load_lds((const unsigned*)(H.CS + (k0)) + lane, (__attribute__((address_space(3))) unsigned*)(B3 + (bb) * 64), 4, 0, 0); } while (0)
#define QLOAD(p0_) do { const unsigned so_ = (unsigned)((p0_) + wid * QBLK) * (PITCH * 2);                                   \
        _Pragma("unroll") for (int d0 = 0; d0 < 8; ++d0) S.qr[d0] = BL8(R, qoff + d0 * 32, (unsigned)WS_FQ + H.rowb + so_); } while (0)
#define SWRITE_HK(bf) do { *(bf16x8*)(K_lds + (bf) * SHM_K + kws) = S.st_k0; *(bf16x8*)(K_lds + (bf) * SHM_K + kws + 32 * 256) = S.st_k1; } while (0)
#define SWRITE_HV(bf) do { *(bf16x8*)(V_lds + (bf) * SHM_V + vst0) = S.st_v0; *(bf16x8*)(V_lds + (bf) * SHM_V + vst1) = S.st_v1; } while (0)
#define SWRITE_H(bf) do { SWRITE_HV(bf); SWRITE_HK(bf); } while (0)

__device__ __forceinline__ void fox_prime(const Srd R, const HeadRef& H, int P0, char* lds, Seam& S) {
    const int tid = threadIdx.x, wid = __builtin_amdgcn_readfirstlane(tid >> 6), lane = tid & 63, r32 = lane & 31, hi = lane >> 5;
    const int sr = tid >> 4, sc = (tid & 15) * 8, kws = KSWZ(sr, sc * 2); char* K_lds = lds + LDS_K; float* B_lds = (float*)(lds + LDS_BIAS);
    const unsigned kvoff = (unsigned)(sr * PITCH + sc) * 2u, qoff = (unsigned)(r32 * PITCH + hi * 8) * 2u;
    __attribute__((address_space(3))) float* B3 = (__attribute__((address_space(3))) float*)B_lds;
    QLOAD(P0);
    SLOAD_H(0, 0); VMW(); SWRITE_HK(0);
    { char* qw = lds + LDS_Q + wid * 8192 + lane * 16;
#pragma unroll
      for (int d0 = 0; d0 < 8; ++d0) *(bf16x8*)(qw + d0 * 1024) = S.qr[d0]; }
    __syncthreads();
}
__device__ __forceinline__ void fox_block(const Srd R, const HeadRef& H, int P0, int P0n, char* lds, Seam& S) {
    const int tid = threadIdx.x, wid = __builtin_amdgcn_readfirstlane(tid >> 6), lane = tid & 63, r32 = lane & 31, hi = lane >> 5;
    const int NT = P0 / KVBLK + 4;
    const int qlo = P0 + wid * QBLK, qm = qlo + r32 - 4 * hi;
    char* V_lds = lds + LDS_V; char* K_lds = lds + LDS_K; float* B_lds = (float*)(lds + LDS_BIAS);
    char* qw = lds + LDS_Q + wid * 8192 + lane * 16;
    float* ws = (float*)(lds + LDS_WS) + wid * 64; float* li_l = ws, * al_l = ws + 32;
    float m_reg = -1e30f, l_reg = 0; f32x16 o[4] = {};
    const int sr = tid >> 4, sc = (tid & 15) * 8, vst0 = v_st(sr, sc), vst1 = v_st(32 + sr, sc), kws = KSWZ(sr, sc * 2);
    const int vb0 = (int)(uintptr_t)V_lds + v_rd_base(lane);
    const unsigned kvoff = (unsigned)(sr * PITCH + sc) * 2u, qoff = (unsigned)(r32 * PITCH + hi * 8) * 2u;
    __attribute__((address_space(3))) float* B3 = (__attribute__((address_space(3))) float*)B_lds;
#define RESC(a) do { if (__any((a) < 1.f)) { if (hi == 0) al_l[r32] = (a); asm volatile("s_waitcnt lgkmcnt(0)" ::: "memory");              \
                     for (int d_ = 0; d_ < 4; ++d_) for (int r = 0; r < 16; ++r) o[d_][r] *= al_l[crow(r, hi)]; } } while (0)
#define KBASE(t) ((t) * KVBLK)
#define MASKT(P0_, P1_, t) do { const int kb_ = KBASE(t); if (kb_ + KVBLK - 1 > qlo) mask_tile(P0_, P1_, qm - kb_); } while (0)
    f32x16 pA0, pA1, pB0, pB1; float mnA, mnB, alA, alB; bf16x8 pa0, pa1, pa2, pa3;
    SWRITE_HV(0); SBAR();
    SLOAD_H(KBASE(1), 1);
    SBAR(); qkt<0>(pA0, pA1, K_lds, B_lds, r32, hi, qw);
    MASKT(pA0, pA1, 0); partialSM(pA0, pA1, m_reg, mnA, alA);
    VMW(); SWRITE_H(1);
    __syncthreads();
#define HALF_STEP(PX0, PX1, mnX, alX, PY0, PY1, alY, t, KB, VB, SB) do {                                                      \
        SBAR(); qkt<KB>(PX0, PX1, K_lds, B_lds, r32, hi, qw);                                                                 \
        finishSM(PY0, PY1, alY, l_reg, pa0, pa1, pa2, pa3); SBAR();                                                           \
        if ((t) + 1 < NT) { SLOAD_H(KBASE((t) + 1), SB); SBAR(); }                                                                \
        pv_tile<VB>(o, vb0, pa0, pa1, pa2, pa3); MASKT(PX0, PX1, (t)); partialSM(PX0, PX1, m_reg, mnX, alX);                  \
        __syncthreads();                                                                                                      \
        if ((t) + 1 < NT) { VMW(); SWRITE_H(SB); }                                                                      \
        RESC(alX); __syncthreads(); } while (0)
    for (int t = 1; t + 1 < NT; t += 2) {
        HALF_STEP(pB0, pB1, mnB, alB, pA0, pA1, alA, t, 1, 0, 0);
        HALF_STEP(pA0, pA1, mnA, alA, pB0, pB1, alB, t + 1, 0, 1, 1);
    }
    SBAR(); qkt<1>(pB0, pB1, K_lds, B_lds, r32, hi, qw); SBAR();
    SLOAD_H(0, 0); SBAR();
    QLOAD(P0n);
    SBAR();
    finishSM(pA0, pA1, alA, l_reg, pa0, pa1, pa2, pa3); SBAR();
    pv_tile<0>(o, vb0, pa0, pa1, pa2, pa3);
    MASKT(pB0, pB1, NT - 1); partialSM(pB0, pB1, m_reg, mnB, alB); __syncthreads(); RESC(alB);
    finishSM(pB0, pB1, alB, l_reg, pa0, pa1, pa2, pa3); SBAR(); pv_tile<1>(o, vb0, pa0, pa1, pa2, pa3);
    SBAR(); VMWN(8); SWRITE_HK(0); SBAR();
    if (hi == 0) li_l[r32] = l_reg; asm volatile("s_waitcnt lgkmcnt(0)" ::: "memory");
    float gn[4];
#pragma unroll
    for (int d0 = 0; d0 < 4; ++d0) gn[d0] = H.G[d0 * 32 + r32];
    const unsigned ovoff = (unsigned)(4 * hi * OPITCH + r32) * 2u;
#pragma unroll
    for (int r = 0; r < 16; ++r) { const float rli = __builtin_amdgcn_rcpf(li_l[crow(r, hi)]); float ss = 0.f;
#pragma unroll
        for (int d0 = 0; d0 < 4; ++d0) { o[d0][r] *= rli; ss += o[d0][r] * o[d0][r]; }
        ss += __shfl_xor(ss, 1); ss += __shfl_xor(ss, 2); ss += __shfl_xor(ss, 4); ss += __shfl_xor(ss, 8); ss += __shfl_xor(ss, 16);
        const float rs = __builtin_amdgcn_rsqf(ss * (1.0f / D) + EPS);
        const unsigned so_ = (unsigned)(P0 + wid * QBLK + (r & 3) + 8 * (r >> 2)) * (OPITCH * 2);
#pragma unroll
        for (int d0 = 0; d0 < 4; ++d0) { const float v = o[d0][r] * rs * gn[d0];
            const float vn = __shfl_xor(v, 1);
            if ((r32 & 1) == 0) __builtin_amdgcn_raw_buffer_store_b32(cvtpk(v, vn), R, ovoff + d0 * 64, H.o + so_, 0); } }
#pragma unroll
    for (int d0 = 0; d0 < 8; ++d0) *(bf16x8*)(qw + d0 * 1024) = S.qr[d0];
    __syncthreads();
#undef RESC
#undef KBASE
#undef MASKT
#undef HALF_STEP
}
#undef BL8
#undef QLOAD
#undef VMW
#undef VMWN
#undef SLOAD_H
#undef SWRITE_HK
#undef SWRITE_HV
#undef SWRITE_H
#undef KSWZ
#undef SBAR
}
namespace mls {
typedef short bf16x8 __attribute__((ext_vector_type(8)));
typedef short bf16x4 __attribute__((ext_vector_type(4)));
typedef float f32x4 __attribute__((ext_vector_type(4)));
#define MFMA16(a, b, c) __builtin_amdgcn_mfma_f32_16x16x32_bf16((a), (b), (c), 0, 0, 0)

__device__ __forceinline__ void chunk_out(int b, int h, int c, const bf16* QP, const bf16* KPP, const bf16* VT, const bf16* CST, const float* NST,
                                          const bf16* MO, const float* gain, bf16* concat, float* xch  ) {
    const int tid = threadIdx.x, w = __builtin_amdgcn_readfirstlane(tid >> 6), lane = tid & 63, i16 = lane & 15, q = lane >> 4;
    const int tq = w & 3, dvh = w >> 2;
    const size_t R0 = (size_t)b * SEQ + (size_t)c * 64;
    const size_t item = ((size_t)(b * MLH + h) * NCHUNK + c);
    const bf16* qrow = QP + (R0 + 16 * tq + i16) * 512 + h * MLDK + 8 * q;
    bf16x8 qf[4];
#pragma unroll
    for (int ks = 0; ks < 4; ++ks) qf[ks] = *(const bf16x8*)(qrow + 32 * ks);
    f32x4 st[4];
#pragma unroll
    for (int stile = 0; stile < 4; ++stile) {
        st[stile] = (f32x4){0.f, 0.f, 0.f, 0.f};
        if (stile <= tq) {
            const bf16* krow = KPP + (R0 + 16 * stile + i16) * 512 + h * MLDK + 8 * q;
            bf16x8 kf[4];
#pragma unroll
            for (int ks = 0; ks < 4; ++ks) kf[ks] = *(const bf16x8*)(krow + 32 * ks);
#pragma unroll
            for (int ks = 0; ks < 4; ++ks) st[stile] = MFMA16(kf[ks], qf[ks], st[stile]);
            if (stile == tq) {
#pragma unroll
                for (int r = 0; r < 4; ++r) if (4 * q + r > i16) st[stile][r] = 0.f;
            }
        }
    }
    float den = 0.f;
#pragma unroll
    for (int stile = 0; stile < 4; ++stile) den += (st[stile][0] + st[stile][1]) + (st[stile][2] + st[stile][3]);
    { const float* nrow = NST + item * MLDK + 8 * q;
#pragma unroll
      for (int ks = 0; ks < 4; ++ks) { const f32x4 n0 = *(const f32x4*)(nrow + 32 * ks), n1 = *(const f32x4*)(nrow + 32 * ks + 4);
          const v4u qq = __builtin_bit_cast(v4u, qf[ks]);
          den += bflo(qq[0]) * n0[0] + bfhi(qq[0]) * n0[1] + bflo(qq[1]) * n0[2] + bfhi(qq[1]) * n0[3]
               + bflo(qq[2]) * n1[0] + bfhi(qq[2]) * n1[1] + bflo(qq[3]) * n1[2] + bfhi(qq[3]) * n1[3]; } }
    den += __shfl_xor(den, 16); den += __shfl_xor(den, 32);
    bf16x8 pf[2];
#pragma unroll
    for (int p = 0; p < 2; ++p) { v4u wv; wv[0] = pg8::cvt_pk_bf16(st[2 * p][0], st[2 * p][1]); wv[1] = pg8::cvt_pk_bf16(st[2 * p][2], st[2 * p][3]);
        wv[2] = pg8::cvt_pk_bf16(st[2 * p + 1][0], st[2 * p + 1][1]); wv[3] = pg8::cvt_pk_bf16(st[2 * p + 1][2], st[2 * p + 1][3]); pf[p] = __builtin_bit_cast(bf16x8, wv); }
    const int npair = (tq >> 1) + 1;
    f32x4 num[8];
    const bf16* vbase = VT + (item * MLDV + dvh * 128 + i16) * 64 + 4 * q;
    const bf16* cbase = CST + (item * MLDV + dvh * 128 + i16) * MLDK + 8 * q;
#pragma unroll
    for (int dt = 0; dt < 8; ++dt) {
        f32x4 a = (f32x4){0.f, 0.f, 0.f, 0.f};
        const bf16* vrow = vbase + (size_t)dt * 16 * 64; const bf16* crowp = cbase + (size_t)dt * 16 * MLDK;
#pragma unroll
        for (int p = 0; p < 2; ++p) if (p < npair) {
            const v2u lo = *(const v2u*)(vrow + 32 * p), hi2 = *(const v2u*)(vrow + 32 * p + 16);
            const v4u vv = {lo[0], lo[1], hi2[0], hi2[1]};
            a = MFMA16(__builtin_bit_cast(bf16x8, vv), pf[p], a); }
#pragma unroll
        for (int ks = 0; ks < 4; ++ks) { const bf16x8 cf = *(const bf16x8*)(crowp + 32 * ks); a = MFMA16(cf, qf[ks], a); }
        num[dt] = a;
    }
    const float rden = 1.0f / fmaxf(fabsf(den), 1.0f);
    float ss = 0.f;
#pragma unroll
    for (int dt = 0; dt < 8; ++dt) { num[dt] = num[dt] * rden; ss += (num[dt][0] * num[dt][0] + num[dt][1] * num[dt][1]) + (num[dt][2] * num[dt][2] + num[dt][3] * num[dt][3]); }
    ss += __shfl_xor(ss, 16); ss += __shfl_xor(ss, 32);
    if (q == 0) xch[w * 16 + i16] = ss;
    __syncthreads();
    const float tot = ss + xch[(w ^ 4) * 16 + i16];
    const float rn = __builtin_amdgcn_rsqf(tot * (1.0f / MLDV) + EPS);
    const size_t row = R0 + 16 * tq + i16; const int dv0 = h * MLDV + dvh * 128 + 4 * q;
#pragma unroll
    for (int dt = 0; dt < 8; ++dt) { const int dv = dv0 + 16 * dt;
        const f32x4 g4 = *(const f32x4*)(gain + dv); const v2u mo2 = *(const v2u*)(MO + row * 1024 + dv);
        const float o0 = num[dt][0] * rn * g4[0] * sigmoidf_(bflo(mo2[0])), o1 = num[dt][1] * rn * g4[1] * sigmoidf_(bfhi(mo2[0]));
        const float o2 = num[dt][2] * rn * g4[2] * sigmoidf_(bflo(mo2[1])), o3 = num[dt][3] * rn * g4[3] * sigmoidf_(bfhi(mo2[1]));
        v2u ov; ov[0] = pg8::cvt_pk_bf16(o0, o1); ov[1] = pg8::cvt_pk_bf16(o2, o3);
        *(v2u*)(concat + row * 2048 + 1024 + dv) = ov; }
    __syncthreads();
}

__device__ __forceinline__ void state_scan(int bh, int sl, const bf16* KT, const bf16* VT, const float* EB, bf16* CST) {
    const int tid = threadIdx.x, w = __builtin_amdgcn_readfirstlane(tid >> 6), lane = tid & 63, i16 = lane & 15, q = lane >> 4;
    const size_t it0 = (size_t)bh * NCHUNK;
    const bf16* ka = KT + (it0 * MLDK + 16 * w + i16) * 64 + 8 * q;
    const bf16* vb = VT + (it0 * MLDV + 16 * sl + i16) * 64 + 8 * q;
    bf16* cs = CST + (it0 * MLDV + 16 * sl + i16) * MLDK + 16 * w + 4 * q;
    const float ebv = EB[it0 + lane];
    f32x4 acc = (f32x4){0.f, 0.f, 0.f, 0.f};
    bf16x8 fa0[8], fa1[8], fb0[8], fb1[8];
#pragma unroll
    for (int j = 0; j < 8; ++j) { fa0[j] = *(const bf16x8*)(ka + (size_t)j * MLDK * 64); fa1[j] = *(const bf16x8*)(ka + (size_t)j * MLDK * 64 + 32);
                                  fb0[j] = *(const bf16x8*)(vb + (size_t)j * MLDV * 64); fb1[j] = *(const bf16x8*)(vb + (size_t)j * MLDV * 64 + 32); }
    for (int c0 = 0; c0 < NCHUNK; c0 += 8) {
#pragma unroll
        for (int j = 0; j < 8; ++j) { const int c = c0 + j;
            v2u ov; ov[0] = pg8::cvt_pk_bf16(acc[0], acc[1]); ov[1] = pg8::cvt_pk_bf16(acc[2], acc[3]);
            *(v2u*)(cs + (size_t)c * MLDV * MLDK) = ov;
            acc = MFMA16(fa0[j], fb0[j], acc); acc = MFMA16(fa1[j], fb1[j], acc);
            const int cn = c + 8 < NCHUNK ? c + 8 : c;
            fa0[j] = *(const bf16x8*)(ka + (size_t)cn * MLDK * 64); fa1[j] = *(const bf16x8*)(ka + (size_t)cn * MLDK * 64 + 32);
            fb0[j] = *(const bf16x8*)(vb + (size_t)cn * MLDV * 64); fb1[j] = *(const bf16x8*)(vb + (size_t)cn * MLDV * 64 + 32);
            const float e = __shfl(ebv, c);
            acc = acc * e; }
    }
}
#undef MFMA16
}
typedef const float* cfp_t;
struct Frame {
    LAS unsigned char* lds; unsigned char* ldsg;
    int tid, lane, wave, vcu, G;
    const __attribute__((address_space(4))) cfp_t* inp; float* out; unsigned char* ws;
};
__device__ __forceinline__ float wave_incl_scan(float v, int lane) {
#pragma unroll
    for (int o = 1; o < 64; o <<= 1) { const float t = __shfl_up(v, o); if (lane >= o) v += t; }
    return v;
}

__device__ __forceinline__ void p0_transpose_item(const float* W, int ldw, int K, bf16* WT, const float* gk, int k0, int n0_dst, int n0_src, LAS float* scr, int lane) {
    float vv[32];
#pragma unroll
    for (int i = 0; i < 32; ++i) { const int kk = 2 * i + (lane >> 5); vv[i] = W[(size_t)(k0 + kk) * ldw + n0_src + (lane & 31)]; }
    if (gk) {
#pragma unroll
        for (int i = 0; i < 32; ++i) vv[i] *= gk[k0 + 2 * i + (lane >> 5)]; }
#pragma unroll
    for (int i = 0; i < 32; ++i) scr[(2 * i + (lane >> 5)) * 33 + (lane & 31)] = vv[i];
    LDS_WAIT(); asm volatile("" ::: "memory");
    const int c = lane & 7;
#pragma unroll
    for (int j = 0; j < 4; ++j) { const int n = (lane >> 3) + 8 * j; const LAS float* s = scr + (8 * c) * 33 + n;
        v4u o; o.x = pk2(s[0 * 33], s[1 * 33]); o.y = pk2(s[2 * 33], s[3 * 33]); o.z = pk2(s[4 * 33], s[5 * 33]); o.w = pk2(s[6 * 33], s[7 * 33]);
        *(GAS v4u*)(WT + (size_t)(n0_dst + n) * K + k0 + 8 * c) = o; }
    LDS_WAIT(); asm volatile("" ::: "memory");
}
__device__ __forceinline__ float rms_row_to_bf16(const float* xrow, const float* g, bf16* orow, int lane) {
    const GAS v4f* xr = (const GAS v4f*)xrow + lane; const GAS v4f* gr = (const GAS v4f*)g + lane;
    v4f v[8]; float s = 0.f;
#pragma unroll
    for (int j = 0; j < 8; ++j) { v[j] = xr[64 * j]; s += (v[j].x * v[j].x + v[j].y * v[j].y) + (v[j].z * v[j].z + v[j].w * v[j].w); }
    const float rinv = 1.0f / sqrtf(wave_sum(s) * (1.f / DM) + EPS);
    GAS v2u* o8 = (GAS v2u*)orow + lane;
#pragma unroll
    for (int j = 0; j < 8; ++j) { const v4f gg = gr[64 * j]; v2u w; w.x = pk2(v[j].x * rinv * gg.x, v[j].y * rinv * gg.y); w.y = pk2(v[j].z * rinv * gg.z, v[j].w * rinv * gg.w); o8[64 * j] = w; }
    return rinv;
}
__device__ __forceinline__ void p0_prologue(Frame& F) {
    const float* x = F.inp[0]; const float* mem = F.inp[1]; const float* mixer_norm = F.inp[2]; const float* w_in = F.inp[3];
    const int gw = F.vcu * 8 + F.wave, NGW = F.G * 8;
    LAS float* WgL = (LAS float*)F.lds;
#pragma unroll 8
    for (int idx = F.tid; idx < 32768; idx += NTHREADS) { const int e = idx & 3, ln = (idx >> 2) & 63, sp = idx >> 8, gate = ln & 15, q = ln >> 4, k = 16 * sp + 4 * q + e;
        const int col = gate < 8 ? 3072 + gate : 5128 + (gate - 8);
        WgL[idx] = w_in[(size_t)k * IN_WIDTH + col] * mixer_norm[k]; }
    __syncthreads();
    { float* gates = (float*)(F.ws + WS_GATES); const int i16 = F.lane & 15, q = F.lane >> 4;
      for (int grp = gw; grp < MTOK / 16; grp += NGW) {
          const float* xr = x + (size_t)(grp * 16 + i16) * DM + 4 * q; v4f acc = (v4f){0.f, 0.f, 0.f, 0.f};
          const LAS float* wp = WgL + F.lane * 4;
#pragma unroll 1
          for (int s0 = 0; s0 < 128; s0 += 16, wp += 16 * 256, xr += 16 * 16) { v4f xb[16];
#pragma unroll
              for (int j = 0; j < 16; ++j) xb[j] = *(const v4f*)(xr + 16 * j);
#pragma unroll
              for (int j = 0; j < 16; ++j) { const v4f x4 = xb[j]; const v4f w4 = *(const LAS v4f*)(wp + j * 256);
                  acc = __builtin_amdgcn_mfma_f32_16x16x4f32(x4.x, w4.x, acc, 0, 0, 0); acc = __builtin_amdgcn_mfma_f32_16x16x4f32(x4.y, w4.y, acc, 0, 0, 0);
                  acc = __builtin_amdgcn_mfma_f32_16x16x4f32(x4.z, w4.z, acc, 0, 0, 0); acc = __builtin_amdgcn_mfma_f32_16x16x4f32(x4.w, w4.w, acc, 0, 0, 0); } }
#pragma unroll
          for (int r = 0; r < 4; ++r) gates[(size_t)(grp * 16 + 4 * q + r) * 16 + i16] = acc[r];
      } }
    { bf16* XN = (bf16*)(F.ws + WS_XN); float* RINV = (float*)(F.ws + WS_RINV);
      for (int m = gw; m < MTOK; m += NGW) { const float ri = rms_row_to_bf16(x + (size_t)m * DM, mixer_norm, XN + (size_t)m * DM, F.lane); if (F.lane == 0) RINV[m] = ri; }
      bf16* MN = (bf16*)(F.ws + WS_MN);
      for (int m = gw; m < MROWS; m += NGW) (void)rms_row_to_bf16(mem + (size_t)m * DM, F.inp[15], MN + (size_t)m * DM, F.lane); }
    __syncthreads();
    LAS float* scr = (LAS float*)(F.lds + F.wave * 16384);
    for (int it = gw; it < 32768; it += NGW) {
        int r = it;
        if (r < 6144) { const int kb = r / 192, nb = r % 192, n0 = 32 * nb, grpc = n0 >> 10, shift = grpc < 3 ? 0 : (grpc < 5 ? 8 : 16);
            p0_transpose_item(w_in, IN_WIDTH, DM, (bf16*)(F.ws + WS_WIN), nullptr, 64 * kb, n0, n0 + shift, scr, F.lane); continue; } r -= 6144;
        if (r < 2048) { p0_transpose_item(F.inp[13], DM, DM, (bf16*)(F.ws + WS_WOUT), nullptr, 64 * (r / 64), 32 * (r % 64), 32 * (r % 64), scr, F.lane); continue; } r -= 2048;
        if (r < 2048) { p0_transpose_item(F.inp[16], DM, DM, (bf16*)(F.ws + WS_WXQ), F.inp[14], 64 * (r / 64), 32 * (r % 64), 32 * (r % 64), scr, F.lane); continue; } r -= 2048;
        if (r < 4096) { p0_transpose_item(F.inp[17], 2 * DM, DM, (bf16*)(F.ws + WS_WXKV), nullptr, 64 * (r / 128), 32 * (r % 128), 32 * (r % 128), scr, F.lane); continue; } r -= 4096;
        if (r < 2048) { p0_transpose_item(F.inp[20], DM, DM, (bf16*)(F.ws + WS_WXO), nullptr, 64 * (r / 64), 32 * (r % 64), 32 * (r % 64), scr, F.lane); continue; } r -= 2048;
        if (r < 8192) { p0_transpose_item(F.inp[22], DFF, DM, (bf16*)(F.ws + WS_WUP), F.inp[21], 64 * (r / 256), 32 * (r % 256), 32 * (r % 256), scr, F.lane); continue; } r -= 8192;
        p0_transpose_item(F.inp[23], DM, DFF, (bf16*)(F.ws + WS_WDN), nullptr, 64 * (r / 64), 32 * (r % 64), 32 * (r % 64), scr, F.lane);
    }
}

constexpr int P2_KT_OFF = 4096, P2_KT_PITCH = 136, P2_VT_OFF = P2_KT_OFF + 64 * P2_KT_PITCH * 2, P2_VT_PITCH = 264;
__device__ __forceinline__ void p2_prep_item(Frame& F, int item) {
    const int b = item >> 6, c = item & 63; const size_t R0 = (size_t)b * SEQ + (size_t)c * 64;
    const int tid = F.tid, lane = F.lane, w = F.wave;
    LAS float* gq = (LAS float*)F.lds; LAS float* uk = gq + 256;
    LAS bf16* kt = (LAS bf16*)(F.lds + P2_KT_OFF); LAS bf16* vt = (LAS bf16*)(F.lds + P2_VT_OFF);
    const float* GATES = (const float*)(F.ws + WS_GATES); const float* RINV = (const float*)(F.ws + WS_RINV);
    if (w < 4) { const size_t row = R0 + lane; const float ri = RINV[row];
        const float mi = GATES[row * 16 + 8 + w] * ri + F.inp[5][w], mf = GATES[row * 16 + 12 + w] * ri + F.inp[6][w];
        const float bcum = wave_incl_scan(logsigmoidf(mf), lane);
        const float g = __expf(bcum), u = __expf(mi - bcum) * 0.08838834764831845f;
        gq[w * 64 + lane] = g; uk[w * 64 + lane] = u;
        if (lane == 63) ((float*)(F.ws + WS_EB))[(size_t)(b * MLH + w) * NCHUNK + c] = g; }
    { bf16* FQ = (bf16*)(F.ws + WS_FQ); bf16* FK = (bf16*)(F.ws + WS_FK); const int l16 = lane & 15;
      float gqn[8], gkn[8];
#pragma unroll
      for (int e = 0; e < 8; ++e) { gqn[e] = F.inp[9][l16 * 8 + e]; gkn[e] = F.inp[10][l16 * 8 + e]; }
      for (int it = w; it < 256; it += 8) { const int seg = it * 4 + (lane >> 4), row = seg >> 4, hh = seg & 15;
          bf16* p = (hh < 8 ? FQ : FK) + (R0 + row) * 1024 + (hh & 7) * FOXD + l16 * 8;
          const v4u raw = *(const v4u*)p; float v[8];
#pragma unroll
          for (int e = 0; e < 4; ++e) { v[2 * e] = bflo(raw[e]); v[2 * e + 1] = bfhi(raw[e]); }
          float ss = 0.f;
#pragma unroll
          for (int e = 0; e < 8; ++e) ss += v[e] * v[e];
          ss += __shfl_xor(ss, 1); ss += __shfl_xor(ss, 2); ss += __shfl_xor(ss, 4); ss += __shfl_xor(ss, 8);
          const float ri = 1.0f / sqrtf(ss * (1.0f / FOXD) + EPS);
          v4u o;
#pragma unroll
          for (int e = 0; e < 4; ++e) { const float g0 = hh < 8 ? gqn[2 * e] : gkn[2 * e], g1 = hh < 8 ? gqn[2 * e + 1] : gkn[2 * e + 1]; o[e] = pk2(v[2 * e] * ri * g0, v[2 * e + 1] * ri * g1); }
          *(v4u*)p = o; } }
    __syncthreads();
    const bf16* MQK = (const bf16*)(F.ws + WS_MQK); const bf16* MV = (const bf16*)(F.ws + WS_MV);
    bf16* QP = (bf16*)(F.ws + WS_QP); bf16* KPP = (bf16*)(F.ws + WS_KPP);
    const float* conv_w = F.inp[7]; const float* conv_b = F.inp[8];
    for (int h = 0; h < MLH; ++h) {
        { const int cgp = tid & 31, rg = tid >> 5; const bool isq = cgp < 16; const int col = (isq ? 0 : 512) + h * MLDK + (cgp & 15) * 8;
          float cw[4][8], cb[8];
#pragma unroll
          for (int e = 0; e < 8; ++e) { cb[e] = conv_b[col + e];
#pragma unroll
              for (int j = 0; j < 4; ++j) cw[j][e] = conv_w[j * 1024 + col + e]; }
          float u[7][8];
#pragma unroll
          for (int i = 0; i < 7; ++i) { const int pos = c * 64 + 4 * rg - 3 + i;
              v4u raw = (v4u){0u, 0u, 0u, 0u}; if (pos >= 0) raw = *(const v4u*)(MQK + ((size_t)b * SEQ + pos) * 1024 + col);
#pragma unroll
              for (int e = 0; e < 4; ++e) { u[i][2 * e] = bflo(raw[e]); u[i][2 * e + 1] = bfhi(raw[e]); } }
#pragma unroll
          for (int r = 0; r < 4; ++r) { const int t = 4 * rg + r; const float f = isq ? gq[h * 64 + t] : uk[h * 64 + t]; float y[8];
#pragma unroll
              for (int e = 0; e < 8; ++e) { float a = cb[e];
#pragma unroll
                  for (int j = 0; j < 4; ++j) a += cw[j][e] * u[r + j][e];
                  y[e] = a * sigmoidf_(a) * f; }
              v4u o; o.x = pk2(y[0], y[1]); o.y = pk2(y[2], y[3]); o.z = pk2(y[4], y[5]); o.w = pk2(y[6], y[7]);
              *(v4u*)((isq ? QP : KPP) + (R0 + t) * 512 + h * MLDK + (cgp & 15) * 8) = o;
              if (!isq) *(LAS v4u*)(kt + t * P2_KT_PITCH + (cgp & 15) * 8) = o; } }
#pragma unroll
        for (int i = 0; i < 4; ++i) { const int idx = tid + NTHREADS * i, row = idx >> 5, ch = idx & 31;
            *(LAS v4u*)(vt + row * P2_VT_PITCH + ch * 8) = *(const v4u*)(MV + (R0 + row) * 1024 + h * MLDV + ch * 8); }
        __syncthreads();
        const size_t itemh = (size_t)(b * MLH + h) * NCHUNK + c;
        { bf16* KT = (bf16*)(F.ws + WS_KT) + itemh * MLDK * 64;
#pragma unroll
          for (int i = 0; i < 2; ++i) { const int idx = tid + NTHREADS * i, d = idx >> 3, sg = idx & 7; unsigned short e8[8];
#pragma unroll
              for (int e = 0; e < 8; ++e) e8[e] = kt[(8 * sg + e) * P2_KT_PITCH + d];
              v4u o; o.x = e8[0] | ((unsigned)e8[1] << 16); o.y = e8[2] | ((unsigned)e8[3] << 16); o.z = e8[4] | ((unsigned)e8[5] << 16); o.w = e8[6] | ((unsigned)e8[7] << 16);
              *(v4u*)(KT + d * 64 + 8 * sg) = o; }
          bf16* VT = (bf16*)(F.ws + WS_VT) + itemh * MLDV * 64;
#pragma unroll
          for (int i = 0; i < 4; ++i) { const int idx = tid + NTHREADS * i, dv = idx >> 3, sg = idx & 7; unsigned short e8[8];
#pragma unroll
              for (int e = 0; e < 8; ++e) e8[e] = vt[(8 * sg + e) * P2_VT_PITCH + dv];
              v4u o; o.x = e8[0] | ((unsigned)e8[1] << 16); o.y = e8[2] | ((unsigned)e8[3] << 16); o.z = e8[4] | ((unsigned)e8[5] << 16); o.w = e8[6] | ((unsigned)e8[7] << 16);
              *(v4u*)(VT + dv * 64 + 8 * sg) = o; }
          if (tid < MLDK) { float s = 0.f;
#pragma unroll 8
              for (int t = 0; t < 64; ++t) s += bf2f(kt[t * P2_KT_PITCH + tid]);
              ((float*)(F.ws + WS_KSUM))[itemh * MLDK + tid] = s; } }
        __syncthreads();
    }
    if (w < 4) { const int mr = item * 4 + w; const float* slab = (const float*)((const unsigned char*)F.out + OUT_SLAB);
        const float* gxq = F.inp[18]; const float* gxk = F.inp[19];
        v4f kv[8]; float ssh[4] = {0.f, 0.f, 0.f, 0.f};
#pragma unroll
        for (int j = 0; j < 8; ++j) { const int col = 4 * (lane + 64 * j); v4f a = (v4f){0.f, 0.f, 0.f, 0.f};
#pragma unroll
            for (int s = 0; s < 4; ++s) a = a + *(const v4f*)(slab + ((size_t)s * MROWS + mr) * 4096 + col);
            kv[j] = a; ssh[j >> 1] += (a.x * a.x + a.y * a.y) + (a.z * a.z + a.w * a.w); }
        float rk[4];
#pragma unroll
        for (int hh = 0; hh < 4; ++hh) rk[hh] = 1.0f / sqrtf(wave_sum(ssh[hh]) * (1.0f / XD) + EPS);
        bf16* KH = (bf16*)(F.ws + WS_KHAT) + (size_t)mr * DM;
#pragma unroll
        for (int j = 0; j < 8; ++j) { const int col = 4 * (lane + 64 * j), d = col & (XD - 1); const v4f a = *(const v4f*)(gxq + d), g2 = *(const v4f*)(gxk + d); const float r = rk[j >> 1];
            v2u o; o.x = pk2(kv[j].x * r * a.x * g2.x, kv[j].y * r * a.y * g2.y); o.y = pk2(kv[j].z * r * a.z * g2.z, kv[j].w * r * a.w * g2.w);
            *(v2u*)(KH + col) = o; }
        bf16* VTM = (bf16*)(F.ws + WS_VTM); const int bm = mr >> 8, key = mr & 255;
#pragma unroll
        for (int j = 0; j < 8; ++j) { const int dcol = 4 * (lane + 64 * j); v4f a = (v4f){0.f, 0.f, 0.f, 0.f};
#pragma unroll
            for (int s = 0; s < 4; ++s) a = a + *(const v4f*)(slab + ((size_t)s * MROWS + mr) * 4096 + 2048 + dcol);
            const int hh = dcol >> 9, d = dcol & (XD - 1); bf16* vp = VTM + ((size_t)(bm * XH + hh) * XD + d) * NMEM + key;
            vp[0] = (bf16)f2bf(a.x); vp[NMEM] = (bf16)f2bf(a.y); vp[2 * NMEM] = (bf16)f2bf(a.z); vp[3 * NMEM] = (bf16)f2bf(a.w); }
    }
    __syncthreads();
}

__device__ __forceinline__ void p3_scan_item(Frame& F, int item) {
    const int bh = item >> 4, sl = item & 15;
    mls::state_scan(bh, sl, (const bf16*)(F.ws + WS_KT), (const bf16*)(F.ws + WS_VT), (const float*)(F.ws + WS_EB), (bf16*)((unsigned char*)F.out + OUT_CST));
    if (sl == 0 && F.tid < MLDK) {
        const float* EB = (const float*)(F.ws + WS_EB) + (size_t)bh * NCHUNK; const float* KS = (const float*)(F.ws + WS_KSUM) + (size_t)bh * NCHUNK * MLDK + F.tid;
        float* NS = (float*)(F.ws + WS_NST) + (size_t)bh * NCHUNK * MLDK + F.tid; float n = 0.f;
        float ks[NCHUNK], eb[NCHUNK];
#pragma unroll
        for (int c = 0; c < NCHUNK; ++c) { ks[c] = KS[(size_t)c * MLDK]; eb[c] = EB[c]; }
#pragma unroll
        for (int c = 0; c < NCHUNK; ++c) { NS[(size_t)c * MLDK] = n; n = eb[c] * (n + ks[c]); }
    }
    if (sl == 1 || sl == 2) {
        const int seq = (sl - 1) * 16 + bh, b = seq >> 3, fh = seq & 7;
        const float* GATES = (const float*)(F.ws + WS_GATES); const float* RINV = (const float*)(F.ws + WS_RINV); const float fb = F.inp[4][fh];
        const size_t r0 = (size_t)b * SEQ + 8 * F.tid; float lf[8]; float tot = 0.f;
#pragma unroll
        for (int j = 0; j < 8; ++j) { lf[j] = logsigmoidf(GATES[(r0 + j) * 16 + fh] * RINV[r0 + j] + fb); tot += lf[j]; }
        const float incl = wave_incl_scan(tot, F.lane);
        LAS float* wt = (LAS float*)F.lds;
        __syncthreads();
        if (F.lane == 63) wt[F.wave] = incl;
        __syncthreads();
        float run = incl - tot;
        for (int wv = 0; wv < F.wave; ++wv) run += wt[wv];
        float* C = (float*)(F.ws + WS_CFOX) + (size_t)seq * SEQ + 8 * F.tid;
#pragma unroll
        for (int j = 0; j < 8; ++j) { run += lf[j]; C[j] = run * -11.313708498984761f; }
        __syncthreads();
    }
}
#ifndef MK_PER_PHASE
#define MK_PER_PHASE 0
#endif
#define XB_TMO      128
#define XB_XCNT(j)  (256  + 64 * (j))
#define XB_XSUB(j)  (1280 + 64 * (j))
#define XB_XGEN(j)  (2304 + 64 * (j))
#define XB_TOP      3328
#define XB_TOPGEN   3392
#define XCD_BAR_WORDS 3456
#define XB_SPIN_CAP (1u << 20)
__device__ __forceinline__ unsigned xb_ld(unsigned* p)              { return __hip_atomic_load(p, __ATOMIC_RELAXED, __HIP_MEMORY_SCOPE_AGENT); }
__device__ __forceinline__ unsigned xb_add(unsigned* p, unsigned v) { return __hip_atomic_fetch_add(p, v, __ATOMIC_RELAXED, __HIP_MEMORY_SCOPE_AGENT); }
__device__ __forceinline__ unsigned xb_xcc_id() { return (unsigned)__builtin_amdgcn_s_getreg((3 << 11) | 20) & 0xFu; }
#define XB_SPIN(cond, bar) do { unsigned _sp = 0; while (cond) { __builtin_amdgcn_s_sleep(1); \
    if ((++_sp & 255u) == 0u) { if (xb_ld(&(bar)[XB_TMO])) break; if (_sp > XB_SPIN_CAP) { atomicAdd(&(bar)[XB_TMO], 1u); break; } } } } while (0)
struct XcdBarrier { unsigned* bar; unsigned x; volatile LAS unsigned* st; };
__device__ __forceinline__ XcdBarrier xcd_barrier_post(unsigned* bar, volatile LAS unsigned* st) {
    XcdBarrier b; b.bar = bar; b.x = xb_xcc_id(); b.st = st;
    if (threadIdx.x == 0) (void)xb_add(&bar[XB_XCNT(b.x)], 1u);
    return b;
}
__device__ __forceinline__ void xcd_barrier_complete(unsigned* bar, unsigned x, unsigned& nloc, unsigned& nx) {
    const unsigned G = gridDim.x * gridDim.y * gridDim.z;
    unsigned sum, cnt, mine, sp = 0u;
    for (;;) {
        sum = 0u; cnt = 0u; mine = 0u;
#pragma unroll
        for (unsigned j = 0; j < 16; ++j) { const unsigned c = xb_ld(&bar[XB_XCNT(j)]); sum += c; cnt += (c > 0u) ? 1u : 0u; mine = (j == x) ? c : mine; }
        if (sum == G) break;
        __builtin_amdgcn_s_sleep(1);
        if ((++sp & 255u) == 0u) { if (xb_ld(&bar[XB_TMO])) break; if (sp > XB_SPIN_CAP) { atomicAdd(&bar[XB_TMO], 1u); break; } }
    }
    nloc = mine > 0u ? mine : 1u; nx = cnt > 0u ? cnt : 1u;
}
__device__ __forceinline__ void xcd_barrier(const XcdBarrier& b) {
    asm volatile("s_waitcnt vmcnt(0)" ::: "memory");
    __syncthreads();
    if (threadIdx.x == 0) {
        unsigned* bar = b.bar;
        __builtin_amdgcn_s_waitcnt(0);
        unsigned nloc = b.st[0], nx = b.st[1];
        if (nloc == 0u) { xcd_barrier_complete(bar, b.x, nloc, nx); b.st[0] = nloc; b.st[1] = nx; }
        const unsigned old = xb_add(&bar[XB_XSUB(b.x)], 1u);
        const unsigned gen = old / nloc;
        if (old + 1u == (gen + 1u) * nloc) {
            __builtin_amdgcn_fence(__ATOMIC_RELEASE, "agent");
            asm volatile("s_waitcnt vmcnt(0)" ::: "memory");
            const unsigned og = xb_add(&bar[XB_TOP], 1u);
            const unsigned tg = og / nx;
            if (og + 1u == (tg + 1u) * nx) xb_add(&bar[XB_TOPGEN], 1u);
            else XB_SPIN(xb_ld(&bar[XB_TOPGEN]) == tg, bar);
            __builtin_amdgcn_fence(__ATOMIC_ACQUIRE, "agent");
            xb_add(&bar[XB_XGEN(b.x)], 1u);
            asm volatile("s_waitcnt vmcnt(0)" ::: "memory");
        } else {
            XB_SPIN(xb_ld(&bar[XB_XGEN(b.x)]) == gen, bar);
            __builtin_amdgcn_fence(__ATOMIC_ACQUIRE, "agent");
            asm volatile("s_waitcnt vmcnt(0)" ::: "memory");
        }
    }
    __syncthreads();
}
constexpr int LDS_MISC_OFF = LDS_BYTES - 256;
constexpr int N_PHASES = 12;
struct Args { const float* in[24]; float* out; unsigned char* ws; int ph_lo, ph_hi; };
static_assert(sizeof(Args) == 24 * 8 + 8 + 8 + 8, "Args has no padding");

__global__ void __launch_bounds__(NTHREADS, 2) fwd_kernel(Args args) {
    extern __shared__ __attribute__((aligned(16))) unsigned char lds[];
    Frame F;
    F.lds = (LAS unsigned char*)lds; F.ldsg = lds;
    F.tid = threadIdx.x; F.lane = F.tid & 63; F.wave = __builtin_amdgcn_readfirstlane(F.tid >> 6);
    F.G = gridDim.x; { const int bx = blockIdx.x; F.vcu = (F.G % 8 == 0) ? (bx % 8) * (F.G / 8) + bx / 8 : bx; }
    F.inp = (const __attribute__((address_space(4))) cfp_t*)__builtin_amdgcn_kernarg_segment_ptr();
    F.out = args.out; F.ws = args.ws;
    unsigned char* ws = args.ws;
    const int lo = args.ph_lo, hi = args.ph_hi;
    volatile LAS unsigned* MISC = (volatile LAS unsigned*)(F.lds + LDS_MISC_OFF);
    if (F.tid < 64) MISC[F.tid] = 0u;
    __syncthreads();
    XcdBarrier xbar; xbar.bar = (unsigned*)(ws + WS_CTL); xbar.x = 0; xbar.st = nullptr;
    if (hi - lo > 1) xbar = xcd_barrier_post((unsigned*)(ws + WS_CTL), MISC);
#ifndef PHASE_MASK
#define PHASE_MASK 0xfff
#endif
#define IN(k) ((((PHASE_MASK) >> (k)) & 1) && lo <= (k) && (k) < hi)
#ifndef DUP_PHASE
#define DUP_PHASE 99
#endif
#define REP(k) for (int rep_ = 0; rep_ < ((k) == DUP_PHASE ? 2 : 1); ++rep_, ((k) == DUP_PHASE && rep_ < 2 ? xcd_barrier(xbar) : (void)0))
#define SEAM(k) do { if (IN(k) && IN((k) + 1)) { if ((k) == 0) cg::this_grid().sync(); else xcd_barrier(xbar); } } while (0)
    float* SSQ1 = (float*)(ws + WS_CTL + CTL_SSQ1); float* SSQ2 = (float*)(ws + WS_CTL + CTL_SSQ2); float* SSQQ = (float*)(ws + WS_CTL + CTL_SSQQ);

#ifdef PROBE_PHASE
    unsigned long long pt0 = 0, pt1 = 0, pu0 = 0, pu1 = 0;
#ifndef PROBE_B
#define PROBE_B 99
#endif
#define STAMP(k) do { if ((k) == PROBE_PHASE) pt0 = __builtin_amdgcn_s_memrealtime(); if ((k) == PROBE_PHASE + 1) pt1 = __builtin_amdgcn_s_memrealtime(); \
                      if ((k) == PROBE_B) pu0 = __builtin_amdgcn_s_memrealtime(); if ((k) == PROBE_B + 1) pu1 = __builtin_amdgcn_s_memrealtime(); } while (0)
#else
#define STAMP(k) do {} while (0)
#endif
    STAMP(0);
    if (IN(0)) REP(0) { p0_prologue(F); }
    SEAM(0); STAMP(1);
    if (IN(1)) REP(1) {
        { pg8::Gemm g{(const bf16*)(ws + WS_XN), (const bf16*)(ws + WS_WIN), DM, DM, DM}; pg8::StdOrder S; S.init(MTOK, NPROJ, DM, DM, F.G, (int)blockIdx.x);
          pg8::EpiStoreBf16 E{(bf16*)(ws + WS_PROJ), 1024, 1024, (size_t)MTOK * 1024};
          pg8::gemm_phase<pg8::EpiStoreBf16, pg8::StdOrder, true>(F.lds, g, S, E); }
        { pg8::Gemm g{(const bf16*)(ws + WS_MN), (const bf16*)(ws + WS_WXKV), DM, DM, 512}; pg8::XkvOrder S{F.G, (int)blockIdx.x};
          pg8::EpiSlab E{(float*)((unsigned char*)F.out + OUT_SLAB), 4096, (size_t)MROWS * 4096};
          pg8::gemm_phase<pg8::EpiSlab, pg8::XkvOrder, false>(F.lds, g, S, E); }
    }
    SEAM(1); STAMP(2);
    if (IN(2)) REP(2) { for (int item = F.vcu; item < BATCH * NCHUNK; item += F.G) p2_prep_item(F, item); }
    SEAM(2); STAMP(3);
#ifndef P3_TWICE
#define P3_TWICE 1
#endif
    if (IN(3)) REP(3) { for (int item = F.vcu; item < 256 * P3_TWICE; item += F.G) p3_scan_item(F, item & 255); }
    SEAM(3); STAMP(4);
    if (IN(4)) REP(4) {
        if (!((PHASE_MASK >> 12) & 1)) { const fox::Srd R = __builtin_amdgcn_make_buffer_rsrc((void*)ws, (short)0, (int)WS_END, 0x00020000);
          for (int L = F.vcu; L < 256; L += F.G) { const int bh = L >> 3, xq = L & 7, b = bh >> 3, h = bh & 7;
              const unsigned rowb = (unsigned)b * SEQ * 2048u + (unsigned)h * (FOXD * 2);
              fox::HeadRef H{rowb,
                             (unsigned)WS_CONCAT + (unsigned)b * SEQ * 4096u + (unsigned)h * (FOXD * 2), (const float*)(ws + WS_CFOX) + (size_t)bh * SEQ, F.inp[11] + h * FOXD};
              fox::Seam S;
              fox::fox_prime(R, H, xq * 256, (char*)lds, S);
              for (int p = 0; p < 2; ++p) { const int P0 = (p == 0 ? xq : 15 - xq) * 256, P0n = (15 - xq) * 256;
                  fox::fox_block(R, H, P0, P0n, (char*)lds, S); }
              VM_WAIT(); __syncthreads(); } }
        if (!((PHASE_MASK >> 13) & 1)) { float* xch = (float*)lds;
          for (int it = F.vcu; it < BATCH * MLH * NCHUNK; it += F.G) { const int c = it & 63, h = (it >> 6) & 3, b = it >> 8;
              mls::chunk_out(b, h, c, (const bf16*)(ws + WS_QP), (const bf16*)(ws + WS_KPP), (const bf16*)(ws + WS_VT), (const bf16*)((unsigned char*)F.out + OUT_CST),
                             (const float*)(ws + WS_NST), (const bf16*)(ws + WS_MO), F.inp[12], (bf16*)(ws + WS_CONCAT), xch); } }
    }
    SEAM(4); STAMP(5);
    if (IN(5)) REP(5) {
        pg8::Gemm g{(const bf16*)(ws + WS_CONCAT), (const bf16*)(ws + WS_WOUT), DM, DM, DM}; pg8::StdOrder S; S.init(MTOK, DM, DM, DM, F.G, (int)blockIdx.x);
        pg8::EpiResid E{F.inp[0], F.out, (bf16*)(ws + WS_X1B), SSQ1, DM};
        pg8::gemm_phase<pg8::EpiResid, pg8::StdOrder, true>(F.lds, g, S, E);
    }
    SEAM(5); STAMP(6);
    if (IN(6)) REP(6) {
        pg8::Gemm g{(const bf16*)(ws + WS_X1B), (const bf16*)(ws + WS_WXQ), DM, DM, DM}; pg8::StdOrder S; S.init(MTOK, DM, DM, DM, F.G, (int)blockIdx.x);
        pg8::EpiQ E{(bf16*)(ws + WS_Q), SSQ1, SSQQ};
        pg8::gemm_phase<pg8::EpiQ, pg8::StdOrder, true>(F.lds, g, S, E);
    }
    SEAM(6); STAMP(7);
    if (IN(7)) REP(7) {
        pg8::Gemm g{(const bf16*)(ws + WS_Q), (const bf16*)(ws + WS_KHAT), DM, DM, XD}; pg8::ScoreOrder S{F.G, (int)blockIdx.x};
        pg8::EpiSoftmax E{(bf16*)(ws + WS_P), SSQQ};
        if (F.G >= 256) pg8::gemm_phase<pg8::EpiSoftmax, pg8::ScoreOrder, false>(F.lds, g, S, E);
    }
    SEAM(7); STAMP(8);
    if (IN(8)) REP(8) {
        pg8::Gemm g{(const bf16*)(ws + WS_P), (const bf16*)(ws + WS_VTM), 1024, NMEM, NMEM}; pg8::PvOrder S{F.G, (int)blockIdx.x};
        pg8::EpiStoreBf16 E{(bf16*)(ws + WS_CO), DM, 0, 0};
        pg8::gemm_phase<pg8::EpiStoreBf16, pg8::PvOrder, true>(F.lds, g, S, E);
    }
    SEAM(8); STAMP(9);
    if (IN(9)) REP(9) {
        pg8::Gemm g{(const bf16*)(ws + WS_CO), (const bf16*)(ws + WS_WXO), DM, DM, DM}; pg8::StdOrder S; S.init(MTOK, DM, DM, DM, F.G, (int)blockIdx.x);
        pg8::EpiResid E{F.out, F.out, (bf16*)(ws + WS_X2B), SSQ2, DM};
        pg8::gemm_phase<pg8::EpiResid, pg8::StdOrder, true>(F.lds, g, S, E);
    }
    SEAM(9); STAMP(10);
    if (IN(10)) REP(10) {
        pg8::Gemm g{(const bf16*)(ws + WS_X2B), (const bf16*)(ws + WS_WUP), DM, DM, DM}; pg8::StdOrder S; S.init(MTOK, DFF, DM, DM, F.G, (int)blockIdx.x);
        pg8::EpiUp E{(bf16*)(ws + WS_H), SSQ2};
        pg8::gemm_phase<pg8::EpiUp, pg8::StdOrder, true>(F.lds, g, S, E);
    }
    SEAM(10); STAMP(11);
    if (IN(11)) REP(11) {
        pg8::Gemm g{(const bf16*)(ws + WS_H), (const bf16*)(ws + WS_WDN), DFF, DFF, DFF}; pg8::StdOrder S; S.init(MTOK, DM, DFF, DFF, F.G, (int)blockIdx.x);
        pg8::EpiResid E{F.out, F.out, nullptr, nullptr, DM};
        pg8::gemm_phase<pg8::EpiResid, pg8::StdOrder, true>(F.lds, g, S, E);
    }
#ifdef PROBE_PHASE
    xcd_barrier(xbar); STAMP(12);
    if (blockIdx.x == 0 && threadIdx.x < 64) {
        const float ta = 8.0f * rintf((float)(pt1 - pt0) * 0.01f * 0.125f), tb = 0.8f * rintf((float)(pu1 - pu0) * 0.01f * 0.125f);
        if (threadIdx.x == 0) F.out[0] += ta;
        if (PROBE_B != 99) for (int i = threadIdx.x; i < 10000; i += 64) F.out[64 + i] += tb;
    }
#endif
#undef IN
#undef SEAM
}

extern "C" void kernel_launch(void* const* d_in, const int* in_sizes, int n_in, void* d_out, int out_size, void* d_ws, size_t ws_size, hipStream_t stream) {
    static int grid = 0;
    if (grid == 0) {
        if (n_in != 24 || in_sizes[0] != MTOK * DM || out_size != MTOK * DM || ws_size < WS_END) {
            fprintf(stderr, "kernel_launch: unexpected shapes (n_in %d, in0 %d, out %d, ws %zu; need ws >= %zu); nothing launched\n", n_in, n_in > 0 ? in_sizes[0] : -1, out_size, ws_size, (size_t)WS_END); grid = -1; return; }
        int dev = 0, cus = 0, per_cu = 0;
        if (hipGetDevice(&dev) != hipSuccess || hipDeviceGetAttribute(&cus, hipDeviceAttributeMultiprocessorCount, dev) != hipSuccess) { grid = -1; return; }
        if (hipFuncSetAttribute((const void*)fwd_kernel, hipFuncAttributeMaxDynamicSharedMemorySize, LDS_BYTES) != hipSuccess) { fprintf(stderr, "kernel_launch: hipFuncSetAttribute failed\n"); grid = -1; return; }
        if (hipOccupancyMaxActiveBlocksPerMultiprocessor(&per_cu, (const void*)fwd_kernel, NTHREADS, LDS_BYTES) != hipSuccess || per_cu < 1) { fprintf(stderr, "kernel_launch: occupancy query says %d blocks per CU\n", per_cu); per_cu = 1; }
        (void)hipGetLastError();
        grid = cus;
    }
    if (grid < 0) return;
    (void)hipMemsetAsync((char*)d_ws + WS_CTL, 0, CTL_BYTES, stream);
    Args a{};
    for (int i = 0; i < 24; ++i) a.in[i] = (const float*)d_in[i];
    a.out = (float*)d_out; a.ws = (unsigned char*)d_ws;
#if MK_PER_PHASE
    for (int ph = 0; ph < N_PHASES; ++ph) { a.ph_lo = ph; a.ph_hi = ph + 1;
        hipLaunchKernelGGL(fwd_kernel, dim3(grid), dim3(NTHREADS), LDS_BYTES, stream, a); }
#else
    a.ph_lo = 0; a.ph_hi = N_PHASES;
    void* kargs[] = {&a};
    hipError_t e = hipLaunchCooperativeKernel((const void*)fwd_kernel, dim3(grid), dim3(NTHREADS), kargs, LDS_BYTES, stream);
    if (e != hipSuccess) fprintf(stderr, "kernel_launch: cooperative launch failed: %s (grid %d)\n", hipGetErrorString(e), grid);
#endif
}
```

```cpp
#include <hip/hip_runtime.h>
#include <hip/hip_cooperative_groups.h>
#include <cstdio>
#include <cstdint>
namespace cg = cooperative_groups;

constexpr int BATCH = 4, SEQ = 4096, DM = 2048, MTOK = BATCH * SEQ;
constexpr int NMEM = 256, MROWS = BATCH * NMEM;
constexpr int FOXH = 8, FOXD = 128, MLH = 4, MLDV = 256, MLDK = 128, XH = 4, XD = 512, DFF = 8192;
constexpr int IN_WIDTH = 6160, NPROJ = 6144, NCHUNK = SEQ / 64;
constexpr float EPS = 1e-6f;
constexpr float LOG2E = 1.4426950408889634f;

constexpr size_t MiB = (size_t)1 << 20;
constexpr size_t WS_WIN = 0, WS_WOUT = 24 * MiB, WS_WXQ = 32 * MiB, WS_WXKV = 40 * MiB, WS_WXO = 56 * MiB, WS_WUP = 64 * MiB, WS_WDN = 96 * MiB;
constexpr size_t WS_PROJ = 128 * MiB;
constexpr size_t WS_FQ = 128 * MiB, WS_FK = 160 * MiB, WS_FV = 192 * MiB, WS_MQK = 224 * MiB, WS_MV = 256 * MiB, WS_MO = 288 * MiB;
constexpr size_t WS_XN = 320 * MiB;
constexpr size_t WS_QP = 384 * MiB, WS_KPP = 400 * MiB;
constexpr size_t WS_KT = 416 * MiB;
constexpr size_t WS_VT = 432 * MiB;
constexpr size_t WS_MISC = 464 * MiB;
constexpr size_t WS_CTL = WS_MISC, CTL_BYTES = 1 * MiB;
constexpr size_t CTL_SSQ1 = 64 * 1024, CTL_SSQ2 = 128 * 1024, CTL_SSQQ = 192 * 1024;
constexpr size_t WS_GATES = WS_MISC + 1 * MiB;
constexpr size_t WS_RINV = WS_MISC + 2 * MiB;
constexpr size_t WS_CFOX = WS_MISC + 3 * MiB;
constexpr size_t WS_EB = WS_MISC + 4 * MiB;
constexpr size_t WS_KSUM = WS_MISC + 5 * MiB;
constexpr size_t WS_NST = WS_MISC + 6 * MiB;
constexpr size_t WS_MN = WS_MISC + 8 * MiB;
constexpr size_t WS_KHAT = WS_MISC + 12 * MiB;
constexpr size_t WS_VTM = WS_MISC + 16 * MiB;
constexpr size_t WS_END = 512 * MiB;
constexpr size_t WS_CONCAT = 224 * MiB;
constexpr size_t WS_X1B = 128 * MiB;
constexpr size_t WS_Q = 192 * MiB;
constexpr size_t WS_CO = 256 * MiB;
constexpr size_t WS_P = 320 * MiB;
constexpr size_t WS_X2B = 128 * MiB;
constexpr size_t WS_H = 192 * MiB;
constexpr size_t OUT_SLAB = 0, OUT_CST = 64 * MiB;

constexpr int LDS_BYTES = 147456;
constexpr int NTHREADS = 512;

#define GAS __attribute__((address_space(1)))
#define LAS __attribute__((address_space(3)))
typedef unsigned short bf16;
typedef unsigned v4u __attribute__((ext_vector_type(4)));
typedef unsigned v2u __attribute__((ext_vector_type(2)));
typedef float v4f __attribute__((ext_vector_type(4)));
typedef short v8s __attribute__((ext_vector_type(8)));
typedef short v4s __attribute__((ext_vector_type(4)));
#define LDS_WAIT() asm volatile("s_waitcnt lgkmcnt(0)" ::: "memory")
#define VM_WAIT() asm volatile("s_waitcnt vmcnt(0)" ::: "memory")
__device__ __forceinline__ unsigned f2bf(float f) { unsigned u = __builtin_bit_cast(unsigned, f); return (u + 0x7fffu + ((u >> 16) & 1u)) >> 16; }
__device__ __forceinline__ unsigned pk2(float lo, float hi) { return f2bf(lo) | (f2bf(hi) << 16); }
__device__ __forceinline__ float bf2f(unsigned h) { return __builtin_bit_cast(float, h << 16); }
__device__ __forceinline__ float bflo(unsigned w) { return __builtin_bit_cast(float, w << 16); }
__device__ __forceinline__ float bfhi(unsigned w) { return __builtin_bit_cast(float, w & 0xffff0000u); }
__device__ __forceinline__ float wave_sum(float v) {
#pragma unroll
    for (int o = 1; o < 64; o <<= 1) v += __shfl_xor(v, o);
    return v;
}
__device__ __forceinline__ float logsigmoidf(float x) { return x >= 0.f ? -log1pf(__expf(-x)) : x - log1pf(__expf(x)); }
__device__ __forceinline__ float sigmoidf_(float x) { return 1.f / (1.f + __expf(-x)); }
#define MK_PER_PHASE 0
namespace pg8 {
#define PG8_LAS __attribute__((address_space(3)))
typedef unsigned short bf16_t;
typedef short bf16x8 __attribute__((ext_vector_type(8)));
typedef float f32x4 __attribute__((ext_vector_type(4)));
typedef float f32x2 __attribute__((ext_vector_type(2)));
typedef unsigned u32x4 __attribute__((ext_vector_type(4)));
typedef unsigned u32x2 __attribute__((ext_vector_type(2)));
constexpr int BM = 256, BK = 64, HALF = 128, HTB = HALF * BK * 2, STAGE_BYTES = 8 * HTB, NXCD = 8, WGM = 8;

__host__ __device__ __forceinline__ int lds_byte(int r, int c) { const int st = (r >> 4) * 2 + (c >> 5), rr = r & 15, cc = c & 31, ob = rr * 64 + cc * 2; return st * 1024 + (ob ^ (((ob >> 9) & 1) << 5)); }
__host__ __device__ __forceinline__ void stage_rc(int b, int& R, int& C) { const int st = b / 1024, sb = b % 1024, swz = sb ^ (((sb >> 9) & 1) << 5); R = (st >> 1) * 16 + swz / 64; C = (st & 1) * 32 + (swz % 64) / 2; }
__host__ __device__ __forceinline__ int perm32(int rho) { const int n = rho >> 4, i = rho & 15; return 8 * (i >> 2) + 4 * n + (i & 3); }

struct Unit { int row0, col0; long aoff, boff; int aux; };
struct Gemm { const bf16_t* A; const bf16_t* Bt; int lda, ldb, K; };

struct StdOrder {
    int nM, nN, nwg, G, c, lda, ldb, rsh;
    __device__ void init(int M, int N, int lda_, int ldb_, int G_, int c_, int rsh_ = 0) { nM = M / BM; nN = N / BM; nwg = nM * nN; G = G_; c = c_; lda = lda_; ldb = ldb_; rsh = rsh_; }
    __device__ bool next(int i, Unit& u) const {
        const long L = (long)(i >> rsh) * G + c; if (L >= nwg) return false;
        int wgid = (int)L; { const int q = nwg / NXCD, r = nwg % NXCD, xcd = wgid % NXCD, off = wgid / NXCD; wgid = (xcd < r ? xcd * (q + 1) : r * (q + 1) + (xcd - r) * q) + off; }
        const int nig = WGM * nN, gid = wgid / nig, fm = gid * WGM, gsz = (nM - fm) < WGM ? (nM - fm) : WGM;
        const int pm = fm + ((wgid % nig) % gsz), pn = (wgid % nig) / gsz;
        u.row0 = pm * BM; u.col0 = pn * BM; u.aoff = (long)pm * BM * lda; u.boff = (long)pn * BM * ldb; u.aux = i & rsh; return true;
    }
};

__device__ __forceinline__ unsigned cvt_pk_bf16(float lo, float hi) { unsigned r; asm volatile("v_cvt_pk_bf16_f32 %0, %1, %2" : "=v"(r) : "v"(lo), "v"(hi)); return r; }

template <class Epi, class Sched, bool ALIGN_EPI>
__device__ __forceinline__ void gemm_phase(PG8_LAS unsigned char* lds, const Gemm g, const Sched& S, const Epi& E) {
    const int tid = threadIdx.x, wid = __builtin_amdgcn_readfirstlane(tid >> 6), lane = tid & 63, wr = wid >> 2, wc = wid & 3, fr = lane & 15, fq = lane >> 4;
    const int K = g.K, nt = K / BK;
    unsigned voffA[2], voffB[2];
#pragma unroll
    for (int i = 0; i < 2; ++i) { int R, C; stage_rc(tid * 16 + i * 8192, R, C); const int Rb = Epi::PERM ? ((R & ~31) + perm32(R & 31)) : R;
        voffA[i] = (unsigned)(R * g.lda + C) * 2u; voffB[i] = (unsigned)(Rb * g.ldb + C) * 2u; }
    const size_t kstep = (size_t)(BK * 2);
    const size_t hA = (size_t)HALF * g.lda * 2, hB = (size_t)HALF * g.ldb * 2;
    const unsigned ldsw = (unsigned)wid * 1024u;
    const int aoff = lds_byte(wr * 64 + fr, fq * 8), boff = lds_byte(wc * 32 + fr, fq * 8);
#define PG8_SA(b, h) (((b) * 2 + (h)) * HTB)
#define PG8_SB(b, h) ((4 + (b) * 2 + (h)) * HTB)
#define PG8_STAGE(bufoff, gbase, voff) do { _Pragma("unroll") for (int _i = 0; _i < 2; ++_i) \
        __builtin_amdgcn_global_load_lds((const unsigned*)((const char*)(gbase) + (voff)[_i]), (PG8_LAS unsigned*)(lds + (bufoff) + ldsw + _i * 8192), 16, 0, 0); } while (0)
#define PG8_LDA(dst, b, h) do { _Pragma("unroll") for (int m = 0; m < 4; ++m) _Pragma("unroll") for (int k = 0; k < 2; ++k) dst[m][k] = *(const PG8_LAS bf16x8*)(lds + PG8_SA(b, h) + aoff + m * 2048 + k * 1024); } while (0)
#define PG8_LDB(dst, b, h) do { _Pragma("unroll") for (int n = 0; n < 2; ++n) _Pragma("unroll") for (int k = 0; k < 2; ++k) dst[n][k] = *(const PG8_LAS bf16x8*)(lds + PG8_SB(b, h) + boff + n * 2048 + k * 1024); } while (0)
#define PG8_MMA(ai, bj, At, Bt) do { __builtin_amdgcn_s_setprio(1); _Pragma("unroll") for (int m = 0; m < 4; ++m) _Pragma("unroll") for (int n = 0; n < 2; ++n) _Pragma("unroll") for (int k = 0; k < 2; ++k) \
        acc[ai][bj][m][n] = __builtin_amdgcn_mfma_f32_16x16x32_bf16(Bt[n][k], At[m][k], acc[ai][bj][m][n], 0, 0, 0); __builtin_amdgcn_s_setprio(0); } while (0)
#define PG8_WAIT_V(n) asm volatile("s_waitcnt vmcnt(" #n ")" ::: "memory")
#define PG8_WAIT_L(n) asm volatile("s_waitcnt lgkmcnt(" #n ")" ::: "memory")
#define PG8_BAR __builtin_amdgcn_s_barrier()
#define PG8_SCHED __builtin_amdgcn_sched_barrier(0)
    Unit cur, nxt; int ui = 0;
    if (!S.next(0, cur)) return;
    f32x4 acc[2][2][4][2];
#pragma unroll
    for (int a = 0; a < 2; ++a)
#pragma unroll
        for (int b = 0; b < 2; ++b)
#pragma unroll
            for (int m = 0; m < 4; ++m)
#pragma unroll
                for (int n = 0; n < 2; ++n) acc[a][b][m][n] = (f32x4){0.f, 0.f, 0.f, 0.f};
    bf16x8 At[4][2], B0[2][2], B1[2][2];
    const char* cA = (const char*)g.A + (size_t)cur.aoff * 2; const char* cB = (const char*)g.Bt + (size_t)cur.boff * 2;
    PG8_STAGE(PG8_SB(0, 0), cB, voffB); PG8_STAGE(PG8_SB(0, 1), cB + hB, voffB); PG8_STAGE(PG8_SA(0, 0), cA, voffA); PG8_STAGE(PG8_SA(0, 1), cA + hA, voffA);
    if (wr == 1) PG8_BAR;
    PG8_WAIT_V(2); PG8_BAR;
    PG8_STAGE(PG8_SB(1, 0), cB + kstep, voffB); PG8_STAGE(PG8_SA(1, 0), cA + kstep, voffA); PG8_STAGE(PG8_SB(1, 1), cB + hB + kstep, voffB);
    PG8_WAIT_V(6); PG8_BAR;
    for (;;) {
        const bool has_next = S.next(ui + 1, nxt);
        const char* nA = has_next ? (const char*)g.A + (size_t)nxt.aoff * 2 : cA; const char* nB = has_next ? (const char*)g.Bt + (size_t)nxt.boff * 2 : cB;
        for (int t = 0; t < nt; t += 2) {
            const bool last = (t == nt - 2);
            const char* a1 = cA + (size_t)(t + 1) * kstep;
            const char* a2 = last ? nA : cA + (size_t)(t + 2) * kstep; const char* b2 = last ? nB : cB + (size_t)(t + 2) * kstep;
            const char* a3 = a2 + kstep; const char* b3 = b2 + kstep;
            PG8_LDB(B0, 0, 0); PG8_LDB(B1, 0, 1); PG8_SCHED; PG8_LDA(At, 0, 0); PG8_STAGE(PG8_SA(1, 1), a1 + hA, voffA);
            PG8_WAIT_V(8); PG8_WAIT_L(0); PG8_BAR; PG8_MMA(0, 0, At, B0); PG8_MMA(0, 1, At, B1); PG8_BAR; PG8_SCHED;
            PG8_LDA(At, 0, 1); PG8_STAGE(PG8_SB(0, 0), b2, voffB); PG8_STAGE(PG8_SB(0, 1), b2 + hB, voffB); PG8_STAGE(PG8_SA(0, 0), a2, voffA);
            PG8_WAIT_V(8); PG8_WAIT_L(0); PG8_BAR; PG8_MMA(1, 0, At, B0); PG8_MMA(1, 1, At, B1); PG8_BAR; PG8_SCHED;
            PG8_LDB(B0, 1, 0); PG8_LDB(B1, 1, 1); PG8_SCHED; PG8_LDA(At, 1, 0); PG8_STAGE(PG8_SA(0, 1), a2 + hA, voffA);
            PG8_WAIT_V(8); PG8_WAIT_L(0); PG8_BAR; PG8_MMA(0, 0, At, B0); PG8_MMA(0, 1, At, B1); PG8_BAR; PG8_SCHED;
            PG8_LDA(At, 1, 1); PG8_STAGE(PG8_SB(1, 0), b3, voffB); PG8_STAGE(PG8_SB(1, 1), b3 + hB, voffB); PG8_STAGE(PG8_SA(1, 0), a3, voffA);
            PG8_WAIT_V(8); PG8_WAIT_L(0); PG8_BAR; PG8_MMA(1, 0, At, B0); PG8_MMA(1, 1, At, B1); PG8_BAR; PG8_SCHED;
        }
        if constexpr (ALIGN_EPI) { if (wr == 0) PG8_BAR; }
        if constexpr (!Epi::AFTER_DRAIN) { E(acc, cur, wr, wc, fr, fq); }
        if (!has_next) break;
#pragma unroll
        for (int a = 0; a < 2; ++a)
#pragma unroll
            for (int b = 0; b < 2; ++b)
#pragma unroll
                for (int m = 0; m < 4; ++m)
#pragma unroll
                    for (int n = 0; n < 2; ++n) acc[a][b][m][n] = (f32x4){0.f, 0.f, 0.f, 0.f};
        cur = nxt; cA = nA; cB = nB; ++ui;
        if constexpr (ALIGN_EPI) { if (wr == 1) PG8_BAR; }
    }
    PG8_WAIT_V(0);
    if constexpr (!ALIGN_EPI) { if (wr == 0) PG8_BAR; }
    PG8_BAR;
    if constexpr (Epi::AFTER_DRAIN) { E.fused(acc, cur, wr, wc, fr, fq, lds, wid, lane); }
#undef PG8_SA
#undef PG8_SB
#undef PG8_STAGE
#undef PG8_LDA
#undef PG8_LDB
#undef PG8_MMA
#undef PG8_WAIT_V
#undef PG8_WAIT_L
#undef PG8_BAR
#undef PG8_SCHED
}
}
namespace pg8 {
struct XkvOrder {
    int G, c;
    __device__ bool next(int i, Unit& u) const {
        const int L = i * G + c; if (L >= 256) return false;
        const int kq = L & 3, tile = L >> 2, pm = tile & 3, pn = tile >> 2;
        u.row0 = pm * 256; u.col0 = pn * 256; u.aoff = (long)pm * 256 * DM + kq * 512; u.boff = (long)pn * 256 * DM + kq * 512; u.aux = kq; return true;
    }
};
struct ScoreOrder {
    int G, c;
    __device__ bool next(int i, Unit& u) const {
        const int L = i * G + c; if (L >= 256) return false;
        const int b = L >> 6, h = (L >> 4) & 3, mt = L & 15;
        u.row0 = b * SEQ + mt * 256; u.col0 = h * 256; u.aoff = (long)u.row0 * DM + h * XD; u.boff = (long)(b * NMEM) * DM + h * XD; u.aux = h; return true;
    }
};
struct PvOrder {
    int G, c, rsh;
    __device__ bool next(int i, Unit& u) const {
        const int L = (i >> rsh) * G + c; if (L >= 512) return false;
        const int nt = L & 1, mt = (L >> 1) & 15, h = (L >> 5) & 3, b = L >> 7;
        u.row0 = b * SEQ + mt * 256; u.col0 = h * XD + nt * 256; u.aoff = (long)u.row0 * 1024 + h * 256; u.boff = ((long)(b * XH + h) * XD + nt * 256) * NMEM; u.aux = 0; return true;
    }
};

struct EpiStoreBf16 {
    static constexpr bool PERM = true, AFTER_DRAIN = false;
    bf16_t* O; int ldc; int split_cols; size_t split_stride;
    __device__ __forceinline__ void operator()(const f32x4 (&acc)[2][2][4][2], const Unit& u, int wr, int wc, int fr, int fq) const {
        int colt = u.col0; bf16_t* base = O;
        if (split_cols) { const int t = colt / split_cols; base += (size_t)t * split_stride; colt -= t * split_cols; }
        const int row0 = u.row0 + wr * 64 + fr, col0 = colt + wc * 32 + 8 * fq;
#pragma unroll
        for (int ai = 0; ai < 2; ++ai)
#pragma unroll
            for (int m = 0; m < 4; ++m) { bf16_t* rowp = base + (size_t)(row0 + ai * HALF + m * 16) * ldc + col0;
#pragma unroll
                for (int bj = 0; bj < 2; ++bj) { const f32x4 v0 = acc[ai][bj][m][0], v1 = acc[ai][bj][m][1];
                    u32x4 w; w.x = cvt_pk_bf16(v0[0], v0[1]); w.y = cvt_pk_bf16(v0[2], v0[3]); w.z = cvt_pk_bf16(v1[0], v1[1]); w.w = cvt_pk_bf16(v1[2], v1[3]);
                    *(u32x4*)(rowp + bj * HALF) = w; } }
    }
};
struct EpiSlab {
    static constexpr bool PERM = false, AFTER_DRAIN = false;
    float* slab; int ldc; size_t slab_stride;
    __device__ __forceinline__ void operator()(const f32x4 (&acc)[2][2][4][2], const Unit& u, int wr, int wc, int fr, int fq) const {
        float* base = slab + (size_t)u.aux * slab_stride; const int col0 = u.col0 + wc * 32 + 4 * fq;
#pragma unroll
        for (int ai = 0; ai < 2; ++ai)
#pragma unroll
            for (int m = 0; m < 4; ++m) { float* rowp = base + (size_t)(u.row0 + ai * HALF + wr * 64 + m * 16 + fr) * ldc + col0;
#pragma unroll
                for (int bj = 0; bj < 2; ++bj)
#pragma unroll
                    for (int n = 0; n < 2; ++n) *(f32x4*)(rowp + bj * HALF + n * 16) = acc[ai][bj][m][n]; }
    }
};
template <bool BASEF, bool OUTF>
struct EpiResid {
    static constexpr bool PERM = true, AFTER_DRAIN = false;
    const void* base; void* out; float* ssq; int ldc;
    __device__ __forceinline__ void operator()(const f32x4 (&acc)[2][2][4][2], const Unit& u, int wr, int wc, int fr, int fq) const {
        const int col0 = u.col0 + wc * 32 + 8 * fq;
        float ssum[2][4];
#pragma unroll
        for (int ai = 0; ai < 2; ++ai) {
            f32x4 bv[4][2][2];
#pragma unroll
            for (int m = 0; m < 4; ++m) { const size_t off = (size_t)(u.row0 + ai * HALF + wr * 64 + m * 16 + fr) * ldc + col0;
#pragma unroll
                for (int bj = 0; bj < 2; ++bj) {
                    if constexpr (BASEF) { bv[m][bj][0] = *(const f32x4*)((const float*)base + off + bj * HALF); bv[m][bj][1] = *(const f32x4*)((const float*)base + off + bj * HALF + 4); }
                    else { const u32x4 w = *(const u32x4*)((const bf16_t*)base + off + bj * HALF);
                        bv[m][bj][0] = (f32x4){__builtin_bit_cast(float, w.x << 16), __builtin_bit_cast(float, w.x & 0xffff0000u), __builtin_bit_cast(float, w.y << 16), __builtin_bit_cast(float, w.y & 0xffff0000u)};
                        bv[m][bj][1] = (f32x4){__builtin_bit_cast(float, w.z << 16), __builtin_bit_cast(float, w.z & 0xffff0000u), __builtin_bit_cast(float, w.w << 16), __builtin_bit_cast(float, w.w & 0xffff0000u)}; } } }
#pragma unroll
            for (int m = 0; m < 4; ++m) { const size_t off = (size_t)(u.row0 + ai * HALF + wr * 64 + m * 16 + fr) * ldc + col0; float s = 0.f;
#pragma unroll
                for (int bj = 0; bj < 2; ++bj) { const f32x4 v0 = bv[m][bj][0] + acc[ai][bj][m][0], v1 = bv[m][bj][1] + acc[ai][bj][m][1];
                    if constexpr (OUTF) { *(f32x4*)((float*)out + off + bj * HALF) = v0; *(f32x4*)((float*)out + off + bj * HALF + 4) = v1; }
                    else { u32x4 w; w.x = cvt_pk_bf16(v0[0], v0[1]); w.y = cvt_pk_bf16(v0[2], v0[3]); w.z = cvt_pk_bf16(v1[0], v1[1]); w.w = cvt_pk_bf16(v1[2], v1[3]);
                        *(u32x4*)((bf16_t*)out + off + bj * HALF) = w; }
                    s += (v0[0] * v0[0] + v0[1] * v0[1]) + (v0[2] * v0[2] + v0[3] * v0[3]) + (v1[0] * v1[0] + v1[1] * v1[1]) + (v1[2] * v1[2] + v1[3] * v1[3]); }
                s += __shfl_xor(s, 16); s += __shfl_xor(s, 32); ssum[ai][m] = s; } }
        if (ssq && u.aux == 0) {
#pragma unroll
            for (int ai = 0; ai < 2; ++ai) { const float v = fq == 0 ? ssum[ai][0] : fq == 1 ? ssum[ai][1] : fq == 2 ? ssum[ai][2] : ssum[ai][3];
                atomicAdd(ssq + u.row0 + ai * HALF + wr * 64 + fq * 16 + fr, v); }
        }
    }
};
struct EpiQ {
    static constexpr bool PERM = true, AFTER_DRAIN = false;
    bf16_t* O; const float* ssq_in; float* ssq_out;
    __device__ __forceinline__ void operator()(const f32x4 (&acc)[2][2][4][2], const Unit& u, int wr, int wc, int fr, int fq) const {
        const int col0 = u.col0 + wc * 32 + 8 * fq; float* so = ssq_out + (size_t)(u.col0 / XD) * MTOK;
        float ssum[2][4];
#pragma unroll
        for (int ai = 0; ai < 2; ++ai)
#pragma unroll
            for (int m = 0; m < 4; ++m) { const int row = u.row0 + ai * HALF + wr * 64 + m * 16 + fr; const float ri = __builtin_amdgcn_rsqf(ssq_in[row] * (1.0f / DM) + EPS);
                bf16_t* rowp = O + (size_t)row * DM + col0; float s = 0.f;
#pragma unroll
                for (int bj = 0; bj < 2; ++bj) { const f32x4 v0 = acc[ai][bj][m][0] * ri, v1 = acc[ai][bj][m][1] * ri;
                    u32x4 w; w.x = cvt_pk_bf16(v0[0], v0[1]); w.y = cvt_pk_bf16(v0[2], v0[3]); w.z = cvt_pk_bf16(v1[0], v1[1]); w.w = cvt_pk_bf16(v1[2], v1[3]);
                    *(u32x4*)(rowp + bj * HALF) = w;
                    s += (v0[0] * v0[0] + v0[1] * v0[1]) + (v0[2] * v0[2] + v0[3] * v0[3]) + (v1[0] * v1[0] + v1[1] * v1[1]) + (v1[2] * v1[2] + v1[3] * v1[3]); }
                s += __shfl_xor(s, 16); s += __shfl_xor(s, 32); ssum[ai][m] = s; }
        if (u.aux == 0)
#pragma unroll
        for (int ai = 0; ai < 2; ++ai) { const float v = fq == 0 ? ssum[ai][0] : fq == 1 ? ssum[ai][1] : fq == 2 ? ssum[ai][2] : ssum[ai][3];
            atomicAdd(so + u.row0 + ai * HALF + wr * 64 + fq * 16 + fr, v); }
    }
};
struct EpiUp {
    static constexpr bool PERM = true, AFTER_DRAIN = false;
    bf16_t* O; const float* ssq_in;
    __device__ __forceinline__ void operator()(const f32x4 (&acc)[2][2][4][2], const Unit& u, int wr, int wc, int fr, int fq) const {
        const int col0 = u.col0 + wc * 32 + 8 * fq;
#pragma unroll
        for (int ai = 0; ai < 2; ++ai)
#pragma unroll
            for (int m = 0; m < 4; ++m) { const int row = u.row0 + ai * HALF + wr * 64 + m * 16 + fr; const float ri = __builtin_amdgcn_rsqf(ssq_in[row] * (1.0f / DM) + EPS);
                bf16_t* rowp = O + (size_t)row * DFF + col0;
#pragma unroll
                for (int bj = 0; bj < 2; ++bj) { f32x4 v0 = acc[ai][bj][m][0] * ri, v1 = acc[ai][bj][m][1] * ri;
#pragma unroll
                    for (int e = 0; e < 4; ++e) { const float a = fmaxf(v0[e], 0.f), b = fmaxf(v1[e], 0.f); v0[e] = a * a; v1[e] = b * b; }
                    u32x4 w; w.x = cvt_pk_bf16(v0[0], v0[1]); w.y = cvt_pk_bf16(v0[2], v0[3]); w.z = cvt_pk_bf16(v1[0], v1[1]); w.w = cvt_pk_bf16(v1[2], v1[3]);
                    *(u32x4*)(rowp + bj * HALF) = w; } }
    }
};
struct EpiSoftmax {
    static constexpr bool PERM = true, AFTER_DRAIN = true;
    bf16_t* P; const float* ssqq;
    __device__ __forceinline__ void fused(f32x4 (&acc)[2][2][4][2], const Unit& u, int wr, int wc, int fr, int fq, PG8_LAS unsigned char* lds, int wid, int lane) const {
        PG8_LAS float* RM = (PG8_LAS float*)lds;
        PG8_LAS float* RS = (PG8_LAS float*)(lds + 4096);
        const float* sq = ssqq + (size_t)u.aux * MTOK;
        float mx[2][4];
#pragma unroll
        for (int ai = 0; ai < 2; ++ai)
#pragma unroll
            for (int m = 0; m < 4; ++m) { const int rl = ai * HALF + wr * 64 + m * 16 + fr; const int row = u.row0 + rl;
                const float sc = __builtin_amdgcn_rsqf(sq[row] * (1.0f / XD) + EPS) * (0.044194173824159216f * LOG2E);
                float mxx = -3.0e38f;
#pragma unroll
                for (int bj = 0; bj < 2; ++bj)
#pragma unroll
                    for (int n = 0; n < 2; ++n) { f32x4 v = acc[ai][bj][m][n] * sc; acc[ai][bj][m][n] = v; mxx = fmaxf(mxx, fmaxf(fmaxf(v[0], v[1]), fmaxf(v[2], v[3]))); }
                mxx = fmaxf(mxx, __shfl_xor(mxx, 16)); mxx = fmaxf(mxx, __shfl_xor(mxx, 32));
                if (fq == 0) RM[rl * 4 + wc] = mxx; }
        asm volatile("s_waitcnt lgkmcnt(0)" ::: "memory"); __builtin_amdgcn_s_barrier(); asm volatile("" ::: "memory");
#pragma unroll
        for (int ai = 0; ai < 2; ++ai)
#pragma unroll
            for (int m = 0; m < 4; ++m) { const int rl = ai * HALF + wr * 64 + m * 16 + fr;
                const f32x4 r4 = *(const PG8_LAS f32x4*)(RM + rl * 4); const float mxx = fmaxf(fmaxf(r4[0], r4[1]), fmaxf(r4[2], r4[3])); mx[ai][m] = mxx; float s = 0.f;
#pragma unroll
                for (int bj = 0; bj < 2; ++bj)
#pragma unroll
                    for (int n = 0; n < 2; ++n) { f32x4 v = acc[ai][bj][m][n];
#pragma unroll
                        for (int e = 0; e < 4; ++e) { v[e] = __builtin_amdgcn_exp2f(v[e] - mxx); s += v[e]; }
                        acc[ai][bj][m][n] = v; }
                s += __shfl_xor(s, 16); s += __shfl_xor(s, 32);
                if (fq == 0) RS[rl * 4 + wc] = s; }
        asm volatile("s_waitcnt lgkmcnt(0)" ::: "memory"); __builtin_amdgcn_s_barrier(); asm volatile("" ::: "memory");
        const int col0 = u.col0 + wc * 32 + 8 * fq;
#pragma unroll
        for (int ai = 0; ai < 2; ++ai)
#pragma unroll
            for (int m = 0; m < 4; ++m) { const int rl = ai * HALF + wr * 64 + m * 16 + fr;
                const f32x4 r4 = *(const PG8_LAS f32x4*)(RS + rl * 4); const float inv = 1.0f / ((r4[0] + r4[1]) + (r4[2] + r4[3]));
                bf16_t* rowp = P + (size_t)(u.row0 + rl) * 1024 + col0;
#pragma unroll
                for (int bj = 0; bj < 2; ++bj) { const f32x4 v0 = acc[ai][bj][m][0] * inv, v1 = acc[ai][bj][m][1] * inv;
                    u32x4 w; w.x = cvt_pk_bf16(v0[0], v0[1]); w.y = cvt_pk_bf16(v0[2], v0[3]); w.z = cvt_pk_bf16(v1[0], v1[1]); w.w = cvt_pk_bf16(v1[2], v1[3]);
                    *(u32x4*)(rowp + bj * HALF) = w; } }
        (void)mx; (void)wid; (void)lane;
    }
};
}
namespace fox {
typedef short bf16x8 __attribute__((ext_vector_type(8)));
typedef short s16x4 __attribute__((ext_vector_type(4)));
typedef float f32x16 __attribute__((ext_vector_type(16)));
typedef float f32x4 __attribute__((ext_vector_type(4)));
typedef unsigned u32x4 __attribute__((ext_vector_type(4)));
constexpr int D = 128, PITCH = 1024, OPITCH = 2048;
constexpr int NW = 8, QBLK = 32, KVBLK = 64, QB = NW * QBLK;
constexpr int SHM_V = KVBLK * D * 2, SHM_K = KVBLK * D * 2;
constexpr int LDS_BIAS = 0, LDS_WS = 512, LDS_V = 4096, LDS_K = LDS_V + 2 * SHM_V, LDS_Q = LDS_K + 2 * SHM_K, LDS_BYTES = LDS_Q + NW * 8192;
constexpr float SCALE = 0.08838834764831845f, C2 = LOG2E * SCALE, THR = 8.f;

#define KSWZ(row, colB) ((row) * 256 + ((colB) ^ (((row) & 7) << 4)))
#define SBAR() __builtin_amdgcn_sched_barrier(0)
__device__ __forceinline__ int v_st(int k, int c) { const int kk = (k & ~0xC) | ((k & 4) << 1) | ((k & 8) >> 1); return ((kk >> 3) * 4 + (c >> 5)) * 512 + ((kk & 7) * 32 + (c & 31)) * 2; }
__device__ __forceinline__ int v_rd_base(int lane) { return ((lane & 3) << 3) | (((lane >> 2) & 3) << 6) | (((lane >> 4) & 1) << 5) | (((lane >> 5) & 1) << 8); }
constexpr int v_rd_off(int d0, int ks, int half) { return d0 * 512 + ks * 4096 + half * 2048; }
__device__ __forceinline__ int crow(int r, int hi) { return (r & 3) + 8 * (r >> 2) + 4 * hi; }
__device__ __forceinline__ unsigned cvtpk(float lo, float hi) { unsigned r; asm volatile("v_cvt_pk_bf16_f32 %0, %1, %2" : "=v"(r) : "v"(lo), "v"(hi)); return r; }
__device__ __forceinline__ bf16x8 load8(const bf16* p) { return *reinterpret_cast<const bf16x8*>(p); }

__device__ __forceinline__ void mask_tile(f32x16& p0, f32x16& p1, int dq) {
    const float NEG = -__builtin_inff();
#pragma unroll
    for (int r = 0; r < 16; ++r) { const int c = (r & 3) + 8 * (r >> 2);
        if (dq - c < 0) p0[r] = NEG;
        if (dq - c - 32 < 0) p1[r] = NEG; }
}
__device__ __forceinline__ void partialSM(f32x16& p0, f32x16& p1, float& m_reg, float& mn, float& alpha) {
    float pmax = p0[0];
#pragma unroll
    for (int r = 1; r < 16; ++r) pmax = fmaxf(pmax, p0[r]);
#pragma unroll
    for (int r = 0; r < 16; ++r) pmax = fmaxf(pmax, p1[r]);
    { auto rr = __builtin_amdgcn_permlane32_swap(__float_as_uint(pmax), __float_as_uint(pmax), false, false);
      pmax = fmaxf(__uint_as_float(rr[0]), __uint_as_float(rr[1])); }
    if (__builtin_expect(__all((pmax - m_reg) * SCALE <= THR), 1)) { mn = m_reg; alpha = 1.f; }
    else { mn = fmaxf(m_reg, pmax); alpha = __builtin_amdgcn_exp2f((m_reg - mn) * C2); m_reg = mn; }
    const float mnL = -mn * C2;
#pragma unroll
    for (int r = 0; r < 16; ++r) p0[r] = fmaf(p0[r], C2, mnL);
#pragma unroll
    for (int r = 0; r < 16; ++r) p1[r] = fmaf(p1[r], C2, mnL);
#pragma unroll
    for (int r = 0; r < 16; ++r) p0[r] = __builtin_amdgcn_exp2f(p0[r]);
}
__device__ __forceinline__ void finishSM(f32x16& p0, f32x16& p1, float alpha, float& l_reg, bf16x8& pa0, bf16x8& pa1, bf16x8& pa2, bf16x8& pa3) {
#pragma unroll
    for (int r = 0; r < 16; ++r) p1[r] = __builtin_amdgcn_exp2f(p1[r]);
    float ps = 0;
#pragma unroll
    for (int r = 0; r < 16; ++r) ps += p0[r];
#pragma unroll
    for (int r = 0; r < 16; ++r) ps += p1[r];
    { auto rr = __builtin_amdgcn_permlane32_swap(__float_as_uint(ps), __float_as_uint(ps), false, false);
      ps = __uint_as_float(rr[0]) + __uint_as_float(rr[1]); }
    l_reg = l_reg * alpha + ps;
#define PK4(P, B_, OUT) do { unsigned a0 = cvtpk(P[B_+0], P[B_+1]), a1 = cvtpk(P[B_+2], P[B_+3]);                          \
        unsigned b0 = cvtpk(P[B_+4], P[B_+5]), b1 = cvtpk(P[B_+6], P[B_+7]);                                             \
        auto r0 = __builtin_amdgcn_permlane32_swap(a0, b0, false, false); auto r1 = __builtin_amdgcn_permlane32_swap(a1, b1, false, false); \
        u32x4 w = {r0[0], r1[0], r0[1], r1[1]}; OUT = *reinterpret_cast<bf16x8*>(&w); } while (0)
    PK4(p0, 0, pa0); PK4(p0, 8, pa1); PK4(p1, 0, pa2); PK4(p1, 8, pa3);
#undef PK4
}
template <int KB>
__device__ __forceinline__ void qkt(f32x16& p0, f32x16& p1, const char* K_lds, const float* bl, int r32, int hi, const char* qw) {
#pragma unroll
    for (int g = 0; g < 4; ++g) { const f32x4 b0 = *(const f32x4*)(bl + KB * 64 + 8 * g + 4 * hi), b1 = *(const f32x4*)(bl + KB * 64 + 32 + 8 * g + 4 * hi);
#pragma unroll
        for (int i = 0; i < 4; ++i) { p0[4 * g + i] = b0[i]; p1[4 * g + i] = b1[i]; } }
    const char* kb[4];
#pragma unroll
    for (int dd = 0; dd < 4; ++dd) kb[dd] = K_lds + KB * SHM_K + KSWZ(r32, (dd * 16 + hi * 8) * 2);
#pragma unroll
    for (int d0 = 0; d0 < 8; ++d0) { const char* a = kb[d0 & 3] + (d0 >> 2) * 128;
        bf16x8 b0 = *reinterpret_cast<const bf16x8*>(a);
        bf16x8 b1 = *reinterpret_cast<const bf16x8*>(a + 32 * 256);
        const bf16x8 qf = *reinterpret_cast<const bf16x8*>(qw + d0 * 1024);
        p0 = __builtin_amdgcn_mfma_f32_32x32x16_bf16(b0, qf, p0, 0, 0, 0);
        p1 = __builtin_amdgcn_mfma_f32_32x32x16_bf16(b1, qf, p1, 0, 0, 0); }
}
template <int VB>
__device__ __forceinline__ void pv_tile(f32x16* o, int vb0, bf16x8 pa0, bf16x8 pa1, bf16x8 pa2, bf16x8 pa3) {
#define TRRD(dst, off) asm volatile("ds_read_b64_tr_b16 %0, %1 offset:%2" : "=&v"(dst) : "v"(vb0), "i"(off) : "memory")
#define PV_D0(d0) do { s16x4 l0, l1, l2, l3, h0, h1, h2, h3; constexpr int b_ = VB * SHM_V + v_rd_off(d0, 0, 0); \
        TRRD(l0, b_); TRRD(h0, b_ + 2048); TRRD(l1, b_ + 4096); TRRD(h1, b_ + 6144); TRRD(l2, b_ + 8192); TRRD(h2, b_ + 10240); TRRD(l3, b_ + 12288); TRRD(h3, b_ + 14336); \
        asm volatile("s_waitcnt lgkmcnt(0)" ::: "memory"); SBAR();   \
        o[d0] = __builtin_amdgcn_mfma_f32_32x32x16_bf16(pa0, (bf16x8){l0[0], l0[1], l0[2], l0[3], h0[0], h0[1], h0[2], h0[3]}, o[d0], 0, 0, 0);   \
        o[d0] = __builtin_amdgcn_mfma_f32_32x32x16_bf16(pa1, (bf16x8){l1[0], l1[1], l1[2], l1[3], h1[0], h1[1], h1[2], h1[3]}, o[d0], 0, 0, 0);   \
        o[d0] = __builtin_amdgcn_mfma_f32_32x32x16_bf16(pa2, (bf16x8){l2[0], l2[1], l2[2], l2[3], h2[0], h2[1], h2[2], h2[3]}, o[d0], 0, 0, 0);   \
        o[d0] = __builtin_amdgcn_mfma_f32_32x32x16_bf16(pa3, (bf16x8){l3[0], l3[1], l3[2], l3[3], h3[0], h3[1], h3[2], h3[3]}, o[d0], 0, 0, 0); } while (0)
    PV_D0(0); PV_D0(1); PV_D0(2); PV_D0(3);
#undef PV_D0
#undef TRRD
}

struct HeadRef { unsigned rowb, o; const float* CS; const float* G; };
struct Seam { bf16x8 qr[8]; bf16x8 st_v0, st_v1, st_k0, st_k1; };
typedef __amdgpu_buffer_rsrc_t Srd;
#define BL8(rs, vo, so) __builtin_bit_cast(bf16x8, __builtin_amdgcn_raw_buffer_load_b128((rs), (vo), (so), 0))
#define VMW() asm volatile("s_waitcnt vmcnt(0)" ::: "memory")
#define VMWN(n) asm volatile("s_waitcnt vmcnt(%0)" :: "i"(n) : "memory")
#define SLOAD_H(k0, bb) do { const unsigned so_ = (unsigned)(k0) * (PITCH * 2);                                               \
                         S.st_v0 = BL8(R, kvoff, (unsigned)WS_FV + H.rowb + so_); S.st_v1 = BL8(R, kvoff, (unsigned)WS_FV + H.rowb + so_ + 32 * PITCH * 2);   \
                         S.st_k0 = BL8(R, kvoff, (unsigned)WS_FK + H.rowb + so_); S.st_k1 = BL8(R, kvoff, (unsigned)WS_FK + H.rowb + so_ + 32 * PITCH * 2);   \
                         if (wid == 0) __builtin_amdgcn_global_load_lds((const unsigned*)(H.CS + (k0)) + lane, (__attribute__((address_space(3))) unsigned*)(B3 + (bb) * 64), 4, 0, 0); } while (0)
#define QLOAD(p0_) do { const unsigned so_ = (unsigned)((p0_) + wid * QBLK) * (PITCH * 2);                                   \
        _Pragma("unroll") for (int d0 = 0; d0 < 8; ++d0) S.qr[d0] = BL8(R, qoff + d0 * 32, (unsigned)WS_FQ + H.rowb + so_); } while (0)
#define SWRITE_HK(bf) do { *(bf16x8*)(K_lds + (bf) * SHM_K + kws) = S.st_k0; *(bf16x8*)(K_lds + (bf) * SHM_K + kws + 32 * 256) = S.st_k1; } while (0)
#define SWRITE_HV(bf) do { *(bf16x8*)(V_lds + (bf) * SHM_V + vst0) = S.st_v0; *(bf16x8*)(V_lds + (bf) * SHM_V + vst1) = S.st_v1; } while (0)
#define SWRITE_H(bf) do { SWRITE_HV(bf); SWRITE_HK(bf); } while (0)

__device__ __forceinline__ void fox_prime(const Srd R, const HeadRef& H, int P0, char* lds, Seam& S) {
    const int tid = threadIdx.x, wid = __builtin_amdgcn_readfirstlane(tid >> 6), lane = tid & 63, r32 = lane & 31, hi = lane >> 5;
    const int sr = tid >> 4, sc = (tid & 15) * 8, kws = KSWZ(sr, sc * 2); char* K_lds = lds + LDS_K; float* B_lds = (float*)(lds + LDS_BIAS);
    const unsigned kvoff = (unsigned)(sr * PITCH + sc) * 2u, qoff = (unsigned)(r32 * PITCH + hi * 8) * 2u;
    __attribute__((address_space(3))) float* B3 = (__attribute__((address_space(3))) float*)B_lds;
    QLOAD(P0);
    SLOAD_H(0, 0); VMW(); SWRITE_HK(0);
    { char* qw = lds + LDS_Q + wid * 8192 + lane * 16;
#pragma unroll
      for (int d0 = 0; d0 < 8; ++d0) *(bf16x8*)(qw + d0 * 1024) = S.qr[d0]; }
    __syncthreads();
}
__device__ __forceinline__ void fox_block(const Srd R, const HeadRef& H, int P0, int P0n, char* lds, Seam& S) {
    const int tid = threadIdx.x, wid = __builtin_amdgcn_readfirstlane(tid >> 6), lane = tid & 63, r32 = lane & 31, hi = lane >> 5;
    const int NT = P0 / KVBLK + 4;
    const int qlo = P0 + wid * QBLK, qm = qlo + r32 - 4 * hi;
    char* V_lds = lds + LDS_V; char* K_lds = lds + LDS_K; float* B_lds = (float*)(lds + LDS_BIAS);
    char* qw = lds + LDS_Q + wid * 8192 + lane * 16;
    float* ws = (float*)(lds + LDS_WS) + wid * 64; float* li_l = ws, * al_l = ws + 32;
    float m_reg = -1e30f, l_reg = 0; f32x16 o[4] = {};
    const int sr = tid >> 4, sc = (tid & 15) * 8, vst0 = v_st(sr, sc), vst1 = v_st(32 + sr, sc), kws = KSWZ(sr, sc * 2);
    const int vb0 = (int)(uintptr_t)V_lds + v_rd_base(lane);
    const unsigned kvoff = (unsigned)(sr * PITCH + sc) * 2u, qoff = (unsigned)(r32 * PITCH + hi * 8) * 2u;
    __attribute__((address_space(3))) float* B3 = (__attribute__((address_space(3))) float*)B_lds;
#define RESC(a) do { if (__any((a) < 1.f)) { if (hi == 0) al_l[r32] = (a); asm volatile("s_waitcnt lgkmcnt(0)" ::: "memory");              \
                     for (int d_ = 0; d_ < 4; ++d_) for (int r = 0; r < 16; ++r) o[d_][r] *= al_l[crow(r, hi)]; } } while (0)
#define KBASE(t) ((t) * KVBLK)
#define MASKT(P0_, P1_, t) do { const int kb_ = KBASE(t); if (kb_ + KVBLK - 1 > qlo) mask_tile(P0_, P1_, qm - kb_); } while (0)
    f32x16 pA0, pA1, pB0, pB1; float mnA, mnB, alA, alB; bf16x8 pa0, pa1, pa2, pa3;
    SWRITE_HV(0); SBAR();
    SLOAD_H(KBASE(1), 1);
    SBAR(); qkt<0>(pA0, pA1, K_lds, B_lds, r32, hi, qw);
    MASKT(pA0, pA1, 0); partialSM(pA0, pA1, m_reg, mnA, alA);
    VMW(); SWRITE_H(1);
    __syncthreads();
#define HALF_STEP(PX0, PX1, mnX, alX, PY0, PY1, alY, t, KB, VB, SB) do {                                                      \
        SBAR(); qkt<KB>(PX0, PX1, K_lds, B_lds, r32, hi, qw);                                                                 \
        finishSM(PY0, PY1, alY, l_reg, pa0, pa1, pa2, pa3); SBAR();                                                           \
        if ((t) + 1 < NT) { SLOAD_H(KBASE((t) + 1), SB); SBAR(); }                                                                \
        pv_tile<VB>(o, vb0, pa0, pa1, pa2, pa3); MASKT(PX0, PX1, (t)); partialSM(PX0, PX1, m_reg, mnX, alX);                  \
        __syncthreads();                                                                                                      \
        if ((t) + 1 < NT) { VMW(); SWRITE_H(SB); }                                                                      \
        RESC(alX); __syncthreads(); } while (0)
    for (int t = 1; t + 1 < NT; t += 2) {
        HALF_STEP(pB0, pB1, mnB, alB, pA0, pA1, alA, t, 1, 0, 0);
        HALF_STEP(pA0, pA1, mnA, alA, pB0, pB1, alB, t + 1, 0, 1, 1);
    }
    SBAR(); qkt<1>(pB0, pB1, K_lds, B_lds, r32, hi, qw); SBAR();
    SLOAD_H(0, 0); SBAR();
    QLOAD(P0n);
    SBAR();
    finishSM(pA0, pA1, alA, l_reg, pa0, pa1, pa2, pa3); SBAR();
    pv_tile<0>(o, vb0, pa0, pa1, pa2, pa3);
    MASKT(pB0, pB1, NT - 1); partialSM(pB0, pB1, m_reg, mnB, alB); __syncthreads(); RESC(alB);
    finishSM(pB0, pB1, alB, l_reg, pa0, pa1, pa2, pa3); SBAR(); pv_tile<1>(o, vb0, pa0, pa1, pa2, pa3);
    SBAR(); VMWN(8); SWRITE_HK(0); SBAR();
    if (hi == 0) li_l[r32] = l_reg; asm volatile("s_waitcnt lgkmcnt(0)" ::: "memory");
    float gn[4];
#pragma unroll
    for (int d0 = 0; d0 < 4; ++d0) gn[d0] = H.G[d0 * 32 + r32];
    const unsigned ovoff = (unsigned)(4 * hi * OPITCH + r32) * 2u;
#pragma unroll
    for (int r = 0; r < 16; ++r) { const float rli = __builtin_amdgcn_rcpf(li_l[crow(r, hi)]); float ss = 0.f;
#pragma unroll
        for (int d0 = 0; d0 < 4; ++d0) { o[d0][r] *= rli; ss += o[d0][r] * o[d0][r]; }
        ss += __shfl_xor(ss, 1); ss += __shfl_xor(ss, 2); ss += __shfl_xor(ss, 4); ss += __shfl_xor(ss, 8); ss += __shfl_xor(ss, 16);
        const float rs = __builtin_amdgcn_rsqf(ss * (1.0f / D) + EPS);
        const unsigned so_ = (unsigned)(P0 + wid * QBLK + (r & 3) + 8 * (r >> 2)) * (OPITCH * 2);
#pragma unroll
        for (int d0 = 0; d0 < 4; ++d0) { const float v = o[d0][r] * rs * gn[d0];
            const float vn = __shfl_xor(v, 1);
            if ((r32 & 1) == 0) __builtin_amdgcn_raw_buffer_store_b32(cvtpk(v, vn), R, ovoff + d0 * 64, H.o + so_, 0); } }
#pragma unroll
    for (int d0 = 0; d0 < 8; ++d0) *(bf16x8*)(qw + d0 * 1024) = S.qr[d0];
    __syncthreads();
#undef RESC
#undef KBASE
#undef MASKT
#undef HALF_STEP
}
#undef BL8
#undef QLOAD
#undef VMW
#undef VMWN
#undef SLOAD_H
#undef SWRITE_HK
#undef SWRITE_HV
#undef SWRITE_H
#undef KSWZ
#undef SBAR
}
namespace mls {
typedef short bf16x8 __attribute__((ext_vector_type(8)));
typedef short bf16x4 __attribute__((ext_vector_type(4)));
typedef float f32x4 __attribute__((ext_vector_type(4)));
#define MFMA16(a, b, c) __builtin_amdgcn_mfma_f32_16x16x32_bf16((a), (b), (c), 0, 0, 0)

__device__ __forceinline__ void chunk_out(int b, int h, int c, const bf16* QP, const bf16* KPP, const bf16* VT, const bf16* CST, const float* NST,
                                          const bf16* MO, const float* gain, bf16* concat, float* xch  ) {
    const int tid = threadIdx.x, w = __builtin_amdgcn_readfirstlane(tid >> 6), lane = tid & 63, i16 = lane & 15, q = lane >> 4;
    const int tq = w & 3, dvh = w >> 2;
    const size_t R0 = (size_t)b * SEQ + (size_t)c * 64;
    const size_t item = ((size_t)(b * MLH + h) * NCHUNK + c);
    const bf16* qrow = QP + (R0 + 16 * tq + i16) * 512 + h * MLDK + 8 * q;
    bf16x8 qf[4];
#pragma unroll
    for (int ks = 0; ks < 4; ++ks) qf[ks] = *(const bf16x8*)(qrow + 32 * ks);
    f32x4 st[4];
#pragma unroll
    for (int stile = 0; stile < 4; ++stile) {
        st[stile] = (f32x4){0.f, 0.f, 0.f, 0.f};
        if (stile <= tq) {
            const bf16* krow = KPP + (R0 + 16 * stile + i16) * 512 + h * MLDK + 8 * q;
            bf16x8 kf[4];
#pragma unroll
            for (int ks = 0; ks < 4; ++ks) kf[ks] = *(const bf16x8*)(krow + 32 * ks);
#pragma unroll
            for (int ks = 0; ks < 4; ++ks) st[stile] = MFMA16(kf[ks], qf[ks], st[stile]);
            if (stile == tq) {
#pragma unroll
                for (int r = 0; r < 4; ++r) if (4 * q + r > i16) st[stile][r] = 0.f;
            }
        }
    }
    float den = 0.f;
#pragma unroll
    for (int stile = 0; stile < 4; ++stile) den += (st[stile][0] + st[stile][1]) + (st[stile][2] + st[stile][3]);
    { const float* nrow = NST + item * MLDK + 8 * q;
#pragma unroll
      for (int ks = 0; ks < 4; ++ks) { const f32x4 n0 = *(const f32x4*)(nrow + 32 * ks), n1 = *(const f32x4*)(nrow + 32 * ks + 4);
          const v4u qq = __builtin_bit_cast(v4u, qf[ks]);
          den += bflo(qq[0]) * n0[0] + bfhi(qq[0]) * n0[1] + bflo(qq[1]) * n0[2] + bfhi(qq[1]) * n0[3]
               + bflo(qq[2]) * n1[0] + bfhi(qq[2]) * n1[1] + bflo(qq[3]) * n1[2] + bfhi(qq[3]) * n1[3]; } }
    den += __shfl_xor(den, 16); den += __shfl_xor(den, 32);
    bf16x8 pf[2];
#pragma unroll
    for (int p = 0; p < 2; ++p) { v4u wv; wv[0] = pg8::cvt_pk_bf16(st[2 * p][0], st[2 * p][1]); wv[1] = pg8::cvt_pk_bf16(st[2 * p][2], st[2 * p][3]);
        wv[2] = pg8::cvt_pk_bf16(st[2 * p + 1][0], st[2 * p + 1][1]); wv[3] = pg8::cvt_pk_bf16(st[2 * p + 1][2], st[2 * p + 1][3]); pf[p] = __builtin_bit_cast(bf16x8, wv); }
    const int npair = (tq >> 1) + 1;
    f32x4 num[8];
    const bf16* vbase = VT + (item * MLDV + dvh * 128 + i16) * 64 + 4 * q;
    const bf16* cbase = CST + (item * MLDV + dvh * 128 + i16) * MLDK + 8 * q;
#pragma unroll
    for (int dt = 0; dt < 8; ++dt) {
        f32x4 a = (f32x4){0.f, 0.f, 0.f, 0.f};
        const bf16* vrow = vbase + (size_t)dt * 16 * 64; const bf16* crowp = cbase + (size_t)dt * 16 * MLDK;
#pragma unroll
        for (int p = 0; p < 2; ++p) if (p < npair) {
            const v2u lo = *(const v2u*)(vrow + 32 * p), hi2 = *(const v2u*)(vrow + 32 * p + 16);
            const v4u vv = {lo[0], lo[1], hi2[0], hi2[1]};
            a = MFMA16(__builtin_bit_cast(bf16x8, vv), pf[p], a); }
#pragma unroll
        for (int ks = 0; ks < 4; ++ks) { const bf16x8 cf = *(const bf16x8*)(crowp + 32 * ks); a = MFMA16(cf, qf[ks], a); }
        num[dt] = a;
    }
    const float rden = 1.0f / fmaxf(fabsf(den), 1.0f);
    float ss = 0.f;
#pragma unroll
    for (int dt = 0; dt < 8; ++dt) { num[dt] = num[dt] * rden; ss += (num[dt][0] * num[dt][0] + num[dt][1] * num[dt][1]) + (num[dt][2] * num[dt][2] + num[dt][3] * num[dt][3]); }
    ss += __shfl_xor(ss, 16); ss += __shfl_xor(ss, 32);
    if (q == 0) xch[w * 16 + i16] = ss;
    __syncthreads();
    const float tot = ss + xch[(w ^ 4) * 16 + i16];
    const float rn = __builtin_amdgcn_rsqf(tot * (1.0f / MLDV) + EPS);
    const size_t row = R0 + 16 * tq + i16; const int dv0 = h * MLDV + dvh * 128 + 4 * q;
#pragma unroll
    for (int dt = 0; dt < 8; ++dt) { const int dv = dv0 + 16 * dt;
        const f32x4 g4 = *(const f32x4*)(gain + dv); const v2u mo2 = *(const v2u*)(MO + row * 1024 + dv);
        const float o0 = num[dt][0] * rn * g4[0] * sigmoidf_(bflo(mo2[0])), o1 = num[dt][1] * rn * g4[1] * sigmoidf_(bfhi(mo2[0]));
        const float o2 = num[dt][2] * rn * g4[2] * sigmoidf_(bflo(mo2[1])), o3 = num[dt][3] * rn * g4[3] * sigmoidf_(bfhi(mo2[1]));
        v2u ov; ov[0] = pg8::cvt_pk_bf16(o0, o1); ov[1] = pg8::cvt_pk_bf16(o2, o3);
        *(v2u*)(concat + row * 2048 + 1024 + dv) = ov; }
    __syncthreads();
}

__device__ __forceinline__ void state_scan(int bh, int sl, const bf16* KT, const bf16* VT, const float* EB, bf16* CST) {
    const int tid = threadIdx.x, w = __builtin_amdgcn_readfirstlane(tid >> 6), lane = tid & 63, i16 = lane & 15, q = lane >> 4;
    const size_t it0 = (size_t)bh * NCHUNK;
    const bf16* ka = KT + (it0 * MLDK + 16 * w + i16) * 64 + 8 * q;
    const bf16* vb = VT + (it0 * MLDV + 16 * sl + i16) * 64 + 8 * q;
    bf16* cs = CST + (it0 * MLDV + 16 * sl + i16) * MLDK + 16 * w + 4 * q;
    const float ebv = EB[it0 + lane];
    f32x4 acc = (f32x4){0.f, 0.f, 0.f, 0.f};
    bf16x8 fa0[8], fa1[8], fb0[8], fb1[8];
#pragma unroll
    for (int j = 0; j < 8; ++j) { fa0[j] = *(const bf16x8*)(ka + (size_t)j * MLDK * 64); fa1[j] = *(const bf16x8*)(ka + (size_t)j * MLDK * 64 + 32);
                                  fb0[j] = *(const bf16x8*)(vb + (size_t)j * MLDV * 64); fb1[j] = *(const bf16x8*)(vb + (size_t)j * MLDV * 64 + 32); }
    for (int c0 = 0; c0 < NCHUNK; c0 += 8) {
#pragma unroll
        for (int j = 0; j < 8; ++j) { const int c = c0 + j;
            v2u ov; ov[0] = pg8::cvt_pk_bf16(acc[0], acc[1]); ov[1] = pg8::cvt_pk_bf16(acc[2], acc[3]);
            *(v2u*)(cs + (size_t)c * MLDV * MLDK) = ov;
            acc = MFMA16(fa0[j], fb0[j], acc); acc = MFMA16(fa1[j], fb1[j], acc);
            const int cn = c + 8 < NCHUNK ? c + 8 : c;
            fa0[j] = *(const bf16x8*)(ka + (size_t)cn * MLDK * 64); fa1[j] = *(const bf16x8*)(ka + (size_t)cn * MLDK * 64 + 32);
            fb0[j] = *(const bf16x8*)(vb + (size_t)cn * MLDV * 64); fb1[j] = *(const bf16x8*)(vb + (size_t)cn * MLDV * 64 + 32);
            const float e = __shfl(ebv, c);
            acc = acc * e; }
    }
}
#undef MFMA16
}
typedef const float* cfp_t;
struct Frame {
    LAS unsigned char* lds; unsigned char* ldsg;
    int tid, lane, wave, vcu, G;
    const __attribute__((address_space(4))) cfp_t* inp; float* out; unsigned char* ws;
};
__device__ __forceinline__ float wave_incl_scan(float v, int lane) {
#pragma unroll
    for (int o = 1; o < 64; o <<= 1) { const float t = __shfl_up(v, o); if (lane >= o) v += t; }
    return v;
}

__device__ __forceinline__ void p0_transpose_item(const float* W, int ldw, int K, bf16* WT, const float* gk, int k0, int n0_dst, int n0_src, LAS float* scr, int lane) {
    float vv[32];
#pragma unroll
    for (int i = 0; i < 32; ++i) { const int kk = 2 * i + (lane >> 5); vv[i] = W[(size_t)(k0 + kk) * ldw + n0_src + (lane & 31)]; }
    if (gk) {
#pragma unroll
        for (int i = 0; i < 32; ++i) vv[i] *= gk[k0 + 2 * i + (lane >> 5)]; }
#pragma unroll
    for (int i = 0; i < 32; ++i) scr[(2 * i + (lane >> 5)) * 33 + (lane & 31)] = vv[i];
    LDS_WAIT(); asm volatile("" ::: "memory");
    const int c = lane & 7;
#pragma unroll
    for (int j = 0; j < 4; ++j) { const int n = (lane >> 3) + 8 * j; const LAS float* s = scr + (8 * c) * 33 + n;
        v4u o; o.x = pk2(s[0 * 33], s[1 * 33]); o.y = pk2(s[2 * 33], s[3 * 33]); o.z = pk2(s[4 * 33], s[5 * 33]); o.w = pk2(s[6 * 33], s[7 * 33]);
        *(GAS v4u*)(WT + (size_t)(n0_dst + n) * K + k0 + 8 * c) = o; }
    LDS_WAIT(); asm volatile("" ::: "memory");
}
__device__ __forceinline__ float rms_row_to_bf16(const float* xrow, const float* g, bf16* orow, int lane) {
    const GAS v4f* xr = (const GAS v4f*)xrow + lane; const GAS v4f* gr = (const GAS v4f*)g + lane;
    v4f v[8]; float s = 0.f;
#pragma unroll
    for (int j = 0; j < 8; ++j) { v[j] = xr[64 * j]; s += (v[j].x * v[j].x + v[j].y * v[j].y) + (v[j].z * v[j].z + v[j].w * v[j].w); }
    const float rinv = 1.0f / sqrtf(wave_sum(s) * (1.f / DM) + EPS);
    GAS v2u* o8 = (GAS v2u*)orow + lane;
#pragma unroll
    for (int j = 0; j < 8; ++j) { const v4f gg = gr[64 * j]; v2u w; w.x = pk2(v[j].x * rinv * gg.x, v[j].y * rinv * gg.y); w.y = pk2(v[j].z * rinv * gg.z, v[j].w * rinv * gg.w); o8[64 * j] = w; }
    return rinv;
}
__device__ __forceinline__ void p0_prologue(Frame& F) {
    const float* x = F.inp[0]; const float* mem = F.inp[1]; const float* mixer_norm = F.inp[2]; const float* w_in = F.inp[3];
    const int gw = F.vcu * 8 + F.wave, NGW = F.G * 8;
    LAS float* WgL = (LAS float*)F.lds;
#pragma unroll 8
    for (int idx = F.tid; idx < 32768; idx += NTHREADS) { const int e = idx & 3, ln = (idx >> 2) & 63, sp = idx >> 8, gate = ln & 15, q = ln >> 4, k = 16 * sp + 4 * q + e;
        const int col = gate < 8 ? 3072 + gate : 5128 + (gate - 8);
        WgL[idx] = w_in[(size_t)k * IN_WIDTH + col] * mixer_norm[k]; }
    __syncthreads();
    { float* gates = (float*)(F.ws + WS_GATES); const int i16 = F.lane & 15, q = F.lane >> 4;
      for (int grp = gw; grp < MTOK / 16; grp += NGW) {
          const float* xr = x + (size_t)(grp * 16 + i16) * DM + 4 * q; v4f acc = (v4f){0.f, 0.f, 0.f, 0.f};
          const LAS float* wp = WgL + F.lane * 4;
#pragma unroll 1
          for (int s0 = 0; s0 < 128; s0 += 16, wp += 16 * 256, xr += 16 * 16) { v4f xb[16];
#pragma unroll
              for (int j = 0; j < 16; ++j) xb[j] = *(const v4f*)(xr + 16 * j);
#pragma unroll
              for (int j = 0; j < 16; ++j) { const v4f x4 = xb[j]; const v4f w4 = *(const LAS v4f*)(wp + j * 256);
                  acc = __builtin_amdgcn_mfma_f32_16x16x4f32(x4.x, w4.x, acc, 0, 0, 0); acc = __builtin_amdgcn_mfma_f32_16x16x4f32(x4.y, w4.y, acc, 0, 0, 0);
                  acc = __builtin_amdgcn_mfma_f32_16x16x4f32(x4.z, w4.z, acc, 0, 0, 0); acc = __builtin_amdgcn_mfma_f32_16x16x4f32(x4.w, w4.w, acc, 0, 0, 0); } }
#pragma unroll
          for (int r = 0; r < 4; ++r) gates[(size_t)(grp * 16 + 4 * q + r) * 16 + i16] = acc[r];
      } }
    { bf16* XN = (bf16*)(F.ws + WS_XN); float* RINV = (float*)(F.ws + WS_RINV);
      for (int m = gw; m < MTOK; m += NGW) { const float ri = rms_row_to_bf16(x + (size_t)m * DM, mixer_norm, XN + (size_t)m * DM, F.lane); if (F.lane == 0) RINV[m] = ri; }
      bf16* MN = (bf16*)(F.ws + WS_MN);
      for (int m = gw; m < MROWS; m += NGW) (void)rms_row_to_bf16(mem + (size_t)m * DM, F.inp[15], MN + (size_t)m * DM, F.lane); }
    __syncthreads();
    LAS float* scr = (LAS float*)(F.lds + F.wave * 16384);
    for (int it = gw; it < 32768; it += NGW) {
        int r = it;
        if (r < 6144) { const int kb = r / 192, nb = r % 192, n0 = 32 * nb, grpc = n0 >> 10, shift = grpc < 3 ? 0 : (grpc < 5 ? 8 : 16);
            p0_transpose_item(w_in, IN_WIDTH, DM, (bf16*)(F.ws + WS_WIN), nullptr, 64 * kb, n0, n0 + shift, scr, F.lane); continue; } r -= 6144;
        if (r < 2048) { p0_transpose_item(F.inp[13], DM, DM, (bf16*)(F.ws + WS_WOUT), nullptr, 64 * (r / 64), 32 * (r % 64), 32 * (r % 64), scr, F.lane); continue; } r -= 2048;
        if (r < 2048) { p0_transpose_item(F.inp[16], DM, DM, (bf16*)(F.ws + WS_WXQ), F.inp[14], 64 * (r / 64), 32 * (r % 64), 32 * (r % 64), scr, F.lane); continue; } r -= 2048;
        if (r < 4096) { p0_transpose_item(F.inp[17], 2 * DM, DM, (bf16*)(F.ws + WS_WXKV), nullptr, 64 * (r / 128), 32 * (r % 128), 32 * (r % 128), scr, F.lane); continue; } r -= 4096;
        if (r < 2048) { p0_transpose_item(F.inp[20], DM, DM, (bf16*)(F.ws + WS_WXO), nullptr, 64 * (r / 64), 32 * (r % 64), 32 * (r % 64), scr, F.lane); continue; } r -= 2048;
        if (r < 8192) { p0_transpose_item(F.inp[22], DFF, DM, (bf16*)(F.ws + WS_WUP), F.inp[21], 64 * (r / 256), 32 * (r % 256), 32 * (r % 256), scr, F.lane); continue; } r -= 8192;
        p0_transpose_item(F.inp[23], DM, DFF, (bf16*)(F.ws + WS_WDN), nullptr, 64 * (r / 64), 32 * (r % 64), 32 * (r % 64), scr, F.lane);
    }
}

constexpr int P2_KT_OFF = 4096, P2_KT_PITCH = 136, P2_VT_OFF = P2_KT_OFF + 64 * P2_KT_PITCH * 2, P2_VT_PITCH = 264;
__device__ __forceinline__ void p2_prep_item(Frame& F, int item, bool do_norm = true) {
    const int b = item >> 6, c = item & 63; const size_t R0 = (size_t)b * SEQ + (size_t)c * 64;
    const int tid = F.tid, lane = F.lane, w = F.wave;
    LAS float* gq = (LAS float*)F.lds; LAS float* uk = gq + 256;
    LAS bf16* kt = (LAS bf16*)(F.lds + P2_KT_OFF); LAS bf16* vt = (LAS bf16*)(F.lds + P2_VT_OFF);
    const float* GATES = (const float*)(F.ws + WS_GATES); const float* RINV = (const float*)(F.ws + WS_RINV);
    if (w < 4) { const size_t row = R0 + lane; const float ri = RINV[row];
        const float mi = GATES[row * 16 + 8 + w] * ri + F.inp[5][w], mf = GATES[row * 16 + 12 + w] * ri + F.inp[6][w];
        const float bcum = wave_incl_scan(logsigmoidf(mf), lane);
        const float g = __expf(bcum), u = __expf(mi - bcum) * 0.08838834764831845f;
        gq[w * 64 + lane] = g; uk[w * 64 + lane] = u;
        if (lane == 63) ((float*)(F.ws + WS_EB))[(size_t)(b * MLH + w) * NCHUNK + c] = g; }
    if (do_norm) { bf16* FQ = (bf16*)(F.ws + WS_FQ); bf16* FK = (bf16*)(F.ws + WS_FK); const int l16 = lane & 15;
      float gqn[8], gkn[8];
#pragma unroll
      for (int e = 0; e < 8; ++e) { gqn[e] = F.inp[9][l16 * 8 + e]; gkn[e] = F.inp[10][l16 * 8 + e]; }
      for (int it = w; it < 256; it += 8) { const int seg = it * 4 + (lane >> 4), row = seg >> 4, hh = seg & 15;
          bf16* p = (hh < 8 ? FQ : FK) + (R0 + row) * 1024 + (hh & 7) * FOXD + l16 * 8;
          const v4u raw = *(const v4u*)p; float v[8];
#pragma unroll
          for (int e = 0; e < 4; ++e) { v[2 * e] = bflo(raw[e]); v[2 * e + 1] = bfhi(raw[e]); }
          float ss = 0.f;
#pragma unroll
          for (int e = 0; e < 8; ++e) ss += v[e] * v[e];
          ss += __shfl_xor(ss, 1); ss += __shfl_xor(ss, 2); ss += __shfl_xor(ss, 4); ss += __shfl_xor(ss, 8);
          const float ri = 1.0f / sqrtf(ss * (1.0f / FOXD) + EPS);
          v4u o;
#pragma unroll
          for (int e = 0; e < 4; ++e) { const float g0 = hh < 8 ? gqn[2 * e] : gkn[2 * e], g1 = hh < 8 ? gqn[2 * e + 1] : gkn[2 * e + 1]; o[e] = pk2(v[2 * e] * ri * g0, v[2 * e + 1] * ri * g1); }
          *(v4u*)p = o; } }
    __syncthreads();
    const bf16* MQK = (const bf16*)(F.ws + WS_MQK); const bf16* MV = (const bf16*)(F.ws + WS_MV);
    bf16* QP = (bf16*)(F.ws + WS_QP); bf16* KPP = (bf16*)(F.ws + WS_KPP);
    const float* conv_w = F.inp[7]; const float* conv_b = F.inp[8];
    for (int h = 0; h < MLH; ++h) {
        { const int cgp = tid & 31, rg = tid >> 5; const bool isq = cgp < 16; const int col = (isq ? 0 : 512) + h * MLDK + (cgp & 15) * 8;
          float cw[4][8], cb[8];
#pragma unroll
          for (int e = 0; e < 8; ++e) { cb[e] = conv_b[col + e];
#pragma unroll
              for (int j = 0; j < 4; ++j) cw[j][e] = conv_w[j * 1024 + col + e]; }
          float u[7][8];
#pragma unroll
          for (int i = 0; i < 7; ++i) { const int pos = c * 64 + 4 * rg - 3 + i;
              v4u raw = (v4u){0u, 0u, 0u, 0u}; if (pos >= 0) raw = *(const v4u*)(MQK + ((size_t)b * SEQ + pos) * 1024 + col);
#pragma unroll
              for (int e = 0; e < 4; ++e) { u[i][2 * e] = bflo(raw[e]); u[i][2 * e + 1] = bfhi(raw[e]); } }
#pragma unroll
          for (int r = 0; r < 4; ++r) { const int t = 4 * rg + r; const float f = isq ? gq[h * 64 + t] : uk[h * 64 + t]; float y[8];
#pragma unroll
              for (int e = 0; e < 8; ++e) { float a = cb[e];
#pragma unroll
                  for (int j = 0; j < 4; ++j) a += cw[j][e] * u[r + j][e];
                  y[e] = a * sigmoidf_(a) * f; }
              v4u o; o.x = pk2(y[0], y[1]); o.y = pk2(y[2], y[3]); o.z = pk2(y[4], y[5]); o.w = pk2(y[6], y[7]);
              *(v4u*)((isq ? QP : KPP) + (R0 + t) * 512 + h * MLDK + (cgp & 15) * 8) = o;
              if (!isq) *(LAS v4u*)(kt + t * P2_KT_PITCH + (cgp & 15) * 8) = o; } }
#pragma unroll
        for (int i = 0; i < 4; ++i) { const int idx = tid + NTHREADS * i, row = idx >> 5, ch = idx & 31;
            *(LAS v4u*)(vt + row * P2_VT_PITCH + ch * 8) = *(const v4u*)(MV + (R0 + row) * 1024 + h * MLDV + ch * 8); }
        __syncthreads();
        const size_t itemh = (size_t)(b * MLH + h) * NCHUNK + c;
        { bf16* KT = (bf16*)(F.ws + WS_KT) + itemh * MLDK * 64;
#pragma unroll
          for (int i = 0; i < 2; ++i) { const int idx = tid + NTHREADS * i, d = idx >> 3, sg = idx & 7; unsigned short e8[8];
#pragma unroll
              for (int e = 0; e < 8; ++e) e8[e] = kt[(8 * sg + e) * P2_KT_PITCH + d];
              v4u o; o.x = e8[0] | ((unsigned)e8[1] << 16); o.y = e8[2] | ((unsigned)e8[3] << 16); o.z = e8[4] | ((unsigned)e8[5] << 16); o.w = e8[6] | ((unsigned)e8[7] << 16);
              *(v4u*)(KT + d * 64 + 8 * sg) = o; }
          bf16* VT = (bf16*)(F.ws + WS_VT) + itemh * MLDV * 64;
#pragma unroll
          for (int i = 0; i < 4; ++i) { const int idx = tid + NTHREADS * i, dv = idx >> 3, sg = idx & 7; unsigned short e8[8];
#pragma unroll
              for (int e = 0; e < 8; ++e) e8[e] = vt[(8 * sg + e) * P2_VT_PITCH + dv];
              v4u o; o.x = e8[0] | ((unsigned)e8[1] << 16); o.y = e8[2] | ((unsigned)e8[3] << 16); o.z = e8[4] | ((unsigned)e8[5] << 16); o.w = e8[6] | ((unsigned)e8[7] << 16);
              *(v4u*)(VT + dv * 64 + 8 * sg) = o; }
          if (tid < MLDK) { float s = 0.f;
#pragma unroll 8
              for (int t = 0; t < 64; ++t) s += bf2f(kt[t * P2_KT_PITCH + tid]);
              ((float*)(F.ws + WS_KSUM))[itemh * MLDK + tid] = s; } }
        __syncthreads();
    }
    if (w < 4) { const int mr = item * 4 + w; const float* slab = (const float*)((const unsigned char*)F.out + OUT_SLAB);
        const float* gxq = F.inp[18]; const float* gxk = F.inp[19];
        v4f kv[8]; float ssh[4] = {0.f, 0.f, 0.f, 0.f};
#pragma unroll
        for (int j = 0; j < 8; ++j) { const int col = 4 * (lane + 64 * j); v4f a = (v4f){0.f, 0.f, 0.f, 0.f};
#pragma unroll
            for (int s = 0; s < 4; ++s) a = a + *(const v4f*)(slab + ((size_t)s * MROWS + mr) * 4096 + col);
            kv[j] = a; ssh[j >> 1] += (a.x * a.x + a.y * a.y) + (a.z * a.z + a.w * a.w); }
        float rk[4];
#pragma unroll
        for (int hh = 0; hh < 4; ++hh) rk[hh] = 1.0f / sqrtf(wave_sum(ssh[hh]) * (1.0f / XD) + EPS);
        bf16* KH = (bf16*)(F.ws + WS_KHAT) + (size_t)mr * DM;
#pragma unroll
        for (int j = 0; j < 8; ++j) { const int col = 4 * (lane + 64 * j), d = col & (XD - 1); const v4f a = *(const v4f*)(gxq + d), g2 = *(const v4f*)(gxk + d); const float r = rk[j >> 1];
            v2u o; o.x = pk2(kv[j].x * r * a.x * g2.x, kv[j].y * r * a.y * g2.y); o.y = pk2(kv[j].z * r * a.z * g2.z, kv[j].w * r * a.w * g2.w);
            *(v2u*)(KH + col) = o; }
        bf16* VTM = (bf16*)(F.ws + WS_VTM); const int bm = mr >> 8, key = mr & 255;
#pragma unroll
        for (int j = 0; j < 8; ++j) { const int dcol = 4 * (lane + 64 * j); v4f a = (v4f){0.f, 0.f, 0.f, 0.f};
#pragma unroll
            for (int s = 0; s < 4; ++s) a = a + *(const v4f*)(slab + ((size_t)s * MROWS + mr) * 4096 + 2048 + dcol);
            const int hh = dcol >> 9, d = dcol & (XD - 1); bf16* vp = VTM + ((size_t)(bm * XH + hh) * XD + d) * NMEM + key;
            vp[0] = (bf16)f2bf(a.x); vp[NMEM] = (bf16)f2bf(a.y); vp[2 * NMEM] = (bf16)f2bf(a.z); vp[3 * NMEM] = (bf16)f2bf(a.w); }
    }
    __syncthreads();
}

__device__ __forceinline__ void p3_scan_item(Frame& F, int item) {
    const int bh = item >> 4, sl = item & 15;
    mls::state_scan(bh, sl, (const bf16*)(F.ws + WS_KT), (const bf16*)(F.ws + WS_VT), (const float*)(F.ws + WS_EB), (bf16*)((unsigned char*)F.out + OUT_CST));
    if (sl == 0 && F.tid < MLDK) {
        const float* EB = (const float*)(F.ws + WS_EB) + (size_t)bh * NCHUNK; const float* KS = (const float*)(F.ws + WS_KSUM) + (size_t)bh * NCHUNK * MLDK + F.tid;
        float* NS = (float*)(F.ws + WS_NST) + (size_t)bh * NCHUNK * MLDK + F.tid; float n = 0.f;
        float ks[NCHUNK], eb[NCHUNK];
#pragma unroll
        for (int c = 0; c < NCHUNK; ++c) { ks[c] = KS[(size_t)c * MLDK]; eb[c] = EB[c]; }
#pragma unroll
        for (int c = 0; c < NCHUNK; ++c) { NS[(size_t)c * MLDK] = n; n = eb[c] * (n + ks[c]); }
    }
    if (sl == 1 || sl == 2) {
        const int seq = (sl - 1) * 16 + bh, b = seq >> 3, fh = seq & 7;
        const float* GATES = (const float*)(F.ws + WS_GATES); const float* RINV = (const float*)(F.ws + WS_RINV); const float fb = F.inp[4][fh];
        const size_t r0 = (size_t)b * SEQ + 8 * F.tid; float lf[8]; float tot = 0.f;
#pragma unroll
        for (int j = 0; j < 8; ++j) { lf[j] = logsigmoidf(GATES[(r0 + j) * 16 + fh] * RINV[r0 + j] + fb); tot += lf[j]; }
        const float incl = wave_incl_scan(tot, F.lane);
        LAS float* wt = (LAS float*)F.lds;
        __syncthreads();
        if (F.lane == 63) wt[F.wave] = incl;
        __syncthreads();
        float run = incl - tot;
        for (int wv = 0; wv < F.wave; ++wv) run += wt[wv];
        float* C = (float*)(F.ws + WS_CFOX) + (size_t)seq * SEQ + 8 * F.tid;
#pragma unroll
        for (int j = 0; j < 8; ++j) { run += lf[j]; C[j] = run * -11.313708498984761f; }
        __syncthreads();
    }
}
#ifndef MK_PER_PHASE
#define MK_PER_PHASE 0
#endif
#define XB_TMO      128
#define XB_XCNT(j)  (256  + 64 * (j))
#define XB_XSUB(j)  (1280 + 64 * (j))
#define XB_XGEN(j)  (2304 + 64 * (j))
#define XB_TOP      3328
#define XB_TOPGEN   3392
#define XCD_BAR_WORDS 3456
#define XB_SPIN_CAP (1u << 20)
__device__ __forceinline__ unsigned xb_ld(unsigned* p)              { return __hip_atomic_load(p, __ATOMIC_RELAXED, __HIP_MEMORY_SCOPE_AGENT); }
__device__ __forceinline__ unsigned xb_add(unsigned* p, unsigned v) { return __hip_atomic_fetch_add(p, v, __ATOMIC_RELAXED, __HIP_MEMORY_SCOPE_AGENT); }
__device__ __forceinline__ unsigned xb_xcc_id() { return (unsigned)__builtin_amdgcn_s_getreg((3 << 11) | 20) & 0xFu; }
#define XB_SPIN(cond, bar) do { unsigned _sp = 0; while (cond) { __builtin_amdgcn_s_sleep(1); \
    if ((++_sp & 255u) == 0u) { if (xb_ld(&(bar)[XB_TMO])) break; if (_sp > XB_SPIN_CAP) { atomicAdd(&(bar)[XB_TMO], 1u); break; } } } } while (0)
struct XcdBarrier { unsigned* bar; unsigned x; volatile LAS unsigned* st; };
__device__ __forceinline__ XcdBarrier xcd_barrier_post(unsigned* bar, volatile LAS unsigned* st) {
    XcdBarrier b; b.bar = bar; b.x = xb_xcc_id(); b.st = st;
    if (threadIdx.x == 0) (void)xb_add(&bar[XB_XCNT(b.x)], 1u);
    return b;
}
__device__ __forceinline__ void xcd_barrier_complete(unsigned* bar, unsigned x, unsigned& nloc, unsigned& nx) {
    const unsigned G = gridDim.x * gridDim.y * gridDim.z;
    unsigned sum, cnt, mine, sp = 0u;
    for (;;) {
        sum = 0u; cnt = 0u; mine = 0u;
#pragma unroll
        for (unsigned j = 0; j < 16; ++j) { const unsigned c = xb_ld(&bar[XB_XCNT(j)]); sum += c; cnt += (c > 0u) ? 1u : 0u; mine = (j == x) ? c : mine; }
        if (sum == G) break;
        __builtin_amdgcn_s_sleep(1);
        if ((++sp & 255u) == 0u) { if (xb_ld(&bar[XB_TMO])) break; if (sp > XB_SPIN_CAP) { atomicAdd(&bar[XB_TMO], 1u); break; } }
    }
    nloc = mine > 0u ? mine : 1u; nx = cnt > 0u ? cnt : 1u;
}
__device__ __forceinline__ void xcd_barrier(const XcdBarrier& b) {
    asm volatile("s_waitcnt vmcnt(0)" ::: "memory");
    __syncthreads();
    if (threadIdx.x == 0) {
        unsigned* bar = b.bar;
        __builtin_amdgcn_s_waitcnt(0);
        unsigned nloc = b.st[0], nx = b.st[1];
        if (nloc == 0u) { xcd_barrier_complete(bar, b.x, nloc, nx); b.st[0] = nloc; b.st[1] = nx; }
        const unsigned old = xb_add(&bar[XB_XSUB(b.x)], 1u);
        const unsigned gen = old / nloc;
        if (old + 1u == (gen + 1u) * nloc) {
            __builtin_amdgcn_fence(__ATOMIC_RELEASE, "agent");
            asm volatile("s_waitcnt vmcnt(0)" ::: "memory");
            const unsigned og = xb_add(&bar[XB_TOP], 1u);
            const unsigned tg = og / nx;
            if (og + 1u == (tg + 1u) * nx) xb_add(&bar[XB_TOPGEN], 1u);
            else XB_SPIN(xb_ld(&bar[XB_TOPGEN]) == tg, bar);
            __builtin_amdgcn_fence(__ATOMIC_ACQUIRE, "agent");
            xb_add(&bar[XB_XGEN(b.x)], 1u);
            asm volatile("s_waitcnt vmcnt(0)" ::: "memory");
        } else {
            XB_SPIN(xb_ld(&bar[XB_XGEN(b.x)]) == gen, bar);
            __builtin_amdgcn_fence(__ATOMIC_ACQUIRE, "agent");
            asm volatile("s_waitcnt vmcnt(0)" ::: "memory");
        }
    }
    __syncthreads();
}
constexpr int LDS_MISC_OFF = LDS_BYTES - 256;
#ifndef TWICE_P5
#define TWICE_P5 0
#endif
#ifndef TWICE_P6
#define TWICE_P6 0
#endif
#ifndef TWICE_P8
#define TWICE_P8 0
#endif
#ifndef TWICE_P10
#define TWICE_P10 0
#endif
#ifndef TWICE_P1
#define TWICE_P1 0
#endif
constexpr int N_PHASES = 12;
struct Args { const float* in[24]; float* out; unsigned char* ws; int ph_lo, ph_hi; };
static_assert(sizeof(Args) == 24 * 8 + 8 + 8 + 8, "Args has no padding");

__global__ void __launch_bounds__(NTHREADS, 2) fwd_kernel(Args args) {
    extern __shared__ __attribute__((aligned(16))) unsigned char lds[];
    Frame F;
    F.lds = (LAS unsigned char*)lds; F.ldsg = lds;
    F.tid = threadIdx.x; F.lane = F.tid & 63; F.wave = __builtin_amdgcn_readfirstlane(F.tid >> 6);
    F.G = gridDim.x; { const int bx = blockIdx.x; F.vcu = (F.G % 8 == 0) ? (bx % 8) * (F.G / 8) + bx / 8 : bx; }
    F.inp = (const __attribute__((address_space(4))) cfp_t*)__builtin_amdgcn_kernarg_segment_ptr();
    F.out = args.out; F.ws = args.ws;
    unsigned char* ws = args.ws;
    const int lo = args.ph_lo, hi = args.ph_hi;
    volatile LAS unsigned* MISC = (volatile LAS unsigned*)(F.lds + LDS_MISC_OFF);
    if (F.tid < 64) MISC[F.tid] = 0u;
    __syncthreads();
    XcdBarrier xbar; xbar.bar = (unsigned*)(ws + WS_CTL); xbar.x = 0; xbar.st = nullptr;
    if (hi - lo > 1) xbar = xcd_barrier_post((unsigned*)(ws + WS_CTL), MISC);
#ifndef PHASE_MASK
#define PHASE_MASK 0xfff
#endif
#define IN(k) ((((PHASE_MASK) >> (k)) & 1) && lo <= (k) && (k) < hi)
#ifndef DUP_PHASE
#define DUP_PHASE 99
#endif
#define REP(k) for (int rep_ = 0; rep_ < ((k) == DUP_PHASE ? 2 : 1); ++rep_, ((k) == DUP_PHASE && rep_ < 2 ? xcd_barrier(xbar) : (void)0))
#define SEAM(k) do { if (IN(k) && IN((k) + 1)) { if ((k) == 0) cg::this_grid().sync(); else xcd_barrier(xbar); } } while (0)
    float* SSQ1 = (float*)(ws + WS_CTL + CTL_SSQ1); float* SSQ2 = (float*)(ws + WS_CTL + CTL_SSQ2); float* SSQQ = (float*)(ws + WS_CTL + CTL_SSQQ);

#ifdef PROBE_PHASE
    unsigned long long pt0 = 0, pt1 = 0, pu0 = 0, pu1 = 0;
#ifndef PROBE_B
#define PROBE_B 99
#endif
#define STAMP(k) do { if ((k) == PROBE_PHASE) pt0 = __builtin_amdgcn_s_memrealtime(); if ((k) == PROBE_PHASE + 1) pt1 = __builtin_amdgcn_s_memrealtime(); \
                      if ((k) == PROBE_B) pu0 = __builtin_amdgcn_s_memrealtime(); if ((k) == PROBE_B + 1) pu1 = __builtin_amdgcn_s_memrealtime(); } while (0)
#else
#define STAMP(k) do {} while (0)
#endif
    STAMP(0);
    if (IN(0)) REP(0) { p0_prologue(F); }
    SEAM(0); STAMP(1);
    if (IN(1)) REP(1) {
        { pg8::Gemm g{(const bf16*)(ws + WS_XN), (const bf16*)(ws + WS_WIN), DM, DM, DM}; pg8::StdOrder S; S.init(MTOK, NPROJ, DM, DM, F.G, (int)blockIdx.x, TWICE_P1);
          pg8::EpiStoreBf16 E{(bf16*)(ws + WS_PROJ), 1024, 1024, (size_t)MTOK * 1024};
          pg8::gemm_phase<pg8::EpiStoreBf16, pg8::StdOrder, true>(F.lds, g, S, E); }
        { pg8::Gemm g{(const bf16*)(ws + WS_MN), (const bf16*)(ws + WS_WXKV), DM, DM, 512}; pg8::XkvOrder S{F.G, (int)blockIdx.x};
          pg8::EpiSlab E{(float*)((unsigned char*)F.out + OUT_SLAB), 4096, (size_t)MROWS * 4096};
          pg8::gemm_phase<pg8::EpiSlab, pg8::XkvOrder, false>(F.lds, g, S, E); }
    }
    SEAM(1); STAMP(2);
#ifndef P2_TWICE
#define P2_TWICE 1
#endif
    if (IN(2)) REP(2) { for (int item = F.vcu; item < BATCH * NCHUNK * P2_TWICE; item += F.G) p2_prep_item(F, item & 255, item < 256); }
    SEAM(2); STAMP(3);
#ifndef P3_TWICE
#define P3_TWICE 1
#endif
    if (IN(3)) REP(3) { for (int item = F.vcu; item < 256 * P3_TWICE; item += F.G) p3_scan_item(F, item & 255); }
    SEAM(3); STAMP(4);
    if (IN(4)) REP(4) {
        if (!((PHASE_MASK >> 12) & 1)) { const fox::Srd R = __builtin_amdgcn_make_buffer_rsrc((void*)ws, (short)0, (int)WS_END, 0x00020000);
          for (int L = F.vcu; L < 256; L += F.G) { const int bh = L >> 3, xq = L & 7, b = bh >> 3, h = bh & 7;
              const unsigned rowb = (unsigned)b * SEQ * 2048u + (unsigned)h * (FOXD * 2);
              fox::HeadRef H{rowb,
                             (unsigned)WS_CONCAT + (unsigned)b * SEQ * 4096u + (unsigned)h * (FOXD * 2), (const float*)(ws + WS_CFOX) + (size_t)bh * SEQ, F.inp[11] + h * FOXD};
              fox::Seam S;
              fox::fox_prime(R, H, xq * 256, (char*)lds, S);
              for (int p = 0; p < 2; ++p) { const int P0 = (p == 0 ? xq : 15 - xq) * 256, P0n = (15 - xq) * 256;
                  fox::fox_block(R, H, P0, P0n, (char*)lds, S); }
              VM_WAIT(); __syncthreads(); } }
        if (!((PHASE_MASK >> 13) & 1)) { float* xch = (float*)lds;
          for (int it = F.vcu; it < BATCH * MLH * NCHUNK; it += F.G) { const int c = it & 63, h = (it >> 6) & 3, b = it >> 8;
              mls::chunk_out(b, h, c, (const bf16*)(ws + WS_QP), (const bf16*)(ws + WS_KPP), (const bf16*)(ws + WS_VT), (const bf16*)((unsigned char*)F.out + OUT_CST),
                             (const float*)(ws + WS_NST), (const bf16*)(ws + WS_MO), F.inp[12], (bf16*)(ws + WS_CONCAT), xch); } }
    }
    SEAM(4); STAMP(5);
    if (IN(5)) REP(5) {
        pg8::Gemm g{(const bf16*)(ws + WS_CONCAT), (const bf16*)(ws + WS_WOUT), DM, DM, DM}; pg8::StdOrder S; S.init(MTOK, DM, DM, DM, F.G, (int)blockIdx.x, TWICE_P5);
        pg8::EpiResid<true, false> E{F.inp[0], (bf16*)(ws + WS_X1B), SSQ1, DM};
        pg8::gemm_phase<pg8::EpiResid<true, false>, pg8::StdOrder, true>(F.lds, g, S, E);
    }
    SEAM(5); STAMP(6);
    if (IN(6)) REP(6) {
        pg8::Gemm g{(const bf16*)(ws + WS_X1B), (const bf16*)(ws + WS_WXQ), DM, DM, DM}; pg8::StdOrder S; S.init(MTOK, DM, DM, DM, F.G, (int)blockIdx.x, TWICE_P6);
        pg8::EpiQ E{(bf16*)(ws + WS_Q), SSQ1, SSQQ};
        pg8::gemm_phase<pg8::EpiQ, pg8::StdOrder, true>(F.lds, g, S, E);
    }
    SEAM(6); STAMP(7);
    if (IN(7)) REP(7) {
        pg8::Gemm g{(const bf16*)(ws + WS_Q), (const bf16*)(ws + WS_KHAT), DM, DM, XD}; pg8::ScoreOrder S{F.G, (int)blockIdx.x};
        pg8::EpiSoftmax E{(bf16*)(ws + WS_P), SSQQ};
        if (F.G >= 256) pg8::gemm_phase<pg8::EpiSoftmax, pg8::ScoreOrder, false>(F.lds, g, S, E);
    }
    SEAM(7); STAMP(8);
    if (IN(8)) REP(8) {
        pg8::Gemm g{(const bf16*)(ws + WS_P), (const bf16*)(ws + WS_VTM), 1024, NMEM, NMEM}; pg8::PvOrder S{F.G, (int)blockIdx.x, TWICE_P8};
        pg8::EpiStoreBf16 E{(bf16*)(ws + WS_CO), DM, 0, 0};
        pg8::gemm_phase<pg8::EpiStoreBf16, pg8::PvOrder, true>(F.lds, g, S, E);
    }
    SEAM(8); STAMP(9);
#ifdef EXTRA_BARS
    for (int eb = 0; eb < EXTRA_BARS; ++eb) xcd_barrier(xbar);
#endif
    if (IN(9)) REP(9) {
        pg8::Gemm g{(const bf16*)(ws + WS_CO), (const bf16*)(ws + WS_WXO), DM, DM, DM}; pg8::StdOrder S; S.init(MTOK, DM, DM, DM, F.G, (int)blockIdx.x);
        pg8::EpiResid<false, false> E{(const bf16*)(ws + WS_X1B), (bf16*)(ws + WS_X2B), SSQ2, DM};
        pg8::gemm_phase<pg8::EpiResid<false, false>, pg8::StdOrder, true>(F.lds, g, S, E);
    }
    SEAM(9); STAMP(10);
    if (IN(10)) REP(10) {
        pg8::Gemm g{(const bf16*)(ws + WS_X2B), (const bf16*)(ws + WS_WUP), DM, DM, DM}; pg8::StdOrder S; S.init(MTOK, DFF, DM, DM, F.G, (int)blockIdx.x, TWICE_P10);
        pg8::EpiUp E{(bf16*)(ws + WS_H), SSQ2};
        pg8::gemm_phase<pg8::EpiUp, pg8::StdOrder, true>(F.lds, g, S, E);
    }
    SEAM(10); STAMP(11);
    if (IN(11)) REP(11) {
        pg8::Gemm g{(const bf16*)(ws + WS_H), (const bf16*)(ws + WS_WDN), DFF, DFF, DFF}; pg8::StdOrder S; S.init(MTOK, DM, DFF, DFF, F.G, (int)blockIdx.x);
        pg8::EpiResid<false, true> E{(const bf16*)(ws + WS_X2B), F.out, nullptr, DM};
        pg8::gemm_phase<pg8::EpiResid<false, true>, pg8::StdOrder, true>(F.lds, g, S, E);
    }
#ifdef PROBE_PHASE
    xcd_barrier(xbar); STAMP(12);
    if (blockIdx.x == 0 && threadIdx.x < 64) {
        const float ta = 8.0f * rintf((float)(pt1 - pt0) * 0.01f * 0.125f), tb = 0.8f * rintf((float)(pu1 - pu0) * 0.01f * 0.125f);
        if (threadIdx.x == 0) F.out[0] += ta;
        if (PROBE_B != 99) for (int i = threadIdx.x; i < 10000; i += 64) F.out[64 + i] += tb;
    }
#endif
#undef IN
#undef SEAM
}

extern "C" void kernel_launch(void* const* d_in, const int* in_sizes, int n_in, void* d_out, int out_size, void* d_ws, size_t ws_size, hipStream_t stream) {
    static int grid = 0;
    if (grid == 0) {
        if (n_in != 24 || in_sizes[0] != MTOK * DM || out_size != MTOK * DM || ws_size < WS_END) {
            fprintf(stderr, "kernel_launch: unexpected shapes (n_in %d, in0 %d, out %d, ws %zu; need ws >= %zu); nothing launched\n", n_in, n_in > 0 ? in_sizes[0] : -1, out_size, ws_size, (size_t)WS_END); grid = -1; return; }
        int dev = 0, cus = 0, per_cu = 0;
        if (hipGetDevice(&dev) != hipSuccess || hipDeviceGetAttribute(&cus, hipDeviceAttributeMultiprocessorCount, dev) != hipSuccess) { grid = -1; return; }
        if (hipFuncSetAttribute((const void*)fwd_kernel, hipFuncAttributeMaxDynamicSharedMemorySize, LDS_BYTES) != hipSuccess) { fprintf(stderr, "kernel_launch: hipFuncSetAttribute failed\n"); grid = -1; return; }
        if (hipOccupancyMaxActiveBlocksPerMultiprocessor(&per_cu, (const void*)fwd_kernel, NTHREADS, LDS_BYTES) != hipSuccess || per_cu < 1) { fprintf(stderr, "kernel_launch: occupancy query says %d blocks per CU\n", per_cu); per_cu = 1; }
        (void)hipGetLastError();
        grid = cus;
    }
    if (grid < 0) return;
    (void)hipMemsetAsync((char*)d_ws + WS_CTL, 0, CTL_BYTES, stream);
    Args a{};
    for (int i = 0; i < 24; ++i) a.in[i] = (const float*)d_in[i];
    a.out = (float*)d_out; a.ws = (unsigned char*)d_ws;
#if MK_PER_PHASE
    for (int ph = 0; ph < N_PHASES; ++ph) { a.ph_lo = ph; a.ph_hi = ph + 1;
        hipLaunchKernelGGL(fwd_kernel, dim3(grid), dim3(NTHREADS), LDS_BYTES, stream, a); }
#else
    a.ph_lo = 0; a.ph_hi = N_PHASES;
    void* kargs[] = {&a};
    hipError_t e = hipLaunchCooperativeKernel((const void*)fwd_kernel, dim3(grid), dim3(NTHREADS), kargs, LDS_BYTES, stream);
    if (e != hipSuccess) fprintf(stderr, "kernel_launch: cooperative launch failed: %s (grid %d)\n", hipGetErrorString(e), grid);
#endif
}
```

```cpp
#include <hip/hip_runtime.h>
#include <hip/hip_cooperative_groups.h>
#include <cstdio>
#include <cstdint>
namespace cg = cooperative_groups;

constexpr int BATCH = 4, SEQ = 4096, DM = 2048, MTOK = BATCH * SEQ;
constexpr int NMEM = 256, MROWS = BATCH * NMEM;
constexpr int FOXH = 8, FOXD = 128, MLH = 4, MLDV = 256, MLDK = 128, XH = 4, XD = 512, DFF = 8192;
constexpr int IN_WIDTH = 6160, NPROJ = 6144, NCHUNK = SEQ / 64;
constexpr float EPS = 1e-6f;
constexpr float LOG2E = 1.4426950408889634f;

constexpr size_t MiB = (size_t)1 << 20;
constexpr size_t WS_WIN = 0, WS_WOUT = 24 * MiB, WS_WXQ = 32 * MiB, WS_WXKV = 40 * MiB, WS_WXO = 56 * MiB, WS_WUP = 64 * MiB, WS_WDN = 96 * MiB;
constexpr size_t WS_PROJ = 128 * MiB;
constexpr size_t WS_FQ = 128 * MiB, WS_FK = 160 * MiB, WS_FV = 192 * MiB, WS_MQK = 224 * MiB, WS_MV = 256 * MiB, WS_MO = 288 * MiB;
constexpr size_t WS_XN = 320 * MiB;
constexpr size_t WS_QP = 384 * MiB, WS_KPP = 400 * MiB;
constexpr size_t WS_KT = 416 * MiB;
constexpr size_t WS_VT = 432 * MiB;
constexpr size_t WS_MISC = 464 * MiB;
constexpr size_t WS_CTL = WS_MISC, CTL_BYTES = 1 * MiB;
constexpr size_t CTL_QCTR = 32 * 1024;
constexpr size_t CTL_SSQ1 = 64 * 1024, CTL_SSQ2 = 128 * 1024, CTL_SSQQ = 192 * 1024;
constexpr size_t WS_GATES = WS_MISC + 1 * MiB;
constexpr size_t WS_RINV = WS_MISC + 2 * MiB;
constexpr size_t WS_CFOX = WS_MISC + 3 * MiB;
constexpr size_t WS_EB = WS_MISC + 4 * MiB;
constexpr size_t WS_KSUM = WS_MISC + 5 * MiB;
constexpr size_t WS_NST = WS_MISC + 6 * MiB;
constexpr size_t WS_JLO = WS_MISC + 7 * MiB;
constexpr size_t WS_MN = WS_MISC + 8 * MiB;
constexpr size_t WS_KHAT = WS_MISC + 12 * MiB;
constexpr size_t WS_VTM = WS_MISC + 16 * MiB;
constexpr size_t WS_END = 512 * MiB;
constexpr size_t WS_CONCAT = 224 * MiB;
constexpr size_t WS_X1B = 128 * MiB;
constexpr size_t WS_Q = 192 * MiB;
constexpr size_t WS_CO = 256 * MiB;
constexpr size_t WS_P = 320 * MiB;
constexpr size_t WS_X2B = 128 * MiB;
constexpr size_t WS_H = 192 * MiB;
constexpr size_t OUT_SLAB = 0, OUT_CST = 64 * MiB;

#ifndef JLO_DISABLE
#define JLO_DISABLE 0
#endif
constexpr int LDS_BYTES = 147456;
constexpr int NTHREADS = 512;

#define GAS __attribute__((address_space(1)))
#define LAS __attribute__((address_space(3)))
typedef unsigned short bf16;
typedef unsigned v4u __attribute__((ext_vector_type(4)));
typedef unsigned v2u __attribute__((ext_vector_type(2)));
typedef float v4f __attribute__((ext_vector_type(4)));
typedef short v8s __attribute__((ext_vector_type(8)));
typedef short v4s __attribute__((ext_vector_type(4)));
#define LDS_WAIT() asm volatile("s_waitcnt lgkmcnt(0)" ::: "memory")
#define VM_WAIT() asm volatile("s_waitcnt vmcnt(0)" ::: "memory")
__device__ __forceinline__ unsigned f2bf(float f) { unsigned u = __builtin_bit_cast(unsigned, f); return (u + 0x7fffu + ((u >> 16) & 1u)) >> 16; }
__device__ __forceinline__ unsigned pk2(float lo, float hi) { return f2bf(lo) | (f2bf(hi) << 16); }
__device__ __forceinline__ float bf2f(unsigned h) { return __builtin_bit_cast(float, h << 16); }
__device__ __forceinline__ float bflo(unsigned w) { return __builtin_bit_cast(float, w << 16); }
__device__ __forceinline__ float bfhi(unsigned w) { return __builtin_bit_cast(float, w & 0xffff0000u); }
__device__ __forceinline__ float wave_sum(float v) {
#pragma unroll
    for (int o = 1; o < 64; o <<= 1) v += __shfl_xor(v, o);
    return v;
}
__device__ __forceinline__ float logsigmoidf(float x) { return x >= 0.f ? -log1pf(__expf(-x)) : x - log1pf(__expf(x)); }
__device__ __forceinline__ float sigmoidf_(float x) { return 1.f / (1.f + __expf(-x)); }
#define MK_PER_PHASE 0
namespace pg8 {
#define PG8_LAS __attribute__((address_space(3)))
typedef unsigned short bf16_t;
typedef short bf16x8 __attribute__((ext_vector_type(8)));
typedef float f32x4 __attribute__((ext_vector_type(4)));
typedef float f32x2 __attribute__((ext_vector_type(2)));
typedef unsigned u32x4 __attribute__((ext_vector_type(4)));
typedef unsigned u32x2 __attribute__((ext_vector_type(2)));
constexpr int BM = 256, BK = 64, HALF = 128, HTB = HALF * BK * 2, STAGE_BYTES = 8 * HTB, NXCD = 8, WGM = 8;

__host__ __device__ __forceinline__ int lds_byte(int r, int c) { const int st = (r >> 4) * 2 + (c >> 5), rr = r & 15, cc = c & 31, ob = rr * 64 + cc * 2; return st * 1024 + (ob ^ (((ob >> 9) & 1) << 5)); }
__host__ __device__ __forceinline__ void stage_rc(int b, int& R, int& C) { const int st = b / 1024, sb = b % 1024, swz = sb ^ (((sb >> 9) & 1) << 5); R = (st >> 1) * 16 + swz / 64; C = (st & 1) * 32 + (swz % 64) / 2; }
__host__ __device__ __forceinline__ int perm32(int rho) { const int n = rho >> 4, i = rho & 15; return 8 * (i >> 2) + 4 * n + (i & 3); }

struct Unit { int row0, col0; long aoff, boff; int aux; };
struct Gemm { const bf16_t* A; const bf16_t* Bt; int lda, ldb, K; };

struct StdOrder {
    int nM, nN, nwg, G, c, lda, ldb, rsh;
    __device__ void init(int M, int N, int lda_, int ldb_, int G_, int c_, int rsh_ = 0) { nM = M / BM; nN = N / BM; nwg = nM * nN; G = G_; c = c_; lda = lda_; ldb = ldb_; rsh = rsh_; }
    __device__ bool next(int i, Unit& u) const {
        const long L = (long)(i >> rsh) * G + c; if (L >= nwg) return false;
        int wgid = (int)L; { const int q = nwg / NXCD, r = nwg % NXCD, xcd = wgid % NXCD, off = wgid / NXCD; wgid = (xcd < r ? xcd * (q + 1) : r * (q + 1) + (xcd - r) * q) + off; }
        const int nig = WGM * nN, gid = wgid / nig, fm = gid * WGM, gsz = (nM - fm) < WGM ? (nM - fm) : WGM;
        const int pm = fm + ((wgid % nig) % gsz), pn = (wgid % nig) / gsz;
        u.row0 = pm * BM; u.col0 = pn * BM; u.aoff = (long)pm * BM * lda; u.boff = (long)pn * BM * ldb; u.aux = i & rsh; return true;
    }
};

__device__ __forceinline__ unsigned cvt_pk_bf16(float lo, float hi) { unsigned r; asm volatile("v_cvt_pk_bf16_f32 %0, %1, %2" : "=v"(r) : "v"(lo), "v"(hi)); return r; }

template <class Epi, class Sched, bool ALIGN_EPI>
__device__ __forceinline__ void gemm_phase(PG8_LAS unsigned char* lds, const Gemm g, const Sched& S, const Epi& E) {
    int tid_ = threadIdx.x; asm volatile("" : "+v"(tid_));
    const int tid = tid_, wid = __builtin_amdgcn_readfirstlane(tid >> 6), lane = tid & 63, wr = wid >> 2, wc = wid & 3, fr = lane & 15, fq = lane >> 4;
    const int K = g.K, nt = K / BK;
    unsigned voffA[2], voffB[2];
#pragma unroll
    for (int i = 0; i < 2; ++i) { int R, C; stage_rc(tid * 16 + i * 8192, R, C); const int Rb = Epi::PERM ? ((R & ~31) + perm32(R & 31)) : R;
        voffA[i] = (unsigned)(R * g.lda + C) * 2u; voffB[i] = (unsigned)(Rb * g.ldb + C) * 2u; }
    const size_t kstep = (size_t)(BK * 2);
    const size_t hA = (size_t)HALF * g.lda * 2, hB = (size_t)HALF * g.ldb * 2;
    const unsigned ldsw = (unsigned)wid * 1024u;
    const int aoff = lds_byte(wr * 64 + fr, fq * 8), boff = lds_byte(wc * 32 + fr, fq * 8);
#define PG8_SA(b, h) (((b) * 2 + (h)) * HTB)
#define PG8_SB(b, h) ((4 + (b) * 2 + (h)) * HTB)
#define PG8_STAGE(bufoff, gbase, voff) do { _Pragma("unroll") for (int _i = 0; _i < 2; ++_i) \
        __builtin_amdgcn_global_load_lds((const unsigned*)((const char*)(gbase) + (voff)[_i]), (PG8_LAS unsigned*)(lds + (bufoff) + ldsw + _i * 8192), 16, 0, 0); } while (0)
#define PG8_LDA(dst, b, h) do { _Pragma("unroll") for (int m = 0; m < 4; ++m) _Pragma("unroll") for (int k = 0; k < 2; ++k) dst[m][k] = *(const PG8_LAS bf16x8*)(lds + PG8_SA(b, h) + aoff + m * 2048 + k * 1024); } while (0)
#define PG8_LDB(dst, b, h) do { _Pragma("unroll") for (int n = 0; n < 2; ++n) _Pragma("unroll") for (int k = 0; k < 2; ++k) dst[n][k] = *(const PG8_LAS bf16x8*)(lds + PG8_SB(b, h) + boff + n * 2048 + k * 1024); } while (0)
#define PG8_MMA(ai, bj, At, Bt) do { __builtin_amdgcn_s_setprio(1); _Pragma("unroll") for (int m = 0; m < 4; ++m) _Pragma("unroll") for (int n = 0; n < 2; ++n) _Pragma("unroll") for (int k = 0; k < 2; ++k) \
        acc[ai][bj][m][n] = __builtin_amdgcn_mfma_f32_16x16x32_bf16(Bt[n][k], At[m][k], acc[ai][bj][m][n], 0, 0, 0); __builtin_amdgcn_s_setprio(0); } while (0)
#define PG8_WAIT_V(n) asm volatile("s_waitcnt vmcnt(" #n ")" ::: "memory")
#define PG8_WAIT_L(n) asm volatile("s_waitcnt lgkmcnt(" #n ")" ::: "memory")
#define PG8_BAR __builtin_amdgcn_s_barrier()
#define PG8_SCHED __builtin_amdgcn_sched_barrier(0)
    Unit cur, nxt; int ui = 0;
    if (!S.next(0, cur)) return;
    f32x4 acc[2][2][4][2];
#pragma unroll
    for (int a = 0; a < 2; ++a)
#pragma unroll
        for (int b = 0; b < 2; ++b)
#pragma unroll
            for (int m = 0; m < 4; ++m)
#pragma unroll
                for (int n = 0; n < 2; ++n) acc[a][b][m][n] = (f32x4){0.f, 0.f, 0.f, 0.f};
    bf16x8 At[4][2], B0[2][2], B1[2][2];
    const char* cA = (const char*)g.A + (size_t)cur.aoff * 2; const char* cB = (const char*)g.Bt + (size_t)cur.boff * 2;
    PG8_STAGE(PG8_SB(0, 0), cB, voffB); PG8_STAGE(PG8_SB(0, 1), cB + hB, voffB); PG8_STAGE(PG8_SA(0, 0), cA, voffA); PG8_STAGE(PG8_SA(0, 1), cA + hA, voffA);
    if (wr == 1) PG8_BAR;
    PG8_WAIT_V(2); PG8_BAR;
    PG8_STAGE(PG8_SB(1, 0), cB + kstep, voffB); PG8_STAGE(PG8_SA(1, 0), cA + kstep, voffA); PG8_STAGE(PG8_SB(1, 1), cB + hB + kstep, voffB);
    PG8_WAIT_V(6); PG8_BAR;
    for (;;) {
        const bool has_next = S.next(ui + 1, nxt);
        const char* nA = has_next ? (const char*)g.A + (size_t)nxt.aoff * 2 : cA; const char* nB = has_next ? (const char*)g.Bt + (size_t)nxt.boff * 2 : cB;
        for (int t = 0; t < nt; t += 2) {
            const bool last = (t == nt - 2);
            const char* a1 = cA + (size_t)(t + 1) * kstep;
            const char* a2 = last ? nA : cA + (size_t)(t + 2) * kstep; const char* b2 = last ? nB : cB + (size_t)(t + 2) * kstep;
            const char* a3 = a2 + kstep; const char* b3 = b2 + kstep;
            PG8_LDB(B0, 0, 0); PG8_LDB(B1, 0, 1); PG8_SCHED; PG8_LDA(At, 0, 0); PG8_STAGE(PG8_SA(1, 1), a1 + hA, voffA);
            PG8_WAIT_V(8); PG8_WAIT_L(0); PG8_BAR; PG8_MMA(0, 0, At, B0); PG8_MMA(0, 1, At, B1); PG8_BAR; PG8_SCHED;
            PG8_LDA(At, 0, 1); PG8_STAGE(PG8_SB(0, 0), b2, voffB); PG8_STAGE(PG8_SB(0, 1), b2 + hB, voffB); PG8_STAGE(PG8_SA(0, 0), a2, voffA);
            PG8_WAIT_V(8); PG8_WAIT_L(0); PG8_BAR; PG8_MMA(1, 0, At, B0); PG8_MMA(1, 1, At, B1); PG8_BAR; PG8_SCHED;
            PG8_LDB(B0, 1, 0); PG8_LDB(B1, 1, 1); PG8_SCHED; PG8_LDA(At, 1, 0); PG8_STAGE(PG8_SA(0, 1), a2 + hA, voffA);
            PG8_WAIT_V(8); PG8_WAIT_L(0); PG8_BAR; PG8_MMA(0, 0, At, B0); PG8_MMA(0, 1, At, B1); PG8_BAR; PG8_SCHED;
            PG8_LDA(At, 1, 1); PG8_STAGE(PG8_SB(1, 0), b3, voffB); PG8_STAGE(PG8_SB(1, 1), b3 + hB, voffB); PG8_STAGE(PG8_SA(1, 0), a3, voffA);
            PG8_WAIT_V(8); PG8_WAIT_L(0); PG8_BAR; PG8_MMA(1, 0, At, B0); PG8_MMA(1, 1, At, B1); PG8_BAR; PG8_SCHED;
        }
        if constexpr (ALIGN_EPI) { if (wr == 0) PG8_BAR; }
        if constexpr (!Epi::AFTER_DRAIN) { E(acc, cur, wr, wc, fr, fq); }
        if (!has_next) break;
#pragma unroll
        for (int a = 0; a < 2; ++a)
#pragma unroll
            for (int b = 0; b < 2; ++b)
#pragma unroll
                for (int m = 0; m < 4; ++m)
#pragma unroll
                    for (int n = 0; n < 2; ++n) acc[a][b][m][n] = (f32x4){0.f, 0.f, 0.f, 0.f};
        cur = nxt; cA = nA; cB = nB; ++ui;
        if constexpr (ALIGN_EPI) { if (wr == 1) PG8_BAR; }
    }
    PG8_WAIT_V(0);
    if constexpr (!ALIGN_EPI) { if (wr == 0) PG8_BAR; }
    PG8_BAR;
    if constexpr (Epi::AFTER_DRAIN) { E.fused(acc, cur, wr, wc, fr, fq, lds, wid, lane); }
#undef PG8_SA
#undef PG8_SB
#undef PG8_STAGE
#undef PG8_LDA
#undef PG8_LDB
#undef PG8_MMA
#undef PG8_WAIT_V
#undef PG8_WAIT_L
#undef PG8_BAR
#undef PG8_SCHED
}
}
namespace pg8 {
struct XkvOrder {
    int G, c;
    __device__ bool next(int i, Unit& u) const {
        const int L = i * G + c; if (L >= 256) return false;
        const int kq = L & 3, tile = L >> 2, pm = tile & 3, pn = tile >> 2;
        u.row0 = pm * 256; u.col0 = pn * 256; u.aoff = (long)pm * 256 * DM + kq * 512; u.boff = (long)pn * 256 * DM + kq * 512; u.aux = kq; return true;
    }
};
struct ScoreOrder {
    int G, c;
    __device__ bool next(int i, Unit& u) const {
        const int L = i * G + c; if (L >= 256) return false;
        const int b = L >> 6, h = (L >> 4) & 3, mt = L & 15;
        u.row0 = b * SEQ + mt * 256; u.col0 = h * 256; u.aoff = (long)u.row0 * DM + h * XD; u.boff = (long)(b * NMEM) * DM + h * XD; u.aux = h; return true;
    }
};
struct PvOrder {
    int G, c, rsh;
    __device__ bool next(int i, Unit& u) const {
        const int L = (i >> rsh) * G + c; if (L >= 512) return false;
        const int nt = L & 1, mt = (L >> 1) & 15, h = (L >> 5) & 3, b = L >> 7;
        u.row0 = b * SEQ + mt * 256; u.col0 = h * XD + nt * 256; u.aoff = (long)u.row0 * 1024 + h * 256; u.boff = ((long)(b * XH + h) * XD + nt * 256) * NMEM; u.aux = 0; return true;
    }
};

struct EpiStoreBf16 {
    static constexpr bool PERM = true, AFTER_DRAIN = false;
    bf16_t* O; int ldc; int split_cols; size_t split_stride;
    __device__ __forceinline__ void operator()(const f32x4 (&acc)[2][2][4][2], const Unit& u, int wr, int wc, int fr, int fq) const {
        int colt = u.col0; bf16_t* base = O;
        if (split_cols) { const int t = colt / split_cols; base += (size_t)t * split_stride; colt -= t * split_cols; }
        const int row0 = u.row0 + wr * 64 + fr, col0 = colt + wc * 32 + 8 * fq;
#pragma unroll
        for (int ai = 0; ai < 2; ++ai)
#pragma unroll
            for (int m = 0; m < 4; ++m) { bf16_t* rowp = base + (size_t)(row0 + ai * HALF + m * 16) * ldc + col0;
#pragma unroll
                for (int bj = 0; bj < 2; ++bj) { const f32x4 v0 = acc[ai][bj][m][0], v1 = acc[ai][bj][m][1];
                    u32x4 w; w.x = cvt_pk_bf16(v0[0], v0[1]); w.y = cvt_pk_bf16(v0[2], v0[3]); w.z = cvt_pk_bf16(v1[0], v1[1]); w.w = cvt_pk_bf16(v1[2], v1[3]);
                    *(u32x4*)(rowp + bj * HALF) = w; } }
    }
};
struct EpiSlab {
    static constexpr bool PERM = false, AFTER_DRAIN = false;
    float* slab; int ldc; size_t slab_stride;
    __device__ __forceinline__ void operator()(const f32x4 (&acc)[2][2][4][2], const Unit& u, int wr, int wc, int fr, int fq) const {
        float* base = slab + (size_t)u.aux * slab_stride; const int col0 = u.col0 + wc * 32 + 4 * fq;
#pragma unroll
        for (int ai = 0; ai < 2; ++ai)
#pragma unroll
            for (int m = 0; m < 4; ++m) { float* rowp = base + (size_t)(u.row0 + ai * HALF + wr * 64 + m * 16 + fr) * ldc + col0;
#pragma unroll
                for (int bj = 0; bj < 2; ++bj)
#pragma unroll
                    for (int n = 0; n < 2; ++n) *(f32x4*)(rowp + bj * HALF + n * 16) = acc[ai][bj][m][n]; }
    }
};
template <bool BASEF, bool OUTF>
struct EpiResid {
    static constexpr bool PERM = true, AFTER_DRAIN = false;
    const void* base; void* out; float* ssq; int ldc;
    __device__ __forceinline__ void operator()(const f32x4 (&acc)[2][2][4][2], const Unit& u, int wr, int wc, int fr, int fq) const {
        const int col0 = u.col0 + wc * 32 + 8 * fq;
        float ssum[2][4];
#pragma unroll
        for (int ai = 0; ai < 2; ++ai) {
            f32x4 bv[4][2][2];
#pragma unroll
            for (int m = 0; m < 4; ++m) { const size_t off = (size_t)(u.row0 + ai * HALF + wr * 64 + m * 16 + fr) * ldc + col0;
#pragma unroll
                for (int bj = 0; bj < 2; ++bj) {
                    if constexpr (BASEF) { bv[m][bj][0] = *(const f32x4*)((const float*)base + off + bj * HALF); bv[m][bj][1] = *(const f32x4*)((const float*)base + off + bj * HALF + 4); }
                    else { const u32x4 w = *(const u32x4*)((const bf16_t*)base + off + bj * HALF);
                        bv[m][bj][0] = (f32x4){__builtin_bit_cast(float, w.x << 16), __builtin_bit_cast(float, w.x & 0xffff0000u), __builtin_bit_cast(float, w.y << 16), __builtin_bit_cast(float, w.y & 0xffff0000u)};
                        bv[m][bj][1] = (f32x4){__builtin_bit_cast(float, w.z << 16), __builtin_bit_cast(float, w.z & 0xffff0000u), __builtin_bit_cast(float, w.w << 16), __builtin_bit_cast(float, w.w & 0xffff0000u)}; } } }
#pragma unroll
            for (int m = 0; m < 4; ++m) { const size_t off = (size_t)(u.row0 + ai * HALF + wr * 64 + m * 16 + fr) * ldc + col0; float s = 0.f;
#pragma unroll
                for (int bj = 0; bj < 2; ++bj) { const f32x4 v0 = bv[m][bj][0] + acc[ai][bj][m][0], v1 = bv[m][bj][1] + acc[ai][bj][m][1];
                    if constexpr (OUTF) { *(f32x4*)((float*)out + off + bj * HALF) = v0; *(f32x4*)((float*)out + off + bj * HALF + 4) = v1; }
                    else { u32x4 w; w.x = cvt_pk_bf16(v0[0], v0[1]); w.y = cvt_pk_bf16(v0[2], v0[3]); w.z = cvt_pk_bf16(v1[0], v1[1]); w.w = cvt_pk_bf16(v1[2], v1[3]);
                        *(u32x4*)((bf16_t*)out + off + bj * HALF) = w; }
                    s += (v0[0] * v0[0] + v0[1] * v0[1]) + (v0[2] * v0[2] + v0[3] * v0[3]) + (v1[0] * v1[0] + v1[1] * v1[1]) + (v1[2] * v1[2] + v1[3] * v1[3]); }
                s += __shfl_xor(s, 16); s += __shfl_xor(s, 32); ssum[ai][m] = s; } }
        if (ssq && u.aux == 0) {
#pragma unroll
            for (int ai = 0; ai < 2; ++ai) { const float v = fq == 0 ? ssum[ai][0] : fq == 1 ? ssum[ai][1] : fq == 2 ? ssum[ai][2] : ssum[ai][3];
                atomicAdd(ssq + u.row0 + ai * HALF + wr * 64 + fq * 16 + fr, v); }
        }
    }
};
struct EpiQ {
    static constexpr bool PERM = true, AFTER_DRAIN = false;
    bf16_t* O; const float* ssq_in; float* ssq_out;
    __device__ __forceinline__ void operator()(const f32x4 (&acc)[2][2][4][2], const Unit& u, int wr, int wc, int fr, int fq) const {
        const int col0 = u.col0 + wc * 32 + 8 * fq; float* so = ssq_out + (size_t)(u.col0 / XD) * MTOK;
        float ssum[2][4];
#pragma unroll
        for (int ai = 0; ai < 2; ++ai)
#pragma unroll
            for (int m = 0; m < 4; ++m) { const int row = u.row0 + ai * HALF + wr * 64 + m * 16 + fr; const float ri = __builtin_amdgcn_rsqf(ssq_in[row] * (1.0f / DM) + EPS);
                bf16_t* rowp = O + (size_t)row * DM + col0; float s = 0.f;
#pragma unroll
                for (int bj = 0; bj < 2; ++bj) { const f32x4 v0 = acc[ai][bj][m][0] * ri, v1 = acc[ai][bj][m][1] * ri;
                    u32x4 w; w.x = cvt_pk_bf16(v0[0], v0[1]); w.y = cvt_pk_bf16(v0[2], v0[3]); w.z = cvt_pk_bf16(v1[0], v1[1]); w.w = cvt_pk_bf16(v1[2], v1[3]);
                    *(u32x4*)(rowp + bj * HALF) = w;
                    s += (v0[0] * v0[0] + v0[1] * v0[1]) + (v0[2] * v0[2] + v0[3] * v0[3]) + (v1[0] * v1[0] + v1[1] * v1[1]) + (v1[2] * v1[2] + v1[3] * v1[3]); }
                s += __shfl_xor(s, 16); s += __shfl_xor(s, 32); ssum[ai][m] = s; }
        if (u.aux == 0)
#pragma unroll
        for (int ai = 0; ai < 2; ++ai) { const float v = fq == 0 ? ssum[ai][0] : fq == 1 ? ssum[ai][1] : fq == 2 ? ssum[ai][2] : ssum[ai][3];
            atomicAdd(so + u.row0 + ai * HALF + wr * 64 + fq * 16 + fr, v); }
    }
};
struct EpiUp {
    static constexpr bool PERM = true, AFTER_DRAIN = false;
    bf16_t* O; const float* ssq_in;
    __device__ __forceinline__ void operator()(const f32x4 (&acc)[2][2][4][2], const Unit& u, int wr, int wc, int fr, int fq) const {
        const int col0 = u.col0 + wc * 32 + 8 * fq;
#pragma unroll
        for (int ai = 0; ai < 2; ++ai)
#pragma unroll
            for (int m = 0; m < 4; ++m) { const int row = u.row0 + ai * HALF + wr * 64 + m * 16 + fr; const float ri = __builtin_amdgcn_rsqf(ssq_in[row] * (1.0f / DM) + EPS);
                bf16_t* rowp = O + (size_t)row * DFF + col0;
#pragma unroll
                for (int bj = 0; bj < 2; ++bj) { f32x4 v0 = acc[ai][bj][m][0] * ri, v1 = acc[ai][bj][m][1] * ri;
#pragma unroll
                    for (int e = 0; e < 4; ++e) { const float a = fmaxf(v0[e], 0.f), b = fmaxf(v1[e], 0.f); v0[e] = a * a; v1[e] = b * b; }
                    u32x4 w; w.x = cvt_pk_bf16(v0[0], v0[1]); w.y = cvt_pk_bf16(v0[2], v0[3]); w.z = cvt_pk_bf16(v1[0], v1[1]); w.w = cvt_pk_bf16(v1[2], v1[3]);
                    *(u32x4*)(rowp + bj * HALF) = w; } }
    }
};
struct EpiSoftmax {
    static constexpr bool PERM = true, AFTER_DRAIN = true;
    bf16_t* P; const float* ssqq;
    __device__ __forceinline__ void fused(f32x4 (&acc)[2][2][4][2], const Unit& u, int wr, int wc, int fr, int fq, PG8_LAS unsigned char* lds, int wid, int lane) const {
        PG8_LAS float* RM = (PG8_LAS float*)lds;
        PG8_LAS float* RS = (PG8_LAS float*)(lds + 4096);
        const float* sq = ssqq + (size_t)u.aux * MTOK;
        float mx[2][4];
#pragma unroll
        for (int ai = 0; ai < 2; ++ai)
#pragma unroll
            for (int m = 0; m < 4; ++m) { const int rl = ai * HALF + wr * 64 + m * 16 + fr; const int row = u.row0 + rl;
                const float sc = __builtin_amdgcn_rsqf(sq[row] * (1.0f / XD) + EPS) * (0.044194173824159216f * LOG2E);
                float mxx = -3.0e38f;
#pragma unroll
                for (int bj = 0; bj < 2; ++bj)
#pragma unroll
                    for (int n = 0; n < 2; ++n) { f32x4 v = acc[ai][bj][m][n] * sc; acc[ai][bj][m][n] = v; mxx = fmaxf(mxx, fmaxf(fmaxf(v[0], v[1]), fmaxf(v[2], v[3]))); }
                mxx = fmaxf(mxx, __shfl_xor(mxx, 16)); mxx = fmaxf(mxx, __shfl_xor(mxx, 32));
                if (fq == 0) RM[rl * 4 + wc] = mxx; }
        asm volatile("s_waitcnt lgkmcnt(0)" ::: "memory"); __builtin_amdgcn_s_barrier(); asm volatile("" ::: "memory");
#pragma unroll
        for (int ai = 0; ai < 2; ++ai)
#pragma unroll
            for (int m = 0; m < 4; ++m) { const int rl = ai * HALF + wr * 64 + m * 16 + fr;
                const f32x4 r4 = *(const PG8_LAS f32x4*)(RM + rl * 4); const float mxx = fmaxf(fmaxf(r4[0], r4[1]), fmaxf(r4[2], r4[3])); mx[ai][m] = mxx; float s = 0.f;
#pragma unroll
                for (int bj = 0; bj < 2; ++bj)
#pragma unroll
                    for (int n = 0; n < 2; ++n) { f32x4 v = acc[ai][bj][m][n];
#pragma unroll
                        for (int e = 0; e < 4; ++e) { v[e] = __builtin_amdgcn_exp2f(v[e] - mxx); s += v[e]; }
                        acc[ai][bj][m][n] = v; }
                s += __shfl_xor(s, 16); s += __shfl_xor(s, 32);
                if (fq == 0) RS[rl * 4 + wc] = s; }
        asm volatile("s_waitcnt lgkmcnt(0)" ::: "memory"); __builtin_amdgcn_s_barrier(); asm volatile("" ::: "memory");
        const int col0 = u.col0 + wc * 32 + 8 * fq;
#pragma unroll
        for (int ai = 0; ai < 2; ++ai)
#pragma unroll
            for (int m = 0; m < 4; ++m) { const int rl = ai * HALF + wr * 64 + m * 16 + fr;
                const f32x4 r4 = *(const PG8_LAS f32x4*)(RS + rl * 4); const float inv = 1.0f / ((r4[0] + r4[1]) + (r4[2] + r4[3]));
                bf16_t* rowp = P + (size_t)(u.row0 + rl) * 1024 + col0;
#pragma unroll
                for (int bj = 0; bj < 2; ++bj) { const f32x4 v0 = acc[ai][bj][m][0] * inv, v1 = acc[ai][bj][m][1] * inv;
                    u32x4 w; w.x = cvt_pk_bf16(v0[0], v0[1]); w.y = cvt_pk_bf16(v0[2], v0[3]); w.z = cvt_pk_bf16(v1[0], v1[1]); w.w = cvt_pk_bf16(v1[2], v1[3]);
                    *(u32x4*)(rowp + bj * HALF) = w; } }
        (void)mx; (void)wid; (void)lane;
    }
};
}
namespace fox {
typedef short bf16x8 __attribute__((ext_vector_type(8)));
typedef short s16x4 __attribute__((ext_vector_type(4)));
typedef float f32x16 __attribute__((ext_vector_type(16)));
typedef float f32x4 __attribute__((ext_vector_type(4)));
typedef unsigned u32x4 __attribute__((ext_vector_type(4)));
constexpr int D = 128, PITCH = 1024, OPITCH = 2048;
constexpr int NW = 8, QBLK = 32, KVBLK = 64, QB = NW * QBLK;
constexpr int SHM_V = KVBLK * D * 2, SHM_K = KVBLK * D * 2;
constexpr int LDS_BIAS = 0, LDS_WS = 512, LDS_V = 4096, LDS_K = LDS_V + 2 * SHM_V, LDS_Q = LDS_K + 2 * SHM_K, LDS_BYTES = LDS_Q + NW * 8192;
constexpr float SCALE = 0.08838834764831845f, C2 = LOG2E * SCALE, THR = 8.f;

#define KSWZ(row, colB) ((row) * 256 + ((colB) ^ (((row) & 7) << 4)))
#define SBAR() __builtin_amdgcn_sched_barrier(0)
__device__ __forceinline__ int v_st(int k, int c) { const int kk = (k & ~0xC) | ((k & 4) << 1) | ((k & 8) >> 1); return ((kk >> 3) * 4 + (c >> 5)) * 512 + ((kk & 7) * 32 + (c & 31)) * 2; }
__device__ __forceinline__ int v_rd_base(int lane) { return ((lane & 3) << 3) | (((lane >> 2) & 3) << 6) | (((lane >> 4) & 1) << 5) | (((lane >> 5) & 1) << 8); }
constexpr int v_rd_off(int d0, int ks, int half) { return d0 * 512 + ks * 4096 + half * 2048; }
__device__ __forceinline__ int crow(int r, int hi) { return (r & 3) + 8 * (r >> 2) + 4 * hi; }
__device__ __forceinline__ unsigned cvtpk(float lo, float hi) { unsigned r; asm volatile("v_cvt_pk_bf16_f32 %0, %1, %2" : "=v"(r) : "v"(lo), "v"(hi)); return r; }
__device__ __forceinline__ bf16x8 load8(const bf16* p) { return *reinterpret_cast<const bf16x8*>(p); }

__device__ __forceinline__ void mask_tile(f32x16& p0, f32x16& p1, int dq) {
    const float NEG = -__builtin_inff();
#pragma unroll
    for (int r = 0; r < 16; ++r) { const int c = (r & 3) + 8 * (r >> 2);
        if (dq - c < 0) p0[r] = NEG;
        if (dq - c - 32 < 0) p1[r] = NEG; }
}
__device__ __forceinline__ void partialSM(f32x16& p0, f32x16& p1, float& m_reg, float& mn, float& alpha) {
    float pmax = p0[0];
#pragma unroll
    for (int r = 1; r < 16; ++r) pmax = fmaxf(pmax, p0[r]);
#pragma unroll
    for (int r = 0; r < 16; ++r) pmax = fmaxf(pmax, p1[r]);
    { auto rr = __builtin_amdgcn_permlane32_swap(__float_as_uint(pmax), __float_as_uint(pmax), false, false);
      pmax = fmaxf(__uint_as_float(rr[0]), __uint_as_float(rr[1])); }
    if (__builtin_expect(__all((pmax - m_reg) * SCALE <= THR), 1)) { mn = m_reg; alpha = 1.f; }
    else { mn = fmaxf(m_reg, pmax); alpha = __builtin_amdgcn_exp2f((m_reg - mn) * C2); m_reg = mn; }
    const float mnL = -mn * C2;
#pragma unroll
    for (int r = 0; r < 16; ++r) p0[r] = fmaf(p0[r], C2, mnL);
#pragma unroll
    for (int r = 0; r < 16; ++r) p1[r] = fmaf(p1[r], C2, mnL);
#pragma unroll
    for (int r = 0; r < 16; ++r) p0[r] = __builtin_amdgcn_exp2f(p0[r]);
}
__device__ __forceinline__ void finishSM(f32x16& p0, f32x16& p1, float alpha, float& l_reg, bf16x8& pa0, bf16x8& pa1, bf16x8& pa2, bf16x8& pa3) {
#pragma unroll
    for (int r = 0; r < 16; ++r) p1[r] = __builtin_amdgcn_exp2f(p1[r]);
    float ps = 0;
#pragma unroll
    for (int r = 0; r < 16; ++r) ps += p0[r];
#pragma unroll
    for (int r = 0; r < 16; ++r) ps += p1[r];
    { auto rr = __builtin_amdgcn_permlane32_swap(__float_as_uint(ps), __float_as_uint(ps), false, false);
      ps = __uint_as_float(rr[0]) + __uint_as_float(rr[1]); }
    l_reg = l_reg * alpha + ps;
#define PK4(P, B_, OUT) do { unsigned a0 = cvtpk(P[B_+0], P[B_+1]), a1 = cvtpk(P[B_+2], P[B_+3]);                          \
        unsigned b0 = cvtpk(P[B_+4], P[B_+5]), b1 = cvtpk(P[B_+6], P[B_+7]);                                             \
        auto r0 = __builtin_amdgcn_permlane32_swap(a0, b0, false, false); auto r1 = __builtin_amdgcn_permlane32_swap(a1, b1, false, false); \
        u32x4 w = {r0[0], r1[0], r0[1], r1[1]}; OUT = *reinterpret_cast<bf16x8*>(&w); } while (0)
    PK4(p0, 0, pa0); PK4(p0, 8, pa1); PK4(p1, 0, pa2); PK4(p1, 8, pa3);
#undef PK4
}
template <int KB>
__device__ __forceinline__ void qkt(f32x16& p0, f32x16& p1, const char* K_lds, const float* bl, int r32, int hi, const char* qw) {
#pragma unroll
    for (int g = 0; g < 4; ++g) { const f32x4 b0 = *(const f32x4*)(bl + KB * 64 + 8 * g + 4 * hi), b1 = *(const f32x4*)(bl + KB * 64 + 32 + 8 * g + 4 * hi);
#pragma unroll
        for (int i = 0; i < 4; ++i) { p0[4 * g + i] = b0[i]; p1[4 * g + i] = b1[i]; } }
    const char* kb[4];
#pragma unroll
    for (int dd = 0; dd < 4; ++dd) kb[dd] = K_lds + KB * SHM_K + KSWZ(r32, (dd * 16 + hi * 8) * 2);
#pragma unroll
    for (int d0 = 0; d0 < 8; ++d0) { const char* a = kb[d0 & 3] + (d0 >> 2) * 128;
        bf16x8 b0 = *reinterpret_cast<const bf16x8*>(a);
        bf16x8 b1 = *reinterpret_cast<const bf16x8*>(a + 32 * 256);
        const bf16x8 qf = *reinterpret_cast<const bf16x8*>(qw + d0 * 1024);
        p0 = __builtin_amdgcn_mfma_f32_32x32x16_bf16(b0, qf, p0, 0, 0, 0);
        p1 = __builtin_amdgcn_mfma_f32_32x32x16_bf16(b1, qf, p1, 0, 0, 0); }
}
template <int VB>
__device__ __forceinline__ void pv_tile(f32x16* o, int vb0, bf16x8 pa0, bf16x8 pa1, bf16x8 pa2, bf16x8 pa3) {
#define TRRD(dst, off) asm volatile("ds_read_b64_tr_b16 %0, %1 offset:%2" : "=&v"(dst) : "v"(vb0), "i"(off) : "memory")
#define PV_D0(d0) do { s16x4 l0, l1, l2, l3, h0, h1, h2, h3; constexpr int b_ = VB * SHM_V + v_rd_off(d0, 0, 0); \
        TRRD(l0, b_); TRRD(h0, b_ + 2048); TRRD(l1, b_ + 4096); TRRD(h1, b_ + 6144); TRRD(l2, b_ + 8192); TRRD(h2, b_ + 10240); TRRD(l3, b_ + 12288); TRRD(h3, b_ + 14336); \
        asm volatile("s_waitcnt lgkmcnt(0)" ::: "memory"); SBAR();   \
        o[d0] = __builtin_amdgcn_mfma_f32_32x32x16_bf16(pa0, (bf16x8){l0[0], l0[1], l0[2], l0[3], h0[0], h0[1], h0[2], h0[3]}, o[d0], 0, 0, 0);   \
        o[d0] = __builtin_amdgcn_mfma_f32_32x32x16_bf16(pa1, (bf16x8){l1[0], l1[1], l1[2], l1[3], h1[0], h1[1], h1[2], h1[3]}, o[d0], 0, 0, 0);   \
        o[d0] = __builtin_amdgcn_mfma_f32_32x32x16_bf16(pa2, (bf16x8){l2[0], l2[1], l2[2], l2[3], h2[0], h2[1], h2[2], h2[3]}, o[d0], 0, 0, 0);   \
        o[d0] = __builtin_amdgcn_mfma_f32_32x32x16_bf16(pa3, (bf16x8){l3[0], l3[1], l3[2], l3[3], h3[0], h3[1], h3[2], h3[3]}, o[d0], 0, 0, 0); } while (0)
    PV_D0(0); PV_D0(1); PV_D0(2); PV_D0(3);
#undef PV_D0
#undef TRRD
}

struct Item { unsigned rowb, o; const float* CS; const float* G; int P0, jlo; };
struct Seam { bf16x8 qr[8]; bf16x8 st_v0, st_v1, st_k0, st_k1; };
typedef __amdgpu_buffer_rsrc_t Srd;
#define BL8(rs, vo, so) __builtin_bit_cast(bf16x8, __builtin_amdgcn_raw_buffer_load_b128((rs), (vo), (so), 0))
#define VMW() asm volatile("s_waitcnt vmcnt(0)" ::: "memory")
#define VMWN(n) asm volatile("s_waitcnt vmcnt(%0)" :: "i"(n) : "memory")
#define SLOAD_H(H, k0, bb) do { const unsigned so_ = (unsigned)(k0) * (PITCH * 2);                                               \
                         S.st_v0 = BL8(R, kvoff, (unsigned)WS_FV + (H).rowb + so_); S.st_v1 = BL8(R, kvoff, (unsigned)WS_FV + (H).rowb + so_ + 32 * PITCH * 2);   \
                         S.st_k0 = BL8(R, kvoff, (unsigned)WS_FK + (H).rowb + so_); S.st_k1 = BL8(R, kvoff, (unsigned)WS_FK + (H).rowb + so_ + 32 * PITCH * 2);   \
                         if (wid == 0) __builtin_amdgcn_global_load_lds((const unsigned*)((H).CS + (k0)) + lane, (__attribute__((address_space(3))) unsigned*)(B3 + (bb) * 64), 4, 0, 0); } while (0)
#define QLOAD(H) do { const unsigned so_ = (unsigned)((H).P0 + wid * QBLK) * (PITCH * 2);                                   \
        _Pragma("unroll") for (int d0 = 0; d0 < 8; ++d0) S.qr[d0] = BL8(R, qoff + d0 * 32, (unsigned)WS_FQ + (H).rowb + so_); } while (0)
#define SWRITE_HK(bf) do { *(bf16x8*)(K_lds + (bf) * SHM_K + kws) = S.st_k0; *(bf16x8*)(K_lds + (bf) * SHM_K + kws + 32 * 256) = S.st_k1; } while (0)
#define SWRITE_HV(bf) do { *(bf16x8*)(V_lds + (bf) * SHM_V + vst0) = S.st_v0; *(bf16x8*)(V_lds + (bf) * SHM_V + vst1) = S.st_v1; } while (0)
#define SWRITE_H(bf) do { SWRITE_HV(bf); SWRITE_HK(bf); } while (0)

__device__ __forceinline__ void fox_prime(const Srd R, const Item& H, char* lds, Seam& S) {
    int tid_ = threadIdx.x; asm volatile("" : "+v"(tid_));
    const int tid = tid_, wid = __builtin_amdgcn_readfirstlane(tid >> 6), lane = tid & 63, r32 = lane & 31, hi = lane >> 5;
    const int sr = tid >> 4, sc = (tid & 15) * 8, kws = KSWZ(sr, sc * 2); char* K_lds = lds + LDS_K; float* B_lds = (float*)(lds + LDS_BIAS);
    const unsigned kvoff = (unsigned)(sr * PITCH + sc) * 2u, qoff = (unsigned)(r32 * PITCH + hi * 8) * 2u;
    __attribute__((address_space(3))) float* B3 = (__attribute__((address_space(3))) float*)B_lds;
    QLOAD(H);
    SLOAD_H(H, H.jlo * KVBLK, 0); VMW(); SWRITE_HK(0);
    { char* qw = lds + LDS_Q + wid * 8192 + lane * 16;
#pragma unroll
      for (int d0 = 0; d0 < 8; ++d0) *(bf16x8*)(qw + d0 * 1024) = S.qr[d0]; }
    __syncthreads();
}
template <class NextFn>
__device__ __forceinline__ int fox_block(const Srd R, const Item& H, const NextFn& next_item, char* lds, Seam& S) {
    const int P0 = H.P0;
    int tid_ = threadIdx.x; asm volatile("" : "+v"(tid_));
    const int tid = tid_, wid = __builtin_amdgcn_readfirstlane(tid >> 6), lane = tid & 63, r32 = lane & 31, hi = lane >> 5;
    const int NT = P0 / KVBLK + 4 - H.jlo;
    const int qlo = P0 + wid * QBLK, qm = qlo + r32 - 4 * hi;
    char* V_lds = lds + LDS_V; char* K_lds = lds + LDS_K; float* B_lds = (float*)(lds + LDS_BIAS);
    char* qw = lds + LDS_Q + wid * 8192 + lane * 16;
    float* ws = (float*)(lds + LDS_WS) + wid * 64; float* li_l = ws, * al_l = ws + 32;
    float m_reg = -1e30f, l_reg = 0; f32x16 o[4] = {};
    const int sr = tid >> 4, sc = (tid & 15) * 8, vst0 = v_st(sr, sc), vst1 = v_st(32 + sr, sc), kws = KSWZ(sr, sc * 2);
    const int vb0 = (int)(uintptr_t)V_lds + v_rd_base(lane);
    const unsigned kvoff = (unsigned)(sr * PITCH + sc) * 2u, qoff = (unsigned)(r32 * PITCH + hi * 8) * 2u;
    __attribute__((address_space(3))) float* B3 = (__attribute__((address_space(3))) float*)B_lds;
#define RESC(a) do { if (__any((a) < 1.f)) { if (hi == 0) al_l[r32] = (a); asm volatile("s_waitcnt lgkmcnt(0)" ::: "memory");              \
                     for (int d_ = 0; d_ < 4; ++d_) for (int r = 0; r < 16; ++r) o[d_][r] *= al_l[crow(r, hi)]; } } while (0)
#define KBASE(t) ((H.jlo + (t)) * KVBLK)
#define MASKT(P0_, P1_, t) do { const int kb_ = KBASE(t); if (kb_ + KVBLK - 1 > qlo) mask_tile(P0_, P1_, qm - kb_); } while (0)
    f32x16 pA0, pA1, pB0, pB1; float mnA, mnB, alA, alB; bf16x8 pa0, pa1, pa2, pa3;
    SWRITE_HV(0); SBAR();
    SLOAD_H(H, KBASE(1), 1);
    SBAR(); qkt<0>(pA0, pA1, K_lds, B_lds, r32, hi, qw);
    MASKT(pA0, pA1, 0); partialSM(pA0, pA1, m_reg, mnA, alA);
    VMW(); SWRITE_H(1);
    __syncthreads();
#define HALF_STEP(PX0, PX1, mnX, alX, PY0, PY1, alY, t, KB, VB, SB) do {                                                      \
        SBAR(); qkt<KB>(PX0, PX1, K_lds, B_lds, r32, hi, qw);                                                                 \
        finishSM(PY0, PY1, alY, l_reg, pa0, pa1, pa2, pa3); SBAR();                                                           \
        if ((t) + 1 < NT) { SLOAD_H(H, KBASE((t) + 1), SB); SBAR(); }                                                                \
        pv_tile<VB>(o, vb0, pa0, pa1, pa2, pa3); MASKT(PX0, PX1, (t)); partialSM(PX0, PX1, m_reg, mnX, alX);                  \
        __syncthreads();                                                                                                      \
        if ((t) + 1 < NT) { VMW(); SWRITE_H(SB); }                                                                      \
        RESC(alX); __syncthreads(); } while (0)
    for (int t = 1; t + 1 < NT; t += 2) {
        HALF_STEP(pB0, pB1, mnB, alB, pA0, pA1, alA, t, 1, 0, 0);
        HALF_STEP(pA0, pA1, mnA, alA, pB0, pB1, alB, t + 1, 0, 1, 1);
    }
    SBAR(); qkt<1>(pB0, pB1, K_lds, B_lds, r32, hi, qw); SBAR();
    int nidx; const Item N = next_item(H, nidx);
    SLOAD_H(N, N.jlo * KVBLK, 0); SBAR();
    QLOAD(N);
    SBAR();
    finishSM(pA0, pA1, alA, l_reg, pa0, pa1, pa2, pa3); SBAR();
    pv_tile<0>(o, vb0, pa0, pa1, pa2, pa3);
    MASKT(pB0, pB1, NT - 1); partialSM(pB0, pB1, m_reg, mnB, alB); __syncthreads(); RESC(alB);
    finishSM(pB0, pB1, alB, l_reg, pa0, pa1, pa2, pa3); SBAR(); pv_tile<1>(o, vb0, pa0, pa1, pa2, pa3);
    SBAR(); VMWN(8); SWRITE_HK(0); SBAR();
    if (hi == 0) li_l[r32] = l_reg; asm volatile("s_waitcnt lgkmcnt(0)" ::: "memory");
    float gn[4];
#pragma unroll
    for (int d0 = 0; d0 < 4; ++d0) gn[d0] = H.G[d0 * 32 + r32];
    const unsigned ovoff = (unsigned)(4 * hi * OPITCH + r32) * 2u;
#pragma unroll
    for (int r = 0; r < 16; ++r) { const float rli = __builtin_amdgcn_rcpf(li_l[crow(r, hi)]); float ss = 0.f;
#pragma unroll
        for (int d0 = 0; d0 < 4; ++d0) { o[d0][r] *= rli; ss += o[d0][r] * o[d0][r]; }
        ss += __shfl_xor(ss, 1); ss += __shfl_xor(ss, 2); ss += __shfl_xor(ss, 4); ss += __shfl_xor(ss, 8); ss += __shfl_xor(ss, 16);
        const float rs = __builtin_amdgcn_rsqf(ss * (1.0f / D) + EPS);
        const unsigned so_ = (unsigned)(P0 + wid * QBLK + (r & 3) + 8 * (r >> 2)) * (OPITCH * 2);
#pragma unroll
        for (int d0 = 0; d0 < 4; ++d0) { const float v = o[d0][r] * rs * gn[d0];
            const float vn = __shfl_xor(v, 1);
            if ((r32 & 1) == 0) __builtin_amdgcn_raw_buffer_store_b32(cvtpk(v, vn), R, ovoff + d0 * 64, H.o + so_, 0); } }
#pragma unroll
    for (int d0 = 0; d0 < 8; ++d0) *(bf16x8*)(qw + d0 * 1024) = S.qr[d0];
    __syncthreads();
    return nidx;
#undef RESC
#undef KBASE
#undef MASKT
#undef HALF_STEP
}
#undef BL8
#undef QLOAD
#undef VMW
#undef VMWN
#undef SLOAD_H
#undef SWRITE_HK
#undef SWRITE_HV
#undef SWRITE_H
#undef KSWZ
#undef SBAR
}
namespace mls {
typedef short bf16x8 __attribute__((ext_vector_type(8)));
typedef short bf16x4 __attribute__((ext_vector_type(4)));
typedef float f32x4 __attribute__((ext_vector_type(4)));
#define MFMA16(a, b, c) __builtin_amdgcn_mfma_f32_16x16x32_bf16((a), (b), (c), 0, 0, 0)

constexpr int CO_CST = 0, CO_VT = 65536, CO_XCH = 98304, CO_LDS_BYTES = CO_XCH + 512;
__device__ __forceinline__ void chunk_out(int b, int h, int c, const bf16* QP, const bf16* KPP, const bf16* VT, const bf16* CST, const float* NST,
                                          const bf16* MO, const float* gain, bf16* concat, __attribute__((address_space(3))) unsigned char* lds) {
    typedef __attribute__((address_space(3))) unsigned char* lptr;
    int tid_ = threadIdx.x; asm volatile("" : "+v"(tid_));
    const int tid = tid_, w = __builtin_amdgcn_readfirstlane(tid >> 6), lane = tid & 63, i16 = lane & 15, q = lane >> 4;
    const int tq = w & 3, dvh = w >> 2;
    const size_t R0 = (size_t)b * SEQ + (size_t)c * 64;
    const size_t item = ((size_t)(b * MLH + h) * NCHUNK + c);
    { const bf16* cs = CST + item * MLDV * MLDK; const bf16* vs = VT + item * MLDV * 64;
#pragma unroll
      for (int j = 0; j < 8; ++j) { const int p = w + 8 * j, row = 4 * p + (lane >> 4), lc = (lane & 15) ^ (row & 15);
          __builtin_amdgcn_global_load_lds((const unsigned*)(cs + row * MLDK + lc * 8), (__attribute__((address_space(3))) unsigned*)(lds + CO_CST + p * 1024), 16, 0, 0); }
#pragma unroll
      for (int j = 0; j < 4; ++j) { const int p = w + 8 * j, row = 8 * p + (lane >> 3), lc = (lane & 7) ^ ((row >> 1) & 7);
          __builtin_amdgcn_global_load_lds((const unsigned*)(vs + row * 64 + lc * 8), (__attribute__((address_space(3))) unsigned*)(lds + CO_VT + p * 1024), 16, 0, 0); } }
    const size_t row = R0 + 16 * tq + i16;
    const bf16* qrow = QP + row * 512 + h * MLDK + 8 * q;
    bf16x8 qf[4];
#pragma unroll
    for (int ks = 0; ks < 4; ++ks) qf[ks] = *(const bf16x8*)(qrow + 32 * ks);
    f32x4 st[4];
#pragma unroll
    for (int stile = 0; stile < 4; ++stile) {
        st[stile] = (f32x4){0.f, 0.f, 0.f, 0.f};
        if (stile <= tq) {
            const bf16* krow = KPP + (R0 + 16 * stile + i16) * 512 + h * MLDK + 8 * q;
            bf16x8 kf[4];
#pragma unroll
            for (int ks = 0; ks < 4; ++ks) kf[ks] = *(const bf16x8*)(krow + 32 * ks);
#pragma unroll
            for (int ks = 0; ks < 4; ++ks) st[stile] = MFMA16(kf[ks], qf[ks], st[stile]);
            if (stile == tq) {
#pragma unroll
                for (int r = 0; r < 4; ++r) if (4 * q + r > i16) st[stile][r] = 0.f;
            }
        }
    }
    float den = 0.f;
#pragma unroll
    for (int stile = 0; stile < 4; ++stile) den += (st[stile][0] + st[stile][1]) + (st[stile][2] + st[stile][3]);
    { const float* nrow = NST + item * MLDK + 8 * q;
#pragma unroll
      for (int ks = 0; ks < 4; ++ks) { const f32x4 n0 = *(const f32x4*)(nrow + 32 * ks), n1 = *(const f32x4*)(nrow + 32 * ks + 4);
          const v4u qq = __builtin_bit_cast(v4u, qf[ks]);
          den += bflo(qq[0]) * n0[0] + bfhi(qq[0]) * n0[1] + bflo(qq[1]) * n0[2] + bfhi(qq[1]) * n0[3]
               + bflo(qq[2]) * n1[0] + bfhi(qq[2]) * n1[1] + bflo(qq[3]) * n1[2] + bfhi(qq[3]) * n1[3]; } }
    den += __shfl_xor(den, 16); den += __shfl_xor(den, 32);
    const int dv0 = h * MLDV + dvh * 128 + 4 * q;
    v2u mo2[8];
#pragma unroll
    for (int dt = 0; dt < 8; ++dt) mo2[dt] = *(const v2u*)(MO + row * 1024 + dv0 + 16 * dt);
    bf16x8 pf[2];
#pragma unroll
    for (int p = 0; p < 2; ++p) { v4u wv; wv[0] = pg8::cvt_pk_bf16(st[2 * p][0], st[2 * p][1]); wv[1] = pg8::cvt_pk_bf16(st[2 * p][2], st[2 * p][3]);
        wv[2] = pg8::cvt_pk_bf16(st[2 * p + 1][0], st[2 * p + 1][1]); wv[3] = pg8::cvt_pk_bf16(st[2 * p + 1][2], st[2 * p + 1][3]); pf[p] = __builtin_bit_cast(bf16x8, wv); }
    const int npair = (tq >> 1) + 1;
    asm volatile("s_waitcnt vmcnt(0)" ::: "memory");
    __syncthreads();
    f32x4 num[8];
    const lptr cb = lds + CO_CST + (dvh * 128 + i16) * 256, vb = lds + CO_VT + (dvh * 128 + i16) * 128 + (q & 1) * 8;
    const int vsw = i16 >> 1;
#pragma unroll
    for (int dt = 0; dt < 8; ++dt) {
        f32x4 a = (f32x4){0.f, 0.f, 0.f, 0.f};
#pragma unroll
        for (int p = 0; p < 2; ++p) if (p < npair) {
            const v2u lo = *(const __attribute__((address_space(3))) v2u*)(vb + dt * 16 * 128 + (((4 * p + (q >> 1)) ^ vsw) * 16));
            const v2u hi2 = *(const __attribute__((address_space(3))) v2u*)(vb + dt * 16 * 128 + (((4 * p + 2 + (q >> 1)) ^ vsw) * 16));
            const v4u vv = {lo[0], lo[1], hi2[0], hi2[1]};
            a = MFMA16(__builtin_bit_cast(bf16x8, vv), pf[p], a); }
#pragma unroll
        for (int ks = 0; ks < 4; ++ks) { const bf16x8 cf = *(const __attribute__((address_space(3))) bf16x8*)(cb + dt * 16 * 256 + (((4 * ks + q) ^ i16) * 16)); a = MFMA16(cf, qf[ks], a); }
        num[dt] = a;
    }
    const float rden = 1.0f / fmaxf(fabsf(den), 1.0f);
    float ss = 0.f;
#pragma unroll
    for (int dt = 0; dt < 8; ++dt) { num[dt] = num[dt] * rden; ss += (num[dt][0] * num[dt][0] + num[dt][1] * num[dt][1]) + (num[dt][2] * num[dt][2] + num[dt][3] * num[dt][3]); }
    ss += __shfl_xor(ss, 16); ss += __shfl_xor(ss, 32);
    __attribute__((address_space(3))) float* xch = (__attribute__((address_space(3))) float*)(lds + CO_XCH);
    if (q == 0) xch[w * 16 + i16] = ss;
    __syncthreads();
    const float tot = ss + xch[(w ^ 4) * 16 + i16];
    const float rn = __builtin_amdgcn_rsqf(tot * (1.0f / MLDV) + EPS);
#pragma unroll
    for (int dt = 0; dt < 8; ++dt) { const int dv = dv0 + 16 * dt;
        const f32x4 g4 = *(const f32x4*)(gain + dv);
        const float o0 = num[dt][0] * rn * g4[0] * sigmoidf_(bflo(mo2[dt][0])), o1 = num[dt][1] * rn * g4[1] * sigmoidf_(bfhi(mo2[dt][0]));
        const float o2 = num[dt][2] * rn * g4[2] * sigmoidf_(bflo(mo2[dt][1])), o3 = num[dt][3] * rn * g4[3] * sigmoidf_(bfhi(mo2[dt][1]));
        v2u ov; ov[0] = pg8::cvt_pk_bf16(o0, o1); ov[1] = pg8::cvt_pk_bf16(o2, o3);
        *(v2u*)(concat + row * 2048 + 1024 + dv) = ov; }
    __syncthreads();
}

__device__ __forceinline__ void state_scan(int bh, int sl, const bf16* KT, const bf16* VT, const float* EB, bf16* CST) {
    int tid_ = threadIdx.x; asm volatile("" : "+v"(tid_));
    const int tid = tid_, w = __builtin_amdgcn_readfirstlane(tid >> 6), lane = tid & 63, i16 = lane & 15, q = lane >> 4;
    const size_t it0 = (size_t)bh * NCHUNK;
    const bf16* ka = KT + (it0 * MLDK + 16 * w + i16) * 64 + 8 * q;
    const bf16* vb = VT + (it0 * MLDV + 16 * sl + i16) * 64 + 8 * q;
    bf16* cs = CST + (it0 * MLDV + 16 * sl + i16) * MLDK + 16 * w + 4 * q;
    const float ebv = EB[it0 + lane];
    f32x4 acc = (f32x4){0.f, 0.f, 0.f, 0.f};
    bf16x8 fa0[8], fa1[8], fb0[8], fb1[8];
#pragma unroll
    for (int j = 0; j < 8; ++j) { fa0[j] = *(const bf16x8*)(ka + (size_t)j * MLDK * 64); fa1[j] = *(const bf16x8*)(ka + (size_t)j * MLDK * 64 + 32);
                                  fb0[j] = *(const bf16x8*)(vb + (size_t)j * MLDV * 64); fb1[j] = *(const bf16x8*)(vb + (size_t)j * MLDV * 64 + 32); }
    for (int c0 = 0; c0 < NCHUNK; c0 += 8) {
#pragma unroll
        for (int j = 0; j < 8; ++j) { const int c = c0 + j;
            v2u ov; ov[0] = pg8::cvt_pk_bf16(acc[0], acc[1]); ov[1] = pg8::cvt_pk_bf16(acc[2], acc[3]);
            *(v2u*)(cs + (size_t)c * MLDV * MLDK) = ov;
            acc = MFMA16(fa0[j], fb0[j], acc); acc = MFMA16(fa1[j], fb1[j], acc);
            const int cn = c + 8 < NCHUNK ? c + 8 : c;
            fa0[j] = *(const bf16x8*)(ka + (size_t)cn * MLDK * 64); fa1[j] = *(const bf16x8*)(ka + (size_t)cn * MLDK * 64 + 32);
            fb0[j] = *(const bf16x8*)(vb + (size_t)cn * MLDV * 64); fb1[j] = *(const bf16x8*)(vb + (size_t)cn * MLDV * 64 + 32);
            const float e = __shfl(ebv, c);
            acc = acc * e; }
    }
}
#undef MFMA16
}
typedef const float* cfp_t;
struct Frame {
    LAS unsigned char* lds; unsigned char* ldsg;
    int tid, lane, wave, vcu, G;
    const __attribute__((address_space(4))) cfp_t* inp; float* out; unsigned char* ws;
};
__device__ __forceinline__ float wave_incl_scan(float v, int lane) {
#pragma unroll
    for (int o = 1; o < 64; o <<= 1) { const float t = __shfl_up(v, o); if (lane >= o) v += t; }
    return v;
}

__device__ __forceinline__ void p0_transpose_item(const float* W, int ldw, int K, bf16* WT, const float* gk, int k0, int n0_dst, int n0_src, LAS float* scr, int lane) {
    float vv[32];
#pragma unroll
    for (int i = 0; i < 32; ++i) { const int kk = 2 * i + (lane >> 5); vv[i] = W[(size_t)(k0 + kk) * ldw + n0_src + (lane & 31)]; }
    if (gk) {
#pragma unroll
        for (int i = 0; i < 32; ++i) vv[i] *= gk[k0 + 2 * i + (lane >> 5)]; }
#pragma unroll
    for (int i = 0; i < 32; ++i) scr[(2 * i + (lane >> 5)) * 33 + (lane & 31)] = vv[i];
    LDS_WAIT(); asm volatile("" ::: "memory");
    const int c = lane & 7;
#pragma unroll
    for (int j = 0; j < 4; ++j) { const int n = (lane >> 3) + 8 * j; const LAS float* s = scr + (8 * c) * 33 + n;
        v4u o; o.x = pk2(s[0 * 33], s[1 * 33]); o.y = pk2(s[2 * 33], s[3 * 33]); o.z = pk2(s[4 * 33], s[5 * 33]); o.w = pk2(s[6 * 33], s[7 * 33]);
        *(GAS v4u*)(WT + (size_t)(n0_dst + n) * K + k0 + 8 * c) = o; }
    LDS_WAIT(); asm volatile("" ::: "memory");
}
__device__ __forceinline__ float rms_row_to_bf16(const float* xrow, const float* g, bf16* orow, int lane) {
    const GAS v4f* xr = (const GAS v4f*)xrow + lane; const GAS v4f* gr = (const GAS v4f*)g + lane;
    v4f v[8]; float s = 0.f;
#pragma unroll
    for (int j = 0; j < 8; ++j) { v[j] = xr[64 * j]; s += (v[j].x * v[j].x + v[j].y * v[j].y) + (v[j].z * v[j].z + v[j].w * v[j].w); }
    const float rinv = 1.0f / sqrtf(wave_sum(s) * (1.f / DM) + EPS);
    GAS v2u* o8 = (GAS v2u*)orow + lane;
#pragma unroll
    for (int j = 0; j < 8; ++j) { const v4f gg = gr[64 * j]; v2u w; w.x = pk2(v[j].x * rinv * gg.x, v[j].y * rinv * gg.y); w.y = pk2(v[j].z * rinv * gg.z, v[j].w * rinv * gg.w); o8[64 * j] = w; }
    return rinv;
}
__device__ __forceinline__ void p0_prologue(Frame& F) {
    const float* x = F.inp[0]; const float* mem = F.inp[1]; const float* mixer_norm = F.inp[2]; const float* w_in = F.inp[3];
    const int gw = F.vcu * 8 + F.wave, NGW = F.G * 8;
    LAS float* WgL = (LAS float*)F.lds;
#pragma unroll 8
    for (int idx = F.tid; idx < 32768; idx += NTHREADS) { const int e = idx & 3, ln = (idx >> 2) & 63, sp = idx >> 8, gate = ln & 15, q = ln >> 4, k = 16 * sp + 4 * q + e;
        const int col = gate < 8 ? 3072 + gate : 5128 + (gate - 8);
        WgL[idx] = w_in[(size_t)k * IN_WIDTH + col] * mixer_norm[k]; }
    __syncthreads();
    { float* gates = (float*)(F.ws + WS_GATES); const int i16 = F.lane & 15, q = F.lane >> 4;
      for (int grp = gw; grp < MTOK / 16; grp += NGW) {
          const float* xr = x + (size_t)(grp * 16 + i16) * DM + 4 * q; v4f acc = (v4f){0.f, 0.f, 0.f, 0.f};
          const LAS float* wp = WgL + F.lane * 4;
#pragma unroll 1
          for (int s0 = 0; s0 < 128; s0 += 16, wp += 16 * 256, xr += 16 * 16) { v4f xb[16];
#pragma unroll
              for (int j = 0; j < 16; ++j) xb[j] = *(const v4f*)(xr + 16 * j);
#pragma unroll
              for (int j = 0; j < 16; ++j) { const v4f x4 = xb[j]; const v4f w4 = *(const LAS v4f*)(wp + j * 256);
                  acc = __builtin_amdgcn_mfma_f32_16x16x4f32(x4.x, w4.x, acc, 0, 0, 0); acc = __builtin_amdgcn_mfma_f32_16x16x4f32(x4.y, w4.y, acc, 0, 0, 0);
                  acc = __builtin_amdgcn_mfma_f32_16x16x4f32(x4.z, w4.z, acc, 0, 0, 0); acc = __builtin_amdgcn_mfma_f32_16x16x4f32(x4.w, w4.w, acc, 0, 0, 0); } }
#pragma unroll
          for (int r = 0; r < 4; ++r) gates[(size_t)(grp * 16 + 4 * q + r) * 16 + i16] = acc[r];
      } }
    { bf16* XN = (bf16*)(F.ws + WS_XN); float* RINV = (float*)(F.ws + WS_RINV);
      for (int m = gw; m < MTOK; m += NGW) { const float ri = rms_row_to_bf16(x + (size_t)m * DM, mixer_norm, XN + (size_t)m * DM, F.lane); if (F.lane == 0) RINV[m] = ri; }
      bf16* MN = (bf16*)(F.ws + WS_MN);
      for (int m = gw; m < MROWS; m += NGW) (void)rms_row_to_bf16(mem + (size_t)m * DM, F.inp[15], MN + (size_t)m * DM, F.lane); }
    __syncthreads();
    LAS float* scr = (LAS float*)(F.lds + F.wave * 16384);
    for (int it = gw; it < 32768; it += NGW) {
        int r = it;
        if (r < 6144) { const int kb = r / 192, nb = r % 192, n0 = 32 * nb, grpc = n0 >> 10, shift = grpc < 3 ? 0 : (grpc < 5 ? 8 : 16);
            p0_transpose_item(w_in, IN_WIDTH, DM, (bf16*)(F.ws + WS_WIN), nullptr, 64 * kb, n0, n0 + shift, scr, F.lane); continue; } r -= 6144;
        if (r < 2048) { p0_transpose_item(F.inp[13], DM, DM, (bf16*)(F.ws + WS_WOUT), nullptr, 64 * (r / 64), 32 * (r % 64), 32 * (r % 64), scr, F.lane); continue; } r -= 2048;
        if (r < 2048) { p0_transpose_item(F.inp[16], DM, DM, (bf16*)(F.ws + WS_WXQ), F.inp[14], 64 * (r / 64), 32 * (r % 64), 32 * (r % 64), scr, F.lane); continue; } r -= 2048;
        if (r < 4096) { p0_transpose_item(F.inp[17], 2 * DM, DM, (bf16*)(F.ws + WS_WXKV), nullptr, 64 * (r / 128), 32 * (r % 128), 32 * (r % 128), scr, F.lane); continue; } r -= 4096;
        if (r < 2048) { p0_transpose_item(F.inp[20], DM, DM, (bf16*)(F.ws + WS_WXO), nullptr, 64 * (r / 64), 32 * (r % 64), 32 * (r % 64), scr, F.lane); continue; } r -= 2048;
        if (r < 8192) { p0_transpose_item(F.inp[22], DFF, DM, (bf16*)(F.ws + WS_WUP), F.inp[21], 64 * (r / 256), 32 * (r % 256), 32 * (r % 256), scr, F.lane); continue; } r -= 8192;
        p0_transpose_item(F.inp[23], DM, DFF, (bf16*)(F.ws + WS_WDN), nullptr, 64 * (r / 64), 32 * (r % 64), 32 * (r % 64), scr, F.lane);
    }
}

constexpr int P2_KT_OFF = 4096, P2_KT_PITCH = 136, P2_VT_OFF = P2_KT_OFF + 64 * P2_KT_PITCH * 2, P2_VT_PITCH = 264;
__device__ __forceinline__ void p2_prep_item(Frame& F, int item, bool do_norm = true) {
    const int b = item >> 6, c = item & 63; const size_t R0 = (size_t)b * SEQ + (size_t)c * 64;
    const int tid = F.tid, lane = F.lane, w = F.wave;
    LAS float* gq = (LAS float*)F.lds; LAS float* uk = gq + 256;
    LAS bf16* kt = (LAS bf16*)(F.lds + P2_KT_OFF); LAS bf16* vt = (LAS bf16*)(F.lds + P2_VT_OFF);
    const float* GATES = (const float*)(F.ws + WS_GATES); const float* RINV = (const float*)(F.ws + WS_RINV);
    if (w < 4) { const size_t row = R0 + lane; const float ri = RINV[row];
        const float mi = GATES[row * 16 + 8 + w] * ri + F.inp[5][w], mf = GATES[row * 16 + 12 + w] * ri + F.inp[6][w];
        const float bcum = wave_incl_scan(logsigmoidf(mf), lane);
        const float g = __expf(bcum), u = __expf(mi - bcum) * 0.08838834764831845f;
        gq[w * 64 + lane] = g; uk[w * 64 + lane] = u;
        if (lane == 63) ((float*)(F.ws + WS_EB))[(size_t)(b * MLH + w) * NCHUNK + c] = g; }
    if (do_norm) { bf16* FQ = (bf16*)(F.ws + WS_FQ); bf16* FK = (bf16*)(F.ws + WS_FK); const int l16 = lane & 15;
      float gqn[8], gkn[8];
#pragma unroll
      for (int e = 0; e < 8; ++e) { gqn[e] = F.inp[9][l16 * 8 + e]; gkn[e] = F.inp[10][l16 * 8 + e]; }
      for (int it0 = w; it0 < 256; it0 += 64) {
          v4u raw[8];
#pragma unroll
          for (int j = 0; j < 8; ++j) { const int seg = (it0 + 8 * j) * 4 + (lane >> 4), row = seg >> 4, hh = seg & 15;
              raw[j] = *(const v4u*)((hh < 8 ? FQ : FK) + (R0 + row) * 1024 + (hh & 7) * FOXD + l16 * 8); }
#pragma unroll
          for (int j = 0; j < 8; ++j) { const int seg = (it0 + 8 * j) * 4 + (lane >> 4), row = seg >> 4, hh = seg & 15;
              bf16* p = (hh < 8 ? FQ : FK) + (R0 + row) * 1024 + (hh & 7) * FOXD + l16 * 8; float v[8];
#pragma unroll
              for (int e = 0; e < 4; ++e) { v[2 * e] = bflo(raw[j][e]); v[2 * e + 1] = bfhi(raw[j][e]); }
              float ss = 0.f;
#pragma unroll
              for (int e = 0; e < 8; ++e) ss += v[e] * v[e];
              ss += __shfl_xor(ss, 1); ss += __shfl_xor(ss, 2); ss += __shfl_xor(ss, 4); ss += __shfl_xor(ss, 8);
              const float ri = 1.0f / sqrtf(ss * (1.0f / FOXD) + EPS);
              v4u o;
#pragma unroll
              for (int e = 0; e < 4; ++e) { const float g0 = hh < 8 ? gqn[2 * e] : gkn[2 * e], g1 = hh < 8 ? gqn[2 * e + 1] : gkn[2 * e + 1]; o[e] = pk2(v[2 * e] * ri * g0, v[2 * e + 1] * ri * g1); }
              *(v4u*)p = o; } } }
    __syncthreads();
    const bf16* MQK = (const bf16*)(F.ws + WS_MQK); const bf16* MV = (const bf16*)(F.ws + WS_MV);
    bf16* QP = (bf16*)(F.ws + WS_QP); bf16* KPP = (bf16*)(F.ws + WS_KPP);
    const float* conv_w = F.inp[7]; const float* conv_b = F.inp[8];
    for (int h = 0; h < MLH; ++h) {
        { const int cgp = tid & 31, rg = tid >> 5; const bool isq = cgp < 16; const int col = (isq ? 0 : 512) + h * MLDK + (cgp & 15) * 8;
          float cw[4][8], cb[8];
#pragma unroll
          for (int e = 0; e < 8; ++e) { cb[e] = conv_b[col + e];
#pragma unroll
              for (int j = 0; j < 4; ++j) cw[j][e] = conv_w[j * 1024 + col + e]; }
          float u[7][8];
#pragma unroll
          for (int i = 0; i < 7; ++i) { const int pos = c * 64 + 4 * rg - 3 + i;
              v4u raw = (v4u){0u, 0u, 0u, 0u}; if (pos >= 0) raw = *(const v4u*)(MQK + ((size_t)b * SEQ + pos) * 1024 + col);
#pragma unroll
              for (int e = 0; e < 4; ++e) { u[i][2 * e] = bflo(raw[e]); u[i][2 * e + 1] = bfhi(raw[e]); } }
#pragma unroll
          for (int r = 0; r < 4; ++r) { const int t = 4 * rg + r; const float f = isq ? gq[h * 64 + t] : uk[h * 64 + t]; float y[8];
#pragma unroll
              for (int e = 0; e < 8; ++e) { float a = cb[e];
#pragma unroll
                  for (int j = 0; j < 4; ++j) a += cw[j][e] * u[r + j][e];
                  y[e] = a * sigmoidf_(a) * f; }
              v4u o; o.x = pk2(y[0], y[1]); o.y = pk2(y[2], y[3]); o.z = pk2(y[4], y[5]); o.w = pk2(y[6], y[7]);
              *(v4u*)((isq ? QP : KPP) + (R0 + t) * 512 + h * MLDK + (cgp & 15) * 8) = o;
              if (!isq) *(LAS v4u*)(kt + t * P2_KT_PITCH + (cgp & 15) * 8) = o; } }
#pragma unroll
        for (int i = 0; i < 4; ++i) { const int idx = tid + NTHREADS * i, row = idx >> 5, ch = idx & 31;
            *(LAS v4u*)(vt + row * P2_VT_PITCH + ch * 8) = *(const v4u*)(MV + (R0 + row) * 1024 + h * MLDV + ch * 8); }
        __syncthreads();
        const size_t itemh = (size_t)(b * MLH + h) * NCHUNK + c;
        { bf16* KT = (bf16*)(F.ws + WS_KT) + itemh * MLDK * 64;
#pragma unroll
          for (int i = 0; i < 2; ++i) { const int idx = tid + NTHREADS * i, d = idx >> 3, sg = idx & 7; unsigned short e8[8];
#pragma unroll
              for (int e = 0; e < 8; ++e) e8[e] = kt[(8 * sg + e) * P2_KT_PITCH + d];
              v4u o; o.x = e8[0] | ((unsigned)e8[1] << 16); o.y = e8[2] | ((unsigned)e8[3] << 16); o.z = e8[4] | ((unsigned)e8[5] << 16); o.w = e8[6] | ((unsigned)e8[7] << 16);
              *(v4u*)(KT + d * 64 + 8 * sg) = o; }
          bf16* VT = (bf16*)(F.ws + WS_VT) + itemh * MLDV * 64;
#pragma unroll
          for (int i = 0; i < 4; ++i) { const int idx = tid + NTHREADS * i, dv = idx >> 3, sg = idx & 7; unsigned short e8[8];
#pragma unroll
              for (int e = 0; e < 8; ++e) e8[e] = vt[(8 * sg + e) * P2_VT_PITCH + dv];
              v4u o; o.x = e8[0] | ((unsigned)e8[1] << 16); o.y = e8[2] | ((unsigned)e8[3] << 16); o.z = e8[4] | ((unsigned)e8[5] << 16); o.w = e8[6] | ((unsigned)e8[7] << 16);
              *(v4u*)(VT + dv * 64 + 8 * sg) = o; }
          if (tid < MLDK) { float s = 0.f;
#pragma unroll 8
              for (int t = 0; t < 64; ++t) s += bf2f(kt[t * P2_KT_PITCH + tid]);
              ((float*)(F.ws + WS_KSUM))[itemh * MLDK + tid] = s; } }
        __syncthreads();
    }
    { const int mr = item * 4 + (w & 3); const float* slab = (const float*)((const unsigned char*)F.out + OUT_SLAB);
      if (w < 4) {
        const float* gxq = F.inp[18]; const float* gxk = F.inp[19];
        v4f kv[8]; float ssh[4] = {0.f, 0.f, 0.f, 0.f};
#pragma unroll
        for (int j = 0; j < 8; ++j) { const int col = 4 * (lane + 64 * j); v4f a = (v4f){0.f, 0.f, 0.f, 0.f};
#pragma unroll
            for (int s = 0; s < 4; ++s) a = a + *(const v4f*)(slab + ((size_t)s * MROWS + mr) * 4096 + col);
            kv[j] = a; ssh[j >> 1] += (a.x * a.x + a.y * a.y) + (a.z * a.z + a.w * a.w); }
        float rk[4];
#pragma unroll
        for (int hh = 0; hh < 4; ++hh) rk[hh] = 1.0f / sqrtf(wave_sum(ssh[hh]) * (1.0f / XD) + EPS);
        bf16* KH = (bf16*)(F.ws + WS_KHAT) + (size_t)mr * DM;
#pragma unroll
        for (int j = 0; j < 8; ++j) { const int col = 4 * (lane + 64 * j), d = col & (XD - 1); const v4f a = *(const v4f*)(gxq + d), g2 = *(const v4f*)(gxk + d); const float r = rk[j >> 1];
            v2u o; o.x = pk2(kv[j].x * r * a.x * g2.x, kv[j].y * r * a.y * g2.y); o.y = pk2(kv[j].z * r * a.z * g2.z, kv[j].w * r * a.w * g2.w);
            *(v2u*)(KH + col) = o; }
      } else {
        bf16* VTM = (bf16*)(F.ws + WS_VTM); const int bm = mr >> 8, key = mr & 255;
        v4f vv[8];
#pragma unroll
        for (int j = 0; j < 8; ++j) { const int dcol = 4 * (lane + 64 * j); v4f a = (v4f){0.f, 0.f, 0.f, 0.f};
#pragma unroll
            for (int s = 0; s < 4; ++s) a = a + *(const v4f*)(slab + ((size_t)s * MROWS + mr) * 4096 + 2048 + dcol);
            vv[j] = a; }
#pragma unroll
        for (int j = 0; j < 8; ++j) { const int dcol = 4 * (lane + 64 * j); const v4f a = vv[j];
            const int hh = dcol >> 9, d = dcol & (XD - 1); bf16* vp = VTM + ((size_t)(bm * XH + hh) * XD + d) * NMEM + key;
            vp[0] = (bf16)f2bf(a.x); vp[NMEM] = (bf16)f2bf(a.y); vp[2 * NMEM] = (bf16)f2bf(a.z); vp[3 * NMEM] = (bf16)f2bf(a.w); }
      } }
    __syncthreads();
}

__device__ __forceinline__ void p3_scan_item(Frame& F, int item) {
    const int bh = item >> 4, sl = item & 15;
    mls::state_scan(bh, sl, (const bf16*)(F.ws + WS_KT), (const bf16*)(F.ws + WS_VT), (const float*)(F.ws + WS_EB), (bf16*)((unsigned char*)F.out + OUT_CST));
    if (sl == 0 && F.tid < MLDK) {
        const float* EB = (const float*)(F.ws + WS_EB) + (size_t)bh * NCHUNK; const float* KS = (const float*)(F.ws + WS_KSUM) + (size_t)bh * NCHUNK * MLDK + F.tid;
        float* NS = (float*)(F.ws + WS_NST) + (size_t)bh * NCHUNK * MLDK + F.tid; float n = 0.f;
        float ks[NCHUNK], eb[NCHUNK];
#pragma unroll
        for (int c = 0; c < NCHUNK; ++c) { ks[c] = KS[(size_t)c * MLDK]; eb[c] = EB[c]; }
#pragma unroll
        for (int c = 0; c < NCHUNK; ++c) { NS[(size_t)c * MLDK] = n; n = eb[c] * (n + ks[c]); }
    }
    if (sl == 1 || sl == 2) {
        const int seq = (sl - 1) * 16 + bh, b = seq >> 3, fh = seq & 7;
        const float* GATES = (const float*)(F.ws + WS_GATES); const float* RINV = (const float*)(F.ws + WS_RINV); const float fb = F.inp[4][fh];
        const size_t r0 = (size_t)b * SEQ + 8 * F.tid; float lf[8]; float tot = 0.f;
#pragma unroll
        for (int j = 0; j < 8; ++j) { lf[j] = logsigmoidf(GATES[(r0 + j) * 16 + fh] * RINV[r0 + j] + fb); tot += lf[j]; }
        const float incl = wave_incl_scan(tot, F.lane);
        LAS float* wt = (LAS float*)F.lds;
        __syncthreads();
        if (F.lane == 63) wt[F.wave] = incl;
        __syncthreads();
        float run = incl - tot;
        for (int wv = 0; wv < F.wave; ++wv) run += wt[wv];
        float* C = (float*)(F.ws + WS_CFOX) + (size_t)seq * SEQ + 8 * F.tid;
        float cs[8];
#pragma unroll
        for (int j = 0; j < 8; ++j) { run += lf[j]; cs[j] = run * -11.313708498984761f; C[j] = cs[j]; }
        LAS float* cp0 = wt + 16; LAS float* cend = wt + 32; LAS float* thr = wt + 96;
        if ((F.tid & 31) == 0) cp0[F.tid >> 5] = cs[0];
        if ((F.tid & 7) == 7) cend[F.tid >> 3] = cs[7];
        if (F.wave == 0) { float gq = fmaxf(fabsf(F.inp[9][F.lane]), fabsf(F.inp[9][F.lane + 64])), gk = fmaxf(fabsf(F.inp[10][F.lane]), fabsf(F.inp[10][F.lane + 64]));
#pragma unroll
            for (int o = 1; o < 64; o <<= 1) { gq = fmaxf(gq, __shfl_xor(gq, o)); gk = fmaxf(gk, __shfl_xor(gk, o)); }
            if (F.lane == 0) thr[0] = 2.0f * 11.313708498984761f * gq * gk + 29.0f; }
        __syncthreads();
        if (F.tid < 16) { const int qb = F.tid; const float T = thr[0], c0 = cp0[qb]; int j = 0;
            while (j < 4 * qb && (c0 - cend[j]) * 0.08838834764831845f > T) ++j;
            ((int*)(F.ws + WS_JLO))[seq * 16 + qb] = JLO_DISABLE ? 0 : (j & ~1); }
        __syncthreads();
    }
}
#ifndef MK_PER_PHASE
#define MK_PER_PHASE 0
#endif
#define XB_TMO      128
#define XB_XCNT(j)  (256  + 64 * (j))
#define XB_XSUB(j)  (1280 + 64 * (j))
#define XB_XGEN(j)  (2304 + 64 * (j))
#define XB_TOP      3328
#define XB_TOPGEN   3392
#define XCD_BAR_WORDS 3456
#define XB_SPIN_CAP (1u << 20)
__device__ __forceinline__ unsigned xb_ld(unsigned* p)              { return __hip_atomic_load(p, __ATOMIC_RELAXED, __HIP_MEMORY_SCOPE_AGENT); }
__device__ __forceinline__ unsigned xb_add(unsigned* p, unsigned v) { return __hip_atomic_fetch_add(p, v, __ATOMIC_RELAXED, __HIP_MEMORY_SCOPE_AGENT); }
__device__ __forceinline__ unsigned xb_xcc_id() { return (unsigned)__builtin_amdgcn_s_getreg((3 << 11) | 20) & 0xFu; }
#define XB_SPIN(cond, bar) do { unsigned _sp = 0; while (cond) { __builtin_amdgcn_s_sleep(1); \
    if ((++_sp & 255u) == 0u) { if (xb_ld(&(bar)[XB_TMO])) break; if (_sp > XB_SPIN_CAP) { atomicAdd(&(bar)[XB_TMO], 1u); break; } } } } while (0)
struct XcdBarrier { unsigned* bar; unsigned x; volatile LAS unsigned* st; };
__device__ __forceinline__ XcdBarrier xcd_barrier_post(unsigned* bar, volatile LAS unsigned* st) {
    XcdBarrier b; b.bar = bar; b.x = xb_xcc_id(); b.st = st;
    if (threadIdx.x == 0) (void)xb_add(&bar[XB_XCNT(b.x)], 1u);
    return b;
}
__device__ __forceinline__ void xcd_barrier_complete(unsigned* bar, unsigned x, unsigned& nloc, unsigned& nx) {
    const unsigned G = gridDim.x * gridDim.y * gridDim.z;
    unsigned sum, cnt, mine, sp = 0u;
    for (;;) {
        sum = 0u; cnt = 0u; mine = 0u;
#pragma unroll
        for (unsigned j = 0; j < 16; ++j) { const unsigned c = xb_ld(&bar[XB_XCNT(j)]); sum += c; cnt += (c > 0u) ? 1u : 0u; mine = (j == x) ? c : mine; }
        if (sum == G) break;
        __builtin_amdgcn_s_sleep(1);
        if ((++sp & 255u) == 0u) { if (xb_ld(&bar[XB_TMO])) break; if (sp > XB_SPIN_CAP) { atomicAdd(&bar[XB_TMO], 1u); break; } }
    }
    nloc = mine > 0u ? mine : 1u; nx = cnt > 0u ? cnt : 1u;
}
__device__ __forceinline__ void xcd_barrier(const XcdBarrier& b) {
    asm volatile("s_waitcnt vmcnt(0)" ::: "memory");
    __syncthreads();
    if (threadIdx.x == 0) {
        unsigned* bar = b.bar;
        __builtin_amdgcn_s_waitcnt(0);
        unsigned nloc = b.st[0], nx = b.st[1];
        if (nloc == 0u) { xcd_barrier_complete(bar, b.x, nloc, nx); b.st[0] = nloc; b.st[1] = nx; }
        const unsigned old = xb_add(&bar[XB_XSUB(b.x)], 1u);
        const unsigned gen = old / nloc;
        if (old + 1u == (gen + 1u) * nloc) {
            __builtin_amdgcn_fence(__ATOMIC_RELEASE, "agent");
            asm volatile("s_waitcnt vmcnt(0)" ::: "memory");
            const unsigned og = xb_add(&bar[XB_TOP], 1u);
            const unsigned tg = og / nx;
            if (og + 1u == (tg + 1u) * nx) xb_add(&bar[XB_TOPGEN], 1u);
            else XB_SPIN(xb_ld(&bar[XB_TOPGEN]) == tg, bar);
            __builtin_amdgcn_fence(__ATOMIC_ACQUIRE, "agent");
            xb_add(&bar[XB_XGEN(b.x)], 1u);
            asm volatile("s_waitcnt vmcnt(0)" ::: "memory");
        } else {
            XB_SPIN(xb_ld(&bar[XB_XGEN(b.x)]) == gen, bar);
            __builtin_amdgcn_fence(__ATOMIC_ACQUIRE, "agent");
            asm volatile("s_waitcnt vmcnt(0)" ::: "memory");
        }
    }
    __syncthreads();
}
constexpr int LDS_MISC_OFF = LDS_BYTES - 256;
#ifndef ML_TWICE
#define ML_TWICE 1
#endif
#ifndef TWICE_P5
#define TWICE_P5 0
#endif
#ifndef TWICE_P6
#define TWICE_P6 0
#endif
#ifndef TWICE_P8
#define TWICE_P8 0
#endif
#ifndef TWICE_P10
#define TWICE_P10 0
#endif
#ifndef TWICE_P1
#define TWICE_P1 0
#endif
#ifndef JLO_DISABLE
#define JLO_DISABLE 0
#endif
constexpr int N_PHASES = 12;
struct Args { const float* in[24]; float* out; unsigned char* ws; int ph_lo, ph_hi; };
static_assert(sizeof(Args) == 24 * 8 + 8 + 8 + 8, "Args has no padding");

__global__ void __launch_bounds__(NTHREADS, 2) fwd_kernel(Args args) {
    extern __shared__ __attribute__((aligned(16))) unsigned char lds[];
    Frame F;
    F.lds = (LAS unsigned char*)lds; F.ldsg = lds;
    F.tid = threadIdx.x; F.lane = F.tid & 63; F.wave = __builtin_amdgcn_readfirstlane(F.tid >> 6);
    F.G = gridDim.x; { const int bx = blockIdx.x; F.vcu = (F.G % 8 == 0) ? (bx % 8) * (F.G / 8) + bx / 8 : bx; }
    F.inp = (const __attribute__((address_space(4))) cfp_t*)__builtin_amdgcn_kernarg_segment_ptr();
    F.out = args.out; F.ws = args.ws;
    unsigned char* ws = args.ws;
    const int lo = args.ph_lo, hi = args.ph_hi;
    volatile LAS unsigned* MISC = (volatile LAS unsigned*)(F.lds + LDS_MISC_OFF);
    if (F.tid < 64) MISC[F.tid] = 0u;
    __syncthreads();
    XcdBarrier xbar; xbar.bar = (unsigned*)(ws + WS_CTL); xbar.x = 0; xbar.st = nullptr;
    if (hi - lo > 1) xbar = xcd_barrier_post((unsigned*)(ws + WS_CTL), MISC);
#ifndef PHASE_MASK
#define PHASE_MASK 0xfff
#endif
#define IN(k) ((((PHASE_MASK) >> (k)) & 1) && lo <= (k) && (k) < hi)
#ifndef DUP_PHASE
#define DUP_PHASE 99
#endif
#define REP(k) for (int rep_ = 0; rep_ < ((k) == DUP_PHASE ? 2 : 1); ++rep_, ((k) == DUP_PHASE && rep_ < 2 ? xcd_barrier(xbar) : (void)0))
#define SEAM(k) do { if (IN(k) && IN((k) + 1)) { xcd_barrier(xbar); } } while (0)
    if (__builtin_expect(lo < 0, 0)) cg::this_grid().sync();
    float* SSQ1 = (float*)(ws + WS_CTL + CTL_SSQ1); float* SSQ2 = (float*)(ws + WS_CTL + CTL_SSQ2); float* SSQQ = (float*)(ws + WS_CTL + CTL_SSQQ);

#ifdef PROBE_PHASE
    unsigned long long pt0 = 0, pt1 = 0, pu0 = 0, pu1 = 0;
#ifndef PROBE_B
#define PROBE_B 99
#endif
#define STAMP(k) do { if ((k) == PROBE_PHASE) pt0 = __builtin_amdgcn_s_memrealtime(); if ((k) == PROBE_PHASE + 1) pt1 = __builtin_amdgcn_s_memrealtime(); \
                      if ((k) == PROBE_B) pu0 = __builtin_amdgcn_s_memrealtime(); if ((k) == PROBE_B + 1) pu1 = __builtin_amdgcn_s_memrealtime(); } while (0)
#else
#define STAMP(k) do {} while (0)
#endif
    STAMP(0);
    if (IN(0)) REP(0) { p0_prologue(F); }
    SEAM(0); STAMP(1);
    if (IN(1)) REP(1) {
        { pg8::Gemm g{(const bf16*)(ws + WS_XN), (const bf16*)(ws + WS_WIN), DM, DM, DM}; pg8::StdOrder S; S.init(MTOK, NPROJ, DM, DM, F.G, (int)blockIdx.x, TWICE_P1);
          pg8::EpiStoreBf16 E{(bf16*)(ws + WS_PROJ), 1024, 1024, (size_t)MTOK * 1024};
          pg8::gemm_phase<pg8::EpiStoreBf16, pg8::StdOrder, true>(F.lds, g, S, E); }
        { pg8::Gemm g{(const bf16*)(ws + WS_MN), (const bf16*)(ws + WS_WXKV), DM, DM, 512}; pg8::XkvOrder S{F.G, (int)blockIdx.x};
          pg8::EpiSlab E{(float*)((unsigned char*)F.out + OUT_SLAB), 4096, (size_t)MROWS * 4096};
          pg8::gemm_phase<pg8::EpiSlab, pg8::XkvOrder, false>(F.lds, g, S, E); }
    }
    SEAM(1); STAMP(2);
#ifndef P2_TWICE
#define P2_TWICE 1
#endif
    if (IN(2)) REP(2) { for (int item = F.vcu; item < BATCH * NCHUNK * P2_TWICE; item += F.G) p2_prep_item(F, item & 255, item < 256); }
    SEAM(2); STAMP(3);
#ifndef P3_TWICE
#define P3_TWICE 1
#endif
    if (IN(3)) REP(3) { for (int item = F.vcu; item < 256 * P3_TWICE; item += F.G) p3_scan_item(F, item & 255); }
    SEAM(3); STAMP(4);
    if (IN(4)) REP(4) {
        {
            const fox::Srd R = __builtin_amdgcn_make_buffer_rsrc((void*)ws, (short)0, (int)WS_END, 0x00020000);
            unsigned* QC = (unsigned*)(ws + WS_CTL + CTL_QCTR); const int* JLO = (const int*)(ws + WS_JLO);
            const float* CF = (const float*)(ws + WS_CFOX); const float* GO = F.inp[11];
            constexpr int QN = 192, NONE = 1 << 20;
            auto mk_item = [&](int g) { const int qx = g / QN, i = g - qx * QN, qb = 15 - (i >> 2), bh = 4 * qx + (i & 3), b = bh >> 3, h = bh & 7;
                fox::Item I; I.rowb = (unsigned)b * SEQ * 2048u + (unsigned)h * (FOXD * 2); I.o = (unsigned)WS_CONCAT + (unsigned)b * SEQ * 4096u + (unsigned)h * (FOXD * 2);
                I.CS = CF + (size_t)bh * SEQ; I.G = GO + h * FOXD; I.P0 = qb * 256; I.jlo = JLO[bh * 16 + qb]; return I; };
            auto is_fox = [&](int g) { return g < NONE && (g % QN) < 64; };
            auto pull = [&]() { if (F.tid == 0) { unsigned qc = MISC[17], left = MISC[18]; int g = NONE;
                    while (left > 0u) { const unsigned i = atomicAdd(QC + qc * 64, 1u); if (i < (unsigned)QN) { g = (int)(qc * QN + i); break; } qc = (qc + 1u) & 7u; --left; }
                    MISC[17] = qc; MISC[18] = left; MISC[16] = (unsigned)g; } };
            if (F.tid == 0) { MISC[17] = xb_xcc_id() & 7u; MISC[18] = 8u; }
            pull();
            __syncthreads();
            int cur = __builtin_amdgcn_readfirstlane((int)MISC[16]);
            __syncthreads();
            while (cur < NONE) {
                if (is_fox(cur)) {
                    fox::Item I = mk_item(cur); fox::Seam S;
                    fox::fox_prime(R, I, (char*)lds, S);
                    for (;;) {
                        pull();
                        auto next_item = [&](const fox::Item& self, int& nidx) { nidx = __builtin_amdgcn_readfirstlane((int)MISC[16]); return is_fox(nidx) ? mk_item(nidx) : self; };
                        const int nidx = fox::fox_block(R, I, next_item, (char*)lds, S);
                        if (!is_fox(nidx)) { cur = nidx; break; }
                        I = mk_item(nidx);
                    }
                    VM_WAIT(); __syncthreads();
                } else {
                    const int qx = cur / QN, it = qx * 128 + (cur - qx * QN - 64), c = it & 63, h = (it >> 6) & 3, b = it >> 8;
                    pull();
                    mls::chunk_out(b, h, c, (const bf16*)(ws + WS_QP), (const bf16*)(ws + WS_KPP), (const bf16*)(ws + WS_VT), (const bf16*)((unsigned char*)F.out + OUT_CST),
                                   (const float*)(ws + WS_NST), (const bf16*)(ws + WS_MO), F.inp[12], (bf16*)(ws + WS_CONCAT), F.lds);
                    cur = __builtin_amdgcn_readfirstlane((int)MISC[16]);
                    __syncthreads();
                }
            }
        }
    }
    SEAM(4); STAMP(5);
    if (IN(5)) REP(5) {
        pg8::Gemm g{(const bf16*)(ws + WS_CONCAT), (const bf16*)(ws + WS_WOUT), DM, DM, DM}; pg8::StdOrder S; S.init(MTOK, DM, DM, DM, F.G, (int)blockIdx.x, TWICE_P5);
        pg8::EpiResid<true, false> E{F.inp[0], (bf16*)(ws + WS_X1B), SSQ1, DM};
        pg8::gemm_phase<pg8::EpiResid<true, false>, pg8::StdOrder, true>(F.lds, g, S, E);
    }
    SEAM(5); STAMP(6);
    if (IN(6)) REP(6) {
        pg8::Gemm g{(const bf16*)(ws + WS_X1B), (const bf16*)(ws + WS_WXQ), DM, DM, DM}; pg8::StdOrder S; S.init(MTOK, DM, DM, DM, F.G, (int)blockIdx.x, TWICE_P6);
        pg8::EpiQ E{(bf16*)(ws + WS_Q), SSQ1, SSQQ};
        pg8::gemm_phase<pg8::EpiQ, pg8::StdOrder, true>(F.lds, g, S, E);
    }
    SEAM(6); STAMP(7);
    if (IN(7)) REP(7) {
        pg8::Gemm g{(const bf16*)(ws + WS_Q), (const bf16*)(ws + WS_KHAT), DM, DM, XD}; pg8::ScoreOrder S{F.G, (int)blockIdx.x};
        pg8::EpiSoftmax E{(bf16*)(ws + WS_P), SSQQ};
        if (F.G >= 256) pg8::gemm_phase<pg8::EpiSoftmax, pg8::ScoreOrder, false>(F.lds, g, S, E);
    }
    SEAM(7); STAMP(8);
    if (IN(8)) REP(8) {
        pg8::Gemm g{(const bf16*)(ws + WS_P), (const bf16*)(ws + WS_VTM), 1024, NMEM, NMEM}; pg8::PvOrder S{F.G, (int)blockIdx.x, TWICE_P8};
        pg8::EpiStoreBf16 E{(bf16*)(ws + WS_CO), DM, 0, 0};
        pg8::gemm_phase<pg8::EpiStoreBf16, pg8::PvOrder, true>(F.lds, g, S, E);
    }
    SEAM(8); STAMP(9);
#ifdef EXTRA_BARS
    for (int eb = 0; eb < EXTRA_BARS; ++eb) xcd_barrier(xbar);
#endif
    if (IN(9)) REP(9) {
        pg8::Gemm g{(const bf16*)(ws + WS_CO), (const bf16*)(ws + WS_WXO), DM, DM, DM}; pg8::StdOrder S; S.init(MTOK, DM, DM, DM, F.G, (int)blockIdx.x);
        pg8::EpiResid<false, false> E{(const bf16*)(ws + WS_X1B), (bf16*)(ws + WS_X2B), SSQ2, DM};
        pg8::gemm_phase<pg8::EpiResid<false, false>, pg8::StdOrder, true>(F.lds, g, S, E);
    }
    SEAM(9); STAMP(10);
    if (IN(10)) REP(10) {
        pg8::Gemm g{(const bf16*)(ws + WS_X2B), (const bf16*)(ws + WS_WUP), DM, DM, DM}; pg8::StdOrder S; S.init(MTOK, DFF, DM, DM, F.G, (int)blockIdx.x, TWICE_P10);
        pg8::EpiUp E{(bf16*)(ws + WS_H), SSQ2};
        pg8::gemm_phase<pg8::EpiUp, pg8::StdOrder, true>(F.lds, g, S, E);
    }
    SEAM(10); STAMP(11);
    if (IN(11)) REP(11) {
        pg8::Gemm g{(const bf16*)(ws + WS_H), (const bf16*)(ws + WS_WDN), DFF, DFF, DFF}; pg8::StdOrder S; S.init(MTOK, DM, DFF, DFF, F.G, (int)blockIdx.x);
        pg8::EpiResid<false, true> E{(const bf16*)(ws + WS_X2B), F.out, nullptr, DM};
        pg8::gemm_phase<pg8::EpiResid<false, true>, pg8::StdOrder, true>(F.lds, g, S, E);
    }
#ifdef PROBE_PHASE
    xcd_barrier(xbar); STAMP(12);
    if (blockIdx.x == 0 && threadIdx.x < 64) {
        const float ta = 8.0f * rintf((float)(pt1 - pt0) * 0.01f * 0.125f), tb = 0.8f * rintf((float)(pu1 - pu0) * 0.01f * 0.125f);
        if (threadIdx.x == 0) F.out[0] += ta;
        if (PROBE_B != 99) for (int i = threadIdx.x; i < 10000; i += 64) F.out[64 + i] += tb;
    }
#endif
#undef IN
#undef SEAM
}

extern "C" void kernel_launch(void* const* d_in, const int* in_sizes, int n_in, void* d_out, int out_size, void* d_ws, size_t ws_size, hipStream_t stream) {
    static int grid = 0;
    if (grid == 0) {
        if (n_in != 24 || in_sizes[0] != MTOK * DM || out_size != MTOK * DM || ws_size < WS_END) {
            fprintf(stderr, "kernel_launch: unexpected shapes (n_in %d, in0 %d, out %d, ws %zu; need ws >= %zu); nothing launched\n", n_in, n_in > 0 ? in_sizes[0] : -1, out_size, ws_size, (size_t)WS_END); grid = -1; return; }
        int dev = 0, cus = 0, per_cu = 0;
        if (hipGetDevice(&dev) != hipSuccess || hipDeviceGetAttribute(&cus, hipDeviceAttributeMultiprocessorCount, dev) != hipSuccess) { grid = -1; return; }
        if (hipFuncSetAttribute((const void*)fwd_kernel, hipFuncAttributeMaxDynamicSharedMemorySize, LDS_BYTES) != hipSuccess) { fprintf(stderr, "kernel_launch: hipFuncSetAttribute failed\n"); grid = -1; return; }
        if (hipOccupancyMaxActiveBlocksPerMultiprocessor(&per_cu, (const void*)fwd_kernel, NTHREADS, LDS_BYTES) != hipSuccess || per_cu < 1) { fprintf(stderr, "kernel_launch: occupancy query says %d blocks per CU\n", per_cu); per_cu = 1; }
        (void)hipGetLastError();
        grid = cus;
    }
    if (grid < 0) return;
    (void)hipMemsetAsync((char*)d_ws + WS_CTL, 0, CTL_BYTES, stream);
    Args a{};
    for (int i = 0; i < 24; ++i) a.in[i] = (const float*)d_in[i];
    a.out = (float*)d_out; a.ws = (unsigned char*)d_ws;
#if MK_PER_PHASE
    for (int ph = 0; ph < N_PHASES; ++ph) { a.ph_lo = ph; a.ph_hi = ph + 1;
        hipLaunchKernelGGL(fwd_kernel, dim3(grid), dim3(NTHREADS), LDS_BYTES, stream, a); }
#else
    a.ph_lo = 0; a.ph_hi = N_PHASES;
    void* kargs[] = {&a};
    hipError_t e = hipLaunchCooperativeKernel((const void*)fwd_kernel, dim3(grid), dim3(NTHREADS), kargs, LDS_BYTES, stream);
    if (e != hipSuccess) fprintf(stderr, "kernel_launch: cooperative launch failed: %s (grid %d)\n", hipGetErrorString(e), grid);
#endif
}
```

```cpp
#include <hip/hip_runtime.h>
#include <hip/hip_cooperative_groups.h>
#include <cstdio>
#include <cstdint>
namespace cg = cooperative_groups;

constexpr int BATCH = 4, SEQ = 4096, DM = 2048, MTOK = BATCH * SEQ;
constexpr int NMEM = 256, MROWS = BATCH * NMEM;
constexpr int FOXH = 8, FOXD = 128, MLH = 4, MLDV = 256, MLDK = 128, XH = 4, XD = 512, DFF = 8192;
constexpr int IN_WIDTH = 6160, NPROJ = 6144, NCHUNK = SEQ / 64;
constexpr float EPS = 1e-6f;
constexpr float LOG2E = 1.4426950408889634f;

constexpr size_t MiB = (size_t)1 << 20;
constexpr size_t WS_WIN = 0, WS_WOUT = 24 * MiB, WS_WXQ = 32 * MiB, WS_WXKV = 40 * MiB, WS_WXO = 56 * MiB, WS_WUP = 64 * MiB, WS_WDN = 96 * MiB;
constexpr size_t WS_PROJ = 128 * MiB;
constexpr size_t WS_FQ = 128 * MiB, WS_FK = 160 * MiB, WS_FV = 192 * MiB, WS_MQK = 224 * MiB, WS_MV = 256 * MiB, WS_MO = 288 * MiB;
constexpr size_t WS_XN = 320 * MiB;
constexpr size_t WS_QP = 384 * MiB, WS_KPP = 400 * MiB;
constexpr size_t WS_KT = 416 * MiB;
constexpr size_t WS_VT = 432 * MiB;
constexpr size_t WS_MISC = 464 * MiB;
constexpr size_t WS_CTL = WS_MISC, CTL_BYTES = 2 * MiB;
constexpr size_t CTL_QCTR = 32 * 1024;
constexpr size_t CTL_SSQ1 = 64 * 1024, CTL_SSQ2 = 128 * 1024, CTL_SSQQ = 192 * 1024, CTL_SSQX = 448 * 1024;
constexpr size_t WS_GATES = WS_MISC + 1 * MiB;
constexpr size_t WS_CFOX = WS_MISC + 3 * MiB;
constexpr size_t WS_EB = WS_MISC + 4 * MiB;
constexpr size_t WS_KSUM = WS_MISC + 5 * MiB;
constexpr size_t WS_NST = WS_MISC + 6 * MiB;
constexpr size_t WS_JLO = WS_MISC + 7 * MiB;
constexpr size_t WS_MN = WS_MISC + 8 * MiB;
constexpr size_t WS_KHAT = WS_MISC + 12 * MiB;
constexpr size_t WS_VTM = WS_MISC + 16 * MiB;
constexpr size_t WS_END = 512 * MiB;
constexpr size_t WS_CONCAT = 224 * MiB;
constexpr size_t WS_X1B = 128 * MiB;
constexpr size_t WS_Q = 192 * MiB;
constexpr size_t WS_CO = 256 * MiB;
constexpr size_t WS_P = 320 * MiB;
constexpr size_t WS_X2B = 128 * MiB;
constexpr size_t WS_H = 192 * MiB;
constexpr size_t OUT_SLAB = 0, OUT_CST = 64 * MiB;

#ifndef JLO_DISABLE
#define JLO_DISABLE 0
#endif
constexpr int LDS_BYTES = 147456;
constexpr int NTHREADS = 512;

#define GAS __attribute__((address_space(1)))
#define LAS __attribute__((address_space(3)))
typedef unsigned short bf16;
typedef unsigned v4u __attribute__((ext_vector_type(4)));
typedef unsigned v2u __attribute__((ext_vector_type(2)));
typedef float v4f __attribute__((ext_vector_type(4)));
typedef short v8s __attribute__((ext_vector_type(8)));
typedef short v4s __attribute__((ext_vector_type(4)));
#define LDS_WAIT() asm volatile("s_waitcnt lgkmcnt(0)" ::: "memory")
#define VM_WAIT() asm volatile("s_waitcnt vmcnt(0)" ::: "memory")
__device__ __forceinline__ unsigned f2bf(float f) { unsigned u = __builtin_bit_cast(unsigned, f); return (u + 0x7fffu + ((u >> 16) & 1u)) >> 16; }
__device__ __forceinline__ unsigned pk2(float lo, float hi) { return f2bf(lo) | (f2bf(hi) << 16); }
__device__ __forceinline__ float bf2f(unsigned h) { return __builtin_bit_cast(float, h << 16); }
__device__ __forceinline__ float bflo(unsigned w) { return __builtin_bit_cast(float, w << 16); }
__device__ __forceinline__ float bfhi(unsigned w) { return __builtin_bit_cast(float, w & 0xffff0000u); }
__device__ __forceinline__ float wave_sum(float v) {
#pragma unroll
    for (int o = 1; o < 64; o <<= 1) v += __shfl_xor(v, o);
    return v;
}
__device__ __forceinline__ float logsigmoidf(float x) { return x >= 0.f ? -log1pf(__expf(-x)) : x - log1pf(__expf(x)); }
__device__ __forceinline__ float sigmoidf_(float x) { return 1.f / (1.f + __expf(-x)); }
__device__ __forceinline__ float rinv_of(const float* ssqx, size_t row) { return 1.0f / sqrtf(ssqx[row] * (1.0f / DM) + EPS); }
#define MK_PER_PHASE 0
namespace pg8 {
#define PG8_LAS __attribute__((address_space(3)))
typedef unsigned short bf16_t;
typedef short bf16x8 __attribute__((ext_vector_type(8)));
typedef float f32x4 __attribute__((ext_vector_type(4)));
typedef float f32x2 __attribute__((ext_vector_type(2)));
typedef unsigned u32x4 __attribute__((ext_vector_type(4)));
typedef unsigned u32x2 __attribute__((ext_vector_type(2)));
constexpr int BM = 256, BK = 64, HALF = 128, HTB = HALF * BK * 2, STAGE_BYTES = 8 * HTB, NXCD = 8, WGM = 8;

__host__ __device__ __forceinline__ int lds_byte(int r, int c) { const int st = (r >> 4) * 2 + (c >> 5), rr = r & 15, cc = c & 31, ob = rr * 64 + cc * 2; return st * 1024 + (ob ^ (((ob >> 9) & 1) << 5)); }
__host__ __device__ __forceinline__ void stage_rc(int b, int& R, int& C) { const int st = b / 1024, sb = b % 1024, swz = sb ^ (((sb >> 9) & 1) << 5); R = (st >> 1) * 16 + swz / 64; C = (st & 1) * 32 + (swz % 64) / 2; }
__host__ __device__ __forceinline__ int perm32(int rho) { const int n = rho >> 4, i = rho & 15; return 8 * (i >> 2) + 4 * n + (i & 3); }

struct Unit { int row0, col0; long aoff, boff; int aux; };
struct Gemm { const bf16_t* A; const bf16_t* Bt; int lda, ldb, K; };

struct StdOrder {
    int nM, nN, nwg, G, c, lda, ldb, rsh;
    __device__ void init(int M, int N, int lda_, int ldb_, int G_, int c_, int rsh_ = 0) { nM = M / BM; nN = N / BM; nwg = nM * nN; G = G_; c = c_; lda = lda_; ldb = ldb_; rsh = rsh_; }
    __device__ bool next(int i, Unit& u) const {
        const long L = (long)(i >> rsh) * G + c; if (L >= nwg) return false;
        int wgid = (int)L; { const int q = nwg / NXCD, r = nwg % NXCD, xcd = wgid % NXCD, off = wgid / NXCD; wgid = (xcd < r ? xcd * (q + 1) : r * (q + 1) + (xcd - r) * q) + off; }
        const int nig = WGM * nN, gid = wgid / nig, fm = gid * WGM, gsz = (nM - fm) < WGM ? (nM - fm) : WGM;
        const int pm = fm + ((wgid % nig) % gsz), pn = (wgid % nig) / gsz;
        u.row0 = pm * BM; u.col0 = pn * BM; u.aoff = (long)pm * BM * lda; u.boff = (long)pn * BM * ldb; u.aux = i & ((1 << rsh) - 1); return true;
    }
};

__device__ __forceinline__ unsigned cvt_pk_bf16(float lo, float hi) { unsigned r; asm volatile("v_cvt_pk_bf16_f32 %0, %1, %2" : "=v"(r) : "v"(lo), "v"(hi)); return r; }

template <class Epi, class Sched, bool ALIGN_EPI>
__device__ __forceinline__ void gemm_phase(PG8_LAS unsigned char* lds, const Gemm g, const Sched& S, const Epi& E) {
    int tid_ = threadIdx.x; asm volatile("" : "+v"(tid_));
    const int tid = tid_, wid = __builtin_amdgcn_readfirstlane(tid >> 6), lane = tid & 63, wr = wid >> 2, wc = wid & 3, fr = lane & 15, fq = lane >> 4;
    const int K = g.K, nt = K / BK;
    unsigned voffA[2], voffB[2];
#pragma unroll
    for (int i = 0; i < 2; ++i) { int R, C; stage_rc(tid * 16 + i * 8192, R, C); const int Rb = Epi::PERM ? ((R & ~31) + perm32(R & 31)) : R;
        voffA[i] = (unsigned)(R * g.lda + C) * 2u; voffB[i] = (unsigned)(Rb * g.ldb + C) * 2u; }
    const size_t kstep = (size_t)(BK * 2);
    const size_t hA = (size_t)HALF * g.lda * 2, hB = (size_t)HALF * g.ldb * 2;
    const unsigned ldsw = (unsigned)wid * 1024u;
    const int aoff = lds_byte(wr * 64 + fr, fq * 8), boff = lds_byte(wc * 32 + fr, fq * 8);
#define PG8_SA(b, h) (((b) * 2 + (h)) * HTB)
#define PG8_SB(b, h) ((4 + (b) * 2 + (h)) * HTB)
#define PG8_STAGE(bufoff, gbase, voff) do { _Pragma("unroll") for (int _i = 0; _i < 2; ++_i) \
        __builtin_amdgcn_global_load_lds((const unsigned*)((const char*)(gbase) + (voff)[_i]), (PG8_LAS unsigned*)(lds + (bufoff) + ldsw + _i * 8192), 16, 0, 0); } while (0)
#define PG8_LDA(dst, b, h) do { _Pragma("unroll") for (int m = 0; m < 4; ++m) _Pragma("unroll") for (int k = 0; k < 2; ++k) dst[m][k] = *(const PG8_LAS bf16x8*)(lds + PG8_SA(b, h) + aoff + m * 2048 + k * 1024); } while (0)
#define PG8_LDB(dst, b, h) do { _Pragma("unroll") for (int n = 0; n < 2; ++n) _Pragma("unroll") for (int k = 0; k < 2; ++k) dst[n][k] = *(const PG8_LAS bf16x8*)(lds + PG8_SB(b, h) + boff + n * 2048 + k * 1024); } while (0)
#define PG8_MMA(ai, bj, At, Bt) do { __builtin_amdgcn_s_setprio(1); _Pragma("unroll") for (int m = 0; m < 4; ++m) _Pragma("unroll") for (int n = 0; n < 2; ++n) _Pragma("unroll") for (int k = 0; k < 2; ++k) \
        acc[ai][bj][m][n] = __builtin_amdgcn_mfma_f32_16x16x32_bf16(Bt[n][k], At[m][k], acc[ai][bj][m][n], 0, 0, 0); __builtin_amdgcn_s_setprio(0); } while (0)
#define PG8_WAIT_V(n) asm volatile("s_waitcnt vmcnt(" #n ")" ::: "memory")
#define PG8_WAIT_L(n) asm volatile("s_waitcnt lgkmcnt(" #n ")" ::: "memory")
#define PG8_BAR __builtin_amdgcn_s_barrier()
#define PG8_SCHED __builtin_amdgcn_sched_barrier(0)
    Unit cur, nxt; int ui = 0;
    if (!S.next(0, cur)) return;
    f32x4 acc[2][2][4][2];
#pragma unroll
    for (int a = 0; a < 2; ++a)
#pragma unroll
        for (int b = 0; b < 2; ++b)
#pragma unroll
            for (int m = 0; m < 4; ++m)
#pragma unroll
                for (int n = 0; n < 2; ++n) acc[a][b][m][n] = (f32x4){0.f, 0.f, 0.f, 0.f};
    bf16x8 At[4][2], B0[2][2], B1[2][2];
    const char* cA = (const char*)g.A + (size_t)cur.aoff * 2; const char* cB = (const char*)g.Bt + (size_t)cur.boff * 2;
    PG8_STAGE(PG8_SB(0, 0), cB, voffB); PG8_STAGE(PG8_SB(0, 1), cB + hB, voffB); PG8_STAGE(PG8_SA(0, 0), cA, voffA); PG8_STAGE(PG8_SA(0, 1), cA + hA, voffA);
    if (wr == 1) PG8_BAR;
    PG8_WAIT_V(2); PG8_BAR;
    PG8_STAGE(PG8_SB(1, 0), cB + kstep, voffB); PG8_STAGE(PG8_SA(1, 0), cA + kstep, voffA); PG8_STAGE(PG8_SB(1, 1), cB + hB + kstep, voffB);
    PG8_WAIT_V(6); PG8_BAR;
    for (;;) {
        const bool has_next = S.next(ui + 1, nxt);
        const char* nA = has_next ? (const char*)g.A + (size_t)nxt.aoff * 2 : cA; const char* nB = has_next ? (const char*)g.Bt + (size_t)nxt.boff * 2 : cB;
        for (int t = 0; t < nt; t += 2) {
            const bool last = (t == nt - 2);
            const char* a1 = cA + (size_t)(t + 1) * kstep;
            const char* a2 = last ? nA : cA + (size_t)(t + 2) * kstep; const char* b2 = last ? nB : cB + (size_t)(t + 2) * kstep;
            const char* a3 = a2 + kstep; const char* b3 = b2 + kstep;
            PG8_LDB(B0, 0, 0); PG8_LDB(B1, 0, 1); PG8_SCHED; PG8_LDA(At, 0, 0); PG8_STAGE(PG8_SA(1, 1), a1 + hA, voffA);
            PG8_WAIT_V(8); PG8_WAIT_L(0); PG8_BAR; PG8_MMA(0, 0, At, B0); PG8_MMA(0, 1, At, B1); PG8_BAR; PG8_SCHED;
            PG8_LDA(At, 0, 1); PG8_STAGE(PG8_SB(0, 0), b2, voffB); PG8_STAGE(PG8_SB(0, 1), b2 + hB, voffB); PG8_STAGE(PG8_SA(0, 0), a2, voffA);
            PG8_WAIT_V(8); PG8_WAIT_L(0); PG8_BAR; PG8_MMA(1, 0, At, B0); PG8_MMA(1, 1, At, B1); PG8_BAR; PG8_SCHED;
            PG8_LDB(B0, 1, 0); PG8_LDB(B1, 1, 1); PG8_SCHED; PG8_LDA(At, 1, 0); PG8_STAGE(PG8_SA(0, 1), a2 + hA, voffA);
            PG8_WAIT_V(8); PG8_WAIT_L(0); PG8_BAR; PG8_MMA(0, 0, At, B0); PG8_MMA(0, 1, At, B1); PG8_BAR; PG8_SCHED;
            PG8_LDA(At, 1, 1); PG8_STAGE(PG8_SB(1, 0), b3, voffB); PG8_STAGE(PG8_SB(1, 1), b3 + hB, voffB); PG8_STAGE(PG8_SA(1, 0), a3, voffA);
            PG8_WAIT_V(8); PG8_WAIT_L(0); PG8_BAR; PG8_MMA(1, 0, At, B0); PG8_MMA(1, 1, At, B1); PG8_BAR; PG8_SCHED;
        }
        if constexpr (ALIGN_EPI) { if (wr == 0) PG8_BAR; }
        if constexpr (!Epi::AFTER_DRAIN) { E(acc, cur, wr, wc, fr, fq); }
        if (!has_next) break;
#pragma unroll
        for (int a = 0; a < 2; ++a)
#pragma unroll
            for (int b = 0; b < 2; ++b)
#pragma unroll
                for (int m = 0; m < 4; ++m)
#pragma unroll
                    for (int n = 0; n < 2; ++n) acc[a][b][m][n] = (f32x4){0.f, 0.f, 0.f, 0.f};
        cur = nxt; cA = nA; cB = nB; ++ui;
        if constexpr (ALIGN_EPI) { if (wr == 1) PG8_BAR; }
    }
    PG8_WAIT_V(0);
    if constexpr (!ALIGN_EPI) { if (wr == 0) PG8_BAR; }
    PG8_BAR;
    if constexpr (Epi::AFTER_DRAIN) { E.fused(acc, cur, wr, wc, fr, fq, lds, wid, lane); }
#undef PG8_SA
#undef PG8_SB
#undef PG8_STAGE
#undef PG8_LDA
#undef PG8_LDB
#undef PG8_MMA
#undef PG8_WAIT_V
#undef PG8_WAIT_L
#undef PG8_BAR
#undef PG8_SCHED
}
}
namespace pg8 {
struct XkvOrder {
    int G, c;
    __device__ bool next(int i, Unit& u) const {
        const int L = i * G + c; if (L >= 256) return false;
        const int kq = L & 3, tile = L >> 2, pm = tile & 3, pn = tile >> 2;
        u.row0 = pm * 256; u.col0 = pn * 256; u.aoff = (long)pm * 256 * DM + kq * 512; u.boff = (long)pn * 256 * DM + kq * 512; u.aux = kq; return true;
    }
};
struct ScoreOrder {
    int G, c;
    __device__ bool next(int i, Unit& u) const {
        const int L = i * G + c; if (L >= 256) return false;
        const int b = L >> 6, h = (L >> 4) & 3, mt = L & 15;
        u.row0 = b * SEQ + mt * 256; u.col0 = h * 256; u.aoff = (long)u.row0 * DM + h * XD; u.boff = (long)(b * NMEM) * DM + h * XD; u.aux = h; return true;
    }
};
struct PvOrder {
    int G, c, rsh;
    __device__ bool next(int i, Unit& u) const {
        const int L = (i >> rsh) * G + c; if (L >= 512) return false;
        const int nt = L & 1, mt = (L >> 1) & 15, h = (L >> 5) & 3, b = L >> 7;
        u.row0 = b * SEQ + mt * 256; u.col0 = h * XD + nt * 256; u.aoff = (long)u.row0 * 1024 + h * 256; u.boff = ((long)(b * XH + h) * XD + nt * 256) * NMEM; u.aux = 0; return true;
    }
};

struct EpiStoreBf16 {
    static constexpr bool PERM = true, AFTER_DRAIN = false;
    bf16_t* O; int ldc; int split_cols; size_t split_stride;
    __device__ __forceinline__ void operator()(const f32x4 (&acc)[2][2][4][2], const Unit& u, int wr, int wc, int fr, int fq) const {
        int colt = u.col0; bf16_t* base = O;
        if (split_cols) { const int t = colt / split_cols; base += (size_t)t * split_stride; colt -= t * split_cols; }
        const int row0 = u.row0 + wr * 64 + fr, col0 = colt + wc * 32 + 8 * fq;
#pragma unroll
        for (int ai = 0; ai < 2; ++ai)
#pragma unroll
            for (int m = 0; m < 4; ++m) { bf16_t* rowp = base + (size_t)(row0 + ai * HALF + m * 16) * ldc + col0;
#pragma unroll
                for (int bj = 0; bj < 2; ++bj) { const f32x4 v0 = acc[ai][bj][m][0], v1 = acc[ai][bj][m][1];
                    u32x4 w; w.x = cvt_pk_bf16(v0[0], v0[1]); w.y = cvt_pk_bf16(v0[2], v0[3]); w.z = cvt_pk_bf16(v1[0], v1[1]); w.w = cvt_pk_bf16(v1[2], v1[3]);
                    *(u32x4*)(rowp + bj * HALF) = w; } }
    }
};
struct EpiProj {
    static constexpr bool PERM = true, AFTER_DRAIN = false;
    bf16_t* O; const float* gq; const float* gk; const float* ssqx; PG8_LAS float* red;
    __device__ __forceinline__ void operator()(f32x4 (&acc)[2][2][4][2], const Unit& u, int wr, int wc, int fr, int fq) const {
        const int t = u.col0 >> 10, colt = u.col0 & 1023; bf16_t* base = O + (size_t)t * ((size_t)MTOK * 1024);
        const int row0 = u.row0 + wr * 64 + fr, col0 = colt + wc * 32 + 8 * fq;
#pragma unroll
        for (int ai = 0; ai < 2; ++ai)
#pragma unroll
            for (int m = 0; m < 4; ++m) { const float rx = __builtin_amdgcn_rsqf(ssqx[row0 + ai * HALF + m * 16] * (1.0f / DM) + EPS);
#pragma unroll
                for (int bj = 0; bj < 2; ++bj) { acc[ai][bj][m][0] = acc[ai][bj][m][0] * rx; acc[ai][bj][m][1] = acc[ai][bj][m][1] * rx; } }
        if (u.col0 < 2048) {
            const float* g = (t == 0 ? gq : gk) + wc * 32 + 8 * fq; const f32x4 g0 = *(const f32x4*)g, g1 = *(const f32x4*)(g + 4);
#pragma unroll
            for (int ai = 0; ai < 2; ++ai)
#pragma unroll
                for (int m = 0; m < 4; ++m) { const int rl = ai * HALF + wr * 64 + m * 16 + fr;
#pragma unroll
                    for (int bj = 0; bj < 2; ++bj) { const f32x4 v0 = acc[ai][bj][m][0], v1 = acc[ai][bj][m][1];
                        float s = (v0[0] * v0[0] + v0[1] * v0[1]) + (v0[2] * v0[2] + v0[3] * v0[3]) + (v1[0] * v1[0] + v1[1] * v1[1]) + (v1[2] * v1[2] + v1[3] * v1[3]);
                        s += __shfl_xor(s, 16); s += __shfl_xor(s, 32);
                        if (fq == 0) red[(rl * 2 + bj) * 4 + wc] = s; } }
            asm volatile("s_waitcnt lgkmcnt(0)" ::: "memory"); __builtin_amdgcn_s_barrier(); asm volatile("" ::: "memory");
#pragma unroll
            for (int ai = 0; ai < 2; ++ai)
#pragma unroll
                for (int m = 0; m < 4; ++m) { const int rl = ai * HALF + wr * 64 + m * 16 + fr;
#pragma unroll
                    for (int bj = 0; bj < 2; ++bj) { const f32x4 r4 = *(const PG8_LAS f32x4*)(red + (rl * 2 + bj) * 4);
                        const float ri = __builtin_amdgcn_rsqf(((r4[0] + r4[1]) + (r4[2] + r4[3])) * (1.0f / FOXD) + EPS);
                        acc[ai][bj][m][0] = acc[ai][bj][m][0] * ri * g0; acc[ai][bj][m][1] = acc[ai][bj][m][1] * ri * g1; } }
        }
#pragma unroll
        for (int ai = 0; ai < 2; ++ai)
#pragma unroll
            for (int m = 0; m < 4; ++m) { bf16_t* rowp = base + (size_t)(row0 + ai * HALF + m * 16) * 1024 + col0;
#pragma unroll
                for (int bj = 0; bj < 2; ++bj) { const f32x4 v0 = acc[ai][bj][m][0], v1 = acc[ai][bj][m][1];
                    u32x4 w; w.x = cvt_pk_bf16(v0[0], v0[1]); w.y = cvt_pk_bf16(v0[2], v0[3]); w.z = cvt_pk_bf16(v1[0], v1[1]); w.w = cvt_pk_bf16(v1[2], v1[3]);
                    *(u32x4*)(rowp + bj * HALF) = w; } }
    }
};
struct EpiSlab {
    static constexpr bool PERM = false, AFTER_DRAIN = false;
    float* slab; int ldc; size_t slab_stride;
    __device__ __forceinline__ void operator()(const f32x4 (&acc)[2][2][4][2], const Unit& u, int wr, int wc, int fr, int fq) const {
        float* base = slab + (size_t)u.aux * slab_stride; const int col0 = u.col0 + wc * 32 + 4 * fq;
#pragma unroll
        for (int ai = 0; ai < 2; ++ai)
#pragma unroll
            for (int m = 0; m < 4; ++m) { float* rowp = base + (size_t)(u.row0 + ai * HALF + wr * 64 + m * 16 + fr) * ldc + col0;
#pragma unroll
                for (int bj = 0; bj < 2; ++bj)
#pragma unroll
                    for (int n = 0; n < 2; ++n) *(f32x4*)(rowp + bj * HALF + n * 16) = acc[ai][bj][m][n]; }
    }
};
template <bool BASEF, bool OUTF>
struct EpiResid {
    static constexpr bool PERM = true, AFTER_DRAIN = false;
    const void* base; void* out; float* ssq; int ldc;
    __device__ __forceinline__ void operator()(const f32x4 (&acc)[2][2][4][2], const Unit& u, int wr, int wc, int fr, int fq) const {
        const int col0 = u.col0 + wc * 32 + 8 * fq;
        float ssum[2][4];
#pragma unroll
        for (int ai = 0; ai < 2; ++ai) {
            f32x4 bv[4][2][2];
#pragma unroll
            for (int m = 0; m < 4; ++m) { const size_t off = (size_t)(u.row0 + ai * HALF + wr * 64 + m * 16 + fr) * ldc + col0;
#pragma unroll
                for (int bj = 0; bj < 2; ++bj) {
                    if constexpr (BASEF) { bv[m][bj][0] = *(const f32x4*)((const float*)base + off + bj * HALF); bv[m][bj][1] = *(const f32x4*)((const float*)base + off + bj * HALF + 4); }
                    else { const u32x4 w = *(const u32x4*)((const bf16_t*)base + off + bj * HALF);
                        bv[m][bj][0] = (f32x4){__builtin_bit_cast(float, w.x << 16), __builtin_bit_cast(float, w.x & 0xffff0000u), __builtin_bit_cast(float, w.y << 16), __builtin_bit_cast(float, w.y & 0xffff0000u)};
                        bv[m][bj][1] = (f32x4){__builtin_bit_cast(float, w.z << 16), __builtin_bit_cast(float, w.z & 0xffff0000u), __builtin_bit_cast(float, w.w << 16), __builtin_bit_cast(float, w.w & 0xffff0000u)}; } } }
#pragma unroll
            for (int m = 0; m < 4; ++m) { const size_t off = (size_t)(u.row0 + ai * HALF + wr * 64 + m * 16 + fr) * ldc + col0; float s = 0.f;
#pragma unroll
                for (int bj = 0; bj < 2; ++bj) { const f32x4 v0 = bv[m][bj][0] + acc[ai][bj][m][0], v1 = bv[m][bj][1] + acc[ai][bj][m][1];
                    if constexpr (OUTF) { *(f32x4*)((float*)out + off + bj * HALF) = v0; *(f32x4*)((float*)out + off + bj * HALF + 4) = v1; }
                    else { u32x4 w; w.x = cvt_pk_bf16(v0[0], v0[1]); w.y = cvt_pk_bf16(v0[2], v0[3]); w.z = cvt_pk_bf16(v1[0], v1[1]); w.w = cvt_pk_bf16(v1[2], v1[3]);
                        *(u32x4*)((bf16_t*)out + off + bj * HALF) = w; }
                    s += (v0[0] * v0[0] + v0[1] * v0[1]) + (v0[2] * v0[2] + v0[3] * v0[3]) + (v1[0] * v1[0] + v1[1] * v1[1]) + (v1[2] * v1[2] + v1[3] * v1[3]); }
                s += __shfl_xor(s, 16); s += __shfl_xor(s, 32); ssum[ai][m] = s; } }
        if (ssq && u.aux == 0) {
#pragma unroll
            for (int ai = 0; ai < 2; ++ai) { const float v = fq == 0 ? ssum[ai][0] : fq == 1 ? ssum[ai][1] : fq == 2 ? ssum[ai][2] : ssum[ai][3];
                atomicAdd(ssq + u.row0 + ai * HALF + wr * 64 + fq * 16 + fr, v); }
        }
    }
};
struct EpiQ {
    static constexpr bool PERM = true, AFTER_DRAIN = false;
    bf16_t* O; const float* ssq_in; float* ssq_out;
    __device__ __forceinline__ void operator()(const f32x4 (&acc)[2][2][4][2], const Unit& u, int wr, int wc, int fr, int fq) const {
        const int col0 = u.col0 + wc * 32 + 8 * fq; float* so = ssq_out + (size_t)(u.col0 / XD) * MTOK;
        float ssum[2][4];
#pragma unroll
        for (int ai = 0; ai < 2; ++ai)
#pragma unroll
            for (int m = 0; m < 4; ++m) { const int row = u.row0 + ai * HALF + wr * 64 + m * 16 + fr; const float ri = __builtin_amdgcn_rsqf(ssq_in[row] * (1.0f / DM) + EPS);
                bf16_t* rowp = O + (size_t)row * DM + col0; float s = 0.f;
#pragma unroll
                for (int bj = 0; bj < 2; ++bj) { const f32x4 v0 = acc[ai][bj][m][0] * ri, v1 = acc[ai][bj][m][1] * ri;
                    u32x4 w; w.x = cvt_pk_bf16(v0[0], v0[1]); w.y = cvt_pk_bf16(v0[2], v0[3]); w.z = cvt_pk_bf16(v1[0], v1[1]); w.w = cvt_pk_bf16(v1[2], v1[3]);
                    *(u32x4*)(rowp + bj * HALF) = w;
                    s += (v0[0] * v0[0] + v0[1] * v0[1]) + (v0[2] * v0[2] + v0[3] * v0[3]) + (v1[0] * v1[0] + v1[1] * v1[1]) + (v1[2] * v1[2] + v1[3] * v1[3]); }
                s += __shfl_xor(s, 16); s += __shfl_xor(s, 32); ssum[ai][m] = s; }
        if (u.aux == 0)
#pragma unroll
        for (int ai = 0; ai < 2; ++ai) { const float v = fq == 0 ? ssum[ai][0] : fq == 1 ? ssum[ai][1] : fq == 2 ? ssum[ai][2] : ssum[ai][3];
            atomicAdd(so + u.row0 + ai * HALF + wr * 64 + fq * 16 + fr, v); }
    }
};
struct EpiUp {
    static constexpr bool PERM = true, AFTER_DRAIN = false;
    bf16_t* O; const float* ssq_in;
    __device__ __forceinline__ void operator()(const f32x4 (&acc)[2][2][4][2], const Unit& u, int wr, int wc, int fr, int fq) const {
        const int col0 = u.col0 + wc * 32 + 8 * fq;
#pragma unroll
        for (int ai = 0; ai < 2; ++ai)
#pragma unroll
            for (int m = 0; m < 4; ++m) { const int row = u.row0 + ai * HALF + wr * 64 + m * 16 + fr; const float ri = __builtin_amdgcn_rsqf(ssq_in[row] * (1.0f / DM) + EPS);
                bf16_t* rowp = O + (size_t)row * DFF + col0;
#pragma unroll
                for (int bj = 0; bj < 2; ++bj) { f32x4 v0 = acc[ai][bj][m][0] * ri, v1 = acc[ai][bj][m][1] * ri;
#pragma unroll
                    for (int e = 0; e < 4; ++e) { const float a = fmaxf(v0[e], 0.f), b = fmaxf(v1[e], 0.f); v0[e] = a * a; v1[e] = b * b; }
                    u32x4 w; w.x = cvt_pk_bf16(v0[0], v0[1]); w.y = cvt_pk_bf16(v0[2], v0[3]); w.z = cvt_pk_bf16(v1[0], v1[1]); w.w = cvt_pk_bf16(v1[2], v1[3]);
                    *(u32x4*)(rowp + bj * HALF) = w; } }
    }
};
struct EpiSoftmax {
    static constexpr bool PERM = true, AFTER_DRAIN = true;
    bf16_t* P; const float* ssqq;
    __device__ __forceinline__ void fused(f32x4 (&acc)[2][2][4][2], const Unit& u, int wr, int wc, int fr, int fq, PG8_LAS unsigned char* lds, int wid, int lane) const {
        PG8_LAS float* RM = (PG8_LAS float*)lds;
        PG8_LAS float* RS = (PG8_LAS float*)(lds + 4096);
        const float* sq = ssqq + (size_t)u.aux * MTOK;
        float mx[2][4];
#pragma unroll
        for (int ai = 0; ai < 2; ++ai)
#pragma unroll
            for (int m = 0; m < 4; ++m) { const int rl = ai * HALF + wr * 64 + m * 16 + fr; const int row = u.row0 + rl;
                const float sc = __builtin_amdgcn_rsqf(sq[row] * (1.0f / XD) + EPS) * (0.044194173824159216f * LOG2E);
                float mxx = -3.0e38f;
#pragma unroll
                for (int bj = 0; bj < 2; ++bj)
#pragma unroll
                    for (int n = 0; n < 2; ++n) { f32x4 v = acc[ai][bj][m][n] * sc; acc[ai][bj][m][n] = v; mxx = fmaxf(mxx, fmaxf(fmaxf(v[0], v[1]), fmaxf(v[2], v[3]))); }
                mxx = fmaxf(mxx, __shfl_xor(mxx, 16)); mxx = fmaxf(mxx, __shfl_xor(mxx, 32));
                if (fq == 0) RM[rl * 4 + wc] = mxx; }
        asm volatile("s_waitcnt lgkmcnt(0)" ::: "memory"); __builtin_amdgcn_s_barrier(); asm volatile("" ::: "memory");
#pragma unroll
        for (int ai = 0; ai < 2; ++ai)
#pragma unroll
            for (int m = 0; m < 4; ++m) { const int rl = ai * HALF + wr * 64 + m * 16 + fr;
                const f32x4 r4 = *(const PG8_LAS f32x4*)(RM + rl * 4); const float mxx = fmaxf(fmaxf(r4[0], r4[1]), fmaxf(r4[2], r4[3])); mx[ai][m] = mxx; float s = 0.f;
#pragma unroll
                for (int bj = 0; bj < 2; ++bj)
#pragma unroll
                    for (int n = 0; n < 2; ++n) { f32x4 v = acc[ai][bj][m][n];
#pragma unroll
                        for (int e = 0; e < 4; ++e) { v[e] = __builtin_amdgcn_exp2f(v[e] - mxx); s += v[e]; }
                        acc[ai][bj][m][n] = v; }
                s += __shfl_xor(s, 16); s += __shfl_xor(s, 32);
                if (fq == 0) RS[rl * 4 + wc] = s; }
        asm volatile("s_waitcnt lgkmcnt(0)" ::: "memory"); __builtin_amdgcn_s_barrier(); asm volatile("" ::: "memory");
        const int col0 = u.col0 + wc * 32 + 8 * fq;
#pragma unroll
        for (int ai = 0; ai < 2; ++ai)
#pragma unroll
            for (int m = 0; m < 4; ++m) { const int rl = ai * HALF + wr * 64 + m * 16 + fr;
                const f32x4 r4 = *(const PG8_LAS f32x4*)(RS + rl * 4); const float inv = 1.0f / ((r4[0] + r4[1]) + (r4[2] + r4[3]));
                bf16_t* rowp = P + (size_t)(u.row0 + rl) * 1024 + col0;
#pragma unroll
                for (int bj = 0; bj < 2; ++bj) { const f32x4 v0 = acc[ai][bj][m][0] * inv, v1 = acc[ai][bj][m][1] * inv;
                    u32x4 w; w.x = cvt_pk_bf16(v0[0], v0[1]); w.y = cvt_pk_bf16(v0[2], v0[3]); w.z = cvt_pk_bf16(v1[0], v1[1]); w.w = cvt_pk_bf16(v1[2], v1[3]);
                    *(u32x4*)(rowp + bj * HALF) = w; } }
        (void)mx; (void)wid; (void)lane;
    }
};
}
namespace fox {
typedef short bf16x8 __attribute__((ext_vector_type(8)));
typedef short s16x4 __attribute__((ext_vector_type(4)));
typedef float f32x16 __attribute__((ext_vector_type(16)));
typedef float f32x4 __attribute__((ext_vector_type(4)));
typedef unsigned u32x4 __attribute__((ext_vector_type(4)));
constexpr int D = 128, PITCH = 1024, OPITCH = 2048;
constexpr int NW = 8, QBLK = 32, KVBLK = 64, QB = NW * QBLK;
constexpr int SHM_V = KVBLK * D * 2, SHM_K = KVBLK * D * 2;
constexpr int LDS_BIAS = 0, LDS_WS = 512, LDS_V = 4096, LDS_K = LDS_V + 2 * SHM_V, LDS_Q = LDS_K + 2 * SHM_K, LDS_BYTES = LDS_Q + NW * 8192;
constexpr float SCALE = 0.08838834764831845f, C2 = LOG2E * SCALE, THR = 8.f;

#define KSWZ(row, colB) ((row) * 256 + ((colB) ^ (((row) & 7) << 4)))
#define SBAR() __builtin_amdgcn_sched_barrier(0)
__device__ __forceinline__ int v_st(int k, int c) { const int kk = (k & ~0xC) | ((k & 4) << 1) | ((k & 8) >> 1); return ((kk >> 3) * 4 + (c >> 5)) * 512 + ((kk & 7) * 32 + (c & 31)) * 2; }
__device__ __forceinline__ int v_rd_base(int lane) { return ((lane & 3) << 3) | (((lane >> 2) & 3) << 6) | (((lane >> 4) & 1) << 5) | (((lane >> 5) & 1) << 8); }
constexpr int v_rd_off(int d0, int ks, int half) { return d0 * 512 + ks * 4096 + half * 2048; }
__device__ __forceinline__ int crow(int r, int hi) { return (r & 3) + 8 * (r >> 2) + 4 * hi; }
__device__ __forceinline__ unsigned cvtpk(float lo, float hi) { unsigned r; asm volatile("v_cvt_pk_bf16_f32 %0, %1, %2" : "=v"(r) : "v"(lo), "v"(hi)); return r; }
__device__ __forceinline__ bf16x8 load8(const bf16* p) { return *reinterpret_cast<const bf16x8*>(p); }

__device__ __forceinline__ void mask_tile(f32x16& p0, f32x16& p1, int dq) {
    const float NEG = -__builtin_inff();
#pragma unroll
    for (int r = 0; r < 16; ++r) { const int c = (r & 3) + 8 * (r >> 2);
        if (dq - c < 0) p0[r] = NEG;
        if (dq - c - 32 < 0) p1[r] = NEG; }
}
__device__ __forceinline__ void partialSM(f32x16& p0, f32x16& p1, float& m_reg, float& mn, float& alpha) {
    float pmax = p0[0];
#pragma unroll
    for (int r = 1; r < 16; ++r) pmax = fmaxf(pmax, p0[r]);
#pragma unroll
    for (int r = 0; r < 16; ++r) pmax = fmaxf(pmax, p1[r]);
    { auto rr = __builtin_amdgcn_permlane32_swap(__float_as_uint(pmax), __float_as_uint(pmax), false, false);
      pmax = fmaxf(__uint_as_float(rr[0]), __uint_as_float(rr[1])); }
    if (__builtin_expect(__all((pmax - m_reg) * SCALE <= THR), 1)) { mn = m_reg; alpha = 1.f; }
    else { mn = fmaxf(m_reg, pmax); alpha = __builtin_amdgcn_exp2f((m_reg - mn) * C2); m_reg = mn; }
    const float mnL = -mn * C2;
#pragma unroll
    for (int r = 0; r < 16; ++r) p0[r] = fmaf(p0[r], C2, mnL);
#pragma unroll
    for (int r = 0; r < 16; ++r) p1[r] = fmaf(p1[r], C2, mnL);
#pragma unroll
    for (int r = 0; r < 16; ++r) p0[r] = __builtin_amdgcn_exp2f(p0[r]);
}
__device__ __forceinline__ void finishSM(f32x16& p0, f32x16& p1, float alpha, float& l_reg, bf16x8& pa0, bf16x8& pa1, bf16x8& pa2, bf16x8& pa3) {
#pragma unroll
    for (int r = 0; r < 16; ++r) p1[r] = __builtin_amdgcn_exp2f(p1[r]);
    float ps = 0;
#pragma unroll
    for (int r = 0; r < 16; ++r) ps += p0[r];
#pragma unroll
    for (int r = 0; r < 16; ++r) ps += p1[r];
    { auto rr = __builtin_amdgcn_permlane32_swap(__float_as_uint(ps), __float_as_uint(ps), false, false);
      ps = __uint_as_float(rr[0]) + __uint_as_float(rr[1]); }
    l_reg = l_reg * alpha + ps;
#define PK4(P, B_, OUT) do { unsigned a0 = cvtpk(P[B_+0], P[B_+1]), a1 = cvtpk(P[B_+2], P[B_+3]);                          \
        unsigned b0 = cvtpk(P[B_+4], P[B_+5]), b1 = cvtpk(P[B_+6], P[B_+7]);                                             \
        auto r0 = __builtin_amdgcn_permlane32_swap(a0, b0, false, false); auto r1 = __builtin_amdgcn_permlane32_swap(a1, b1, false, false); \
        u32x4 w = {r0[0], r1[0], r0[1], r1[1]}; OUT = *reinterpret_cast<bf16x8*>(&w); } while (0)
    PK4(p0, 0, pa0); PK4(p0, 8, pa1); PK4(p1, 0, pa2); PK4(p1, 8, pa3);
#undef PK4
}
template <int KB>
__device__ __forceinline__ void qkt(f32x16& p0, f32x16& p1, const char* K_lds, const float* bl, int r32, int hi, const char* qw) {
#pragma unroll
    for (int g = 0; g < 4; ++g) { const f32x4 b0 = *(const f32x4*)(bl + KB * 64 + 8 * g + 4 * hi), b1 = *(const f32x4*)(bl + KB * 64 + 32 + 8 * g + 4 * hi);
#pragma unroll
        for (int i = 0; i < 4; ++i) { p0[4 * g + i] = b0[i]; p1[4 * g + i] = b1[i]; } }
    const char* kb[4];
#pragma unroll
    for (int dd = 0; dd < 4; ++dd) kb[dd] = K_lds + KB * SHM_K + KSWZ(r32, (dd * 16 + hi * 8) * 2);
#pragma unroll
    for (int d0 = 0; d0 < 8; ++d0) { const char* a = kb[d0 & 3] + (d0 >> 2) * 128;
        bf16x8 b0 = *reinterpret_cast<const bf16x8*>(a);
        bf16x8 b1 = *reinterpret_cast<const bf16x8*>(a + 32 * 256);
        const bf16x8 qf = *reinterpret_cast<const bf16x8*>(qw + d0 * 1024);
        p0 = __builtin_amdgcn_mfma_f32_32x32x16_bf16(b0, qf, p0, 0, 0, 0);
        p1 = __builtin_amdgcn_mfma_f32_32x32x16_bf16(b1, qf, p1, 0, 0, 0); }
}
template <int VB>
__device__ __forceinline__ void pv_tile(f32x16* o, int vb0, bf16x8 pa0, bf16x8 pa1, bf16x8 pa2, bf16x8 pa3) {
#define TRRD(dst, off) asm volatile("ds_read_b64_tr_b16 %0, %1 offset:%2" : "=&v"(dst) : "v"(vb0), "i"(off) : "memory")
#define PV_D0(d0) do { s16x4 l0, l1, l2, l3, h0, h1, h2, h3; constexpr int b_ = VB * SHM_V + v_rd_off(d0, 0, 0); \
        TRRD(l0, b_); TRRD(h0, b_ + 2048); TRRD(l1, b_ + 4096); TRRD(h1, b_ + 6144); TRRD(l2, b_ + 8192); TRRD(h2, b_ + 10240); TRRD(l3, b_ + 12288); TRRD(h3, b_ + 14336); \
        asm volatile("s_waitcnt lgkmcnt(0)" ::: "memory"); SBAR();   \
        o[d0] = __builtin_amdgcn_mfma_f32_32x32x16_bf16(pa0, (bf16x8){l0[0], l0[1], l0[2], l0[3], h0[0], h0[1], h0[2], h0[3]}, o[d0], 0, 0, 0);   \
        o[d0] = __builtin_amdgcn_mfma_f32_32x32x16_bf16(pa1, (bf16x8){l1[0], l1[1], l1[2], l1[3], h1[0], h1[1], h1[2], h1[3]}, o[d0], 0, 0, 0);   \
        o[d0] = __builtin_amdgcn_mfma_f32_32x32x16_bf16(pa2, (bf16x8){l2[0], l2[1], l2[2], l2[3], h2[0], h2[1], h2[2], h2[3]}, o[d0], 0, 0, 0);   \
        o[d0] = __builtin_amdgcn_mfma_f32_32x32x16_bf16(pa3, (bf16x8){l3[0], l3[1], l3[2], l3[3], h3[0], h3[1], h3[2], h3[3]}, o[d0], 0, 0, 0); } while (0)
    PV_D0(0); PV_D0(1); PV_D0(2); PV_D0(3);
#undef PV_D0
#undef TRRD
}

struct Item { unsigned rowb, o; const float* CS; const float* G; int P0, jlo; };
struct Seam { bf16x8 qr[8]; bf16x8 st_v0, st_v1, st_k0, st_k1; };
typedef __amdgpu_buffer_rsrc_t Srd;
#define BL8(rs, vo, so) __builtin_bit_cast(bf16x8, __builtin_amdgcn_raw_buffer_load_b128((rs), (vo), (so), 0))
#define VMW() asm volatile("s_waitcnt vmcnt(0)" ::: "memory")
#define VMWN(n) asm volatile("s_waitcnt vmcnt(%0)" :: "i"(n) : "memory")
#define SLOAD_H(H, k0, bb) do { const unsigned so_ = (unsigned)(k0) * (PITCH * 2);                                               \
                         S.st_v0 = BL8(R, kvoff, (unsigned)WS_FV + (H).rowb + so_); S.st_v1 = BL8(R, kvoff, (unsigned)WS_FV + (H).rowb + so_ + 32 * PITCH * 2);   \
                         S.st_k0 = BL8(R, kvoff, (unsigned)WS_FK + (H).rowb + so_); S.st_k1 = BL8(R, kvoff, (unsigned)WS_FK + (H).rowb + so_ + 32 * PITCH * 2);   \
                         if (wid == 0) __builtin_amdgcn_global_load_lds((const unsigned*)((H).CS + (k0)) + lane, (__attribute__((address_space(3))) unsigned*)(B3 + (bb) * 64), 4, 0, 0); } while (0)
#define QLOAD(H) do { const unsigned so_ = (unsigned)((H).P0 + wid * QBLK) * (PITCH * 2);                                   \
        _Pragma("unroll") for (int d0 = 0; d0 < 8; ++d0) S.qr[d0] = BL8(R, qoff + d0 * 32, (unsigned)WS_FQ + (H).rowb + so_); } while (0)
#define SWRITE_HK(bf) do { *(bf16x8*)(K_lds + (bf) * SHM_K + kws) = S.st_k0; *(bf16x8*)(K_lds + (bf) * SHM_K + kws + 32 * 256) = S.st_k1; } while (0)
#define SWRITE_HV(bf) do { *(bf16x8*)(V_lds + (bf) * SHM_V + vst0) = S.st_v0; *(bf16x8*)(V_lds + (bf) * SHM_V + vst1) = S.st_v1; } while (0)
#define SWRITE_H(bf) do { SWRITE_HV(bf); SWRITE_HK(bf); } while (0)

__device__ __forceinline__ void fox_prime(const Srd R, const Item& H, char* lds, Seam& S) {
    int tid_ = threadIdx.x; asm volatile("" : "+v"(tid_));
    const int tid = tid_, wid = __builtin_amdgcn_readfirstlane(tid >> 6), lane = tid & 63, r32 = lane & 31, hi = lane >> 5;
    const int sr = tid >> 4, sc = (tid & 15) * 8, kws = KSWZ(sr, sc * 2); char* K_lds = lds + LDS_K; float* B_lds = (float*)(lds + LDS_BIAS);
    const unsigned kvoff = (unsigned)(sr * PITCH + sc) * 2u, qoff = (unsigned)(r32 * PITCH + hi * 8) * 2u;
    __attribute__((address_space(3))) float* B3 = (__attribute__((address_space(3))) float*)B_lds;
    QLOAD(H);
    SLOAD_H(H, H.jlo * KVBLK, 0); VMW(); SWRITE_HK(0);
    { char* qw = lds + LDS_Q + wid * 8192 + lane * 16;
#pragma unroll
      for (int d0 = 0; d0 < 8; ++d0) *(bf16x8*)(qw + d0 * 1024) = S.qr[d0]; }
    __syncthreads();
}
template <class NextFn>
__device__ __forceinline__ int fox_block(const Srd R, const Item& H, const NextFn& next_item, char* lds, Seam& S) {
    const int P0 = H.P0;
    int tid_ = threadIdx.x; asm volatile("" : "+v"(tid_));
    const int tid = tid_, wid = __builtin_amdgcn_readfirstlane(tid >> 6), lane = tid & 63, r32 = lane & 31, hi = lane >> 5;
    const int NT = P0 / KVBLK + 4 - H.jlo;
    const int qlo = P0 + wid * QBLK, qm = qlo + r32 - 4 * hi;
    char* V_lds = lds + LDS_V; char* K_lds = lds + LDS_K; float* B_lds = (float*)(lds + LDS_BIAS);
    char* qw = lds + LDS_Q + wid * 8192 + lane * 16;
    float* ws = (float*)(lds + LDS_WS) + wid * 64; float* li_l = ws, * al_l = ws + 32;
    float m_reg = -1e30f, l_reg = 0; f32x16 o[4] = {};
    const int sr = tid >> 4, sc = (tid & 15) * 8, vst0 = v_st(sr, sc), vst1 = v_st(32 + sr, sc), kws = KSWZ(sr, sc * 2);
    const int vb0 = (int)(uintptr_t)V_lds + v_rd_base(lane);
    const unsigned kvoff = (unsigned)(sr * PITCH + sc) * 2u, qoff = (unsigned)(r32 * PITCH + hi * 8) * 2u;
    __attribute__((address_space(3))) float* B3 = (__attribute__((address_space(3))) float*)B_lds;
#define RESC(a) do { if (__any((a) < 1.f)) { if (hi == 0) al_l[r32] = (a); asm volatile("s_waitcnt lgkmcnt(0)" ::: "memory");              \
                     for (int d_ = 0; d_ < 4; ++d_) for (int r = 0; r < 16; ++r) o[d_][r] *= al_l[crow(r, hi)]; } } while (0)
#define KBASE(t) ((H.jlo + (t)) * KVBLK)
#define MASKT(P0_, P1_, t) do { const int kb_ = KBASE(t); if (kb_ + KVBLK - 1 > qlo) mask_tile(P0_, P1_, qm - kb_); } while (0)
    f32x16 pA0, pA1, pB0, pB1; float mnA, mnB, alA, alB; bf16x8 pa0, pa1, pa2, pa3;
    SWRITE_HV(0); SBAR();
    SLOAD_H(H, KBASE(1), 1);
    SBAR(); qkt<0>(pA0, pA1, K_lds, B_lds, r32, hi, qw);
    MASKT(pA0, pA1, 0); partialSM(pA0, pA1, m_reg, mnA, alA);
    VMW(); SWRITE_H(1);
    __syncthreads();
#define HALF_STEP(PX0, PX1, mnX, alX, PY0, PY1, alY, t, KB, VB, SB) do {                                                      \
        SBAR(); qkt<KB>(PX0, PX1, K_lds, B_lds, r32, hi, qw);                                                                 \
        finishSM(PY0, PY1, alY, l_reg, pa0, pa1, pa2, pa3); SBAR();                                                           \
        if ((t) + 1 < NT) { SLOAD_H(H, KBASE((t) + 1), SB); SBAR(); }                                                                \
        pv_tile<VB>(o, vb0, pa0, pa1, pa2, pa3); MASKT(PX0, PX1, (t)); partialSM(PX0, PX1, m_reg, mnX, alX);                  \
        __syncthreads();                                                                                                      \
        if ((t) + 1 < NT) { VMW(); SWRITE_H(SB); }                                                                      \
        RESC(alX); __syncthreads(); } while (0)
    for (int t = 1; t + 1 < NT; t += 2) {
        HALF_STEP(pB0, pB1, mnB, alB, pA0, pA1, alA, t, 1, 0, 0);
        HALF_STEP(pA0, pA1, mnA, alA, pB0, pB1, alB, t + 1, 0, 1, 1);
    }
    SBAR(); qkt<1>(pB0, pB1, K_lds, B_lds, r32, hi, qw); SBAR();
    int nidx; const Item N = next_item(H, nidx);
    SLOAD_H(N, N.jlo * KVBLK, 0); SBAR();
    QLOAD(N);
    SBAR();
    finishSM(pA0, pA1, alA, l_reg, pa0, pa1, pa2, pa3); SBAR();
    pv_tile<0>(o, vb0, pa0, pa1, pa2, pa3);
    MASKT(pB0, pB1, NT - 1); partialSM(pB0, pB1, m_reg, mnB, alB); __syncthreads(); RESC(alB);
    finishSM(pB0, pB1, alB, l_reg, pa0, pa1, pa2, pa3); SBAR(); pv_tile<1>(o, vb0, pa0, pa1, pa2, pa3);
    SBAR(); VMWN(8); SWRITE_HK(0); SBAR();
    if (hi == 0) li_l[r32] = l_reg; asm volatile("s_waitcnt lgkmcnt(0)" ::: "memory");
    float gn[4];
#pragma unroll
    for (int d0 = 0; d0 < 4; ++d0) gn[d0] = H.G[d0 * 32 + r32];
    const unsigned ovoff = (unsigned)(4 * hi * OPITCH + r32) * 2u;
#pragma unroll
    for (int r = 0; r < 16; ++r) { const float rli = __builtin_amdgcn_rcpf(li_l[crow(r, hi)]); float ss = 0.f;
#pragma unroll
        for (int d0 = 0; d0 < 4; ++d0) { o[d0][r] *= rli; ss += o[d0][r] * o[d0][r]; }
        ss += __shfl_xor(ss, 1); ss += __shfl_xor(ss, 2); ss += __shfl_xor(ss, 4); ss += __shfl_xor(ss, 8); ss += __shfl_xor(ss, 16);
        const float rs = __builtin_amdgcn_rsqf(ss * (1.0f / D) + EPS);
        const unsigned so_ = (unsigned)(P0 + wid * QBLK + (r & 3) + 8 * (r >> 2)) * (OPITCH * 2);
#pragma unroll
        for (int d0 = 0; d0 < 4; ++d0) { const float v = o[d0][r] * rs * gn[d0];
            const float vn = __shfl_xor(v, 1);
            if ((r32 & 1) == 0) __builtin_amdgcn_raw_buffer_store_b32(cvtpk(v, vn), R, ovoff + d0 * 64, H.o + so_, 0); } }
#pragma unroll
    for (int d0 = 0; d0 < 8; ++d0) *(bf16x8*)(qw + d0 * 1024) = S.qr[d0];
    __syncthreads();
    return nidx;
#undef RESC
#undef KBASE
#undef MASKT
#undef HALF_STEP
}
#undef BL8
#undef QLOAD
#undef VMW
#undef VMWN
#undef SLOAD_H
#undef SWRITE_HK
#undef SWRITE_HV
#undef SWRITE_H
#undef KSWZ
#undef SBAR
}
namespace mls {
typedef short bf16x8 __attribute__((ext_vector_type(8)));
typedef short bf16x4 __attribute__((ext_vector_type(4)));
typedef float f32x4 __attribute__((ext_vector_type(4)));
#define MFMA16(a, b, c) __builtin_amdgcn_mfma_f32_16x16x32_bf16((a), (b), (c), 0, 0, 0)

constexpr int CO_CST = 0, CO_VT = 65536, CO_XCH = 98304, CO_LDS_BYTES = CO_XCH + 512;
__device__ __forceinline__ void chunk_out(int b, int h, int c, const bf16* QP, const bf16* KPP, const bf16* VT, const bf16* CST, const float* NST,
                                          const bf16* MO, const float* gain, bf16* concat, __attribute__((address_space(3))) unsigned char* lds) {
    typedef __attribute__((address_space(3))) unsigned char* lptr;
    int tid_ = threadIdx.x; asm volatile("" : "+v"(tid_));
    const int tid = tid_, w = __builtin_amdgcn_readfirstlane(tid >> 6), lane = tid & 63, i16 = lane & 15, q = lane >> 4;
    const int tq = w & 3, dvh = w >> 2;
    const size_t R0 = (size_t)b * SEQ + (size_t)c * 64;
    const size_t item = ((size_t)(b * MLH + h) * NCHUNK + c);
    { const bf16* cs = CST + item * MLDV * MLDK; const bf16* vs = VT + item * MLDV * 64;
#pragma unroll
      for (int j = 0; j < 8; ++j) { const int p = w + 8 * j, row = 4 * p + (lane >> 4), lc = (lane & 15) ^ (row & 15);
          __builtin_amdgcn_global_load_lds((const unsigned*)(cs + row * MLDK + lc * 8), (__attribute__((address_space(3))) unsigned*)(lds + CO_CST + p * 1024), 16, 0, 0); }
#pragma unroll
      for (int j = 0; j < 4; ++j) { const int p = w + 8 * j, row = 8 * p + (lane >> 3), lc = (lane & 7) ^ ((row >> 1) & 7);
          __builtin_amdgcn_global_load_lds((const unsigned*)(vs + row * 64 + lc * 8), (__attribute__((address_space(3))) unsigned*)(lds + CO_VT + p * 1024), 16, 0, 0); } }
    const size_t row = R0 + 16 * tq + i16;
    const bf16* qrow = QP + row * 512 + h * MLDK + 8 * q;
    bf16x8 qf[4];
#pragma unroll
    for (int ks = 0; ks < 4; ++ks) qf[ks] = *(const bf16x8*)(qrow + 32 * ks);
    f32x4 st[4];
#pragma unroll
    for (int stile = 0; stile < 4; ++stile) {
        st[stile] = (f32x4){0.f, 0.f, 0.f, 0.f};
        if (stile <= tq) {
            const bf16* krow = KPP + (R0 + 16 * stile + i16) * 512 + h * MLDK + 8 * q;
            bf16x8 kf[4];
#pragma unroll
            for (int ks = 0; ks < 4; ++ks) kf[ks] = *(const bf16x8*)(krow + 32 * ks);
#pragma unroll
            for (int ks = 0; ks < 4; ++ks) st[stile] = MFMA16(kf[ks], qf[ks], st[stile]);
            if (stile == tq) {
#pragma unroll
                for (int r = 0; r < 4; ++r) if (4 * q + r > i16) st[stile][r] = 0.f;
            }
        }
    }
    float den = 0.f;
#pragma unroll
    for (int stile = 0; stile < 4; ++stile) den += (st[stile][0] + st[stile][1]) + (st[stile][2] + st[stile][3]);
    { const float* nrow = NST + item * MLDK + 8 * q;
#pragma unroll
      for (int ks = 0; ks < 4; ++ks) { const f32x4 n0 = *(const f32x4*)(nrow + 32 * ks), n1 = *(const f32x4*)(nrow + 32 * ks + 4);
          const v4u qq = __builtin_bit_cast(v4u, qf[ks]);
          den += bflo(qq[0]) * n0[0] + bfhi(qq[0]) * n0[1] + bflo(qq[1]) * n0[2] + bfhi(qq[1]) * n0[3]
               + bflo(qq[2]) * n1[0] + bfhi(qq[2]) * n1[1] + bflo(qq[3]) * n1[2] + bfhi(qq[3]) * n1[3]; } }
    den += __shfl_xor(den, 16); den += __shfl_xor(den, 32);
    const int dv0 = h * MLDV + dvh * 128 + 4 * q;
    v2u mo2[8];
#pragma unroll
    for (int dt = 0; dt < 8; ++dt) mo2[dt] = *(const v2u*)(MO + row * 1024 + dv0 + 16 * dt);
    bf16x8 pf[2];
#pragma unroll
    for (int p = 0; p < 2; ++p) { v4u wv; wv[0] = pg8::cvt_pk_bf16(st[2 * p][0], st[2 * p][1]); wv[1] = pg8::cvt_pk_bf16(st[2 * p][2], st[2 * p][3]);
        wv[2] = pg8::cvt_pk_bf16(st[2 * p + 1][0], st[2 * p + 1][1]); wv[3] = pg8::cvt_pk_bf16(st[2 * p + 1][2], st[2 * p + 1][3]); pf[p] = __builtin_bit_cast(bf16x8, wv); }
    const int npair = (tq >> 1) + 1;
    asm volatile("s_waitcnt vmcnt(0)" ::: "memory");
    __syncthreads();
    f32x4 num[8];
    const lptr cb = lds + CO_CST + (dvh * 128 + i16) * 256, vb = lds + CO_VT + (dvh * 128 + i16) * 128 + (q & 1) * 8;
    const int vsw = i16 >> 1;
#pragma unroll
    for (int dt = 0; dt < 8; ++dt) {
        f32x4 a = (f32x4){0.f, 0.f, 0.f, 0.f};
#pragma unroll
        for (int p = 0; p < 2; ++p) if (p < npair) {
            const v2u lo = *(const __attribute__((address_space(3))) v2u*)(vb + dt * 16 * 128 + (((4 * p + (q >> 1)) ^ vsw) * 16));
            const v2u hi2 = *(const __attribute__((address_space(3))) v2u*)(vb + dt * 16 * 128 + (((4 * p + 2 + (q >> 1)) ^ vsw) * 16));
            const v4u vv = {lo[0], lo[1], hi2[0], hi2[1]};
            a = MFMA16(__builtin_bit_cast(bf16x8, vv), pf[p], a); }
#pragma unroll
        for (int ks = 0; ks < 4; ++ks) { const bf16x8 cf = *(const __attribute__((address_space(3))) bf16x8*)(cb + dt * 16 * 256 + (((4 * ks + q) ^ i16) * 16)); a = MFMA16(cf, qf[ks], a); }
        num[dt] = a;
    }
    const float rden = 1.0f / fmaxf(fabsf(den), 1.0f);
    float ss = 0.f;
#pragma unroll
    for (int dt = 0; dt < 8; ++dt) { num[dt] = num[dt] * rden; ss += (num[dt][0] * num[dt][0] + num[dt][1] * num[dt][1]) + (num[dt][2] * num[dt][2] + num[dt][3] * num[dt][3]); }
    ss += __shfl_xor(ss, 16); ss += __shfl_xor(ss, 32);
    __attribute__((address_space(3))) float* xch = (__attribute__((address_space(3))) float*)(lds + CO_XCH);
    if (q == 0) xch[w * 16 + i16] = ss;
    __syncthreads();
    const float tot = ss + xch[(w ^ 4) * 16 + i16];
    const float rn = __builtin_amdgcn_rsqf(tot * (1.0f / MLDV) + EPS);
#pragma unroll
    for (int dt = 0; dt < 8; ++dt) { const int dv = dv0 + 16 * dt;
        const f32x4 g4 = *(const f32x4*)(gain + dv);
        const float o0 = num[dt][0] * rn * g4[0] * sigmoidf_(bflo(mo2[dt][0])), o1 = num[dt][1] * rn * g4[1] * sigmoidf_(bfhi(mo2[dt][0]));
        const float o2 = num[dt][2] * rn * g4[2] * sigmoidf_(bflo(mo2[dt][1])), o3 = num[dt][3] * rn * g4[3] * sigmoidf_(bfhi(mo2[dt][1]));
        v2u ov; ov[0] = pg8::cvt_pk_bf16(o0, o1); ov[1] = pg8::cvt_pk_bf16(o2, o3);
        *(v2u*)(concat + row * 2048 + 1024 + dv) = ov; }
    __syncthreads();
}

__device__ __forceinline__ void state_scan(int bh, int sl, const bf16* KT, const bf16* VT, const float* EB, bf16* CST) {
    int tid_ = threadIdx.x; asm volatile("" : "+v"(tid_));
    const int tid = tid_, w = __builtin_amdgcn_readfirstlane(tid >> 6), lane = tid & 63, i16 = lane & 15, q = lane >> 4;
    const size_t it0 = (size_t)bh * NCHUNK;
    const bf16* ka = KT + (it0 * MLDK + 16 * w + i16) * 64 + 8 * q;
    const bf16* vb = VT + (it0 * MLDV + 16 * sl + i16) * 64 + 8 * q;
    bf16* cs = CST + (it0 * MLDV + 16 * sl + i16) * MLDK + 16 * w + 4 * q;
    const float ebv = EB[it0 + lane];
    f32x4 acc = (f32x4){0.f, 0.f, 0.f, 0.f};
    bf16x8 fa0[8], fa1[8], fb0[8], fb1[8];
#pragma unroll
    for (int j = 0; j < 8; ++j) { fa0[j] = *(const bf16x8*)(ka + (size_t)j * MLDK * 64); fa1[j] = *(const bf16x8*)(ka + (size_t)j * MLDK * 64 + 32);
                                  fb0[j] = *(const bf16x8*)(vb + (size_t)j * MLDV * 64); fb1[j] = *(const bf16x8*)(vb + (size_t)j * MLDV * 64 + 32); }
    for (int c0 = 0; c0 < NCHUNK; c0 += 8) {
#pragma unroll
        for (int j = 0; j < 8; ++j) { const int c = c0 + j;
            v2u ov; ov[0] = pg8::cvt_pk_bf16(acc[0], acc[1]); ov[1] = pg8::cvt_pk_bf16(acc[2], acc[3]);
            *(v2u*)(cs + (size_t)c * MLDV * MLDK) = ov;
            acc = MFMA16(fa0[j], fb0[j], acc); acc = MFMA16(fa1[j], fb1[j], acc);
            const int cn = c + 8 < NCHUNK ? c + 8 : c;
            fa0[j] = *(const bf16x8*)(ka + (size_t)cn * MLDK * 64); fa1[j] = *(const bf16x8*)(ka + (size_t)cn * MLDK * 64 + 32);
            fb0[j] = *(const bf16x8*)(vb + (size_t)cn * MLDV * 64); fb1[j] = *(const bf16x8*)(vb + (size_t)cn * MLDV * 64 + 32);
            const float e = __shfl(ebv, c);
            acc = acc * e; }
    }
}
#undef MFMA16
}
typedef const float* cfp_t;
struct Frame {
    LAS unsigned char* lds; unsigned char* ldsg;
    int tid, lane, wave, vcu, G;
    const __attribute__((address_space(4))) cfp_t* inp; float* out; unsigned char* ws;
};
__device__ __forceinline__ void refresh_ids(Frame& F) { int t = threadIdx.x; asm volatile("" : "+v"(t)); F.tid = t; F.lane = t & 63; F.wave = __builtin_amdgcn_readfirstlane(t >> 6); }
__device__ __forceinline__ float wave_incl_scan(float v, int lane) {
#pragma unroll
    for (int o = 1; o < 64; o <<= 1) { const float t = __shfl_up(v, o); if (lane >= o) v += t; }
    return v;
}

__device__ __forceinline__ void p0_transpose_item(const float* W, int ldw, int K, bf16* WT, const float* gk, int k0, int n0_dst, int n0_src, LAS float* scr, int lane) {
    float vv[32];
#pragma unroll
    for (int i = 0; i < 32; ++i) { const int kk = 2 * i + (lane >> 5); vv[i] = W[(size_t)(k0 + kk) * ldw + n0_src + (lane & 31)]; }
    if (gk) {
#pragma unroll
        for (int i = 0; i < 32; ++i) vv[i] *= gk[k0 + 2 * i + (lane >> 5)]; }
#pragma unroll
    for (int i = 0; i < 32; ++i) scr[(2 * i + (lane >> 5)) * 33 + (lane & 31)] = vv[i];
    LDS_WAIT(); asm volatile("" ::: "memory");
    const int c = lane & 7;
#pragma unroll
    for (int j = 0; j < 4; ++j) { const int n = (lane >> 3) + 8 * j; const LAS float* s = scr + (8 * c) * 33 + n;
        v4u o; o.x = pk2(s[0 * 33], s[1 * 33]); o.y = pk2(s[2 * 33], s[3 * 33]); o.z = pk2(s[4 * 33], s[5 * 33]); o.w = pk2(s[6 * 33], s[7 * 33]);
        *(GAS v4u*)(WT + (size_t)(n0_dst + n) * K + k0 + 8 * c) = o; }
    LDS_WAIT(); asm volatile("" ::: "memory");
}
__device__ __forceinline__ float rms_row_to_bf16(const float* xrow, const float* g, bf16* orow, int lane) {
    const GAS v4f* xr = (const GAS v4f*)xrow + lane; const GAS v4f* gr = (const GAS v4f*)g + lane;
    v4f v[8]; float s = 0.f;
#pragma unroll
    for (int j = 0; j < 8; ++j) { v[j] = xr[64 * j]; s += (v[j].x * v[j].x + v[j].y * v[j].y) + (v[j].z * v[j].z + v[j].w * v[j].w); }
    const float rinv = 1.0f / sqrtf(wave_sum(s) * (1.f / DM) + EPS);
    GAS v2u* o8 = (GAS v2u*)orow + lane;
#pragma unroll
    for (int j = 0; j < 8; ++j) { const v4f gg = gr[64 * j]; v2u w; w.x = pk2(v[j].x * rinv * gg.x, v[j].y * rinv * gg.y); w.y = pk2(v[j].z * rinv * gg.z, v[j].w * rinv * gg.w); o8[64 * j] = w; }
    return rinv;
}
__device__ __forceinline__ void p0_prologue(Frame& F) {
    refresh_ids(F);
    const float* x = F.inp[0]; const float* mem = F.inp[1]; const float* mixer_norm = F.inp[2]; const float* w_in = F.inp[3];
    const int gw = F.vcu * 8 + F.wave, NGW = F.G * 8;
    LAS float* WgL = (LAS float*)F.lds;
#pragma unroll 8
    for (int idx = F.tid; idx < 32768; idx += NTHREADS) { const int e = idx & 7, ln = (idx >> 3) & 63, sp = idx >> 9, gate = ln & 15, q = ln >> 4, k = 32 * sp + 8 * q + e;
        const int col = gate < 8 ? 3072 + gate : 5128 + (gate - 8);
        WgL[idx] = w_in[(size_t)k * IN_WIDTH + col] * mixer_norm[k]; }
    __syncthreads();
    { float* gates = (float*)(F.ws + WS_GATES); float* ssqx = (float*)(F.ws + WS_CTL + CTL_SSQX); bf16* XG = (bf16*)(F.ws + WS_XN);
      const int i16 = F.lane & 15, q = F.lane >> 4;
      for (int it = gw; it < MTOK / 16 * 2; it += NGW) { const int grp = it >> 1, kh = it & 1; const size_t row = (size_t)grp * 16 + i16;
          const float* xr = x + row * DM + kh * 1024 + 8 * q; const float* gr = mixer_norm + kh * 1024 + 8 * q; bf16* xo = XG + row * DM + kh * 1024 + 8 * q;
          const LAS float* wp = WgL + (kh * 32 * 64 + F.lane) * 8;
          v4f acc = (v4f){0.f, 0.f, 0.f, 0.f}; float ss = 0.f;
#pragma unroll 1
          for (int s0 = 0; s0 < 32; s0 += 8, wp += 8 * 512, xr += 8 * 32, gr += 8 * 32, xo += 8 * 32) { v4f xb[8][2];
#pragma unroll
              for (int j = 0; j < 8; ++j) { xb[j][0] = *(const v4f*)(xr + 32 * j); xb[j][1] = *(const v4f*)(xr + 32 * j + 4); }
#pragma unroll
              for (int j = 0; j < 8; ++j) { const v4f x0 = xb[j][0], x1 = xb[j][1]; const v4f g0 = *(const v4f*)(gr + 32 * j), g1 = *(const v4f*)(gr + 32 * j + 4);
                  const v4f w0 = *(const LAS v4f*)(wp + j * 512), w1 = *(const LAS v4f*)(wp + j * 512 + 4);
                  ss += (x0.x * x0.x + x0.y * x0.y) + (x0.z * x0.z + x0.w * x0.w) + (x1.x * x1.x + x1.y * x1.y) + (x1.z * x1.z + x1.w * x1.w);
                  v4u o; o.x = pk2(x0.x * g0.x, x0.y * g0.y); o.y = pk2(x0.z * g0.z, x0.w * g0.w); o.z = pk2(x1.x * g1.x, x1.y * g1.y); o.w = pk2(x1.z * g1.z, x1.w * g1.w);
                  *(v4u*)(xo + 32 * j) = o;
                  acc = __builtin_amdgcn_mfma_f32_16x16x4f32(x0.x, w0.x, acc, 0, 0, 0); acc = __builtin_amdgcn_mfma_f32_16x16x4f32(x0.y, w0.y, acc, 0, 0, 0);
                  acc = __builtin_amdgcn_mfma_f32_16x16x4f32(x0.z, w0.z, acc, 0, 0, 0); acc = __builtin_amdgcn_mfma_f32_16x16x4f32(x0.w, w0.w, acc, 0, 0, 0);
                  acc = __builtin_amdgcn_mfma_f32_16x16x4f32(x1.x, w1.x, acc, 0, 0, 0); acc = __builtin_amdgcn_mfma_f32_16x16x4f32(x1.y, w1.y, acc, 0, 0, 0);
                  acc = __builtin_amdgcn_mfma_f32_16x16x4f32(x1.z, w1.z, acc, 0, 0, 0); acc = __builtin_amdgcn_mfma_f32_16x16x4f32(x1.w, w1.w, acc, 0, 0, 0); } }
          ss += __shfl_xor(ss, 16); ss += __shfl_xor(ss, 32);
          if (q == 0) atomicAdd(ssqx + row, ss);
#pragma unroll
          for (int r = 0; r < 4; ++r) atomicAdd(gates + ((size_t)grp * 16 + 4 * q + r) * 16 + i16, acc[r]);
      } }
    { bf16* MN = (bf16*)(F.ws + WS_MN);
      for (int m = gw; m < MROWS; m += NGW) (void)rms_row_to_bf16(mem + (size_t)m * DM, F.inp[15], MN + (size_t)m * DM, F.lane); }
    __syncthreads();
    LAS float* scr = (LAS float*)(F.lds + F.wave * 16384);
    for (int it = gw; it < 32768; it += NGW) {
        int r = it;
        if (r < 6144) { const int kb = r / 192, nb = r % 192, n0 = 32 * nb, grpc = n0 >> 10, shift = grpc < 3 ? 0 : (grpc < 5 ? 8 : 16);
            p0_transpose_item(w_in, IN_WIDTH, DM, (bf16*)(F.ws + WS_WIN), nullptr, 64 * kb, n0, n0 + shift, scr, F.lane); continue; } r -= 6144;
        if (r < 2048) { p0_transpose_item(F.inp[13], DM, DM, (bf16*)(F.ws + WS_WOUT), nullptr, 64 * (r / 64), 32 * (r % 64), 32 * (r % 64), scr, F.lane); continue; } r -= 2048;
        if (r < 2048) { p0_transpose_item(F.inp[16], DM, DM, (bf16*)(F.ws + WS_WXQ), F.inp[14], 64 * (r / 64), 32 * (r % 64), 32 * (r % 64), scr, F.lane); continue; } r -= 2048;
        if (r < 4096) { p0_transpose_item(F.inp[17], 2 * DM, DM, (bf16*)(F.ws + WS_WXKV), nullptr, 64 * (r / 128), 32 * (r % 128), 32 * (r % 128), scr, F.lane); continue; } r -= 4096;
        if (r < 2048) { p0_transpose_item(F.inp[20], DM, DM, (bf16*)(F.ws + WS_WXO), nullptr, 64 * (r / 64), 32 * (r % 64), 32 * (r % 64), scr, F.lane); continue; } r -= 2048;
        if (r < 8192) { p0_transpose_item(F.inp[22], DFF, DM, (bf16*)(F.ws + WS_WUP), F.inp[21], 64 * (r / 256), 32 * (r % 256), 32 * (r % 256), scr, F.lane); continue; } r -= 8192;
        p0_transpose_item(F.inp[23], DM, DFF, (bf16*)(F.ws + WS_WDN), nullptr, 64 * (r / 64), 32 * (r % 64), 32 * (r % 64), scr, F.lane);
    }
}

constexpr int P2_KT_OFF = 4096, P2_KT_PITCH = 136, P2_VT_OFF = P2_KT_OFF + 64 * P2_KT_PITCH * 2, P2_VT_PITCH = 264;
constexpr int P2_BUF_ELEMS = (64 * P2_KT_PITCH + 64 * P2_VT_PITCH);
__device__ __forceinline__ void p2_prep_item(Frame& F, int item, bool do_norm = true) {
    refresh_ids(F);
    const int b = item >> 6, c = item & 63; const size_t R0 = (size_t)b * SEQ + (size_t)c * 64;
    const int tid = F.tid, lane = F.lane, w = F.wave;
    LAS float* gq = (LAS float*)F.lds; LAS float* uk = gq + 256;
    LAS bf16* kt = (LAS bf16*)(F.lds + P2_KT_OFF); LAS bf16* vt = (LAS bf16*)(F.lds + P2_VT_OFF);
    const float* GATES = (const float*)(F.ws + WS_GATES); const float* SSQX = (const float*)(F.ws + WS_CTL + CTL_SSQX);
    if (w < 4) { const size_t row = R0 + lane; const float ri = rinv_of(SSQX, row);
        const float mi = GATES[row * 16 + 8 + w] * ri + F.inp[5][w], mf = GATES[row * 16 + 12 + w] * ri + F.inp[6][w];
        const float bcum = wave_incl_scan(logsigmoidf(mf), lane);
        const float g = __expf(bcum), u = __expf(mi - bcum) * 0.08838834764831845f;
        gq[w * 64 + lane] = g; uk[w * 64 + lane] = u;
        if (lane == 63) ((float*)(F.ws + WS_EB))[(size_t)(b * MLH + w) * NCHUNK + c] = g; }
    if (do_norm) { bf16* FQ = (bf16*)(F.ws + WS_FQ); bf16* FK = (bf16*)(F.ws + WS_FK); const int l16 = lane & 15;
      float gqn[8], gkn[8];
#pragma unroll
      for (int e = 0; e < 8; ++e) { gqn[e] = F.inp[9][l16 * 8 + e]; gkn[e] = F.inp[10][l16 * 8 + e]; }
      for (int it0 = w; it0 < 256; it0 += 64) {
          v4u raw[8];
#pragma unroll
          for (int j = 0; j < 8; ++j) { const int seg = (it0 + 8 * j) * 4 + (lane >> 4), row = seg >> 4, hh = seg & 15;
              raw[j] = *(const v4u*)((hh < 8 ? FQ : FK) + (R0 + row) * 1024 + (hh & 7) * FOXD + l16 * 8); }
#pragma unroll
          for (int j = 0; j < 8; ++j) { const int seg = (it0 + 8 * j) * 4 + (lane >> 4), row = seg >> 4, hh = seg & 15;
              bf16* p = (hh < 8 ? FQ : FK) + (R0 + row) * 1024 + (hh & 7) * FOXD + l16 * 8; float v[8];
#pragma unroll
              for (int e = 0; e < 4; ++e) { v[2 * e] = bflo(raw[j][e]); v[2 * e + 1] = bfhi(raw[j][e]); }
              float ss = 0.f;
#pragma unroll
              for (int e = 0; e < 8; ++e) ss += v[e] * v[e];
              ss += __shfl_xor(ss, 1); ss += __shfl_xor(ss, 2); ss += __shfl_xor(ss, 4); ss += __shfl_xor(ss, 8);
              const float ri = 1.0f / sqrtf(ss * (1.0f / FOXD) + EPS);
              v4u o;
#pragma unroll
              for (int e = 0; e < 4; ++e) { const float g0 = hh < 8 ? gqn[2 * e] : gkn[2 * e], g1 = hh < 8 ? gqn[2 * e + 1] : gkn[2 * e + 1]; o[e] = pk2(v[2 * e] * ri * g0, v[2 * e + 1] * ri * g1); }
              *(v4u*)p = o; } } }
    __syncthreads();
    const bf16* MQK = (const bf16*)(F.ws + WS_MQK); const bf16* MV = (const bf16*)(F.ws + WS_MV);
    bf16* QP = (bf16*)(F.ws + WS_QP); bf16* KPP = (bf16*)(F.ws + WS_KPP);
    const float* conv_w = F.inp[7]; const float* conv_b = F.inp[8];
    const int cgp = tid & 31, rg = tid >> 5; const bool isq = cgp < 16;
    v4u rawc[7], rawv[4];
#define P2_LOAD(h_) do { const int col_ = (isq ? 0 : 512) + (h_) * MLDK + (cgp & 15) * 8;                                              \
        _Pragma("unroll") for (int i = 0; i < 7; ++i) { const int pos = c * 64 + 4 * rg - 3 + i;                                           \
            rawc[i] = (v4u){0u, 0u, 0u, 0u}; if (pos >= 0) rawc[i] = *(const v4u*)(MQK + ((size_t)b * SEQ + pos) * 1024 + col_); }            \
        _Pragma("unroll") for (int i = 0; i < 4; ++i) { const int idx = tid + NTHREADS * i, row = idx >> 5, ch = idx & 31;                 \
            rawv[i] = *(const v4u*)(MV + (R0 + row) * 1024 + (h_) * MLDV + ch * 8); } } while (0)
#define P2_CONV(h_, kt_, vt_) do { const int col_ = (isq ? 0 : 512) + (h_) * MLDK + (cgp & 15) * 8;                                       \
        float cw[4][8], cb[8];                                                                                                             \
        _Pragma("unroll") for (int e = 0; e < 8; ++e) { cb[e] = conv_b[col_ + e];                                                          \
            _Pragma("unroll") for (int j = 0; j < 4; ++j) cw[j][e] = conv_w[j * 1024 + col_ + e]; }                                        \
        float u[7][8];                                                                                                                     \
        _Pragma("unroll") for (int i = 0; i < 7; ++i) _Pragma("unroll") for (int e = 0; e < 4; ++e) { u[i][2 * e] = bflo(rawc[i][e]); u[i][2 * e + 1] = bfhi(rawc[i][e]); } \
        _Pragma("unroll") for (int r = 0; r < 4; ++r) { const int t = 4 * rg + r; const float f = isq ? gq[(h_) * 64 + t] : uk[(h_) * 64 + t]; float y[8]; \
            _Pragma("unroll") for (int e = 0; e < 8; ++e) { float a = cb[e];                                                               \
                _Pragma("unroll") for (int j = 0; j < 4; ++j) a += cw[j][e] * u[r + j][e];                                                 \
                y[e] = a * sigmoidf_(a) * f; }                                                                                             \
            v4u o; o.x = pk2(y[0], y[1]); o.y = pk2(y[2], y[3]); o.z = pk2(y[4], y[5]); o.w = pk2(y[6], y[7]);                             \
            *(v4u*)((isq ? QP : KPP) + (R0 + t) * 512 + (h_) * MLDK + (cgp & 15) * 8) = o;                                                 \
            if (!isq) *(LAS v4u*)((kt_) + t * P2_KT_PITCH + (cgp & 15) * 8) = o; }                                                         \
        _Pragma("unroll") for (int i = 0; i < 4; ++i) { const int idx = tid + NTHREADS * i, row = idx >> 5, ch = idx & 31;                 \
            *(LAS v4u*)((vt_) + row * P2_VT_PITCH + ch * 8) = rawv[i]; } } while (0)
    P2_LOAD(0); P2_CONV(0, kt, vt);
    __syncthreads();
    for (int h = 0; h < MLH; ++h) {
        LAS bf16* ktc = kt + (h & 1) * P2_BUF_ELEMS; LAS bf16* vtc = vt + (h & 1) * P2_BUF_ELEMS;
        LAS bf16* ktn = kt + ((h + 1) & 1) * P2_BUF_ELEMS; LAS bf16* vtn = vt + ((h + 1) & 1) * P2_BUF_ELEMS;
        if (h + 1 < MLH) P2_LOAD(h + 1);
        const size_t itemh = (size_t)(b * MLH + h) * NCHUNK + c;
        { bf16* KT = (bf16*)(F.ws + WS_KT) + itemh * MLDK * 64;
#pragma unroll
          for (int i = 0; i < 2; ++i) { const int idx = tid + NTHREADS * i, d = idx >> 3, sg = idx & 7; unsigned short e8[8];
#pragma unroll
              for (int e = 0; e < 8; ++e) e8[e] = ktc[(8 * sg + e) * P2_KT_PITCH + d];
              v4u o; o.x = e8[0] | ((unsigned)e8[1] << 16); o.y = e8[2] | ((unsigned)e8[3] << 16); o.z = e8[4] | ((unsigned)e8[5] << 16); o.w = e8[6] | ((unsigned)e8[7] << 16);
              *(v4u*)(KT + d * 64 + 8 * sg) = o; }
          bf16* VT = (bf16*)(F.ws + WS_VT) + itemh * MLDV * 64;
#pragma unroll
          for (int i = 0; i < 4; ++i) { const int idx = tid + NTHREADS * i, dv = idx >> 3, sg = idx & 7; unsigned short e8[8];
#pragma unroll
              for (int e = 0; e < 8; ++e) e8[e] = vtc[(8 * sg + e) * P2_VT_PITCH + dv];
              v4u o; o.x = e8[0] | ((unsigned)e8[1] << 16); o.y = e8[2] | ((unsigned)e8[3] << 16); o.z = e8[4] | ((unsigned)e8[5] << 16); o.w = e8[6] | ((unsigned)e8[7] << 16);
              *(v4u*)(VT + dv * 64 + 8 * sg) = o; }
          if (tid < MLDK) { float s = 0.f;
#pragma unroll 8
              for (int t = 0; t < 64; ++t) s += bf2f(ktc[t * P2_KT_PITCH + tid]);
              ((float*)(F.ws + WS_KSUM))[itemh * MLDK + tid] = s; } }
        if (h + 1 < MLH) P2_CONV(h + 1, ktn, vtn);
        __syncthreads();
    }
#undef P2_LOAD
#undef P2_CONV
    { const int mr = item * 4 + (w & 3); const float* slab = (const float*)((const unsigned char*)F.out + OUT_SLAB);
      if (w < 4) {
        const float* gxq = F.inp[18]; const float* gxk = F.inp[19];
        v4f kv[8]; float ssh[4] = {0.f, 0.f, 0.f, 0.f};
#pragma unroll
        for (int j = 0; j < 8; ++j) { const int col = 4 * (lane + 64 * j); v4f a = (v4f){0.f, 0.f, 0.f, 0.f};
#pragma unroll
            for (int s = 0; s < 4; ++s) a = a + *(const v4f*)(slab + ((size_t)s * MROWS + mr) * 4096 + col);
            kv[j] = a; ssh[j >> 1] += (a.x * a.x + a.y * a.y) + (a.z * a.z + a.w * a.w); }
        float rk[4];
#pragma unroll
        for (int hh = 0; hh < 4; ++hh) rk[hh] = 1.0f / sqrtf(wave_sum(ssh[hh]) * (1.0f / XD) + EPS);
        bf16* KH = (bf16*)(F.ws + WS_KHAT) + (size_t)mr * DM;
#pragma unroll
        for (int j = 0; j < 8; ++j) { const int col = 4 * (lane + 64 * j), d = col & (XD - 1); const v4f a = *(const v4f*)(gxq + d), g2 = *(const v4f*)(gxk + d); const float r = rk[j >> 1];
            v2u o; o.x = pk2(kv[j].x * r * a.x * g2.x, kv[j].y * r * a.y * g2.y); o.y = pk2(kv[j].z * r * a.z * g2.z, kv[j].w * r * a.w * g2.w);
            *(v2u*)(KH + col) = o; }
      } else {
        bf16* VTM = (bf16*)(F.ws + WS_VTM); const int bm = mr >> 8, key = mr & 255;
        v4f vv[8];
#pragma unroll
        for (int j = 0; j < 8; ++j) { const int dcol = 4 * (lane + 64 * j); v4f a = (v4f){0.f, 0.f, 0.f, 0.f};
#pragma unroll
            for (int s = 0; s < 4; ++s) a = a + *(const v4f*)(slab + ((size_t)s * MROWS + mr) * 4096 + 2048 + dcol);
            vv[j] = a; }
#pragma unroll
        for (int j = 0; j < 8; ++j) { const int dcol = 4 * (lane + 64 * j); const v4f a = vv[j];
            const int hh = dcol >> 9, d = dcol & (XD - 1); bf16* vp = VTM + ((size_t)(bm * XH + hh) * XD + d) * NMEM + key;
            vp[0] = (bf16)f2bf(a.x); vp[NMEM] = (bf16)f2bf(a.y); vp[2 * NMEM] = (bf16)f2bf(a.z); vp[3 * NMEM] = (bf16)f2bf(a.w); }
      } }
    __syncthreads();
}

__device__ __forceinline__ void p3_scan_item(Frame& F, int item) {
    refresh_ids(F);
    const int bh = item >> 4, sl = item & 15;
    mls::state_scan(bh, sl, (const bf16*)(F.ws + WS_KT), (const bf16*)(F.ws + WS_VT), (const float*)(F.ws + WS_EB), (bf16*)((unsigned char*)F.out + OUT_CST));
    if (sl == 0 && F.tid < MLDK) {
        const float* EB = (const float*)(F.ws + WS_EB) + (size_t)bh * NCHUNK; const float* KS = (const float*)(F.ws + WS_KSUM) + (size_t)bh * NCHUNK * MLDK + F.tid;
        float* NS = (float*)(F.ws + WS_NST) + (size_t)bh * NCHUNK * MLDK + F.tid; float n = 0.f;
        float ks[NCHUNK], eb[NCHUNK];
#pragma unroll
        for (int c = 0; c < NCHUNK; ++c) { ks[c] = KS[(size_t)c * MLDK]; eb[c] = EB[c]; }
#pragma unroll
        for (int c = 0; c < NCHUNK; ++c) { NS[(size_t)c * MLDK] = n; n = eb[c] * (n + ks[c]); }
    }
    if (sl == 1 || sl == 2) {
        const int seq = (sl - 1) * 16 + bh, b = seq >> 3, fh = seq & 7;
        const float* GATES = (const float*)(F.ws + WS_GATES); const float* SSQX = (const float*)(F.ws + WS_CTL + CTL_SSQX); const float fb = F.inp[4][fh];
        const size_t r0 = (size_t)b * SEQ + 8 * F.tid; float lf[8]; float tot = 0.f;
#pragma unroll
        for (int j = 0; j < 8; ++j) { lf[j] = logsigmoidf(GATES[(r0 + j) * 16 + fh] * rinv_of(SSQX, r0 + j) + fb); tot += lf[j]; }
        const float incl = wave_incl_scan(tot, F.lane);
        LAS float* wt = (LAS float*)F.lds;
        __syncthreads();
        if (F.lane == 63) wt[F.wave] = incl;
        __syncthreads();
        float run = incl - tot;
        for (int wv = 0; wv < F.wave; ++wv) run += wt[wv];
        float* C = (float*)(F.ws + WS_CFOX) + (size_t)seq * SEQ + 8 * F.tid;
        float cs[8];
#pragma unroll
        for (int j = 0; j < 8; ++j) { run += lf[j]; cs[j] = run * -11.313708498984761f; C[j] = cs[j]; }
        LAS float* cp0 = wt + 16; LAS float* cend = wt + 32; LAS float* thr = wt + 96;
        if ((F.tid & 31) == 0) cp0[F.tid >> 5] = cs[0];
        if ((F.tid & 7) == 7) cend[F.tid >> 3] = cs[7];
        if (F.wave == 0) { float gq = fmaxf(fabsf(F.inp[9][F.lane]), fabsf(F.inp[9][F.lane + 64])), gk = fmaxf(fabsf(F.inp[10][F.lane]), fabsf(F.inp[10][F.lane + 64]));
#pragma unroll
            for (int o = 1; o < 64; o <<= 1) { gq = fmaxf(gq, __shfl_xor(gq, o)); gk = fmaxf(gk, __shfl_xor(gk, o)); }
            if (F.lane == 0) thr[0] = 2.0f * 11.313708498984761f * gq * gk + 29.0f; }
        __syncthreads();
        if (F.tid < 16) { const int qb = F.tid; const float T = thr[0], c0 = cp0[qb]; int j = 0;
            while (j < 4 * qb && (c0 - cend[j]) * 0.08838834764831845f > T) ++j;
            ((int*)(F.ws + WS_JLO))[seq * 16 + qb] = JLO_DISABLE ? 0 : (j & ~1); }
        __syncthreads();
    }
}
#ifndef MK_PER_PHASE
#define MK_PER_PHASE 0
#endif
#define XB_TMO      128
#define XB_XCNT(j)  (256  + 64 * (j))
#define XB_XSUB(j)  (1280 + 64 * (j))
#define XB_XGEN(j)  (2304 + 64 * (j))
#define XB_TOP      3328
#define XB_TOPGEN   3392
#define XCD_BAR_WORDS 3456
#define XB_SPIN_CAP (1u << 20)
__device__ __forceinline__ unsigned xb_ld(unsigned* p)              { return __hip_atomic_load(p, __ATOMIC_RELAXED, __HIP_MEMORY_SCOPE_AGENT); }
__device__ __forceinline__ unsigned xb_add(unsigned* p, unsigned v) { return __hip_atomic_fetch_add(p, v, __ATOMIC_RELAXED, __HIP_MEMORY_SCOPE_AGENT); }
__device__ __forceinline__ unsigned xb_xcc_id() { return (unsigned)__builtin_amdgcn_s_getreg((3 << 11) | 20) & 0xFu; }
#define XB_SPIN(cond, bar) do { unsigned _sp = 0; while (cond) { __builtin_amdgcn_s_sleep(1); \
    if ((++_sp & 255u) == 0u) { if (xb_ld(&(bar)[XB_TMO])) break; if (_sp > XB_SPIN_CAP) { atomicAdd(&(bar)[XB_TMO], 1u); break; } } } } while (0)
struct XcdBarrier { unsigned* bar; unsigned x; volatile LAS unsigned* st; };
__device__ __forceinline__ XcdBarrier xcd_barrier_post(unsigned* bar, volatile LAS unsigned* st) {
    XcdBarrier b; b.bar = bar; b.x = xb_xcc_id(); b.st = st;
    if (threadIdx.x == 0) (void)xb_add(&bar[XB_XCNT(b.x)], 1u);
    return b;
}
__device__ __forceinline__ void xcd_barrier_complete(unsigned* bar, unsigned x, unsigned& nloc, unsigned& nx) {
    const unsigned G = gridDim.x * gridDim.y * gridDim.z;
    unsigned sum, cnt, mine, sp = 0u;
    for (;;) {
        sum = 0u; cnt = 0u; mine = 0u;
#pragma unroll
        for (unsigned j = 0; j < 16; ++j) { const unsigned c = xb_ld(&bar[XB_XCNT(j)]); sum += c; cnt += (c > 0u) ? 1u : 0u; mine = (j == x) ? c : mine; }
        if (sum == G) break;
        __builtin_amdgcn_s_sleep(1);
        if ((++sp & 255u) == 0u) { if (xb_ld(&bar[XB_TMO])) break; if (sp > XB_SPIN_CAP) { atomicAdd(&bar[XB_TMO], 1u); break; } }
    }
    nloc = mine > 0u ? mine : 1u; nx = cnt > 0u ? cnt : 1u;
}
__device__ __forceinline__ void xcd_barrier(const XcdBarrier& b) {
    asm volatile("s_waitcnt vmcnt(0)" ::: "memory");
    __syncthreads();
    if (threadIdx.x == 0) {
        unsigned* bar = b.bar;
        __builtin_amdgcn_s_waitcnt(0);
        unsigned nloc = b.st[0], nx = b.st[1];
        if (nloc == 0u) { xcd_barrier_complete(bar, b.x, nloc, nx); b.st[0] = nloc; b.st[1] = nx; }
        const unsigned old = xb_add(&bar[XB_XSUB(b.x)], 1u);
        const unsigned gen = old / nloc;
        if (old + 1u == (gen + 1u) * nloc) {
            __builtin_amdgcn_fence(__ATOMIC_RELEASE, "agent");
            asm volatile("s_waitcnt vmcnt(0)" ::: "memory");
            const unsigned og = xb_add(&bar[XB_TOP], 1u);
            const unsigned tg = og / nx;
            if (og + 1u == (tg + 1u) * nx) xb_add(&bar[XB_TOPGEN], 1u);
            else XB_SPIN(xb_ld(&bar[XB_TOPGEN]) == tg, bar);
            __builtin_amdgcn_fence(__ATOMIC_ACQUIRE, "agent");
            xb_add(&bar[XB_XGEN(b.x)], 1u);
            asm volatile("s_waitcnt vmcnt(0)" ::: "memory");
        } else {
            XB_SPIN(xb_ld(&bar[XB_XGEN(b.x)]) == gen, bar);
            __builtin_amdgcn_fence(__ATOMIC_ACQUIRE, "agent");
            asm volatile("s_waitcnt vmcnt(0)" ::: "memory");
        }
    }
    __syncthreads();
}
constexpr int LDS_MISC_OFF = LDS_BYTES - 256;
#ifndef ML_TWICE
#define ML_TWICE 1
#endif
#ifndef TWICE_P5
#define TWICE_P5 0
#endif
#ifndef TWICE_P6
#define TWICE_P6 0
#endif
#ifndef TWICE_P8
#define TWICE_P8 0
#endif
#ifndef P4_TWICE
#define P4_TWICE 1
#endif
#ifndef TWICE_P11
#define TWICE_P11 0
#endif
#ifndef TWICE_P10
#define TWICE_P10 0
#endif
#ifndef TWICE_P1
#define TWICE_P1 0
#endif
#ifndef JLO_DISABLE
#define JLO_DISABLE 0
#endif
constexpr int N_PHASES = 12;
struct Args { const float* in[24]; float* out; unsigned char* ws; int ph_lo, ph_hi; };
static_assert(sizeof(Args) == 24 * 8 + 8 + 8 + 8, "Args has no padding");

__global__ void __launch_bounds__(NTHREADS, 2) fwd_kernel(Args args) {
    extern __shared__ __attribute__((aligned(16))) unsigned char lds[];
    Frame F;
    F.lds = (LAS unsigned char*)lds; F.ldsg = lds;
    F.tid = threadIdx.x; F.lane = F.tid & 63; F.wave = __builtin_amdgcn_readfirstlane(F.tid >> 6);
    F.G = gridDim.x; { const int bx = blockIdx.x; F.vcu = (F.G % 8 == 0) ? (bx % 8) * (F.G / 8) + bx / 8 : bx; }
    F.inp = (const __attribute__((address_space(4))) cfp_t*)__builtin_amdgcn_kernarg_segment_ptr();
    F.out = args.out; F.ws = args.ws;
    unsigned char* ws = args.ws;
    const int lo = args.ph_lo, hi = args.ph_hi;
    volatile LAS unsigned* MISC = (volatile LAS unsigned*)(F.lds + LDS_MISC_OFF);
    if (F.tid < 64) MISC[F.tid] = 0u;
    __syncthreads();
    XcdBarrier xbar; xbar.bar = (unsigned*)(ws + WS_CTL); xbar.x = 0; xbar.st = nullptr;
    if (hi - lo > 1) xbar = xcd_barrier_post((unsigned*)(ws + WS_CTL), MISC);
#ifndef PHASE_MASK
#define PHASE_MASK 0xfff
#endif
#define IN(k) ((((PHASE_MASK) >> (k)) & 1) && lo <= (k) && (k) < hi)
#ifndef DUP_PHASE
#define DUP_PHASE 99
#endif
#define REP(k) for (int rep_ = 0; rep_ < ((k) == DUP_PHASE ? 2 : 1); ++rep_, ((k) == DUP_PHASE && rep_ < 2 ? xcd_barrier(xbar) : (void)0))
#define SEAM(k) do { if (IN(k) && IN((k) + 1)) { xcd_barrier(xbar); } } while (0)
    if (__builtin_expect(lo < 0, 0)) cg::this_grid().sync();
    float* SSQ1 = (float*)(ws + WS_CTL + CTL_SSQ1); float* SSQ2 = (float*)(ws + WS_CTL + CTL_SSQ2); float* SSQQ = (float*)(ws + WS_CTL + CTL_SSQQ);

#ifdef PROBE_PHASE
    unsigned long long pt0 = 0, pt1 = 0, pu0 = 0, pu1 = 0;
#ifndef PROBE_B
#define PROBE_B 99
#endif
#define STAMP(k) do { if ((k) == PROBE_PHASE) pt0 = __builtin_amdgcn_s_memrealtime(); if ((k) == PROBE_PHASE + 1) pt1 = __builtin_amdgcn_s_memrealtime(); \
                      if ((k) == PROBE_B) pu0 = __builtin_amdgcn_s_memrealtime(); if ((k) == PROBE_B + 1) pu1 = __builtin_amdgcn_s_memrealtime(); } while (0)
#else
#define STAMP(k) do {} while (0)
#endif
    STAMP(0);
    if (IN(0)) REP(0) { p0_prologue(F); }
    SEAM(0); STAMP(1);
    if (IN(1)) REP(1) {
        { pg8::Gemm g{(const bf16*)(ws + WS_XN), (const bf16*)(ws + WS_WIN), DM, DM, DM}; pg8::StdOrder S; S.init(MTOK, NPROJ, DM, DM, F.G, (int)blockIdx.x, TWICE_P1);
          pg8::EpiProj E{(bf16*)(ws + WS_PROJ), F.inp[9], F.inp[10], (const float*)(ws + WS_CTL + CTL_SSQX), (LAS float*)(F.lds + pg8::STAGE_BYTES)};
          pg8::gemm_phase<pg8::EpiProj, pg8::StdOrder, true>(F.lds, g, S, E); }
        { pg8::Gemm g{(const bf16*)(ws + WS_MN), (const bf16*)(ws + WS_WXKV), DM, DM, 512}; pg8::XkvOrder S{F.G, (int)blockIdx.x};
          pg8::EpiSlab E{(float*)((unsigned char*)F.out + OUT_SLAB), 4096, (size_t)MROWS * 4096};
          pg8::gemm_phase<pg8::EpiSlab, pg8::XkvOrder, false>(F.lds, g, S, E); }
    }
    SEAM(1); STAMP(2);
#ifndef P2_TWICE
#define P2_TWICE 1
#endif
    if (IN(2)) REP(2) { for (int item = F.vcu; item < BATCH * NCHUNK * P2_TWICE; item += F.G) p2_prep_item(F, item & 255, false); }
    SEAM(2); STAMP(3);
#ifndef P3_TWICE
#define P3_TWICE 1
#endif
    if (IN(3)) REP(3) { for (int item = F.vcu; item < 256 * P3_TWICE; item += F.G) p3_scan_item(F, item & 255); }
    SEAM(3); STAMP(4);
    if (IN(4)) REP(4) {
        {
            const fox::Srd R = __builtin_amdgcn_make_buffer_rsrc((void*)ws, (short)0, (int)WS_END, 0x00020000);
            unsigned* QC = (unsigned*)(ws + WS_CTL + CTL_QCTR); const int* JLO = (const int*)(ws + WS_JLO);
            const float* CF = (const float*)(ws + WS_CFOX); const float* GO = F.inp[11];
            constexpr int QN = 192 * P4_TWICE, NONE = 1 << 20;
            auto mk_item = [&](int g) { const int qx = g / QN, i = (g - qx * QN) % 192, qb = 15 - (i >> 2), bh = 4 * qx + (i & 3), b = bh >> 3, h = bh & 7;
                fox::Item I; I.rowb = (unsigned)b * SEQ * 2048u + (unsigned)h * (FOXD * 2); I.o = (unsigned)WS_CONCAT + (unsigned)b * SEQ * 4096u + (unsigned)h * (FOXD * 2);
                I.CS = CF + (size_t)bh * SEQ; I.G = GO + h * FOXD; I.P0 = qb * 256; I.jlo = JLO[bh * 16 + qb]; return I; };
            auto is_fox = [&](int g) { return g < NONE && ((g % QN) % 192) < 64; };
            auto pull = [&]() { if (F.tid == 0) { unsigned qc = MISC[17], left = MISC[18]; int g = NONE;
                    while (left > 0u) { const unsigned i = atomicAdd(QC + qc * 64, 1u); if (i < (unsigned)QN) { g = (int)(qc * QN + i); break; } qc = (qc + 1u) & 7u; --left; }
                    MISC[17] = qc; MISC[18] = left; MISC[16] = (unsigned)g; } };
            if (F.tid == 0) { MISC[17] = xb_xcc_id() & 7u; MISC[18] = 8u; }
            pull();
            __syncthreads();
            int cur = __builtin_amdgcn_readfirstlane((int)MISC[16]);
            __syncthreads();
            while (cur < NONE) {
                if (is_fox(cur)) {
                    fox::Item I = mk_item(cur); fox::Seam S;
                    fox::fox_prime(R, I, (char*)lds, S);
                    for (;;) {
                        pull();
                        auto next_item = [&](const fox::Item& self, int& nidx) { nidx = __builtin_amdgcn_readfirstlane((int)MISC[16]); return is_fox(nidx) ? mk_item(nidx) : self; };
                        const int nidx = fox::fox_block(R, I, next_item, (char*)lds, S);
                        if (!is_fox(nidx)) { cur = nidx; break; }
                        I = mk_item(nidx);
                    }
                    VM_WAIT(); __syncthreads();
                } else {
                    const int qx = cur / QN, it = qx * 128 + ((cur - qx * QN) % 192 - 64), c = it & 63, h = (it >> 6) & 3, b = it >> 8;
                    pull();
                    mls::chunk_out(b, h, c, (const bf16*)(ws + WS_QP), (const bf16*)(ws + WS_KPP), (const bf16*)(ws + WS_VT), (const bf16*)((unsigned char*)F.out + OUT_CST),
                                   (const float*)(ws + WS_NST), (const bf16*)(ws + WS_MO), F.inp[12], (bf16*)(ws + WS_CONCAT), F.lds);
                    cur = __builtin_amdgcn_readfirstlane((int)MISC[16]);
                    __syncthreads();
                }
            }
        }
    }
    SEAM(4); STAMP(5);
    if (IN(5)) REP(5) {
        pg8::Gemm g{(const bf16*)(ws + WS_CONCAT), (const bf16*)(ws + WS_WOUT), DM, DM, DM}; pg8::StdOrder S; S.init(MTOK, DM, DM, DM, F.G, (int)blockIdx.x, TWICE_P5);
        pg8::EpiResid<true, false> E{F.inp[0], (bf16*)(ws + WS_X1B), SSQ1, DM};
        pg8::gemm_phase<pg8::EpiResid<true, false>, pg8::StdOrder, true>(F.lds, g, S, E);
    }
    SEAM(5); STAMP(6);
    if (IN(6)) REP(6) {
        pg8::Gemm g{(const bf16*)(ws + WS_X1B), (const bf16*)(ws + WS_WXQ), DM, DM, DM}; pg8::StdOrder S; S.init(MTOK, DM, DM, DM, F.G, (int)blockIdx.x, TWICE_P6);
        pg8::EpiQ E{(bf16*)(ws + WS_Q), SSQ1, SSQQ};
        pg8::gemm_phase<pg8::EpiQ, pg8::StdOrder, true>(F.lds, g, S, E);
    }
    SEAM(6); STAMP(7);
    if (IN(7)) REP(7) {
        pg8::Gemm g{(const bf16*)(ws + WS_Q), (const bf16*)(ws + WS_KHAT), DM, DM, XD}; pg8::ScoreOrder S{F.G, (int)blockIdx.x};
        pg8::EpiSoftmax E{(bf16*)(ws + WS_P), SSQQ};
        if (F.G >= 256) pg8::gemm_phase<pg8::EpiSoftmax, pg8::ScoreOrder, false>(F.lds, g, S, E);
    }
    SEAM(7); STAMP(8);
    if (IN(8)) REP(8) {
        pg8::Gemm g{(const bf16*)(ws + WS_P), (const bf16*)(ws + WS_VTM), 1024, NMEM, NMEM}; pg8::PvOrder S{F.G, (int)blockIdx.x, TWICE_P8};
        pg8::EpiStoreBf16 E{(bf16*)(ws + WS_CO), DM, 0, 0};
        pg8::gemm_phase<pg8::EpiStoreBf16, pg8::PvOrder, true>(F.lds, g, S, E);
    }
    SEAM(8); STAMP(9);
#ifdef EXTRA_BARS
    for (int eb = 0; eb < EXTRA_BARS; ++eb) xcd_barrier(xbar);
#endif
    if (IN(9)) REP(9) {
        pg8::Gemm g{(const bf16*)(ws + WS_CO), (const bf16*)(ws + WS_WXO), DM, DM, DM}; pg8::StdOrder S; S.init(MTOK, DM, DM, DM, F.G, (int)blockIdx.x);
        pg8::EpiResid<false, false> E{(const bf16*)(ws + WS_X1B), (bf16*)(ws + WS_X2B), SSQ2, DM};
        pg8::gemm_phase<pg8::EpiResid<false, false>, pg8::StdOrder, true>(F.lds, g, S, E);
    }
    SEAM(9); STAMP(10);
    if (IN(10)) REP(10) {
        pg8::Gemm g{(const bf16*)(ws + WS_X2B), (const bf16*)(ws + WS_WUP), DM, DM, DM}; pg8::StdOrder S; S.init(MTOK, DFF, DM, DM, F.G, (int)blockIdx.x, TWICE_P10);
        pg8::EpiUp E{(bf16*)(ws + WS_H), SSQ2};
        pg8::gemm_phase<pg8::EpiUp, pg8::StdOrder, true>(F.lds, g, S, E);
    }
    SEAM(10); STAMP(11);
    if (IN(11)) REP(11) {
        pg8::Gemm g{(const bf16*)(ws + WS_H), (const bf16*)(ws + WS_WDN), DFF, DFF, DFF}; pg8::StdOrder S; S.init(MTOK, DM, DFF, DFF, F.G, (int)blockIdx.x, TWICE_P11);
        pg8::EpiResid<false, true> E{(const bf16*)(ws + WS_X2B), F.out, nullptr, DM};
        pg8::gemm_phase<pg8::EpiResid<false, true>, pg8::StdOrder, true>(F.lds, g, S, E);
    }
#ifdef PROBE_PHASE
    xcd_barrier(xbar); STAMP(12);
    if (blockIdx.x == 0 && threadIdx.x < 64) {
        const float ta = 8.0f * rintf((float)(pt1 - pt0) * 0.01f * 0.125f), tb = 0.8f * rintf((float)(pu1 - pu0) * 0.01f * 0.125f);
        if (threadIdx.x == 0) F.out[0] += ta;
        if (PROBE_B != 99) for (int i = threadIdx.x; i < 10000; i += 64) F.out[64 + i] += tb;
    }
#endif
#undef IN
#undef SEAM
}

extern "C" void kernel_launch(void* const* d_in, const int* in_sizes, int n_in, void* d_out, int out_size, void* d_ws, size_t ws_size, hipStream_t stream) {
    static int grid = 0;
    if (grid == 0) {
        if (n_in != 24 || in_sizes[0] != MTOK * DM || out_size != MTOK * DM || ws_size < WS_END) {
            fprintf(stderr, "kernel_launch: unexpected shapes (n_in %d, in0 %d, out %d, ws %zu; need ws >= %zu); nothing launched\n", n_in, n_in > 0 ? in_sizes[0] : -1, out_size, ws_size, (size_t)WS_END); grid = -1; return; }
        int dev = 0, cus = 0, per_cu = 0;
        if (hipGetDevice(&dev) != hipSuccess || hipDeviceGetAttribute(&cus, hipDeviceAttributeMultiprocessorCount, dev) != hipSuccess) { grid = -1; return; }
        if (hipFuncSetAttribute((const void*)fwd_kernel, hipFuncAttributeMaxDynamicSharedMemorySize, LDS_BYTES) != hipSuccess) { fprintf(stderr, "kernel_launch: hipFuncSetAttribute failed\n"); grid = -1; return; }
        if (hipOccupancyMaxActiveBlocksPerMultiprocessor(&per_cu, (const void*)fwd_kernel, NTHREADS, LDS_BYTES) != hipSuccess || per_cu < 1) { fprintf(stderr, "kernel_launch: occupancy query says %d blocks per CU\n", per_cu); per_cu = 1; }
        (void)hipGetLastError();
        grid = cus;
    }
    if (grid < 0) return;
    (void)hipMemsetAsync((char*)d_ws + WS_CTL, 0, CTL_BYTES, stream);
    Args a{};
    for (int i = 0; i < 24; ++i) a.in[i] = (const float*)d_in[i];
    a.out = (float*)d_out; a.ws = (unsigned char*)d_ws;
#if MK_PER_PHASE
    for (int ph = 0; ph < N_PHASES; ++ph) { a.ph_lo = ph; a.ph_hi = ph + 1;
        hipLaunchKernelGGL(fwd_kernel, dim3(grid), dim3(NTHREADS), LDS_BYTES, stream, a); }
#else
    a.ph_lo = 0; a.ph_hi = N_PHASES;
    void* kargs[] = {&a};
    hipError_t e = hipLaunchCooperativeKernel((const void*)fwd_kernel, dim3(grid), dim3(NTHREADS), kargs, LDS_BYTES, stream);
    if (e != hipSuccess) fprintf(stderr, "kernel_launch: cooperative launch failed: %s (grid %d)\n", hipGetErrorString(e), grid);
#endif
}
```

```cpp
#include <hip/hip_runtime.h>
#include <hip/hip_cooperative_groups.h>
#include <cstdio>
#include <cstdint>
namespace cg = cooperative_groups;

constexpr int BATCH = 4, SEQ = 4096, DM = 2048, MTOK = BATCH * SEQ;
constexpr int NMEM = 256, MROWS = BATCH * NMEM;
constexpr int FOXH = 8, FOXD = 128, MLH = 4, MLDV = 256, MLDK = 128, XH = 4, XD = 512, DFF = 8192;
constexpr int IN_WIDTH = 6160, NPROJ = 6144, NCHUNK = SEQ / 64;
constexpr float EPS = 1e-6f;
constexpr float LOG2E = 1.4426950408889634f;

constexpr size_t MiB = (size_t)1 << 20;
constexpr size_t WS_WIN = 0, WS_WOUT = 24 * MiB, WS_WXQ = 32 * MiB, WS_WXKV = 40 * MiB, WS_WXO = 56 * MiB, WS_WUP = 64 * MiB, WS_WDN = 96 * MiB;
constexpr size_t WS_PROJ = 128 * MiB;
constexpr size_t WS_FQ = 128 * MiB, WS_FK = 160 * MiB, WS_FV = 192 * MiB, WS_MQK = 224 * MiB, WS_MV = 256 * MiB, WS_MO = 288 * MiB;
constexpr size_t WS_XN = 320 * MiB;
constexpr size_t WS_QP = 384 * MiB, WS_KPP = 400 * MiB;
constexpr size_t WS_KT = 416 * MiB;
constexpr size_t WS_VT = 432 * MiB;
constexpr size_t WS_MISC = 464 * MiB;
constexpr size_t WS_CTL = WS_MISC, CTL_BYTES = 2 * MiB;
constexpr size_t CTL_QCTR = 32 * 1024;
constexpr size_t CTL_SSQ1 = 64 * 1024, CTL_SSQ2 = 128 * 1024, CTL_SSQQ = 192 * 1024, CTL_SSQX = 448 * 1024;
constexpr size_t WS_GATES = WS_MISC + 1 * MiB;
constexpr size_t WS_CFOX = WS_MISC + 3 * MiB;
constexpr size_t WS_EB = WS_MISC + 4 * MiB;
constexpr size_t WS_KSUM = WS_MISC + 5 * MiB;
constexpr size_t WS_NST = WS_MISC + 6 * MiB;
constexpr size_t WS_JLO = WS_MISC + 7 * MiB;
constexpr size_t WS_MN = WS_MISC + 8 * MiB;
constexpr size_t WS_KHAT = WS_MISC + 12 * MiB;
constexpr size_t WS_VTM = WS_MISC + 16 * MiB;
constexpr size_t WS_END = 512 * MiB;
constexpr size_t WS_CONCAT = 224 * MiB;
constexpr size_t WS_X1B = 128 * MiB;
constexpr size_t WS_Q = 192 * MiB;
constexpr size_t WS_CO = 256 * MiB;
constexpr size_t WS_P = 320 * MiB;
constexpr size_t WS_X1Q = 288 * MiB;
constexpr size_t WS_X2B = 128 * MiB;
constexpr size_t WS_H = 192 * MiB;
constexpr size_t OUT_SLAB = 0, OUT_CST = 64 * MiB;

#ifndef JLO_DISABLE
#define JLO_DISABLE 0
#endif
constexpr float W8_SCALE = 64.0f, CO8_SCALE = 8.0f;
constexpr int LDS_BYTES = 147456;
constexpr int NTHREADS = 512;

#define GAS __attribute__((address_space(1)))
#define LAS __attribute__((address_space(3)))
typedef unsigned short bf16;
typedef unsigned v4u __attribute__((ext_vector_type(4)));
typedef unsigned v2u __attribute__((ext_vector_type(2)));
typedef float v4f __attribute__((ext_vector_type(4)));
typedef short v8s __attribute__((ext_vector_type(8)));
typedef short v4s __attribute__((ext_vector_type(4)));
#define LDS_WAIT() asm volatile("s_waitcnt lgkmcnt(0)" ::: "memory")
#define VM_WAIT() asm volatile("s_waitcnt vmcnt(0)" ::: "memory")
__device__ __forceinline__ unsigned f2bf(float f) { unsigned u = __builtin_bit_cast(unsigned, f); return (u + 0x7fffu + ((u >> 16) & 1u)) >> 16; }
__device__ __forceinline__ unsigned pk2(float lo, float hi) { return f2bf(lo) | (f2bf(hi) << 16); }
__device__ __forceinline__ float bf2f(unsigned h) { return __builtin_bit_cast(float, h << 16); }
__device__ __forceinline__ float bflo(unsigned w) { return __builtin_bit_cast(float, w << 16); }
__device__ __forceinline__ float bfhi(unsigned w) { return __builtin_bit_cast(float, w & 0xffff0000u); }
__device__ __forceinline__ float wave_sum(float v) {
#pragma unroll
    for (int o = 1; o < 64; o <<= 1) v += __shfl_xor(v, o);
    return v;
}
__device__ __forceinline__ int lane_id() { return (int)__builtin_amdgcn_mbcnt_hi(~0u, __builtin_amdgcn_mbcnt_lo(~0u, 0u)); }
__device__ __forceinline__ int wg_tid(int wv) { int t = wv * 64 + lane_id(); asm volatile("" : "+v"(t)); return t; }
__device__ __forceinline__ float logsigmoidf(float x) { return x >= 0.f ? -log1pf(__expf(-x)) : x - log1pf(__expf(x)); }
__device__ __forceinline__ float sigmoidf_(float x) { return 1.f / (1.f + __expf(-x)); }
__device__ __forceinline__ float rinv_of(const float* ssqx, size_t row) { return 1.0f / sqrtf(ssqx[row] * (1.0f / DM) + EPS); }
#define MK_PER_PHASE 0
namespace pg8 {
#define PG8_LAS __attribute__((address_space(3)))
typedef unsigned short bf16_t;
typedef short bf16x8 __attribute__((ext_vector_type(8)));
typedef float f32x4 __attribute__((ext_vector_type(4)));
typedef float f32x2 __attribute__((ext_vector_type(2)));
typedef unsigned u32x4 __attribute__((ext_vector_type(4)));
typedef unsigned u32x2 __attribute__((ext_vector_type(2)));
constexpr int BM = 256, BK = 64, HALF = 128, HTB = HALF * BK * 2, STAGE_BYTES = 8 * HTB, NXCD = 8, WGM = 8;

__host__ __device__ __forceinline__ int lds_byte(int r, int c) { const int st = (r >> 4) * 2 + (c >> 5), rr = r & 15, cc = c & 31, ob = rr * 64 + cc * 2; return st * 1024 + (ob ^ (((ob >> 9) & 1) << 5)); }
__host__ __device__ __forceinline__ void stage_rc(int b, int& R, int& C) { const int st = b / 1024, sb = b % 1024, swz = sb ^ (((sb >> 9) & 1) << 5); R = (st >> 1) * 16 + swz / 64; C = (st & 1) * 32 + (swz % 64) / 2; }
__host__ __device__ __forceinline__ int perm32(int rho) { const int n = rho >> 4, i = rho & 15; return 8 * (i >> 2) + 4 * n + (i & 3); }

struct Unit { int row0, col0; long aoff, boff; int aux; };
struct Gemm { const void* base; unsigned aoff, boff; int lda, ldb, K; };

struct StdOrder {
    int nM, nN, nwg, G, c, lda, ldb, rsh;
    __device__ void init(int M, int N, int lda_, int ldb_, int G_, int c_, int rsh_ = 0) { nM = M / BM; nN = N / BM; nwg = nM * nN; G = G_; c = c_; lda = lda_; ldb = ldb_; rsh = rsh_; }
    __device__ bool next(int i, Unit& u) const {
        const long L = (long)(i >> rsh) * G + c; if (L >= nwg) return false;
        int wgid = (int)L; { const int q = nwg / NXCD, r = nwg % NXCD, xcd = wgid % NXCD, off = wgid / NXCD; wgid = (xcd < r ? xcd * (q + 1) : r * (q + 1) + (xcd - r) * q) + off; }
        const int nig = WGM * nN, gid = wgid / nig, fm = gid * WGM, gsz = (nM - fm) < WGM ? (nM - fm) : WGM;
        const int pm = fm + ((wgid % nig) % gsz), pn = (wgid % nig) / gsz;
        u.row0 = pm * BM; u.col0 = pn * BM; u.aoff = (long)pm * BM * lda; u.boff = (long)pn * BM * ldb; u.aux = i & ((1 << rsh) - 1); return true;
    }
};

__device__ __forceinline__ unsigned cvt_pk_bf16(float lo, float hi) { unsigned r; asm volatile("v_cvt_pk_bf16_f32 %0, %1, %2" : "=v"(r) : "v"(lo), "v"(hi)); return r; }

typedef int v8i_t __attribute__((ext_vector_type(8)));
typedef int v4i_t __attribute__((ext_vector_type(4)));
template <class Epi, class Sched, bool ALIGN_EPI, bool FP8 = false>
__device__ __forceinline__ void gemm_phase(PG8_LAS unsigned char* lds, const Gemm g, const Sched& S, const Epi& E, int wv) {
    const int tid = wg_tid(wv), wid = wv, lane = tid & 63, wr = wid >> 2, wc = wid & 3, fr = lane & 15, fq = lane >> 4;
    const int K = g.K, nt = K / BK;
    unsigned voffA, voffB;
    { int R, C; stage_rc(tid * 16, R, C); const int Rb = Epi::PERM ? ((R & ~31) + perm32(R & 31)) : R;
      voffA = (unsigned)(R * g.lda + C) * 2u; voffB = (unsigned)(Rb * g.ldb + C) * 2u; }
    const unsigned pA = 64u * (unsigned)g.lda * 2u, pB = 64u * (unsigned)g.ldb * 2u;
    const unsigned voffA_v = voffA, voffB_v = voffB, voffA_p = pA, voffB_p = pB;
    const unsigned kstep = (unsigned)(BK * 2);
    const unsigned hA = (unsigned)HALF * g.lda * 2, hB = (unsigned)HALF * g.ldb * 2;
    const __amdgpu_buffer_rsrc_t rsrc = __builtin_amdgcn_make_buffer_rsrc((void*)g.base, (short)0, 0x7fffffff, 0x00020000);
    const unsigned ldsw = (unsigned)wid * 1024u;
    const int aoff = lds_byte(wr * 64 + fr, fq * 8), boff = lds_byte(wc * 32 + fr, fq * 8);
#define PG8_SA(b, h) (((b) * 2 + (h)) * HTB)
#define PG8_SB(b, h) ((4 + (b) * 2 + (h)) * HTB)
#define PG8_STAGE(bufoff, gbase, voff) do { _Pragma("unroll") for (int _i = 0; _i < 2; ++_i) \
        __builtin_amdgcn_raw_ptr_buffer_load_lds(rsrc, (PG8_LAS void*)(lds + (bufoff) + ldsw + _i * 8192), 16, voff##_v, (gbase) + _i * voff##_p, 0, 0); } while (0)
#define PG8_LDA(dst, b, h) do { _Pragma("unroll") for (int m = 0; m < 4; ++m) dst[m] = PG8_CAT(*(const PG8_LAS v4i_t*)(lds + PG8_SA(b, h) + aoff + m * 2048), *(const PG8_LAS v4i_t*)(lds + PG8_SA(b, h) + aoff + m * 2048 + 1024)); } while (0)
#define PG8_LDB(dst, b, h) do { _Pragma("unroll") for (int n = 0; n < 2; ++n) dst[n] = PG8_CAT(*(const PG8_LAS v4i_t*)(lds + PG8_SB(b, h) + boff + n * 2048), *(const PG8_LAS v4i_t*)(lds + PG8_SB(b, h) + boff + n * 2048 + 1024)); } while (0)
#define PG8_CAT(x0, x1) __builtin_shufflevector((x0), (x1), 0, 1, 2, 3, 4, 5, 6, 7)
#define PG8_K0(x) __builtin_bit_cast(bf16x8, __builtin_shufflevector((x), (x), 0, 1, 2, 3))
#define PG8_K1(x) __builtin_bit_cast(bf16x8, __builtin_shufflevector((x), (x), 4, 5, 6, 7))
#define PG8_MMA(ai, bj, At, Bt) do { __builtin_amdgcn_s_setprio(1); _Pragma("unroll") for (int m = 0; m < 4; ++m) _Pragma("unroll") for (int n = 0; n < 2; ++n) { \
        if constexpr (FP8) asm volatile("v_mfma_f32_16x16x128_f8f6f4 %0, %1, %2, %0" : "+v"(acc[ai][bj][m][n]) : "v"(Bt[n]), "v"(At[m]));     \
        else { acc[ai][bj][m][n] = __builtin_amdgcn_mfma_f32_16x16x32_bf16(PG8_K0(Bt[n]), PG8_K0(At[m]), acc[ai][bj][m][n], 0, 0, 0); \
               acc[ai][bj][m][n] = __builtin_amdgcn_mfma_f32_16x16x32_bf16(PG8_K1(Bt[n]), PG8_K1(At[m]), acc[ai][bj][m][n], 0, 0, 0); } } \
        __builtin_amdgcn_s_setprio(0); } while (0)
#define PG8_WAIT_V(n) asm volatile("s_waitcnt vmcnt(" #n ")" ::: "memory")
#define PG8_WAIT_L(n) asm volatile("s_waitcnt lgkmcnt(" #n ")" ::: "memory")
#define PG8_BAR __builtin_amdgcn_s_barrier()
#define PG8_SCHED __builtin_amdgcn_sched_barrier(0)
    Unit cur, nxt; int ui = 0;
    if (!S.next(0, cur)) return;
    f32x4 acc[2][2][4][2];
#pragma unroll
    for (int a = 0; a < 2; ++a)
#pragma unroll
        for (int b = 0; b < 2; ++b)
#pragma unroll
            for (int m = 0; m < 4; ++m)
#pragma unroll
                for (int n = 0; n < 2; ++n) acc[a][b][m][n] = (f32x4){0.f, 0.f, 0.f, 0.f};
    v8i_t At[4], B0[2], B1[2];
    unsigned cA = g.aoff + (unsigned)cur.aoff * 2u, cB = g.boff + (unsigned)cur.boff * 2u;
    PG8_STAGE(PG8_SB(0, 0), cB, voffB); PG8_STAGE(PG8_SB(0, 1), cB + hB, voffB); PG8_STAGE(PG8_SA(0, 0), cA, voffA); PG8_STAGE(PG8_SA(0, 1), cA + hA, voffA);
    if (wr == 1) PG8_BAR;
    PG8_WAIT_V(2); PG8_BAR;
    PG8_STAGE(PG8_SB(1, 0), cB + kstep, voffB); PG8_STAGE(PG8_SA(1, 0), cA + kstep, voffA); PG8_STAGE(PG8_SB(1, 1), cB + hB + kstep, voffB);
    PG8_WAIT_V(6); PG8_BAR;
    for (;;) {
        const bool has_next = S.next(ui + 1, nxt);
        const unsigned nA = has_next ? g.aoff + (unsigned)nxt.aoff * 2u : cA, nB = has_next ? g.boff + (unsigned)nxt.boff * 2u : cB;
        for (int t = 0; t < nt; t += 2) {
            const bool last = (t == nt - 2);
            const unsigned a1 = cA + (unsigned)(t + 1) * kstep;
            const unsigned a2 = last ? nA : cA + (unsigned)(t + 2) * kstep, b2 = last ? nB : cB + (unsigned)(t + 2) * kstep;
            const unsigned a3 = a2 + kstep, b3 = b2 + kstep;
            PG8_LDB(B0, 0, 0); PG8_LDB(B1, 0, 1); PG8_SCHED; PG8_LDA(At, 0, 0); PG8_STAGE(PG8_SA(1, 1), a1 + hA, voffA);
            PG8_WAIT_V(8); PG8_WAIT_L(0); PG8_BAR; PG8_MMA(0, 0, At, B0); PG8_MMA(0, 1, At, B1); PG8_BAR; PG8_SCHED;
            PG8_LDA(At, 0, 1); PG8_STAGE(PG8_SB(0, 0), b2, voffB); PG8_STAGE(PG8_SB(0, 1), b2 + hB, voffB); PG8_STAGE(PG8_SA(0, 0), a2, voffA);
            PG8_WAIT_V(8); PG8_WAIT_L(0); PG8_BAR; PG8_MMA(1, 0, At, B0); PG8_MMA(1, 1, At, B1); PG8_BAR; PG8_SCHED;
            PG8_LDB(B0, 1, 0); PG8_LDB(B1, 1, 1); PG8_SCHED; PG8_LDA(At, 1, 0); PG8_STAGE(PG8_SA(0, 1), a2 + hA, voffA);
            PG8_WAIT_V(8); PG8_WAIT_L(0); PG8_BAR; PG8_MMA(0, 0, At, B0); PG8_MMA(0, 1, At, B1); PG8_BAR; PG8_SCHED;
            PG8_LDA(At, 1, 1); PG8_STAGE(PG8_SB(1, 0), b3, voffB); PG8_STAGE(PG8_SB(1, 1), b3 + hB, voffB); PG8_STAGE(PG8_SA(1, 0), a3, voffA);
            PG8_WAIT_V(8); PG8_WAIT_L(0); PG8_BAR; PG8_MMA(1, 0, At, B0); PG8_MMA(1, 1, At, B1); PG8_BAR; PG8_SCHED;
        }
        if constexpr (ALIGN_EPI) { if (wr == 0) PG8_BAR; }
        if constexpr (FP8) asm volatile("s_nop 15\n\ts_nop 7" ::: "memory");
        if constexpr (!Epi::AFTER_DRAIN) { E(acc, cur, wr, wc, fr, fq); }
        if (!has_next) break;
#pragma unroll
        for (int a = 0; a < 2; ++a)
#pragma unroll
            for (int b = 0; b < 2; ++b)
#pragma unroll
                for (int m = 0; m < 4; ++m)
#pragma unroll
                    for (int n = 0; n < 2; ++n) acc[a][b][m][n] = (f32x4){0.f, 0.f, 0.f, 0.f};
        cur = nxt; cA = nA; cB = nB; ++ui;
        if constexpr (ALIGN_EPI) { if (wr == 1) PG8_BAR; }
    }
    PG8_WAIT_V(0);
    if constexpr (!ALIGN_EPI) { if (wr == 0) PG8_BAR; }
    PG8_BAR;
    if constexpr (Epi::AFTER_DRAIN) { E.fused(acc, cur, wr, wc, fr, fq, lds, wid, lane); }
#undef PG8_SA
#undef PG8_SB
#undef PG8_STAGE
#undef PG8_LDA
#undef PG8_LDB
#undef PG8_MMA
#undef PG8_CAT
#undef PG8_K0
#undef PG8_K1
#undef PG8_WAIT_V
#undef PG8_WAIT_L
#undef PG8_BAR
#undef PG8_SCHED
}
}
namespace pg8 {
struct XkvOrder {
    int G, c;
    __device__ bool next(int i, Unit& u) const {
        const int L = i * G + c; if (L >= 256) return false;
        const int kq = L & 3, tile = L >> 2, pm = tile & 3, pn = tile >> 2;
        u.row0 = pm * 256; u.col0 = pn * 256; u.aoff = (long)pm * 256 * DM + kq * 512; u.boff = (long)pn * 256 * DM + kq * 512; u.aux = kq; return true;
    }
};
struct ScoreOrder {
    int G, c;
    __device__ bool next(int i, Unit& u) const {
        const int L = i * G + c; if (L >= 256) return false;
        const int b = L >> 6, h = (L >> 4) & 3, mt = L & 15;
        u.row0 = b * SEQ + mt * 256; u.col0 = h * 256; u.aoff = (long)u.row0 * DM + h * XD; u.boff = (long)(b * NMEM) * DM + h * XD; u.aux = h; return true;
    }
};
struct PvOrder {
    int G, c, rsh;
    __device__ bool next(int i, Unit& u) const {
        const int L = (i >> rsh) * G + c; if (L >= 512) return false;
        const int nt = L & 1, mt = (L >> 1) & 15, h = (L >> 5) & 3, b = L >> 7;
        u.row0 = b * SEQ + mt * 256; u.col0 = h * XD + nt * 256; u.aoff = (long)u.row0 * 1024 + h * 256; u.boff = ((long)(b * XH + h) * XD + nt * 256) * NMEM; u.aux = 0; return true;
    }
};

__device__ __forceinline__ unsigned pk4_fp8(float a, float b, float c, float d) { int w = __builtin_amdgcn_cvt_pk_fp8_f32(a, b, 0, false); w = __builtin_amdgcn_cvt_pk_fp8_f32(c, d, w, true); return (unsigned)w; }
struct EpiStoreBf16 {
    static constexpr bool PERM = true, AFTER_DRAIN = false;
    bf16_t* O; int ldc; int split_cols; size_t split_stride;
    __device__ __forceinline__ void operator()(const f32x4 (&acc)[2][2][4][2], const Unit& u, int wr, int wc, int fr, int fq) const {
        int colt = u.col0; bf16_t* base = O;
        if (split_cols) { const int t = colt / split_cols; base += (size_t)t * split_stride; colt -= t * split_cols; }
        const int row0 = u.row0 + wr * 64 + fr, col0 = colt + wc * 32 + 8 * fq;
#pragma unroll
        for (int ai = 0; ai < 2; ++ai)
#pragma unroll
            for (int m = 0; m < 4; ++m) { bf16_t* rowp = base + (size_t)(row0 + ai * HALF + m * 16) * ldc + col0;
#pragma unroll
                for (int bj = 0; bj < 2; ++bj) { const f32x4 v0 = acc[ai][bj][m][0], v1 = acc[ai][bj][m][1];
                    u32x4 w; w.x = cvt_pk_bf16(v0[0], v0[1]); w.y = cvt_pk_bf16(v0[2], v0[3]); w.z = cvt_pk_bf16(v1[0], v1[1]); w.w = cvt_pk_bf16(v1[2], v1[3]);
                    *(u32x4*)(rowp + bj * HALF) = w; } }
    }
};
struct EpiProj {
    static constexpr bool PERM = true, AFTER_DRAIN = false;
    bf16_t* O; const float* gq; const float* gk; const float* ssqx; PG8_LAS float* red;
    __device__ __forceinline__ void operator()(f32x4 (&acc)[2][2][4][2], const Unit& u, int wr, int wc, int fr, int fq) const {
        const int t = u.col0 >> 10, colt = u.col0 & 1023; bf16_t* base = O + (size_t)t * ((size_t)MTOK * 1024);
        const int row0 = u.row0 + wr * 64 + fr, col0 = colt + wc * 32 + 8 * fq;
#pragma unroll
        for (int ai = 0; ai < 2; ++ai)
#pragma unroll
            for (int m = 0; m < 4; ++m) { const float rx = __builtin_amdgcn_rsqf(ssqx[row0 + ai * HALF + m * 16] * (1.0f / DM) + EPS);
#pragma unroll
                for (int bj = 0; bj < 2; ++bj) { acc[ai][bj][m][0] = acc[ai][bj][m][0] * rx; acc[ai][bj][m][1] = acc[ai][bj][m][1] * rx; } }
        if (u.col0 < 2048) {
            const float* g = (t == 0 ? gq : gk) + wc * 32 + 8 * fq; const f32x4 g0 = *(const f32x4*)g, g1 = *(const f32x4*)(g + 4);
#pragma unroll
            for (int ai = 0; ai < 2; ++ai)
#pragma unroll
                for (int m = 0; m < 4; ++m) { const int rl = ai * HALF + wr * 64 + m * 16 + fr;
#pragma unroll
                    for (int bj = 0; bj < 2; ++bj) { const f32x4 v0 = acc[ai][bj][m][0], v1 = acc[ai][bj][m][1];
                        float s = (v0[0] * v0[0] + v0[1] * v0[1]) + (v0[2] * v0[2] + v0[3] * v0[3]) + (v1[0] * v1[0] + v1[1] * v1[1]) + (v1[2] * v1[2] + v1[3] * v1[3]);
                        s += __shfl_xor(s, 16); s += __shfl_xor(s, 32);
                        if (fq == 0) red[(rl * 2 + bj) * 4 + wc] = s; } }
            asm volatile("s_waitcnt lgkmcnt(0)" ::: "memory"); __builtin_amdgcn_s_barrier(); asm volatile("" ::: "memory");
#pragma unroll
            for (int ai = 0; ai < 2; ++ai)
#pragma unroll
                for (int m = 0; m < 4; ++m) { const int rl = ai * HALF + wr * 64 + m * 16 + fr;
#pragma unroll
                    for (int bj = 0; bj < 2; ++bj) { const f32x4 r4 = *(const PG8_LAS f32x4*)(red + (rl * 2 + bj) * 4);
                        const float ri = __builtin_amdgcn_rsqf(((r4[0] + r4[1]) + (r4[2] + r4[3])) * (1.0f / FOXD) + EPS);
                        acc[ai][bj][m][0] = acc[ai][bj][m][0] * ri * g0; acc[ai][bj][m][1] = acc[ai][bj][m][1] * ri * g1; } }
        }
#pragma unroll
        for (int ai = 0; ai < 2; ++ai)
#pragma unroll
            for (int m = 0; m < 4; ++m) { bf16_t* rowp = base + (size_t)(row0 + ai * HALF + m * 16) * 1024 + col0;
#pragma unroll
                for (int bj = 0; bj < 2; ++bj) { const f32x4 v0 = acc[ai][bj][m][0], v1 = acc[ai][bj][m][1];
                    u32x4 w; w.x = cvt_pk_bf16(v0[0], v0[1]); w.y = cvt_pk_bf16(v0[2], v0[3]); w.z = cvt_pk_bf16(v1[0], v1[1]); w.w = cvt_pk_bf16(v1[2], v1[3]);
                    *(u32x4*)(rowp + bj * HALF) = w; } }
    }
};
struct EpiStoreFp8 {
    static constexpr bool PERM = true, AFTER_DRAIN = false;
    unsigned char* O8; int ldc; float scale;
    __device__ __forceinline__ void operator()(const f32x4 (&acc)[2][2][4][2], const Unit& u, int wr, int wc, int fr, int fq) const {
        const int row0 = u.row0 + wr * 64 + fr, col0 = u.col0 + wc * 32 + 8 * fq;
#pragma unroll
        for (int ai = 0; ai < 2; ++ai)
#pragma unroll
            for (int m = 0; m < 4; ++m) { unsigned char* rowp = O8 + (size_t)(row0 + ai * HALF + m * 16) * ldc + col0;
#pragma unroll
                for (int bj = 0; bj < 2; ++bj) { const f32x4 v0 = acc[ai][bj][m][0] * scale, v1 = acc[ai][bj][m][1] * scale;
                    u32x2 w; w.x = pk4_fp8(v0[0], v0[1], v0[2], v0[3]); w.y = pk4_fp8(v1[0], v1[1], v1[2], v1[3]);
                    *(u32x2*)(rowp + bj * HALF) = w; } }
    }
};
struct EpiSlab {
    static constexpr bool PERM = false, AFTER_DRAIN = false;
    float* slab; int ldc; size_t slab_stride;
    __device__ __forceinline__ void operator()(const f32x4 (&acc)[2][2][4][2], const Unit& u, int wr, int wc, int fr, int fq) const {
        float* base = slab + (size_t)u.aux * slab_stride; const int col0 = u.col0 + wc * 32 + 4 * fq;
#pragma unroll
        for (int ai = 0; ai < 2; ++ai)
#pragma unroll
            for (int m = 0; m < 4; ++m) { float* rowp = base + (size_t)(u.row0 + ai * HALF + wr * 64 + m * 16 + fr) * ldc + col0;
#pragma unroll
                for (int bj = 0; bj < 2; ++bj)
#pragma unroll
                    for (int n = 0; n < 2; ++n) *(f32x4*)(rowp + bj * HALF + n * 16) = acc[ai][bj][m][n]; }
    }
};
template <bool BASEF, bool OUTF>
struct EpiResid {
    static constexpr bool PERM = true, AFTER_DRAIN = false;
    const void* base; void* out; float* ssq; int ldc; float ascale; unsigned char* out8;
    __device__ __forceinline__ void operator()(const f32x4 (&acc)[2][2][4][2], const Unit& u, int wr, int wc, int fr, int fq) const {
        const int col0 = u.col0 + wc * 32 + 8 * fq;
        float ssum[2][4];
#pragma unroll
        for (int ai = 0; ai < 2; ++ai) {
            f32x4 bv[4][2][2];
#pragma unroll
            for (int m = 0; m < 4; ++m) { const size_t off = (size_t)(u.row0 + ai * HALF + wr * 64 + m * 16 + fr) * ldc + col0;
#pragma unroll
                for (int bj = 0; bj < 2; ++bj) {
                    if constexpr (BASEF) { bv[m][bj][0] = *(const f32x4*)((const float*)base + off + bj * HALF); bv[m][bj][1] = *(const f32x4*)((const float*)base + off + bj * HALF + 4); }
                    else { const u32x4 w = *(const u32x4*)((const bf16_t*)base + off + bj * HALF);
                        bv[m][bj][0] = (f32x4){__builtin_bit_cast(float, w.x << 16), __builtin_bit_cast(float, w.x & 0xffff0000u), __builtin_bit_cast(float, w.y << 16), __builtin_bit_cast(float, w.y & 0xffff0000u)};
                        bv[m][bj][1] = (f32x4){__builtin_bit_cast(float, w.z << 16), __builtin_bit_cast(float, w.z & 0xffff0000u), __builtin_bit_cast(float, w.w << 16), __builtin_bit_cast(float, w.w & 0xffff0000u)}; } } }
#pragma unroll
            for (int m = 0; m < 4; ++m) { const size_t off = (size_t)(u.row0 + ai * HALF + wr * 64 + m * 16 + fr) * ldc + col0; float s = 0.f;
#pragma unroll
                for (int bj = 0; bj < 2; ++bj) { const f32x4 v0 = bv[m][bj][0] + acc[ai][bj][m][0] * ascale, v1 = bv[m][bj][1] + acc[ai][bj][m][1] * ascale;
                    if (out8) { u32x2 w8; w8.x = pk4_fp8(v0[0], v0[1], v0[2], v0[3]); w8.y = pk4_fp8(v1[0], v1[1], v1[2], v1[3]); *(u32x2*)(out8 + off + bj * HALF) = w8; }
                    if constexpr (OUTF) { *(f32x4*)((float*)out + off + bj * HALF) = v0; *(f32x4*)((float*)out + off + bj * HALF + 4) = v1; }
                    else { u32x4 w; w.x = cvt_pk_bf16(v0[0], v0[1]); w.y = cvt_pk_bf16(v0[2], v0[3]); w.z = cvt_pk_bf16(v1[0], v1[1]); w.w = cvt_pk_bf16(v1[2], v1[3]);
                        *(u32x4*)((bf16_t*)out + off + bj * HALF) = w; }
                    s += (v0[0] * v0[0] + v0[1] * v0[1]) + (v0[2] * v0[2] + v0[3] * v0[3]) + (v1[0] * v1[0] + v1[1] * v1[1]) + (v1[2] * v1[2] + v1[3] * v1[3]); }
                s += __shfl_xor(s, 16); s += __shfl_xor(s, 32); ssum[ai][m] = s; } }
        if (ssq && u.aux == 0) {
#pragma unroll
            for (int ai = 0; ai < 2; ++ai) { const float v = fq == 0 ? ssum[ai][0] : fq == 1 ? ssum[ai][1] : fq == 2 ? ssum[ai][2] : ssum[ai][3];
                atomicAdd(ssq + u.row0 + ai * HALF + wr * 64 + fq * 16 + fr, v); }
        }
    }
};
struct EpiQ {
    static constexpr bool PERM = true, AFTER_DRAIN = false;
    bf16_t* O; const float* ssq_in; float* ssq_out; float oscale;
    __device__ __forceinline__ void operator()(const f32x4 (&acc)[2][2][4][2], const Unit& u, int wr, int wc, int fr, int fq) const {
        const int col0 = u.col0 + wc * 32 + 8 * fq; float* so = ssq_out + (size_t)(u.col0 / XD) * MTOK;
        float ssum[2][4];
#pragma unroll
        for (int ai = 0; ai < 2; ++ai)
#pragma unroll
            for (int m = 0; m < 4; ++m) { const int row = u.row0 + ai * HALF + wr * 64 + m * 16 + fr; const float ri = __builtin_amdgcn_rsqf(ssq_in[row] * (1.0f / DM) + EPS) * oscale;
                bf16_t* rowp = O + (size_t)row * DM + col0; float s = 0.f;
#pragma unroll
                for (int bj = 0; bj < 2; ++bj) { const f32x4 v0 = acc[ai][bj][m][0] * ri, v1 = acc[ai][bj][m][1] * ri;
                    u32x4 w; w.x = cvt_pk_bf16(v0[0], v0[1]); w.y = cvt_pk_bf16(v0[2], v0[3]); w.z = cvt_pk_bf16(v1[0], v1[1]); w.w = cvt_pk_bf16(v1[2], v1[3]);
                    *(u32x4*)(rowp + bj * HALF) = w;
                    s += (v0[0] * v0[0] + v0[1] * v0[1]) + (v0[2] * v0[2] + v0[3] * v0[3]) + (v1[0] * v1[0] + v1[1] * v1[1]) + (v1[2] * v1[2] + v1[3] * v1[3]); }
                s += __shfl_xor(s, 16); s += __shfl_xor(s, 32); ssum[ai][m] = s; }
        if (u.aux == 0)
#pragma unroll
        for (int ai = 0; ai < 2; ++ai) { const float v = fq == 0 ? ssum[ai][0] : fq == 1 ? ssum[ai][1] : fq == 2 ? ssum[ai][2] : ssum[ai][3];
            atomicAdd(so + u.row0 + ai * HALF + wr * 64 + fq * 16 + fr, v); }
    }
};
struct EpiUp {
    static constexpr bool PERM = true, AFTER_DRAIN = false;
    bf16_t* O; const float* ssq_in;
    __device__ __forceinline__ void operator()(const f32x4 (&acc)[2][2][4][2], const Unit& u, int wr, int wc, int fr, int fq) const {
        const int col0 = u.col0 + wc * 32 + 8 * fq;
#pragma unroll
        for (int ai = 0; ai < 2; ++ai)
#pragma unroll
            for (int m = 0; m < 4; ++m) { const int row = u.row0 + ai * HALF + wr * 64 + m * 16 + fr; const float ri = __builtin_amdgcn_rsqf(ssq_in[row] * (1.0f / DM) + EPS);
                bf16_t* rowp = O + (size_t)row * DFF + col0;
#pragma unroll
                for (int bj = 0; bj < 2; ++bj) { f32x4 v0 = acc[ai][bj][m][0] * ri, v1 = acc[ai][bj][m][1] * ri;
#pragma unroll
                    for (int e = 0; e < 4; ++e) { const float a = fmaxf(v0[e], 0.f), b = fmaxf(v1[e], 0.f); v0[e] = a * a; v1[e] = b * b; }
                    u32x4 w; w.x = cvt_pk_bf16(v0[0], v0[1]); w.y = cvt_pk_bf16(v0[2], v0[3]); w.z = cvt_pk_bf16(v1[0], v1[1]); w.w = cvt_pk_bf16(v1[2], v1[3]);
                    *(u32x4*)(rowp + bj * HALF) = w; } }
    }
};
struct EpiSoftmax {
    static constexpr bool PERM = true, AFTER_DRAIN = true;
    bf16_t* P; const float* ssqq;
    __device__ __forceinline__ void fused(f32x4 (&acc)[2][2][4][2], const Unit& u, int wr, int wc, int fr, int fq, PG8_LAS unsigned char* lds, int wid, int lane) const {
        PG8_LAS float* RM = (PG8_LAS float*)lds;
        PG8_LAS float* RS = (PG8_LAS float*)(lds + 4096);
        const float* sq = ssqq + (size_t)u.aux * MTOK;
        float mx[2][4];
#pragma unroll
        for (int ai = 0; ai < 2; ++ai)
#pragma unroll
            for (int m = 0; m < 4; ++m) { const int rl = ai * HALF + wr * 64 + m * 16 + fr; const int row = u.row0 + rl;
                const float sc = __builtin_amdgcn_rsqf(sq[row] * (1.0f / XD) + EPS) * (0.044194173824159216f * LOG2E);
                float mxx = -3.0e38f;
#pragma unroll
                for (int bj = 0; bj < 2; ++bj)
#pragma unroll
                    for (int n = 0; n < 2; ++n) { f32x4 v = acc[ai][bj][m][n] * sc; acc[ai][bj][m][n] = v; mxx = fmaxf(mxx, fmaxf(fmaxf(v[0], v[1]), fmaxf(v[2], v[3]))); }
                mxx = fmaxf(mxx, __shfl_xor(mxx, 16)); mxx = fmaxf(mxx, __shfl_xor(mxx, 32));
                if (fq == 0) RM[rl * 4 + wc] = mxx; }
        asm volatile("s_waitcnt lgkmcnt(0)" ::: "memory"); __builtin_amdgcn_s_barrier(); asm volatile("" ::: "memory");
#pragma unroll
        for (int ai = 0; ai < 2; ++ai)
#pragma unroll
            for (int m = 0; m < 4; ++m) { const int rl = ai * HALF + wr * 64 + m * 16 + fr;
                const f32x4 r4 = *(const PG8_LAS f32x4*)(RM + rl * 4); const float mxx = fmaxf(fmaxf(r4[0], r4[1]), fmaxf(r4[2], r4[3])); mx[ai][m] = mxx; float s = 0.f;
#pragma unroll
                for (int bj = 0; bj < 2; ++bj)
#pragma unroll
                    for (int n = 0; n < 2; ++n) { f32x4 v = acc[ai][bj][m][n];
#pragma unroll
                        for (int e = 0; e < 4; ++e) { v[e] = __builtin_amdgcn_exp2f(v[e] - mxx); s += v[e]; }
                        acc[ai][bj][m][n] = v; }
                s += __shfl_xor(s, 16); s += __shfl_xor(s, 32);
                if (fq == 0) RS[rl * 4 + wc] = s; }
        asm volatile("s_waitcnt lgkmcnt(0)" ::: "memory"); __builtin_amdgcn_s_barrier(); asm volatile("" ::: "memory");
        const int col0 = u.col0 + wc * 32 + 8 * fq;
#pragma unroll
        for (int ai = 0; ai < 2; ++ai)
#pragma unroll
            for (int m = 0; m < 4; ++m) { const int rl = ai * HALF + wr * 64 + m * 16 + fr;
                const f32x4 r4 = *(const PG8_LAS f32x4*)(RS + rl * 4); const float inv = 1.0f / ((r4[0] + r4[1]) + (r4[2] + r4[3]));
                bf16_t* rowp = P + (size_t)(u.row0 + rl) * 1024 + col0;
#pragma unroll
                for (int bj = 0; bj < 2; ++bj) { const f32x4 v0 = acc[ai][bj][m][0] * inv, v1 = acc[ai][bj][m][1] * inv;
                    u32x4 w; w.x = cvt_pk_bf16(v0[0], v0[1]); w.y = cvt_pk_bf16(v0[2], v0[3]); w.z = cvt_pk_bf16(v1[0], v1[1]); w.w = cvt_pk_bf16(v1[2], v1[3]);
                    *(u32x4*)(rowp + bj * HALF) = w; } }
        (void)mx; (void)wid; (void)lane;
    }
};
}
namespace fox {
typedef short bf16x8 __attribute__((ext_vector_type(8)));
typedef short s16x4 __attribute__((ext_vector_type(4)));
typedef float f32x16 __attribute__((ext_vector_type(16)));
typedef float f32x4 __attribute__((ext_vector_type(4)));
typedef unsigned u32x4 __attribute__((ext_vector_type(4)));
constexpr int D = 128, PITCH = 1024, OPITCH = 2048;
constexpr int NW = 8, QBLK = 32, KVBLK = 64, QB = NW * QBLK;
constexpr int SHM_V = KVBLK * D * 2, SHM_K = KVBLK * D * 2;
constexpr int LDS_BIAS = 0, LDS_WS = 512, LDS_V = 4096, LDS_K = LDS_V + 2 * SHM_V, LDS_Q = LDS_K + 2 * SHM_K, LDS_BYTES = LDS_Q + NW * 8192;
constexpr float SCALE = 0.08838834764831845f, C2 = LOG2E * SCALE, THR = 8.f;

#define KSWZ(row, colB) ((row) * 256 + ((colB) ^ (((row) & 7) << 4)))
#define SBAR() __builtin_amdgcn_sched_barrier(0)
__device__ __forceinline__ int v_st(int k, int c) { const int kk = (k & ~0xC) | ((k & 4) << 1) | ((k & 8) >> 1); return ((kk >> 3) * 4 + (c >> 5)) * 512 + ((kk & 7) * 32 + (c & 31)) * 2; }
__device__ __forceinline__ int v_rd_base(int lane) { return ((lane & 3) << 3) | (((lane >> 2) & 3) << 6) | (((lane >> 4) & 1) << 5) | (((lane >> 5) & 1) << 8); }
constexpr int v_rd_off(int d0, int ks, int half) { return d0 * 512 + ks * 4096 + half * 2048; }
__device__ __forceinline__ int crow(int r, int hi) { return (r & 3) + 8 * (r >> 2) + 4 * hi; }
__device__ __forceinline__ unsigned cvtpk(float lo, float hi) { unsigned r; asm volatile("v_cvt_pk_bf16_f32 %0, %1, %2" : "=v"(r) : "v"(lo), "v"(hi)); return r; }
__device__ __forceinline__ bf16x8 load8(const bf16* p) { return *reinterpret_cast<const bf16x8*>(p); }

__device__ __forceinline__ void mask_tile(f32x16& p0, f32x16& p1, int dq) {
    const float NEG = -__builtin_inff();
#pragma unroll
    for (int r = 0; r < 16; ++r) { const int c = (r & 3) + 8 * (r >> 2);
        if (dq - c < 0) p0[r] = NEG;
        if (dq - c - 32 < 0) p1[r] = NEG; }
}
__device__ __forceinline__ void partialSM(f32x16& p0, f32x16& p1, float& m_reg, float& mn, float& alpha) {
    float pmax = p0[0];
#pragma unroll
    for (int r = 1; r < 16; ++r) pmax = fmaxf(pmax, p0[r]);
#pragma unroll
    for (int r = 0; r < 16; ++r) pmax = fmaxf(pmax, p1[r]);
    { auto rr = __builtin_amdgcn_permlane32_swap(__float_as_uint(pmax), __float_as_uint(pmax), false, false);
      pmax = fmaxf(__uint_as_float(rr[0]), __uint_as_float(rr[1])); }
    if (__builtin_expect(__all((pmax - m_reg) * SCALE <= THR), 1)) { mn = m_reg; alpha = 1.f; }
    else { mn = fmaxf(m_reg, pmax); alpha = __builtin_amdgcn_exp2f((m_reg - mn) * C2); m_reg = mn; }
    const float mnL = -mn * C2;
#pragma unroll
    for (int r = 0; r < 16; ++r) p0[r] = fmaf(p0[r], C2, mnL);
#pragma unroll
    for (int r = 0; r < 16; ++r) p1[r] = fmaf(p1[r], C2, mnL);
#pragma unroll
    for (int r = 0; r < 16; ++r) p0[r] = __builtin_amdgcn_exp2f(p0[r]);
}
__device__ __forceinline__ void finishSM(f32x16& p0, f32x16& p1, float alpha, float& l_reg, bf16x8& pa0, bf16x8& pa1, bf16x8& pa2, bf16x8& pa3) {
#pragma unroll
    for (int r = 0; r < 16; ++r) p1[r] = __builtin_amdgcn_exp2f(p1[r]);
    float ps = 0;
#pragma unroll
    for (int r = 0; r < 16; ++r) ps += p0[r];
#pragma unroll
    for (int r = 0; r < 16; ++r) ps += p1[r];
    { auto rr = __builtin_amdgcn_permlane32_swap(__float_as_uint(ps), __float_as_uint(ps), false, false);
      ps = __uint_as_float(rr[0]) + __uint_as_float(rr[1]); }
    l_reg = l_reg * alpha + ps;
#define PK4(P, B_, OUT) do { unsigned a0 = cvtpk(P[B_+0], P[B_+1]), a1 = cvtpk(P[B_+2], P[B_+3]);                          \
        unsigned b0 = cvtpk(P[B_+4], P[B_+5]), b1 = cvtpk(P[B_+6], P[B_+7]);                                             \
        auto r0 = __builtin_amdgcn_permlane32_swap(a0, b0, false, false); auto r1 = __builtin_amdgcn_permlane32_swap(a1, b1, false, false); \
        u32x4 w = {r0[0], r1[0], r0[1], r1[1]}; OUT = *reinterpret_cast<bf16x8*>(&w); } while (0)
    PK4(p0, 0, pa0); PK4(p0, 8, pa1); PK4(p1, 0, pa2); PK4(p1, 8, pa3);
#undef PK4
}
template <int KB>
__device__ __forceinline__ void qkt(f32x16& p0, f32x16& p1, const char* K_lds, const float* bl, int r32, int hi, const char* qw) {
#pragma unroll
    for (int g = 0; g < 4; ++g) { const f32x4 b0 = *(const f32x4*)(bl + KB * 64 + 8 * g + 4 * hi), b1 = *(const f32x4*)(bl + KB * 64 + 32 + 8 * g + 4 * hi);
#pragma unroll
        for (int i = 0; i < 4; ++i) { p0[4 * g + i] = b0[i]; p1[4 * g + i] = b1[i]; } }
    const char* kb[4];
#pragma unroll
    for (int dd = 0; dd < 4; ++dd) kb[dd] = K_lds + KB * SHM_K + KSWZ(r32, (dd * 16 + hi * 8) * 2);
#pragma unroll
    for (int d0 = 0; d0 < 8; ++d0) { const char* a = kb[d0 & 3] + (d0 >> 2) * 128;
        bf16x8 b0 = *reinterpret_cast<const bf16x8*>(a);
        bf16x8 b1 = *reinterpret_cast<const bf16x8*>(a + 32 * 256);
        const bf16x8 qf = *reinterpret_cast<const bf16x8*>(qw + d0 * 1024);
        p0 = __builtin_amdgcn_mfma_f32_32x32x16_bf16(b0, qf, p0, 0, 0, 0);
        p1 = __builtin_amdgcn_mfma_f32_32x32x16_bf16(b1, qf, p1, 0, 0, 0); }
}
template <int VB>
__device__ __forceinline__ void pv_tile(f32x16* o, int vb0, bf16x8 pa0, bf16x8 pa1, bf16x8 pa2, bf16x8 pa3) {
#define TRRD(dst, off) asm volatile("ds_read_b64_tr_b16 %0, %1 offset:%2" : "=&v"(dst) : "v"(vb0), "i"(off) : "memory")
#define PV_D0(d0) do { s16x4 l0, l1, l2, l3, h0, h1, h2, h3; constexpr int b_ = VB * SHM_V + v_rd_off(d0, 0, 0); \
        TRRD(l0, b_); TRRD(h0, b_ + 2048); TRRD(l1, b_ + 4096); TRRD(h1, b_ + 6144); TRRD(l2, b_ + 8192); TRRD(h2, b_ + 10240); TRRD(l3, b_ + 12288); TRRD(h3, b_ + 14336); \
        asm volatile("s_waitcnt lgkmcnt(0)" ::: "memory"); SBAR();   \
        o[d0] = __builtin_amdgcn_mfma_f32_32x32x16_bf16(pa0, (bf16x8){l0[0], l0[1], l0[2], l0[3], h0[0], h0[1], h0[2], h0[3]}, o[d0], 0, 0, 0);   \
        o[d0] = __builtin_amdgcn_mfma_f32_32x32x16_bf16(pa1, (bf16x8){l1[0], l1[1], l1[2], l1[3], h1[0], h1[1], h1[2], h1[3]}, o[d0], 0, 0, 0);   \
        o[d0] = __builtin_amdgcn_mfma_f32_32x32x16_bf16(pa2, (bf16x8){l2[0], l2[1], l2[2], l2[3], h2[0], h2[1], h2[2], h2[3]}, o[d0], 0, 0, 0);   \
        o[d0] = __builtin_amdgcn_mfma_f32_32x32x16_bf16(pa3, (bf16x8){l3[0], l3[1], l3[2], l3[3], h3[0], h3[1], h3[2], h3[3]}, o[d0], 0, 0, 0); } while (0)
    PV_D0(0); PV_D0(1); PV_D0(2); PV_D0(3);
#undef PV_D0
#undef TRRD
}

struct Item { unsigned rowb, o; const float* CS; const float* G; int P0, jlo; };
struct Seam { bf16x8 qr[8]; bf16x8 st_v0, st_v1, st_k0, st_k1; };
typedef __amdgpu_buffer_rsrc_t Srd;
#define BL8(rs, vo, so) __builtin_bit_cast(bf16x8, __builtin_amdgcn_raw_buffer_load_b128((rs), (vo), (so), 0))
#define VMW() asm volatile("s_waitcnt vmcnt(0)" ::: "memory")
#define VMWN(n) asm volatile("s_waitcnt vmcnt(%0)" :: "i"(n) : "memory")
#define SLOAD_H(H, k0, bb) do { const unsigned so_ = (unsigned)(k0) * (PITCH * 2);                                               \
                         S.st_v0 = BL8(R, kvoff, (unsigned)WS_FV + (H).rowb + so_); S.st_v1 = BL8(R, kvoff, (unsigned)WS_FV + (H).rowb + so_ + 32 * PITCH * 2);   \
                         S.st_k0 = BL8(R, kvoff, (unsigned)WS_FK + (H).rowb + so_); S.st_k1 = BL8(R, kvoff, (unsigned)WS_FK + (H).rowb + so_ + 32 * PITCH * 2);   \
                         if (wid == 0) __builtin_amdgcn_global_load_lds((const unsigned*)((H).CS + (k0)) + lane, (__attribute__((address_space(3))) unsigned*)(B3 + (bb) * 64), 4, 0, 0); } while (0)
#define QLOAD(H) do { const unsigned so_ = (unsigned)((H).P0 + wid * QBLK) * (PITCH * 2);                                   \
        _Pragma("unroll") for (int d0 = 0; d0 < 8; ++d0) S.qr[d0] = BL8(R, qoff + d0 * 32, (unsigned)WS_FQ + (H).rowb + so_); } while (0)
#define SWRITE_HK(bf) do { *(bf16x8*)(K_lds + (bf) * SHM_K + kws) = S.st_k0; *(bf16x8*)(K_lds + (bf) * SHM_K + kws + 32 * 256) = S.st_k1; } while (0)
#define SWRITE_HV(bf) do { *(bf16x8*)(V_lds + (bf) * SHM_V + vst0) = S.st_v0; *(bf16x8*)(V_lds + (bf) * SHM_V + vst1) = S.st_v1; } while (0)
#define SWRITE_H(bf) do { SWRITE_HV(bf); SWRITE_HK(bf); } while (0)

__device__ __forceinline__ void fox_prime(const Srd R, const Item& H, char* lds, Seam& S, int wv) {
    const int tid = wg_tid(wv), wid = wv, lane = tid & 63, r32 = lane & 31, hi = lane >> 5;
    const int sr = tid >> 4, sc = (tid & 15) * 8, kws = KSWZ(sr, sc * 2); char* K_lds = lds + LDS_K; float* B_lds = (float*)(lds + LDS_BIAS);
    const unsigned kvoff = (unsigned)(sr * PITCH + sc) * 2u, qoff = (unsigned)(r32 * PITCH + hi * 8) * 2u;
    __attribute__((address_space(3))) float* B3 = (__attribute__((address_space(3))) float*)B_lds;
    QLOAD(H);
    SLOAD_H(H, H.jlo * KVBLK, 0); VMW(); SWRITE_HK(0);
    { char* qw = lds + LDS_Q + wid * 8192 + lane * 16;
#pragma unroll
      for (int d0 = 0; d0 < 8; ++d0) *(bf16x8*)(qw + d0 * 1024) = S.qr[d0]; }
    __syncthreads();
}
template <class NextFn>
__device__ __forceinline__ int fox_block(const Srd R, const Item& H, const NextFn& next_item, char* lds, Seam& S, int wv) {
    const int P0 = H.P0;
    const int tid = wg_tid(wv), wid = wv, lane = tid & 63, r32 = lane & 31, hi = lane >> 5;
    const int NT = P0 / KVBLK + 4 - H.jlo;
    const int qlo = P0 + wid * QBLK, qm = qlo + r32 - 4 * hi;
    char* V_lds = lds + LDS_V; char* K_lds = lds + LDS_K; float* B_lds = (float*)(lds + LDS_BIAS);
    char* qw = lds + LDS_Q + wid * 8192 + lane * 16;
    float* ws = (float*)(lds + LDS_WS) + wid * 64; float* li_l = ws, * al_l = ws + 32;
    float m_reg = -1e30f, l_reg = 0; f32x16 o[4] = {};
    const int sr = tid >> 4, sc = (tid & 15) * 8, vst0 = v_st(sr, sc), vst1 = v_st(32 + sr, sc), kws = KSWZ(sr, sc * 2);
    const int vb0 = (int)(uintptr_t)V_lds + v_rd_base(lane);
    const unsigned kvoff = (unsigned)(sr * PITCH + sc) * 2u, qoff = (unsigned)(r32 * PITCH + hi * 8) * 2u;
    __attribute__((address_space(3))) float* B3 = (__attribute__((address_space(3))) float*)B_lds;
#define RESC(a) do { if (__any((a) < 1.f)) { if (hi == 0) al_l[r32] = (a); asm volatile("s_waitcnt lgkmcnt(0)" ::: "memory");              \
                     for (int d_ = 0; d_ < 4; ++d_) for (int r = 0; r < 16; ++r) o[d_][r] *= al_l[crow(r, hi)]; } } while (0)
#define KBASE(t) ((H.jlo + (t)) * KVBLK)
#define MASKT(P0_, P1_, t) do { const int kb_ = KBASE(t); if (kb_ + KVBLK - 1 > qlo) mask_tile(P0_, P1_, qm - kb_); } while (0)
    f32x16 pA0, pA1, pB0, pB1; float mnA, mnB, alA, alB; bf16x8 pa0, pa1, pa2, pa3;
    SWRITE_HV(0); SBAR();
    SLOAD_H(H, KBASE(1), 1);
    SBAR(); qkt<0>(pA0, pA1, K_lds, B_lds, r32, hi, qw);
    MASKT(pA0, pA1, 0); partialSM(pA0, pA1, m_reg, mnA, alA);
    VMW(); SWRITE_H(1);
    __syncthreads();
#define HALF_STEP(PX0, PX1, mnX, alX, PY0, PY1, alY, t, KB, VB, SB) do {                                                      \
        SBAR(); qkt<KB>(PX0, PX1, K_lds, B_lds, r32, hi, qw);                                                                 \
        finishSM(PY0, PY1, alY, l_reg, pa0, pa1, pa2, pa3); SBAR();                                                           \
        if ((t) + 1 < NT) { SLOAD_H(H, KBASE((t) + 1), SB); SBAR(); }                                                                \
        pv_tile<VB>(o, vb0, pa0, pa1, pa2, pa3); MASKT(PX0, PX1, (t)); partialSM(PX0, PX1, m_reg, mnX, alX);                  \
        __syncthreads();                                                                                                      \
        if ((t) + 1 < NT) { VMW(); SWRITE_H(SB); }                                                                      \
        RESC(alX); __syncthreads(); } while (0)
    for (int t = 1; t + 1 < NT; t += 2) {
        HALF_STEP(pB0, pB1, mnB, alB, pA0, pA1, alA, t, 1, 0, 0);
        HALF_STEP(pA0, pA1, mnA, alA, pB0, pB1, alB, t + 1, 0, 1, 1);
    }
    SBAR(); qkt<1>(pB0, pB1, K_lds, B_lds, r32, hi, qw); SBAR();
    int nidx; const Item N = next_item(H, nidx);
    SLOAD_H(N, N.jlo * KVBLK, 0); SBAR();
    QLOAD(N);
    SBAR();
    finishSM(pA0, pA1, alA, l_reg, pa0, pa1, pa2, pa3); SBAR();
    pv_tile<0>(o, vb0, pa0, pa1, pa2, pa3);
    MASKT(pB0, pB1, NT - 1); partialSM(pB0, pB1, m_reg, mnB, alB); __syncthreads(); RESC(alB);
    finishSM(pB0, pB1, alB, l_reg, pa0, pa1, pa2, pa3); SBAR(); pv_tile<1>(o, vb0, pa0, pa1, pa2, pa3);
    SBAR(); VMWN(8); SWRITE_HK(0); SBAR();
    if (hi == 0) li_l[r32] = l_reg; asm volatile("s_waitcnt lgkmcnt(0)" ::: "memory");
    float gn[4];
#pragma unroll
    for (int d0 = 0; d0 < 4; ++d0) gn[d0] = H.G[d0 * 32 + r32];
    const unsigned ovoff = (unsigned)(4 * hi * OPITCH + r32) * 2u;
#pragma unroll
    for (int r = 0; r < 16; ++r) { const float rli = __builtin_amdgcn_rcpf(li_l[crow(r, hi)]); float ss = 0.f;
#pragma unroll
        for (int d0 = 0; d0 < 4; ++d0) { o[d0][r] *= rli; ss += o[d0][r] * o[d0][r]; }
        ss += __shfl_xor(ss, 1); ss += __shfl_xor(ss, 2); ss += __shfl_xor(ss, 4); ss += __shfl_xor(ss, 8); ss += __shfl_xor(ss, 16);
        const float rs = __builtin_amdgcn_rsqf(ss * (1.0f / D) + EPS);
        const unsigned so_ = (unsigned)(P0 + wid * QBLK + (r & 3) + 8 * (r >> 2)) * (OPITCH * 2);
#pragma unroll
        for (int d0 = 0; d0 < 4; ++d0) { const float v = o[d0][r] * rs * gn[d0];
            const float vn = __shfl_xor(v, 1);
            if ((r32 & 1) == 0) __builtin_amdgcn_raw_buffer_store_b32(cvtpk(v, vn), R, ovoff + d0 * 64, H.o + so_, 0); } }
#pragma unroll
    for (int d0 = 0; d0 < 8; ++d0) *(bf16x8*)(qw + d0 * 1024) = S.qr[d0];
    __syncthreads();
    return nidx;
#undef RESC
#undef KBASE
#undef MASKT
#undef HALF_STEP
}
#undef BL8
#undef QLOAD
#undef VMW
#undef VMWN
#undef SLOAD_H
#undef SWRITE_HK
#undef SWRITE_HV
#undef SWRITE_H
#undef KSWZ
#undef SBAR
}
namespace mls {
typedef short bf16x8 __attribute__((ext_vector_type(8)));
typedef short bf16x4 __attribute__((ext_vector_type(4)));
typedef float f32x4 __attribute__((ext_vector_type(4)));
#define MFMA16(a, b, c) __builtin_amdgcn_mfma_f32_16x16x32_bf16((a), (b), (c), 0, 0, 0)

constexpr int CO_CST = 0, CO_VT = 65536, CO_XCH = 98304, CO_LDS_BYTES = CO_XCH + 512;
__device__ __forceinline__ void chunk_out(int b, int h, int c, const bf16* QP, const bf16* KPP, const bf16* VT, const bf16* CST, const float* NST,
                                          const bf16* MO, const float* gain, bf16* concat, __attribute__((address_space(3))) unsigned char* lds, int wv) {
    typedef __attribute__((address_space(3))) unsigned char* lptr;
    const int tid = wg_tid(wv), w = wv, lane = tid & 63, i16 = lane & 15, q = lane >> 4;
    const int tq = w & 3, dvh = w >> 2;
    const size_t R0 = (size_t)b * SEQ + (size_t)c * 64;
    const size_t item = ((size_t)(b * MLH + h) * NCHUNK + c);
    { const bf16* cs = CST + item * MLDV * MLDK; const bf16* vs = VT + item * MLDV * 64;
#pragma unroll
      for (int j = 0; j < 8; ++j) { const int p = w + 8 * j, row = 4 * p + (lane >> 4), lc = (lane & 15) ^ (row & 15);
          __builtin_amdgcn_global_load_lds((const unsigned*)(cs + row * MLDK + lc * 8), (__attribute__((address_space(3))) unsigned*)(lds + CO_CST + p * 1024), 16, 0, 0); }
#pragma unroll
      for (int j = 0; j < 4; ++j) { const int p = w + 8 * j, row = 8 * p + (lane >> 3), lc = (lane & 7) ^ ((row >> 1) & 7);
          __builtin_amdgcn_global_load_lds((const unsigned*)(vs + row * 64 + lc * 8), (__attribute__((address_space(3))) unsigned*)(lds + CO_VT + p * 1024), 16, 0, 0); } }
    const size_t row = R0 + 16 * tq + i16;
    const bf16* qrow = QP + row * 512 + h * MLDK + 8 * q;
    bf16x8 qf[4];
#pragma unroll
    for (int ks = 0; ks < 4; ++ks) qf[ks] = *(const bf16x8*)(qrow + 32 * ks);
    f32x4 st[4];
#pragma unroll
    for (int stile = 0; stile < 4; ++stile) {
        st[stile] = (f32x4){0.f, 0.f, 0.f, 0.f};
        if (stile <= tq) {
            const bf16* krow = KPP + (R0 + 16 * stile + i16) * 512 + h * MLDK + 8 * q;
            bf16x8 kf[4];
#pragma unroll
            for (int ks = 0; ks < 4; ++ks) kf[ks] = *(const bf16x8*)(krow + 32 * ks);
#pragma unroll
            for (int ks = 0; ks < 4; ++ks) st[stile] = MFMA16(kf[ks], qf[ks], st[stile]);
            if (stile == tq) {
#pragma unroll
                for (int r = 0; r < 4; ++r) if (4 * q + r > i16) st[stile][r] = 0.f;
            }
        }
    }
    float den = 0.f;
#pragma unroll
    for (int stile = 0; stile < 4; ++stile) den += (st[stile][0] + st[stile][1]) + (st[stile][2] + st[stile][3]);
    { const float* nrow = NST + item * MLDK + 8 * q;
#pragma unroll
      for (int ks = 0; ks < 4; ++ks) { const f32x4 n0 = *(const f32x4*)(nrow + 32 * ks), n1 = *(const f32x4*)(nrow + 32 * ks + 4);
          const v4u qq = __builtin_bit_cast(v4u, qf[ks]);
          den += bflo(qq[0]) * n0[0] + bfhi(qq[0]) * n0[1] + bflo(qq[1]) * n0[2] + bfhi(qq[1]) * n0[3]
               + bflo(qq[2]) * n1[0] + bfhi(qq[2]) * n1[1] + bflo(qq[3]) * n1[2] + bfhi(qq[3]) * n1[3]; } }
    den += __shfl_xor(den, 16); den += __shfl_xor(den, 32);
    const int dv0 = h * MLDV + dvh * 128 + 4 * q;
    v2u mo2[8];
#pragma unroll
    for (int dt = 0; dt < 8; ++dt) mo2[dt] = *(const v2u*)(MO + row * 1024 + dv0 + 16 * dt);
    bf16x8 pf[2];
#pragma unroll
    for (int p = 0; p < 2; ++p) { v4u wv; wv[0] = pg8::cvt_pk_bf16(st[2 * p][0], st[2 * p][1]); wv[1] = pg8::cvt_pk_bf16(st[2 * p][2], st[2 * p][3]);
        wv[2] = pg8::cvt_pk_bf16(st[2 * p + 1][0], st[2 * p + 1][1]); wv[3] = pg8::cvt_pk_bf16(st[2 * p + 1][2], st[2 * p + 1][3]); pf[p] = __builtin_bit_cast(bf16x8, wv); }
    const int npair = (tq >> 1) + 1;
    asm volatile("s_waitcnt vmcnt(0)" ::: "memory");
    __syncthreads();
    f32x4 num[8];
    const lptr cb = lds + CO_CST + (dvh * 128 + i16) * 256, vb = lds + CO_VT + (dvh * 128 + i16) * 128 + (q & 1) * 8;
    const int vsw = i16 >> 1;
#pragma unroll
    for (int dt = 0; dt < 8; ++dt) {
        f32x4 a = (f32x4){0.f, 0.f, 0.f, 0.f};
#pragma unroll
        for (int p = 0; p < 2; ++p) if (p < npair) {
            const v2u lo = *(const __attribute__((address_space(3))) v2u*)(vb + dt * 16 * 128 + (((4 * p + (q >> 1)) ^ vsw) * 16));
            const v2u hi2 = *(const __attribute__((address_space(3))) v2u*)(vb + dt * 16 * 128 + (((4 * p + 2 + (q >> 1)) ^ vsw) * 16));
            const v4u vv = {lo[0], lo[1], hi2[0], hi2[1]};
            a = MFMA16(__builtin_bit_cast(bf16x8, vv), pf[p], a); }
#pragma unroll
        for (int ks = 0; ks < 4; ++ks) { const bf16x8 cf = *(const __attribute__((address_space(3))) bf16x8*)(cb + dt * 16 * 256 + (((4 * ks + q) ^ i16) * 16)); a = MFMA16(cf, qf[ks], a); }
        num[dt] = a;
    }
    const float rden = 1.0f / fmaxf(fabsf(den), 1.0f);
    float ss = 0.f;
#pragma unroll
    for (int dt = 0; dt < 8; ++dt) { num[dt] = num[dt] * rden; ss += (num[dt][0] * num[dt][0] + num[dt][1] * num[dt][1]) + (num[dt][2] * num[dt][2] + num[dt][3] * num[dt][3]); }
    ss += __shfl_xor(ss, 16); ss += __shfl_xor(ss, 32);
    __attribute__((address_space(3))) float* xch = (__attribute__((address_space(3))) float*)(lds + CO_XCH);
    if (q == 0) xch[w * 16 + i16] = ss;
    __syncthreads();
    const float tot = ss + xch[(w ^ 4) * 16 + i16];
    const float rn = __builtin_amdgcn_rsqf(tot * (1.0f / MLDV) + EPS);
#pragma unroll
    for (int dt = 0; dt < 8; ++dt) { const int dv = dv0 + 16 * dt;
        const f32x4 g4 = *(const f32x4*)(gain + dv);
        const float o0 = num[dt][0] * rn * g4[0] * sigmoidf_(bflo(mo2[dt][0])), o1 = num[dt][1] * rn * g4[1] * sigmoidf_(bfhi(mo2[dt][0]));
        const float o2 = num[dt][2] * rn * g4[2] * sigmoidf_(bflo(mo2[dt][1])), o3 = num[dt][3] * rn * g4[3] * sigmoidf_(bfhi(mo2[dt][1]));
        v2u ov; ov[0] = pg8::cvt_pk_bf16(o0, o1); ov[1] = pg8::cvt_pk_bf16(o2, o3);
        *(v2u*)(concat + row * 2048 + 1024 + dv) = ov; }
    __syncthreads();
}

__device__ __forceinline__ void state_scan(int bh, int sl, const bf16* KT, const bf16* VT, const float* EB, bf16* CST, int wv) {
    const int tid = wg_tid(wv), w = wv, lane = tid & 63, i16 = lane & 15, q = lane >> 4;
    const size_t it0 = (size_t)bh * NCHUNK;
    const bf16* ka = KT + (it0 * MLDK + 16 * w + i16) * 64 + 8 * q;
    const bf16* vb = VT + (it0 * MLDV + 16 * sl + i16) * 64 + 8 * q;
    bf16* cs = CST + (it0 * MLDV + 16 * sl + i16) * MLDK + 16 * w + 4 * q;
    const float ebv = EB[it0 + lane];
    f32x4 acc = (f32x4){0.f, 0.f, 0.f, 0.f};
    bf16x8 fa0[8], fa1[8], fb0[8], fb1[8];
#pragma unroll
    for (int j = 0; j < 8; ++j) { fa0[j] = *(const bf16x8*)(ka + (size_t)j * MLDK * 64); fa1[j] = *(const bf16x8*)(ka + (size_t)j * MLDK * 64 + 32);
                                  fb0[j] = *(const bf16x8*)(vb + (size_t)j * MLDV * 64); fb1[j] = *(const bf16x8*)(vb + (size_t)j * MLDV * 64 + 32); }
    for (int c0 = 0; c0 < NCHUNK; c0 += 8) {
#pragma unroll
        for (int j = 0; j < 8; ++j) { const int c = c0 + j;
            v2u ov; ov[0] = pg8::cvt_pk_bf16(acc[0], acc[1]); ov[1] = pg8::cvt_pk_bf16(acc[2], acc[3]);
            *(v2u*)(cs + (size_t)c * MLDV * MLDK) = ov;
            acc = MFMA16(fa0[j], fb0[j], acc); acc = MFMA16(fa1[j], fb1[j], acc);
            const int cn = c + 8 < NCHUNK ? c + 8 : c;
            fa0[j] = *(const bf16x8*)(ka + (size_t)cn * MLDK * 64); fa1[j] = *(const bf16x8*)(ka + (size_t)cn * MLDK * 64 + 32);
            fb0[j] = *(const bf16x8*)(vb + (size_t)cn * MLDV * 64); fb1[j] = *(const bf16x8*)(vb + (size_t)cn * MLDV * 64 + 32);
            const float e = __shfl(ebv, c);
            acc = acc * e; }
    }
}
#undef MFMA16
}
typedef const float* cfp_t;
struct Frame {
    LAS unsigned char* lds; unsigned char* ldsg;
    int tid, lane, wave, vcu, G;
    const __attribute__((address_space(4))) cfp_t* inp; float* out; unsigned char* ws;
};
__device__ __forceinline__ void refresh_ids(Frame& F) { F.tid = wg_tid(F.wave); F.lane = F.tid & 63; }
__device__ __forceinline__ float wave_incl_scan(float v, int lane) {
#pragma unroll
    for (int o = 1; o < 64; o <<= 1) { const float t = __shfl_up(v, o); if (lane >= o) v += t; }
    return v;
}

__device__ __forceinline__ void p0_transpose_item(const float* W, int ldw, int K, bf16* WT, const float* gk, int k0, int n0_dst, int n0_src, LAS float* scr, int lane) {
    float vv[32];
#pragma unroll
    for (int i = 0; i < 32; ++i) { const int kk = 2 * i + (lane >> 5); vv[i] = W[(size_t)(k0 + kk) * ldw + n0_src + (lane & 31)]; }
    if (gk) {
#pragma unroll
        for (int i = 0; i < 32; ++i) vv[i] *= gk[k0 + 2 * i + (lane >> 5)]; }
#pragma unroll
    for (int i = 0; i < 32; ++i) scr[(2 * i + (lane >> 5)) * 33 + (lane & 31)] = vv[i];
    LDS_WAIT(); asm volatile("" ::: "memory");
    const int c = lane & 7;
#pragma unroll
    for (int j = 0; j < 4; ++j) { const int n = (lane >> 3) + 8 * j; const LAS float* s = scr + (8 * c) * 33 + n;
        v4u o; o.x = pk2(s[0 * 33], s[1 * 33]); o.y = pk2(s[2 * 33], s[3 * 33]); o.z = pk2(s[4 * 33], s[5 * 33]); o.w = pk2(s[6 * 33], s[7 * 33]);
        *(GAS v4u*)(WT + (size_t)(n0_dst + n) * K + k0 + 8 * c) = o; }
    LDS_WAIT(); asm volatile("" ::: "memory");
}
__device__ __forceinline__ void p0_transpose_item8(const float* W, int ldw, int K, unsigned char* WT8, const float* gk, float scale, int k0, int n0, LAS float* scr, int lane) {
    float vv[32];
#pragma unroll
    for (int i = 0; i < 32; ++i) { const int kk = 2 * i + (lane >> 5); vv[i] = W[(size_t)(k0 + kk) * ldw + n0 + (lane & 31)]; }
#pragma unroll
    for (int i = 0; i < 32; ++i) vv[i] *= (gk ? gk[k0 + 2 * i + (lane >> 5)] : 1.0f) * scale;
#pragma unroll
    for (int i = 0; i < 32; ++i) scr[(2 * i + (lane >> 5)) * 33 + (lane & 31)] = vv[i];
    LDS_WAIT(); asm volatile("" ::: "memory");
    const int c = lane & 7;
#pragma unroll
    for (int j = 0; j < 4; ++j) { const int n = (lane >> 3) + 8 * j; const LAS float* s = scr + (8 * c) * 33 + n;
        v2u o; o.x = pg8::pk4_fp8(s[0 * 33], s[1 * 33], s[2 * 33], s[3 * 33]); o.y = pg8::pk4_fp8(s[4 * 33], s[5 * 33], s[6 * 33], s[7 * 33]);
        *(GAS v2u*)(WT8 + (size_t)(n0 + n) * K + k0 + 8 * c) = o; }
    LDS_WAIT(); asm volatile("" ::: "memory");
}
__device__ __forceinline__ float rms_row_to_bf16(const float* xrow, const float* g, bf16* orow, int lane) {
    const GAS v4f* xr = (const GAS v4f*)xrow + lane; const GAS v4f* gr = (const GAS v4f*)g + lane;
    v4f v[8]; float s = 0.f;
#pragma unroll
    for (int j = 0; j < 8; ++j) { v[j] = xr[64 * j]; s += (v[j].x * v[j].x + v[j].y * v[j].y) + (v[j].z * v[j].z + v[j].w * v[j].w); }
    const float rinv = 1.0f / sqrtf(wave_sum(s) * (1.f / DM) + EPS);
    GAS v2u* o8 = (GAS v2u*)orow + lane;
#pragma unroll
    for (int j = 0; j < 8; ++j) { const v4f gg = gr[64 * j]; v2u w; w.x = pk2(v[j].x * rinv * gg.x, v[j].y * rinv * gg.y); w.y = pk2(v[j].z * rinv * gg.z, v[j].w * rinv * gg.w); o8[64 * j] = w; }
    return rinv;
}
__device__ __forceinline__ void p0_prologue(Frame& F) {
    refresh_ids(F);
    const float* x = F.inp[0]; const float* mem = F.inp[1]; const float* mixer_norm = F.inp[2]; const float* w_in = F.inp[3];
    const int gw = F.vcu * 8 + F.wave, NGW = F.G * 8;
    LAS float* WgL = (LAS float*)F.lds;
#pragma unroll 8
    for (int idx = F.tid; idx < 32768; idx += NTHREADS) { const int e = idx & 7, ln = (idx >> 3) & 63, sp = idx >> 9, gate = ln & 15, q = ln >> 4, k = 32 * sp + 8 * q + e;
        const int col = gate < 8 ? 3072 + gate : 5128 + (gate - 8);
        WgL[idx] = w_in[(size_t)k * IN_WIDTH + col] * mixer_norm[k]; }
    __syncthreads();
    { float* gates = (float*)(F.ws + WS_GATES); float* ssqx = (float*)(F.ws + WS_CTL + CTL_SSQX); bf16* XG = (bf16*)(F.ws + WS_XN);
      const int i16 = F.lane & 15, q = F.lane >> 4;
      for (int it = gw; it < MTOK / 16 * 2; it += NGW) { const int grp = it >> 1, kh = it & 1; const size_t row = (size_t)grp * 16 + i16;
          const float* xr = x + row * DM + kh * 1024 + 8 * q; const float* gr = mixer_norm + kh * 1024 + 8 * q; bf16* xo = XG + row * DM + kh * 1024 + 8 * q;
          const LAS float* wp = WgL + (kh * 32 * 64 + F.lane) * 8;
          v4f acc = (v4f){0.f, 0.f, 0.f, 0.f}; float ss = 0.f;
#pragma unroll 1
          for (int s0 = 0; s0 < 32; s0 += 8, wp += 8 * 512, xr += 8 * 32, gr += 8 * 32, xo += 8 * 32) { v4f xb[8][2];
#pragma unroll
              for (int j = 0; j < 8; ++j) { xb[j][0] = *(const v4f*)(xr + 32 * j); xb[j][1] = *(const v4f*)(xr + 32 * j + 4); }
#pragma unroll
              for (int j = 0; j < 8; ++j) { const v4f x0 = xb[j][0], x1 = xb[j][1]; const v4f g0 = *(const v4f*)(gr + 32 * j), g1 = *(const v4f*)(gr + 32 * j + 4);
                  const v4f w0 = *(const LAS v4f*)(wp + j * 512), w1 = *(const LAS v4f*)(wp + j * 512 + 4);
                  ss += (x0.x * x0.x + x0.y * x0.y) + (x0.z * x0.z + x0.w * x0.w) + (x1.x * x1.x + x1.y * x1.y) + (x1.z * x1.z + x1.w * x1.w);
                  v4u o; o.x = pk2(x0.x * g0.x, x0.y * g0.y); o.y = pk2(x0.z * g0.z, x0.w * g0.w); o.z = pk2(x1.x * g1.x, x1.y * g1.y); o.w = pk2(x1.z * g1.z, x1.w * g1.w);
                  *(v4u*)(xo + 32 * j) = o;
                  acc = __builtin_amdgcn_mfma_f32_16x16x4f32(x0.x, w0.x, acc, 0, 0, 0); acc = __builtin_amdgcn_mfma_f32_16x16x4f32(x0.y, w0.y, acc, 0, 0, 0);
                  acc = __builtin_amdgcn_mfma_f32_16x16x4f32(x0.z, w0.z, acc, 0, 0, 0); acc = __builtin_amdgcn_mfma_f32_16x16x4f32(x0.w, w0.w, acc, 0, 0, 0);
                  acc = __builtin_amdgcn_mfma_f32_16x16x4f32(x1.x, w1.x, acc, 0, 0, 0); acc = __builtin_amdgcn_mfma_f32_16x16x4f32(x1.y, w1.y, acc, 0, 0, 0);
                  acc = __builtin_amdgcn_mfma_f32_16x16x4f32(x1.z, w1.z, acc, 0, 0, 0); acc = __builtin_amdgcn_mfma_f32_16x16x4f32(x1.w, w1.w, acc, 0, 0, 0); } }
          ss += __shfl_xor(ss, 16); ss += __shfl_xor(ss, 32);
          if (q == 0) atomicAdd(ssqx + row, ss);
#pragma unroll
          for (int r = 0; r < 4; ++r) atomicAdd(gates + ((size_t)grp * 16 + 4 * q + r) * 16 + i16, acc[r]);
      } }
    { bf16* MN = (bf16*)(F.ws + WS_MN);
      for (int m = gw; m < MROWS; m += NGW) (void)rms_row_to_bf16(mem + (size_t)m * DM, F.inp[15], MN + (size_t)m * DM, F.lane); }
    __syncthreads();
    LAS float* scr = (LAS float*)(F.lds + F.wave * 16384);
    for (int it = gw; it < 32768; it += NGW) {
        int r = it;
        if (r < 6144) { const int kb = r / 192, nb = r % 192, n0 = 32 * nb, grpc = n0 >> 10, shift = grpc < 3 ? 0 : (grpc < 5 ? 8 : 16);
            p0_transpose_item(w_in, IN_WIDTH, DM, (bf16*)(F.ws + WS_WIN), nullptr, 64 * kb, n0, n0 + shift, scr, F.lane); continue; } r -= 6144;
        if (r < 2048) { p0_transpose_item(F.inp[13], DM, DM, (bf16*)(F.ws + WS_WOUT), nullptr, 64 * (r / 64), 32 * (r % 64), 32 * (r % 64), scr, F.lane); continue; } r -= 2048;
        if (r < 2048) { p0_transpose_item8(F.inp[16], DM, DM, F.ws + WS_WXQ, F.inp[14], W8_SCALE, 64 * (r / 64), 32 * (r % 64), scr, F.lane); continue; } r -= 2048;
        if (r < 4096) { p0_transpose_item(F.inp[17], 2 * DM, DM, (bf16*)(F.ws + WS_WXKV), nullptr, 64 * (r / 128), 32 * (r % 128), 32 * (r % 128), scr, F.lane); continue; } r -= 4096;
        if (r < 2048) { p0_transpose_item8(F.inp[20], DM, DM, F.ws + WS_WXO, nullptr, W8_SCALE, 64 * (r / 64), 32 * (r % 64), scr, F.lane); continue; } r -= 2048;
        if (r < 8192) { p0_transpose_item(F.inp[22], DFF, DM, (bf16*)(F.ws + WS_WUP), F.inp[21], 64 * (r / 256), 32 * (r % 256), 32 * (r % 256), scr, F.lane); continue; } r -= 8192;
        p0_transpose_item(F.inp[23], DM, DFF, (bf16*)(F.ws + WS_WDN), nullptr, 64 * (r / 64), 32 * (r % 64), 32 * (r % 64), scr, F.lane);
    }
}

constexpr int P2_KT_OFF = 4096, P2_KT_PITCH = 136, P2_VT_OFF = P2_KT_OFF + 64 * P2_KT_PITCH * 2, P2_VT_PITCH = 264;
constexpr int P2_BUF_ELEMS = (64 * P2_KT_PITCH + 64 * P2_VT_PITCH);
__device__ __forceinline__ void p2_prep_item(Frame& F, int item, bool do_norm = true) {
    refresh_ids(F);
    const int b = item >> 6, c = item & 63; const size_t R0 = (size_t)b * SEQ + (size_t)c * 64;
    const int tid = F.tid, lane = F.lane, w = F.wave;
    LAS float* gq = (LAS float*)F.lds; LAS float* uk = gq + 256;
    LAS bf16* kt = (LAS bf16*)(F.lds + P2_KT_OFF); LAS bf16* vt = (LAS bf16*)(F.lds + P2_VT_OFF);
    const float* GATES = (const float*)(F.ws + WS_GATES); const float* SSQX = (const float*)(F.ws + WS_CTL + CTL_SSQX);
    if (w < 4) { const size_t row = R0 + lane; const float ri = rinv_of(SSQX, row);
        const float mi = GATES[row * 16 + 8 + w] * ri + F.inp[5][w], mf = GATES[row * 16 + 12 + w] * ri + F.inp[6][w];
        const float bcum = wave_incl_scan(logsigmoidf(mf), lane);
        const float g = __expf(bcum), u = __expf(mi - bcum) * 0.08838834764831845f;
        gq[w * 64 + lane] = g; uk[w * 64 + lane] = u;
        if (lane == 63) ((float*)(F.ws + WS_EB))[(size_t)(b * MLH + w) * NCHUNK + c] = g; }
    if (do_norm) { bf16* FQ = (bf16*)(F.ws + WS_FQ); bf16* FK = (bf16*)(F.ws + WS_FK); const int l16 = lane & 15;
      float gqn[8], gkn[8];
#pragma unroll
      for (int e = 0; e < 8; ++e) { gqn[e] = F.inp[9][l16 * 8 + e]; gkn[e] = F.inp[10][l16 * 8 + e]; }
      for (int it0 = w; it0 < 256; it0 += 64) {
          v4u raw[8];
#pragma unroll
          for (int j = 0; j < 8; ++j) { const int seg = (it0 + 8 * j) * 4 + (lane >> 4), row = seg >> 4, hh = seg & 15;
              raw[j] = *(const v4u*)((hh < 8 ? FQ : FK) + (R0 + row) * 1024 + (hh & 7) * FOXD + l16 * 8); }
#pragma unroll
          for (int j = 0; j < 8; ++j) { const int seg = (it0 + 8 * j) * 4 + (lane >> 4), row = seg >> 4, hh = seg & 15;
              bf16* p = (hh < 8 ? FQ : FK) + (R0 + row) * 1024 + (hh & 7) * FOXD + l16 * 8; float v[8];
#pragma unroll
              for (int e = 0; e < 4; ++e) { v[2 * e] = bflo(raw[j][e]); v[2 * e + 1] = bfhi(raw[j][e]); }
              float ss = 0.f;
#pragma unroll
              for (int e = 0; e < 8; ++e) ss += v[e] * v[e];
              ss += __shfl_xor(ss, 1); ss += __shfl_xor(ss, 2); ss += __shfl_xor(ss, 4); ss += __shfl_xor(ss, 8);
              const float ri = 1.0f / sqrtf(ss * (1.0f / FOXD) + EPS);
              v4u o;
#pragma unroll
              for (int e = 0; e < 4; ++e) { const float g0 = hh < 8 ? gqn[2 * e] : gkn[2 * e], g1 = hh < 8 ? gqn[2 * e + 1] : gkn[2 * e + 1]; o[e] = pk2(v[2 * e] * ri * g0, v[2 * e + 1] * ri * g1); }
              *(v4u*)p = o; } } }
    __syncthreads();
    const bf16* MQK = (const bf16*)(F.ws + WS_MQK); const bf16* MV = (const bf16*)(F.ws + WS_MV);
    bf16* QP = (bf16*)(F.ws + WS_QP); bf16* KPP = (bf16*)(F.ws + WS_KPP);
    const float* conv_w = F.inp[7]; const float* conv_b = F.inp[8];
    const int cgp = tid & 31, rg = tid >> 5; const bool isq = cgp < 16;
    v4u rawc[7], rawv[4];
#define P2_LOAD(h_) do { const int col_ = (isq ? 0 : 512) + (h_) * MLDK + (cgp & 15) * 8;                                              \
        _Pragma("unroll") for (int i = 0; i < 7; ++i) { const int pos = c * 64 + 4 * rg - 3 + i;                                           \
            rawc[i] = (v4u){0u, 0u, 0u, 0u}; if (pos >= 0) rawc[i] = *(const v4u*)(MQK + ((size_t)b * SEQ + pos) * 1024 + col_); }            \
        _Pragma("unroll") for (int i = 0; i < 4; ++i) { const int idx = tid + NTHREADS * i, row = idx >> 5, ch = idx & 31;                 \
            rawv[i] = *(const v4u*)(MV + (R0 + row) * 1024 + (h_) * MLDV + ch * 8); } } while (0)
#define P2_CONV(h_, kt_, vt_) do { const int col_ = (isq ? 0 : 512) + (h_) * MLDK + (cgp & 15) * 8;                                       \
        float cw[4][8], cb[8];                                                                                                             \
        _Pragma("unroll") for (int e = 0; e < 8; ++e) { cb[e] = conv_b[col_ + e];                                                          \
            _Pragma("unroll") for (int j = 0; j < 4; ++j) cw[j][e] = conv_w[j * 1024 + col_ + e]; }                                        \
        float u[7][8];                                                                                                                     \
        _Pragma("unroll") for (int i = 0; i < 7; ++i) _Pragma("unroll") for (int e = 0; e < 4; ++e) { u[i][2 * e] = bflo(rawc[i][e]); u[i][2 * e + 1] = bfhi(rawc[i][e]); } \
        _Pragma("unroll") for (int r = 0; r < 4; ++r) { const int t = 4 * rg + r; const float f = isq ? gq[(h_) * 64 + t] : uk[(h_) * 64 + t]; float y[8]; \
            _Pragma("unroll") for (int e = 0; e < 8; ++e) { float a = cb[e];                                                               \
                _Pragma("unroll") for (int j = 0; j < 4; ++j) a += cw[j][e] * u[r + j][e];                                                 \
                y[e] = a * sigmoidf_(a) * f; }                                                                                             \
            v4u o; o.x = pk2(y[0], y[1]); o.y = pk2(y[2], y[3]); o.z = pk2(y[4], y[5]); o.w = pk2(y[6], y[7]);                             \
            *(v4u*)((isq ? QP : KPP) + (R0 + t) * 512 + (h_) * MLDK + (cgp & 15) * 8) = o;                                                 \
            if (!isq) *(LAS v4u*)((kt_) + t * P2_KT_PITCH + (cgp & 15) * 8) = o; }                                                         \
        _Pragma("unroll") for (int i = 0; i < 4; ++i) { const int idx = tid + NTHREADS * i, row = idx >> 5, ch = idx & 31;                 \
            *(LAS v4u*)((vt_) + row * P2_VT_PITCH + ch * 8) = rawv[i]; } } while (0)
    P2_LOAD(0); P2_CONV(0, kt, vt);
    __syncthreads();
    for (int h = 0; h < MLH; ++h) {
        LAS bf16* ktc = kt + (h & 1) * P2_BUF_ELEMS; LAS bf16* vtc = vt + (h & 1) * P2_BUF_ELEMS;
        LAS bf16* ktn = kt + ((h + 1) & 1) * P2_BUF_ELEMS; LAS bf16* vtn = vt + ((h + 1) & 1) * P2_BUF_ELEMS;
        if (h + 1 < MLH) P2_LOAD(h + 1);
        const size_t itemh = (size_t)(b * MLH + h) * NCHUNK + c;
        { bf16* KT = (bf16*)(F.ws + WS_KT) + itemh * MLDK * 64;
#pragma unroll
          for (int i = 0; i < 2; ++i) { const int idx = tid + NTHREADS * i, d = idx >> 3, sg = idx & 7; unsigned short e8[8];
#pragma unroll
              for (int e = 0; e < 8; ++e) e8[e] = ktc[(8 * sg + e) * P2_KT_PITCH + d];
              v4u o; o.x = e8[0] | ((unsigned)e8[1] << 16); o.y = e8[2] | ((unsigned)e8[3] << 16); o.z = e8[4] | ((unsigned)e8[5] << 16); o.w = e8[6] | ((unsigned)e8[7] << 16);
              *(v4u*)(KT + d * 64 + 8 * sg) = o; }
          bf16* VT = (bf16*)(F.ws + WS_VT) + itemh * MLDV * 64;
#pragma unroll
          for (int i = 0; i < 4; ++i) { const int idx = tid + NTHREADS * i, dv = idx >> 3, sg = idx & 7; unsigned short e8[8];
#pragma unroll
              for (int e = 0; e < 8; ++e) e8[e] = vtc[(8 * sg + e) * P2_VT_PITCH + dv];
              v4u o; o.x = e8[0] | ((unsigned)e8[1] << 16); o.y = e8[2] | ((unsigned)e8[3] << 16); o.z = e8[4] | ((unsigned)e8[5] << 16); o.w = e8[6] | ((unsigned)e8[7] << 16);
              *(v4u*)(VT + dv * 64 + 8 * sg) = o; }
          if (tid < MLDK) { float s = 0.f;
#pragma unroll 8
              for (int t = 0; t < 64; ++t) s += bf2f(ktc[t * P2_KT_PITCH + tid]);
              ((float*)(F.ws + WS_KSUM))[itemh * MLDK + tid] = s; } }
        if (h + 1 < MLH) P2_CONV(h + 1, ktn, vtn);
        __syncthreads();
    }
#undef P2_LOAD
#undef P2_CONV
    { const int mr = item * 4 + (w & 3); const float* slab = (const float*)((const unsigned char*)F.out + OUT_SLAB);
      if (w < 4) {
        const float* gxq = F.inp[18]; const float* gxk = F.inp[19];
        v4f kv[8]; float ssh[4] = {0.f, 0.f, 0.f, 0.f};
#pragma unroll
        for (int j = 0; j < 8; ++j) { const int col = 4 * (lane + 64 * j); v4f a = (v4f){0.f, 0.f, 0.f, 0.f};
#pragma unroll
            for (int s = 0; s < 4; ++s) a = a + *(const v4f*)(slab + ((size_t)s * MROWS + mr) * 4096 + col);
            kv[j] = a; ssh[j >> 1] += (a.x * a.x + a.y * a.y) + (a.z * a.z + a.w * a.w); }
        float rk[4];
#pragma unroll
        for (int hh = 0; hh < 4; ++hh) rk[hh] = 1.0f / sqrtf(wave_sum(ssh[hh]) * (1.0f / XD) + EPS);
        bf16* KH = (bf16*)(F.ws + WS_KHAT) + (size_t)mr * DM;
#pragma unroll
        for (int j = 0; j < 8; ++j) { const int col = 4 * (lane + 64 * j), d = col & (XD - 1); const v4f a = *(const v4f*)(gxq + d), g2 = *(const v4f*)(gxk + d); const float r = rk[j >> 1];
            v2u o; o.x = pk2(kv[j].x * r * a.x * g2.x, kv[j].y * r * a.y * g2.y); o.y = pk2(kv[j].z * r * a.z * g2.z, kv[j].w * r * a.w * g2.w);
            *(v2u*)(KH + col) = o; }
      } else {
        bf16* VTM = (bf16*)(F.ws + WS_VTM); const int bm = mr >> 8, key = mr & 255;
        v4f vv[8];
#pragma unroll
        for (int j = 0; j < 8; ++j) { const int dcol = 4 * (lane + 64 * j); v4f a = (v4f){0.f, 0.f, 0.f, 0.f};
#pragma unroll
            for (int s = 0; s < 4; ++s) a = a + *(const v4f*)(slab + ((size_t)s * MROWS + mr) * 4096 + 2048 + dcol);
            vv[j] = a; }
#pragma unroll
        for (int j = 0; j < 8; ++j) { const int dcol = 4 * (lane + 64 * j); const v4f a = vv[j];
            const int hh = dcol >> 9, d = dcol & (XD - 1); bf16* vp = VTM + ((size_t)(bm * XH + hh) * XD + d) * NMEM + key;
            vp[0] = (bf16)f2bf(a.x); vp[NMEM] = (bf16)f2bf(a.y); vp[2 * NMEM] = (bf16)f2bf(a.z); vp[3 * NMEM] = (bf16)f2bf(a.w); }
      } }
    __syncthreads();
}

__device__ __forceinline__ void p3_scan_item(Frame& F, int item) {
    refresh_ids(F);
    const int bh = item >> 4, sl = item & 15;
    mls::state_scan(bh, sl, (const bf16*)(F.ws + WS_KT), (const bf16*)(F.ws + WS_VT), (const float*)(F.ws + WS_EB), (bf16*)((unsigned char*)F.out + OUT_CST), F.wave);
    if (sl == 0 && F.tid < MLDK) {
        const float* EB = (const float*)(F.ws + WS_EB) + (size_t)bh * NCHUNK; const float* KS = (const float*)(F.ws + WS_KSUM) + (size_t)bh * NCHUNK * MLDK + F.tid;
        float* NS = (float*)(F.ws + WS_NST) + (size_t)bh * NCHUNK * MLDK + F.tid; float n = 0.f;
        float ks[NCHUNK], eb[NCHUNK];
#pragma unroll
        for (int c = 0; c < NCHUNK; ++c) { ks[c] = KS[(size_t)c * MLDK]; eb[c] = EB[c]; }
#pragma unroll
        for (int c = 0; c < NCHUNK; ++c) { NS[(size_t)c * MLDK] = n; n = eb[c] * (n + ks[c]); }
    }
    if (sl == 1 || sl == 2) {
        const int seq = (sl - 1) * 16 + bh, b = seq >> 3, fh = seq & 7;
        const float* GATES = (const float*)(F.ws + WS_GATES); const float* SSQX = (const float*)(F.ws + WS_CTL + CTL_SSQX); const float fb = F.inp[4][fh];
        const size_t r0 = (size_t)b * SEQ + 8 * F.tid; float lf[8]; float tot = 0.f;
#pragma unroll
        for (int j = 0; j < 8; ++j) { lf[j] = logsigmoidf(GATES[(r0 + j) * 16 + fh] * rinv_of(SSQX, r0 + j) + fb); tot += lf[j]; }
        const float incl = wave_incl_scan(tot, F.lane);
        LAS float* wt = (LAS float*)F.lds;
        __syncthreads();
        if (F.lane == 63) wt[F.wave] = incl;
        __syncthreads();
        float run = incl - tot;
        for (int wv = 0; wv < F.wave; ++wv) run += wt[wv];
        float* C = (float*)(F.ws + WS_CFOX) + (size_t)seq * SEQ + 8 * F.tid;
        float cs[8];
#pragma unroll
        for (int j = 0; j < 8; ++j) { run += lf[j]; cs[j] = run * -11.313708498984761f; C[j] = cs[j]; }
        LAS float* cp0 = wt + 16; LAS float* cend = wt + 32; LAS float* thr = wt + 96;
        if ((F.tid & 31) == 0) cp0[F.tid >> 5] = cs[0];
        if ((F.tid & 7) == 7) cend[F.tid >> 3] = cs[7];
        if (F.wave == 0) { float gq = fmaxf(fabsf(F.inp[9][F.lane]), fabsf(F.inp[9][F.lane + 64])), gk = fmaxf(fabsf(F.inp[10][F.lane]), fabsf(F.inp[10][F.lane + 64]));
#pragma unroll
            for (int o = 1; o < 64; o <<= 1) { gq = fmaxf(gq, __shfl_xor(gq, o)); gk = fmaxf(gk, __shfl_xor(gk, o)); }
            if (F.lane == 0) thr[0] = 2.0f * 11.313708498984761f * gq * gk + 29.0f; }
        __syncthreads();
        if (F.tid < 16) { const int qb = F.tid; const float T = thr[0], c0 = cp0[qb]; int j = 0;
            while (j < 4 * qb && (c0 - cend[j]) * 0.08838834764831845f > T) ++j;
            ((int*)(F.ws + WS_JLO))[seq * 16 + qb] = JLO_DISABLE ? 0 : (j & ~1); }
        __syncthreads();
    }
}
#ifndef MK_PER_PHASE
#define MK_PER_PHASE 0
#endif
#define XB_TMO      128
#define XB_XCNT(j)  (256  + 64 * (j))
#define XB_XSUB(j)  (1280 + 64 * (j))
#define XB_XGEN(j)  (2304 + 64 * (j))
#define XB_TOP      3328
#define XB_TOPGEN   3392
#define XCD_BAR_WORDS 3456
#define XB_SPIN_CAP (1u << 20)
__device__ __forceinline__ unsigned xb_ld(unsigned* p)              { return __hip_atomic_load(p, __ATOMIC_RELAXED, __HIP_MEMORY_SCOPE_AGENT); }
__device__ __forceinline__ unsigned xb_add(unsigned* p, unsigned v) { return __hip_atomic_fetch_add(p, v, __ATOMIC_RELAXED, __HIP_MEMORY_SCOPE_AGENT); }
__device__ __forceinline__ unsigned xb_xcc_id() { return (unsigned)__builtin_amdgcn_s_getreg((3 << 11) | 20) & 0xFu; }
#define XB_SPIN(cond, bar) do { unsigned _sp = 0; while (cond) { __builtin_amdgcn_s_sleep(1); \
    if ((++_sp & 255u) == 0u) { if (xb_ld(&(bar)[XB_TMO])) break; if (_sp > XB_SPIN_CAP) { atomicAdd(&(bar)[XB_TMO], 1u); break; } } } } while (0)
struct XcdBarrier { unsigned* bar; unsigned x; volatile LAS unsigned* st; int wv; };
__device__ __forceinline__ XcdBarrier xcd_barrier_post(unsigned* bar, volatile LAS unsigned* st, int wv) {
    XcdBarrier b; b.bar = bar; b.x = xb_xcc_id(); b.st = st; b.wv = wv;
    if (wv == 0 && lane_id() == 0) (void)xb_add(&bar[XB_XCNT(b.x)], 1u);
    return b;
}
__device__ __forceinline__ void xcd_barrier_complete(unsigned* bar, unsigned x, unsigned& nloc, unsigned& nx) {
    const unsigned G = gridDim.x * gridDim.y * gridDim.z;
    unsigned sum, cnt, mine, sp = 0u;
    for (;;) {
        sum = 0u; cnt = 0u; mine = 0u;
#pragma unroll
        for (unsigned j = 0; j < 16; ++j) { const unsigned c = xb_ld(&bar[XB_XCNT(j)]); sum += c; cnt += (c > 0u) ? 1u : 0u; mine = (j == x) ? c : mine; }
        if (sum == G) break;
        __builtin_amdgcn_s_sleep(1);
        if ((++sp & 255u) == 0u) { if (xb_ld(&bar[XB_TMO])) break; if (sp > XB_SPIN_CAP) { atomicAdd(&bar[XB_TMO], 1u); break; } }
    }
    nloc = mine > 0u ? mine : 1u; nx = cnt > 0u ? cnt : 1u;
}
__device__ __forceinline__ void xcd_barrier(const XcdBarrier& b) {
    asm volatile("s_waitcnt vmcnt(0)" ::: "memory");
    __syncthreads();
    if (b.wv == 0 && lane_id() == 0) {
        unsigned* bar = b.bar;
        __builtin_amdgcn_s_waitcnt(0);
        unsigned nloc = b.st[0], nx = b.st[1];
        if (nloc == 0u) { xcd_barrier_complete(bar, b.x, nloc, nx); b.st[0] = nloc; b.st[1] = nx; }
        const unsigned old = xb_add(&bar[XB_XSUB(b.x)], 1u);
        const unsigned gen = old / nloc;
        if (old + 1u == (gen + 1u) * nloc) {
            __builtin_amdgcn_fence(__ATOMIC_RELEASE, "agent");
            asm volatile("s_waitcnt vmcnt(0)" ::: "memory");
            const unsigned og = xb_add(&bar[XB_TOP], 1u);
            const unsigned tg = og / nx;
            if (og + 1u == (tg + 1u) * nx) xb_add(&bar[XB_TOPGEN], 1u);
            else XB_SPIN(xb_ld(&bar[XB_TOPGEN]) == tg, bar);
            __builtin_amdgcn_fence(__ATOMIC_ACQUIRE, "agent");
            xb_add(&bar[XB_XGEN(b.x)], 1u);
            asm volatile("s_waitcnt vmcnt(0)" ::: "memory");
        } else {
            XB_SPIN(xb_ld(&bar[XB_XGEN(b.x)]) == gen, bar);
            __builtin_amdgcn_fence(__ATOMIC_ACQUIRE, "agent");
            asm volatile("s_waitcnt vmcnt(0)" ::: "memory");
        }
    }
    __syncthreads();
}
constexpr int LDS_MISC_OFF = LDS_BYTES - 256;
#ifndef ML_TWICE
#define ML_TWICE 1
#endif
#ifndef TWICE_P5
#define TWICE_P5 0
#endif
#ifndef TWICE_P6
#define TWICE_P6 0
#endif
#ifndef TWICE_P8
#define TWICE_P8 0
#endif
#ifndef P4_TWICE
#define P4_TWICE 1
#endif
#ifndef TWICE_P11
#define TWICE_P11 0
#endif
#ifndef TWICE_P10
#define TWICE_P10 0
#endif
#ifndef TWICE_P1
#define TWICE_P1 0
#endif
#ifndef JLO_DISABLE
#define JLO_DISABLE 0
#endif
constexpr int N_PHASES = 12;
struct Args { const float* in[24]; float* out; unsigned char* ws; int ph_lo, ph_hi; };
static_assert(sizeof(Args) == 24 * 8 + 8 + 8 + 8, "Args has no padding");

__global__ void __launch_bounds__(NTHREADS, 2) fwd_kernel(Args args) {
    extern __shared__ __attribute__((aligned(16))) unsigned char lds[];
    Frame F;
    F.lds = (LAS unsigned char*)lds; F.ldsg = lds;
    F.wave = __builtin_amdgcn_readfirstlane((int)(threadIdx.x >> 6)); F.lane = lane_id(); F.tid = F.wave * 64 + F.lane;
    F.G = gridDim.x; { const int bx = blockIdx.x; F.vcu = (F.G % 8 == 0) ? (bx % 8) * (F.G / 8) + bx / 8 : bx; }
    F.inp = (const __attribute__((address_space(4))) cfp_t*)__builtin_amdgcn_kernarg_segment_ptr();
    F.out = args.out; F.ws = args.ws;
    unsigned char* ws = args.ws;
    const int lo = args.ph_lo, hi = args.ph_hi;
    volatile LAS unsigned* MISC = (volatile LAS unsigned*)(F.lds + LDS_MISC_OFF);
    if (F.tid < 64) MISC[F.tid] = 0u;
    __syncthreads();
    XcdBarrier xbar; xbar.bar = (unsigned*)(ws + WS_CTL); xbar.x = 0; xbar.st = nullptr; xbar.wv = F.wave;
    if (hi - lo > 1) xbar = xcd_barrier_post((unsigned*)(ws + WS_CTL), MISC, F.wave);
#ifndef PHASE_MASK
#define PHASE_MASK 0xfff
#endif
#define IN(k) ((((PHASE_MASK) >> (k)) & 1) && lo <= (k) && (k) < hi)
#ifndef DUP_PHASE
#define DUP_PHASE 99
#endif
#define REP(k) for (int rep_ = 0; rep_ < ((k) == DUP_PHASE ? 2 : 1); ++rep_, ((k) == DUP_PHASE && rep_ < 2 ? xcd_barrier(xbar) : (void)0))
#define SEAM(k) do { if (IN(k) && IN((k) + 1)) { xcd_barrier(xbar); } } while (0)
    if (__builtin_expect(lo < 0, 0)) cg::this_grid().sync();
    float* SSQ1 = (float*)(ws + WS_CTL + CTL_SSQ1); float* SSQ2 = (float*)(ws + WS_CTL + CTL_SSQ2); float* SSQQ = (float*)(ws + WS_CTL + CTL_SSQQ);

#ifdef PROBE_PHASE
    unsigned long long pt0 = 0, pt1 = 0, pu0 = 0, pu1 = 0;
#ifndef PROBE_B
#define PROBE_B 99
#endif
#define STAMP(k) do { if ((k) == PROBE_PHASE) pt0 = __builtin_amdgcn_s_memrealtime(); if ((k) == PROBE_PHASE + 1) pt1 = __builtin_amdgcn_s_memrealtime(); \
                      if ((k) == PROBE_B) pu0 = __builtin_amdgcn_s_memrealtime(); if ((k) == PROBE_B + 1) pu1 = __builtin_amdgcn_s_memrealtime(); } while (0)
#else
#define STAMP(k) do {} while (0)
#endif
    STAMP(0);
#ifdef CLK_PHASE
    unsigned long long ck0 = 0, ck1 = 0, cr0 = 0, cr1 = 0;
#define CLKS(k) do { if ((k) == CLK_PHASE) { ck0 = __builtin_amdgcn_s_memtime(); cr0 = __builtin_amdgcn_s_memrealtime(); } if ((k) == CLK_PHASE + 1) { ck1 = __builtin_amdgcn_s_memtime(); cr1 = __builtin_amdgcn_s_memrealtime(); } } while (0)
#else
#define CLKS(k) do {} while (0)
#endif
    CLKS(0);
    if (IN(0)) REP(0) { p0_prologue(F); }
    SEAM(0); STAMP(1); CLKS(1);
    if (IN(1)) REP(1) {
        { pg8::Gemm g{ws, (unsigned)WS_XN, (unsigned)WS_WIN, DM, DM, DM}; pg8::StdOrder S; S.init(MTOK, NPROJ, DM, DM, F.G, (int)blockIdx.x, TWICE_P1);
          pg8::EpiProj E{(bf16*)(ws + WS_PROJ), F.inp[9], F.inp[10], (const float*)(ws + WS_CTL + CTL_SSQX), (LAS float*)(F.lds + pg8::STAGE_BYTES)};
          pg8::gemm_phase<pg8::EpiProj, pg8::StdOrder, true>(F.lds, g, S, E, F.wave); }
        { pg8::Gemm g{ws, (unsigned)WS_MN, (unsigned)WS_WXKV, DM, DM, 512}; pg8::XkvOrder S{F.G, (int)blockIdx.x};
          pg8::EpiSlab E{(float*)((unsigned char*)F.out + OUT_SLAB), 4096, (size_t)MROWS * 4096};
          pg8::gemm_phase<pg8::EpiSlab, pg8::XkvOrder, false>(F.lds, g, S, E, F.wave); }
    }
    SEAM(1); STAMP(2); CLKS(2);
#ifndef P2_TWICE
#define P2_TWICE 1
#endif
    if (IN(2)) REP(2) { for (int item = F.vcu; item < BATCH * NCHUNK * P2_TWICE; item += F.G) p2_prep_item(F, item & 255, false); }
    SEAM(2); STAMP(3); CLKS(3);
#ifndef P3_TWICE
#define P3_TWICE 1
#endif
    if (IN(3)) REP(3) { for (int item = F.vcu; item < 256 * P3_TWICE; item += F.G) p3_scan_item(F, item & 255); }
    SEAM(3); STAMP(4); CLKS(4);
    if (IN(4)) REP(4) {
        {
            const fox::Srd R = __builtin_amdgcn_make_buffer_rsrc((void*)ws, (short)0, (int)WS_END, 0x00020000);
            unsigned* QC = (unsigned*)(ws + WS_CTL + CTL_QCTR); const int* JLO = (const int*)(ws + WS_JLO);
            const float* CF = (const float*)(ws + WS_CFOX); const float* GO = F.inp[11];
            constexpr int QN = 192 * P4_TWICE, NONE = 1 << 20;
            auto mk_item = [&](int g) { const int qx = g / QN, i = (g - qx * QN) % 192, qb = 15 - (i >> 2), bh = 4 * qx + (i & 3), b = bh >> 3, h = bh & 7;
                fox::Item I; I.rowb = (unsigned)b * SEQ * 2048u + (unsigned)h * (FOXD * 2); I.o = (unsigned)WS_CONCAT + (unsigned)b * SEQ * 4096u + (unsigned)h * (FOXD * 2);
                I.CS = CF + (size_t)bh * SEQ; I.G = GO + h * FOXD; I.P0 = qb * 256; I.jlo = JLO[bh * 16 + qb]; return I; };
            auto is_fox = [&](int g) { return g < NONE && ((g % QN) % 192) < 64; };
            auto pull = [&]() { if (F.tid == 0) { unsigned qc = MISC[17], left = MISC[18]; int g = NONE;
                    while (left > 0u) { const unsigned i = atomicAdd(QC + qc * 64, 1u); if (i < (unsigned)QN) { g = (int)(qc * QN + i); break; } qc = (qc + 1u) & 7u; --left; }
                    MISC[17] = qc; MISC[18] = left; MISC[16] = (unsigned)g; } };
            if (F.tid == 0) { MISC[17] = xb_xcc_id() & 7u; MISC[18] = 8u; }
            pull();
            __syncthreads();
            int cur = __builtin_amdgcn_readfirstlane((int)MISC[16]);
            __syncthreads();
            while (cur < NONE) {
                if (is_fox(cur)) {
                    fox::Item I = mk_item(cur); fox::Seam S;
                    fox::fox_prime(R, I, (char*)lds, S, F.wave);
                    for (;;) {
                        pull();
                        auto next_item = [&](const fox::Item& self, int& nidx) { nidx = __builtin_amdgcn_readfirstlane((int)MISC[16]); return is_fox(nidx) ? mk_item(nidx) : self; };
                        const int nidx = fox::fox_block(R, I, next_item, (char*)lds, S, F.wave);
                        if (!is_fox(nidx)) { cur = nidx; break; }
                        I = mk_item(nidx);
                    }
                    VM_WAIT(); __syncthreads();
                } else {
                    const int qx = cur / QN, it = qx * 128 + ((cur - qx * QN) % 192 - 64), c = it & 63, h = (it >> 6) & 3, b = it >> 8;
                    pull();
                    mls::chunk_out(b, h, c, (const bf16*)(ws + WS_QP), (const bf16*)(ws + WS_KPP), (const bf16*)(ws + WS_VT), (const bf16*)((unsigned char*)F.out + OUT_CST),
                                   (const float*)(ws + WS_NST), (const bf16*)(ws + WS_MO), F.inp[12], (bf16*)(ws + WS_CONCAT), F.lds, F.wave);
                    cur = __builtin_amdgcn_readfirstlane((int)MISC[16]);
                    __syncthreads();
                }
            }
        }
    }
    SEAM(4); STAMP(5); CLKS(5);
    if (IN(5)) REP(5) {
        pg8::Gemm g{ws, (unsigned)WS_CONCAT, (unsigned)WS_WOUT, DM, DM, DM}; pg8::StdOrder S; S.init(MTOK, DM, DM, DM, F.G, (int)blockIdx.x, TWICE_P5);
        pg8::EpiResid<true, false> E{F.inp[0], (bf16*)(ws + WS_X1B), SSQ1, DM, 1.0f, ws + WS_X1Q};
        pg8::gemm_phase<pg8::EpiResid<true, false>, pg8::StdOrder, true>(F.lds, g, S, E, F.wave);
    }
    SEAM(5); STAMP(6); CLKS(6);
    if (IN(6)) REP(6) {
        pg8::Gemm g{ws, (unsigned)WS_X1Q, (unsigned)WS_WXQ, DM / 2, DM / 2, DM / 2}; pg8::StdOrder S; S.init(MTOK, DM, DM / 2, DM / 2, F.G, (int)blockIdx.x, TWICE_P6);
        pg8::EpiQ E{(bf16*)(ws + WS_Q), SSQ1, SSQQ, 1.0f / W8_SCALE};
        pg8::gemm_phase<pg8::EpiQ, pg8::StdOrder, true, true>(F.lds, g, S, E, F.wave);
    }
    SEAM(6); STAMP(7); CLKS(7);
    if (IN(7)) REP(7) {
        pg8::Gemm g{ws, (unsigned)WS_Q, (unsigned)WS_KHAT, DM, DM, XD}; pg8::ScoreOrder S{F.G, (int)blockIdx.x};
        pg8::EpiSoftmax E{(bf16*)(ws + WS_P), SSQQ};
        if (F.G >= 256) pg8::gemm_phase<pg8::EpiSoftmax, pg8::ScoreOrder, false>(F.lds, g, S, E, F.wave);
    }
    SEAM(7); STAMP(8); CLKS(8);
    if (IN(8)) REP(8) {
        pg8::Gemm g{ws, (unsigned)WS_P, (unsigned)WS_VTM, 1024, NMEM, NMEM}; pg8::PvOrder S{F.G, (int)blockIdx.x, TWICE_P8};
        pg8::EpiStoreFp8 E{ws + WS_CO, DM, CO8_SCALE};
        pg8::gemm_phase<pg8::EpiStoreFp8, pg8::PvOrder, true>(F.lds, g, S, E, F.wave);
    }
    SEAM(8); STAMP(9); CLKS(9);
#ifdef EXTRA_BARS
    for (int eb = 0; eb < EXTRA_BARS; ++eb) xcd_barrier(xbar);
#endif
    if (IN(9)) REP(9) {
        pg8::Gemm g{ws, (unsigned)WS_CO, (unsigned)WS_WXO, DM / 2, DM / 2, DM / 2}; pg8::StdOrder S; S.init(MTOK, DM, DM / 2, DM / 2, F.G, (int)blockIdx.x);
        pg8::EpiResid<false, false> E{(const bf16*)(ws + WS_X1B), (bf16*)(ws + WS_X2B), SSQ2, DM, 1.0f / (W8_SCALE * CO8_SCALE), nullptr};
        pg8::gemm_phase<pg8::EpiResid<false, false>, pg8::StdOrder, true, true>(F.lds, g, S, E, F.wave);
    }
    SEAM(9); STAMP(10); CLKS(10);
    if (IN(10)) REP(10) {
        pg8::Gemm g{ws, (unsigned)WS_X2B, (unsigned)WS_WUP, DM, DM, DM}; pg8::StdOrder S; S.init(MTOK, DFF, DM, DM, F.G, (int)blockIdx.x, TWICE_P10);
        pg8::EpiUp E{(bf16*)(ws + WS_H), SSQ2};
        pg8::gemm_phase<pg8::EpiUp, pg8::StdOrder, true>(F.lds, g, S, E, F.wave);
    }
    SEAM(10); STAMP(11); CLKS(11);
    if (IN(11)) REP(11) {
        pg8::Gemm g{ws, (unsigned)WS_H, (unsigned)WS_WDN, DFF, DFF, DFF}; pg8::StdOrder S; S.init(MTOK, DM, DFF, DFF, F.G, (int)blockIdx.x, TWICE_P11);
        pg8::EpiResid<false, true> E{(const bf16*)(ws + WS_X2B), F.out, nullptr, DM, 1.0f, nullptr};
        pg8::gemm_phase<pg8::EpiResid<false, true>, pg8::StdOrder, true>(F.lds, g, S, E, F.wave);
    }
#ifdef CLK_PHASE
    xcd_barrier(xbar); CLKS(12);
    if (blockIdx.x == 0 && threadIdx.x == 0) F.out[0] += rintf((float)(ck1 - ck0) / (float)(cr1 - cr0));
#endif
#ifdef PROBE_PHASE
    xcd_barrier(xbar); STAMP(12);
    if (blockIdx.x == 0 && threadIdx.x < 64) {
        const float ta = 8.0f * rintf((float)(pt1 - pt0) * 0.01f * 0.125f), tb = 0.8f * rintf((float)(pu1 - pu0) * 0.01f * 0.125f);
        if (threadIdx.x == 0) F.out[0] += ta;
        if (PROBE_B != 99) for (int i = threadIdx.x; i < 10000; i += 64) F.out[64 + i] += tb;
    }
#endif
#undef IN
#undef SEAM
}

extern "C" void kernel_launch(void* const* d_in, const int* in_sizes, int n_in, void* d_out, int out_size, void* d_ws, size_t ws_size, hipStream_t stream) {
    static int grid = 0;
    if (grid == 0) {
        if (n_in != 24 || in_sizes[0] != MTOK * DM || out_size != MTOK * DM || ws_size < WS_END) {
            fprintf(stderr, "kernel_launch: unexpected shapes (n_in %d, in0 %d, out %d, ws %zu; need ws >= %zu); nothing launched\n", n_in, n_in > 0 ? in_sizes[0] : -1, out_size, ws_size, (size_t)WS_END); grid = -1; return; }
        int dev = 0, cus = 0, per_cu = 0;
        if (hipGetDevice(&dev) != hipSuccess || hipDeviceGetAttribute(&cus, hipDeviceAttributeMultiprocessorCount, dev) != hipSuccess) { grid = -1; return; }
        if (hipFuncSetAttribute((const void*)fwd_kernel, hipFuncAttributeMaxDynamicSharedMemorySize, LDS_BYTES) != hipSuccess) { fprintf(stderr, "kernel_launch: hipFuncSetAttribute failed\n"); grid = -1; return; }
        if (hipOccupancyMaxActiveBlocksPerMultiprocessor(&per_cu, (const void*)fwd_kernel, NTHREADS, LDS_BYTES) != hipSuccess || per_cu < 1) { fprintf(stderr, "kernel_launch: occupancy query says %d blocks per CU\n", per_cu); per_cu = 1; }
        (void)hipGetLastError();
        grid = cus;
    }
    if (grid < 0) return;
    (void)hipMemsetAsync((char*)d_ws + WS_CTL, 0, CTL_BYTES, stream);
    Args a{};
    for (int i = 0; i < 24; ++i) a.in[i] = (const float*)d_in[i];
    a.out = (float*)d_out; a.ws = (unsigned char*)d_ws;
#if MK_PER_PHASE
    for (int ph = 0; ph < N_PHASES; ++ph) { a.ph_lo = ph; a.ph_hi = ph + 1;
        hipLaunchKernelGGL(fwd_kernel, dim3(grid), dim3(NTHREADS), LDS_BYTES, stream, a); }
#else
    a.ph_lo = 0; a.ph_hi = N_PHASES;
    void* kargs[] = {&a};
    hipError_t e = hipLaunchCooperativeKernel((const void*)fwd_kernel, dim3(grid), dim3(NTHREADS), kargs, LDS_BYTES, stream);
    if (e != hipSuccess) fprintf(stderr, "kernel_launch: cooperative launch failed: %s (grid %d)\n", hipGetErrorString(e), grid);
#endif
}
```

```cpp
#include <hip/hip_runtime.h>
#include <hip/hip_cooperative_groups.h>
#include <cstdio>
#include <cstdint>
namespace cg = cooperative_groups;

constexpr int BATCH = 4, SEQ = 4096, DM = 2048, MTOK = BATCH * SEQ;
constexpr int NMEM = 256, MROWS = BATCH * NMEM;
constexpr int FOXH = 8, FOXD = 128, MLH = 4, MLDV = 256, MLDK = 128, XH = 4, XD = 512, DFF = 8192;
constexpr int IN_WIDTH = 6160, NPROJ = 6144, NCHUNK = SEQ / 64;
constexpr float EPS = 1e-6f;
constexpr float LOG2E = 1.4426950408889634f;

constexpr size_t MiB = (size_t)1 << 20;
constexpr size_t WS_WIN = 0, WS_WOUT = 24 * MiB, WS_WXQ = 32 * MiB, WS_WXKV = 40 * MiB, WS_WXO = 56 * MiB, WS_WUP = 64 * MiB, WS_WDN = 96 * MiB;
constexpr size_t WS_PROJ = 128 * MiB;
constexpr size_t WS_FQ = 128 * MiB, WS_FK = 160 * MiB, WS_FV = 192 * MiB, WS_MQK = 224 * MiB, WS_MV = 256 * MiB, WS_MO = 288 * MiB;
constexpr size_t WS_XN = 320 * MiB;
constexpr size_t WS_QP = 320 * MiB, WS_KPP = 336 * MiB;
constexpr size_t WS_KT = 352 * MiB;
constexpr size_t WS_VT = 368 * MiB;
constexpr size_t WS_MISC = 464 * MiB;
constexpr size_t WS_CTL = WS_MISC, CTL_BYTES = 2 * MiB;
constexpr size_t CTL_QCTR = 32 * 1024;
constexpr size_t CTL_SSQ1 = 64 * 1024, CTL_SSQ2 = 128 * 1024, CTL_SSQQ = 192 * 1024, CTL_SSQX = 448 * 1024;
constexpr size_t WS_GATES = WS_MISC + 1 * MiB;
constexpr size_t WS_CFOX = WS_MISC + 3 * MiB;
constexpr size_t WS_EB = WS_MISC + 4 * MiB;
constexpr size_t WS_KSUM = WS_MISC + 5 * MiB;
constexpr size_t WS_NST = WS_MISC + 6 * MiB;
constexpr size_t WS_JLO = WS_MISC + 7 * MiB;
constexpr size_t WS_MN = WS_MISC + 8 * MiB;
constexpr size_t WS_KHAT = WS_MISC + 12 * MiB;
constexpr size_t WS_VTM = WS_MISC + 16 * MiB;
constexpr size_t WS_END = 512 * MiB;
constexpr size_t WS_CONCAT = 224 * MiB;
constexpr size_t WS_X1B = 128 * MiB;
constexpr size_t WS_Q = 192 * MiB;
constexpr size_t WS_CO = 256 * MiB;
constexpr size_t WS_P = 320 * MiB;
constexpr size_t WS_X1Q = 288 * MiB;
constexpr size_t WS_X2B = 128 * MiB;
constexpr size_t WS_H = 192 * MiB;
constexpr size_t WS_SLAB = 400 * MiB;
constexpr size_t WS_CST = 400 * MiB;

#ifndef P3_SCAN_REP
#define P3_SCAN_REP 1
#endif
#ifndef JLO_DISABLE
#define JLO_DISABLE 0
#endif
constexpr float W8_SCALE = 64.0f, CO8_SCALE = 8.0f;
constexpr int LDS_BYTES = 147456;
constexpr int NTHREADS = 512;

#define GAS __attribute__((address_space(1)))
#define LAS __attribute__((address_space(3)))
typedef unsigned short bf16;
typedef unsigned v4u __attribute__((ext_vector_type(4)));
typedef unsigned v2u __attribute__((ext_vector_type(2)));
typedef float v4f __attribute__((ext_vector_type(4)));
typedef short v8s __attribute__((ext_vector_type(8)));
typedef short v4s __attribute__((ext_vector_type(4)));
#define LDS_WAIT() asm volatile("s_waitcnt lgkmcnt(0)" ::: "memory")
#define VM_WAIT() asm volatile("s_waitcnt vmcnt(0)" ::: "memory")
__device__ __forceinline__ unsigned f2bf(float f) { unsigned u = __builtin_bit_cast(unsigned, f); return (u + 0x7fffu + ((u >> 16) & 1u)) >> 16; }
__device__ __forceinline__ unsigned pk2(float lo, float hi) { return f2bf(lo) | (f2bf(hi) << 16); }
__device__ __forceinline__ float bf2f(unsigned h) { return __builtin_bit_cast(float, h << 16); }
__device__ __forceinline__ float bflo(unsigned w) { return __builtin_bit_cast(float, w << 16); }
__device__ __forceinline__ float bfhi(unsigned w) { return __builtin_bit_cast(float, w & 0xffff0000u); }
__device__ __forceinline__ float wave_sum(float v) {
#pragma unroll
    for (int o = 1; o < 64; o <<= 1) v += __shfl_xor(v, o);
    return v;
}
__device__ __forceinline__ int lane_id() { return (int)__builtin_amdgcn_mbcnt_hi(~0u, __builtin_amdgcn_mbcnt_lo(~0u, 0u)); }
__device__ __forceinline__ int wg_tid(int wv) { int t = wv * 64 + lane_id(); asm volatile("" : "+v"(t)); return t; }
__device__ __forceinline__ float logsigmoidf(float x) { return x >= 0.f ? -log1pf(__expf(-x)) : x - log1pf(__expf(x)); }
__device__ __forceinline__ float sigmoidf_(float x) { return 1.f / (1.f + __expf(-x)); }
__device__ __forceinline__ float rinv_of(const float* ssqx, size_t row) { return 1.0f / sqrtf(ssqx[row] * (1.0f / DM) + EPS); }
#define MK_PER_PHASE 0
namespace pg8 {
#define PG8_LAS __attribute__((address_space(3)))
typedef unsigned short bf16_t;
typedef short bf16x8 __attribute__((ext_vector_type(8)));
typedef float f32x4 __attribute__((ext_vector_type(4)));
typedef float f32x2 __attribute__((ext_vector_type(2)));
typedef unsigned u32x4 __attribute__((ext_vector_type(4)));
typedef unsigned u32x2 __attribute__((ext_vector_type(2)));
constexpr int BM = 256, BK = 64, HALF = 128, HTB = HALF * BK * 2, STAGE_BYTES = 8 * HTB, NXCD = 8, WGM = 8;

__host__ __device__ __forceinline__ int lds_byte(int r, int c) { const int st = (r >> 4) * 2 + (c >> 5), rr = r & 15, cc = c & 31, ob = rr * 64 + cc * 2; return st * 1024 + (ob ^ (((ob >> 9) & 1) << 5)); }
__host__ __device__ __forceinline__ void stage_rc(int b, int& R, int& C) { const int st = b / 1024, sb = b % 1024, swz = sb ^ (((sb >> 9) & 1) << 5); R = (st >> 1) * 16 + swz / 64; C = (st & 1) * 32 + (swz % 64) / 2; }
__host__ __device__ __forceinline__ int perm32(int rho) { const int n = rho >> 4, i = rho & 15; return 8 * (i >> 2) + 4 * n + (i & 3); }

struct Unit { int row0, col0; long aoff, boff; int aux; };
struct Gemm { const void* base; unsigned aoff, boff; int lda, ldb, K; };

struct StdOrder {
    int nM, nN, nwg, G, c, lda, ldb, rsh;
    __device__ void init(int M, int N, int lda_, int ldb_, int G_, int c_, int rsh_ = 0) { nM = M / BM; nN = N / BM; nwg = nM * nN; G = G_; c = c_; lda = lda_; ldb = ldb_; rsh = rsh_; }
    __device__ bool next(int i, Unit& u) const {
        const long L = (long)(i >> rsh) * G + c; if (L >= nwg) return false;
        int wgid = (int)L; { const int q = nwg / NXCD, r = nwg % NXCD, xcd = wgid % NXCD, off = wgid / NXCD; wgid = (xcd < r ? xcd * (q + 1) : r * (q + 1) + (xcd - r) * q) + off; }
        const int nig = WGM * nN, gid = wgid / nig, fm = gid * WGM, gsz = (nM - fm) < WGM ? (nM - fm) : WGM;
        const int pm = fm + ((wgid % nig) % gsz), pn = (wgid % nig) / gsz;
        u.row0 = pm * BM; u.col0 = pn * BM; u.aoff = (long)pm * BM * lda; u.boff = (long)pn * BM * ldb; u.aux = i & ((1 << rsh) - 1); return true;
    }
};

__device__ __forceinline__ unsigned cvt_pk_bf16(float lo, float hi) { unsigned r; asm volatile("v_cvt_pk_bf16_f32 %0, %1, %2" : "=v"(r) : "v"(lo), "v"(hi)); return r; }

typedef int v8i_t __attribute__((ext_vector_type(8)));
typedef int v4i_t __attribute__((ext_vector_type(4)));
template <class Epi, class Sched, bool ALIGN_EPI, bool FP8 = false>
__device__ __forceinline__ void gemm_phase(PG8_LAS unsigned char* lds, const Gemm g, const Sched& S, const Epi& E, int wv) {
    const int tid = wg_tid(wv), wid = wv, lane = tid & 63, wr = wid >> 2, wc = wid & 3, fr = lane & 15, fq = lane >> 4;
    const int K = g.K, nt = K / BK;
    unsigned voffA, voffB;
    { int R, C; stage_rc(tid * 16, R, C); const int Rb = Epi::PERM ? ((R & ~31) + perm32(R & 31)) : R;
      voffA = (unsigned)(R * g.lda + C) * 2u; voffB = (unsigned)(Rb * g.ldb + C) * 2u; }
    const unsigned pA = 64u * (unsigned)g.lda * 2u, pB = 64u * (unsigned)g.ldb * 2u;
    const unsigned voffA_v = voffA, voffB_v = voffB, voffA_p = pA, voffB_p = pB;
    const unsigned kstep = (unsigned)(BK * 2);
    const unsigned hA = (unsigned)HALF * g.lda * 2, hB = (unsigned)HALF * g.ldb * 2;
    const __amdgpu_buffer_rsrc_t rsrc = __builtin_amdgcn_make_buffer_rsrc((void*)g.base, (short)0, 0x7fffffff, 0x00020000);
    const unsigned ldsw = (unsigned)wid * 1024u;
    const int aoff = lds_byte(wr * 64 + fr, fq * 8), boff = lds_byte(wc * 32 + fr, fq * 8);
#define PG8_SA(b, h) (((b) * 2 + (h)) * HTB)
#define PG8_SB(b, h) ((4 + (b) * 2 + (h)) * HTB)
#define PG8_STAGE(bufoff, gbase, voff) do { _Pragma("unroll") for (int _i = 0; _i < 2; ++_i) \
        __builtin_amdgcn_raw_ptr_buffer_load_lds(rsrc, (PG8_LAS void*)(lds + (bufoff) + ldsw + _i * 8192), 16, voff##_v, (gbase) + _i * voff##_p, 0, 0); } while (0)
#define PG8_LDA(dst, b, h) do { _Pragma("unroll") for (int m = 0; m < 4; ++m) dst[m] = PG8_CAT(*(const PG8_LAS v4i_t*)(lds + PG8_SA(b, h) + aoff + m * 2048), *(const PG8_LAS v4i_t*)(lds + PG8_SA(b, h) + aoff + m * 2048 + 1024)); } while (0)
#define PG8_LDB(dst, b, h) do { _Pragma("unroll") for (int n = 0; n < 2; ++n) dst[n] = PG8_CAT(*(const PG8_LAS v4i_t*)(lds + PG8_SB(b, h) + boff + n * 2048), *(const PG8_LAS v4i_t*)(lds + PG8_SB(b, h) + boff + n * 2048 + 1024)); } while (0)
#define PG8_CAT(x0, x1) __builtin_shufflevector((x0), (x1), 0, 1, 2, 3, 4, 5, 6, 7)
#define PG8_K0(x) __builtin_bit_cast(bf16x8, __builtin_shufflevector((x), (x), 0, 1, 2, 3))
#define PG8_K1(x) __builtin_bit_cast(bf16x8, __builtin_shufflevector((x), (x), 4, 5, 6, 7))
#define PG8_MMA(ai, bj, At, Bt) do { __builtin_amdgcn_s_setprio(1); _Pragma("unroll") for (int m = 0; m < 4; ++m) _Pragma("unroll") for (int n = 0; n < 2; ++n) { \
        if constexpr (FP8) asm volatile("v_mfma_f32_16x16x128_f8f6f4 %0, %1, %2, %0" : "+v"(acc[ai][bj][m][n]) : "v"(Bt[n]), "v"(At[m]));     \
        else { acc[ai][bj][m][n] = __builtin_amdgcn_mfma_f32_16x16x32_bf16(PG8_K0(Bt[n]), PG8_K0(At[m]), acc[ai][bj][m][n], 0, 0, 0); \
               acc[ai][bj][m][n] = __builtin_amdgcn_mfma_f32_16x16x32_bf16(PG8_K1(Bt[n]), PG8_K1(At[m]), acc[ai][bj][m][n], 0, 0, 0); } } \
        __builtin_amdgcn_s_setprio(0); } while (0)
#define PG8_WAIT_V(n) asm volatile("s_waitcnt vmcnt(" #n ")" ::: "memory")
#define PG8_WAIT_L(n) asm volatile("s_waitcnt lgkmcnt(" #n ")" ::: "memory")
#define PG8_BAR __builtin_amdgcn_s_barrier()
#define PG8_SCHED __builtin_amdgcn_sched_barrier(0)
    Unit cur, nxt; int ui = 0;
    if (!S.next(0, cur)) return;
    f32x4 acc[2][2][4][2];
#pragma unroll
    for (int a = 0; a < 2; ++a)
#pragma unroll
        for (int b = 0; b < 2; ++b)
#pragma unroll
            for (int m = 0; m < 4; ++m)
#pragma unroll
                for (int n = 0; n < 2; ++n) acc[a][b][m][n] = (f32x4){0.f, 0.f, 0.f, 0.f};
    v8i_t At[4], B0[2], B1[2];
    unsigned cA = g.aoff + (unsigned)cur.aoff * 2u, cB = g.boff + (unsigned)cur.boff * 2u;
    PG8_STAGE(PG8_SB(0, 0), cB, voffB); PG8_STAGE(PG8_SB(0, 1), cB + hB, voffB); PG8_STAGE(PG8_SA(0, 0), cA, voffA); PG8_STAGE(PG8_SA(0, 1), cA + hA, voffA);
    if (wr == 1) PG8_BAR;
    PG8_WAIT_V(2); PG8_BAR;
    PG8_STAGE(PG8_SB(1, 0), cB + kstep, voffB); PG8_STAGE(PG8_SA(1, 0), cA + kstep, voffA); PG8_STAGE(PG8_SB(1, 1), cB + hB + kstep, voffB);
    PG8_WAIT_V(6); PG8_BAR;
    for (;;) {
        const bool has_next = S.next(ui + 1, nxt);
        const unsigned nA = has_next ? g.aoff + (unsigned)nxt.aoff * 2u : cA, nB = has_next ? g.boff + (unsigned)nxt.boff * 2u : cB;
        for (int t = 0; t < nt; t += 2) {
            const bool last = (t == nt - 2);
            const unsigned a1 = cA + (unsigned)(t + 1) * kstep;
            const unsigned a2 = last ? nA : cA + (unsigned)(t + 2) * kstep, b2 = last ? nB : cB + (unsigned)(t + 2) * kstep;
            const unsigned a3 = a2 + kstep, b3 = b2 + kstep;
            PG8_LDB(B0, 0, 0); PG8_LDB(B1, 0, 1); PG8_SCHED; PG8_LDA(At, 0, 0); PG8_STAGE(PG8_SA(1, 1), a1 + hA, voffA);
            PG8_WAIT_V(8); PG8_WAIT_L(0); PG8_BAR; PG8_MMA(0, 0, At, B0); PG8_MMA(0, 1, At, B1); PG8_BAR; PG8_SCHED;
            PG8_LDA(At, 0, 1); PG8_STAGE(PG8_SB(0, 0), b2, voffB); PG8_STAGE(PG8_SB(0, 1), b2 + hB, voffB); PG8_STAGE(PG8_SA(0, 0), a2, voffA);
            PG8_WAIT_V(8); PG8_WAIT_L(0); PG8_BAR; PG8_MMA(1, 0, At, B0); PG8_MMA(1, 1, At, B1); PG8_BAR; PG8_SCHED;
            PG8_LDB(B0, 1, 0); PG8_LDB(B1, 1, 1); PG8_SCHED; PG8_LDA(At, 1, 0); PG8_STAGE(PG8_SA(0, 1), a2 + hA, voffA);
            PG8_WAIT_V(8); PG8_WAIT_L(0); PG8_BAR; PG8_MMA(0, 0, At, B0); PG8_MMA(0, 1, At, B1); PG8_BAR; PG8_SCHED;
            PG8_LDA(At, 1, 1); PG8_STAGE(PG8_SB(1, 0), b3, voffB); PG8_STAGE(PG8_SB(1, 1), b3 + hB, voffB); PG8_STAGE(PG8_SA(1, 0), a3, voffA);
            PG8_WAIT_V(8); PG8_WAIT_L(0); PG8_BAR; PG8_MMA(1, 0, At, B0); PG8_MMA(1, 1, At, B1); PG8_BAR; PG8_SCHED;
        }
        if constexpr (ALIGN_EPI) { if (wr == 0) PG8_BAR; }
        if constexpr (FP8) asm volatile("s_nop 15\n\ts_nop 7" ::: "memory");
        if constexpr (!Epi::AFTER_DRAIN) { E(acc, cur, wr, wc, fr, fq); }
        if (!has_next) break;
#pragma unroll
        for (int a = 0; a < 2; ++a)
#pragma unroll
            for (int b = 0; b < 2; ++b)
#pragma unroll
                for (int m = 0; m < 4; ++m)
#pragma unroll
                    for (int n = 0; n < 2; ++n) acc[a][b][m][n] = (f32x4){0.f, 0.f, 0.f, 0.f};
        cur = nxt; cA = nA; cB = nB; ++ui;
        if constexpr (ALIGN_EPI) { if (wr == 1) PG8_BAR; }
    }
    PG8_WAIT_V(0);
    if constexpr (!ALIGN_EPI) { if (wr == 0) PG8_BAR; }
    PG8_BAR;
    if constexpr (Epi::AFTER_DRAIN) { E.fused(acc, cur, wr, wc, fr, fq, lds, wid, lane); }
#undef PG8_SA
#undef PG8_SB
#undef PG8_STAGE
#undef PG8_LDA
#undef PG8_LDB
#undef PG8_MMA
#undef PG8_CAT
#undef PG8_K0
#undef PG8_K1
#undef PG8_WAIT_V
#undef PG8_WAIT_L
#undef PG8_BAR
#undef PG8_SCHED
}
}
namespace pg8 {
struct XkvOrder {
    int G, c;
    __device__ bool next(int i, Unit& u) const {
        const int L = i * G + c; if (L >= 256) return false;
        const int kq = L & 3, tile = L >> 2, pm = tile & 3, pn = tile >> 2;
        u.row0 = pm * 256; u.col0 = pn * 256; u.aoff = (long)pm * 256 * DM + kq * 512; u.boff = (long)pn * 256 * DM + kq * 512; u.aux = kq; return true;
    }
};
struct ScoreOrder {
    int G, c;
    __device__ bool next(int i, Unit& u) const {
        const int L = i * G + c; if (L >= 256) return false;
        const int b = L >> 6, h = (L >> 4) & 3, mt = L & 15;
        u.row0 = b * SEQ + mt * 256; u.col0 = h * 256; u.aoff = (long)u.row0 * DM + h * XD; u.boff = (long)(b * NMEM) * DM + h * XD; u.aux = h; return true;
    }
};
struct PvOrder {
    int G, c, rsh;
    __device__ bool next(int i, Unit& u) const {
        const int L = (i >> rsh) * G + c; if (L >= 512) return false;
        const int nt = L & 1, mt = (L >> 1) & 15, h = (L >> 5) & 3, b = L >> 7;
        u.row0 = b * SEQ + mt * 256; u.col0 = h * XD + nt * 256; u.aoff = (long)u.row0 * 1024 + h * 256; u.boff = ((long)(b * XH + h) * XD + nt * 256) * NMEM; u.aux = 0; return true;
    }
};

__device__ __forceinline__ unsigned pk4_fp8(float a, float b, float c, float d) { int w = __builtin_amdgcn_cvt_pk_fp8_f32(a, b, 0, false); w = __builtin_amdgcn_cvt_pk_fp8_f32(c, d, w, true); return (unsigned)w; }
struct EpiStoreBf16 {
    static constexpr bool PERM = true, AFTER_DRAIN = false;
    bf16_t* O; int ldc; int split_cols; size_t split_stride;
    __device__ __forceinline__ void operator()(const f32x4 (&acc)[2][2][4][2], const Unit& u, int wr, int wc, int fr, int fq) const {
        int colt = u.col0; bf16_t* base = O;
        if (split_cols) { const int t = colt / split_cols; base += (size_t)t * split_stride; colt -= t * split_cols; }
        const int row0 = u.row0 + wr * 64 + fr, col0 = colt + wc * 32 + 8 * fq;
#pragma unroll
        for (int ai = 0; ai < 2; ++ai)
#pragma unroll
            for (int m = 0; m < 4; ++m) { bf16_t* rowp = base + (size_t)(row0 + ai * HALF + m * 16) * ldc + col0;
#pragma unroll
                for (int bj = 0; bj < 2; ++bj) { const f32x4 v0 = acc[ai][bj][m][0], v1 = acc[ai][bj][m][1];
                    u32x4 w; w.x = cvt_pk_bf16(v0[0], v0[1]); w.y = cvt_pk_bf16(v0[2], v0[3]); w.z = cvt_pk_bf16(v1[0], v1[1]); w.w = cvt_pk_bf16(v1[2], v1[3]);
                    *(u32x4*)(rowp + bj * HALF) = w; } }
    }
};
struct EpiProj {
    static constexpr bool PERM = true, AFTER_DRAIN = false;
    bf16_t* O; const float* gq; const float* gk; const float* ssqx; PG8_LAS float* red;
    __device__ __forceinline__ void operator()(f32x4 (&acc)[2][2][4][2], const Unit& u, int wr, int wc, int fr, int fq) const {
        const int t = u.col0 >> 10, colt = u.col0 & 1023; bf16_t* base = O + (size_t)t * ((size_t)MTOK * 1024);
        const int row0 = u.row0 + wr * 64 + fr, col0 = colt + wc * 32 + 8 * fq;
#pragma unroll
        for (int ai = 0; ai < 2; ++ai)
#pragma unroll
            for (int m = 0; m < 4; ++m) { const float rx = __builtin_amdgcn_rsqf(ssqx[row0 + ai * HALF + m * 16] * (1.0f / DM) + EPS);
#pragma unroll
                for (int bj = 0; bj < 2; ++bj) { acc[ai][bj][m][0] = acc[ai][bj][m][0] * rx; acc[ai][bj][m][1] = acc[ai][bj][m][1] * rx; } }
        if (u.col0 < 2048) {
            const float* g = (t == 0 ? gq : gk) + wc * 32 + 8 * fq; const f32x4 g0 = *(const f32x4*)g, g1 = *(const f32x4*)(g + 4);
#pragma unroll
            for (int ai = 0; ai < 2; ++ai)
#pragma unroll
                for (int m = 0; m < 4; ++m) { const int rl = ai * HALF + wr * 64 + m * 16 + fr;
#pragma unroll
                    for (int bj = 0; bj < 2; ++bj) { const f32x4 v0 = acc[ai][bj][m][0], v1 = acc[ai][bj][m][1];
                        float s = (v0[0] * v0[0] + v0[1] * v0[1]) + (v0[2] * v0[2] + v0[3] * v0[3]) + (v1[0] * v1[0] + v1[1] * v1[1]) + (v1[2] * v1[2] + v1[3] * v1[3]);
                        s += __shfl_xor(s, 16); s += __shfl_xor(s, 32);
                        if (fq == 0) red[(rl * 2 + bj) * 4 + wc] = s; } }
            asm volatile("s_waitcnt lgkmcnt(0)" ::: "memory"); __builtin_amdgcn_s_barrier(); asm volatile("" ::: "memory");
#pragma unroll
            for (int ai = 0; ai < 2; ++ai)
#pragma unroll
                for (int m = 0; m < 4; ++m) { const int rl = ai * HALF + wr * 64 + m * 16 + fr;
#pragma unroll
                    for (int bj = 0; bj < 2; ++bj) { const f32x4 r4 = *(const PG8_LAS f32x4*)(red + (rl * 2 + bj) * 4);
                        const float ri = __builtin_amdgcn_rsqf(((r4[0] + r4[1]) + (r4[2] + r4[3])) * (1.0f / FOXD) + EPS);
                        acc[ai][bj][m][0] = acc[ai][bj][m][0] * ri * g0; acc[ai][bj][m][1] = acc[ai][bj][m][1] * ri * g1; } }
        }
#pragma unroll
        for (int ai = 0; ai < 2; ++ai)
#pragma unroll
            for (int m = 0; m < 4; ++m) { bf16_t* rowp = base + (size_t)(row0 + ai * HALF + m * 16) * 1024 + col0;
#pragma unroll
                for (int bj = 0; bj < 2; ++bj) { const f32x4 v0 = acc[ai][bj][m][0], v1 = acc[ai][bj][m][1];
                    u32x4 w; w.x = cvt_pk_bf16(v0[0], v0[1]); w.y = cvt_pk_bf16(v0[2], v0[3]); w.z = cvt_pk_bf16(v1[0], v1[1]); w.w = cvt_pk_bf16(v1[2], v1[3]);
                    *(u32x4*)(rowp + bj * HALF) = w; } }
    }
};
struct EpiStoreFp8 {
    static constexpr bool PERM = true, AFTER_DRAIN = false;
    unsigned char* O8; int ldc; float scale;
    __device__ __forceinline__ void operator()(const f32x4 (&acc)[2][2][4][2], const Unit& u, int wr, int wc, int fr, int fq) const {
        const int row0 = u.row0 + wr * 64 + fr, col0 = u.col0 + wc * 32 + 8 * fq;
#pragma unroll
        for (int ai = 0; ai < 2; ++ai)
#pragma unroll
            for (int m = 0; m < 4; ++m) { unsigned char* rowp = O8 + (size_t)(row0 + ai * HALF + m * 16) * ldc + col0;
#pragma unroll
                for (int bj = 0; bj < 2; ++bj) { const f32x4 v0 = acc[ai][bj][m][0] * scale, v1 = acc[ai][bj][m][1] * scale;
                    u32x2 w; w.x = pk4_fp8(v0[0], v0[1], v0[2], v0[3]); w.y = pk4_fp8(v1[0], v1[1], v1[2], v1[3]);
                    *(u32x2*)(rowp + bj * HALF) = w; } }
    }
};
struct EpiSlab {
    static constexpr bool PERM = false, AFTER_DRAIN = false;
    float* slab; int ldc; size_t slab_stride;
    __device__ __forceinline__ void operator()(const f32x4 (&acc)[2][2][4][2], const Unit& u, int wr, int wc, int fr, int fq) const {
        float* base = slab + (size_t)u.aux * slab_stride; const int col0 = u.col0 + wc * 32 + 4 * fq;
#pragma unroll
        for (int ai = 0; ai < 2; ++ai)
#pragma unroll
            for (int m = 0; m < 4; ++m) { float* rowp = base + (size_t)(u.row0 + ai * HALF + wr * 64 + m * 16 + fr) * ldc + col0;
#pragma unroll
                for (int bj = 0; bj < 2; ++bj)
#pragma unroll
                    for (int n = 0; n < 2; ++n) *(f32x4*)(rowp + bj * HALF + n * 16) = acc[ai][bj][m][n]; }
    }
};
template <bool BASEF, bool OUTF>
struct EpiResid {
    static constexpr bool PERM = true, AFTER_DRAIN = false;
    const void* base; void* out; float* ssq; int ldc; float ascale; unsigned char* out8;
    __device__ __forceinline__ void operator()(const f32x4 (&acc)[2][2][4][2], const Unit& u, int wr, int wc, int fr, int fq) const {
        const int col0 = u.col0 + wc * 32 + 8 * fq;
        float ssum[2][4];
#pragma unroll
        for (int ai = 0; ai < 2; ++ai) {
            f32x4 bv[4][2][2];
#pragma unroll
            for (int m = 0; m < 4; ++m) { const size_t off = (size_t)(u.row0 + ai * HALF + wr * 64 + m * 16 + fr) * ldc + col0;
#pragma unroll
                for (int bj = 0; bj < 2; ++bj) {
                    if constexpr (BASEF) { bv[m][bj][0] = *(const f32x4*)((const float*)base + off + bj * HALF); bv[m][bj][1] = *(const f32x4*)((const float*)base + off + bj * HALF + 4); }
                    else { const u32x4 w = *(const u32x4*)((const bf16_t*)base + off + bj * HALF);
                        bv[m][bj][0] = (f32x4){__builtin_bit_cast(float, w.x << 16), __builtin_bit_cast(float, w.x & 0xffff0000u), __builtin_bit_cast(float, w.y << 16), __builtin_bit_cast(float, w.y & 0xffff0000u)};
                        bv[m][bj][1] = (f32x4){__builtin_bit_cast(float, w.z << 16), __builtin_bit_cast(float, w.z & 0xffff0000u), __builtin_bit_cast(float, w.w << 16), __builtin_bit_cast(float, w.w & 0xffff0000u)}; } } }
#pragma unroll
            for (int m = 0; m < 4; ++m) { const size_t off = (size_t)(u.row0 + ai * HALF + wr * 64 + m * 16 + fr) * ldc + col0; float s = 0.f;
#pragma unroll
                for (int bj = 0; bj < 2; ++bj) { const f32x4 v0 = bv[m][bj][0] + acc[ai][bj][m][0] * ascale, v1 = bv[m][bj][1] + acc[ai][bj][m][1] * ascale;
                    if (out8) { u32x2 w8; w8.x = pk4_fp8(v0[0], v0[1], v0[2], v0[3]); w8.y = pk4_fp8(v1[0], v1[1], v1[2], v1[3]); *(u32x2*)(out8 + off + bj * HALF) = w8; }
                    if constexpr (OUTF) { *(f32x4*)((float*)out + off + bj * HALF) = v0; *(f32x4*)((float*)out + off + bj * HALF + 4) = v1; }
                    else { u32x4 w; w.x = cvt_pk_bf16(v0[0], v0[1]); w.y = cvt_pk_bf16(v0[2], v0[3]); w.z = cvt_pk_bf16(v1[0], v1[1]); w.w = cvt_pk_bf16(v1[2], v1[3]);
                        *(u32x4*)((bf16_t*)out + off + bj * HALF) = w; }
                    s += (v0[0] * v0[0] + v0[1] * v0[1]) + (v0[2] * v0[2] + v0[3] * v0[3]) + (v1[0] * v1[0] + v1[1] * v1[1]) + (v1[2] * v1[2] + v1[3] * v1[3]); }
                s += __shfl_xor(s, 16); s += __shfl_xor(s, 32); ssum[ai][m] = s; } }
        if (ssq && u.aux == 0) {
#pragma unroll
            for (int ai = 0; ai < 2; ++ai) { const float v = fq == 0 ? ssum[ai][0] : fq == 1 ? ssum[ai][1] : fq == 2 ? ssum[ai][2] : ssum[ai][3];
                atomicAdd(ssq + u.row0 + ai * HALF + wr * 64 + fq * 16 + fr, v); }
        }
    }
};
struct EpiQ {
    static constexpr bool PERM = true, AFTER_DRAIN = false;
    bf16_t* O; const float* ssq_in; float* ssq_out; float oscale;
    __device__ __forceinline__ void operator()(const f32x4 (&acc)[2][2][4][2], const Unit& u, int wr, int wc, int fr, int fq) const {
        const int col0 = u.col0 + wc * 32 + 8 * fq; float* so = ssq_out + (size_t)(u.col0 / XD) * MTOK;
        float ssum[2][4];
#pragma unroll
        for (int ai = 0; ai < 2; ++ai)
#pragma unroll
            for (int m = 0; m < 4; ++m) { const int row = u.row0 + ai * HALF + wr * 64 + m * 16 + fr; const float ri = __builtin_amdgcn_rsqf(ssq_in[row] * (1.0f / DM) + EPS) * oscale;
                bf16_t* rowp = O + (size_t)row * DM + col0; float s = 0.f;
#pragma unroll
                for (int bj = 0; bj < 2; ++bj) { const f32x4 v0 = acc[ai][bj][m][0] * ri, v1 = acc[ai][bj][m][1] * ri;
                    u32x4 w; w.x = cvt_pk_bf16(v0[0], v0[1]); w.y = cvt_pk_bf16(v0[2], v0[3]); w.z = cvt_pk_bf16(v1[0], v1[1]); w.w = cvt_pk_bf16(v1[2], v1[3]);
                    *(u32x4*)(rowp + bj * HALF) = w;
                    s += (v0[0] * v0[0] + v0[1] * v0[1]) + (v0[2] * v0[2] + v0[3] * v0[3]) + (v1[0] * v1[0] + v1[1] * v1[1]) + (v1[2] * v1[2] + v1[3] * v1[3]); }
                s += __shfl_xor(s, 16); s += __shfl_xor(s, 32); ssum[ai][m] = s; }
        if (u.aux == 0)
#pragma unroll
        for (int ai = 0; ai < 2; ++ai) { const float v = fq == 0 ? ssum[ai][0] : fq == 1 ? ssum[ai][1] : fq == 2 ? ssum[ai][2] : ssum[ai][3];
            atomicAdd(so + u.row0 + ai * HALF + wr * 64 + fq * 16 + fr, v); }
    }
};
struct EpiUp {
    static constexpr bool PERM = true, AFTER_DRAIN = false;
    bf16_t* O; const float* ssq_in;
    __device__ __forceinline__ void operator()(const f32x4 (&acc)[2][2][4][2], const Unit& u, int wr, int wc, int fr, int fq) const {
        const int col0 = u.col0 + wc * 32 + 8 * fq;
#pragma unroll
        for (int ai = 0; ai < 2; ++ai)
#pragma unroll
            for (int m = 0; m < 4; ++m) { const int row = u.row0 + ai * HALF + wr * 64 + m * 16 + fr; const float ri = __builtin_amdgcn_rsqf(ssq_in[row] * (1.0f / DM) + EPS);
                bf16_t* rowp = O + (size_t)row * DFF + col0;
#pragma unroll
                for (int bj = 0; bj < 2; ++bj) { f32x4 v0 = acc[ai][bj][m][0] * ri, v1 = acc[ai][bj][m][1] * ri;
#pragma unroll
                    for (int e = 0; e < 4; ++e) { const float a = fmaxf(v0[e], 0.f), b = fmaxf(v1[e], 0.f); v0[e] = a * a; v1[e] = b * b; }
                    u32x4 w; w.x = cvt_pk_bf16(v0[0], v0[1]); w.y = cvt_pk_bf16(v0[2], v0[3]); w.z = cvt_pk_bf16(v1[0], v1[1]); w.w = cvt_pk_bf16(v1[2], v1[3]);
                    *(u32x4*)(rowp + bj * HALF) = w; } }
    }
};
struct EpiSoftmax {
    static constexpr bool PERM = true, AFTER_DRAIN = true;
    bf16_t* P; const float* ssqq;
    __device__ __forceinline__ void fused(f32x4 (&acc)[2][2][4][2], const Unit& u, int wr, int wc, int fr, int fq, PG8_LAS unsigned char* lds, int wid, int lane) const {
        PG8_LAS float* RM = (PG8_LAS float*)lds;
        PG8_LAS float* RS = (PG8_LAS float*)(lds + 4096);
        const float* sq = ssqq + (size_t)u.aux * MTOK;
        float mx[2][4];
#pragma unroll
        for (int ai = 0; ai < 2; ++ai)
#pragma unroll
            for (int m = 0; m < 4; ++m) { const int rl = ai * HALF + wr * 64 + m * 16 + fr; const int row = u.row0 + rl;
                const float sc = __builtin_amdgcn_rsqf(sq[row] * (1.0f / XD) + EPS) * (0.044194173824159216f * LOG2E);
                float mxx = -3.0e38f;
#pragma unroll
                for (int bj = 0; bj < 2; ++bj)
#pragma unroll
                    for (int n = 0; n < 2; ++n) { f32x4 v = acc[ai][bj][m][n] * sc; acc[ai][bj][m][n] = v; mxx = fmaxf(mxx, fmaxf(fmaxf(v[0], v[1]), fmaxf(v[2], v[3]))); }
                mxx = fmaxf(mxx, __shfl_xor(mxx, 16)); mxx = fmaxf(mxx, __shfl_xor(mxx, 32));
                if (fq == 0) RM[rl * 4 + wc] = mxx; }
        asm volatile("s_waitcnt lgkmcnt(0)" ::: "memory"); __builtin_amdgcn_s_barrier(); asm volatile("" ::: "memory");
#pragma unroll
        for (int ai = 0; ai < 2; ++ai)
#pragma unroll
            for (int m = 0; m < 4; ++m) { const int rl = ai * HALF + wr * 64 + m * 16 + fr;
                const f32x4 r4 = *(const PG8_LAS f32x4*)(RM + rl * 4); const float mxx = fmaxf(fmaxf(r4[0], r4[1]), fmaxf(r4[2], r4[3])); mx[ai][m] = mxx; float s = 0.f;
#pragma unroll
                for (int bj = 0; bj < 2; ++bj)
#pragma unroll
                    for (int n = 0; n < 2; ++n) { f32x4 v = acc[ai][bj][m][n];
#pragma unroll
                        for (int e = 0; e < 4; ++e) { v[e] = __builtin_amdgcn_exp2f(v[e] - mxx); s += v[e]; }
                        acc[ai][bj][m][n] = v; }
                s += __shfl_xor(s, 16); s += __shfl_xor(s, 32);
                if (fq == 0) RS[rl * 4 + wc] = s; }
        asm volatile("s_waitcnt lgkmcnt(0)" ::: "memory"); __builtin_amdgcn_s_barrier(); asm volatile("" ::: "memory");
        const int col0 = u.col0 + wc * 32 + 8 * fq;
#pragma unroll
        for (int ai = 0; ai < 2; ++ai)
#pragma unroll
            for (int m = 0; m < 4; ++m) { const int rl = ai * HALF + wr * 64 + m * 16 + fr;
                const f32x4 r4 = *(const PG8_LAS f32x4*)(RS + rl * 4); const float inv = 1.0f / ((r4[0] + r4[1]) + (r4[2] + r4[3]));
                bf16_t* rowp = P + (size_t)(u.row0 + rl) * 1024 + col0;
#pragma unroll
                for (int bj = 0; bj < 2; ++bj) { const f32x4 v0 = acc[ai][bj][m][0] * inv, v1 = acc[ai][bj][m][1] * inv;
                    u32x4 w; w.x = cvt_pk_bf16(v0[0], v0[1]); w.y = cvt_pk_bf16(v0[2], v0[3]); w.z = cvt_pk_bf16(v1[0], v1[1]); w.w = cvt_pk_bf16(v1[2], v1[3]);
                    *(u32x4*)(rowp + bj * HALF) = w; } }
        (void)mx; (void)wid; (void)lane;
    }
};
}
namespace fox {
typedef short bf16x8 __attribute__((ext_vector_type(8)));
typedef short s16x4 __attribute__((ext_vector_type(4)));
typedef float f32x16 __attribute__((ext_vector_type(16)));
typedef float f32x4 __attribute__((ext_vector_type(4)));
typedef unsigned u32x4 __attribute__((ext_vector_type(4)));
constexpr int D = 128, PITCH = 1024, OPITCH = 2048;
constexpr int NW = 8, QBLK = 32, KVBLK = 64, QB = NW * QBLK;
constexpr int SHM_V = KVBLK * D * 2, SHM_K = KVBLK * D * 2;
constexpr int LDS_BIAS = 0, LDS_WS = 512, LDS_V = 4096, LDS_K = LDS_V + 2 * SHM_V, LDS_Q = LDS_K + 2 * SHM_K, LDS_BYTES = LDS_Q + NW * 8192;
constexpr float SCALE = 0.08838834764831845f, C2 = LOG2E * SCALE, THR = 8.f;

#define KSWZ(row, colB) ((row) * 256 + ((colB) ^ (((row) & 7) << 4)))
#define SBAR() __builtin_amdgcn_sched_barrier(0)
__device__ __forceinline__ int v_st(int k, int c) { const int kk = (k & ~0xC) | ((k & 4) << 1) | ((k & 8) >> 1); return ((kk >> 3) * 4 + (c >> 5)) * 512 + ((kk & 7) * 32 + (c & 31)) * 2; }
__device__ __forceinline__ int v_rd_base(int lane) { return ((lane & 3) << 3) | (((lane >> 2) & 3) << 6) | (((lane >> 4) & 1) << 5) | (((lane >> 5) & 1) << 8); }
constexpr int v_rd_off(int d0, int ks, int half) { return d0 * 512 + ks * 4096 + half * 2048; }
__device__ __forceinline__ int crow(int r, int hi) { return (r & 3) + 8 * (r >> 2) + 4 * hi; }
__device__ __forceinline__ unsigned cvtpk(float lo, float hi) { unsigned r; asm volatile("v_cvt_pk_bf16_f32 %0, %1, %2" : "=v"(r) : "v"(lo), "v"(hi)); return r; }
__device__ __forceinline__ bf16x8 load8(const bf16* p) { return *reinterpret_cast<const bf16x8*>(p); }

__device__ __forceinline__ void mask_tile(f32x16& p0, f32x16& p1, int dq) {
    const float NEG = -__builtin_inff();
#pragma unroll
    for (int r = 0; r < 16; ++r) { const int c = (r & 3) + 8 * (r >> 2);
        if (dq - c < 0) p0[r] = NEG;
        if (dq - c - 32 < 0) p1[r] = NEG; }
}
__device__ __forceinline__ void partialSM(f32x16& p0, f32x16& p1, float& m_reg, float& mn, float& alpha) {
    float pmax = p0[0];
#pragma unroll
    for (int r = 1; r < 16; ++r) pmax = fmaxf(pmax, p0[r]);
#pragma unroll
    for (int r = 0; r < 16; ++r) pmax = fmaxf(pmax, p1[r]);
    { auto rr = __builtin_amdgcn_permlane32_swap(__float_as_uint(pmax), __float_as_uint(pmax), false, false);
      pmax = fmaxf(__uint_as_float(rr[0]), __uint_as_float(rr[1])); }
    if (__builtin_expect(__all((pmax - m_reg) * SCALE <= THR), 1)) { mn = m_reg; alpha = 1.f; }
    else { mn = fmaxf(m_reg, pmax); alpha = __builtin_amdgcn_exp2f((m_reg - mn) * C2); m_reg = mn; }
    const float mnL = -mn * C2;
#pragma unroll
    for (int r = 0; r < 16; ++r) p0[r] = fmaf(p0[r], C2, mnL);
#pragma unroll
    for (int r = 0; r < 16; ++r) p1[r] = fmaf(p1[r], C2, mnL);
#pragma unroll
    for (int r = 0; r < 16; ++r) p0[r] = __builtin_amdgcn_exp2f(p0[r]);
}
__device__ __forceinline__ void finishSM(f32x16& p0, f32x16& p1, float alpha, float& l_reg, bf16x8& pa0, bf16x8& pa1, bf16x8& pa2, bf16x8& pa3) {
#pragma unroll
    for (int r = 0; r < 16; ++r) p1[r] = __builtin_amdgcn_exp2f(p1[r]);
    float ps = 0;
#pragma unroll
    for (int r = 0; r < 16; ++r) ps += p0[r];
#pragma unroll
    for (int r = 0; r < 16; ++r) ps += p1[r];
    { auto rr = __builtin_amdgcn_permlane32_swap(__float_as_uint(ps), __float_as_uint(ps), false, false);
      ps = __uint_as_float(rr[0]) + __uint_as_float(rr[1]); }
    l_reg = l_reg * alpha + ps;
#define PK4(P, B_, OUT) do { unsigned a0 = cvtpk(P[B_+0], P[B_+1]), a1 = cvtpk(P[B_+2], P[B_+3]);                          \
        unsigned b0 = cvtpk(P[B_+4], P[B_+5]), b1 = cvtpk(P[B_+6], P[B_+7]);                                             \
        auto r0 = __builtin_amdgcn_permlane32_swap(a0, b0, false, false); auto r1 = __builtin_amdgcn_permlane32_swap(a1, b1, false, false); \
        u32x4 w = {r0[0], r1[0], r0[1], r1[1]}; OUT = *reinterpret_cast<bf16x8*>(&w); } while (0)
    PK4(p0, 0, pa0); PK4(p0, 8, pa1); PK4(p1, 0, pa2); PK4(p1, 8, pa3);
#undef PK4
}
template <int KB>
__device__ __forceinline__ void qkt(f32x16& p0, f32x16& p1, const char* K_lds, const float* bl, int r32, int hi, const char* qw) {
#pragma unroll
    for (int g = 0; g < 4; ++g) { const f32x4 b0 = *(const f32x4*)(bl + KB * 64 + 8 * g + 4 * hi), b1 = *(const f32x4*)(bl + KB * 64 + 32 + 8 * g + 4 * hi);
#pragma unroll
        for (int i = 0; i < 4; ++i) { p0[4 * g + i] = b0[i]; p1[4 * g + i] = b1[i]; } }
    const char* kb[4];
#pragma unroll
    for (int dd = 0; dd < 4; ++dd) kb[dd] = K_lds + KB * SHM_K + KSWZ(r32, (dd * 16 + hi * 8) * 2);
#pragma unroll
    for (int d0 = 0; d0 < 8; ++d0) { const char* a = kb[d0 & 3] + (d0 >> 2) * 128;
        bf16x8 b0 = *reinterpret_cast<const bf16x8*>(a);
        bf16x8 b1 = *reinterpret_cast<const bf16x8*>(a + 32 * 256);
        const bf16x8 qf = *reinterpret_cast<const bf16x8*>(qw + d0 * 1024);
        p0 = __builtin_amdgcn_mfma_f32_32x32x16_bf16(b0, qf, p0, 0, 0, 0);
        p1 = __builtin_amdgcn_mfma_f32_32x32x16_bf16(b1, qf, p1, 0, 0, 0); }
}
template <int VB>
__device__ __forceinline__ void pv_tile(f32x16* o, int vb0, bf16x8 pa0, bf16x8 pa1, bf16x8 pa2, bf16x8 pa3) {
#define TRRD(dst, off) asm volatile("ds_read_b64_tr_b16 %0, %1 offset:%2" : "=&v"(dst) : "v"(vb0), "i"(off) : "memory")
#define PV_D0(d0) do { s16x4 l0, l1, l2, l3, h0, h1, h2, h3; constexpr int b_ = VB * SHM_V + v_rd_off(d0, 0, 0); \
        TRRD(l0, b_); TRRD(h0, b_ + 2048); TRRD(l1, b_ + 4096); TRRD(h1, b_ + 6144); TRRD(l2, b_ + 8192); TRRD(h2, b_ + 10240); TRRD(l3, b_ + 12288); TRRD(h3, b_ + 14336); \
        asm volatile("s_waitcnt lgkmcnt(0)" ::: "memory"); SBAR();   \
        o[d0] = __builtin_amdgcn_mfma_f32_32x32x16_bf16(pa0, (bf16x8){l0[0], l0[1], l0[2], l0[3], h0[0], h0[1], h0[2], h0[3]}, o[d0], 0, 0, 0);   \
        o[d0] = __builtin_amdgcn_mfma_f32_32x32x16_bf16(pa1, (bf16x8){l1[0], l1[1], l1[2], l1[3], h1[0], h1[1], h1[2], h1[3]}, o[d0], 0, 0, 0);   \
        o[d0] = __builtin_amdgcn_mfma_f32_32x32x16_bf16(pa2, (bf16x8){l2[0], l2[1], l2[2], l2[3], h2[0], h2[1], h2[2], h2[3]}, o[d0], 0, 0, 0);   \
        o[d0] = __builtin_amdgcn_mfma_f32_32x32x16_bf16(pa3, (bf16x8){l3[0], l3[1], l3[2], l3[3], h3[0], h3[1], h3[2], h3[3]}, o[d0], 0, 0, 0); } while (0)
    PV_D0(0); PV_D0(1); PV_D0(2); PV_D0(3);
#undef PV_D0
#undef TRRD
}

struct Item { unsigned rowb, o; const float* CS; const float* G; int P0, jlo; };
struct Seam { bf16x8 qr[8]; bf16x8 st_v0, st_v1, st_k0, st_k1; };
typedef __amdgpu_buffer_rsrc_t Srd;
#define BL8(rs, vo, so) __builtin_bit_cast(bf16x8, __builtin_amdgcn_raw_buffer_load_b128((rs), (vo), (so), 0))
#define VMW() asm volatile("s_waitcnt vmcnt(0)" ::: "memory")
#define VMWN(n) asm volatile("s_waitcnt vmcnt(%0)" :: "i"(n) : "memory")
#define SLOAD_H(H, k0, bb) do { const unsigned so_ = (unsigned)(k0) * (PITCH * 2);                                               \
                         S.st_v0 = BL8(R, kvoff, (unsigned)WS_FV + (H).rowb + so_); S.st_v1 = BL8(R, kvoff, (unsigned)WS_FV + (H).rowb + so_ + 32 * PITCH * 2);   \
                         S.st_k0 = BL8(R, kvoff, (unsigned)WS_FK + (H).rowb + so_); S.st_k1 = BL8(R, kvoff, (unsigned)WS_FK + (H).rowb + so_ + 32 * PITCH * 2);   \
                         if (wid == 0) __builtin_amdgcn_global_load_lds((const unsigned*)((H).CS + (k0)) + lane, (__attribute__((address_space(3))) unsigned*)(B3 + (bb) * 64), 4, 0, 0); } while (0)
#define QLOAD(H) do { const unsigned so_ = (unsigned)((H).P0 + wid * QBLK) * (PITCH * 2);                                   \
        _Pragma("unroll") for (int d0 = 0; d0 < 8; ++d0) S.qr[d0] = BL8(R, qoff + d0 * 32, (unsigned)WS_FQ + (H).rowb + so_); } while (0)
#define SWRITE_HK(bf) do { *(bf16x8*)(K_lds + (bf) * SHM_K + kws) = S.st_k0; *(bf16x8*)(K_lds + (bf) * SHM_K + kws + 32 * 256) = S.st_k1; } while (0)
#define SWRITE_HV(bf) do { *(bf16x8*)(V_lds + (bf) * SHM_V + vst0) = S.st_v0; *(bf16x8*)(V_lds + (bf) * SHM_V + vst1) = S.st_v1; } while (0)
#define SWRITE_H(bf) do { SWRITE_HV(bf); SWRITE_HK(bf); } while (0)

__device__ __forceinline__ void fox_prime(const Srd R, const Item& H, char* lds, Seam& S, int wv) {
    const int tid = wg_tid(wv), wid = wv, lane = tid & 63, r32 = lane & 31, hi = lane >> 5;
    const int sr = tid >> 4, sc = (tid & 15) * 8, kws = KSWZ(sr, sc * 2); char* K_lds = lds + LDS_K; float* B_lds = (float*)(lds + LDS_BIAS);
    const unsigned kvoff = (unsigned)(sr * PITCH + sc) * 2u, qoff = (unsigned)(r32 * PITCH + hi * 8) * 2u;
    __attribute__((address_space(3))) float* B3 = (__attribute__((address_space(3))) float*)B_lds;
    QLOAD(H);
    SLOAD_H(H, H.jlo * KVBLK, 0); VMW(); SWRITE_HK(0);
    { char* qw = lds + LDS_Q + wid * 8192 + lane * 16;
#pragma unroll
      for (int d0 = 0; d0 < 8; ++d0) *(bf16x8*)(qw + d0 * 1024) = S.qr[d0]; }
    __syncthreads();
}
template <class NextFn>
__device__ __forceinline__ int fox_block(const Srd R, const Item& H, const NextFn& next_item, char* lds, Seam& S, int wv) {
    const int P0 = H.P0;
    const int tid = wg_tid(wv), wid = wv, lane = tid & 63, r32 = lane & 31, hi = lane >> 5;
    const int NT = P0 / KVBLK + 4 - H.jlo;
    const int qlo = P0 + wid * QBLK, qm = qlo + r32 - 4 * hi;
    char* V_lds = lds + LDS_V; char* K_lds = lds + LDS_K; float* B_lds = (float*)(lds + LDS_BIAS);
    char* qw = lds + LDS_Q + wid * 8192 + lane * 16;
    float* ws = (float*)(lds + LDS_WS) + wid * 64; float* li_l = ws, * al_l = ws + 32;
    float m_reg = -1e30f, l_reg = 0; f32x16 o[4] = {};
    const int sr = tid >> 4, sc = (tid & 15) * 8, vst0 = v_st(sr, sc), vst1 = v_st(32 + sr, sc), kws = KSWZ(sr, sc * 2);
    const int vb0 = (int)(uintptr_t)V_lds + v_rd_base(lane);
    const unsigned kvoff = (unsigned)(sr * PITCH + sc) * 2u, qoff = (unsigned)(r32 * PITCH + hi * 8) * 2u;
    __attribute__((address_space(3))) float* B3 = (__attribute__((address_space(3))) float*)B_lds;
#define RESC(a) do { if (__any((a) < 1.f)) { if (hi == 0) al_l[r32] = (a); asm volatile("s_waitcnt lgkmcnt(0)" ::: "memory");              \
                     for (int d_ = 0; d_ < 4; ++d_) for (int r = 0; r < 16; ++r) o[d_][r] *= al_l[crow(r, hi)]; } } while (0)
#define KBASE(t) ((H.jlo + (t)) * KVBLK)
#define MASKT(P0_, P1_, t) do { const int kb_ = KBASE(t); if (kb_ + KVBLK - 1 > qlo) mask_tile(P0_, P1_, qm - kb_); } while (0)
    f32x16 pA0, pA1, pB0, pB1; float mnA, mnB, alA, alB; bf16x8 pa0, pa1, pa2, pa3;
    SWRITE_HV(0); SBAR();
    SLOAD_H(H, KBASE(1), 1);
    SBAR(); qkt<0>(pA0, pA1, K_lds, B_lds, r32, hi, qw);
    MASKT(pA0, pA1, 0); partialSM(pA0, pA1, m_reg, mnA, alA);
    VMW(); SWRITE_H(1);
    __syncthreads();
#define HALF_STEP(PX0, PX1, mnX, alX, PY0, PY1, alY, t, KB, VB, SB) do {                                                      \
        SBAR(); qkt<KB>(PX0, PX1, K_lds, B_lds, r32, hi, qw);                                                                 \
        finishSM(PY0, PY1, alY, l_reg, pa0, pa1, pa2, pa3); SBAR();                                                           \
        if ((t) + 1 < NT) { SLOAD_H(H, KBASE((t) + 1), SB); SBAR(); }                                                                \
        pv_tile<VB>(o, vb0, pa0, pa1, pa2, pa3); MASKT(PX0, PX1, (t)); partialSM(PX0, PX1, m_reg, mnX, alX);                  \
        __syncthreads();                                                                                                      \
        if ((t) + 1 < NT) { VMW(); SWRITE_H(SB); }                                                                      \
        RESC(alX); __syncthreads(); } while (0)
    for (int t = 1; t + 1 < NT; t += 2) {
        HALF_STEP(pB0, pB1, mnB, alB, pA0, pA1, alA, t, 1, 0, 0);
        HALF_STEP(pA0, pA1, mnA, alA, pB0, pB1, alB, t + 1, 0, 1, 1);
    }
    SBAR(); qkt<1>(pB0, pB1, K_lds, B_lds, r32, hi, qw); SBAR();
    int nidx; const Item N = next_item(H, nidx);
    SLOAD_H(N, N.jlo * KVBLK, 0); SBAR();
    QLOAD(N);
    SBAR();
    finishSM(pA0, pA1, alA, l_reg, pa0, pa1, pa2, pa3); SBAR();
    pv_tile<0>(o, vb0, pa0, pa1, pa2, pa3);
    MASKT(pB0, pB1, NT - 1); partialSM(pB0, pB1, m_reg, mnB, alB); __syncthreads(); RESC(alB);
    finishSM(pB0, pB1, alB, l_reg, pa0, pa1, pa2, pa3); SBAR(); pv_tile<1>(o, vb0, pa0, pa1, pa2, pa3);
    SBAR(); VMWN(8); SWRITE_HK(0); SBAR();
    if (hi == 0) li_l[r32] = l_reg; asm volatile("s_waitcnt lgkmcnt(0)" ::: "memory");
    float gn[4];
#pragma unroll
    for (int d0 = 0; d0 < 4; ++d0) gn[d0] = H.G[d0 * 32 + r32];
    const unsigned ovoff = (unsigned)(4 * hi * OPITCH + r32) * 2u;
#pragma unroll
    for (int r = 0; r < 16; ++r) { const float rli = __builtin_amdgcn_rcpf(li_l[crow(r, hi)]); float ss = 0.f;
#pragma unroll
        for (int d0 = 0; d0 < 4; ++d0) { o[d0][r] *= rli; ss += o[d0][r] * o[d0][r]; }
        ss += __shfl_xor(ss, 1); ss += __shfl_xor(ss, 2); ss += __shfl_xor(ss, 4); ss += __shfl_xor(ss, 8); ss += __shfl_xor(ss, 16);
        const float rs = __builtin_amdgcn_rsqf(ss * (1.0f / D) + EPS);
        const unsigned so_ = (unsigned)(P0 + wid * QBLK + (r & 3) + 8 * (r >> 2)) * (OPITCH * 2);
#pragma unroll
        for (int d0 = 0; d0 < 4; ++d0) { const float v = o[d0][r] * rs * gn[d0];
            const float vn = __shfl_xor(v, 1);
            if ((r32 & 1) == 0) __builtin_amdgcn_raw_buffer_store_b32(cvtpk(v, vn), R, ovoff + d0 * 64, H.o + so_, 0); } }
#pragma unroll
    for (int d0 = 0; d0 < 8; ++d0) *(bf16x8*)(qw + d0 * 1024) = S.qr[d0];
    __syncthreads();
    return nidx;
#undef RESC
#undef KBASE
#undef MASKT
#undef HALF_STEP
}
#undef BL8
#undef QLOAD
#undef VMW
#undef VMWN
#undef SLOAD_H
#undef SWRITE_HK
#undef SWRITE_HV
#undef SWRITE_H
#undef KSWZ
#undef SBAR
}
namespace mls {
typedef short bf16x8 __attribute__((ext_vector_type(8)));
typedef short bf16x4 __attribute__((ext_vector_type(4)));
typedef float f32x4 __attribute__((ext_vector_type(4)));
#define MFMA16(a, b, c) __builtin_amdgcn_mfma_f32_16x16x32_bf16((a), (b), (c), 0, 0, 0)

constexpr int CO_CST = 0, CO_VT = 65536, CO_XCH = 98304, CO_LDS_BYTES = CO_XCH + 512;
__device__ __forceinline__ void chunk_out(int b, int h, int c, const bf16* QP, const bf16* KPP, const bf16* VT, const bf16* CST, const float* NST,
                                          const bf16* MO, const float* gain, bf16* concat, __attribute__((address_space(3))) unsigned char* lds, int wv) {
    typedef __attribute__((address_space(3))) unsigned char* lptr;
    const int tid = wg_tid(wv), w = wv, lane = tid & 63, i16 = lane & 15, q = lane >> 4;
    const int tq = w & 3, dvh = w >> 2;
    const size_t R0 = (size_t)b * SEQ + (size_t)c * 64;
    const size_t item = ((size_t)(b * MLH + h) * NCHUNK + c);
    { const bf16* cs = CST + item * MLDV * MLDK; const bf16* vs = VT + item * MLDV * 64;
#pragma unroll
      for (int j = 0; j < 8; ++j) { const int p = w + 8 * j, row = 4 * p + (lane >> 4), lc = (lane & 15) ^ (row & 15);
          __builtin_amdgcn_global_load_lds((const unsigned*)(cs + row * MLDK + lc * 8), (__attribute__((address_space(3))) unsigned*)(lds + CO_CST + p * 1024), 16, 0, 0); }
#pragma unroll
      for (int j = 0; j < 4; ++j) { const int p = w + 8 * j, row = 8 * p + (lane >> 3), lc = (lane & 7) ^ ((row >> 1) & 7);
          __builtin_amdgcn_global_load_lds((const unsigned*)(vs + row * 64 + lc * 8), (__attribute__((address_space(3))) unsigned*)(lds + CO_VT + p * 1024), 16, 0, 0); } }
    const size_t row = R0 + 16 * tq + i16;
    const bf16* qrow = QP + row * 512 + h * MLDK + 8 * q;
    bf16x8 qf[4];
#pragma unroll
    for (int ks = 0; ks < 4; ++ks) qf[ks] = *(const bf16x8*)(qrow + 32 * ks);
    f32x4 st[4];
#pragma unroll
    for (int stile = 0; stile < 4; ++stile) {
        st[stile] = (f32x4){0.f, 0.f, 0.f, 0.f};
        if (stile <= tq) {
            const bf16* krow = KPP + (R0 + 16 * stile + i16) * 512 + h * MLDK + 8 * q;
            bf16x8 kf[4];
#pragma unroll
            for (int ks = 0; ks < 4; ++ks) kf[ks] = *(const bf16x8*)(krow + 32 * ks);
#pragma unroll
            for (int ks = 0; ks < 4; ++ks) st[stile] = MFMA16(kf[ks], qf[ks], st[stile]);
            if (stile == tq) {
#pragma unroll
                for (int r = 0; r < 4; ++r) if (4 * q + r > i16) st[stile][r] = 0.f;
            }
        }
    }
    float den = 0.f;
#pragma unroll
    for (int stile = 0; stile < 4; ++stile) den += (st[stile][0] + st[stile][1]) + (st[stile][2] + st[stile][3]);
    { const float* nrow = NST + item * MLDK + 8 * q;
#pragma unroll
      for (int ks = 0; ks < 4; ++ks) { const f32x4 n0 = *(const f32x4*)(nrow + 32 * ks), n1 = *(const f32x4*)(nrow + 32 * ks + 4);
          const v4u qq = __builtin_bit_cast(v4u, qf[ks]);
          den += bflo(qq[0]) * n0[0] + bfhi(qq[0]) * n0[1] + bflo(qq[1]) * n0[2] + bfhi(qq[1]) * n0[3]
               + bflo(qq[2]) * n1[0] + bfhi(qq[2]) * n1[1] + bflo(qq[3]) * n1[2] + bfhi(qq[3]) * n1[3]; } }
    den += __shfl_xor(den, 16); den += __shfl_xor(den, 32);
    const int dv0 = h * MLDV + dvh * 128 + 4 * q;
    v2u mo2[8];
#pragma unroll
    for (int dt = 0; dt < 8; ++dt) mo2[dt] = *(const v2u*)(MO + row * 1024 + dv0 + 16 * dt);
    bf16x8 pf[2];
#pragma unroll
    for (int p = 0; p < 2; ++p) { v4u wv; wv[0] = pg8::cvt_pk_bf16(st[2 * p][0], st[2 * p][1]); wv[1] = pg8::cvt_pk_bf16(st[2 * p][2], st[2 * p][3]);
        wv[2] = pg8::cvt_pk_bf16(st[2 * p + 1][0], st[2 * p + 1][1]); wv[3] = pg8::cvt_pk_bf16(st[2 * p + 1][2], st[2 * p + 1][3]); pf[p] = __builtin_bit_cast(bf16x8, wv); }
    const int npair = (tq >> 1) + 1;
    asm volatile("s_waitcnt vmcnt(0)" ::: "memory");
    __syncthreads();
    f32x4 num[8];
    const lptr cb = lds + CO_CST + (dvh * 128 + i16) * 256, vb = lds + CO_VT + (dvh * 128 + i16) * 128 + (q & 1) * 8;
    const int vsw = i16 >> 1;
#pragma unroll
    for (int dt = 0; dt < 8; ++dt) {
        f32x4 a = (f32x4){0.f, 0.f, 0.f, 0.f};
#pragma unroll
        for (int p = 0; p < 2; ++p) if (p < npair) {
            const v2u lo = *(const __attribute__((address_space(3))) v2u*)(vb + dt * 16 * 128 + (((4 * p + (q >> 1)) ^ vsw) * 16));
            const v2u hi2 = *(const __attribute__((address_space(3))) v2u*)(vb + dt * 16 * 128 + (((4 * p + 2 + (q >> 1)) ^ vsw) * 16));
            const v4u vv = {lo[0], lo[1], hi2[0], hi2[1]};
            a = MFMA16(__builtin_bit_cast(bf16x8, vv), pf[p], a); }
#pragma unroll
        for (int ks = 0; ks < 4; ++ks) { const bf16x8 cf = *(const __attribute__((address_space(3))) bf16x8*)(cb + dt * 16 * 256 + (((4 * ks + q) ^ i16) * 16)); a = MFMA16(cf, qf[ks], a); }
        num[dt] = a;
    }
    const float rden = 1.0f / fmaxf(fabsf(den), 1.0f);
    float ss = 0.f;
#pragma unroll
    for (int dt = 0; dt < 8; ++dt) { num[dt] = num[dt] * rden; ss += (num[dt][0] * num[dt][0] + num[dt][1] * num[dt][1]) + (num[dt][2] * num[dt][2] + num[dt][3] * num[dt][3]); }
    ss += __shfl_xor(ss, 16); ss += __shfl_xor(ss, 32);
    __attribute__((address_space(3))) float* xch = (__attribute__((address_space(3))) float*)(lds + CO_XCH);
    if (q == 0) xch[w * 16 + i16] = ss;
    __syncthreads();
    const float tot = ss + xch[(w ^ 4) * 16 + i16];
    const float rn = __builtin_amdgcn_rsqf(tot * (1.0f / MLDV) + EPS);
#pragma unroll
    for (int dt = 0; dt < 8; ++dt) { const int dv = dv0 + 16 * dt;
        const f32x4 g4 = *(const f32x4*)(gain + dv);
        const float o0 = num[dt][0] * rn * g4[0] * sigmoidf_(bflo(mo2[dt][0])), o1 = num[dt][1] * rn * g4[1] * sigmoidf_(bfhi(mo2[dt][0]));
        const float o2 = num[dt][2] * rn * g4[2] * sigmoidf_(bflo(mo2[dt][1])), o3 = num[dt][3] * rn * g4[3] * sigmoidf_(bfhi(mo2[dt][1]));
        v2u ov; ov[0] = pg8::cvt_pk_bf16(o0, o1); ov[1] = pg8::cvt_pk_bf16(o2, o3);
        *(v2u*)(concat + row * 2048 + 1024 + dv) = ov; }
    __syncthreads();
}

constexpr int SS_NS = 6, SS_SLOT = 18432;
__device__ __forceinline__ void state_scan(int bh, int sl, const bf16* KT, const bf16* VT, const float* EB, bf16* CST, __attribute__((address_space(3))) unsigned char* lds, int wv, bool do_store = true) {
    typedef __attribute__((address_space(3))) unsigned char* lptr;
    const int tid = wg_tid(wv), w = wv, lane = tid & 63, i16 = lane & 15, q = lane >> 4;
    const size_t it0 = (size_t)bh * NCHUNK;
    const bf16* kt0 = KT + it0 * MLDK * 64; const bf16* vt0 = VT + (it0 * MLDV + 16 * sl) * 64;
    bf16* cs = CST + (it0 * MLDV + 16 * sl + i16) * MLDK + 16 * w + 4 * q;
    const float ebv = EB[it0 + lane];
    const int prow = lane >> 3, pcol = lane & 7;
    const unsigned ksrc0 = (unsigned)((8 * w + prow) * 64 + ((pcol ^ (((8 * w + prow) >> 1) & 7)) * 8));
    const unsigned ksrc1 = (unsigned)((8 * (w + 8) + prow) * 64 + ((pcol ^ (((8 * (w + 8) + prow) >> 1) & 7)) * 8));
    const unsigned vsrc = (unsigned)((8 * (w & 1) + prow) * 64 + ((pcol ^ (((8 * (w & 1) + prow) >> 1) & 7)) * 8));
#define SS_DMA(cc, slot) do { const bf16* kc_ = kt0 + (size_t)(cc) * MLDK * 64; const lptr sb_ = lds + (slot) * SS_SLOT;                                        \
        __builtin_amdgcn_global_load_lds((const unsigned*)(kc_ + ksrc0), (__attribute__((address_space(3))) unsigned*)(sb_ + w * 1024), 16, 0, 0);             \
        __builtin_amdgcn_global_load_lds((const unsigned*)(kc_ + ksrc1), (__attribute__((address_space(3))) unsigned*)(sb_ + (w + 8) * 1024), 16, 0, 0);       \
        if (w < 2) __builtin_amdgcn_global_load_lds((const unsigned*)(vt0 + (size_t)(cc) * MLDV * 64 + vsrc), (__attribute__((address_space(3))) unsigned*)(sb_ + 16384 + w * 1024), 16, 0, 0); } while (0)
#pragma unroll
    for (int j = 0; j < SS_NS - 1; ++j) SS_DMA(j, j);
    f32x4 acc = (f32x4){0.f, 0.f, 0.f, 0.f};
    const int swz = (i16 >> 1) & 7;
    const unsigned aoff = (unsigned)((16 * w + i16) * 128), boff = (unsigned)(16384 + i16 * 128);
    int slot = 0;
    for (int c = 0; c < NCHUNK; ++c) {
        if (w < 2) asm volatile("s_waitcnt vmcnt(12)" ::: "memory"); else asm volatile("s_waitcnt vmcnt(8)" ::: "memory");
        asm volatile("s_waitcnt lgkmcnt(0)" ::: "memory");
        __builtin_amdgcn_s_barrier();
        asm volatile("" ::: "memory");
        { const int cn = c + SS_NS - 1 < NCHUNK ? c + SS_NS - 1 : NCHUNK - 1; const int sn = slot == 0 ? SS_NS - 1 : slot - 1; SS_DMA(cn, sn); }
        const lptr sb = lds + slot * SS_SLOT;
        const bf16x8 a0 = *(const __attribute__((address_space(3))) bf16x8*)(sb + aoff + ((q ^ swz) * 16)), a1 = *(const __attribute__((address_space(3))) bf16x8*)(sb + aoff + (((4 + q) ^ swz) * 16));
        const bf16x8 b0 = *(const __attribute__((address_space(3))) bf16x8*)(sb + boff + ((q ^ swz) * 16)), b1 = *(const __attribute__((address_space(3))) bf16x8*)(sb + boff + (((4 + q) ^ swz) * 16));
        v2u ov; ov[0] = pg8::cvt_pk_bf16(acc[0], acc[1]); ov[1] = pg8::cvt_pk_bf16(acc[2], acc[3]);
        if (do_store) *(v2u*)(cs + (size_t)c * MLDV * MLDK) = ov; else asm volatile("" :: "v"(ov));
        acc = MFMA16(a0, b0, acc); acc = MFMA16(a1, b1, acc);
        const float e = __builtin_bit_cast(float, __builtin_amdgcn_readlane(__builtin_bit_cast(int, ebv), c));
        acc = acc * e;
        slot = slot == SS_NS - 1 ? 0 : slot + 1;
    }
    asm volatile("s_waitcnt vmcnt(0) lgkmcnt(0)" ::: "memory");
    __builtin_amdgcn_s_barrier();
#undef SS_DMA
}
#undef MFMA16
}
typedef const float* cfp_t;
struct Frame {
    LAS unsigned char* lds; unsigned char* ldsg;
    int tid, lane, wave, vcu, G;
    const __attribute__((address_space(4))) cfp_t* inp; float* out; unsigned char* ws;
};
__device__ __forceinline__ void refresh_ids(Frame& F) { F.tid = wg_tid(F.wave); F.lane = F.tid & 63; }
__device__ __forceinline__ float wave_incl_scan(float v, int lane) {
#pragma unroll
    for (int o = 1; o < 64; o <<= 1) { const float t = __shfl_up(v, o); if (lane >= o) v += t; }
    return v;
}

__device__ __forceinline__ void p0_transpose_item(const float* W, int ldw, int K, bf16* WT, const float* gk, int k0, int n0_dst, int n0_src, LAS float* scr, int lane) {
    float vv[32];
#pragma unroll
    for (int i = 0; i < 32; ++i) { const int kk = 2 * i + (lane >> 5); vv[i] = W[(size_t)(k0 + kk) * ldw + n0_src + (lane & 31)]; }
    if (gk) {
#pragma unroll
        for (int i = 0; i < 32; ++i) vv[i] *= gk[k0 + 2 * i + (lane >> 5)]; }
#pragma unroll
    for (int i = 0; i < 32; ++i) scr[(2 * i + (lane >> 5)) * 33 + (lane & 31)] = vv[i];
    LDS_WAIT(); asm volatile("" ::: "memory");
    const int c = lane & 7;
#pragma unroll
    for (int j = 0; j < 4; ++j) { const int n = (lane >> 3) + 8 * j; const LAS float* s = scr + (8 * c) * 33 + n;
        v4u o; o.x = pk2(s[0 * 33], s[1 * 33]); o.y = pk2(s[2 * 33], s[3 * 33]); o.z = pk2(s[4 * 33], s[5 * 33]); o.w = pk2(s[6 * 33], s[7 * 33]);
        *(GAS v4u*)(WT + (size_t)(n0_dst + n) * K + k0 + 8 * c) = o; }
    LDS_WAIT(); asm volatile("" ::: "memory");
}
__device__ __forceinline__ void p0_transpose_item8(const float* W, int ldw, int K, unsigned char* WT8, const float* gk, float scale, int k0, int n0, LAS float* scr, int lane) {
    float vv[32];
#pragma unroll
    for (int i = 0; i < 32; ++i) { const int kk = 2 * i + (lane >> 5); vv[i] = W[(size_t)(k0 + kk) * ldw + n0 + (lane & 31)]; }
#pragma unroll
    for (int i = 0; i < 32; ++i) vv[i] *= (gk ? gk[k0 + 2 * i + (lane >> 5)] : 1.0f) * scale;
#pragma unroll
    for (int i = 0; i < 32; ++i) scr[(2 * i + (lane >> 5)) * 33 + (lane & 31)] = vv[i];
    LDS_WAIT(); asm volatile("" ::: "memory");
    const int c = lane & 7;
#pragma unroll
    for (int j = 0; j < 4; ++j) { const int n = (lane >> 3) + 8 * j; const LAS float* s = scr + (8 * c) * 33 + n;
        v2u o; o.x = pg8::pk4_fp8(s[0 * 33], s[1 * 33], s[2 * 33], s[3 * 33]); o.y = pg8::pk4_fp8(s[4 * 33], s[5 * 33], s[6 * 33], s[7 * 33]);
        *(GAS v2u*)(WT8 + (size_t)(n0 + n) * K + k0 + 8 * c) = o; }
    LDS_WAIT(); asm volatile("" ::: "memory");
}
__device__ __forceinline__ float rms_row_to_bf16(const float* xrow, const float* g, bf16* orow, int lane) {
    const GAS v4f* xr = (const GAS v4f*)xrow + lane; const GAS v4f* gr = (const GAS v4f*)g + lane;
    v4f v[8]; float s = 0.f;
#pragma unroll
    for (int j = 0; j < 8; ++j) { v[j] = xr[64 * j]; s += (v[j].x * v[j].x + v[j].y * v[j].y) + (v[j].z * v[j].z + v[j].w * v[j].w); }
    const float rinv = 1.0f / sqrtf(wave_sum(s) * (1.f / DM) + EPS);
    GAS v2u* o8 = (GAS v2u*)orow + lane;
#pragma unroll
    for (int j = 0; j < 8; ++j) { const v4f gg = gr[64 * j]; v2u w; w.x = pk2(v[j].x * rinv * gg.x, v[j].y * rinv * gg.y); w.y = pk2(v[j].z * rinv * gg.z, v[j].w * rinv * gg.w); o8[64 * j] = w; }
    return rinv;
}
__device__ __forceinline__ void p0_prologue(Frame& F) {
    refresh_ids(F);
    const float* x = F.inp[0]; const float* mem = F.inp[1]; const float* mixer_norm = F.inp[2]; const float* w_in = F.inp[3];
    const int gw = F.vcu * 8 + F.wave, NGW = F.G * 8;
    LAS float* WgL = (LAS float*)F.lds;
#pragma unroll 8
    for (int idx = F.tid; idx < 32768; idx += NTHREADS) { const int e = idx & 7, ln = (idx >> 3) & 63, sp = idx >> 9, gate = ln & 15, q = ln >> 4, k = 32 * sp + 8 * q + e;
        const int col = gate < 8 ? 3072 + gate : 5128 + (gate - 8);
        WgL[idx] = w_in[(size_t)k * IN_WIDTH + col] * mixer_norm[k]; }
    __syncthreads();
    { float* gates = (float*)(F.ws + WS_GATES); float* ssqx = (float*)(F.ws + WS_CTL + CTL_SSQX); bf16* XG = (bf16*)(F.ws + WS_XN);
      const int i16 = F.lane & 15, q = F.lane >> 4;
      for (int it = gw; it < MTOK / 16 * 2; it += NGW) { const int grp = it >> 1, kh = it & 1; const size_t row = (size_t)grp * 16 + i16;
          const float* xr = x + row * DM + kh * 1024 + 8 * q; const float* gr = mixer_norm + kh * 1024 + 8 * q; bf16* xo = XG + row * DM + kh * 1024 + 8 * q;
          const LAS float* wp = WgL + (kh * 32 * 64 + F.lane) * 8;
          v4f acc = (v4f){0.f, 0.f, 0.f, 0.f}; float ss = 0.f;
#pragma unroll 1
          for (int s0 = 0; s0 < 32; s0 += 8, wp += 8 * 512, xr += 8 * 32, gr += 8 * 32, xo += 8 * 32) { v4f xb[8][2];
#pragma unroll
              for (int j = 0; j < 8; ++j) { xb[j][0] = *(const v4f*)(xr + 32 * j); xb[j][1] = *(const v4f*)(xr + 32 * j + 4); }
#pragma unroll
              for (int j = 0; j < 8; ++j) { const v4f x0 = xb[j][0], x1 = xb[j][1]; const v4f g0 = *(const v4f*)(gr + 32 * j), g1 = *(const v4f*)(gr + 32 * j + 4);
                  const v4f w0 = *(const LAS v4f*)(wp + j * 512), w1 = *(const LAS v4f*)(wp + j * 512 + 4);
                  ss += (x0.x * x0.x + x0.y * x0.y) + (x0.z * x0.z + x0.w * x0.w) + (x1.x * x1.x + x1.y * x1.y) + (x1.z * x1.z + x1.w * x1.w);
                  v4u o; o.x = pk2(x0.x * g0.x, x0.y * g0.y); o.y = pk2(x0.z * g0.z, x0.w * g0.w); o.z = pk2(x1.x * g1.x, x1.y * g1.y); o.w = pk2(x1.z * g1.z, x1.w * g1.w);
                  *(v4u*)(xo + 32 * j) = o;
                  acc = __builtin_amdgcn_mfma_f32_16x16x4f32(x0.x, w0.x, acc, 0, 0, 0); acc = __builtin_amdgcn_mfma_f32_16x16x4f32(x0.y, w0.y, acc, 0, 0, 0);
                  acc = __builtin_amdgcn_mfma_f32_16x16x4f32(x0.z, w0.z, acc, 0, 0, 0); acc = __builtin_amdgcn_mfma_f32_16x16x4f32(x0.w, w0.w, acc, 0, 0, 0);
                  acc = __builtin_amdgcn_mfma_f32_16x16x4f32(x1.x, w1.x, acc, 0, 0, 0); acc = __builtin_amdgcn_mfma_f32_16x16x4f32(x1.y, w1.y, acc, 0, 0, 0);
                  acc = __builtin_amdgcn_mfma_f32_16x16x4f32(x1.z, w1.z, acc, 0, 0, 0); acc = __builtin_amdgcn_mfma_f32_16x16x4f32(x1.w, w1.w, acc, 0, 0, 0); } }
          ss += __shfl_xor(ss, 16); ss += __shfl_xor(ss, 32);
          if (q == 0) atomicAdd(ssqx + row, ss);
#pragma unroll
          for (int r = 0; r < 4; ++r) atomicAdd(gates + ((size_t)grp * 16 + 4 * q + r) * 16 + i16, acc[r]);
      } }
    { bf16* MN = (bf16*)(F.ws + WS_MN);
      for (int m = gw; m < MROWS; m += NGW) (void)rms_row_to_bf16(mem + (size_t)m * DM, F.inp[15], MN + (size_t)m * DM, F.lane); }
    __syncthreads();
    LAS float* scr = (LAS float*)(F.lds + F.wave * 16384);
    for (int it = gw; it < 32768; it += NGW) {
        int r = it;
        if (r < 6144) { const int kb = r / 192, nb = r % 192, n0 = 32 * nb, grpc = n0 >> 10, shift = grpc < 3 ? 0 : (grpc < 5 ? 8 : 16);
            p0_transpose_item(w_in, IN_WIDTH, DM, (bf16*)(F.ws + WS_WIN), nullptr, 64 * kb, n0, n0 + shift, scr, F.lane); continue; } r -= 6144;
        if (r < 2048) { p0_transpose_item(F.inp[13], DM, DM, (bf16*)(F.ws + WS_WOUT), nullptr, 64 * (r / 64), 32 * (r % 64), 32 * (r % 64), scr, F.lane); continue; } r -= 2048;
        if (r < 2048) { p0_transpose_item8(F.inp[16], DM, DM, F.ws + WS_WXQ, F.inp[14], W8_SCALE, 64 * (r / 64), 32 * (r % 64), scr, F.lane); continue; } r -= 2048;
        if (r < 4096) { p0_transpose_item(F.inp[17], 2 * DM, DM, (bf16*)(F.ws + WS_WXKV), nullptr, 64 * (r / 128), 32 * (r % 128), 32 * (r % 128), scr, F.lane); continue; } r -= 4096;
        if (r < 2048) { p0_transpose_item8(F.inp[20], DM, DM, F.ws + WS_WXO, nullptr, W8_SCALE, 64 * (r / 64), 32 * (r % 64), scr, F.lane); continue; } r -= 2048;
        if (r < 8192) { p0_transpose_item(F.inp[22], DFF, DM, (bf16*)(F.ws + WS_WUP), F.inp[21], 64 * (r / 256), 32 * (r % 256), 32 * (r % 256), scr, F.lane); continue; } r -= 8192;
        p0_transpose_item(F.inp[23], DM, DFF, (bf16*)(F.ws + WS_WDN), nullptr, 64 * (r / 64), 32 * (r % 64), 32 * (r % 64), scr, F.lane);
    }
}

constexpr int P2_KT_OFF = 4096, P2_KT_PITCH = 136, P2_VT_OFF = P2_KT_OFF + 64 * P2_KT_PITCH * 2, P2_VT_PITCH = 264;
constexpr int P2_BUF_ELEMS = (64 * P2_KT_PITCH + 64 * P2_VT_PITCH);
__device__ __forceinline__ void p2_prep_item(Frame& F, int item, bool do_norm = true) {
    refresh_ids(F);
    const int b = item >> 6, c = item & 63; const size_t R0 = (size_t)b * SEQ + (size_t)c * 64;
    const int tid = F.tid, lane = F.lane, w = F.wave;
    LAS float* gq = (LAS float*)F.lds; LAS float* uk = gq + 256;
    LAS bf16* kt = (LAS bf16*)(F.lds + P2_KT_OFF); LAS bf16* vt = (LAS bf16*)(F.lds + P2_VT_OFF);
    const float* GATES = (const float*)(F.ws + WS_GATES); const float* SSQX = (const float*)(F.ws + WS_CTL + CTL_SSQX);
    if (w < 4) { const size_t row = R0 + lane; const float ri = rinv_of(SSQX, row);
        const float mi = GATES[row * 16 + 8 + w] * ri + F.inp[5][w], mf = GATES[row * 16 + 12 + w] * ri + F.inp[6][w];
        const float bcum = wave_incl_scan(logsigmoidf(mf), lane);
        const float g = __expf(bcum), u = __expf(mi - bcum) * 0.08838834764831845f;
        gq[w * 64 + lane] = g; uk[w * 64 + lane] = u;
        if (lane == 63) ((float*)(F.ws + WS_EB))[(size_t)(b * MLH + w) * NCHUNK + c] = g; }
    if (do_norm) { bf16* FQ = (bf16*)(F.ws + WS_FQ); bf16* FK = (bf16*)(F.ws + WS_FK); const int l16 = lane & 15;
      float gqn[8], gkn[8];
#pragma unroll
      for (int e = 0; e < 8; ++e) { gqn[e] = F.inp[9][l16 * 8 + e]; gkn[e] = F.inp[10][l16 * 8 + e]; }
      for (int it0 = w; it0 < 256; it0 += 64) {
          v4u raw[8];
#pragma unroll
          for (int j = 0; j < 8; ++j) { const int seg = (it0 + 8 * j) * 4 + (lane >> 4), row = seg >> 4, hh = seg & 15;
              raw[j] = *(const v4u*)((hh < 8 ? FQ : FK) + (R0 + row) * 1024 + (hh & 7) * FOXD + l16 * 8); }
#pragma unroll
          for (int j = 0; j < 8; ++j) { const int seg = (it0 + 8 * j) * 4 + (lane >> 4), row = seg >> 4, hh = seg & 15;
              bf16* p = (hh < 8 ? FQ : FK) + (R0 + row) * 1024 + (hh & 7) * FOXD + l16 * 8; float v[8];
#pragma unroll
              for (int e = 0; e < 4; ++e) { v[2 * e] = bflo(raw[j][e]); v[2 * e + 1] = bfhi(raw[j][e]); }
              float ss = 0.f;
#pragma unroll
              for (int e = 0; e < 8; ++e) ss += v[e] * v[e];
              ss += __shfl_xor(ss, 1); ss += __shfl_xor(ss, 2); ss += __shfl_xor(ss, 4); ss += __shfl_xor(ss, 8);
              const float ri = 1.0f / sqrtf(ss * (1.0f / FOXD) + EPS);
              v4u o;
#pragma unroll
              for (int e = 0; e < 4; ++e) { const float g0 = hh < 8 ? gqn[2 * e] : gkn[2 * e], g1 = hh < 8 ? gqn[2 * e + 1] : gkn[2 * e + 1]; o[e] = pk2(v[2 * e] * ri * g0, v[2 * e + 1] * ri * g1); }
              *(v4u*)p = o; } } }
    __syncthreads();
    const bf16* MQK = (const bf16*)(F.ws + WS_MQK); const bf16* MV = (const bf16*)(F.ws + WS_MV);
    bf16* QP = (bf16*)(F.ws + WS_QP); bf16* KPP = (bf16*)(F.ws + WS_KPP);
    const float* conv_w = F.inp[7]; const float* conv_b = F.inp[8];
    const int cgp = tid & 31, rg = tid >> 5; const bool isq = cgp < 16;
    v4u rawc[7], rawv[4];
#define P2_LOAD(h_) do { const int col_ = (isq ? 0 : 512) + (h_) * MLDK + (cgp & 15) * 8;                                              \
        _Pragma("unroll") for (int i = 0; i < 7; ++i) { const int pos = c * 64 + 4 * rg - 3 + i;                                           \
            rawc[i] = (v4u){0u, 0u, 0u, 0u}; if (pos >= 0) rawc[i] = *(const v4u*)(MQK + ((size_t)b * SEQ + pos) * 1024 + col_); }            \
        _Pragma("unroll") for (int i = 0; i < 4; ++i) { const int idx = tid + NTHREADS * i, row = idx >> 5, ch = idx & 31;                 \
            rawv[i] = *(const v4u*)(MV + (R0 + row) * 1024 + (h_) * MLDV + ch * 8); } } while (0)
#define P2_CONV(h_, kt_, vt_) do { const int col_ = (isq ? 0 : 512) + (h_) * MLDK + (cgp & 15) * 8;                                       \
        float cw[4][8], cb[8];                                                                                                             \
        _Pragma("unroll") for (int e = 0; e < 8; ++e) { cb[e] = conv_b[col_ + e];                                                          \
            _Pragma("unroll") for (int j = 0; j < 4; ++j) cw[j][e] = conv_w[j * 1024 + col_ + e]; }                                        \
        float u[7][8];                                                                                                                     \
        _Pragma("unroll") for (int i = 0; i < 7; ++i) _Pragma("unroll") for (int e = 0; e < 4; ++e) { u[i][2 * e] = bflo(rawc[i][e]); u[i][2 * e + 1] = bfhi(rawc[i][e]); } \
        _Pragma("unroll") for (int r = 0; r < 4; ++r) { const int t = 4 * rg + r; const float f = isq ? gq[(h_) * 64 + t] : uk[(h_) * 64 + t]; float y[8]; \
            _Pragma("unroll") for (int e = 0; e < 8; ++e) { float a = cb[e];                                                               \
                _Pragma("unroll") for (int j = 0; j < 4; ++j) a += cw[j][e] * u[r + j][e];                                                 \
                y[e] = a * sigmoidf_(a) * f; }                                                                                             \
            v4u o; o.x = pk2(y[0], y[1]); o.y = pk2(y[2], y[3]); o.z = pk2(y[4], y[5]); o.w = pk2(y[6], y[7]);                             \
            *(v4u*)((isq ? QP : KPP) + (R0 + t) * 512 + (h_) * MLDK + (cgp & 15) * 8) = o;                                                 \
            if (!isq) *(LAS v4u*)((kt_) + t * P2_KT_PITCH + (cgp & 15) * 8) = o; }                                                         \
        _Pragma("unroll") for (int i = 0; i < 4; ++i) { const int idx = tid + NTHREADS * i, row = idx >> 5, ch = idx & 31;                 \
            *(LAS v4u*)((vt_) + row * P2_VT_PITCH + ch * 8) = rawv[i]; } } while (0)
    P2_LOAD(0); P2_CONV(0, kt, vt);
    __syncthreads();
    for (int h = 0; h < MLH; ++h) {
        LAS bf16* ktc = kt + (h & 1) * P2_BUF_ELEMS; LAS bf16* vtc = vt + (h & 1) * P2_BUF_ELEMS;
        LAS bf16* ktn = kt + ((h + 1) & 1) * P2_BUF_ELEMS; LAS bf16* vtn = vt + ((h + 1) & 1) * P2_BUF_ELEMS;
        if (h + 1 < MLH) P2_LOAD(h + 1);
        const size_t itemh = (size_t)(b * MLH + h) * NCHUNK + c;
        { bf16* KT = (bf16*)(F.ws + WS_KT) + itemh * MLDK * 64;
#pragma unroll
          for (int i = 0; i < 2; ++i) { const int idx = tid + NTHREADS * i, d = idx >> 3, sg = idx & 7; unsigned short e8[8];
#pragma unroll
              for (int e = 0; e < 8; ++e) e8[e] = ktc[(8 * sg + e) * P2_KT_PITCH + d];
              v4u o; o.x = e8[0] | ((unsigned)e8[1] << 16); o.y = e8[2] | ((unsigned)e8[3] << 16); o.z = e8[4] | ((unsigned)e8[5] << 16); o.w = e8[6] | ((unsigned)e8[7] << 16);
              *(v4u*)(KT + d * 64 + 8 * sg) = o; }
          bf16* VT = (bf16*)(F.ws + WS_VT) + itemh * MLDV * 64;
#pragma unroll
          for (int i = 0; i < 4; ++i) { const int idx = tid + NTHREADS * i, dv = idx >> 3, sg = idx & 7; unsigned short e8[8];
#pragma unroll
              for (int e = 0; e < 8; ++e) e8[e] = vtc[(8 * sg + e) * P2_VT_PITCH + dv];
              v4u o; o.x = e8[0] | ((unsigned)e8[1] << 16); o.y = e8[2] | ((unsigned)e8[3] << 16); o.z = e8[4] | ((unsigned)e8[5] << 16); o.w = e8[6] | ((unsigned)e8[7] << 16);
              *(v4u*)(VT + dv * 64 + 8 * sg) = o; }
          if (tid < MLDK) { float s = 0.f;
#pragma unroll 8
              for (int t = 0; t < 64; ++t) s += bf2f(ktc[t * P2_KT_PITCH + tid]);
              ((float*)(F.ws + WS_KSUM))[itemh * MLDK + tid] = s; } }
        if (h + 1 < MLH) P2_CONV(h + 1, ktn, vtn);
        __syncthreads();
    }
#undef P2_LOAD
#undef P2_CONV
    { const int mr = item * 4 + (w & 3); const float* slab = (const float*)(F.ws + WS_SLAB);
      if (w < 4) {
        const float* gxq = F.inp[18]; const float* gxk = F.inp[19];
        v4f kv[8]; float ssh[4] = {0.f, 0.f, 0.f, 0.f};
#pragma unroll
        for (int j = 0; j < 8; ++j) { const int col = 4 * (lane + 64 * j); v4f a = (v4f){0.f, 0.f, 0.f, 0.f};
#pragma unroll
            for (int s = 0; s < 4; ++s) a = a + *(const v4f*)(slab + ((size_t)s * MROWS + mr) * 4096 + col);
            kv[j] = a; ssh[j >> 1] += (a.x * a.x + a.y * a.y) + (a.z * a.z + a.w * a.w); }
        float rk[4];
#pragma unroll
        for (int hh = 0; hh < 4; ++hh) rk[hh] = 1.0f / sqrtf(wave_sum(ssh[hh]) * (1.0f / XD) + EPS);
        bf16* KH = (bf16*)(F.ws + WS_KHAT) + (size_t)mr * DM;
#pragma unroll
        for (int j = 0; j < 8; ++j) { const int col = 4 * (lane + 64 * j), d = col & (XD - 1); const v4f a = *(const v4f*)(gxq + d), g2 = *(const v4f*)(gxk + d); const float r = rk[j >> 1];
            v2u o; o.x = pk2(kv[j].x * r * a.x * g2.x, kv[j].y * r * a.y * g2.y); o.y = pk2(kv[j].z * r * a.z * g2.z, kv[j].w * r * a.w * g2.w);
            *(v2u*)(KH + col) = o; }
      } else {
        bf16* VTM = (bf16*)(F.ws + WS_VTM); const int bm = mr >> 8, key = mr & 255;
        v4f vv[8];
#pragma unroll
        for (int j = 0; j < 8; ++j) { const int dcol = 4 * (lane + 64 * j); v4f a = (v4f){0.f, 0.f, 0.f, 0.f};
#pragma unroll
            for (int s = 0; s < 4; ++s) a = a + *(const v4f*)(slab + ((size_t)s * MROWS + mr) * 4096 + 2048 + dcol);
            vv[j] = a; }
#pragma unroll
        for (int j = 0; j < 8; ++j) { const int dcol = 4 * (lane + 64 * j); const v4f a = vv[j];
            const int hh = dcol >> 9, d = dcol & (XD - 1); bf16* vp = VTM + ((size_t)(bm * XH + hh) * XD + d) * NMEM + key;
            vp[0] = (bf16)f2bf(a.x); vp[NMEM] = (bf16)f2bf(a.y); vp[2 * NMEM] = (bf16)f2bf(a.z); vp[3 * NMEM] = (bf16)f2bf(a.w); }
      } }
    __syncthreads();
}

__device__ __forceinline__ void p3_scan_item(Frame& F, int item) {
    refresh_ids(F);
    if (item < 256) { for (int rep = 0; rep < P3_SCAN_REP; ++rep)
        mls::state_scan(item >> 4, item & 15, (const bf16*)(F.ws + WS_KT), (const bf16*)(F.ws + WS_VT), (const float*)(F.ws + WS_EB), (bf16*)(F.ws + WS_CST), F.lds, F.wave, rep == P3_SCAN_REP - 1); return; }
    const int bh = item - 288, sl = item >= 288 ? 0 : 1;
    if (sl == 0 && F.tid < MLDK) {
        const float* EB = (const float*)(F.ws + WS_EB) + (size_t)bh * NCHUNK; const float* KS = (const float*)(F.ws + WS_KSUM) + (size_t)bh * NCHUNK * MLDK + F.tid;
        float* NS = (float*)(F.ws + WS_NST) + (size_t)bh * NCHUNK * MLDK + F.tid; float n = 0.f;
        float ks[NCHUNK], eb[NCHUNK];
#pragma unroll
        for (int c = 0; c < NCHUNK; ++c) { ks[c] = KS[(size_t)c * MLDK]; eb[c] = EB[c]; }
#pragma unroll
        for (int c = 0; c < NCHUNK; ++c) { NS[(size_t)c * MLDK] = n; n = eb[c] * (n + ks[c]); }
    }
    if (sl == 1) {
        const int seq = item - 256, b = seq >> 3, fh = seq & 7;
        const float* GATES = (const float*)(F.ws + WS_GATES); const float* SSQX = (const float*)(F.ws + WS_CTL + CTL_SSQX); const float fb = F.inp[4][fh];
        const size_t r0 = (size_t)b * SEQ + 8 * F.tid; float lf[8]; float tot = 0.f;
#pragma unroll
        for (int j = 0; j < 8; ++j) { lf[j] = logsigmoidf(GATES[(r0 + j) * 16 + fh] * rinv_of(SSQX, r0 + j) + fb); tot += lf[j]; }
        const float incl = wave_incl_scan(tot, F.lane);
        LAS float* wt = (LAS float*)F.lds;
        __syncthreads();
        if (F.lane == 63) wt[F.wave] = incl;
        __syncthreads();
        float run = incl - tot;
        for (int wv = 0; wv < F.wave; ++wv) run += wt[wv];
        float* C = (float*)(F.ws + WS_CFOX) + (size_t)seq * SEQ + 8 * F.tid;
        float cs[8];
#pragma unroll
        for (int j = 0; j < 8; ++j) { run += lf[j]; cs[j] = run * -11.313708498984761f; C[j] = cs[j]; }
        LAS float* cp0 = wt + 16; LAS float* cend = wt + 32; LAS float* thr = wt + 96;
        if ((F.tid & 31) == 0) cp0[F.tid >> 5] = cs[0];
        if ((F.tid & 7) == 7) cend[F.tid >> 3] = cs[7];
        if (F.wave == 0) { float gq = fmaxf(fabsf(F.inp[9][F.lane]), fabsf(F.inp[9][F.lane + 64])), gk = fmaxf(fabsf(F.inp[10][F.lane]), fabsf(F.inp[10][F.lane + 64]));
#pragma unroll
            for (int o = 1; o < 64; o <<= 1) { gq = fmaxf(gq, __shfl_xor(gq, o)); gk = fmaxf(gk, __shfl_xor(gk, o)); }
            if (F.lane == 0) thr[0] = 2.0f * 11.313708498984761f * gq * gk + 29.0f; }
        __syncthreads();
        if (F.tid < 16) { const int qb = F.tid; const float T = thr[0], c0 = cp0[qb]; int j = 0;
            while (j < 4 * qb && (c0 - cend[j]) * 0.08838834764831845f > T) ++j;
            ((int*)(F.ws + WS_JLO))[seq * 16 + qb] = JLO_DISABLE ? 0 : (j & ~1); }
        __syncthreads();
    }
}
#ifndef MK_PER_PHASE
#define MK_PER_PHASE 0
#endif
#define XB_TMO      128
#define XB_XCNT(j)  (256  + 64 * (j))
#define XB_XSUB(j)  (1280 + 64 * (j))
#define XB_XGEN(j)  (2304 + 64 * (j))
#define XB_TOP      3328
#define XB_TOPGEN   3392
#define XCD_BAR_WORDS 3456
#define XB_SPIN_CAP (1u << 20)
__device__ __forceinline__ unsigned xb_ld(unsigned* p)              { return __hip_atomic_load(p, __ATOMIC_RELAXED, __HIP_MEMORY_SCOPE_AGENT); }
__device__ __forceinline__ unsigned xb_add(unsigned* p, unsigned v) { return __hip_atomic_fetch_add(p, v, __ATOMIC_RELAXED, __HIP_MEMORY_SCOPE_AGENT); }
__device__ __forceinline__ unsigned xb_xcc_id() { return (unsigned)__builtin_amdgcn_s_getreg((3 << 11) | 20) & 0xFu; }
#define XB_SPIN(cond, bar) do { unsigned _sp = 0; while (cond) { __builtin_amdgcn_s_sleep(1); \
    if ((++_sp & 255u) == 0u) { if (xb_ld(&(bar)[XB_TMO])) break; if (_sp > XB_SPIN_CAP) { atomicAdd(&(bar)[XB_TMO], 1u); break; } } } } while (0)
struct XcdBarrier { unsigned* bar; unsigned x; volatile LAS unsigned* st; int wv; };
__device__ __forceinline__ XcdBarrier xcd_barrier_post(unsigned* bar, volatile LAS unsigned* st, int wv) {
    XcdBarrier b; b.bar = bar; b.x = xb_xcc_id(); b.st = st; b.wv = wv;
    if (wv == 0 && lane_id() == 0) (void)xb_add(&bar[XB_XCNT(b.x)], 1u);
    return b;
}
__device__ __forceinline__ void xcd_barrier_complete(unsigned* bar, unsigned x, unsigned& nloc, unsigned& nx) {
    const unsigned G = gridDim.x * gridDim.y * gridDim.z;
    unsigned sum, cnt, mine, sp = 0u;
    for (;;) {
        sum = 0u; cnt = 0u; mine = 0u;
#pragma unroll
        for (unsigned j = 0; j < 16; ++j) { const unsigned c = xb_ld(&bar[XB_XCNT(j)]); sum += c; cnt += (c > 0u) ? 1u : 0u; mine = (j == x) ? c : mine; }
        if (sum == G) break;
        __builtin_amdgcn_s_sleep(1);
        if ((++sp & 255u) == 0u) { if (xb_ld(&bar[XB_TMO])) break; if (sp > XB_SPIN_CAP) { atomicAdd(&bar[XB_TMO], 1u); break; } }
    }
    nloc = mine > 0u ? mine : 1u; nx = cnt > 0u ? cnt : 1u;
}
__device__ __forceinline__ void xcd_barrier(const XcdBarrier& b) {
    asm volatile("s_waitcnt vmcnt(0)" ::: "memory");
    __syncthreads();
    if (b.wv == 0 && lane_id() == 0) {
        unsigned* bar = b.bar;
        __builtin_amdgcn_s_waitcnt(0);
        unsigned nloc = b.st[0], nx = b.st[1];
        if (nloc == 0u) { xcd_barrier_complete(bar, b.x, nloc, nx); b.st[0] = nloc; b.st[1] = nx; }
        const unsigned old = xb_add(&bar[XB_XSUB(b.x)], 1u);
        const unsigned gen = old / nloc;
        if (old + 1u == (gen + 1u) * nloc) {
            __builtin_amdgcn_fence(__ATOMIC_RELEASE, "agent");
            asm volatile("s_waitcnt vmcnt(0)" ::: "memory");
            const unsigned og = xb_add(&bar[XB_TOP], 1u);
            const unsigned tg = og / nx;
            if (og + 1u == (tg + 1u) * nx) xb_add(&bar[XB_TOPGEN], 1u);
            else XB_SPIN(xb_ld(&bar[XB_TOPGEN]) == tg, bar);
            __builtin_amdgcn_fence(__ATOMIC_ACQUIRE, "agent");
            xb_add(&bar[XB_XGEN(b.x)], 1u);
            asm volatile("s_waitcnt vmcnt(0)" ::: "memory");
        } else {
            XB_SPIN(xb_ld(&bar[XB_XGEN(b.x)]) == gen, bar);
            __builtin_amdgcn_fence(__ATOMIC_ACQUIRE, "agent");
            asm volatile("s_waitcnt vmcnt(0)" ::: "memory");
        }
    }
    __syncthreads();
}
constexpr int LDS_MISC_OFF = LDS_BYTES - 256;
#ifndef ML_TWICE
#define ML_TWICE 1
#endif
#ifndef TWICE_P5
#define TWICE_P5 0
#endif
#ifndef TWICE_P6
#define TWICE_P6 0
#endif
#ifndef TWICE_P8
#define TWICE_P8 0
#endif
#ifndef P4_TWICE
#define P4_TWICE 1
#endif
#ifndef TWICE_P11
#define TWICE_P11 0
#endif
#ifndef TWICE_P10
#define TWICE_P10 0
#endif
#ifndef TWICE_P1
#define TWICE_P1 0
#endif
#ifndef JLO_DISABLE
#define JLO_DISABLE 0
#endif
constexpr int N_PHASES = 12;
struct Args { const float* in[24]; float* out; unsigned char* ws; int ph_lo, ph_hi; };
static_assert(sizeof(Args) == 24 * 8 + 8 + 8 + 8, "Args has no padding");

__global__ void __launch_bounds__(NTHREADS, 2) fwd_kernel(Args args) {
    extern __shared__ __attribute__((aligned(16))) unsigned char lds[];
    Frame F;
    F.lds = (LAS unsigned char*)lds; F.ldsg = lds;
    F.wave = __builtin_amdgcn_readfirstlane((int)(threadIdx.x >> 6)); F.lane = lane_id(); F.tid = F.wave * 64 + F.lane;
    F.G = gridDim.x; { const int bx = blockIdx.x; F.vcu = (F.G % 8 == 0) ? (bx % 8) * (F.G / 8) + bx / 8 : bx; }
    F.inp = (const __attribute__((address_space(4))) cfp_t*)__builtin_amdgcn_kernarg_segment_ptr();
    F.out = args.out; F.ws = args.ws;
    unsigned char* ws = args.ws;
    const int lo = args.ph_lo, hi = args.ph_hi;
    volatile LAS unsigned* MISC = (volatile LAS unsigned*)(F.lds + LDS_MISC_OFF);
    if (F.tid < 64) MISC[F.tid] = 0u;
    __syncthreads();
    XcdBarrier xbar; xbar.bar = (unsigned*)(ws + WS_CTL); xbar.x = 0; xbar.st = nullptr; xbar.wv = F.wave;
    if (hi - lo > 1) xbar = xcd_barrier_post((unsigned*)(ws + WS_CTL), MISC, F.wave);
#ifndef PHASE_MASK
#define PHASE_MASK 0xfff
#endif
#define IN(k) ((((PHASE_MASK) >> (k)) & 1) && lo <= (k) && (k) < hi)
#ifndef DUP_PHASE
#define DUP_PHASE 99
#endif
#define REP(k) for (int rep_ = 0; rep_ < ((k) == DUP_PHASE ? 2 : 1); ++rep_, ((k) == DUP_PHASE && rep_ < 2 ? xcd_barrier(xbar) : (void)0))
#define SEAM(k) do { if (IN(k) && IN((k) + 1)) { xcd_barrier(xbar); } } while (0)
    if (__builtin_expect(lo < 0, 0)) cg::this_grid().sync();
    float* SSQ1 = (float*)(ws + WS_CTL + CTL_SSQ1); float* SSQ2 = (float*)(ws + WS_CTL + CTL_SSQ2); float* SSQQ = (float*)(ws + WS_CTL + CTL_SSQQ);

#ifdef PROBE_PHASE
    unsigned long long pt0 = 0, pt1 = 0, pu0 = 0, pu1 = 0;
#ifndef PROBE_B
#define PROBE_B 99
#endif
#define STAMP(k) do { if ((k) == PROBE_PHASE) pt0 = __builtin_amdgcn_s_memrealtime(); if ((k) == PROBE_PHASE + 1) pt1 = __builtin_amdgcn_s_memrealtime(); \
                      if ((k) == PROBE_B) pu0 = __builtin_amdgcn_s_memrealtime(); if ((k) == PROBE_B + 1) pu1 = __builtin_amdgcn_s_memrealtime(); } while (0)
#else
#define STAMP(k) do {} while (0)
#endif
    STAMP(0);
#ifdef CLK_PHASE
    unsigned long long ck0 = 0, ck1 = 0, cr0 = 0, cr1 = 0;
#define CLKS(k) do { if ((k) == CLK_PHASE) { ck0 = __builtin_amdgcn_s_memtime(); cr0 = __builtin_amdgcn_s_memrealtime(); } if ((k) == CLK_PHASE + 1) { ck1 = __builtin_amdgcn_s_memtime(); cr1 = __builtin_amdgcn_s_memrealtime(); } } while (0)
#else
#define CLKS(k) do {} while (0)
#endif
    CLKS(0);
    if (IN(0)) REP(0) { p0_prologue(F); }
    SEAM(0); STAMP(1); CLKS(1);
    if (IN(1)) REP(1) {
        { pg8::Gemm g{ws, (unsigned)WS_XN, (unsigned)WS_WIN, DM, DM, DM}; pg8::StdOrder S; S.init(MTOK, NPROJ, DM, DM, F.G, (int)blockIdx.x, TWICE_P1);
          pg8::EpiProj E{(bf16*)(ws + WS_PROJ), F.inp[9], F.inp[10], (const float*)(ws + WS_CTL + CTL_SSQX), (LAS float*)(F.lds + pg8::STAGE_BYTES)};
          pg8::gemm_phase<pg8::EpiProj, pg8::StdOrder, true>(F.lds, g, S, E, F.wave); }
        { pg8::Gemm g{ws, (unsigned)WS_MN, (unsigned)WS_WXKV, DM, DM, 512}; pg8::XkvOrder S{F.G, (int)blockIdx.x};
          pg8::EpiSlab E{(float*)(ws + WS_SLAB), 4096, (size_t)MROWS * 4096};
          pg8::gemm_phase<pg8::EpiSlab, pg8::XkvOrder, false>(F.lds, g, S, E, F.wave); }
    }
    SEAM(1); STAMP(2); CLKS(2);
#ifndef P2_TWICE
#define P2_TWICE 1
#endif
    if (IN(2)) REP(2) { for (int item = F.vcu; item < BATCH * NCHUNK * P2_TWICE; item += F.G) p2_prep_item(F, item & 255, false); }
    SEAM(2); STAMP(3); CLKS(3);
#ifndef P3_TWICE
#define P3_TWICE 1
#endif
    if (IN(3)) REP(3) { for (int item = F.vcu; item < 304 * P3_TWICE; item += F.G) p3_scan_item(F, item % 304); }
    SEAM(3); STAMP(4); CLKS(4);
    if (IN(4)) REP(4) {
        {
            const fox::Srd R = __builtin_amdgcn_make_buffer_rsrc((void*)ws, (short)0, (int)WS_END, 0x00020000);
            unsigned* QC = (unsigned*)(ws + WS_CTL + CTL_QCTR); const int* JLO = (const int*)(ws + WS_JLO);
            const float* CF = (const float*)(ws + WS_CFOX); const float* GO = F.inp[11];
            constexpr int QN = 192 * P4_TWICE, NONE = 1 << 20;
            auto mk_item = [&](int g) { const int qx = g / QN, i = (g - qx * QN) % 192, qb = 15 - (i >> 2), bh = 4 * qx + (i & 3), b = bh >> 3, h = bh & 7;
                fox::Item I; I.rowb = (unsigned)b * SEQ * 2048u + (unsigned)h * (FOXD * 2); I.o = (unsigned)WS_CONCAT + (unsigned)b * SEQ * 4096u + (unsigned)h * (FOXD * 2);
                I.CS = CF + (size_t)bh * SEQ; I.G = GO + h * FOXD; I.P0 = qb * 256; I.jlo = JLO[bh * 16 + qb]; return I; };
            auto is_fox = [&](int g) { return g < NONE && ((g % QN) % 192) < 64; };
            auto pull = [&]() { if (F.tid == 0) { unsigned qc = MISC[17], left = MISC[18]; int g = NONE;
                    while (left > 0u) { const unsigned i = atomicAdd(QC + qc * 64, 1u); if (i < (unsigned)QN) { g = (int)(qc * QN + i); break; } qc = (qc + 1u) & 7u; --left; }
                    MISC[17] = qc; MISC[18] = left; MISC[16] = (unsigned)g; } };
            if (F.tid == 0) { MISC[17] = xb_xcc_id() & 7u; MISC[18] = 8u; }
            pull();
            __syncthreads();
            int cur = __builtin_amdgcn_readfirstlane((int)MISC[16]);
            __syncthreads();
            while (cur < NONE) {
                if (is_fox(cur)) {
                    fox::Item I = mk_item(cur); fox::Seam S;
                    fox::fox_prime(R, I, (char*)lds, S, F.wave);
                    for (;;) {
                        pull();
                        auto next_item = [&](const fox::Item& self, int& nidx) { nidx = __builtin_amdgcn_readfirstlane((int)MISC[16]); return is_fox(nidx) ? mk_item(nidx) : self; };
                        const int nidx = fox::fox_block(R, I, next_item, (char*)lds, S, F.wave);
                        if (!is_fox(nidx)) { cur = nidx; break; }
                        I = mk_item(nidx);
                    }
                    VM_WAIT(); __syncthreads();
                } else {
                    const int qx = cur / QN, it = qx * 128 + ((cur - qx * QN) % 192 - 64), c = it & 63, h = (it >> 6) & 3, b = it >> 8;
                    pull();
                    mls::chunk_out(b, h, c, (const bf16*)(ws + WS_QP), (const bf16*)(ws + WS_KPP), (const bf16*)(ws + WS_VT), (const bf16*)(ws + WS_CST),
                                   (const float*)(ws + WS_NST), (const bf16*)(ws + WS_MO), F.inp[12], (bf16*)(ws + WS_CONCAT), F.lds, F.wave);
                    cur = __builtin_amdgcn_readfirstlane((int)MISC[16]);
                    __syncthreads();
                }
            }
        }
    }
    SEAM(4); STAMP(5); CLKS(5);
    if (IN(5)) REP(5) {
        pg8::Gemm g{ws, (unsigned)WS_CONCAT, (unsigned)WS_WOUT, DM, DM, DM}; pg8::StdOrder S; S.init(MTOK, DM, DM, DM, F.G, (int)blockIdx.x, TWICE_P5);
        pg8::EpiResid<true, false> E{F.inp[0], (bf16*)(ws + WS_X1B), SSQ1, DM, 1.0f, ws + WS_X1Q};
        pg8::gemm_phase<pg8::EpiResid<true, false>, pg8::StdOrder, true>(F.lds, g, S, E, F.wave);
    }
    SEAM(5); STAMP(6); CLKS(6);
    if (IN(6)) REP(6) {
        pg8::Gemm g{ws, (unsigned)WS_X1Q, (unsigned)WS_WXQ, DM / 2, DM / 2, DM / 2}; pg8::StdOrder S; S.init(MTOK, DM, DM / 2, DM / 2, F.G, (int)blockIdx.x, TWICE_P6);
        pg8::EpiQ E{(bf16*)(ws + WS_Q), SSQ1, SSQQ, 1.0f / W8_SCALE};
        pg8::gemm_phase<pg8::EpiQ, pg8::StdOrder, true, true>(F.lds, g, S, E, F.wave);
    }
    SEAM(6); STAMP(7); CLKS(7);
    if (IN(7)) REP(7) {
        pg8::Gemm g{ws, (unsigned)WS_Q, (unsigned)WS_KHAT, DM, DM, XD}; pg8::ScoreOrder S{F.G, (int)blockIdx.x};
        pg8::EpiSoftmax E{(bf16*)(ws + WS_P), SSQQ};
        if (F.G >= 256) pg8::gemm_phase<pg8::EpiSoftmax, pg8::ScoreOrder, false>(F.lds, g, S, E, F.wave);
    }
    SEAM(7); STAMP(8); CLKS(8);
    if (IN(8)) REP(8) {
        pg8::Gemm g{ws, (unsigned)WS_P, (unsigned)WS_VTM, 1024, NMEM, NMEM}; pg8::PvOrder S{F.G, (int)blockIdx.x, TWICE_P8};
        pg8::EpiStoreFp8 E{ws + WS_CO, DM, CO8_SCALE};
        pg8::gemm_phase<pg8::EpiStoreFp8, pg8::PvOrder, true>(F.lds, g, S, E, F.wave);
    }
    SEAM(8); STAMP(9); CLKS(9);
#ifdef EXTRA_BARS
    for (int eb = 0; eb < EXTRA_BARS; ++eb) xcd_barrier(xbar);
#endif
    if (IN(9)) REP(9) {
        pg8::Gemm g{ws, (unsigned)WS_CO, (unsigned)WS_WXO, DM / 2, DM / 2, DM / 2}; pg8::StdOrder S; S.init(MTOK, DM, DM / 2, DM / 2, F.G, (int)blockIdx.x);
        pg8::EpiResid<false, false> E{(const bf16*)(ws + WS_X1B), (bf16*)(ws + WS_X2B), SSQ2, DM, 1.0f / (W8_SCALE * CO8_SCALE), nullptr};
        pg8::gemm_phase<pg8::EpiResid<false, false>, pg8::StdOrder, true, true>(F.lds, g, S, E, F.wave);
    }
    SEAM(9); STAMP(10); CLKS(10);
    if (IN(10)) REP(10) {
        pg8::Gemm g{ws, (unsigned)WS_X2B, (unsigned)WS_WUP, DM, DM, DM}; pg8::StdOrder S; S.init(MTOK, DFF, DM, DM, F.G, (int)blockIdx.x, TWICE_P10);
        pg8::EpiUp E{(bf16*)(ws + WS_H), SSQ2};
        pg8::gemm_phase<pg8::EpiUp, pg8::StdOrder, true>(F.lds, g, S, E, F.wave);
    }
    SEAM(10); STAMP(11); CLKS(11);
    if (IN(11)) REP(11) {
        pg8::Gemm g{ws, (unsigned)WS_H, (unsigned)WS_WDN, DFF, DFF, DFF}; pg8::StdOrder S; S.init(MTOK, DM, DFF, DFF, F.G, (int)blockIdx.x, TWICE_P11);
        pg8::EpiResid<false, true> E{(const bf16*)(ws + WS_X2B), F.out, nullptr, DM, 1.0f, nullptr};
        pg8::gemm_phase<pg8::EpiResid<false, true>, pg8::StdOrder, true>(F.lds, g, S, E, F.wave);
    }
#ifdef CLK_PHASE
    xcd_barrier(xbar); CLKS(12);
    if (blockIdx.x == 0 && F.tid == 0) F.out[0] += rintf((float)(ck1 - ck0) / (float)(cr1 - cr0));
#endif
#ifdef PROBE_PHASE
    xcd_barrier(xbar); STAMP(12);
    if (blockIdx.x == 0 && F.tid < 64) {
        const float ta = 20.0f * rintf((float)(pt1 - pt0) * 0.01f * 0.05f), tb = 0.8f * rintf((float)(pu1 - pu0) * 0.01f * 0.125f);
        if (F.tid == 0) F.out[0] += ta;
        if (PROBE_B != 99) for (int i = F.tid; i < 10000; i += 64) F.out[64 + i] += tb;
    }
#endif
#undef IN
#undef SEAM
}

extern "C" void kernel_launch(void* const* d_in, const int* in_sizes, int n_in, void* d_out, int out_size, void* d_ws, size_t ws_size, hipStream_t stream) {
    static int grid = 0;
    if (grid == 0) {
        if (n_in != 24 || in_sizes[0] != MTOK * DM || out_size != MTOK * DM || ws_size < WS_END) {
            fprintf(stderr, "kernel_launch: unexpected shapes (n_in %d, in0 %d, out %d, ws %zu; need ws >= %zu); nothing launched\n", n_in, n_in > 0 ? in_sizes[0] : -1, out_size, ws_size, (size_t)WS_END); grid = -1; return; }
        int dev = 0, cus = 0, per_cu = 0;
        if (hipGetDevice(&dev) != hipSuccess || hipDeviceGetAttribute(&cus, hipDeviceAttributeMultiprocessorCount, dev) != hipSuccess) { grid = -1; return; }
        if (hipFuncSetAttribute((const void*)fwd_kernel, hipFuncAttributeMaxDynamicSharedMemorySize, LDS_BYTES) != hipSuccess) { fprintf(stderr, "kernel_launch: hipFuncSetAttribute failed\n"); grid = -1; return; }
        if (hipOccupancyMaxActiveBlocksPerMultiprocessor(&per_cu, (const void*)fwd_kernel, NTHREADS, LDS_BYTES) != hipSuccess || per_cu < 1) { fprintf(stderr, "kernel_launch: occupancy query says %d blocks per CU\n", per_cu); per_cu = 1; }
        (void)hipGetLastError();
        grid = cus;
    }
    if (grid < 0) return;
    (void)hipMemsetAsync((char*)d_ws + WS_CTL, 0, CTL_BYTES, stream);
    Args a{};
    for (int i = 0; i < 24; ++i) a.in[i] = (const float*)d_in[i];
    a.out = (float*)d_out; a.ws = (unsigned char*)d_ws;
#if MK_PER_PHASE
    for (int ph = 0; ph < N_PHASES; ++ph) { a.ph_lo = ph; a.ph_hi = ph + 1;
        hipLaunchKernelGGL(fwd_kernel, dim3(grid), dim3(NTHREADS), LDS_BYTES, stream, a); }
#else
    a.ph_lo = 0; a.ph_hi = N_PHASES;
    void* kargs[] = {&a};
    hipError_t e = hipLaunchCooperativeKernel((const void*)fwd_kernel, dim3(grid), dim3(NTHREADS), kargs, LDS_BYTES, stream);
    if (e != hipSuccess) fprintf(stderr, "kernel_launch: cooperative launch failed: %s (grid %d)\n", hipGetErrorString(e), grid);
#endif
}
```

```cpp
#include <hip/hip_runtime.h>
#include <hip/hip_cooperative_groups.h>
#include <cstdio>
#include <cstdint>
namespace cg = cooperative_groups;

constexpr int BATCH = 4, SEQ = 4096, DM = 2048, MTOK = BATCH * SEQ;
constexpr int NMEM = 256, MROWS = BATCH * NMEM;
constexpr int FOXH = 8, FOXD = 128, MLH = 4, MLDV = 256, MLDK = 128, XH = 4, XD = 512, DFF = 8192;
constexpr int IN_WIDTH = 6160, NPROJ = 6144, NCHUNK = SEQ / 64;
constexpr float EPS = 1e-6f;
constexpr float LOG2E = 1.4426950408889634f;

constexpr size_t MiB = (size_t)1 << 20;
constexpr size_t WS_WIN = 0, WS_WOUT = 24 * MiB, WS_WXQ = 32 * MiB, WS_WXKV = 40 * MiB, WS_WXO = 56 * MiB, WS_WUP = 64 * MiB, WS_WDN = 96 * MiB;
constexpr size_t WS_PROJ = 128 * MiB;
constexpr size_t WS_FQ = 128 * MiB, WS_FK = 160 * MiB, WS_FV = 192 * MiB, WS_MQK = 224 * MiB, WS_MV = 256 * MiB, WS_MO = 288 * MiB;
constexpr size_t WS_XN = 320 * MiB;
constexpr size_t WS_QP = 320 * MiB, WS_KPP = 336 * MiB;
constexpr size_t WS_KT = 352 * MiB;
constexpr size_t WS_VT = 368 * MiB;
constexpr size_t WS_MISC = 464 * MiB;
constexpr size_t WS_CTL = WS_MISC, CTL_BYTES = 2 * MiB;
constexpr size_t CTL_QCTR = 32 * 1024;
constexpr size_t CTL_SSQ1 = 64 * 1024, CTL_SSQ2 = 128 * 1024, CTL_SSQQ = 192 * 1024, CTL_SSQX = 448 * 1024;
constexpr size_t WS_GATES = WS_MISC + 1 * MiB;
constexpr size_t WS_CFOX = WS_MISC + 3 * MiB;
constexpr size_t WS_EB = WS_MISC + 4 * MiB;
constexpr size_t WS_KSUM = WS_MISC + 5 * MiB;
constexpr size_t WS_NST = WS_MISC + 6 * MiB;
constexpr size_t WS_JLO = WS_MISC + 7 * MiB;
constexpr size_t WS_MN = WS_MISC + 8 * MiB;
constexpr size_t WS_KHAT = WS_MISC + 12 * MiB;
constexpr size_t WS_VTM = WS_MISC + 16 * MiB;
constexpr size_t WS_END = 512 * MiB;
constexpr size_t WS_CONCAT = 224 * MiB;
constexpr size_t WS_X1B = 128 * MiB;
constexpr size_t WS_Q = 192 * MiB;
constexpr size_t WS_CO = 256 * MiB;
constexpr size_t WS_P = 320 * MiB;
constexpr size_t WS_X1Q = 288 * MiB;
constexpr size_t WS_X2B = 128 * MiB;
constexpr size_t WS_H = 192 * MiB;
constexpr size_t WS_SLAB = 400 * MiB;
constexpr size_t WS_CST = 400 * MiB;

#ifndef P3_SCAN_REP
#define P3_SCAN_REP 1
#endif
#ifndef JLO_DISABLE
#define JLO_DISABLE 0
#endif
constexpr float W8_SCALE = 64.0f, CO8_SCALE = 8.0f;
constexpr int LDS_BYTES = 147456;
constexpr int NTHREADS = 512;

#define GAS __attribute__((address_space(1)))
#define LAS __attribute__((address_space(3)))
typedef unsigned short bf16;
typedef unsigned v4u __attribute__((ext_vector_type(4)));
typedef unsigned v2u __attribute__((ext_vector_type(2)));
typedef float v4f __attribute__((ext_vector_type(4)));
typedef short v8s __attribute__((ext_vector_type(8)));
typedef short v4s __attribute__((ext_vector_type(4)));
#define LDS_WAIT() asm volatile("s_waitcnt lgkmcnt(0)" ::: "memory")
#define VM_WAIT() asm volatile("s_waitcnt vmcnt(0)" ::: "memory")
__device__ __forceinline__ unsigned f2bf(float f) { unsigned u = __builtin_bit_cast(unsigned, f); return (u + 0x7fffu + ((u >> 16) & 1u)) >> 16; }
__device__ __forceinline__ unsigned pk2(float lo, float hi) { return f2bf(lo) | (f2bf(hi) << 16); }
__device__ __forceinline__ float bf2f(unsigned h) { return __builtin_bit_cast(float, h << 16); }
__device__ __forceinline__ float bflo(unsigned w) { return __builtin_bit_cast(float, w << 16); }
__device__ __forceinline__ float bfhi(unsigned w) { return __builtin_bit_cast(float, w & 0xffff0000u); }
__device__ __forceinline__ float wave_sum(float v) {
#pragma unroll
    for (int o = 1; o < 64; o <<= 1) v += __shfl_xor(v, o);
    return v;
}
__device__ __forceinline__ int lane_id() { return (int)__builtin_amdgcn_mbcnt_hi(~0u, __builtin_amdgcn_mbcnt_lo(~0u, 0u)); }
__device__ __forceinline__ int wg_tid(int wv) { int t = wv * 64 + lane_id(); asm volatile("" : "+v"(t)); return t; }
__device__ __forceinline__ float logsigmoidf(float x) { return x >= 0.f ? -log1pf(__expf(-x)) : x - log1pf(__expf(x)); }
__device__ __forceinline__ float sigmoidf_(float x) { return 1.f / (1.f + __expf(-x)); }
__device__ __forceinline__ float rinv_of(const float* ssqx, size_t row) { return 1.0f / sqrtf(ssqx[row] * (1.0f / DM) + EPS); }
#define MK_PER_PHASE 0
namespace pg8 {
#define PG8_LAS __attribute__((address_space(3)))
typedef unsigned short bf16_t;
typedef short bf16x8 __attribute__((ext_vector_type(8)));
typedef float f32x4 __attribute__((ext_vector_type(4)));
typedef float f32x2 __attribute__((ext_vector_type(2)));
typedef unsigned u32x4 __attribute__((ext_vector_type(4)));
typedef unsigned u32x2 __attribute__((ext_vector_type(2)));
constexpr int BM = 256, BK = 64, HALF = 128, HTB = HALF * BK * 2, STAGE_BYTES = 8 * HTB, NXCD = 8, WGM = 8;

__host__ __device__ __forceinline__ int lds_byte(int r, int c) { const int st = (r >> 4) * 2 + (c >> 5), rr = r & 15, cc = c & 31, ob = rr * 64 + cc * 2; return st * 1024 + (ob ^ (((ob >> 9) & 1) << 5)); }
__host__ __device__ __forceinline__ void stage_rc(int b, int& R, int& C) { const int st = b / 1024, sb = b % 1024, swz = sb ^ (((sb >> 9) & 1) << 5); R = (st >> 1) * 16 + swz / 64; C = (st & 1) * 32 + (swz % 64) / 2; }
__host__ __device__ __forceinline__ int perm32(int rho) { const int n = rho >> 4, i = rho & 15; return 8 * (i >> 2) + 4 * n + (i & 3); }

struct Unit { int row0, col0; long aoff, boff; int aux; };
struct Gemm { const void* base; unsigned aoff, boff; int lda, ldb, K; };

struct StdOrder {
    int nM, nN, nwg, G, c, lda, ldb, rsh;
    __device__ void init(int M, int N, int lda_, int ldb_, int G_, int c_, int rsh_ = 0) { nM = M / BM; nN = N / BM; nwg = nM * nN; G = G_; c = c_; lda = lda_; ldb = ldb_; rsh = rsh_; }
    __device__ bool next(int i, Unit& u) const {
        const long L = (long)(i >> rsh) * G + c; if (L >= nwg) return false;
        int wgid = (int)L; { const int q = nwg / NXCD, r = nwg % NXCD, xcd = wgid % NXCD, off = wgid / NXCD; wgid = (xcd < r ? xcd * (q + 1) : r * (q + 1) + (xcd - r) * q) + off; }
        const int nig = WGM * nN, gid = wgid / nig, fm = gid * WGM, gsz = (nM - fm) < WGM ? (nM - fm) : WGM;
        const int pm = fm + ((wgid % nig) % gsz), pn = (wgid % nig) / gsz;
        u.row0 = pm * BM; u.col0 = pn * BM; u.aoff = (long)pm * BM * lda; u.boff = (long)pn * BM * ldb; u.aux = i & ((1 << rsh) - 1); return true;
    }
};

__device__ __forceinline__ unsigned cvt_pk_bf16(float lo, float hi) { unsigned r; asm volatile("v_cvt_pk_bf16_f32 %0, %1, %2" : "=v"(r) : "v"(lo), "v"(hi)); return r; }

typedef int v8i_t __attribute__((ext_vector_type(8)));
typedef int v4i_t __attribute__((ext_vector_type(4)));
template <class Epi, class Sched, bool ALIGN_EPI, bool FP8 = false>
__device__ __forceinline__ void gemm_phase(PG8_LAS unsigned char* lds, const Gemm g, const Sched& S, const Epi& E, int wv) {
    const int tid = wg_tid(wv), wid = wv, lane = tid & 63, wr = wid >> 2, wc = wid & 3, fr = lane & 15, fq = lane >> 4;
    const int K = g.K, nt = K / BK;
    unsigned voffA, voffB;
    { int R, C; stage_rc(tid * 16, R, C); const int Rb = Epi::PERM ? ((R & ~31) + perm32(R & 31)) : R;
      voffA = (unsigned)(R * g.lda + C) * 2u; voffB = (unsigned)(Rb * g.ldb + C) * 2u; }
    const unsigned pA = 64u * (unsigned)g.lda * 2u, pB = 64u * (unsigned)g.ldb * 2u;
    const unsigned voffA_v = voffA, voffB_v = voffB, voffA_p = pA, voffB_p = pB;
    const unsigned kstep = (unsigned)(BK * 2);
    const unsigned hA = (unsigned)HALF * g.lda * 2, hB = (unsigned)HALF * g.ldb * 2;
    const __amdgpu_buffer_rsrc_t rsrc = __builtin_amdgcn_make_buffer_rsrc((void*)g.base, (short)0, 0x7fffffff, 0x00020000);
    const unsigned ldsw = (unsigned)wid * 1024u;
    const int aoff = lds_byte(wr * 64 + fr, fq * 8), boff = lds_byte(wc * 32 + fr, fq * 8);
#define PG8_SA(b, h) (((b) * 2 + (h)) * HTB)
#define PG8_SB(b, h) ((4 + (b) * 2 + (h)) * HTB)
#define PG8_STAGE(bufoff, gbase, voff) do { _Pragma("unroll") for (int _i = 0; _i < 2; ++_i) \
        __builtin_amdgcn_raw_ptr_buffer_load_lds(rsrc, (PG8_LAS void*)(lds + (bufoff) + ldsw + _i * 8192), 16, voff##_v, (gbase) + _i * voff##_p, 0, 0); } while (0)
#define PG8_LDA(dst, b, h) do { _Pragma("unroll") for (int m = 0; m < 4; ++m) dst[m] = PG8_CAT(*(const PG8_LAS v4i_t*)(lds + PG8_SA(b, h) + aoff + m * 2048), *(const PG8_LAS v4i_t*)(lds + PG8_SA(b, h) + aoff + m * 2048 + 1024)); } while (0)
#define PG8_LDB(dst, b, h) do { _Pragma("unroll") for (int n = 0; n < 2; ++n) dst[n] = PG8_CAT(*(const PG8_LAS v4i_t*)(lds + PG8_SB(b, h) + boff + n * 2048), *(const PG8_LAS v4i_t*)(lds + PG8_SB(b, h) + boff + n * 2048 + 1024)); } while (0)
#define PG8_CAT(x0, x1) __builtin_shufflevector((x0), (x1), 0, 1, 2, 3, 4, 5, 6, 7)
#define PG8_K0(x) __builtin_bit_cast(bf16x8, __builtin_shufflevector((x), (x), 0, 1, 2, 3))
#define PG8_K1(x) __builtin_bit_cast(bf16x8, __builtin_shufflevector((x), (x), 4, 5, 6, 7))
#define PG8_MMA(ai, bj, At, Bt) do { __builtin_amdgcn_s_setprio(1); _Pragma("unroll") for (int m = 0; m < 4; ++m) _Pragma("unroll") for (int n = 0; n < 2; ++n) { \
        if constexpr (FP8) asm volatile("v_mfma_f32_16x16x128_f8f6f4 %0, %1, %2, %0" : "+v"(acc[ai][bj][m][n]) : "v"(Bt[n]), "v"(At[m]));     \
        else { acc[ai][bj][m][n] = __builtin_amdgcn_mfma_f32_16x16x32_bf16(PG8_K0(Bt[n]), PG8_K0(At[m]), acc[ai][bj][m][n], 0, 0, 0); \
               acc[ai][bj][m][n] = __builtin_amdgcn_mfma_f32_16x16x32_bf16(PG8_K1(Bt[n]), PG8_K1(At[m]), acc[ai][bj][m][n], 0, 0, 0); } } \
        __builtin_amdgcn_s_setprio(0); } while (0)
#define PG8_WAIT_V(n) asm volatile("s_waitcnt vmcnt(" #n ")" ::: "memory")
#define PG8_WAIT_L(n) asm volatile("s_waitcnt lgkmcnt(" #n ")" ::: "memory")
#define PG8_BAR __builtin_amdgcn_s_barrier()
#define PG8_SCHED __builtin_amdgcn_sched_barrier(0)
    Unit cur, nxt; int ui = 0;
    if (!S.next(0, cur)) return;
    f32x4 acc[2][2][4][2];
#pragma unroll
    for (int a = 0; a < 2; ++a)
#pragma unroll
        for (int b = 0; b < 2; ++b)
#pragma unroll
            for (int m = 0; m < 4; ++m)
#pragma unroll
                for (int n = 0; n < 2; ++n) acc[a][b][m][n] = (f32x4){0.f, 0.f, 0.f, 0.f};
    v8i_t At[4], B0[2], B1[2];
    unsigned cA = g.aoff + (unsigned)cur.aoff * 2u, cB = g.boff + (unsigned)cur.boff * 2u;
    PG8_STAGE(PG8_SB(0, 0), cB, voffB); PG8_STAGE(PG8_SB(0, 1), cB + hB, voffB); PG8_STAGE(PG8_SA(0, 0), cA, voffA); PG8_STAGE(PG8_SA(0, 1), cA + hA, voffA);
    if (wr == 1) PG8_BAR;
    PG8_WAIT_V(2); PG8_BAR;
    PG8_STAGE(PG8_SB(1, 0), cB + kstep, voffB); PG8_STAGE(PG8_SA(1, 0), cA + kstep, voffA); PG8_STAGE(PG8_SB(1, 1), cB + hB + kstep, voffB);
    PG8_WAIT_V(6); PG8_BAR;
    for (;;) {
        const bool has_next = S.next(ui + 1, nxt);
        const unsigned nA = has_next ? g.aoff + (unsigned)nxt.aoff * 2u : cA, nB = has_next ? g.boff + (unsigned)nxt.boff * 2u : cB;
        for (int t = 0; t < nt; t += 2) {
            const bool last = (t == nt - 2);
            const unsigned a1 = cA + (unsigned)(t + 1) * kstep;
            const unsigned a2 = last ? nA : cA + (unsigned)(t + 2) * kstep, b2 = last ? nB : cB + (unsigned)(t + 2) * kstep;
            const unsigned a3 = a2 + kstep, b3 = b2 + kstep;
            PG8_LDB(B0, 0, 0); PG8_LDB(B1, 0, 1); PG8_SCHED; PG8_LDA(At, 0, 0); PG8_STAGE(PG8_SA(1, 1), a1 + hA, voffA);
            PG8_WAIT_V(8); PG8_WAIT_L(0); PG8_BAR; PG8_MMA(0, 0, At, B0); PG8_MMA(0, 1, At, B1); PG8_BAR; PG8_SCHED;
            PG8_LDA(At, 0, 1); PG8_STAGE(PG8_SB(0, 0), b2, voffB); PG8_STAGE(PG8_SB(0, 1), b2 + hB, voffB); PG8_STAGE(PG8_SA(0, 0), a2, voffA);
            PG8_WAIT_V(8); PG8_WAIT_L(0); PG8_BAR; PG8_MMA(1, 0, At, B0); PG8_MMA(1, 1, At, B1); PG8_BAR; PG8_SCHED;
            PG8_LDB(B0, 1, 0); PG8_LDB(B1, 1, 1); PG8_SCHED; PG8_LDA(At, 1, 0); PG8_STAGE(PG8_SA(0, 1), a2 + hA, voffA);
            PG8_WAIT_V(8); PG8_WAIT_L(0); PG8_BAR; PG8_MMA(0, 0, At, B0); PG8_MMA(0, 1, At, B1); PG8_BAR; PG8_SCHED;
            PG8_LDA(At, 1, 1); PG8_STAGE(PG8_SB(1, 0), b3, voffB); PG8_STAGE(PG8_SB(1, 1), b3 + hB, voffB); PG8_STAGE(PG8_SA(1, 0), a3, voffA);
            PG8_WAIT_V(8); PG8_WAIT_L(0); PG8_BAR; PG8_MMA(1, 0, At, B0); PG8_MMA(1, 1, At, B1); PG8_BAR; PG8_SCHED;
        }
        if constexpr (ALIGN_EPI) { if (wr == 0) PG8_BAR; }
        if constexpr (FP8) asm volatile("s_nop 15\n\ts_nop 7" ::: "memory");
        if constexpr (!Epi::AFTER_DRAIN) { E(acc, cur, wr, wc, fr, fq); }
        if (!has_next) break;
#pragma unroll
        for (int a = 0; a < 2; ++a)
#pragma unroll
            for (int b = 0; b < 2; ++b)
#pragma unroll
                for (int m = 0; m < 4; ++m)
#pragma unroll
                    for (int n = 0; n < 2; ++n) acc[a][b][m][n] = (f32x4){0.f, 0.f, 0.f, 0.f};
        cur = nxt; cA = nA; cB = nB; ++ui;
        if constexpr (ALIGN_EPI) { if (wr == 1) PG8_BAR; }
    }
    PG8_WAIT_V(0);
    if constexpr (!ALIGN_EPI) { if (wr == 0) PG8_BAR; }
    PG8_BAR;
    if constexpr (Epi::AFTER_DRAIN) { E.fused(acc, cur, wr, wc, fr, fq, lds, wid, lane); }
#undef PG8_SA
#undef PG8_SB
#undef PG8_STAGE
#undef PG8_LDA
#undef PG8_LDB
#undef PG8_MMA
#undef PG8_CAT
#undef PG8_K0
#undef PG8_K1
#undef PG8_WAIT_V
#undef PG8_WAIT_L
#undef PG8_BAR
#undef PG8_SCHED
}
}
namespace pg8 {
struct XkvOrder {
    int G, c;
    __device__ bool next(int i, Unit& u) const {
        const int L = i * G + c; if (L >= 256) return false;
        const int kq = L & 3, tile = L >> 2, pm = tile & 3, pn = tile >> 2;
        u.row0 = pm * 256; u.col0 = pn * 256; u.aoff = (long)pm * 256 * DM + kq * 512; u.boff = (long)pn * 256 * DM + kq * 512; u.aux = kq; return true;
    }
};
struct ScoreOrder {
    int G, c;
    __device__ bool next(int i, Unit& u) const {
        const int L = i * G + c; if (L >= 256) return false;
        const int b = L >> 6, h = (L >> 4) & 3, mt = L & 15;
        u.row0 = b * SEQ + mt * 256; u.col0 = h * 256; u.aoff = (long)u.row0 * DM + h * XD; u.boff = (long)(b * NMEM) * DM + h * XD; u.aux = h; return true;
    }
};
struct PvOrder {
    int G, c, rsh;
    __device__ bool next(int i, Unit& u) const {
        const int L = (i >> rsh) * G + c; if (L >= 512) return false;
        const int nt = L & 1, mt = (L >> 1) & 15, h = (L >> 5) & 3, b = L >> 7;
        u.row0 = b * SEQ + mt * 256; u.col0 = h * XD + nt * 256; u.aoff = (long)u.row0 * 1024 + h * 256; u.boff = ((long)(b * XH + h) * XD + nt * 256) * NMEM; u.aux = 0; return true;
    }
};

__device__ __forceinline__ unsigned pk4_fp8(float a, float b, float c, float d) { int w = __builtin_amdgcn_cvt_pk_fp8_f32(a, b, 0, false); w = __builtin_amdgcn_cvt_pk_fp8_f32(c, d, w, true); return (unsigned)w; }
struct EpiStoreBf16 {
    static constexpr bool PERM = true, AFTER_DRAIN = false;
    bf16_t* O; int ldc; int split_cols; size_t split_stride;
    __device__ __forceinline__ void operator()(const f32x4 (&acc)[2][2][4][2], const Unit& u, int wr, int wc, int fr, int fq) const {
        int colt = u.col0; bf16_t* base = O;
        if (split_cols) { const int t = colt / split_cols; base += (size_t)t * split_stride; colt -= t * split_cols; }
        const int row0 = u.row0 + wr * 64 + fr, col0 = colt + wc * 32 + 8 * fq;
#pragma unroll
        for (int ai = 0; ai < 2; ++ai)
#pragma unroll
            for (int m = 0; m < 4; ++m) { bf16_t* rowp = base + (size_t)(row0 + ai * HALF + m * 16) * ldc + col0;
#pragma unroll
                for (int bj = 0; bj < 2; ++bj) { const f32x4 v0 = acc[ai][bj][m][0], v1 = acc[ai][bj][m][1];
                    u32x4 w; w.x = cvt_pk_bf16(v0[0], v0[1]); w.y = cvt_pk_bf16(v0[2], v0[3]); w.z = cvt_pk_bf16(v1[0], v1[1]); w.w = cvt_pk_bf16(v1[2], v1[3]);
                    *(u32x4*)(rowp + bj * HALF) = w; } }
    }
};
struct EpiProj {
    static constexpr bool PERM = true, AFTER_DRAIN = false;
    bf16_t* O; const float* gq; const float* gk; const float* ssqx; PG8_LAS float* red;
    __device__ __forceinline__ void operator()(f32x4 (&acc)[2][2][4][2], const Unit& u, int wr, int wc, int fr, int fq) const {
        const int t = u.col0 >> 10, colt = u.col0 & 1023; bf16_t* base = O + (size_t)t * ((size_t)MTOK * 1024);
        const int row0 = u.row0 + wr * 64 + fr, col0 = colt + wc * 32 + 8 * fq;
#pragma unroll
        for (int ai = 0; ai < 2; ++ai)
#pragma unroll
            for (int m = 0; m < 4; ++m) { const float rx = __builtin_amdgcn_rsqf(ssqx[row0 + ai * HALF + m * 16] * (1.0f / DM) + EPS);
#pragma unroll
                for (int bj = 0; bj < 2; ++bj) { acc[ai][bj][m][0] = acc[ai][bj][m][0] * rx; acc[ai][bj][m][1] = acc[ai][bj][m][1] * rx; } }
        if (u.col0 < 2048) {
            const float* g = (t == 0 ? gq : gk) + wc * 32 + 8 * fq; const f32x4 g0 = *(const f32x4*)g, g1 = *(const f32x4*)(g + 4);
#pragma unroll
            for (int ai = 0; ai < 2; ++ai)
#pragma unroll
                for (int m = 0; m < 4; ++m) { const int rl = ai * HALF + wr * 64 + m * 16 + fr;
#pragma unroll
                    for (int bj = 0; bj < 2; ++bj) { const f32x4 v0 = acc[ai][bj][m][0], v1 = acc[ai][bj][m][1];
                        float s = (v0[0] * v0[0] + v0[1] * v0[1]) + (v0[2] * v0[2] + v0[3] * v0[3]) + (v1[0] * v1[0] + v1[1] * v1[1]) + (v1[2] * v1[2] + v1[3] * v1[3]);
                        s += __shfl_xor(s, 16); s += __shfl_xor(s, 32);
                        if (fq == 0) red[(rl * 2 + bj) * 4 + wc] = s; } }
            asm volatile("s_waitcnt lgkmcnt(0)" ::: "memory"); __builtin_amdgcn_s_barrier(); asm volatile("" ::: "memory");
#pragma unroll
            for (int ai = 0; ai < 2; ++ai)
#pragma unroll
                for (int m = 0; m < 4; ++m) { const int rl = ai * HALF + wr * 64 + m * 16 + fr;
#pragma unroll
                    for (int bj = 0; bj < 2; ++bj) { const f32x4 r4 = *(const PG8_LAS f32x4*)(red + (rl * 2 + bj) * 4);
                        const float ri = __builtin_amdgcn_rsqf(((r4[0] + r4[1]) + (r4[2] + r4[3])) * (1.0f / FOXD) + EPS);
                        acc[ai][bj][m][0] = acc[ai][bj][m][0] * ri * g0; acc[ai][bj][m][1] = acc[ai][bj][m][1] * ri * g1; } }
        }
#pragma unroll
        for (int ai = 0; ai < 2; ++ai)
#pragma unroll
            for (int m = 0; m < 4; ++m) { bf16_t* rowp = base + (size_t)(row0 + ai * HALF + m * 16) * 1024 + col0;
#pragma unroll
                for (int bj = 0; bj < 2; ++bj) { const f32x4 v0 = acc[ai][bj][m][0], v1 = acc[ai][bj][m][1];
                    u32x4 w; w.x = cvt_pk_bf16(v0[0], v0[1]); w.y = cvt_pk_bf16(v0[2], v0[3]); w.z = cvt_pk_bf16(v1[0], v1[1]); w.w = cvt_pk_bf16(v1[2], v1[3]);
                    *(u32x4*)(rowp + bj * HALF) = w; } }
    }
};
struct EpiStoreFp8 {
    static constexpr bool PERM = true, AFTER_DRAIN = false;
    unsigned char* O8; int ldc; float scale;
    __device__ __forceinline__ void operator()(const f32x4 (&acc)[2][2][4][2], const Unit& u, int wr, int wc, int fr, int fq) const {
        const int row0 = u.row0 + wr * 64 + fr, col0 = u.col0 + wc * 32 + 8 * fq;
#pragma unroll
        for (int ai = 0; ai < 2; ++ai)
#pragma unroll
            for (int m = 0; m < 4; ++m) { unsigned char* rowp = O8 + (size_t)(row0 + ai * HALF + m * 16) * ldc + col0;
#pragma unroll
                for (int bj = 0; bj < 2; ++bj) { const f32x4 v0 = acc[ai][bj][m][0] * scale, v1 = acc[ai][bj][m][1] * scale;
                    u32x2 w; w.x = pk4_fp8(v0[0], v0[1], v0[2], v0[3]); w.y = pk4_fp8(v1[0], v1[1], v1[2], v1[3]);
                    *(u32x2*)(rowp + bj * HALF) = w; } }
    }
};
struct EpiSlab {
    static constexpr bool PERM = false, AFTER_DRAIN = false;
    float* slab; int ldc; size_t slab_stride;
    __device__ __forceinline__ void operator()(const f32x4 (&acc)[2][2][4][2], const Unit& u, int wr, int wc, int fr, int fq) const {
        float* base = slab + (size_t)u.aux * slab_stride; const int col0 = u.col0 + wc * 32 + 4 * fq;
#pragma unroll
        for (int ai = 0; ai < 2; ++ai)
#pragma unroll
            for (int m = 0; m < 4; ++m) { float* rowp = base + (size_t)(u.row0 + ai * HALF + wr * 64 + m * 16 + fr) * ldc + col0;
#pragma unroll
                for (int bj = 0; bj < 2; ++bj)
#pragma unroll
                    for (int n = 0; n < 2; ++n) *(f32x4*)(rowp + bj * HALF + n * 16) = acc[ai][bj][m][n]; }
    }
};
template <bool BASEF, bool OUTF>
struct EpiResid {
    static constexpr bool PERM = true, AFTER_DRAIN = false;
    const void* base; void* out; float* ssq; int ldc; float ascale; unsigned char* out8;
    __device__ __forceinline__ void operator()(const f32x4 (&acc)[2][2][4][2], const Unit& u, int wr, int wc, int fr, int fq) const {
        const int col0 = u.col0 + wc * 32 + 8 * fq;
        float ssum[2][4];
#pragma unroll
        for (int ai = 0; ai < 2; ++ai) {
            f32x4 bv[4][2][2];
#pragma unroll
            for (int m = 0; m < 4; ++m) { const size_t off = (size_t)(u.row0 + ai * HALF + wr * 64 + m * 16 + fr) * ldc + col0;
#pragma unroll
                for (int bj = 0; bj < 2; ++bj) {
                    if constexpr (BASEF) { bv[m][bj][0] = *(const f32x4*)((const float*)base + off + bj * HALF); bv[m][bj][1] = *(const f32x4*)((const float*)base + off + bj * HALF + 4); }
                    else { const u32x4 w = *(const u32x4*)((const bf16_t*)base + off + bj * HALF);
                        bv[m][bj][0] = (f32x4){__builtin_bit_cast(float, w.x << 16), __builtin_bit_cast(float, w.x & 0xffff0000u), __builtin_bit_cast(float, w.y << 16), __builtin_bit_cast(float, w.y & 0xffff0000u)};
                        bv[m][bj][1] = (f32x4){__builtin_bit_cast(float, w.z << 16), __builtin_bit_cast(float, w.z & 0xffff0000u), __builtin_bit_cast(float, w.w << 16), __builtin_bit_cast(float, w.w & 0xffff0000u)}; } } }
#pragma unroll
            for (int m = 0; m < 4; ++m) { const size_t off = (size_t)(u.row0 + ai * HALF + wr * 64 + m * 16 + fr) * ldc + col0; float s = 0.f;
#pragma unroll
                for (int bj = 0; bj < 2; ++bj) { const f32x4 v0 = bv[m][bj][0] + acc[ai][bj][m][0] * ascale, v1 = bv[m][bj][1] + acc[ai][bj][m][1] * ascale;
                    if (out8) { u32x2 w8; w8.x = pk4_fp8(v0[0], v0[1], v0[2], v0[3]); w8.y = pk4_fp8(v1[0], v1[1], v1[2], v1[3]); *(u32x2*)(out8 + off + bj * HALF) = w8; }
                    if constexpr (OUTF) { *(f32x4*)((float*)out + off + bj * HALF) = v0; *(f32x4*)((float*)out + off + bj * HALF + 4) = v1; }
                    else { u32x4 w; w.x = cvt_pk_bf16(v0[0], v0[1]); w.y = cvt_pk_bf16(v0[2], v0[3]); w.z = cvt_pk_bf16(v1[0], v1[1]); w.w = cvt_pk_bf16(v1[2], v1[3]);
                        *(u32x4*)((bf16_t*)out + off + bj * HALF) = w; }
                    s += (v0[0] * v0[0] + v0[1] * v0[1]) + (v0[2] * v0[2] + v0[3] * v0[3]) + (v1[0] * v1[0] + v1[1] * v1[1]) + (v1[2] * v1[2] + v1[3] * v1[3]); }
                s += __shfl_xor(s, 16); s += __shfl_xor(s, 32); ssum[ai][m] = s; } }
        if (ssq && u.aux == 0) {
#pragma unroll
            for (int ai = 0; ai < 2; ++ai) { const float v = fq == 0 ? ssum[ai][0] : fq == 1 ? ssum[ai][1] : fq == 2 ? ssum[ai][2] : ssum[ai][3];
                atomicAdd(ssq + u.row0 + ai * HALF + wr * 64 + fq * 16 + fr, v); }
        }
    }
};
struct EpiQ {
    static constexpr bool PERM = true, AFTER_DRAIN = false;
    bf16_t* O; const float* ssq_in; float* ssq_out; float oscale;
    __device__ __forceinline__ void operator()(const f32x4 (&acc)[2][2][4][2], const Unit& u, int wr, int wc, int fr, int fq) const {
        const int col0 = u.col0 + wc * 32 + 8 * fq; float* so = ssq_out + (size_t)(u.col0 / XD) * MTOK;
        float ssum[2][4];
#pragma unroll
        for (int ai = 0; ai < 2; ++ai)
#pragma unroll
            for (int m = 0; m < 4; ++m) { const int row = u.row0 + ai * HALF + wr * 64 + m * 16 + fr; const float ri = __builtin_amdgcn_rsqf(ssq_in[row] * (1.0f / DM) + EPS) * oscale;
                bf16_t* rowp = O + (size_t)row * DM + col0; float s = 0.f;
#pragma unroll
                for (int bj = 0; bj < 2; ++bj) { const f32x4 v0 = acc[ai][bj][m][0] * ri, v1 = acc[ai][bj][m][1] * ri;
                    u32x4 w; w.x = cvt_pk_bf16(v0[0], v0[1]); w.y = cvt_pk_bf16(v0[2], v0[3]); w.z = cvt_pk_bf16(v1[0], v1[1]); w.w = cvt_pk_bf16(v1[2], v1[3]);
                    *(u32x4*)(rowp + bj * HALF) = w;
                    s += (v0[0] * v0[0] + v0[1] * v0[1]) + (v0[2] * v0[2] + v0[3] * v0[3]) + (v1[0] * v1[0] + v1[1] * v1[1]) + (v1[2] * v1[2] + v1[3] * v1[3]); }
                s += __shfl_xor(s, 16); s += __shfl_xor(s, 32); ssum[ai][m] = s; }
        if (u.aux == 0)
#pragma unroll
        for (int ai = 0; ai < 2; ++ai) { const float v = fq == 0 ? ssum[ai][0] : fq == 1 ? ssum[ai][1] : fq == 2 ? ssum[ai][2] : ssum[ai][3];
            atomicAdd(so + u.row0 + ai * HALF + wr * 64 + fq * 16 + fr, v); }
    }
};
struct EpiUp {
    static constexpr bool PERM = true, AFTER_DRAIN = false;
    bf16_t* O; const float* ssq_in;
    __device__ __forceinline__ void operator()(const f32x4 (&acc)[2][2][4][2], const Unit& u, int wr, int wc, int fr, int fq) const {
        const int col0 = u.col0 + wc * 32 + 8 * fq;
#pragma unroll
        for (int ai = 0; ai < 2; ++ai)
#pragma unroll
            for (int m = 0; m < 4; ++m) { const int row = u.row0 + ai * HALF + wr * 64 + m * 16 + fr; const float ri = __builtin_amdgcn_rsqf(ssq_in[row] * (1.0f / DM) + EPS);
                bf16_t* rowp = O + (size_t)row * DFF + col0;
#pragma unroll
                for (int bj = 0; bj < 2; ++bj) { f32x4 v0 = acc[ai][bj][m][0] * ri, v1 = acc[ai][bj][m][1] * ri;
#pragma unroll
                    for (int e = 0; e < 4; ++e) { const float a = fmaxf(v0[e], 0.f), b = fmaxf(v1[e], 0.f); v0[e] = a * a; v1[e] = b * b; }
                    u32x4 w; w.x = cvt_pk_bf16(v0[0], v0[1]); w.y = cvt_pk_bf16(v0[2], v0[3]); w.z = cvt_pk_bf16(v1[0], v1[1]); w.w = cvt_pk_bf16(v1[2], v1[3]);
                    *(u32x4*)(rowp + bj * HALF) = w; } }
    }
};
struct EpiSoftmax {
    static constexpr bool PERM = true, AFTER_DRAIN = true;
    bf16_t* P; const float* ssqq;
    __device__ __forceinline__ void fused(f32x4 (&acc)[2][2][4][2], const Unit& u, int wr, int wc, int fr, int fq, PG8_LAS unsigned char* lds, int wid, int lane) const {
        PG8_LAS float* RM = (PG8_LAS float*)lds;
        PG8_LAS float* RS = (PG8_LAS float*)(lds + 4096);
        const float* sq = ssqq + (size_t)u.aux * MTOK;
        float mx[2][4];
#pragma unroll
        for (int ai = 0; ai < 2; ++ai)
#pragma unroll
            for (int m = 0; m < 4; ++m) { const int rl = ai * HALF + wr * 64 + m * 16 + fr; const int row = u.row0 + rl;
                const float sc = __builtin_amdgcn_rsqf(sq[row] * (1.0f / XD) + EPS) * (0.044194173824159216f * LOG2E);
                float mxx = -3.0e38f;
#pragma unroll
                for (int bj = 0; bj < 2; ++bj)
#pragma unroll
                    for (int n = 0; n < 2; ++n) { f32x4 v = acc[ai][bj][m][n] * sc; acc[ai][bj][m][n] = v; mxx = fmaxf(mxx, fmaxf(fmaxf(v[0], v[1]), fmaxf(v[2], v[3]))); }
                mxx = fmaxf(mxx, __shfl_xor(mxx, 16)); mxx = fmaxf(mxx, __shfl_xor(mxx, 32));
                if (fq == 0) RM[rl * 4 + wc] = mxx; }
        asm volatile("s_waitcnt lgkmcnt(0)" ::: "memory"); __builtin_amdgcn_s_barrier(); asm volatile("" ::: "memory");
#pragma unroll
        for (int ai = 0; ai < 2; ++ai)
#pragma unroll
            for (int m = 0; m < 4; ++m) { const int rl = ai * HALF + wr * 64 + m * 16 + fr;
                const f32x4 r4 = *(const PG8_LAS f32x4*)(RM + rl * 4); const float mxx = fmaxf(fmaxf(r4[0], r4[1]), fmaxf(r4[2], r4[3])); mx[ai][m] = mxx; float s = 0.f;
#pragma unroll
                for (int bj = 0; bj < 2; ++bj)
#pragma unroll
                    for (int n = 0; n < 2; ++n) { f32x4 v = acc[ai][bj][m][n];
#pragma unroll
                        for (int e = 0; e < 4; ++e) { v[e] = __builtin_amdgcn_exp2f(v[e] - mxx); s += v[e]; }
                        acc[ai][bj][m][n] = v; }
                s += __shfl_xor(s, 16); s += __shfl_xor(s, 32);
                if (fq == 0) RS[rl * 4 + wc] = s; }
        asm volatile("s_waitcnt lgkmcnt(0)" ::: "memory"); __builtin_amdgcn_s_barrier(); asm volatile("" ::: "memory");
        const int col0 = u.col0 + wc * 32 + 8 * fq;
#pragma unroll
        for (int ai = 0; ai < 2; ++ai)
#pragma unroll
            for (int m = 0; m < 4; ++m) { const int rl = ai * HALF + wr * 64 + m * 16 + fr;
                const f32x4 r4 = *(const PG8_LAS f32x4*)(RS + rl * 4); const float inv = 1.0f / ((r4[0] + r4[1]) + (r4[2] + r4[3]));
                bf16_t* rowp = P + (size_t)(u.row0 + rl) * 1024 + col0;
#pragma unroll
                for (int bj = 0; bj < 2; ++bj) { const f32x4 v0 = acc[ai][bj][m][0] * inv, v1 = acc[ai][bj][m][1] * inv;
                    u32x4 w; w.x = cvt_pk_bf16(v0[0], v0[1]); w.y = cvt_pk_bf16(v0[2], v0[3]); w.z = cvt_pk_bf16(v1[0], v1[1]); w.w = cvt_pk_bf16(v1[2], v1[3]);
                    *(u32x4*)(rowp + bj * HALF) = w; } }
        (void)mx; (void)wid; (void)lane;
    }
};
}
namespace fox {
typedef short bf16x8 __attribute__((ext_vector_type(8)));
typedef short s16x4 __attribute__((ext_vector_type(4)));
typedef float f32x16 __attribute__((ext_vector_type(16)));
typedef float f32x4 __attribute__((ext_vector_type(4)));
typedef unsigned u32x4 __attribute__((ext_vector_type(4)));
constexpr int D = 128, PITCH = 1024, OPITCH = 2048;
constexpr int NW = 8, QBLK = 32, KVBLK = 64, QB = NW * QBLK;
constexpr int SHM_V = KVBLK * D * 2, SHM_K = KVBLK * D * 2;
constexpr int LDS_BIAS = 0, LDS_WS = 512, LDS_V = 4096, LDS_K = LDS_V + 2 * SHM_V, LDS_BYTES = LDS_K + 2 * SHM_K;
constexpr float SCALE = 0.08838834764831845f, C2 = LOG2E * SCALE, THR = 8.f;

#define KSWZ(row, colB) ((row) * 256 + ((colB) ^ (((row) & 7) << 4)))
#define SBAR() __builtin_amdgcn_sched_barrier(0)
__device__ __forceinline__ int v_st(int k, int c) { const int kk = (k & ~0xC) | ((k & 4) << 1) | ((k & 8) >> 1); return ((kk >> 3) * 4 + (c >> 5)) * 512 + ((kk & 7) * 32 + (c & 31)) * 2; }
__device__ __forceinline__ int v_rd_base(int lane) { return ((lane & 3) << 3) | (((lane >> 2) & 3) << 6) | (((lane >> 4) & 1) << 5) | (((lane >> 5) & 1) << 8); }
constexpr int v_rd_off(int d0, int ks, int half) { return d0 * 512 + ks * 4096 + half * 2048; }
__device__ __forceinline__ int crow(int r, int hi) { return (r & 3) + 8 * (r >> 2) + 4 * hi; }
__device__ __forceinline__ unsigned cvtpk(float lo, float hi) { unsigned r; asm volatile("v_cvt_pk_bf16_f32 %0, %1, %2" : "=v"(r) : "v"(lo), "v"(hi)); return r; }
__device__ __forceinline__ bf16x8 load8(const bf16* p) { return *reinterpret_cast<const bf16x8*>(p); }

__device__ __forceinline__ void mask_tile(f32x16& p0, f32x16& p1, int dq) {
    const float NEG = -__builtin_inff();
#pragma unroll
    for (int r = 0; r < 16; ++r) { const int c = (r & 3) + 8 * (r >> 2);
        if (dq - c < 0) p0[r] = NEG;
        if (dq - c - 32 < 0) p1[r] = NEG; }
}
__device__ __forceinline__ void partialSM(f32x16& p0, f32x16& p1, float& m_reg, float& mn, float& alpha) {
    float pmax = p0[0];
#pragma unroll
    for (int r = 1; r < 16; ++r) pmax = fmaxf(pmax, p0[r]);
#pragma unroll
    for (int r = 0; r < 16; ++r) pmax = fmaxf(pmax, p1[r]);
    { auto rr = __builtin_amdgcn_permlane32_swap(__float_as_uint(pmax), __float_as_uint(pmax), false, false);
      pmax = fmaxf(__uint_as_float(rr[0]), __uint_as_float(rr[1])); }
    if (__builtin_expect(__all((pmax - m_reg) * SCALE <= THR), 1)) { mn = m_reg; alpha = 1.f; }
    else { mn = fmaxf(m_reg, pmax); alpha = __builtin_amdgcn_exp2f((m_reg - mn) * C2); m_reg = mn; }
    const float mnL = -mn * C2;
#pragma unroll
    for (int r = 0; r < 16; ++r) p0[r] = fmaf(p0[r], C2, mnL);
#pragma unroll
    for (int r = 0; r < 16; ++r) p1[r] = fmaf(p1[r], C2, mnL);
#pragma unroll
    for (int r = 0; r < 16; ++r) p0[r] = __builtin_amdgcn_exp2f(p0[r]);
}
__device__ __forceinline__ void finishSM(f32x16& p0, f32x16& p1, float alpha, float& l_reg, bf16x8& pa0, bf16x8& pa1, bf16x8& pa2, bf16x8& pa3) {
#pragma unroll
    for (int r = 0; r < 16; ++r) p1[r] = __builtin_amdgcn_exp2f(p1[r]);
    float ps = 0;
#pragma unroll
    for (int r = 0; r < 16; ++r) ps += p0[r];
#pragma unroll
    for (int r = 0; r < 16; ++r) ps += p1[r];
    { auto rr = __builtin_amdgcn_permlane32_swap(__float_as_uint(ps), __float_as_uint(ps), false, false);
      ps = __uint_as_float(rr[0]) + __uint_as_float(rr[1]); }
    l_reg = l_reg * alpha + ps;
#define PK4(P, B_, OUT) do { unsigned a0 = cvtpk(P[B_+0], P[B_+1]), a1 = cvtpk(P[B_+2], P[B_+3]);                          \
        unsigned b0 = cvtpk(P[B_+4], P[B_+5]), b1 = cvtpk(P[B_+6], P[B_+7]);                                             \
        auto r0 = __builtin_amdgcn_permlane32_swap(a0, b0, false, false); auto r1 = __builtin_amdgcn_permlane32_swap(a1, b1, false, false); \
        u32x4 w = {r0[0], r1[0], r0[1], r1[1]}; OUT = *reinterpret_cast<bf16x8*>(&w); } while (0)
    PK4(p0, 0, pa0); PK4(p0, 8, pa1); PK4(p1, 0, pa2); PK4(p1, 8, pa3);
#undef PK4
}
template <int KB>
__device__ __forceinline__ void qkt(f32x16& p0, f32x16& p1, const char* K_lds, const float* bl, int r32, int hi, const bf16x8* qr) {
#pragma unroll
    for (int g = 0; g < 4; ++g) { const f32x4 b0 = *(const f32x4*)(bl + KB * 64 + 8 * g + 4 * hi), b1 = *(const f32x4*)(bl + KB * 64 + 32 + 8 * g + 4 * hi);
#pragma unroll
        for (int i = 0; i < 4; ++i) { p0[4 * g + i] = b0[i]; p1[4 * g + i] = b1[i]; } }
    const char* kb[4];
#pragma unroll
    for (int dd = 0; dd < 4; ++dd) kb[dd] = K_lds + KB * SHM_K + KSWZ(r32, (dd * 16 + hi * 8) * 2);
#pragma unroll
    for (int d0 = 0; d0 < 8; ++d0) { const char* a = kb[d0 & 3] + (d0 >> 2) * 128;
        bf16x8 b0 = *reinterpret_cast<const bf16x8*>(a);
        bf16x8 b1 = *reinterpret_cast<const bf16x8*>(a + 32 * 256);
        const bf16x8 qf = qr[d0];
        p0 = __builtin_amdgcn_mfma_f32_32x32x16_bf16(b0, qf, p0, 0, 0, 0);
        p1 = __builtin_amdgcn_mfma_f32_32x32x16_bf16(b1, qf, p1, 0, 0, 0); }
}
template <int VB>
__device__ __forceinline__ void pv_tile(f32x16* o, int vb0, bf16x8 pa0, bf16x8 pa1, bf16x8 pa2, bf16x8 pa3) {
#define TRRD(dst, off) asm volatile("ds_read_b64_tr_b16 %0, %1 offset:%2" : "=&v"(dst) : "v"(vb0), "i"(off) : "memory")
#define PV_D0(d0) do { s16x4 l0, l1, l2, l3, h0, h1, h2, h3; constexpr int b_ = VB * SHM_V + v_rd_off(d0, 0, 0); \
        TRRD(l0, b_); TRRD(h0, b_ + 2048); TRRD(l1, b_ + 4096); TRRD(h1, b_ + 6144); TRRD(l2, b_ + 8192); TRRD(h2, b_ + 10240); TRRD(l3, b_ + 12288); TRRD(h3, b_ + 14336); \
        asm volatile("s_waitcnt lgkmcnt(0)" ::: "memory"); SBAR();   \
        o[d0] = __builtin_amdgcn_mfma_f32_32x32x16_bf16(pa0, (bf16x8){l0[0], l0[1], l0[2], l0[3], h0[0], h0[1], h0[2], h0[3]}, o[d0], 0, 0, 0);   \
        o[d0] = __builtin_amdgcn_mfma_f32_32x32x16_bf16(pa1, (bf16x8){l1[0], l1[1], l1[2], l1[3], h1[0], h1[1], h1[2], h1[3]}, o[d0], 0, 0, 0);   \
        o[d0] = __builtin_amdgcn_mfma_f32_32x32x16_bf16(pa2, (bf16x8){l2[0], l2[1], l2[2], l2[3], h2[0], h2[1], h2[2], h2[3]}, o[d0], 0, 0, 0);   \
        o[d0] = __builtin_amdgcn_mfma_f32_32x32x16_bf16(pa3, (bf16x8){l3[0], l3[1], l3[2], l3[3], h3[0], h3[1], h3[2], h3[3]}, o[d0], 0, 0, 0); } while (0)
    PV_D0(0); PV_D0(1); PV_D0(2); PV_D0(3);
#undef PV_D0
#undef TRRD
}

struct Item { unsigned rowb, o; const float* CS; const float* G; int P0, jlo; };
struct Seam { bf16x8 qr[8]; bf16x8 st_v0, st_v1, st_k0, st_k1; };
typedef __amdgpu_buffer_rsrc_t Srd;
#define BL8(rs, vo, so) __builtin_bit_cast(bf16x8, __builtin_amdgcn_raw_buffer_load_b128((rs), (vo), (so), 0))
#define VMW() asm volatile("s_waitcnt vmcnt(0)" ::: "memory")
#define VMWN(n) asm volatile("s_waitcnt vmcnt(%0)" :: "i"(n) : "memory")
#define SLOAD_H(H, k0, bb) do { const unsigned so_ = (unsigned)(k0) * (PITCH * 2);                                               \
                         S.st_v0 = BL8(R, kvoff, (unsigned)WS_FV + (H).rowb + so_); S.st_v1 = BL8(R, kvoff, (unsigned)WS_FV + (H).rowb + so_ + 32 * PITCH * 2);   \
                         S.st_k0 = BL8(R, kvoff, (unsigned)WS_FK + (H).rowb + so_); S.st_k1 = BL8(R, kvoff, (unsigned)WS_FK + (H).rowb + so_ + 32 * PITCH * 2);   \
                         if (wid == 0) __builtin_amdgcn_global_load_lds((const unsigned*)((H).CS + (k0)) + lane, (__attribute__((address_space(3))) unsigned*)(B3 + (bb) * 64), 4, 0, 0); } while (0)
#define QLOAD(H) do { const unsigned so_ = (unsigned)((H).P0 + wid * QBLK) * (PITCH * 2);                                   \
        _Pragma("unroll") for (int d0 = 0; d0 < 8; ++d0) S.qr[d0] = BL8(R, qoff + d0 * 32, (unsigned)WS_FQ + (H).rowb + so_); } while (0)
#define SWRITE_HK(bf) do { *(bf16x8*)(K_lds + (bf) * SHM_K + kws) = S.st_k0; *(bf16x8*)(K_lds + (bf) * SHM_K + kws + 32 * 256) = S.st_k1; } while (0)
#define SWRITE_HV(bf) do { *(bf16x8*)(V_lds + (bf) * SHM_V + vst0) = S.st_v0; *(bf16x8*)(V_lds + (bf) * SHM_V + vst1) = S.st_v1; } while (0)
#define SWRITE_H(bf) do { SWRITE_HV(bf); SWRITE_HK(bf); } while (0)

__device__ __forceinline__ void fox_prime(const Srd R, const Item& H, char* lds, Seam& S, int wv) {
    const int tid = wg_tid(wv), wid = wv, lane = tid & 63, r32 = lane & 31, hi = lane >> 5;
    const int sr = tid >> 4, sc = (tid & 15) * 8, kws = KSWZ(sr, sc * 2); char* K_lds = lds + LDS_K; float* B_lds = (float*)(lds + LDS_BIAS);
    const unsigned kvoff = (unsigned)(sr * PITCH + sc) * 2u, qoff = (unsigned)(r32 * PITCH + hi * 8) * 2u;
    __attribute__((address_space(3))) float* B3 = (__attribute__((address_space(3))) float*)B_lds;
    QLOAD(H);
    SLOAD_H(H, H.jlo * KVBLK, 0); VMW(); SWRITE_HK(0);
    __syncthreads();
}
template <class NextFn>
__device__ __forceinline__ int fox_block(const Srd R, const Item& H, const NextFn& next_item, char* lds, Seam& S, int wv) {
    const int P0 = H.P0;
    const int tid = wg_tid(wv), wid = wv, lane = tid & 63, r32 = lane & 31, hi = lane >> 5;
    const int NT = P0 / KVBLK + 4 - H.jlo;
    const int qlo = P0 + wid * QBLK, qm = qlo + r32 - 4 * hi;
    char* V_lds = lds + LDS_V; char* K_lds = lds + LDS_K; float* B_lds = (float*)(lds + LDS_BIAS);
    float* ws = (float*)(lds + LDS_WS) + wid * 64; float* li_l = ws, * al_l = ws + 32;
    float m_reg = -1e30f, l_reg = 0; f32x16 o[4] = {};
    const int sr = tid >> 4, sc = (tid & 15) * 8, vst0 = v_st(sr, sc), vst1 = v_st(32 + sr, sc), kws = KSWZ(sr, sc * 2);
    const int vb0 = (int)(uintptr_t)V_lds + v_rd_base(lane);
    const unsigned kvoff = (unsigned)(sr * PITCH + sc) * 2u, qoff = (unsigned)(r32 * PITCH + hi * 8) * 2u;
    __attribute__((address_space(3))) float* B3 = (__attribute__((address_space(3))) float*)B_lds;
#define RESC(a) do { if (__any((a) < 1.f)) { if (hi == 0) al_l[r32] = (a); asm volatile("s_waitcnt lgkmcnt(0)" ::: "memory");              \
                     for (int d_ = 0; d_ < 4; ++d_) for (int r = 0; r < 16; ++r) o[d_][r] *= al_l[crow(r, hi)]; } } while (0)
#define KBASE(t) ((H.jlo + (t)) * KVBLK)
#define MASKT(P0_, P1_, t) do { const int kb_ = KBASE(t); if (kb_ + KVBLK - 1 > qlo) mask_tile(P0_, P1_, qm - kb_); } while (0)
    f32x16 pA0, pA1, pB0, pB1; float mnA, mnB, alA, alB; bf16x8 pa0, pa1, pa2, pa3;
    SWRITE_HV(0); SBAR();
    SLOAD_H(H, KBASE(1), 1);
    SBAR(); qkt<0>(pA0, pA1, K_lds, B_lds, r32, hi, S.qr);
    MASKT(pA0, pA1, 0); partialSM(pA0, pA1, m_reg, mnA, alA);
    VMW(); SWRITE_H(1);
    __syncthreads();
#define HALF_STEP(PX0, PX1, mnX, alX, PY0, PY1, alY, t, KB, VB, SB) do {                                                      \
        SBAR(); qkt<KB>(PX0, PX1, K_lds, B_lds, r32, hi, S.qr);                                                                 \
        finishSM(PY0, PY1, alY, l_reg, pa0, pa1, pa2, pa3); SBAR();                                                           \
        if ((t) + 1 < NT) { SLOAD_H(H, KBASE((t) + 1), SB); SBAR(); }                                                                \
        pv_tile<VB>(o, vb0, pa0, pa1, pa2, pa3); MASKT(PX0, PX1, (t)); partialSM(PX0, PX1, m_reg, mnX, alX);                  \
        __syncthreads();                                                                                                      \
        if ((t) + 1 < NT) { VMW(); SWRITE_H(SB); }                                                                      \
        RESC(alX); __syncthreads(); } while (0)
    for (int t = 1; t + 1 < NT; t += 2) {
        HALF_STEP(pB0, pB1, mnB, alB, pA0, pA1, alA, t, 1, 0, 0);
        HALF_STEP(pA0, pA1, mnA, alA, pB0, pB1, alB, t + 1, 0, 1, 1);
    }
    SBAR(); qkt<1>(pB0, pB1, K_lds, B_lds, r32, hi, S.qr); SBAR();
    int nidx; const Item N = next_item(H, nidx);
    SLOAD_H(N, N.jlo * KVBLK, 0); SBAR();
    QLOAD(N);
    SBAR();
    finishSM(pA0, pA1, alA, l_reg, pa0, pa1, pa2, pa3); SBAR();
    pv_tile<0>(o, vb0, pa0, pa1, pa2, pa3);
    MASKT(pB0, pB1, NT - 1); partialSM(pB0, pB1, m_reg, mnB, alB); __syncthreads(); RESC(alB);
    finishSM(pB0, pB1, alB, l_reg, pa0, pa1, pa2, pa3); SBAR(); pv_tile<1>(o, vb0, pa0, pa1, pa2, pa3);
    SBAR(); VMWN(8); SWRITE_HK(0); SBAR();
    if (hi == 0) li_l[r32] = l_reg; asm volatile("s_waitcnt lgkmcnt(0)" ::: "memory");
    float gn[4];
#pragma unroll
    for (int d0 = 0; d0 < 4; ++d0) gn[d0] = H.G[d0 * 32 + r32];
    const unsigned ovoff = (unsigned)(4 * hi * OPITCH + r32) * 2u;
#pragma unroll
    for (int r = 0; r < 16; ++r) { const float rli = __builtin_amdgcn_rcpf(li_l[crow(r, hi)]); float ss = 0.f;
#pragma unroll
        for (int d0 = 0; d0 < 4; ++d0) { o[d0][r] *= rli; ss += o[d0][r] * o[d0][r]; }
        ss += __shfl_xor(ss, 1); ss += __shfl_xor(ss, 2); ss += __shfl_xor(ss, 4); ss += __shfl_xor(ss, 8); ss += __shfl_xor(ss, 16);
        const float rs = __builtin_amdgcn_rsqf(ss * (1.0f / D) + EPS);
        const unsigned so_ = (unsigned)(P0 + wid * QBLK + (r & 3) + 8 * (r >> 2)) * (OPITCH * 2);
#pragma unroll
        for (int d0 = 0; d0 < 4; ++d0) { const float v = o[d0][r] * rs * gn[d0];
            const float vn = __shfl_xor(v, 1);
            if ((r32 & 1) == 0) __builtin_amdgcn_raw_buffer_store_b32(cvtpk(v, vn), R, ovoff + d0 * 64, H.o + so_, 0); } }
    __syncthreads();
    return nidx;
#undef RESC
#undef KBASE
#undef MASKT
#undef HALF_STEP
}
#undef BL8
#undef QLOAD
#undef VMW
#undef VMWN
#undef SLOAD_H
#undef SWRITE_HK
#undef SWRITE_HV
#undef SWRITE_H
#undef KSWZ
#undef SBAR
}
namespace mls {
typedef short bf16x8 __attribute__((ext_vector_type(8)));
typedef short bf16x4 __attribute__((ext_vector_type(4)));
typedef float f32x4 __attribute__((ext_vector_type(4)));
#define MFMA16(a, b, c) __builtin_amdgcn_mfma_f32_16x16x32_bf16((a), (b), (c), 0, 0, 0)

constexpr int CO_CST = 0, CO_VT = 65536, CO_XCH = 98304, CO_LDS_BYTES = CO_XCH + 512;
__device__ __forceinline__ void chunk_out(int b, int h, int c, const bf16* QP, const bf16* KPP, const bf16* VT, const bf16* CST, const float* NST,
                                          const bf16* MO, const float* gain, bf16* concat, __attribute__((address_space(3))) unsigned char* lds, int wv) {
    typedef __attribute__((address_space(3))) unsigned char* lptr;
    const int tid = wg_tid(wv), w = wv, lane = tid & 63, i16 = lane & 15, q = lane >> 4;
    const int tq = w & 3, dvh = w >> 2;
    const size_t R0 = (size_t)b * SEQ + (size_t)c * 64;
    const size_t item = ((size_t)(b * MLH + h) * NCHUNK + c);
    { const bf16* cs = CST + item * MLDV * MLDK; const bf16* vs = VT + item * MLDV * 64;
#pragma unroll
      for (int j = 0; j < 8; ++j) { const int p = w + 8 * j, row = 4 * p + (lane >> 4), lc = (lane & 15) ^ (row & 15);
          __builtin_amdgcn_global_load_lds((const unsigned*)(cs + row * MLDK + lc * 8), (__attribute__((address_space(3))) unsigned*)(lds + CO_CST + p * 1024), 16, 0, 0); }
#pragma unroll
      for (int j = 0; j < 4; ++j) { const int p = w + 8 * j, row = 8 * p + (lane >> 3), lc = (lane & 7) ^ ((row >> 1) & 7);
          __builtin_amdgcn_global_load_lds((const unsigned*)(vs + row * 64 + lc * 8), (__attribute__((address_space(3))) unsigned*)(lds + CO_VT + p * 1024), 16, 0, 0); } }
    const size_t row = R0 + 16 * tq + i16;
    const bf16* qrow = QP + row * 512 + h * MLDK + 8 * q;
    bf16x8 qf[4];
#pragma unroll
    for (int ks = 0; ks < 4; ++ks) qf[ks] = *(const bf16x8*)(qrow + 32 * ks);
    f32x4 st[4];
#pragma unroll
    for (int stile = 0; stile < 4; ++stile) {
        st[stile] = (f32x4){0.f, 0.f, 0.f, 0.f};
        if (stile <= tq) {
            const bf16* krow = KPP + (R0 + 16 * stile + i16) * 512 + h * MLDK + 8 * q;
            bf16x8 kf[4];
#pragma unroll
            for (int ks = 0; ks < 4; ++ks) kf[ks] = *(const bf16x8*)(krow + 32 * ks);
#pragma unroll
            for (int ks = 0; ks < 4; ++ks) st[stile] = MFMA16(kf[ks], qf[ks], st[stile]);
            if (stile == tq) {
#pragma unroll
                for (int r = 0; r < 4; ++r) if (4 * q + r > i16) st[stile][r] = 0.f;
            }
        }
    }
    float den = 0.f;
#pragma unroll
    for (int stile = 0; stile < 4; ++stile) den += (st[stile][0] + st[stile][1]) + (st[stile][2] + st[stile][3]);
    { const float* nrow = NST + item * MLDK + 8 * q;
#pragma unroll
      for (int ks = 0; ks < 4; ++ks) { const f32x4 n0 = *(const f32x4*)(nrow + 32 * ks), n1 = *(const f32x4*)(nrow + 32 * ks + 4);
          const v4u qq = __builtin_bit_cast(v4u, qf[ks]);
          den += bflo(qq[0]) * n0[0] + bfhi(qq[0]) * n0[1] + bflo(qq[1]) * n0[2] + bfhi(qq[1]) * n0[3]
               + bflo(qq[2]) * n1[0] + bfhi(qq[2]) * n1[1] + bflo(qq[3]) * n1[2] + bfhi(qq[3]) * n1[3]; } }
    den += __shfl_xor(den, 16); den += __shfl_xor(den, 32);
    const int dv0 = h * MLDV + dvh * 128 + 4 * q;
    v2u mo2[8];
#pragma unroll
    for (int dt = 0; dt < 8; ++dt) mo2[dt] = *(const v2u*)(MO + row * 1024 + dv0 + 16 * dt);
    bf16x8 pf[2];
#pragma unroll
    for (int p = 0; p < 2; ++p) { v4u wv; wv[0] = pg8::cvt_pk_bf16(st[2 * p][0], st[2 * p][1]); wv[1] = pg8::cvt_pk_bf16(st[2 * p][2], st[2 * p][3]);
        wv[2] = pg8::cvt_pk_bf16(st[2 * p + 1][0], st[2 * p + 1][1]); wv[3] = pg8::cvt_pk_bf16(st[2 * p + 1][2], st[2 * p + 1][3]); pf[p] = __builtin_bit_cast(bf16x8, wv); }
    const int npair = (tq >> 1) + 1;
    asm volatile("s_waitcnt vmcnt(0)" ::: "memory");
    __syncthreads();
    f32x4 num[8];
    const lptr cb = lds + CO_CST + (dvh * 128 + i16) * 256, vb = lds + CO_VT + (dvh * 128 + i16) * 128 + (q & 1) * 8;
    const int vsw = i16 >> 1;
#pragma unroll
    for (int dt = 0; dt < 8; ++dt) {
        f32x4 a = (f32x4){0.f, 0.f, 0.f, 0.f};
#pragma unroll
        for (int p = 0; p < 2; ++p) if (p < npair) {
            const v2u lo = *(const __attribute__((address_space(3))) v2u*)(vb + dt * 16 * 128 + (((4 * p + (q >> 1)) ^ vsw) * 16));
            const v2u hi2 = *(const __attribute__((address_space(3))) v2u*)(vb + dt * 16 * 128 + (((4 * p + 2 + (q >> 1)) ^ vsw) * 16));
            const v4u vv = {lo[0], lo[1], hi2[0], hi2[1]};
            a = MFMA16(__builtin_bit_cast(bf16x8, vv), pf[p], a); }
#pragma unroll
        for (int ks = 0; ks < 4; ++ks) { const bf16x8 cf = *(const __attribute__((address_space(3))) bf16x8*)(cb + dt * 16 * 256 + (((4 * ks + q) ^ i16) * 16)); a = MFMA16(cf, qf[ks], a); }
        num[dt] = a;
    }
    const float rden = 1.0f / fmaxf(fabsf(den), 1.0f);
    float ss = 0.f;
#pragma unroll
    for (int dt = 0; dt < 8; ++dt) { num[dt] = num[dt] * rden; ss += (num[dt][0] * num[dt][0] + num[dt][1] * num[dt][1]) + (num[dt][2] * num[dt][2] + num[dt][3] * num[dt][3]); }
    ss += __shfl_xor(ss, 16); ss += __shfl_xor(ss, 32);
    __attribute__((address_space(3))) float* xch = (__attribute__((address_space(3))) float*)(lds + CO_XCH);
    if (q == 0) xch[w * 16 + i16] = ss;
    __syncthreads();
    const float tot = ss + xch[(w ^ 4) * 16 + i16];
    const float rn = __builtin_amdgcn_rsqf(tot * (1.0f / MLDV) + EPS);
#pragma unroll
    for (int dt = 0; dt < 8; ++dt) { const int dv = dv0 + 16 * dt;
        const f32x4 g4 = *(const f32x4*)(gain + dv);
        const float o0 = num[dt][0] * rn * g4[0] * sigmoidf_(bflo(mo2[dt][0])), o1 = num[dt][1] * rn * g4[1] * sigmoidf_(bfhi(mo2[dt][0]));
        const float o2 = num[dt][2] * rn * g4[2] * sigmoidf_(bflo(mo2[dt][1])), o3 = num[dt][3] * rn * g4[3] * sigmoidf_(bfhi(mo2[dt][1]));
        v2u ov; ov[0] = pg8::cvt_pk_bf16(o0, o1); ov[1] = pg8::cvt_pk_bf16(o2, o3);
        *(v2u*)(concat + row * 2048 + 1024 + dv) = ov; }
    __syncthreads();
}

constexpr int SS_NS = 6, SS_SLOT = 18432;
__device__ __forceinline__ void state_scan(int bh, int sl, const bf16* KT, const bf16* VT, const float* EB, bf16* CST, __attribute__((address_space(3))) unsigned char* lds, int wv, bool do_store = true) {
    typedef __attribute__((address_space(3))) unsigned char* lptr;
    const int tid = wg_tid(wv), w = wv, lane = tid & 63, i16 = lane & 15, q = lane >> 4;
    const size_t it0 = (size_t)bh * NCHUNK;
    const bf16* kt0 = KT + it0 * MLDK * 64; const bf16* vt0 = VT + (it0 * MLDV + 16 * sl) * 64;
    bf16* cs = CST + (it0 * MLDV + 16 * sl + i16) * MLDK + 16 * w + 4 * q;
    const float ebv = EB[it0 + lane];
    const int prow = lane >> 3, pcol = lane & 7;
    const unsigned ksrc0 = (unsigned)((8 * w + prow) * 64 + ((pcol ^ (((8 * w + prow) >> 1) & 7)) * 8));
    const unsigned ksrc1 = (unsigned)((8 * (w + 8) + prow) * 64 + ((pcol ^ (((8 * (w + 8) + prow) >> 1) & 7)) * 8));
    const unsigned vsrc = (unsigned)((8 * (w & 1) + prow) * 64 + ((pcol ^ (((8 * (w & 1) + prow) >> 1) & 7)) * 8));
#define SS_DMA(cc, slot) do { const bf16* kc_ = kt0 + (size_t)(cc) * MLDK * 64; const lptr sb_ = lds + (slot) * SS_SLOT;                                        \
        __builtin_amdgcn_global_load_lds((const unsigned*)(kc_ + ksrc0), (__attribute__((address_space(3))) unsigned*)(sb_ + w * 1024), 16, 0, 0);             \
        __builtin_amdgcn_global_load_lds((const unsigned*)(kc_ + ksrc1), (__attribute__((address_space(3))) unsigned*)(sb_ + (w + 8) * 1024), 16, 0, 0);       \
        if (w < 2) __builtin_amdgcn_global_load_lds((const unsigned*)(vt0 + (size_t)(cc) * MLDV * 64 + vsrc), (__attribute__((address_space(3))) unsigned*)(sb_ + 16384 + w * 1024), 16, 0, 0); } while (0)
#pragma unroll
    for (int j = 0; j < SS_NS - 1; ++j) SS_DMA(j, j);
    f32x4 acc = (f32x4){0.f, 0.f, 0.f, 0.f};
    const int swz = (i16 >> 1) & 7;
    const unsigned aoff = (unsigned)((16 * w + i16) * 128), boff = (unsigned)(16384 + i16 * 128);
    int slot = 0;
    for (int c = 0; c < NCHUNK; ++c) {
        if (w < 2) asm volatile("s_waitcnt vmcnt(12)" ::: "memory"); else asm volatile("s_waitcnt vmcnt(8)" ::: "memory");
        asm volatile("s_waitcnt lgkmcnt(0)" ::: "memory");
        __builtin_amdgcn_s_barrier();
        asm volatile("" ::: "memory");
        { const int cn = c + SS_NS - 1 < NCHUNK ? c + SS_NS - 1 : NCHUNK - 1; const int sn = slot == 0 ? SS_NS - 1 : slot - 1; SS_DMA(cn, sn); }
        const lptr sb = lds + slot * SS_SLOT;
        const bf16x8 a0 = *(const __attribute__((address_space(3))) bf16x8*)(sb + aoff + ((q ^ swz) * 16)), a1 = *(const __attribute__((address_space(3))) bf16x8*)(sb + aoff + (((4 + q) ^ swz) * 16));
        const bf16x8 b0 = *(const __attribute__((address_space(3))) bf16x8*)(sb + boff + ((q ^ swz) * 16)), b1 = *(const __attribute__((address_space(3))) bf16x8*)(sb + boff + (((4 + q) ^ swz) * 16));
        v2u ov; ov[0] = pg8::cvt_pk_bf16(acc[0], acc[1]); ov[1] = pg8::cvt_pk_bf16(acc[2], acc[3]);
        if (do_store) *(v2u*)(cs + (size_t)c * MLDV * MLDK) = ov; else asm volatile("" :: "v"(ov));
        acc = MFMA16(a0, b0, acc); acc = MFMA16(a1, b1, acc);
        const float e = __builtin_bit_cast(float, __builtin_amdgcn_readlane(__builtin_bit_cast(int, ebv), c));
        acc = acc * e;
        slot = slot == SS_NS - 1 ? 0 : slot + 1;
    }
    asm volatile("s_waitcnt vmcnt(0) lgkmcnt(0)" ::: "memory");
    __builtin_amdgcn_s_barrier();
#undef SS_DMA
}
#undef MFMA16
}
typedef const float* cfp_t;
struct Frame {
    LAS unsigned char* lds; unsigned char* ldsg;
    int tid, lane, wave, vcu, G;
    const __attribute__((address_space(4))) cfp_t* inp; float* out; unsigned char* ws;
};
__device__ __forceinline__ void refresh_ids(Frame& F) { F.tid = wg_tid(F.wave); F.lane = F.tid & 63; }
__device__ __forceinline__ float wave_incl_scan(float v, int lane) {
#pragma unroll
    for (int o = 1; o < 64; o <<= 1) { const float t = __shfl_up(v, o); if (lane >= o) v += t; }
    return v;
}

__device__ __forceinline__ void p0_transpose_item(const float* W, int ldw, int K, bf16* WT, const float* gk, int k0, int n0_dst, int n0_src, LAS float* scr, int lane) {
    float vv[32];
#pragma unroll
    for (int i = 0; i < 32; ++i) { const int kk = 2 * i + (lane >> 5); vv[i] = W[(size_t)(k0 + kk) * ldw + n0_src + (lane & 31)]; }
    if (gk) {
#pragma unroll
        for (int i = 0; i < 32; ++i) vv[i] *= gk[k0 + 2 * i + (lane >> 5)]; }
#pragma unroll
    for (int i = 0; i < 32; ++i) scr[(2 * i + (lane >> 5)) * 33 + (lane & 31)] = vv[i];
    LDS_WAIT(); asm volatile("" ::: "memory");
    const int c = lane & 7;
#pragma unroll
    for (int j = 0; j < 4; ++j) { const int n = (lane >> 3) + 8 * j; const LAS float* s = scr + (8 * c) * 33 + n;
        v4u o; o.x = pk2(s[0 * 33], s[1 * 33]); o.y = pk2(s[2 * 33], s[3 * 33]); o.z = pk2(s[4 * 33], s[5 * 33]); o.w = pk2(s[6 * 33], s[7 * 33]);
        *(GAS v4u*)(WT + (size_t)(n0_dst + n) * K + k0 + 8 * c) = o; }
    LDS_WAIT(); asm volatile("" ::: "memory");
}
__device__ __forceinline__ void p0_transpose_item8(const float* W, int ldw, int K, unsigned char* WT8, const float* gk, float scale, int k0, int n0, LAS float* scr, int lane) {
    float vv[32];
#pragma unroll
    for (int i = 0; i < 32; ++i) { const int kk = 2 * i + (lane >> 5); vv[i] = W[(size_t)(k0 + kk) * ldw + n0 + (lane & 31)]; }
#pragma unroll
    for (int i = 0; i < 32; ++i) vv[i] *= (gk ? gk[k0 + 2 * i + (lane >> 5)] : 1.0f) * scale;
#pragma unroll
    for (int i = 0; i < 32; ++i) scr[(2 * i + (lane >> 5)) * 33 + (lane & 31)] = vv[i];
    LDS_WAIT(); asm volatile("" ::: "memory");
    const int c = lane & 7;
#pragma unroll
    for (int j = 0; j < 4; ++j) { const int n = (lane >> 3) + 8 * j; const LAS float* s = scr + (8 * c) * 33 + n;
        v2u o; o.x = pg8::pk4_fp8(s[0 * 33], s[1 * 33], s[2 * 33], s[3 * 33]); o.y = pg8::pk4_fp8(s[4 * 33], s[5 * 33], s[6 * 33], s[7 * 33]);
        *(GAS v2u*)(WT8 + (size_t)(n0 + n) * K + k0 + 8 * c) = o; }
    LDS_WAIT(); asm volatile("" ::: "memory");
}
__device__ __forceinline__ float rms_row_to_bf16(const float* xrow, const float* g, bf16* orow, int lane) {
    const GAS v4f* xr = (const GAS v4f*)xrow + lane; const GAS v4f* gr = (const GAS v4f*)g + lane;
    v4f v[8]; float s = 0.f;
#pragma unroll
    for (int j = 0; j < 8; ++j) { v[j] = xr[64 * j]; s += (v[j].x * v[j].x + v[j].y * v[j].y) + (v[j].z * v[j].z + v[j].w * v[j].w); }
    const float rinv = 1.0f / sqrtf(wave_sum(s) * (1.f / DM) + EPS);
    GAS v2u* o8 = (GAS v2u*)orow + lane;
#pragma unroll
    for (int j = 0; j < 8; ++j) { const v4f gg = gr[64 * j]; v2u w; w.x = pk2(v[j].x * rinv * gg.x, v[j].y * rinv * gg.y); w.y = pk2(v[j].z * rinv * gg.z, v[j].w * rinv * gg.w); o8[64 * j] = w; }
    return rinv;
}
__device__ __forceinline__ void p0_prologue(Frame& F) {
    refresh_ids(F);
    const float* x = F.inp[0]; const float* mem = F.inp[1]; const float* mixer_norm = F.inp[2]; const float* w_in = F.inp[3];
    const int gw = F.vcu * 8 + F.wave, NGW = F.G * 8;
    LAS float* WgL = (LAS float*)F.lds;
#pragma unroll 8
    for (int idx = F.tid; idx < 32768; idx += NTHREADS) { const int e = idx & 7, ln = (idx >> 3) & 63, sp = idx >> 9, gate = ln & 15, q = ln >> 4, k = 32 * sp + 8 * q + e;
        const int col = gate < 8 ? 3072 + gate : 5128 + (gate - 8);
        WgL[idx] = w_in[(size_t)k * IN_WIDTH + col] * mixer_norm[k]; }
    __syncthreads();
    { float* gates = (float*)(F.ws + WS_GATES); float* ssqx = (float*)(F.ws + WS_CTL + CTL_SSQX); bf16* XG = (bf16*)(F.ws + WS_XN);
      const int i16 = F.lane & 15, q = F.lane >> 4;
      for (int it = gw; it < MTOK / 16 * 2; it += NGW) { const int grp = it >> 1, kh = it & 1; const size_t row = (size_t)grp * 16 + i16;
          const float* xr = x + row * DM + kh * 1024 + 8 * q; const float* gr = mixer_norm + kh * 1024 + 8 * q; bf16* xo = XG + row * DM + kh * 1024 + 8 * q;
          const LAS float* wp = WgL + (kh * 32 * 64 + F.lane) * 8;
          v4f acc = (v4f){0.f, 0.f, 0.f, 0.f}; float ss = 0.f;
#pragma unroll 1
          for (int s0 = 0; s0 < 32; s0 += 8, wp += 8 * 512, xr += 8 * 32, gr += 8 * 32, xo += 8 * 32) { v4f xb[8][2];
#pragma unroll
              for (int j = 0; j < 8; ++j) { xb[j][0] = *(const v4f*)(xr + 32 * j); xb[j][1] = *(const v4f*)(xr + 32 * j + 4); }
#pragma unroll
              for (int j = 0; j < 8; ++j) { const v4f x0 = xb[j][0], x1 = xb[j][1]; const v4f g0 = *(const v4f*)(gr + 32 * j), g1 = *(const v4f*)(gr + 32 * j + 4);
                  const v4f w0 = *(const LAS v4f*)(wp + j * 512), w1 = *(const LAS v4f*)(wp + j * 512 + 4);
                  ss += (x0.x * x0.x + x0.y * x0.y) + (x0.z * x0.z + x0.w * x0.w) + (x1.x * x1.x + x1.y * x1.y) + (x1.z * x1.z + x1.w * x1.w);
                  v4u o; o.x = pk2(x0.x * g0.x, x0.y * g0.y); o.y = pk2(x0.z * g0.z, x0.w * g0.w); o.z = pk2(x1.x * g1.x, x1.y * g1.y); o.w = pk2(x1.z * g1.z, x1.w * g1.w);
                  *(v4u*)(xo + 32 * j) = o;
                  acc = __builtin_amdgcn_mfma_f32_16x16x4f32(x0.x, w0.x, acc, 0, 0, 0); acc = __builtin_amdgcn_mfma_f32_16x16x4f32(x0.y, w0.y, acc, 0, 0, 0);
                  acc = __builtin_amdgcn_mfma_f32_16x16x4f32(x0.z, w0.z, acc, 0, 0, 0); acc = __builtin_amdgcn_mfma_f32_16x16x4f32(x0.w, w0.w, acc, 0, 0, 0);
                  acc = __builtin_amdgcn_mfma_f32_16x16x4f32(x1.x, w1.x, acc, 0, 0, 0); acc = __builtin_amdgcn_mfma_f32_16x16x4f32(x1.y, w1.y, acc, 0, 0, 0);
                  acc = __builtin_amdgcn_mfma_f32_16x16x4f32(x1.z, w1.z, acc, 0, 0, 0); acc = __builtin_amdgcn_mfma_f32_16x16x4f32(x1.w, w1.w, acc, 0, 0, 0); } }
          ss += __shfl_xor(ss, 16); ss += __shfl_xor(ss, 32);
          if (q == 0) atomicAdd(ssqx + row, ss);
#pragma unroll
          for (int r = 0; r < 4; ++r) atomicAdd(gates + ((size_t)grp * 16 + 4 * q + r) * 16 + i16, acc[r]);
      } }
    { bf16* MN = (bf16*)(F.ws + WS_MN);
      for (int m = gw; m < MROWS; m += NGW) (void)rms_row_to_bf16(mem + (size_t)m * DM, F.inp[15], MN + (size_t)m * DM, F.lane); }
    __syncthreads();
    LAS float* scr = (LAS float*)(F.lds + F.wave * 16384);
    for (int it = gw; it < 32768; it += NGW) {
        int r = it;
        if (r < 6144) { const int kb = r / 192, nb = r % 192, n0 = 32 * nb, grpc = n0 >> 10, shift = grpc < 3 ? 0 : (grpc < 5 ? 8 : 16);
            p0_transpose_item(w_in, IN_WIDTH, DM, (bf16*)(F.ws + WS_WIN), nullptr, 64 * kb, n0, n0 + shift, scr, F.lane); continue; } r -= 6144;
        if (r < 2048) { p0_transpose_item(F.inp[13], DM, DM, (bf16*)(F.ws + WS_WOUT), nullptr, 64 * (r / 64), 32 * (r % 64), 32 * (r % 64), scr, F.lane); continue; } r -= 2048;
        if (r < 2048) { p0_transpose_item8(F.inp[16], DM, DM, F.ws + WS_WXQ, F.inp[14], W8_SCALE, 64 * (r / 64), 32 * (r % 64), scr, F.lane); continue; } r -= 2048;
        if (r < 4096) { p0_transpose_item(F.inp[17], 2 * DM, DM, (bf16*)(F.ws + WS_WXKV), nullptr, 64 * (r / 128), 32 * (r % 128), 32 * (r % 128), scr, F.lane); continue; } r -= 4096;
        if (r < 2048) { p0_transpose_item8(F.inp[20], DM, DM, F.ws + WS_WXO, nullptr, W8_SCALE, 64 * (r / 64), 32 * (r % 64), scr, F.lane); continue; } r -= 2048;
        if (r < 8192) { p0_transpose_item(F.inp[22], DFF, DM, (bf16*)(F.ws + WS_WUP), F.inp[21], 64 * (r / 256), 32 * (r % 256), 32 * (r % 256), scr, F.lane); continue; } r -= 8192;
        p0_transpose_item(F.inp[23], DM, DFF, (bf16*)(F.ws + WS_WDN), nullptr, 64 * (r / 64), 32 * (r % 64), 32 * (r % 64), scr, F.lane);
    }
}

constexpr int P2_KT_OFF = 4096, P2_KT_PITCH = 136, P2_VT_OFF = P2_KT_OFF + 64 * P2_KT_PITCH * 2, P2_VT_PITCH = 264;
constexpr int P2_BUF_ELEMS = (64 * P2_KT_PITCH + 64 * P2_VT_PITCH);
__device__ __forceinline__ void p2_prep_item(Frame& F, int item, bool do_norm = true) {
    refresh_ids(F);
    const int b = item >> 6, c = item & 63; const size_t R0 = (size_t)b * SEQ + (size_t)c * 64;
    const int tid = F.tid, lane = F.lane, w = F.wave;
    LAS float* gq = (LAS float*)F.lds; LAS float* uk = gq + 256;
    LAS bf16* kt = (LAS bf16*)(F.lds + P2_KT_OFF); LAS bf16* vt = (LAS bf16*)(F.lds + P2_VT_OFF);
    const float* GATES = (const float*)(F.ws + WS_GATES); const float* SSQX = (const float*)(F.ws + WS_CTL + CTL_SSQX);
    if (w < 4) { const size_t row = R0 + lane; const float ri = rinv_of(SSQX, row);
        const float mi = GATES[row * 16 + 8 + w] * ri + F.inp[5][w], mf = GATES[row * 16 + 12 + w] * ri + F.inp[6][w];
        const float bcum = wave_incl_scan(logsigmoidf(mf), lane);
        const float g = __expf(bcum), u = __expf(mi - bcum) * 0.08838834764831845f;
        gq[w * 64 + lane] = g; uk[w * 64 + lane] = u;
        if (lane == 63) ((float*)(F.ws + WS_EB))[(size_t)(b * MLH + w) * NCHUNK + c] = g; }
    if (do_norm) { bf16* FQ = (bf16*)(F.ws + WS_FQ); bf16* FK = (bf16*)(F.ws + WS_FK); const int l16 = lane & 15;
      float gqn[8], gkn[8];
#pragma unroll
      for (int e = 0; e < 8; ++e) { gqn[e] = F.inp[9][l16 * 8 + e]; gkn[e] = F.inp[10][l16 * 8 + e]; }
      for (int it0 = w; it0 < 256; it0 += 64) {
          v4u raw[8];
#pragma unroll
          for (int j = 0; j < 8; ++j) { const int seg = (it0 + 8 * j) * 4 + (lane >> 4), row = seg >> 4, hh = seg & 15;
              raw[j] = *(const v4u*)((hh < 8 ? FQ : FK) + (R0 + row) * 1024 + (hh & 7) * FOXD + l16 * 8); }
#pragma unroll
          for (int j = 0; j < 8; ++j) { const int seg = (it0 + 8 * j) * 4 + (lane >> 4), row = seg >> 4, hh = seg & 15;
              bf16* p = (hh < 8 ? FQ : FK) + (R0 + row) * 1024 + (hh & 7) * FOXD + l16 * 8; float v[8];
#pragma unroll
              for (int e = 0; e < 4; ++e) { v[2 * e] = bflo(raw[j][e]); v[2 * e + 1] = bfhi(raw[j][e]); }
              float ss = 0.f;
#pragma unroll
              for (int e = 0; e < 8; ++e) ss += v[e] * v[e];
              ss += __shfl_xor(ss, 1); ss += __shfl_xor(ss, 2); ss += __shfl_xor(ss, 4); ss += __shfl_xor(ss, 8);
              const float ri = 1.0f / sqrtf(ss * (1.0f / FOXD) + EPS);
              v4u o;
#pragma unroll
              for (int e = 0; e < 4; ++e) { const float g0 = hh < 8 ? gqn[2 * e] : gkn[2 * e], g1 = hh < 8 ? gqn[2 * e + 1] : gkn[2 * e + 1]; o[e] = pk2(v[2 * e] * ri * g0, v[2 * e + 1] * ri * g1); }
              *(v4u*)p = o; } } }
    __syncthreads();
    const bf16* MQK = (const bf16*)(F.ws + WS_MQK); const bf16* MV = (const bf16*)(F.ws + WS_MV);
    bf16* QP = (bf16*)(F.ws + WS_QP); bf16* KPP = (bf16*)(F.ws + WS_KPP);
    const float* conv_w = F.inp[7]; const float* conv_b = F.inp[8];
    const int cgp = tid & 31, rg = tid >> 5; const bool isq = cgp < 16;
    v4u rawc[7], rawv[4];
#define P2_LOAD(h_) do { const int col_ = (isq ? 0 : 512) + (h_) * MLDK + (cgp & 15) * 8;                                              \
        _Pragma("unroll") for (int i = 0; i < 7; ++i) { const int pos = c * 64 + 4 * rg - 3 + i;                                           \
            rawc[i] = (v4u){0u, 0u, 0u, 0u}; if (pos >= 0) rawc[i] = *(const v4u*)(MQK + ((size_t)b * SEQ + pos) * 1024 + col_); }            \
        _Pragma("unroll") for (int i = 0; i < 4; ++i) { const int idx = tid + NTHREADS * i, row = idx >> 5, ch = idx & 31;                 \
            rawv[i] = *(const v4u*)(MV + (R0 + row) * 1024 + (h_) * MLDV + ch * 8); } } while (0)
#define P2_CONV(h_, kt_, vt_) do { const int col_ = (isq ? 0 : 512) + (h_) * MLDK + (cgp & 15) * 8;                                       \
        float cw[4][8], cb[8];                                                                                                             \
        _Pragma("unroll") for (int e = 0; e < 8; ++e) { cb[e] = conv_b[col_ + e];                                                          \
            _Pragma("unroll") for (int j = 0; j < 4; ++j) cw[j][e] = conv_w[j * 1024 + col_ + e]; }                                        \
        float u[7][8];                                                                                                                     \
        _Pragma("unroll") for (int i = 0; i < 7; ++i) _Pragma("unroll") for (int e = 0; e < 4; ++e) { u[i][2 * e] = bflo(rawc[i][e]); u[i][2 * e + 1] = bfhi(rawc[i][e]); } \
        _Pragma("unroll") for (int r = 0; r < 4; ++r) { const int t = 4 * rg + r; const float f = isq ? gq[(h_) * 64 + t] : uk[(h_) * 64 + t]; float y[8]; \
            _Pragma("unroll") for (int e = 0; e < 8; ++e) { float a = cb[e];                                                               \
                _Pragma("unroll") for (int j = 0; j < 4; ++j) a += cw[j][e] * u[r + j][e];                                                 \
                y[e] = a * sigmoidf_(a) * f; }                                                                                             \
            v4u o; o.x = pk2(y[0], y[1]); o.y = pk2(y[2], y[3]); o.z = pk2(y[4], y[5]); o.w = pk2(y[6], y[7]);                             \
            *(v4u*)((isq ? QP : KPP) + (R0 + t) * 512 + (h_) * MLDK + (cgp & 15) * 8) = o;                                                 \
            if (!isq) *(LAS v4u*)((kt_) + t * P2_KT_PITCH + (cgp & 15) * 8) = o; }                                                         \
        _Pragma("unroll") for (int i = 0; i < 4; ++i) { const int idx = tid + NTHREADS * i, row = idx >> 5, ch = idx & 31;                 \
            *(LAS v4u*)((vt_) + row * P2_VT_PITCH + ch * 8) = rawv[i]; } } while (0)
    P2_LOAD(0); P2_CONV(0, kt, vt);
    __syncthreads();
    for (int h = 0; h < MLH; ++h) {
        LAS bf16* ktc = kt + (h & 1) * P2_BUF_ELEMS; LAS bf16* vtc = vt + (h & 1) * P2_BUF_ELEMS;
        LAS bf16* ktn = kt + ((h + 1) & 1) * P2_BUF_ELEMS; LAS bf16* vtn = vt + ((h + 1) & 1) * P2_BUF_ELEMS;
        if (h + 1 < MLH) P2_LOAD(h + 1);
        const size_t itemh = (size_t)(b * MLH + h) * NCHUNK + c;
        { bf16* KT = (bf16*)(F.ws + WS_KT) + itemh * MLDK * 64;
#pragma unroll
          for (int i = 0; i < 2; ++i) { const int idx = tid + NTHREADS * i, d = idx >> 3, sg = idx & 7; unsigned short e8[8];
#pragma unroll
              for (int e = 0; e < 8; ++e) e8[e] = ktc[(8 * sg + e) * P2_KT_PITCH + d];
              v4u o; o.x = e8[0] | ((unsigned)e8[1] << 16); o.y = e8[2] | ((unsigned)e8[3] << 16); o.z = e8[4] | ((unsigned)e8[5] << 16); o.w = e8[6] | ((unsigned)e8[7] << 16);
              *(v4u*)(KT + d * 64 + 8 * sg) = o; }
          bf16* VT = (bf16*)(F.ws + WS_VT) + itemh * MLDV * 64;
#pragma unroll
          for (int i = 0; i < 4; ++i) { const int idx = tid + NTHREADS * i, dv = idx >> 3, sg = idx & 7; unsigned short e8[8];
#pragma unroll
              for (int e = 0; e < 8; ++e) e8[e] = vtc[(8 * sg + e) * P2_VT_PITCH + dv];
              v4u o; o.x = e8[0] | ((unsigned)e8[1] << 16); o.y = e8[2] | ((unsigned)e8[3] << 16); o.z = e8[4] | ((unsigned)e8[5] << 16); o.w = e8[6] | ((unsigned)e8[7] << 16);
              *(v4u*)(VT + dv * 64 + 8 * sg) = o; }
          if (tid < MLDK) { float s = 0.f;
#pragma unroll 8
              for (int t = 0; t < 64; ++t) s += bf2f(ktc[t * P2_KT_PITCH + tid]);
              ((float*)(F.ws + WS_KSUM))[itemh * MLDK + tid] = s; } }
        if (h + 1 < MLH) P2_CONV(h + 1, ktn, vtn);
        __syncthreads();
    }
#undef P2_LOAD
#undef P2_CONV
    { const int mr = item * 4 + (w & 3); const float* slab = (const float*)(F.ws + WS_SLAB);
      if (w < 4) {
        const float* gxq = F.inp[18]; const float* gxk = F.inp[19];
        v4f kv[8]; float ssh[4] = {0.f, 0.f, 0.f, 0.f};
#pragma unroll
        for (int j = 0; j < 8; ++j) { const int col = 4 * (lane + 64 * j); v4f a = (v4f){0.f, 0.f, 0.f, 0.f};
#pragma unroll
            for (int s = 0; s < 4; ++s) a = a + *(const v4f*)(slab + ((size_t)s * MROWS + mr) * 4096 + col);
            kv[j] = a; ssh[j >> 1] += (a.x * a.x + a.y * a.y) + (a.z * a.z + a.w * a.w); }
        float rk[4];
#pragma unroll
        for (int hh = 0; hh < 4; ++hh) rk[hh] = 1.0f / sqrtf(wave_sum(ssh[hh]) * (1.0f / XD) + EPS);
        bf16* KH = (bf16*)(F.ws + WS_KHAT) + (size_t)mr * DM;
#pragma unroll
        for (int j = 0; j < 8; ++j) { const int col = 4 * (lane + 64 * j), d = col & (XD - 1); const v4f a = *(const v4f*)(gxq + d), g2 = *(const v4f*)(gxk + d); const float r = rk[j >> 1];
            v2u o; o.x = pk2(kv[j].x * r * a.x * g2.x, kv[j].y * r * a.y * g2.y); o.y = pk2(kv[j].z * r * a.z * g2.z, kv[j].w * r * a.w * g2.w);
            *(v2u*)(KH + col) = o; }
      } else {
        bf16* VTM = (bf16*)(F.ws + WS_VTM); const int bm = mr >> 8, key = mr & 255;
        v4f vv[8];
#pragma unroll
        for (int j = 0; j < 8; ++j) { const int dcol = 4 * (lane + 64 * j); v4f a = (v4f){0.f, 0.f, 0.f, 0.f};
#pragma unroll
            for (int s = 0; s < 4; ++s) a = a + *(const v4f*)(slab + ((size_t)s * MROWS + mr) * 4096 + 2048 + dcol);
            vv[j] = a; }
#pragma unroll
        for (int j = 0; j < 8; ++j) { const int dcol = 4 * (lane + 64 * j); const v4f a = vv[j];
            const int hh = dcol >> 9, d = dcol & (XD - 1); bf16* vp = VTM + ((size_t)(bm * XH + hh) * XD + d) * NMEM + key;
            vp[0] = (bf16)f2bf(a.x); vp[NMEM] = (bf16)f2bf(a.y); vp[2 * NMEM] = (bf16)f2bf(a.z); vp[3 * NMEM] = (bf16)f2bf(a.w); }
      } }
    __syncthreads();
}

__device__ __forceinline__ void p3_scan_item(Frame& F, int item) {
    refresh_ids(F);
    if (item < 256) { for (int rep = 0; rep < P3_SCAN_REP; ++rep)
        mls::state_scan(item >> 4, item & 15, (const bf16*)(F.ws + WS_KT), (const bf16*)(F.ws + WS_VT), (const float*)(F.ws + WS_EB), (bf16*)(F.ws + WS_CST), F.lds, F.wave, rep == P3_SCAN_REP - 1); return; }
    const int bh = item - 288, sl = item >= 288 ? 0 : 1;
    if (sl == 0 && F.tid < MLDK) {
        const float* EB = (const float*)(F.ws + WS_EB) + (size_t)bh * NCHUNK; const float* KS = (const float*)(F.ws + WS_KSUM) + (size_t)bh * NCHUNK * MLDK + F.tid;
        float* NS = (float*)(F.ws + WS_NST) + (size_t)bh * NCHUNK * MLDK + F.tid; float n = 0.f;
        float ks[NCHUNK], eb[NCHUNK];
#pragma unroll
        for (int c = 0; c < NCHUNK; ++c) { ks[c] = KS[(size_t)c * MLDK]; eb[c] = EB[c]; }
#pragma unroll
        for (int c = 0; c < NCHUNK; ++c) { NS[(size_t)c * MLDK] = n; n = eb[c] * (n + ks[c]); }
    }
    if (sl == 1) {
        const int seq = item - 256, b = seq >> 3, fh = seq & 7;
        const float* GATES = (const float*)(F.ws + WS_GATES); const float* SSQX = (const float*)(F.ws + WS_CTL + CTL_SSQX); const float fb = F.inp[4][fh];
        const size_t r0 = (size_t)b * SEQ + 8 * F.tid; float lf[8]; float tot = 0.f;
#pragma unroll
        for (int j = 0; j < 8; ++j) { lf[j] = logsigmoidf(GATES[(r0 + j) * 16 + fh] * rinv_of(SSQX, r0 + j) + fb); tot += lf[j]; }
        const float incl = wave_incl_scan(tot, F.lane);
        LAS float* wt = (LAS float*)F.lds;
        __syncthreads();
        if (F.lane == 63) wt[F.wave] = incl;
        __syncthreads();
        float run = incl - tot;
        for (int wv = 0; wv < F.wave; ++wv) run += wt[wv];
        float* C = (float*)(F.ws + WS_CFOX) + (size_t)seq * SEQ + 8 * F.tid;
        float cs[8];
#pragma unroll
        for (int j = 0; j < 8; ++j) { run += lf[j]; cs[j] = run * -11.313708498984761f; C[j] = cs[j]; }
        LAS float* cp0 = wt + 16; LAS float* cend = wt + 32; LAS float* thr = wt + 96;
        if ((F.tid & 31) == 0) cp0[F.tid >> 5] = cs[0];
        if ((F.tid & 7) == 7) cend[F.tid >> 3] = cs[7];
        if (F.wave == 0) { float gq = fmaxf(fabsf(F.inp[9][F.lane]), fabsf(F.inp[9][F.lane + 64])), gk = fmaxf(fabsf(F.inp[10][F.lane]), fabsf(F.inp[10][F.lane + 64]));
#pragma unroll
            for (int o = 1; o < 64; o <<= 1) { gq = fmaxf(gq, __shfl_xor(gq, o)); gk = fmaxf(gk, __shfl_xor(gk, o)); }
            if (F.lane == 0) thr[0] = 2.0f * 11.313708498984761f * gq * gk + 29.0f; }
        __syncthreads();
        if (F.tid < 16) { const int qb = F.tid; const float T = thr[0], c0 = cp0[qb]; int j = 0;
            while (j < 4 * qb && (c0 - cend[j]) * 0.08838834764831845f > T) ++j;
            ((int*)(F.ws + WS_JLO))[seq * 16 + qb] = JLO_DISABLE ? 0 : (j & ~1); }
        __syncthreads();
    }
}
#ifndef MK_PER_PHASE
#define MK_PER_PHASE 0
#endif
#define XB_TMO      128
#define XB_XCNT(j)  (256  + 64 * (j))
#define XB_XSUB(j)  (1280 + 64 * (j))
#define XB_XGEN(j)  (2304 + 64 * (j))
#define XB_TOP      3328
#define XB_TOPGEN   3392
#define XCD_BAR_WORDS 3456
#define XB_SPIN_CAP (1u << 20)
__device__ __forceinline__ unsigned xb_ld(unsigned* p)              { return __hip_atomic_load(p, __ATOMIC_RELAXED, __HIP_MEMORY_SCOPE_AGENT); }
__device__ __forceinline__ unsigned xb_add(unsigned* p, unsigned v) { return __hip_atomic_fetch_add(p, v, __ATOMIC_RELAXED, __HIP_MEMORY_SCOPE_AGENT); }
__device__ __forceinline__ unsigned xb_xcc_id() { return (unsigned)__builtin_amdgcn_s_getreg((3 << 11) | 20) & 0xFu; }
#define XB_SPIN(cond, bar) do { unsigned _sp = 0; while (cond) { __builtin_amdgcn_s_sleep(1); \
    if ((++_sp & 255u) == 0u) { if (xb_ld(&(bar)[XB_TMO])) break; if (_sp > XB_SPIN_CAP) { atomicAdd(&(bar)[XB_TMO], 1u); break; } } } } while (0)
struct XcdBarrier { unsigned* bar; unsigned x; volatile LAS unsigned* st; int wv; };
__device__ __forceinline__ XcdBarrier xcd_barrier_post(unsigned* bar, volatile LAS unsigned* st, int wv) {
    XcdBarrier b; b.bar = bar; b.x = xb_xcc_id(); b.st = st; b.wv = wv;
    if (wv == 0 && lane_id() == 0) (void)xb_add(&bar[XB_XCNT(b.x)], 1u);
    return b;
}
__device__ __forceinline__ void xcd_barrier_complete(unsigned* bar, unsigned x, unsigned& nloc, unsigned& nx) {
    const unsigned G = gridDim.x * gridDim.y * gridDim.z;
    unsigned sum, cnt, mine, sp = 0u;
    for (;;) {
        sum = 0u; cnt = 0u; mine = 0u;
#pragma unroll
        for (unsigned j = 0; j < 16; ++j) { const unsigned c = xb_ld(&bar[XB_XCNT(j)]); sum += c; cnt += (c > 0u) ? 1u : 0u; mine = (j == x) ? c : mine; }
        if (sum == G) break;
        __builtin_amdgcn_s_sleep(1);
        if ((++sp & 255u) == 0u) { if (xb_ld(&bar[XB_TMO])) break; if (sp > XB_SPIN_CAP) { atomicAdd(&bar[XB_TMO], 1u); break; } }
    }
    nloc = mine > 0u ? mine : 1u; nx = cnt > 0u ? cnt : 1u;
}
__device__ __forceinline__ void xcd_barrier(const XcdBarrier& b) {
    asm volatile("s_waitcnt vmcnt(0)" ::: "memory");
    __syncthreads();
    if (b.wv == 0 && lane_id() == 0) {
        unsigned* bar = b.bar;
        __builtin_amdgcn_s_waitcnt(0);
        unsigned nloc = b.st[0], nx = b.st[1];
        if (nloc == 0u) { xcd_barrier_complete(bar, b.x, nloc, nx); b.st[0] = nloc; b.st[1] = nx; }
        const unsigned old = xb_add(&bar[XB_XSUB(b.x)], 1u);
        const unsigned gen = old / nloc;
        if (old + 1u == (gen + 1u) * nloc) {
            __builtin_amdgcn_fence(__ATOMIC_RELEASE, "agent");
            asm volatile("s_waitcnt vmcnt(0)" ::: "memory");
            const unsigned og = xb_add(&bar[XB_TOP], 1u);
            const unsigned tg = og / nx;
            if (og + 1u == (tg + 1u) * nx) xb_add(&bar[XB_TOPGEN], 1u);
            else XB_SPIN(xb_ld(&bar[XB_TOPGEN]) == tg, bar);
            __builtin_amdgcn_fence(__ATOMIC_ACQUIRE, "agent");
            xb_add(&bar[XB_XGEN(b.x)], 1u);
            asm volatile("s_waitcnt vmcnt(0)" ::: "memory");
        } else {
            XB_SPIN(xb_ld(&bar[XB_XGEN(b.x)]) == gen, bar);
            __builtin_amdgcn_fence(__ATOMIC_ACQUIRE, "agent");
            asm volatile("s_waitcnt vmcnt(0)" ::: "memory");
        }
    }
    __syncthreads();
}
constexpr int LDS_MISC_OFF = LDS_BYTES - 256;
#ifndef ML_TWICE
#define ML_TWICE 1
#endif
#ifndef TWICE_P5
#define TWICE_P5 0
#endif
#ifndef TWICE_P6
#define TWICE_P6 0
#endif
#ifndef TWICE_P8
#define TWICE_P8 0
#endif
#ifndef P4_TWICE
#define P4_TWICE 1
#endif
#ifndef TWICE_P11
#define TWICE_P11 0
#endif
#ifndef TWICE_P10
#define TWICE_P10 0
#endif
#ifndef TWICE_P1
#define TWICE_P1 0
#endif
#ifndef JLO_DISABLE
#define JLO_DISABLE 0
#endif
constexpr int N_PHASES = 12;
struct Args { const float* in[24]; float* out; unsigned char* ws; int ph_lo, ph_hi; };
static_assert(sizeof(Args) == 24 * 8 + 8 + 8 + 8, "Args has no padding");

__global__ void __launch_bounds__(NTHREADS, 2) fwd_kernel(Args args) {
    extern __shared__ __attribute__((aligned(16))) unsigned char lds[];
    Frame F;
    F.lds = (LAS unsigned char*)lds; F.ldsg = lds;
    F.wave = __builtin_amdgcn_readfirstlane((int)(threadIdx.x >> 6)); F.lane = lane_id(); F.tid = F.wave * 64 + F.lane;
    F.G = gridDim.x; { const int bx = blockIdx.x; F.vcu = (F.G % 8 == 0) ? (bx % 8) * (F.G / 8) + bx / 8 : bx; }
    F.inp = (const __attribute__((address_space(4))) cfp_t*)__builtin_amdgcn_kernarg_segment_ptr();
    F.out = args.out; F.ws = args.ws;
    unsigned char* ws = args.ws;
    const int lo = args.ph_lo, hi = args.ph_hi;
    volatile LAS unsigned* MISC = (volatile LAS unsigned*)(F.lds + LDS_MISC_OFF);
    if (F.tid < 64) MISC[F.tid] = 0u;
    __syncthreads();
    XcdBarrier xbar; xbar.bar = (unsigned*)(ws + WS_CTL); xbar.x = 0; xbar.st = nullptr; xbar.wv = F.wave;
    if (hi - lo > 1) xbar = xcd_barrier_post((unsigned*)(ws + WS_CTL), MISC, F.wave);
#ifndef PHASE_MASK
#define PHASE_MASK 0xfff
#endif
#define IN(k) ((((PHASE_MASK) >> (k)) & 1) && lo <= (k) && (k) < hi)
#ifndef DUP_PHASE
#define DUP_PHASE 99
#endif
#define REP(k) for (int rep_ = 0; rep_ < ((k) == DUP_PHASE ? 2 : 1); ++rep_, ((k) == DUP_PHASE && rep_ < 2 ? xcd_barrier(xbar) : (void)0))
#define SEAM(k) do { if (IN(k) && IN((k) + 1)) { xcd_barrier(xbar); } } while (0)
    if (__builtin_expect(lo < 0, 0)) cg::this_grid().sync();
    float* SSQ1 = (float*)(ws + WS_CTL + CTL_SSQ1); float* SSQ2 = (float*)(ws + WS_CTL + CTL_SSQ2); float* SSQQ = (float*)(ws + WS_CTL + CTL_SSQQ);

#ifdef PROBE_PHASE
    unsigned long long pt0 = 0, pt1 = 0, pu0 = 0, pu1 = 0;
#ifndef PROBE_B
#define PROBE_B 99
#endif
#define STAMP(k) do { if ((k) == PROBE_PHASE) pt0 = __builtin_amdgcn_s_memrealtime(); if ((k) == PROBE_PHASE + 1) pt1 = __builtin_amdgcn_s_memrealtime(); \
                      if ((k) == PROBE_B) pu0 = __builtin_amdgcn_s_memrealtime(); if ((k) == PROBE_B + 1) pu1 = __builtin_amdgcn_s_memrealtime(); } while (0)
#else
#define STAMP(k) do {} while (0)
#endif
    STAMP(0);
#ifdef CLK_PHASE
    unsigned long long ck0 = 0, ck1 = 0, cr0 = 0, cr1 = 0;
#define CLKS(k) do { if ((k) == CLK_PHASE) { ck0 = __builtin_amdgcn_s_memtime(); cr0 = __builtin_amdgcn_s_memrealtime(); } if ((k) == CLK_PHASE + 1) { ck1 = __builtin_amdgcn_s_memtime(); cr1 = __builtin_amdgcn_s_memrealtime(); } } while (0)
#else
#define CLKS(k) do {} while (0)
#endif
    CLKS(0);
    if (IN(0)) REP(0) { p0_prologue(F); }
    SEAM(0); STAMP(1); CLKS(1);
    if (IN(1)) REP(1) {
        { pg8::Gemm g{ws, (unsigned)WS_XN, (unsigned)WS_WIN, DM, DM, DM}; pg8::StdOrder S; S.init(MTOK, NPROJ, DM, DM, F.G, (int)blockIdx.x, TWICE_P1);
          pg8::EpiProj E{(bf16*)(ws + WS_PROJ), F.inp[9], F.inp[10], (const float*)(ws + WS_CTL + CTL_SSQX), (LAS float*)(F.lds + pg8::STAGE_BYTES)};
          pg8::gemm_phase<pg8::EpiProj, pg8::StdOrder, true>(F.lds, g, S, E, F.wave); }
        { pg8::Gemm g{ws, (unsigned)WS_MN, (unsigned)WS_WXKV, DM, DM, 512}; pg8::XkvOrder S{F.G, (int)blockIdx.x};
          pg8::EpiSlab E{(float*)(ws + WS_SLAB), 4096, (size_t)MROWS * 4096};
          pg8::gemm_phase<pg8::EpiSlab, pg8::XkvOrder, false>(F.lds, g, S, E, F.wave); }
    }
    SEAM(1); STAMP(2); CLKS(2);
#ifndef P2_TWICE
#define P2_TWICE 1
#endif
    if (IN(2)) REP(2) { for (int item = F.vcu; item < BATCH * NCHUNK * P2_TWICE; item += F.G) p2_prep_item(F, item & 255, false); }
    SEAM(2); STAMP(3); CLKS(3);
#ifndef P3_TWICE
#define P3_TWICE 1
#endif
    if (IN(3)) REP(3) { for (int item = F.vcu; item < 304 * P3_TWICE; item += F.G) p3_scan_item(F, item % 304); }
    SEAM(3); STAMP(4); CLKS(4);
    if (IN(4)) REP(4) {
        {
            const fox::Srd R = __builtin_amdgcn_make_buffer_rsrc((void*)ws, (short)0, (int)WS_END, 0x00020000);
            unsigned* QC = (unsigned*)(ws + WS_CTL + CTL_QCTR); const int* JLO = (const int*)(ws + WS_JLO);
            const float* CF = (const float*)(ws + WS_CFOX); const float* GO = F.inp[11];
            constexpr int QN = 192 * P4_TWICE, NONE = 1 << 20;
            auto mk_item = [&](int g) { const int qx = g / QN, i = (g - qx * QN) % 192, qb = 15 - (i >> 2), bh = 4 * qx + (i & 3), b = bh >> 3, h = bh & 7;
                fox::Item I; I.rowb = (unsigned)b * SEQ * 2048u + (unsigned)h * (FOXD * 2); I.o = (unsigned)WS_CONCAT + (unsigned)b * SEQ * 4096u + (unsigned)h * (FOXD * 2);
                I.CS = CF + (size_t)bh * SEQ; I.G = GO + h * FOXD; I.P0 = qb * 256; I.jlo = JLO[bh * 16 + qb]; return I; };
            auto is_fox = [&](int g) { return g < NONE && ((g % QN) % 192) < 64; };
            auto pull = [&]() { if (F.tid == 0) { unsigned qc = MISC[17], left = MISC[18]; int g = NONE;
                    while (left > 0u) { const unsigned i = atomicAdd(QC + qc * 64, 1u); if (i < (unsigned)QN) { g = (int)(qc * QN + i); break; } qc = (qc + 1u) & 7u; --left; }
                    MISC[17] = qc; MISC[18] = left; MISC[16] = (unsigned)g; } };
            if (F.tid == 0) { MISC[17] = xb_xcc_id() & 7u; MISC[18] = 8u; }
            pull();
            __syncthreads();
            int cur = __builtin_amdgcn_readfirstlane((int)MISC[16]);
            __syncthreads();
            while (cur < NONE) {
                if (is_fox(cur)) {
                    fox::Item I = mk_item(cur); fox::Seam S;
                    fox::fox_prime(R, I, (char*)lds, S, F.wave);
                    for (;;) {
                        pull();
                        auto next_item = [&](const fox::Item& self, int& nidx) { nidx = __builtin_amdgcn_readfirstlane((int)MISC[16]); return is_fox(nidx) ? mk_item(nidx) : self; };
                        const int nidx = fox::fox_block(R, I, next_item, (char*)lds, S, F.wave);
                        if (!is_fox(nidx)) { cur = nidx; break; }
                        I = mk_item(nidx);
                    }
                    VM_WAIT(); __syncthreads();
                } else {
                    const int qx = cur / QN, it = qx * 128 + ((cur - qx * QN) % 192 - 64), c = it & 63, h = (it >> 6) & 3, b = it >> 8;
                    pull();
                    mls::chunk_out(b, h, c, (const bf16*)(ws + WS_QP), (const bf16*)(ws + WS_KPP), (const bf16*)(ws + WS_VT), (const bf16*)(ws + WS_CST),
                                   (const float*)(ws + WS_NST), (const bf16*)(ws + WS_MO), F.inp[12], (bf16*)(ws + WS_CONCAT), F.lds, F.wave);
                    cur = __builtin_amdgcn_readfirstlane((int)MISC[16]);
                    __syncthreads();
                }
            }
        }
    }
    SEAM(4); STAMP(5); CLKS(5);
    if (IN(5)) REP(5) {
        pg8::Gemm g{ws, (unsigned)WS_CONCAT, (unsigned)WS_WOUT, DM, DM, DM}; pg8::StdOrder S; S.init(MTOK, DM, DM, DM, F.G, (int)blockIdx.x, TWICE_P5);
        pg8::EpiResid<true, false> E{F.inp[0], (bf16*)(ws + WS_X1B), SSQ1, DM, 1.0f, ws + WS_X1Q};
        pg8::gemm_phase<pg8::EpiResid<true, false>, pg8::StdOrder, true>(F.lds, g, S, E, F.wave);
    }
    SEAM(5); STAMP(6); CLKS(6);
    if (IN(6)) REP(6) {
        pg8::Gemm g{ws, (unsigned)WS_X1Q, (unsigned)WS_WXQ, DM / 2, DM / 2, DM / 2}; pg8::StdOrder S; S.init(MTOK, DM, DM / 2, DM / 2, F.G, (int)blockIdx.x, TWICE_P6);
        pg8::EpiQ E{(bf16*)(ws + WS_Q), SSQ1, SSQQ, 1.0f / W8_SCALE};
        pg8::gemm_phase<pg8::EpiQ, pg8::StdOrder, true, true>(F.lds, g, S, E, F.wave);
    }
    SEAM(6); STAMP(7); CLKS(7);
    if (IN(7)) REP(7) {
        pg8::Gemm g{ws, (unsigned)WS_Q, (unsigned)WS_KHAT, DM, DM, XD}; pg8::ScoreOrder S{F.G, (int)blockIdx.x};
        pg8::EpiSoftmax E{(bf16*)(ws + WS_P), SSQQ};
        if (F.G >= 256) pg8::gemm_phase<pg8::EpiSoftmax, pg8::ScoreOrder, false>(F.lds, g, S, E, F.wave);
    }
    SEAM(7); STAMP(8); CLKS(8);
    if (IN(8)) REP(8) {
        pg8::Gemm g{ws, (unsigned)WS_P, (unsigned)WS_VTM, 1024, NMEM, NMEM}; pg8::PvOrder S{F.G, (int)blockIdx.x, TWICE_P8};
        pg8::EpiStoreFp8 E{ws + WS_CO, DM, CO8_SCALE};
        pg8::gemm_phase<pg8::EpiStoreFp8, pg8::PvOrder, true>(F.lds, g, S, E, F.wave);
    }
    SEAM(8); STAMP(9); CLKS(9);
#ifdef EXTRA_BARS
    for (int eb = 0; eb < EXTRA_BARS; ++eb) xcd_barrier(xbar);
#endif
    if (IN(9)) REP(9) {
        pg8::Gemm g{ws, (unsigned)WS_CO, (unsigned)WS_WXO, DM / 2, DM / 2, DM / 2}; pg8::StdOrder S; S.init(MTOK, DM, DM / 2, DM / 2, F.G, (int)blockIdx.x);
        pg8::EpiResid<false, false> E{(const bf16*)(ws + WS_X1B), (bf16*)(ws + WS_X2B), SSQ2, DM, 1.0f / (W8_SCALE * CO8_SCALE), nullptr};
        pg8::gemm_phase<pg8::EpiResid<false, false>, pg8::StdOrder, true, true>(F.lds, g, S, E, F.wave);
    }
    SEAM(9); STAMP(10); CLKS(10);
    if (IN(10)) REP(10) {
        pg8::Gemm g{ws, (unsigned)WS_X2B, (unsigned)WS_WUP, DM, DM, DM}; pg8::StdOrder S; S.init(MTOK, DFF, DM, DM, F.G, (int)blockIdx.x, TWICE_P10);
        pg8::EpiUp E{(bf16*)(ws + WS_H), SSQ2};
        pg8::gemm_phase<pg8::EpiUp, pg8::StdOrder, true>(F.lds, g, S, E, F.wave);
    }
    SEAM(10); STAMP(11); CLKS(11);
    if (IN(11)) REP(11) {
        pg8::Gemm g{ws, (unsigned)WS_H, (unsigned)WS_WDN, DFF, DFF, DFF}; pg8::StdOrder S; S.init(MTOK, DM, DFF, DFF, F.G, (int)blockIdx.x, TWICE_P11);
        pg8::EpiResid<false, true> E{(const bf16*)(ws + WS_X2B), F.out, nullptr, DM, 1.0f, nullptr};
        pg8::gemm_phase<pg8::EpiResid<false, true>, pg8::StdOrder, true>(F.lds, g, S, E, F.wave);
    }
#ifdef CLK_PHASE
    xcd_barrier(xbar); CLKS(12);
    if (blockIdx.x == 0 && F.tid == 0) F.out[0] += rintf((float)(ck1 - ck0) / (float)(cr1 - cr0));
#endif
#ifdef PROBE_PHASE
    xcd_barrier(xbar); STAMP(12);
    if (blockIdx.x == 0 && F.tid < 64) {
        const float ta = 20.0f * rintf((float)(pt1 - pt0) * 0.01f * 0.05f), tb = 0.8f * rintf((float)(pu1 - pu0) * 0.01f * 0.125f);
        if (F.tid == 0) F.out[0] += ta;
        if (PROBE_B != 99) for (int i = F.tid; i < 10000; i += 64) F.out[64 + i] += tb;
    }
#endif
#undef IN
#undef SEAM
}

extern "C" void kernel_launch(void* const* d_in, const int* in_sizes, int n_in, void* d_out, int out_size, void* d_ws, size_t ws_size, hipStream_t stream) {
    static int grid = 0;
    if (grid == 0) {
        if (n_in != 24 || in_sizes[0] != MTOK * DM || out_size != MTOK * DM || ws_size < WS_END) {
            fprintf(stderr, "kernel_launch: unexpected shapes (n_in %d, in0 %d, out %d, ws %zu; need ws >= %zu); nothing launched\n", n_in, n_in > 0 ? in_sizes[0] : -1, out_size, ws_size, (size_t)WS_END); grid = -1; return; }
        int dev = 0, cus = 0, per_cu = 0;
        if (hipGetDevice(&dev) != hipSuccess || hipDeviceGetAttribute(&cus, hipDeviceAttributeMultiprocessorCount, dev) != hipSuccess) { grid = -1; return; }
        if (hipFuncSetAttribute((const void*)fwd_kernel, hipFuncAttributeMaxDynamicSharedMemorySize, LDS_BYTES) != hipSuccess) { fprintf(stderr, "kernel_launch: hipFuncSetAttribute failed\n"); grid = -1; return; }
        if (hipOccupancyMaxActiveBlocksPerMultiprocessor(&per_cu, (const void*)fwd_kernel, NTHREADS, LDS_BYTES) != hipSuccess || per_cu < 1) { fprintf(stderr, "kernel_launch: occupancy query says %d blocks per CU\n", per_cu); per_cu = 1; }
        (void)hipGetLastError();
        grid = cus;
    }
    if (grid < 0) return;
    (void)hipMemsetAsync((char*)d_ws + WS_CTL, 0, CTL_BYTES, stream);
    Args a{};
    for (int i = 0; i < 24; ++i) a.in[i] = (const float*)d_in[i];
    a.out = (float*)d_out; a.ws = (unsigned char*)d_ws;
#if MK_PER_PHASE
    for (int ph = 0; ph < N_PHASES; ++ph) { a.ph_lo = ph; a.ph_hi = ph + 1;
        hipLaunchKernelGGL(fwd_kernel, dim3(grid), dim3(NTHREADS), LDS_BYTES, stream, a); }
#else
    a.ph_lo = 0; a.ph_hi = N_PHASES;
    void* kargs[] = {&a};
    hipError_t e = hipLaunchCooperativeKernel((const void*)fwd_kernel, dim3(grid), dim3(NTHREADS), kargs, LDS_BYTES, stream);
    if (e != hipSuccess) fprintf(stderr, "kernel_launch: cooperative launch failed: %s (grid %d)\n", hipGetErrorString(e), grid);
#endif
}
```

```cpp
#include <hip/hip_runtime.h>
#include <hip/hip_cooperative_groups.h>
#include <cstdio>
#include <cstdint>
namespace cg = cooperative_groups;

constexpr int BATCH = 4, SEQ = 4096, DM = 2048, MTOK = BATCH * SEQ;
constexpr int NMEM = 256, MROWS = BATCH * NMEM;
constexpr int FOXH = 8, FOXD = 128, MLH = 4, MLDV = 256, MLDK = 128, XH = 4, XD = 512, DFF = 8192;
constexpr int IN_WIDTH = 6160, NPROJ = 6144, NCHUNK = SEQ / 64;
constexpr float EPS = 1e-6f;
constexpr float LOG2E = 1.4426950408889634f;

constexpr size_t MiB = (size_t)1 << 20;
constexpr size_t WS_WIN = 0, WS_WOUT = 24 * MiB, WS_WXQ = 32 * MiB, WS_WXKV = 40 * MiB, WS_WXO = 56 * MiB, WS_WUP = 60 * MiB, WS_WDN = 92 * MiB;
constexpr size_t WS_PROJ = 128 * MiB;
constexpr size_t WS_FQ = 128 * MiB, WS_FK = 160 * MiB, WS_FV = 192 * MiB, WS_MQK = 224 * MiB, WS_MV = 256 * MiB, WS_MO = 288 * MiB;
constexpr size_t WS_XN = 320 * MiB;
constexpr size_t WS_QP = 0 * MiB, WS_KPP = 16 * MiB;
constexpr size_t WS_KT = 32 * MiB;
constexpr size_t WS_VT = 48 * MiB;
constexpr size_t WS_MISC = 464 * MiB;
constexpr size_t WS_CTL = WS_MISC, CTL_BYTES = 2 * MiB;
constexpr size_t CTL_QCTR = 32 * 1024;
constexpr size_t CTL_SSQ1 = 64 * 1024, CTL_SSQ2 = 128 * 1024, CTL_SSQQ = 192 * 1024, CTL_SSQX = 448 * 1024;
constexpr size_t WS_GATES = WS_MISC + 1 * MiB;
constexpr size_t WS_CFOX = WS_MISC + 3 * MiB;
constexpr size_t WS_EB = WS_MISC + 4 * MiB;
constexpr size_t WS_KSUM = WS_MISC + 5 * MiB;
constexpr size_t WS_NST = WS_MISC + 6 * MiB;
constexpr size_t WS_JLO = WS_MISC + 7 * MiB;
constexpr size_t WS_MN = WS_MISC + 8 * MiB;
constexpr size_t WS_KHAT = WS_MISC + 12 * MiB;
constexpr size_t WS_VTM = WS_MISC + 16 * MiB;
constexpr size_t WS_END = 512 * MiB;
constexpr size_t WS_CONCAT = 224 * MiB;
constexpr size_t WS_X1B = 128 * MiB;
constexpr size_t WS_Q = 192 * MiB;
constexpr size_t WS_CO = 256 * MiB;
constexpr size_t WS_P = 320 * MiB;
constexpr size_t WS_X1Q = 288 * MiB;
constexpr size_t WS_X2B = 128 * MiB;
constexpr size_t WS_H = 192 * MiB;
constexpr size_t WS_SLAB = 400 * MiB;
constexpr size_t WS_CST = 400 * MiB;

#ifndef P3_SCAN_REP
#define P3_SCAN_REP 1
#endif
#ifndef JLO_DISABLE
#define JLO_DISABLE 0
#endif
constexpr float W8_SCALE = 64.0f, CO8_SCALE = 8.0f;
constexpr float Q8_SCALE = 16.0f, KH8_SCALE = 16.0f, P8_SCALE = 256.0f, V8_SCALE = 16.0f;
constexpr int WDNPITCH = DFF + 64;
constexpr int HPITCH = DFF + 64;
constexpr int LDS_BYTES = 147456;
constexpr int NTHREADS = 512;

#define GAS __attribute__((address_space(1)))
#define LAS __attribute__((address_space(3)))
typedef unsigned short bf16;
typedef unsigned v4u __attribute__((ext_vector_type(4)));
typedef unsigned v2u __attribute__((ext_vector_type(2)));
typedef float v4f __attribute__((ext_vector_type(4)));
typedef short v8s __attribute__((ext_vector_type(8)));
typedef short v4s __attribute__((ext_vector_type(4)));
#define LDS_WAIT() asm volatile("s_waitcnt lgkmcnt(0)" ::: "memory")
#define VM_WAIT() asm volatile("s_waitcnt vmcnt(0)" ::: "memory")
__device__ __forceinline__ unsigned f2bf(float f) { unsigned u = __builtin_bit_cast(unsigned, f); return (u + 0x7fffu + ((u >> 16) & 1u)) >> 16; }
__device__ __forceinline__ unsigned pk2(float lo, float hi) { return f2bf(lo) | (f2bf(hi) << 16); }
__device__ __forceinline__ float bf2f(unsigned h) { return __builtin_bit_cast(float, h << 16); }
__device__ __forceinline__ float bflo(unsigned w) { return __builtin_bit_cast(float, w << 16); }
__device__ __forceinline__ float bfhi(unsigned w) { return __builtin_bit_cast(float, w & 0xffff0000u); }
__device__ __forceinline__ float wave_sum(float v) {
#pragma unroll
    for (int o = 1; o < 64; o <<= 1) v += __shfl_xor(v, o);
    return v;
}
__device__ __forceinline__ int lane_id() { return (int)__builtin_amdgcn_mbcnt_hi(~0u, __builtin_amdgcn_mbcnt_lo(~0u, 0u)); }
__device__ __forceinline__ int wg_tid(int wv) { int t = wv * 64 + lane_id(); asm volatile("" : "+v"(t)); return t; }
__device__ __forceinline__ float logsigmoidf(float x) { return x >= 0.f ? -log1pf(__expf(-x)) : x - log1pf(__expf(x)); }
__device__ __forceinline__ float sigmoidf_(float x) { return 1.f / (1.f + __expf(-x)); }
__device__ __forceinline__ float rinv_of(const float* ssqx, size_t row) { return 1.0f / sqrtf(ssqx[row] * (1.0f / DM) + EPS); }
#define MK_PER_PHASE 0
namespace pg8 {
#define PG8_LAS __attribute__((address_space(3)))
typedef unsigned short bf16_t;
typedef short bf16x8 __attribute__((ext_vector_type(8)));
typedef float f32x4 __attribute__((ext_vector_type(4)));
typedef float f32x2 __attribute__((ext_vector_type(2)));
typedef unsigned u32x4 __attribute__((ext_vector_type(4)));
typedef unsigned u32x2 __attribute__((ext_vector_type(2)));
constexpr int BM = 256, BK = 64, HALF = 128, HTB = HALF * BK * 2, STAGE_BYTES = 8 * HTB, NXCD = 8, WGM = 8;

__host__ __device__ __forceinline__ int lds_byte(int r, int c) { const int st = (r >> 4) * 2 + (c >> 5), rr = r & 15, cc = c & 31, ob = rr * 64 + cc * 2; return st * 1024 + (ob ^ (((ob >> 9) & 1) << 5)); }
__host__ __device__ __forceinline__ void stage_rc(int b, int& R, int& C) { const int st = b / 1024, sb = b % 1024, swz = sb ^ (((sb >> 9) & 1) << 5); R = (st >> 1) * 16 + swz / 64; C = (st & 1) * 32 + (swz % 64) / 2; }
__host__ __device__ __forceinline__ int perm32(int rho) { const int n = rho >> 4, i = rho & 15; return 8 * (i >> 2) + 4 * n + (i & 3); }

struct Unit { int row0, col0; long aoff, boff; int aux; };
struct Gemm { const void* base; unsigned aoff, boff; int lda, ldb, K; int krev = 0; unsigned ksa = BK * 2, ksb = BK * 2; };

struct StdOrder {
    int nM, nN, nwg, G, c, lda, ldb, rsh, wgm;
    __device__ void init(int M, int N, int lda_, int ldb_, int G_, int c_, int rsh_ = 0, int wgm_ = WGM) { nM = M / BM; nN = N / BM; nwg = nM * nN; G = G_; c = c_; lda = lda_; ldb = ldb_; rsh = rsh_; wgm = wgm_; }
    __device__ bool next(int i, Unit& u) const {
        const long L = (long)(i >> rsh) * G + c; if (L >= nwg) return false;
        int wgid = (int)L; { const int q = nwg / NXCD, r = nwg % NXCD, xcd = wgid % NXCD, off = wgid / NXCD; wgid = (xcd < r ? xcd * (q + 1) : r * (q + 1) + (xcd - r) * q) + off; }
        const int nig = wgm * nN, gid = wgid / nig, fm = gid * wgm, gsz = (nM - fm) < wgm ? (nM - fm) : wgm;
        const int pm = fm + ((wgid % nig) % gsz), pn = (wgid % nig) / gsz;
        u.row0 = pm * BM; u.col0 = pn * BM; u.aoff = (long)pm * BM * lda; u.boff = (long)pn * BM * ldb; u.aux = i & ((1 << rsh) - 1); return true;
    }
};

__device__ __forceinline__ unsigned cvt_pk_bf16(float lo, float hi) { unsigned r; asm volatile("v_cvt_pk_bf16_f32 %0, %1, %2" : "=v"(r) : "v"(lo), "v"(hi)); return r; }

typedef int v8i_t __attribute__((ext_vector_type(8)));
typedef int v4i_t __attribute__((ext_vector_type(4)));
template <class Epi, class Sched, bool ALIGN_EPI, bool FP8 = false>
__device__ __forceinline__ void gemm_phase(PG8_LAS unsigned char* lds, const Gemm g, const Sched& S, const Epi& E, int wv) {
    const int tid = wg_tid(wv), wid = wv, lane = tid & 63, wr = wid >> 2, wc = wid & 3, fr = lane & 15, fq = lane >> 4;
    const int K = g.K, nt = K / BK;
    unsigned voffA, voffB;
    { int R, C; stage_rc(tid * 16, R, C); const int Rb = Epi::PERM ? ((R & ~31) + perm32(R & 31)) : R;
      voffA = (unsigned)(R * g.lda + C) * 2u; voffB = (unsigned)(Rb * g.ldb + C) * 2u; }
    const unsigned pA = 64u * (unsigned)g.lda * 2u, pB = 64u * (unsigned)g.ldb * 2u;
    const unsigned voffA_v = voffA, voffB_v = voffB, voffA_p = pA, voffB_p = pB;
    const unsigned kstepA = g.krev ? 0u - g.ksa : g.ksa, kstepB = g.krev ? 0u - g.ksb : g.ksb, k0A = g.krev ? (unsigned)(nt - 1) * g.ksa : 0u, k0B = g.krev ? (unsigned)(nt - 1) * g.ksb : 0u;
    const unsigned hA = (unsigned)HALF * g.lda * 2, hB = (unsigned)HALF * g.ldb * 2;
    const __amdgpu_buffer_rsrc_t rsrc = __builtin_amdgcn_make_buffer_rsrc((void*)g.base, (short)0, 0x7fffffff, 0x00020000);
    const unsigned ldsw = (unsigned)wid * 1024u;
    const int aoff = lds_byte(wr * 64 + fr, fq * 8), boff = lds_byte(wc * 32 + fr, fq * 8);
#define PG8_SA(b, h) (((b) * 2 + (h)) * HTB)
#define PG8_SB(b, h) ((4 + (b) * 2 + (h)) * HTB)
#define PG8_STAGE(bufoff, gbase, voff) do { _Pragma("unroll") for (int _i = 0; _i < 2; ++_i) \
        __builtin_amdgcn_raw_ptr_buffer_load_lds(rsrc, (PG8_LAS void*)(lds + (bufoff) + ldsw + _i * 8192), 16, voff##_v, (gbase) + _i * voff##_p, 0, 0); } while (0)
#define PG8_LDA(dst, b, h) do { _Pragma("unroll") for (int m = 0; m < 4; ++m) dst[m] = PG8_CAT(*(const PG8_LAS v4i_t*)(lds + PG8_SA(b, h) + aoff + m * 2048), *(const PG8_LAS v4i_t*)(lds + PG8_SA(b, h) + aoff + m * 2048 + 1024)); } while (0)
#define PG8_LDB(dst, b, h) do { _Pragma("unroll") for (int n = 0; n < 2; ++n) dst[n] = PG8_CAT(*(const PG8_LAS v4i_t*)(lds + PG8_SB(b, h) + boff + n * 2048), *(const PG8_LAS v4i_t*)(lds + PG8_SB(b, h) + boff + n * 2048 + 1024)); } while (0)
#define PG8_CAT(x0, x1) __builtin_shufflevector((x0), (x1), 0, 1, 2, 3, 4, 5, 6, 7)
#define PG8_K0(x) __builtin_bit_cast(bf16x8, __builtin_shufflevector((x), (x), 0, 1, 2, 3))
#define PG8_K1(x) __builtin_bit_cast(bf16x8, __builtin_shufflevector((x), (x), 4, 5, 6, 7))
#define PG8_MMA(ai, bj, At, Bt) do { __builtin_amdgcn_s_setprio(1); _Pragma("unroll") for (int m = 0; m < 4; ++m) _Pragma("unroll") for (int n = 0; n < 2; ++n) { \
        if constexpr (FP8) asm volatile("v_mfma_f32_16x16x128_f8f6f4 %0, %1, %2, %0" : "+v"(acc[ai][bj][m][n]) : "v"(Bt[n]), "v"(At[m]));     \
        else { acc[ai][bj][m][n] = __builtin_amdgcn_mfma_f32_16x16x32_bf16(PG8_K0(Bt[n]), PG8_K0(At[m]), acc[ai][bj][m][n], 0, 0, 0); \
               acc[ai][bj][m][n] = __builtin_amdgcn_mfma_f32_16x16x32_bf16(PG8_K1(Bt[n]), PG8_K1(At[m]), acc[ai][bj][m][n], 0, 0, 0); } } \
        __builtin_amdgcn_s_setprio(0); } while (0)
#define PG8_WAIT_V(n) asm volatile("s_waitcnt vmcnt(" #n ")" ::: "memory")
#define PG8_WAIT_L(n) asm volatile("s_waitcnt lgkmcnt(" #n ")" ::: "memory")
#define PG8_BAR __builtin_amdgcn_s_barrier()
#define PG8_SCHED __builtin_amdgcn_sched_barrier(0)
    Unit cur, nxt; int ui = 0;
    if (!S.next(0, cur)) return;
    PG8_LAS float* rsc = (PG8_LAS float*)(lds + 140288); int rs_row0 = -1;
    if constexpr (Epi::ROWSCALE) { if (tid < 256) rsc[tid] = __builtin_amdgcn_rsqf(E.rs_src()[cur.row0 + tid] * (1.0f / 2048.0f) + 1e-6f); rs_row0 = cur.row0; }
    f32x4 acc[2][2][4][2];
#pragma unroll
    for (int a = 0; a < 2; ++a)
#pragma unroll
        for (int b = 0; b < 2; ++b)
#pragma unroll
            for (int m = 0; m < 4; ++m)
#pragma unroll
                for (int n = 0; n < 2; ++n) acc[a][b][m][n] = (f32x4){0.f, 0.f, 0.f, 0.f};
    v8i_t At[4], B0[2], B1[2];
    unsigned cA = g.aoff + (unsigned)cur.aoff * 2u + k0A, cB = g.boff + (unsigned)cur.boff * 2u + k0B;
    PG8_STAGE(PG8_SB(0, 0), cB, voffB); PG8_STAGE(PG8_SB(0, 1), cB + hB, voffB); PG8_STAGE(PG8_SA(0, 0), cA, voffA); PG8_STAGE(PG8_SA(0, 1), cA + hA, voffA);
    if (wr == 1) PG8_BAR;
    PG8_WAIT_V(2); PG8_BAR;
    PG8_STAGE(PG8_SB(1, 0), cB + kstepB, voffB); PG8_STAGE(PG8_SA(1, 0), cA + kstepA, voffA); PG8_STAGE(PG8_SB(1, 1), cB + hB + kstepB, voffB);
    PG8_WAIT_V(6); PG8_BAR;
    for (;;) {
        const bool has_next = S.next(ui + 1, nxt);
        const unsigned nA = has_next ? g.aoff + (unsigned)nxt.aoff * 2u + k0A : cA, nB = has_next ? g.boff + (unsigned)nxt.boff * 2u + k0B : cB;
        for (int t = 0; t < nt; t += 2) {
            const bool last = (t == nt - 2);
            const unsigned a1 = cA + (unsigned)(t + 1) * kstepA;
            const unsigned a2 = last ? nA : cA + (unsigned)(t + 2) * kstepA, b2 = last ? nB : cB + (unsigned)(t + 2) * kstepB;
            const unsigned a3 = a2 + kstepA, b3 = b2 + kstepB;
            PG8_LDB(B0, 0, 0); PG8_LDB(B1, 0, 1); PG8_SCHED; PG8_LDA(At, 0, 0); PG8_STAGE(PG8_SA(1, 1), a1 + hA, voffA);
            PG8_WAIT_V(8); PG8_WAIT_L(0); PG8_BAR; PG8_MMA(0, 0, At, B0); PG8_MMA(0, 1, At, B1); PG8_BAR; PG8_SCHED;
            PG8_LDA(At, 0, 1); PG8_STAGE(PG8_SB(0, 0), b2, voffB); PG8_STAGE(PG8_SB(0, 1), b2 + hB, voffB); PG8_STAGE(PG8_SA(0, 0), a2, voffA);
            PG8_WAIT_V(8); PG8_WAIT_L(0); PG8_BAR; PG8_MMA(1, 0, At, B0); PG8_MMA(1, 1, At, B1); PG8_BAR; PG8_SCHED;
            PG8_LDB(B0, 1, 0); PG8_LDB(B1, 1, 1); PG8_SCHED; PG8_LDA(At, 1, 0); PG8_STAGE(PG8_SA(0, 1), a2 + hA, voffA);
            PG8_WAIT_V(8); PG8_WAIT_L(0); PG8_BAR; PG8_MMA(0, 0, At, B0); PG8_MMA(0, 1, At, B1); PG8_BAR; PG8_SCHED;
            PG8_LDA(At, 1, 1); PG8_STAGE(PG8_SB(1, 0), b3, voffB); PG8_STAGE(PG8_SB(1, 1), b3 + hB, voffB); PG8_STAGE(PG8_SA(1, 0), a3, voffA);
            PG8_WAIT_V(8); PG8_WAIT_L(0); PG8_BAR; PG8_MMA(1, 0, At, B0); PG8_MMA(1, 1, At, B1); PG8_BAR; PG8_SCHED;
        }
        if constexpr (ALIGN_EPI) { if (wr == 0) PG8_BAR; }
        if constexpr (FP8) asm volatile("s_nop 15\n\ts_nop 7" ::: "memory");
        if constexpr (!Epi::AFTER_DRAIN) { E(acc, cur, wr, wc, fr, fq, rsc); }
        if (!has_next) break;
#pragma unroll
        for (int a = 0; a < 2; ++a)
#pragma unroll
            for (int b = 0; b < 2; ++b)
#pragma unroll
                for (int m = 0; m < 4; ++m)
#pragma unroll
                    for (int n = 0; n < 2; ++n) acc[a][b][m][n] = (f32x4){0.f, 0.f, 0.f, 0.f};
        cur = nxt; cA = nA; cB = nB; ++ui;
        if constexpr (Epi::ROWSCALE) { if (cur.row0 != rs_row0) { rsc = (PG8_LAS float*)(lds + (rsc == (PG8_LAS float*)(lds + 140288) ? 141312 : 140288)); if (tid < 256) rsc[tid] = __builtin_amdgcn_rsqf(E.rs_src()[cur.row0 + tid] * (1.0f / 2048.0f) + 1e-6f); rs_row0 = cur.row0; } }
        if constexpr (ALIGN_EPI) { if (wr == 1) PG8_BAR; }
    }
    PG8_WAIT_V(0);
    if constexpr (!ALIGN_EPI) { if (wr == 0) PG8_BAR; }
    PG8_BAR;
    if constexpr (Epi::AFTER_DRAIN) { E.fused(acc, cur, wr, wc, fr, fq, lds, wid, lane); }
#undef PG8_SA
#undef PG8_SB
#undef PG8_STAGE
#undef PG8_LDA
#undef PG8_LDB
#undef PG8_MMA
#undef PG8_CAT
#undef PG8_K0
#undef PG8_K1
#undef PG8_WAIT_V
#undef PG8_WAIT_L
#undef PG8_BAR
#undef PG8_SCHED
}
}
namespace pg8 {
struct XkvOrder {
    int G, c;
    __device__ bool next(int i, Unit& u) const {
        const int L = i * G + c; if (L >= 256) return false;
        const int kq = L & 3, tile = L >> 2, pm = tile & 3, pn = tile >> 2;
        u.row0 = pm * 256; u.col0 = pn * 256; u.aoff = (long)pm * 256 * DM + kq * 512; u.boff = (long)pn * 256 * DM + kq * 512; u.aux = kq; return true;
    }
};
struct QOrder {
    int G, c, rsh;
    __device__ bool next(int i, Unit& u) const {
        if (c >= 256 || (i >> rsh) >= 2) return false;
        const int b = c >> 6, h = (c >> 4) & 3, mt = c & 15, pm = b * 16 + mt, pn = 2 * h + (i >> rsh);
        u.row0 = pm * 256; u.col0 = pn * 256; u.aoff = (long)pm * 256 * (DM / 2); u.boff = (long)pn * 256 * (DM / 2); u.aux = i & ((1 << rsh) - 1); return true;
    }
};
struct ScoreOrder {
    int G, c;
    __device__ bool next(int i, Unit& u) const {
        const int L = i * G + c; if (L >= 256) return false;
        const int b = L >> 6, h = (L >> 4) & 3, mt = L & 15;
        u.row0 = b * SEQ + mt * 256; u.col0 = h * 256; u.aoff = (long)u.row0 * (DM / 2) + h * (XD / 2); u.boff = (long)(b * NMEM) * (DM / 2) + h * (XD / 2); u.aux = h; return true;
    }
};
struct PvOrder {
    int G, c, rsh;
    __device__ bool next(int i, Unit& u) const {
        if (c >= 256 || (i >> rsh) >= 2) return false;
        const int nt = i >> rsh, b = c >> 6, h = (c >> 4) & 3, mt = c & 15;
        u.row0 = b * SEQ + mt * 256; u.col0 = h * XD + nt * 256; u.aoff = (long)u.row0 * 512 + h * 128; u.boff = ((long)(b * XH + h) * XD + nt * 256) * (NMEM / 2); u.aux = 0; return true;
    }
};


#ifndef EPI_FULL_LINES
#define EPI_FULL_LINES 0
#endif
#ifndef EPI_SC1
#define EPI_SC1 0
#endif
__device__ __forceinline__ void st16(void* p, u32x4 v) {
#if EPI_SC1
    asm volatile("global_store_dwordx4 %0, %1, off sc1\n\ts_nop 1" :: "v"(p), "v"(v) : "memory");
#else
    *(u32x4*)p = v;
#endif
}
__device__ __forceinline__ void st16f(void* p, f32x4 v) {
#if EPI_SC1
    asm volatile("global_store_dwordx4 %0, %1, off sc1\n\ts_nop 1" :: "v"(p), "v"(v) : "memory");
#else
    *(f32x4*)p = v;
#endif
}
__device__ __forceinline__ void st8(void* p, u32x2 v) {
#if EPI_SC1
    asm volatile("global_store_dwordx2 %0, %1, off sc1\n\ts_nop 0" :: "v"(p), "v"(v) : "memory");
#else
    *(u32x2*)p = v;
#endif
}

__device__ __forceinline__ float lane_xor8(float x) { return __builtin_bit_cast(float, __builtin_amdgcn_update_dpp(0, __builtin_bit_cast(int, x), 0x128, 0xf, 0xf, false)); }
__device__ __forceinline__ unsigned pk4_fp8(float a, float b, float c, float d) { int w = __builtin_amdgcn_cvt_pk_fp8_f32(a, b, 0, false); w = __builtin_amdgcn_cvt_pk_fp8_f32(c, d, w, true); return (unsigned)w; }
struct EpiStoreBf16 {
    static constexpr bool PERM = true, AFTER_DRAIN = false, ROWSCALE = false;
    bf16_t* O; int ldc; int split_cols; size_t split_stride;
    __device__ __forceinline__ void operator()(const f32x4 (&acc)[2][2][4][2], const Unit& u, int wr, int wc, int fr, int fq, PG8_LAS const float* rsc) const {
        int colt = u.col0; bf16_t* base = O;
        if (split_cols) { const int t = colt / split_cols; base += (size_t)t * split_stride; colt -= t * split_cols; }
        const int row0 = u.row0 + wr * 64 + fr, col0 = colt + wc * 32 + 8 * fq;
#pragma unroll
        for (int ai = 0; ai < 2; ++ai)
#pragma unroll
            for (int m = 0; m < 4; ++m) { bf16_t* rowp = base + (size_t)(row0 + ai * HALF + m * 16) * ldc + col0;
#pragma unroll
                for (int bj = 0; bj < 2; ++bj) { const f32x4 v0 = acc[ai][bj][m][0], v1 = acc[ai][bj][m][1];
                    u32x4 w; w.x = cvt_pk_bf16(v0[0], v0[1]); w.y = cvt_pk_bf16(v0[2], v0[3]); w.z = cvt_pk_bf16(v1[0], v1[1]); w.w = cvt_pk_bf16(v1[2], v1[3]);
                    st16(rowp + bj * HALF, w); } }
    }
};
struct EpiProj {
    static constexpr bool PERM = true, AFTER_DRAIN = false, ROWSCALE = true;
    __device__ __forceinline__ const float* rs_src() const { return ssqx; }
    bf16_t* O; const float* gq; const float* gk; const float* ssqx; PG8_LAS float* red;
    __device__ __forceinline__ void operator()(f32x4 (&acc)[2][2][4][2], const Unit& u, int wr, int wc, int fr, int fq, PG8_LAS const float* rsc) const {
        const int t = u.col0 >> 10, colt = u.col0 & 1023; bf16_t* base = O + (size_t)t * ((size_t)MTOK * 1024);
        const int row0 = u.row0 + wr * 64 + fr, col0 = colt + wc * 32 + 8 * fq;
#pragma unroll
        for (int ai = 0; ai < 2; ++ai)
#pragma unroll
            for (int m = 0; m < 4; ++m) { const float rx = rsc[ai * HALF + wr * 64 + m * 16 + fr];
#pragma unroll
                for (int bj = 0; bj < 2; ++bj) { acc[ai][bj][m][0] = acc[ai][bj][m][0] * rx; acc[ai][bj][m][1] = acc[ai][bj][m][1] * rx; } }
        if (u.col0 < 2048) {
            const float* g = (t == 0 ? gq : gk) + wc * 32 + 8 * fq; const f32x4 g0 = *(const f32x4*)g, g1 = *(const f32x4*)(g + 4);
#pragma unroll
            for (int ai = 0; ai < 2; ++ai)
#pragma unroll
                for (int m = 0; m < 4; ++m) { const int rl = ai * HALF + wr * 64 + m * 16 + fr;
#pragma unroll
                    for (int bj = 0; bj < 2; ++bj) { const f32x4 v0 = acc[ai][bj][m][0], v1 = acc[ai][bj][m][1];
                        float s = (v0[0] * v0[0] + v0[1] * v0[1]) + (v0[2] * v0[2] + v0[3] * v0[3]) + (v1[0] * v1[0] + v1[1] * v1[1]) + (v1[2] * v1[2] + v1[3] * v1[3]);
                        s += __shfl_xor(s, 16); s += __shfl_xor(s, 32);
                        if (fq == 0) red[(rl * 2 + bj) * 4 + wc] = s; } }
            asm volatile("s_waitcnt lgkmcnt(0)" ::: "memory"); __builtin_amdgcn_s_barrier(); asm volatile("" ::: "memory");
#pragma unroll
            for (int ai = 0; ai < 2; ++ai)
#pragma unroll
                for (int m = 0; m < 4; ++m) { const int rl = ai * HALF + wr * 64 + m * 16 + fr;
#pragma unroll
                    for (int bj = 0; bj < 2; ++bj) { const f32x4 r4 = *(const PG8_LAS f32x4*)(red + (rl * 2 + bj) * 4);
                        const float ri = __builtin_amdgcn_rsqf(((r4[0] + r4[1]) + (r4[2] + r4[3])) * (1.0f / FOXD) + EPS);
                        acc[ai][bj][m][0] = acc[ai][bj][m][0] * ri * g0; acc[ai][bj][m][1] = acc[ai][bj][m][1] * ri * g1; } }
        }
#pragma unroll
        for (int ai = 0; ai < 2; ++ai)
#pragma unroll
            for (int m = 0; m < 4; ++m) { bf16_t* rowp = base + (size_t)(row0 + ai * HALF + m * 16) * 1024 + col0;
#pragma unroll
                for (int bj = 0; bj < 2; ++bj) { const f32x4 v0 = acc[ai][bj][m][0], v1 = acc[ai][bj][m][1];
                    u32x4 w; w.x = cvt_pk_bf16(v0[0], v0[1]); w.y = cvt_pk_bf16(v0[2], v0[3]); w.z = cvt_pk_bf16(v1[0], v1[1]); w.w = cvt_pk_bf16(v1[2], v1[3]);
                    st16(rowp + bj * HALF, w); } }
    }
};
struct EpiStoreFp8 {
    static constexpr bool PERM = true, AFTER_DRAIN = false, ROWSCALE = false;
    unsigned char* O8; int ldc; float scale;
    __device__ __forceinline__ void operator()(const f32x4 (&acc)[2][2][4][2], const Unit& u, int wr, int wc, int fr, int fq, PG8_LAS const float* rsc) const {
        const int row0 = u.row0 + wr * 64 + fr, col0 = u.col0 + wc * 32 + 8 * fq;
#pragma unroll
        for (int ai = 0; ai < 2; ++ai)
#pragma unroll
            for (int m = 0; m < 4; ++m) { unsigned char* rowp = O8 + (size_t)(row0 + ai * HALF + m * 16) * ldc + col0;
#pragma unroll
                for (int bj = 0; bj < 2; ++bj) { const f32x4 v0 = acc[ai][bj][m][0] * scale, v1 = acc[ai][bj][m][1] * scale;
                    u32x2 w; w.x = pk4_fp8(v0[0], v0[1], v0[2], v0[3]); w.y = pk4_fp8(v1[0], v1[1], v1[2], v1[3]);
                    st8(rowp + bj * HALF, w); } }
    }
};
struct EpiSlab {
    static constexpr bool PERM = true, AFTER_DRAIN = false, ROWSCALE = false;
    bf16_t* slab; int ldc; size_t slab_stride;
    __device__ __forceinline__ void operator()(const f32x4 (&acc)[2][2][4][2], const Unit& u, int wr, int wc, int fr, int fq, PG8_LAS const float* rsc) const {
        bf16_t* base = slab + (size_t)u.aux * slab_stride; const int col0 = u.col0 + wc * 32 + 8 * fq;
#pragma unroll
        for (int ai = 0; ai < 2; ++ai)
#pragma unroll
            for (int m = 0; m < 4; ++m) { bf16_t* rowp = base + (size_t)(u.row0 + ai * HALF + wr * 64 + m * 16 + fr) * ldc + col0;
#pragma unroll
                for (int bj = 0; bj < 2; ++bj) { const f32x4 v0 = acc[ai][bj][m][0], v1 = acc[ai][bj][m][1];
                    u32x4 w; w.x = cvt_pk_bf16(v0[0], v0[1]); w.y = cvt_pk_bf16(v0[2], v0[3]); w.z = cvt_pk_bf16(v1[0], v1[1]); w.w = cvt_pk_bf16(v1[2], v1[3]);
                    st16(rowp + bj * HALF, w); } }
    }
};
template <bool BASEF, bool OUTF>
struct EpiResid {
    static constexpr bool PERM = true, AFTER_DRAIN = false, ROWSCALE = false;
    const void* base; void* out; float* ssq; int ldc; float ascale; unsigned char* out8;
    __device__ __forceinline__ void operator()(const f32x4 (&acc)[2][2][4][2], const Unit& u, int wr, int wc, int fr, int fq, PG8_LAS const float* rsc) const {
        const int col0 = u.col0 + wc * 32 + 8 * fq;
#ifdef EPIRES_SKIP_DUP
        if (u.aux != 0) return;
#endif
        float ssum[2][4];
        if constexpr (!BASEF) {
            u32x4 raw[2][2][2];
#define ER_LOADQ(q, b) do { _Pragma("unroll") for (int mi = 0; mi < 2; ++mi) { const size_t off_ = (size_t)(u.row0 + ((q) >> 1) * HALF + wr * 64 + (2 * ((q) & 1) + mi) * 16 + fr) * ldc + col0;   \
                _Pragma("unroll") for (int bj = 0; bj < 2; ++bj) raw[b][mi][bj] = *(const u32x4*)((const bf16_t*)base + off_ + bj * HALF); } } while (0)
            ER_LOADQ(0, 0); ER_LOADQ(1, 1);
#pragma unroll
            for (int q = 0; q < 4; ++q) { const int ai = q >> 1, b = q & 1;
#pragma unroll
                for (int mi = 0; mi < 2; ++mi) { const int m = 2 * (q & 1) + mi; const size_t off = (size_t)(u.row0 + ai * HALF + wr * 64 + m * 16 + fr) * ldc + col0; float s = 0.f;
#pragma unroll
                    for (int bj = 0; bj < 2; ++bj) { const u32x4 w = raw[b][mi][bj];
                        const f32x4 b0 = (f32x4){__builtin_bit_cast(float, w.x << 16), __builtin_bit_cast(float, w.x & 0xffff0000u), __builtin_bit_cast(float, w.y << 16), __builtin_bit_cast(float, w.y & 0xffff0000u)};
                        const f32x4 b1 = (f32x4){__builtin_bit_cast(float, w.z << 16), __builtin_bit_cast(float, w.z & 0xffff0000u), __builtin_bit_cast(float, w.w << 16), __builtin_bit_cast(float, w.w & 0xffff0000u)};
                        const f32x4 v0 = b0 + acc[ai][bj][m][0] * ascale, v1 = b1 + acc[ai][bj][m][1] * ascale;
                        if (out8) { u32x2 w8; w8.x = pk4_fp8(v0[0], v0[1], v0[2], v0[3]); w8.y = pk4_fp8(v1[0], v1[1], v1[2], v1[3]); st8(out8 + off + bj * HALF, w8); }
                        if constexpr (OUTF) { st16f((float*)out + off + bj * HALF, v0); st16f((float*)out + off + bj * HALF + 4, v1); }
                        else { u32x4 wo; wo.x = cvt_pk_bf16(v0[0], v0[1]); wo.y = cvt_pk_bf16(v0[2], v0[3]); wo.z = cvt_pk_bf16(v1[0], v1[1]); wo.w = cvt_pk_bf16(v1[2], v1[3]);
                            st16((bf16_t*)out + off + bj * HALF, wo); }
                        s += (v0[0] * v0[0] + v0[1] * v0[1]) + (v0[2] * v0[2] + v0[3] * v0[3]) + (v1[0] * v1[0] + v1[1] * v1[1]) + (v1[2] * v1[2] + v1[3] * v1[3]); }
                    s += __shfl_xor(s, 16); s += __shfl_xor(s, 32); ssum[ai][m] = s; }
                if (q + 2 < 4) { if (q == 0) ER_LOADQ(2, 0); else ER_LOADQ(3, 1); } }
#undef ER_LOADQ
        } else {
#pragma unroll
        for (int ai = 0; ai < 2; ++ai) {
            f32x4 bv[4][2][2];
#pragma unroll
            for (int m = 0; m < 4; ++m) { const size_t off = (size_t)(u.row0 + ai * HALF + wr * 64 + m * 16 + fr) * ldc + col0;
#pragma unroll
                for (int bj = 0; bj < 2; ++bj) {
                    if constexpr (BASEF) { bv[m][bj][0] = *(const f32x4*)((const float*)base + off + bj * HALF); bv[m][bj][1] = *(const f32x4*)((const float*)base + off + bj * HALF + 4); }
                    else { const u32x4 w = *(const u32x4*)((const bf16_t*)base + off + bj * HALF);
                        bv[m][bj][0] = (f32x4){__builtin_bit_cast(float, w.x << 16), __builtin_bit_cast(float, w.x & 0xffff0000u), __builtin_bit_cast(float, w.y << 16), __builtin_bit_cast(float, w.y & 0xffff0000u)};
                        bv[m][bj][1] = (f32x4){__builtin_bit_cast(float, w.z << 16), __builtin_bit_cast(float, w.z & 0xffff0000u), __builtin_bit_cast(float, w.w << 16), __builtin_bit_cast(float, w.w & 0xffff0000u)}; } } }
#pragma unroll
            for (int m = 0; m < 4; ++m) { const size_t off = (size_t)(u.row0 + ai * HALF + wr * 64 + m * 16 + fr) * ldc + col0; float s = 0.f;
#pragma unroll
                for (int bj = 0; bj < 2; ++bj) { const f32x4 v0 = bv[m][bj][0] + acc[ai][bj][m][0] * ascale, v1 = bv[m][bj][1] + acc[ai][bj][m][1] * ascale;
                    if (out8) { u32x2 w8; w8.x = pk4_fp8(v0[0], v0[1], v0[2], v0[3]); w8.y = pk4_fp8(v1[0], v1[1], v1[2], v1[3]); st8(out8 + off + bj * HALF, w8); }
                    if constexpr (OUTF) {
#if EPI_FULL_LINES
                        const bool hi = (fr & 8) != 0;
                        const f32x4 rcv = (f32x4){lane_xor8(hi ? v0[0] : v1[0]), lane_xor8(hi ? v0[1] : v1[1]), lane_xor8(hi ? v0[2] : v1[2]), lane_xor8(hi ? v0[3] : v1[3])};
                        const f32x4 sa = hi ? rcv : v0, sb = hi ? v1 : rcv;
                        float* pa = (float*)out + off + bj * HALF + (hi ? 4 - 8 * ldc : 0);
                        st16f(pa, sa); st16f(pa + 8 * ldc, sb);
#else
                        st16f((float*)out + off + bj * HALF, v0); st16f((float*)out + off + bj * HALF + 4, v1);
#endif
                    }
                    else { u32x4 w; w.x = cvt_pk_bf16(v0[0], v0[1]); w.y = cvt_pk_bf16(v0[2], v0[3]); w.z = cvt_pk_bf16(v1[0], v1[1]); w.w = cvt_pk_bf16(v1[2], v1[3]);
                        st16((bf16_t*)out + off + bj * HALF, w); }
                    s += (v0[0] * v0[0] + v0[1] * v0[1]) + (v0[2] * v0[2] + v0[3] * v0[3]) + (v1[0] * v1[0] + v1[1] * v1[1]) + (v1[2] * v1[2] + v1[3] * v1[3]); }
                s += __shfl_xor(s, 16); s += __shfl_xor(s, 32); ssum[ai][m] = s; } }
        }
        if (ssq && u.aux == 0) {
#pragma unroll
            for (int ai = 0; ai < 2; ++ai) { const float v = fq == 0 ? ssum[ai][0] : fq == 1 ? ssum[ai][1] : fq == 2 ? ssum[ai][2] : ssum[ai][3];
                atomicAdd(ssq + u.row0 + ai * HALF + wr * 64 + fq * 16 + fr, v); }
        }
    }
};
struct EpiQ {
    static constexpr bool PERM = true, AFTER_DRAIN = false, ROWSCALE = true;
    __device__ __forceinline__ const float* rs_src() const { return ssq_in; }
    unsigned char* O; const float* ssq_in; float* ssq_out; float oscale;
    __device__ __forceinline__ void operator()(const f32x4 (&acc)[2][2][4][2], const Unit& u, int wr, int wc, int fr, int fq, PG8_LAS const float* rsc) const {
        const int col0 = u.col0 + wc * 32 + 8 * fq; float* so = ssq_out + (size_t)(u.col0 / XD) * MTOK;
        float ssum[2][4];
#pragma unroll
        for (int ai = 0; ai < 2; ++ai)
#pragma unroll
            for (int m = 0; m < 4; ++m) { const int row = u.row0 + ai * HALF + wr * 64 + m * 16 + fr; const float ri = rsc[ai * HALF + wr * 64 + m * 16 + fr] * oscale;
                unsigned char* rowp = O + (size_t)row * DM + col0; float s = 0.f;
#pragma unroll
                for (int bj = 0; bj < 2; ++bj) { const f32x4 v0 = acc[ai][bj][m][0] * ri, v1 = acc[ai][bj][m][1] * ri;
                    u32x2 w; w.x = pk4_fp8(v0[0] * Q8_SCALE, v0[1] * Q8_SCALE, v0[2] * Q8_SCALE, v0[3] * Q8_SCALE); w.y = pk4_fp8(v1[0] * Q8_SCALE, v1[1] * Q8_SCALE, v1[2] * Q8_SCALE, v1[3] * Q8_SCALE);
                    st8(rowp + bj * HALF, w);
                    s += (v0[0] * v0[0] + v0[1] * v0[1]) + (v0[2] * v0[2] + v0[3] * v0[3]) + (v1[0] * v1[0] + v1[1] * v1[1]) + (v1[2] * v1[2] + v1[3] * v1[3]); }
                s += __shfl_xor(s, 16); s += __shfl_xor(s, 32); ssum[ai][m] = s; }
        if (u.aux == 0)
#pragma unroll
        for (int ai = 0; ai < 2; ++ai) { const float v = fq == 0 ? ssum[ai][0] : fq == 1 ? ssum[ai][1] : fq == 2 ? ssum[ai][2] : ssum[ai][3];
            atomicAdd(so + u.row0 + ai * HALF + wr * 64 + fq * 16 + fr, v); }
    }
};
struct EpiUp {
    static constexpr bool PERM = true, AFTER_DRAIN = false, ROWSCALE = true;
    __device__ __forceinline__ const float* rs_src() const { return ssq_in; }
    bf16_t* O; const float* ssq_in;
    __device__ __forceinline__ void operator()(const f32x4 (&acc)[2][2][4][2], const Unit& u, int wr, int wc, int fr, int fq, PG8_LAS const float* rsc) const {
        const int col0 = u.col0 + wc * 32 + 8 * fq;
#ifdef EPIUP_SKIP_DUP
        if (u.aux != 0) return;
#endif
#pragma unroll
        for (int ai = 0; ai < 2; ++ai)
#pragma unroll
            for (int m = 0; m < 4; ++m) { const int row = u.row0 + ai * HALF + wr * 64 + m * 16 + fr; const float ri = rsc[ai * HALF + wr * 64 + m * 16 + fr];
                bf16_t* rowp = O + (size_t)(u.row0 >> 8) * (256 * DFF) + (size_t)((u.col0 >> 6) + (wc >> 1)) * (256 * 64) + (row & 255) * 64 + (wc & 1) * 32 + 8 * fq;
#pragma unroll
                for (int bj = 0; bj < 2; ++bj) { f32x4 v0 = acc[ai][bj][m][0] * ri, v1 = acc[ai][bj][m][1] * ri;
#pragma unroll
                    for (int e = 0; e < 4; ++e) { const float a = fmaxf(v0[e], 0.f), b = fmaxf(v1[e], 0.f); v0[e] = a * a; v1[e] = b * b; }
                    u32x4 w; w.x = cvt_pk_bf16(v0[0], v0[1]); w.y = cvt_pk_bf16(v0[2], v0[3]); w.z = cvt_pk_bf16(v1[0], v1[1]); w.w = cvt_pk_bf16(v1[2], v1[3]);
                    st16(rowp + bj * (2 * 256 * 64), w); } }
    }
};
struct EpiSoftmax {
    static constexpr bool PERM = true, AFTER_DRAIN = true, ROWSCALE = false;
    unsigned char* P; const float* ssqq;
    __device__ __forceinline__ void fused(f32x4 (&acc)[2][2][4][2], const Unit& u, int wr, int wc, int fr, int fq, PG8_LAS unsigned char* lds, int wid, int lane) const {
        PG8_LAS float* RM = (PG8_LAS float*)lds;
        PG8_LAS float* RS = (PG8_LAS float*)(lds + 4096);
        const float* sq = ssqq + (size_t)u.aux * MTOK;
        float mx[2][4];
#pragma unroll
        for (int ai = 0; ai < 2; ++ai)
#pragma unroll
            for (int m = 0; m < 4; ++m) { const int rl = ai * HALF + wr * 64 + m * 16 + fr; const int row = u.row0 + rl;
                const float sc = __builtin_amdgcn_rsqf(sq[row] * (1.0f / XD) + EPS) * (0.044194173824159216f * LOG2E / (Q8_SCALE * KH8_SCALE));
                float mxx = -3.0e38f;
#pragma unroll
                for (int bj = 0; bj < 2; ++bj)
#pragma unroll
                    for (int n = 0; n < 2; ++n) { f32x4 v = acc[ai][bj][m][n] * sc; acc[ai][bj][m][n] = v; mxx = fmaxf(mxx, fmaxf(fmaxf(v[0], v[1]), fmaxf(v[2], v[3]))); }
                mxx = fmaxf(mxx, __shfl_xor(mxx, 16)); mxx = fmaxf(mxx, __shfl_xor(mxx, 32));
                if (fq == 0) RM[rl * 4 + wc] = mxx; }
        asm volatile("s_waitcnt lgkmcnt(0)" ::: "memory"); __builtin_amdgcn_s_barrier(); asm volatile("" ::: "memory");
#pragma unroll
        for (int ai = 0; ai < 2; ++ai)
#pragma unroll
            for (int m = 0; m < 4; ++m) { const int rl = ai * HALF + wr * 64 + m * 16 + fr;
                const f32x4 r4 = *(const PG8_LAS f32x4*)(RM + rl * 4); const float mxx = fmaxf(fmaxf(r4[0], r4[1]), fmaxf(r4[2], r4[3])); mx[ai][m] = mxx; float s = 0.f;
#pragma unroll
                for (int bj = 0; bj < 2; ++bj)
#pragma unroll
                    for (int n = 0; n < 2; ++n) { f32x4 v = acc[ai][bj][m][n];
#pragma unroll
                        for (int e = 0; e < 4; ++e) { v[e] = __builtin_amdgcn_exp2f(v[e] - mxx); s += v[e]; }
                        acc[ai][bj][m][n] = v; }
                s += __shfl_xor(s, 16); s += __shfl_xor(s, 32);
                if (fq == 0) RS[rl * 4 + wc] = s; }
        asm volatile("s_waitcnt lgkmcnt(0)" ::: "memory"); __builtin_amdgcn_s_barrier(); asm volatile("" ::: "memory");
        const int col0 = u.col0 + wc * 32 + 8 * fq;
#pragma unroll
        for (int ai = 0; ai < 2; ++ai)
#pragma unroll
            for (int m = 0; m < 4; ++m) { const int rl = ai * HALF + wr * 64 + m * 16 + fr;
                const f32x4 r4 = *(const PG8_LAS f32x4*)(RS + rl * 4); const float inv = P8_SCALE / ((r4[0] + r4[1]) + (r4[2] + r4[3]));
                unsigned char* rowp = P + (size_t)(u.row0 + rl) * 1024 + col0;
#pragma unroll
                for (int bj = 0; bj < 2; ++bj) { const f32x4 v0 = acc[ai][bj][m][0] * inv, v1 = acc[ai][bj][m][1] * inv;
                    u32x2 w; w.x = pk4_fp8(v0[0], v0[1], v0[2], v0[3]); w.y = pk4_fp8(v1[0], v1[1], v1[2], v1[3]);
                    st8(rowp + bj * HALF, w); } }
        (void)mx; (void)wid; (void)lane;
    }
};
}
namespace fox {
typedef short bf16x8 __attribute__((ext_vector_type(8)));
typedef short s16x4 __attribute__((ext_vector_type(4)));
typedef float f32x16 __attribute__((ext_vector_type(16)));
typedef float f32x4 __attribute__((ext_vector_type(4)));
typedef unsigned u32x4 __attribute__((ext_vector_type(4)));
constexpr int D = 128, PITCH = 1024, OPITCH = 2048;
constexpr int NW = 8, QBLK = 32, KVBLK = 64, QB = NW * QBLK;
constexpr int SHM_V = KVBLK * D * 2, SHM_K = KVBLK * D * 2;
constexpr int LDS_BIAS = 0, LDS_WS = 512, LDS_V = 4096, LDS_K = LDS_V + 2 * SHM_V, LDS_BYTES = LDS_K + 2 * SHM_K;
constexpr float SCALE = 0.08838834764831845f, C2 = LOG2E * SCALE, THR = 8.f;

#define KSWZ(row, colB) ((row) * 256 + ((colB) ^ (((row) & 7) << 4)))
#define SBAR() __builtin_amdgcn_sched_barrier(0)
__device__ __forceinline__ int v_st(int k, int c) { const int kk = (k & ~0xC) | ((k & 4) << 1) | ((k & 8) >> 1); return ((kk >> 3) * 4 + (c >> 5)) * 512 + ((kk & 7) * 32 + (c & 31)) * 2; }
__device__ __forceinline__ int v_rd_base(int lane) { return ((lane & 3) << 3) | (((lane >> 2) & 3) << 6) | (((lane >> 4) & 1) << 5) | (((lane >> 5) & 1) << 8); }
constexpr int v_rd_off(int d0, int ks, int half) { return d0 * 512 + ks * 4096 + half * 2048; }
__device__ __forceinline__ int crow(int r, int hi) { return (r & 3) + 8 * (r >> 2) + 4 * hi; }
__device__ __forceinline__ unsigned cvtpk(float lo, float hi) { unsigned r; asm volatile("v_cvt_pk_bf16_f32 %0, %1, %2" : "=v"(r) : "v"(lo), "v"(hi)); return r; }
template <int CTRL> __device__ __forceinline__ float dppf(float x) { return __builtin_bit_cast(float, __builtin_amdgcn_update_dpp(0, __builtin_bit_cast(int, x), CTRL, 0xf, 0xf, false)); }
__device__ __forceinline__ bf16x8 load8(const bf16* p) { return *reinterpret_cast<const bf16x8*>(p); }

__device__ __forceinline__ void mask_tile(f32x16& p0, f32x16& p1, int dq) {
    const float NEG = -__builtin_inff();
#pragma unroll
    for (int r = 0; r < 16; ++r) { const int c = (r & 3) + 8 * (r >> 2);
        if (dq - c < 0) p0[r] = NEG;
        if (dq - c - 32 < 0) p1[r] = NEG; }
}
__device__ __forceinline__ void partialSM(f32x16& p0, f32x16& p1, float& m_reg, float& mn, float& alpha) {
    float pmax = p0[0];
#pragma unroll
    for (int r = 1; r < 16; ++r) pmax = fmaxf(pmax, p0[r]);
#pragma unroll
    for (int r = 0; r < 16; ++r) pmax = fmaxf(pmax, p1[r]);
    { auto rr = __builtin_amdgcn_permlane32_swap(__float_as_uint(pmax), __float_as_uint(pmax), false, false);
      pmax = fmaxf(__uint_as_float(rr[0]), __uint_as_float(rr[1])); }
    if (__builtin_expect(__all((pmax - m_reg) * SCALE <= THR), 1)) { mn = m_reg; alpha = 1.f; }
    else { mn = fmaxf(m_reg, pmax); alpha = __builtin_amdgcn_exp2f((m_reg - mn) * C2); m_reg = mn; }
    const float mnL = -mn * C2;
#pragma unroll
    for (int r = 0; r < 16; ++r) p0[r] = fmaf(p0[r], C2, mnL);
#pragma unroll
    for (int r = 0; r < 16; ++r) p1[r] = fmaf(p1[r], C2, mnL);
#pragma unroll
    for (int r = 0; r < 16; ++r) p0[r] = __builtin_amdgcn_exp2f(p0[r]);
}
__device__ __forceinline__ void finishSM(f32x16& p0, f32x16& p1, float alpha, float& l_reg, bf16x8& pa0, bf16x8& pa1, bf16x8& pa2, bf16x8& pa3) {
#pragma unroll
    for (int r = 0; r < 16; ++r) p1[r] = __builtin_amdgcn_exp2f(p1[r]);
    float ps = 0;
#pragma unroll
    for (int r = 0; r < 16; ++r) ps += p0[r];
#pragma unroll
    for (int r = 0; r < 16; ++r) ps += p1[r];
    { auto rr = __builtin_amdgcn_permlane32_swap(__float_as_uint(ps), __float_as_uint(ps), false, false);
      ps = __uint_as_float(rr[0]) + __uint_as_float(rr[1]); }
    l_reg = l_reg * alpha + ps;
#define PK4(P, B_, OUT) do { unsigned a0 = cvtpk(P[B_+0], P[B_+1]), a1 = cvtpk(P[B_+2], P[B_+3]);                          \
        unsigned b0 = cvtpk(P[B_+4], P[B_+5]), b1 = cvtpk(P[B_+6], P[B_+7]);                                             \
        auto r0 = __builtin_amdgcn_permlane32_swap(a0, b0, false, false); auto r1 = __builtin_amdgcn_permlane32_swap(a1, b1, false, false); \
        u32x4 w = {r0[0], r1[0], r0[1], r1[1]}; OUT = *reinterpret_cast<bf16x8*>(&w); } while (0)
    PK4(p0, 0, pa0); PK4(p0, 8, pa1); PK4(p1, 0, pa2); PK4(p1, 8, pa3);
#undef PK4
}
template <int KB>
__device__ __forceinline__ void qkt(f32x16& p0, f32x16& p1, const char* K_lds, const float* bl, int r32, int hi, const bf16x8* qr) {
#pragma unroll
    for (int g = 0; g < 4; ++g) { const f32x4 b0 = *(const f32x4*)(bl + KB * 64 + 8 * g + 4 * hi), b1 = *(const f32x4*)(bl + KB * 64 + 32 + 8 * g + 4 * hi);
#pragma unroll
        for (int i = 0; i < 4; ++i) { p0[4 * g + i] = b0[i]; p1[4 * g + i] = b1[i]; } }
    const char* kb[4];
#pragma unroll
    for (int dd = 0; dd < 4; ++dd) kb[dd] = K_lds + KB * SHM_K + KSWZ(r32, (dd * 16 + hi * 8) * 2);
#pragma unroll
    for (int d0 = 0; d0 < 8; ++d0) { const char* a = kb[d0 & 3] + (d0 >> 2) * 128;
        bf16x8 b0 = *reinterpret_cast<const bf16x8*>(a);
        bf16x8 b1 = *reinterpret_cast<const bf16x8*>(a + 32 * 256);
        const bf16x8 qf = qr[d0];
        p0 = __builtin_amdgcn_mfma_f32_32x32x16_bf16(b0, qf, p0, 0, 0, 0);
        p1 = __builtin_amdgcn_mfma_f32_32x32x16_bf16(b1, qf, p1, 0, 0, 0); }
}
template <int VB>
__device__ __forceinline__ void pv_tile(f32x16* o, int vb0, bf16x8 pa0, bf16x8 pa1, bf16x8 pa2, bf16x8 pa3) {
#define TRRD(dst, off) asm volatile("ds_read_b64_tr_b16 %0, %1 offset:%2" : "=&v"(dst) : "v"(vb0), "i"(off) : "memory")
#define PV_D0(d0) do { s16x4 l0, l1, l2, l3, h0, h1, h2, h3; constexpr int b_ = VB * SHM_V + v_rd_off(d0, 0, 0); \
        TRRD(l0, b_); TRRD(h0, b_ + 2048); TRRD(l1, b_ + 4096); TRRD(h1, b_ + 6144); TRRD(l2, b_ + 8192); TRRD(h2, b_ + 10240); TRRD(l3, b_ + 12288); TRRD(h3, b_ + 14336); \
        asm volatile("s_waitcnt lgkmcnt(0)" ::: "memory"); SBAR();   \
        o[d0] = __builtin_amdgcn_mfma_f32_32x32x16_bf16(pa0, (bf16x8){l0[0], l0[1], l0[2], l0[3], h0[0], h0[1], h0[2], h0[3]}, o[d0], 0, 0, 0);   \
        o[d0] = __builtin_amdgcn_mfma_f32_32x32x16_bf16(pa1, (bf16x8){l1[0], l1[1], l1[2], l1[3], h1[0], h1[1], h1[2], h1[3]}, o[d0], 0, 0, 0);   \
        o[d0] = __builtin_amdgcn_mfma_f32_32x32x16_bf16(pa2, (bf16x8){l2[0], l2[1], l2[2], l2[3], h2[0], h2[1], h2[2], h2[3]}, o[d0], 0, 0, 0);   \
        o[d0] = __builtin_amdgcn_mfma_f32_32x32x16_bf16(pa3, (bf16x8){l3[0], l3[1], l3[2], l3[3], h3[0], h3[1], h3[2], h3[3]}, o[d0], 0, 0, 0); } while (0)
    PV_D0(0); PV_D0(1); PV_D0(2); PV_D0(3);
#undef PV_D0
#undef TRRD
}

struct Item { unsigned rowb, o; const float* CS; const float* G; int P0, jlo; };
struct Seam { bf16x8 qr[8]; bf16x8 st_v0, st_v1, st_k0, st_k1; };
typedef __amdgpu_buffer_rsrc_t Srd;
#define BL8(rs, vo, so) __builtin_bit_cast(bf16x8, __builtin_amdgcn_raw_buffer_load_b128((rs), (vo), (so), 0))
#define VMW() asm volatile("s_waitcnt vmcnt(0)" ::: "memory")
#define VMWN(n) asm volatile("s_waitcnt vmcnt(%0)" :: "i"(n) : "memory")
#define SLOAD_H(H, k0, bb) do { const unsigned so_ = (unsigned)(k0) * (PITCH * 2);                                               \
                         S.st_v0 = BL8(R, kvoff, (unsigned)WS_FV + (H).rowb + so_); S.st_v1 = BL8(R, kvoff, (unsigned)WS_FV + (H).rowb + so_ + 32 * PITCH * 2);   \
                         S.st_k0 = BL8(R, kvoff, (unsigned)WS_FK + (H).rowb + so_); S.st_k1 = BL8(R, kvoff, (unsigned)WS_FK + (H).rowb + so_ + 32 * PITCH * 2);   \
                         if (wid == 0) __builtin_amdgcn_global_load_lds((const unsigned*)((H).CS + (k0)) + lane, (__attribute__((address_space(3))) unsigned*)(B3 + (bb) * 64), 4, 0, 0); } while (0)
#define QLOAD(H) do { const unsigned so_ = (unsigned)((H).P0 + wid * QBLK) * (PITCH * 2);                                   \
        _Pragma("unroll") for (int d0 = 0; d0 < 8; ++d0) S.qr[d0] = BL8(R, qoff + d0 * 32, (unsigned)WS_FQ + (H).rowb + so_); } while (0)
#define SWRITE_HK(bf) do { *(bf16x8*)(K_lds + (bf) * SHM_K + kws) = S.st_k0; *(bf16x8*)(K_lds + (bf) * SHM_K + kws + 32 * 256) = S.st_k1; } while (0)
#define SWRITE_HV(bf) do { *(bf16x8*)(V_lds + (bf) * SHM_V + vst0) = S.st_v0; *(bf16x8*)(V_lds + (bf) * SHM_V + vst1) = S.st_v1; } while (0)
#define SWRITE_H(bf) do { SWRITE_HV(bf); SWRITE_HK(bf); } while (0)

__device__ __forceinline__ void fox_prime(const Srd R, const Item& H, char* lds, Seam& S, int wv) {
    const int tid = wg_tid(wv), wid = wv, lane = tid & 63, r32 = lane & 31, hi = lane >> 5;
    const int sr = tid >> 4, sc = (tid & 15) * 8, kws = KSWZ(sr, sc * 2); char* K_lds = lds + LDS_K; float* B_lds = (float*)(lds + LDS_BIAS);
    const unsigned kvoff = (unsigned)(sr * PITCH + sc) * 2u, qoff = (unsigned)(r32 * PITCH + hi * 8) * 2u;
    __attribute__((address_space(3))) float* B3 = (__attribute__((address_space(3))) float*)B_lds;
    QLOAD(H);
    SLOAD_H(H, H.jlo * KVBLK, 0); VMW(); SWRITE_HK(0);
    __syncthreads();
}
template <class NextFn>
__device__ __forceinline__ int fox_block(const Srd R, const Item& H, const NextFn& next_item, char* lds, Seam& S, int wv) {
    const int P0 = H.P0;
    const int tid = wg_tid(wv), wid = wv, lane = tid & 63, r32 = lane & 31, hi = lane >> 5;
    const int NT = P0 / KVBLK + 4 - H.jlo;
    const int qlo = P0 + wid * QBLK, qm = qlo + r32 - 4 * hi;
    char* V_lds = lds + LDS_V; char* K_lds = lds + LDS_K; float* B_lds = (float*)(lds + LDS_BIAS);
    float* ws = (float*)(lds + LDS_WS) + wid * 64; float* li_l = ws, * al_l = ws + 32;
    float m_reg = -1e30f, l_reg = 0; f32x16 o[4] = {};
    const int sr = tid >> 4, sc = (tid & 15) * 8, vst0 = v_st(sr, sc), vst1 = v_st(32 + sr, sc), kws = KSWZ(sr, sc * 2);
    const int vb0 = (int)(uintptr_t)V_lds + v_rd_base(lane);
    const unsigned kvoff = (unsigned)(sr * PITCH + sc) * 2u, qoff = (unsigned)(r32 * PITCH + hi * 8) * 2u;
    __attribute__((address_space(3))) float* B3 = (__attribute__((address_space(3))) float*)B_lds;
#define RESC(a) do { if (__any((a) < 1.f)) { if (hi == 0) al_l[r32] = (a); asm volatile("s_waitcnt lgkmcnt(0)" ::: "memory");              \
                     for (int d_ = 0; d_ < 4; ++d_) for (int r = 0; r < 16; ++r) o[d_][r] *= al_l[crow(r, hi)]; } } while (0)
#define KBASE(t) ((H.jlo + (t)) * KVBLK)
#define MASKT(P0_, P1_, t) do { const int kb_ = KBASE(t); if (kb_ + KVBLK - 1 > qlo) mask_tile(P0_, P1_, qm - kb_); } while (0)
    f32x16 pA0, pA1, pB0, pB1; float mnA, mnB, alA, alB; bf16x8 pa0, pa1, pa2, pa3;
    SWRITE_HV(0); SBAR();
    SLOAD_H(H, KBASE(1), 1);
    SBAR(); qkt<0>(pA0, pA1, K_lds, B_lds, r32, hi, S.qr);
    MASKT(pA0, pA1, 0); partialSM(pA0, pA1, m_reg, mnA, alA);
    VMW(); SWRITE_H(1);
    __syncthreads();
#define HALF_STEP(PX0, PX1, mnX, alX, PY0, PY1, alY, t, KB, VB, SB) do {                                                      \
        SBAR(); qkt<KB>(PX0, PX1, K_lds, B_lds, r32, hi, S.qr);                                                                 \
        finishSM(PY0, PY1, alY, l_reg, pa0, pa1, pa2, pa3); SBAR();                                                           \
        if ((t) + 1 < NT) { SLOAD_H(H, KBASE((t) + 1), SB); SBAR(); }                                                                \
        pv_tile<VB>(o, vb0, pa0, pa1, pa2, pa3); MASKT(PX0, PX1, (t)); partialSM(PX0, PX1, m_reg, mnX, alX);                  \
        __syncthreads();                                                                                                      \
        if ((t) + 1 < NT) { VMW(); SWRITE_H(SB); }                                                                      \
        RESC(alX); __syncthreads(); } while (0)
    for (int t = 1; t + 1 < NT; t += 2) {
        HALF_STEP(pB0, pB1, mnB, alB, pA0, pA1, alA, t, 1, 0, 0);
        HALF_STEP(pA0, pA1, mnA, alA, pB0, pB1, alB, t + 1, 0, 1, 1);
    }
    SBAR(); qkt<1>(pB0, pB1, K_lds, B_lds, r32, hi, S.qr); SBAR();
    int nidx; const Item N = next_item(H, nidx);
    SLOAD_H(N, N.jlo * KVBLK, 0); SBAR();
    QLOAD(N);
    SBAR();
    finishSM(pA0, pA1, alA, l_reg, pa0, pa1, pa2, pa3); SBAR();
    pv_tile<0>(o, vb0, pa0, pa1, pa2, pa3);
    MASKT(pB0, pB1, NT - 1); partialSM(pB0, pB1, m_reg, mnB, alB); __syncthreads(); RESC(alB);
    finishSM(pB0, pB1, alB, l_reg, pa0, pa1, pa2, pa3); SBAR(); pv_tile<1>(o, vb0, pa0, pa1, pa2, pa3);
    SBAR(); VMWN(8); SWRITE_HK(0); SBAR();
    if (hi == 0) li_l[r32] = l_reg; asm volatile("s_waitcnt lgkmcnt(0)" ::: "memory");
    float gn[4];
#pragma unroll
    for (int d0 = 0; d0 < 4; ++d0) gn[d0] = H.G[d0 * 32 + r32];
    const unsigned ovoff2 = (unsigned)(4 * hi * OPITCH + (r32 & ~1)) * 2u + ((r32 & 1) ? 64u : 0u);
#pragma unroll
    for (int r = 0; r < 16; ++r) { const float rli = __builtin_amdgcn_rcpf(li_l[crow(r, hi)]); float ss = 0.f;
#pragma unroll
        for (int d0 = 0; d0 < 4; ++d0) { o[d0][r] *= rli; ss += o[d0][r] * o[d0][r]; }
        ss += dppf<0xB1>(ss); ss += dppf<0x4E>(ss); ss += dppf<0x141>(ss); ss += dppf<0x140>(ss);
        ss += __builtin_bit_cast(float, __builtin_amdgcn_ds_swizzle(__builtin_bit_cast(int, ss), 0x401F));
        const float rs = __builtin_amdgcn_rsqf(ss * (1.0f / D) + EPS);
        const unsigned so_ = (unsigned)(P0 + wid * QBLK + (r & 3) + 8 * (r >> 2)) * (OPITCH * 2);
        const bool odd = (r32 & 1) != 0;
#pragma unroll
        for (int dp = 0; dp < 2; ++dp) { const float va = o[2 * dp][r] * rs * gn[2 * dp], vb = o[2 * dp + 1][r] * rs * gn[2 * dp + 1];
            const float rcv = dppf<0xB1>(odd ? va : vb);
            const unsigned w = odd ? cvtpk(rcv, vb) : cvtpk(va, rcv);
            __builtin_amdgcn_raw_buffer_store_b32(w, R, ovoff2 + dp * 128, H.o + so_, 0); } }
    __syncthreads();
    return nidx;
#undef RESC
#undef KBASE
#undef MASKT
#undef HALF_STEP
}
#undef BL8
#undef QLOAD
#undef VMW
#undef VMWN
#undef SLOAD_H
#undef SWRITE_HK
#undef SWRITE_HV
#undef SWRITE_H
#undef KSWZ
#undef SBAR
}
namespace mls {
typedef short bf16x8 __attribute__((ext_vector_type(8)));
typedef short bf16x4 __attribute__((ext_vector_type(4)));
typedef float f32x4 __attribute__((ext_vector_type(4)));
#define MFMA16(a, b, c) __builtin_amdgcn_mfma_f32_16x16x32_bf16((a), (b), (c), 0, 0, 0)

constexpr int CO_CST = 0, CO_VT = 65536, CO_XCH = 98304, CO_LDS_BYTES = CO_XCH + 512;
__device__ __forceinline__ void chunk_dma(int b, int h, int c, const bf16* VT, const bf16* CST, __attribute__((address_space(3))) unsigned char* lds, int wv) {
    const int w = wv, lane = wg_tid(wv) & 63;
    const size_t item = ((size_t)(b * MLH + h) * NCHUNK + c);
    const bf16* cs = CST + item * MLDV * MLDK; const bf16* vs = VT + item * MLDV * 64;
#pragma unroll
    for (int j = 0; j < 8; ++j) { const int p = w + 8 * j, row = 4 * p + (lane >> 4), lc = (lane & 15) ^ (row & 15);
        __builtin_amdgcn_global_load_lds((const unsigned*)(cs + row * MLDK + lc * 8), (__attribute__((address_space(3))) unsigned*)(lds + CO_CST + p * 1024), 16, 0, 0); }
#pragma unroll
    for (int j = 0; j < 4; ++j) { const int p = w + 8 * j, row = 8 * p + (lane >> 3), lc = (lane & 7) ^ ((row >> 1) & 7);
        __builtin_amdgcn_global_load_lds((const unsigned*)(vs + row * 64 + lc * 8), (__attribute__((address_space(3))) unsigned*)(lds + CO_VT + p * 1024), 16, 0, 0); }
}
template <class NextDma>
__device__ __forceinline__ void chunk_out(int b, int h, int c, const bf16* QP, const bf16* KPP, const bf16* VT, const bf16* CST, const float* NST,
                                          const bf16* MO, const float* gain, bf16* concat, __attribute__((address_space(3))) unsigned char* lds, int wv, bool pre, const NextDma& next_dma) {
    typedef __attribute__((address_space(3))) unsigned char* lptr;
    const int tid = wg_tid(wv), w = wv, lane = tid & 63, i16 = lane & 15, q = lane >> 4;
    const int tq = w & 3, dvh = w >> 2;
    const size_t R0 = (size_t)b * SEQ + (size_t)c * 64;
    const size_t item = ((size_t)(b * MLH + h) * NCHUNK + c);
    if (!pre) chunk_dma(b, h, c, VT, CST, lds, wv);
    const size_t row = R0 + 16 * tq + i16;
    const bf16* qrow = QP + row * 512 + h * MLDK + 8 * q;
    bf16x8 qf[4];
#pragma unroll
    for (int ks = 0; ks < 4; ++ks) qf[ks] = *(const bf16x8*)(qrow + 32 * ks);
    f32x4 st[4];
#pragma unroll
    for (int stile = 0; stile < 4; ++stile) {
        st[stile] = (f32x4){0.f, 0.f, 0.f, 0.f};
        if (stile <= tq) {
            const bf16* krow = KPP + (R0 + 16 * stile + i16) * 512 + h * MLDK + 8 * q;
            bf16x8 kf[4];
#pragma unroll
            for (int ks = 0; ks < 4; ++ks) kf[ks] = *(const bf16x8*)(krow + 32 * ks);
#pragma unroll
            for (int ks = 0; ks < 4; ++ks) st[stile] = MFMA16(kf[ks], qf[ks], st[stile]);
            if (stile == tq) {
#pragma unroll
                for (int r = 0; r < 4; ++r) if (4 * q + r > i16) st[stile][r] = 0.f;
            }
        }
    }
    float den = 0.f;
#pragma unroll
    for (int stile = 0; stile < 4; ++stile) den += (st[stile][0] + st[stile][1]) + (st[stile][2] + st[stile][3]);
    { const float* nrow = NST + item * MLDK + 8 * q;
#pragma unroll
      for (int ks = 0; ks < 4; ++ks) { const f32x4 n0 = *(const f32x4*)(nrow + 32 * ks), n1 = *(const f32x4*)(nrow + 32 * ks + 4);
          const v4u qq = __builtin_bit_cast(v4u, qf[ks]);
          den += bflo(qq[0]) * n0[0] + bfhi(qq[0]) * n0[1] + bflo(qq[1]) * n0[2] + bfhi(qq[1]) * n0[3]
               + bflo(qq[2]) * n1[0] + bfhi(qq[2]) * n1[1] + bflo(qq[3]) * n1[2] + bfhi(qq[3]) * n1[3]; } }
    den += __shfl_xor(den, 16); den += __shfl_xor(den, 32);
    const int dv0 = h * MLDV + dvh * 128 + 4 * q;
    v2u mo2[8];
#pragma unroll
    for (int dt = 0; dt < 8; ++dt) mo2[dt] = *(const v2u*)(MO + row * 1024 + dv0 + 16 * dt);
    f32x4 gn4[8];
#pragma unroll
    for (int dt = 0; dt < 8; ++dt) gn4[dt] = *(const f32x4*)(gain + dv0 + 16 * dt);
    bf16x8 pf[2];
#pragma unroll
    for (int p = 0; p < 2; ++p) { v4u wv; wv[0] = pg8::cvt_pk_bf16(st[2 * p][0], st[2 * p][1]); wv[1] = pg8::cvt_pk_bf16(st[2 * p][2], st[2 * p][3]);
        wv[2] = pg8::cvt_pk_bf16(st[2 * p + 1][0], st[2 * p + 1][1]); wv[3] = pg8::cvt_pk_bf16(st[2 * p + 1][2], st[2 * p + 1][3]); pf[p] = __builtin_bit_cast(bf16x8, wv); }
    const int npair = (tq >> 1) + 1;
    asm volatile("s_waitcnt vmcnt(0)" ::: "memory");
    __syncthreads();
    f32x4 num[8];
    const lptr cb = lds + CO_CST + (dvh * 128 + i16) * 256, vb = lds + CO_VT + (dvh * 128 + i16) * 128 + (q & 1) * 8;
    const int vsw = i16 >> 1;
#pragma unroll
    for (int dt = 0; dt < 8; ++dt) {
        f32x4 a = (f32x4){0.f, 0.f, 0.f, 0.f};
#pragma unroll
        for (int p = 0; p < 2; ++p) if (p < npair) {
            const v2u lo = *(const __attribute__((address_space(3))) v2u*)(vb + dt * 16 * 128 + (((4 * p + (q >> 1)) ^ vsw) * 16));
            const v2u hi2 = *(const __attribute__((address_space(3))) v2u*)(vb + dt * 16 * 128 + (((4 * p + 2 + (q >> 1)) ^ vsw) * 16));
            const v4u vv = {lo[0], lo[1], hi2[0], hi2[1]};
            a = MFMA16(__builtin_bit_cast(bf16x8, vv), pf[p], a); }
#pragma unroll
        for (int ks = 0; ks < 4; ++ks) { const bf16x8 cf = *(const __attribute__((address_space(3))) bf16x8*)(cb + dt * 16 * 256 + (((4 * ks + q) ^ i16) * 16)); a = MFMA16(cf, qf[ks], a); }
        num[dt] = a;
    }
    const float rden = 1.0f / fmaxf(fabsf(den), 1.0f);
    float ss = 0.f;
#pragma unroll
    for (int dt = 0; dt < 8; ++dt) { num[dt] = num[dt] * rden; ss += (num[dt][0] * num[dt][0] + num[dt][1] * num[dt][1]) + (num[dt][2] * num[dt][2] + num[dt][3] * num[dt][3]); }
    ss += __shfl_xor(ss, 16); ss += __shfl_xor(ss, 32);
    __attribute__((address_space(3))) float* xch = (__attribute__((address_space(3))) float*)(lds + CO_XCH);
    if (q == 0) xch[w * 16 + i16] = ss;
    __syncthreads();
    next_dma();
    const float tot = ss + xch[(w ^ 4) * 16 + i16];
    const float rn = __builtin_amdgcn_rsqf(tot * (1.0f / MLDV) + EPS);
#pragma unroll
    for (int dt = 0; dt < 8; ++dt) { const int dv = dv0 + 16 * dt;
        const f32x4 g4 = gn4[dt];
        const float o0 = num[dt][0] * rn * g4[0] * sigmoidf_(bflo(mo2[dt][0])), o1 = num[dt][1] * rn * g4[1] * sigmoidf_(bfhi(mo2[dt][0]));
        const float o2 = num[dt][2] * rn * g4[2] * sigmoidf_(bflo(mo2[dt][1])), o3 = num[dt][3] * rn * g4[3] * sigmoidf_(bfhi(mo2[dt][1]));
        v2u ov; ov[0] = pg8::cvt_pk_bf16(o0, o1); ov[1] = pg8::cvt_pk_bf16(o2, o3);
        *(v2u*)(concat + row * 2048 + 1024 + dv) = ov; }
    asm volatile("s_waitcnt lgkmcnt(0)" ::: "memory"); __builtin_amdgcn_s_barrier(); asm volatile("" ::: "memory");
}

constexpr int SS_NS = 6, SS_SLOT = 12288, SS_STG = SS_NS * SS_SLOT, SS_STG_PITCH = 144, SS_STG_BYTES = 32 * SS_STG_PITCH;
__device__ __forceinline__ void state_scan(int bh, int sl, const bf16* KT, const bf16* VT, const float* EB, bf16* CST, __attribute__((address_space(3))) unsigned char* lds, int wv, bool do_store = true) {
    typedef __attribute__((address_space(3))) unsigned char* lptr;
    const int tid = wg_tid(wv), w = wv, lane = tid & 63, i16 = lane & 15, q = lane >> 4;
    const int dvs = sl >> 1, dkh = sl & 1;
    const size_t it0 = (size_t)bh * NCHUNK;
    const bf16* kt0 = KT + (it0 * MLDK + 64 * dkh) * 64; const bf16* vt0 = VT + (it0 * MLDV + 32 * dvs) * 64;
    const float ebv = EB[it0 + lane];
    const int prow = lane >> 3, pcol = lane & 7;
    const int p0 = w, p1 = w + 6;
    const int r0 = 8 * p0 + prow, r1 = 8 * (p1 & 7) + prow;
    const unsigned src0 = (unsigned)(r0 * 64 + ((pcol ^ ((r0 >> 1) & 7)) * 8));
    const unsigned src1 = (unsigned)(r1 * 64 + ((pcol ^ ((r1 >> 1) & 7)) * 8));
    const bool p1v = p1 >= 8;
    const bf16* s1base = p1v ? vt0 : kt0; const size_t s1stride = p1v ? (size_t)MLDV * 64 : (size_t)MLDK * 64; const unsigned d1 = p1v ? 8192u + (unsigned)(p1 - 8) * 1024u : (unsigned)p1 * 1024u;
#define SS_DMA(cc, slot) do { const lptr sb_ = lds + (slot) * SS_SLOT;                                                                                        \
        __builtin_amdgcn_global_load_lds((const unsigned*)(kt0 + (size_t)(cc) * MLDK * 64 + src0), (__attribute__((address_space(3))) unsigned*)(sb_ + p0 * 1024), 16, 0, 0);   \
        __builtin_amdgcn_global_load_lds((const unsigned*)(s1base + (size_t)(cc) * s1stride + src1), (__attribute__((address_space(3))) unsigned*)(sb_ + d1), 16, 0, 0); } while (0)
    if (w < 6) {
#pragma unroll
        for (int j = 0; j < SS_NS - 1; ++j) SS_DMA(j, j); }
    f32x4 acc = (f32x4){0.f, 0.f, 0.f, 0.f};
    const int swz = (i16 >> 1) & 7;
    const unsigned aoff = (unsigned)((16 * (w & 3) + i16) * 128), boff = (unsigned)(8192 + (16 * (w >> 2) + i16) * 128);
    const unsigned stw = (unsigned)(SS_STG + (16 * (w >> 2) + i16) * SS_STG_PITCH + (16 * (w & 3) + 4 * q) * 2);
    const int wrow = 16 * (w & 1) + (lane >> 3);
    const unsigned strd = (unsigned)(SS_STG + wrow * SS_STG_PITCH + (lane & 7) * 16);
    bf16* cs = CST + (it0 * MLDV + 32 * dvs + wrow) * MLDK + 64 * dkh + 8 * (lane & 7);
    int slot = 0;
    for (int c = 0; c < NCHUNK; ++c) {
        if (w < 6) asm volatile("s_waitcnt vmcnt(8)" ::: "memory");
        asm volatile("s_waitcnt lgkmcnt(0)" ::: "memory");
        __builtin_amdgcn_s_barrier();
        asm volatile("" ::: "memory");
        if (w < 6) { const int cn = c + SS_NS - 1 < NCHUNK ? c + SS_NS - 1 : NCHUNK - 1; const int sn = slot == 0 ? SS_NS - 1 : slot - 1; SS_DMA(cn, sn); }
        else if (c > 0 && do_store) { const lptr sg = lds + ((c - 1) & 1) * SS_STG_BYTES + strd;
            const v4u s0 = *(const __attribute__((address_space(3))) v4u*)sg, s1 = *(const __attribute__((address_space(3))) v4u*)(sg + 8 * SS_STG_PITCH);
            bf16* cd = cs + (size_t)(c - 1) * MLDV * MLDK; *(v4u*)cd = s0; *(v4u*)(cd + 8 * MLDK) = s1; }
        const lptr sb = lds + slot * SS_SLOT;
        const bf16x8 a0 = *(const __attribute__((address_space(3))) bf16x8*)(sb + aoff + ((q ^ swz) * 16)), a1 = *(const __attribute__((address_space(3))) bf16x8*)(sb + aoff + (((4 + q) ^ swz) * 16));
        const bf16x8 b0 = *(const __attribute__((address_space(3))) bf16x8*)(sb + boff + ((q ^ swz) * 16)), b1 = *(const __attribute__((address_space(3))) bf16x8*)(sb + boff + (((4 + q) ^ swz) * 16));
        v2u ov; ov[0] = pg8::cvt_pk_bf16(acc[0], acc[1]); ov[1] = pg8::cvt_pk_bf16(acc[2], acc[3]);
        if (do_store) *(__attribute__((address_space(3))) v2u*)(lds + (c & 1) * SS_STG_BYTES + stw) = ov; else asm volatile("" :: "v"(ov));
        acc = MFMA16(a0, b0, acc); acc = MFMA16(a1, b1, acc);
        const float e = __builtin_bit_cast(float, __builtin_amdgcn_readlane(__builtin_bit_cast(int, ebv), c));
        acc = acc * e;
        slot = slot == SS_NS - 1 ? 0 : slot + 1;
    }
    asm volatile("s_waitcnt lgkmcnt(0)" ::: "memory");
    __builtin_amdgcn_s_barrier();
    asm volatile("" ::: "memory");
    if (w >= 6 && do_store) { const lptr sg = lds + ((NCHUNK - 1) & 1) * SS_STG_BYTES + strd;
        const v4u s0 = *(const __attribute__((address_space(3))) v4u*)sg, s1 = *(const __attribute__((address_space(3))) v4u*)(sg + 8 * SS_STG_PITCH);
        bf16* cd = cs + (size_t)(NCHUNK - 1) * MLDV * MLDK; *(v4u*)cd = s0; *(v4u*)(cd + 8 * MLDK) = s1; }
    asm volatile("s_waitcnt vmcnt(0) lgkmcnt(0)" ::: "memory");
    __builtin_amdgcn_s_barrier();
#undef SS_DMA
}
#undef MFMA16
}
typedef const float* cfp_t;
struct Frame {
    LAS unsigned char* lds; unsigned char* ldsg;
    int tid, lane, wave, vcu, G;
    const __attribute__((address_space(4))) cfp_t* inp; float* out; unsigned char* ws;
};
__device__ __forceinline__ void refresh_ids(Frame& F) { F.tid = wg_tid(F.wave); F.lane = F.tid & 63; }
__device__ __forceinline__ float wave_incl_scan(float v, int lane) {
#pragma unroll
    for (int o = 1; o < 64; o <<= 1) { const float t = __shfl_up(v, o); if (lane >= o) v += t; }
    return v;
}

#ifndef P0_T_TWICE
#define P0_T_TWICE 1
#endif
struct TItem { const float* W; const float* gk; unsigned char* dst; float scale; int ldw, K, k0, n0d, n0s, mode; };
__device__ __forceinline__ TItem p0_titem(Frame& F, int r) {
    TItem I; I.gk = nullptr; I.scale = 1.0f; I.mode = 0; I.K = DM; int kt, nb;
    if (r < 768) { kt = r / 24; nb = r % 24; const int grpc = nb >> 2; I.W = F.inp[3]; I.ldw = IN_WIDTH; I.gk = F.inp[2]; I.dst = F.ws + WS_WIN; I.n0s = 256 * nb + (grpc < 3 ? 0 : (grpc < 5 ? 8 : 16)); }
    else if ((r -= 768) < 512) { kt = r >> 4; nb = r & 15; I.W = F.inp[17]; I.ldw = 2 * DM; I.dst = F.ws + WS_WXKV; I.n0s = 256 * nb; I.mode = 1; }
    else if ((r -= 512) < 256) { kt = r >> 3; nb = r & 7; I.W = F.inp[13]; I.ldw = DM; I.dst = F.ws + WS_WOUT; I.n0s = 256 * nb; }
    else if ((r -= 256) < 256) { kt = r >> 3; nb = r & 7; I.W = F.inp[16]; I.ldw = DM; I.gk = F.inp[14]; I.scale = W8_SCALE; I.dst = F.ws + WS_WXQ; I.n0s = 256 * nb; I.mode = 2; }
    else if ((r -= 256) < 256) { kt = r >> 3; nb = r & 7; I.W = F.inp[20]; I.ldw = DM; I.scale = W8_SCALE; I.dst = F.ws + WS_WXO; I.n0s = 256 * nb; I.mode = 2; }
    else if ((r -= 256) < 1024) { kt = r >> 5; nb = r & 31; I.W = F.inp[22]; I.ldw = DFF; I.gk = F.inp[21]; I.dst = F.ws + WS_WUP; I.n0s = 256 * nb; }
    else { r -= 1024; kt = r >> 3; nb = r & 7; I.W = F.inp[23]; I.ldw = DM; I.K = DFF; I.dst = F.ws + WS_WDN; I.n0s = 256 * nb; }
    I.k0 = 64 * kt; I.n0d = 256 * nb; return I;
}
__device__ __forceinline__ void p0_tload(const TItem& I, v4f (&v)[8], int wave, int lane) {
#pragma unroll
    for (int j = 0; j < 8; ++j) v[j] = *(const v4f*)(I.W + (size_t)(I.k0 + wave + 8 * j) * I.ldw + I.n0s + 4 * lane);
}
__device__ __forceinline__ void p0_tstage(const TItem& I, const v4f (&v)[8], LAS float* tile, int wave, int lane) {
#pragma unroll
    for (int j = 0; j < 8; ++j) { const int row = wave + 8 * j; const float g = (I.gk ? I.gk[I.k0 + row] : 1.0f) * I.scale;
        *(LAS v4f*)(tile + row * 256 + ((4 * lane) ^ (8 * ((row >> 3) & 7)))) = v[j] * g; }
}
__device__ __forceinline__ void p0_tstore(const TItem& I, const LAS float* tile, int wave, int lane) {
    const int nl = lane >> 3, kg = lane & 7;
#pragma unroll
    for (int i = 0; i < 4; ++i) { const int n = 8 * (wave + 8 * i) + nl; const LAS float* s = tile + (8 * kg) * 256 + (n ^ (8 * kg));
        const float e0 = s[0], e1 = s[256], e2 = s[512], e3 = s[768], e4 = s[1024], e5 = s[1280], e6 = s[1536], e7 = s[1792];
        if (I.mode == 2) { v2u o; o.x = pg8::pk4_fp8(e0, e1, e2, e3); o.y = pg8::pk4_fp8(e4, e5, e6, e7);
            *(GAS v2u*)(I.dst + (size_t)I.n0d * I.K + (size_t)(I.k0 >> 7) * 32768 + n * 128 + (I.k0 & 127) + 8 * kg) = o; }
        else { v4u o; o.x = pk2(e0, e1); o.y = pk2(e2, e3); o.z = pk2(e4, e5); o.w = pk2(e6, e7);
            if (I.mode == 0) *(GAS v4u*)((bf16*)I.dst + (size_t)I.n0d * I.K + (size_t)(I.k0 >> 6) * 16384 + n * 64 + 8 * kg) = o;
            else *(GAS v4u*)((bf16*)I.dst + (size_t)(I.n0d + n) * I.K + I.k0 + 8 * kg) = o; } }
}
#ifndef W_LATE_IN_P4
#define W_LATE_IN_P4 1
#endif
constexpr int W_ITEMS = 4096, W_EARLY = W_LATE_IN_P4 ? 1280 : 4096;
template <bool OPAQUE_LANE = false>
__device__ __forceinline__ void p0_convert(Frame& F, int first, int end, int stride) {
    const int lane_ = OPAQUE_LANE ? (wg_tid(F.wave) & 63) : F.lane;
    v4f ta[8], tb8[8]; int it = first;
    if (it < end) p0_tload(p0_titem(F, it), ta, F.wave, lane_);
    if (it + stride < end) p0_tload(p0_titem(F, it + stride), tb8, F.wave, lane_);
    LAS float* tile0 = (LAS float*)F.lds; LAS float* tile1 = (LAS float*)(F.lds + 65536);
    for (; it < end; it += 2 * stride) {
        p0_tstage(p0_titem(F, it), ta, tile0, F.wave, lane_);
        __syncthreads();
        if (it + 2 * stride < end) p0_tload(p0_titem(F, it + 2 * stride), ta, F.wave, lane_);
        p0_tstore(p0_titem(F, it), tile0, F.wave, lane_);
        if (it + stride < end) {
            p0_tstage(p0_titem(F, it + stride), tb8, tile1, F.wave, lane_);
            __syncthreads();
            if (it + 3 * stride < end) p0_tload(p0_titem(F, it + 3 * stride), tb8, F.wave, lane_);
            p0_tstore(p0_titem(F, it + stride), tile1, F.wave, lane_); }
    }
}
__device__ __forceinline__ void p0_convert1(Frame& F, int first, int end) {
    const int lane = wg_tid(F.wave) & 63;
    v4f ta[8]; int tb = 0;
    p0_tload(p0_titem(F, first), ta, F.wave, lane);
    for (int it = first; it < end; ++it) {
        LAS float* tile = (LAS float*)(F.lds + tb * 65536);
        p0_tstage(p0_titem(F, it), ta, tile, F.wave, lane);
        __syncthreads();
        if (it + 1 < end) p0_tload(p0_titem(F, it + 1), ta, F.wave, lane);
        p0_tstore(p0_titem(F, it), tile, F.wave, lane);
        tb ^= 1;
    }
}
__device__ __forceinline__ float rms_row_to_bf16(const float* xrow, const float* g, bf16* orow, int lane) {
    const GAS v4f* xr = (const GAS v4f*)xrow + lane; const GAS v4f* gr = (const GAS v4f*)g + lane;
    v4f v[8]; float s = 0.f;
#pragma unroll
    for (int j = 0; j < 8; ++j) { v[j] = xr[64 * j]; s += (v[j].x * v[j].x + v[j].y * v[j].y) + (v[j].z * v[j].z + v[j].w * v[j].w); }
    const float rinv = 1.0f / sqrtf(wave_sum(s) * (1.f / DM) + EPS);
    GAS v2u* o8 = (GAS v2u*)orow + lane;
#pragma unroll
    for (int j = 0; j < 8; ++j) { const v4f gg = gr[64 * j]; v2u w; w.x = pk2(v[j].x * rinv * gg.x, v[j].y * rinv * gg.y); w.y = pk2(v[j].z * rinv * gg.z, v[j].w * rinv * gg.w); o8[64 * j] = w; }
    return rinv;
}
__device__ __forceinline__ void p0_prologue(Frame& F) {
    refresh_ids(F);
    const float* x = F.inp[0]; const float* mem = F.inp[1]; const float* mixer_norm = F.inp[2]; const float* w_in = F.inp[3];
    const int gw = F.vcu * 8 + F.wave, NGW = F.G * 8;
    LAS float* WgL = (LAS float*)F.lds; const int khw = F.vcu & 1;
#pragma unroll 8
    for (int idx = F.tid; idx < 16384; idx += NTHREADS) { const int e = idx & 7, ln = (idx >> 3) & 63, sp = idx >> 9, gate = ln & 15, q = ln >> 4, k = 1024 * khw + 32 * sp + 8 * q + e;
        const int col = gate < 8 ? 3072 + gate : 5128 + (gate - 8);
        WgL[idx] = w_in[(size_t)k * IN_WIDTH + col] * mixer_norm[k]; }
    __syncthreads();
    { float* gates = (float*)(F.ws + WS_GATES); float* ssqx = (float*)(F.ws + WS_CTL + CTL_SSQX); bf16* XG = (bf16*)(F.ws + WS_XN);
      const int i16 = F.lane & 15, q = F.lane >> 4;
      for (int grp = (F.vcu >> 1) * 8 + F.wave; grp < MTOK / 16; grp += (F.G >> 1) * 8) { const int kh = khw; const size_t row = (size_t)grp * 16 + i16;
          const float* xr = x + row * DM + kh * 1024 + 8 * q; bf16* xo = XG + row * DM + kh * 1024 + 8 * q;
          const LAS float* wp = WgL + F.lane * 8;
          v4f acc = (v4f){0.f, 0.f, 0.f, 0.f}; float ss = 0.f;
#pragma unroll 1
          for (int s0 = 0; s0 < 32; s0 += 8, wp += 8 * 512, xr += 8 * 32, xo += 8 * 32) { v4f xb[8][2];
#pragma unroll
              for (int j = 0; j < 8; ++j) { xb[j][0] = *(const v4f*)(xr + 32 * j); xb[j][1] = *(const v4f*)(xr + 32 * j + 4); }
#pragma unroll
              for (int j = 0; j < 8; ++j) { const v4f x0 = xb[j][0], x1 = xb[j][1];
                  const v4f w0 = *(const LAS v4f*)(wp + j * 512), w1 = *(const LAS v4f*)(wp + j * 512 + 4);
                  ss += (x0.x * x0.x + x0.y * x0.y) + (x0.z * x0.z + x0.w * x0.w) + (x1.x * x1.x + x1.y * x1.y) + (x1.z * x1.z + x1.w * x1.w);
                  v4u o; o.x = pk2(x0.x, x0.y); o.y = pk2(x0.z, x0.w); o.z = pk2(x1.x, x1.y); o.w = pk2(x1.z, x1.w);
                  *(v4u*)(xo + 32 * j) = o;
                  acc = __builtin_amdgcn_mfma_f32_16x16x4f32(x0.x, w0.x, acc, 0, 0, 0); acc = __builtin_amdgcn_mfma_f32_16x16x4f32(x0.y, w0.y, acc, 0, 0, 0);
                  acc = __builtin_amdgcn_mfma_f32_16x16x4f32(x0.z, w0.z, acc, 0, 0, 0); acc = __builtin_amdgcn_mfma_f32_16x16x4f32(x0.w, w0.w, acc, 0, 0, 0);
                  acc = __builtin_amdgcn_mfma_f32_16x16x4f32(x1.x, w1.x, acc, 0, 0, 0); acc = __builtin_amdgcn_mfma_f32_16x16x4f32(x1.y, w1.y, acc, 0, 0, 0);
                  acc = __builtin_amdgcn_mfma_f32_16x16x4f32(x1.z, w1.z, acc, 0, 0, 0); acc = __builtin_amdgcn_mfma_f32_16x16x4f32(x1.w, w1.w, acc, 0, 0, 0); } }
          ss += __shfl_xor(ss, 16); ss += __shfl_xor(ss, 32);
          if (q == 0) atomicAdd(ssqx + row, ss);
#pragma unroll
          for (int r = 0; r < 4; ++r) atomicAdd(gates + ((size_t)grp * 16 + 4 * q + r) * 16 + i16, acc[r]);
      } }
    { bf16* MN = (bf16*)(F.ws + WS_MN);
      for (int m = gw; m < MROWS; m += NGW) (void)rms_row_to_bf16(mem + (size_t)m * DM, F.inp[15], MN + (size_t)m * DM, F.lane); }
    __syncthreads();
    p0_convert(F, F.vcu, W_EARLY, F.G);
}

constexpr int P2_KT_OFF = 4096, P2_KT_PITCH = 128, P2_VT_OFF = P2_KT_OFF + 64 * P2_KT_PITCH * 2, P2_VT_PITCH = 256;
constexpr int P2_BUF_ELEMS = (64 * P2_KT_PITCH + 64 * P2_VT_PITCH);
__device__ __forceinline__ void p2_prep_item(Frame& F, int item, bool do_norm = true) {
    refresh_ids(F);
    const int b = item >> 6, c = item & 63; const size_t R0 = (size_t)b * SEQ + (size_t)c * 64;
    const int tid = F.tid, lane = F.lane, w = F.wave;
    LAS float* gq = (LAS float*)F.lds; LAS float* uk = gq + 256;
    LAS bf16* kt = (LAS bf16*)(F.lds + P2_KT_OFF); LAS bf16* vt = (LAS bf16*)(F.lds + P2_VT_OFF);
    const float* GATES = (const float*)(F.ws + WS_GATES); const float* SSQX = (const float*)(F.ws + WS_CTL + CTL_SSQX);
    const bf16* MQK = (const bf16*)(F.ws + WS_MQK); const bf16* MV = (const bf16*)(F.ws + WS_MV);
    bf16* QP = (bf16*)((unsigned char*)F.out + WS_QP); bf16* KPP = (bf16*)((unsigned char*)F.out + WS_KPP);
    const float* conv_w = F.inp[7]; const float* conv_b = F.inp[8];
    const int cgp = tid & 31, rg = tid >> 5; const bool isq = cgp < 16;
    v4u rawc[7], rawv[4];
#define P2_LOAD(h_) do { const int col_ = (isq ? 0 : 512) + (h_) * MLDK + (cgp & 15) * 8;                                              \
        _Pragma("unroll") for (int i = 0; i < 7; ++i) { const int pos = c * 64 + 4 * rg - 3 + i;                                           \
            rawc[i] = (v4u){0u, 0u, 0u, 0u}; if (pos >= 0) rawc[i] = *(const v4u*)(MQK + ((size_t)b * SEQ + pos) * 1024 + col_); }            \
        _Pragma("unroll") for (int i = 0; i < 4; ++i) { const int idx = tid + NTHREADS * i, row = idx >> 5, ch = idx & 31;                 \
            rawv[i] = *(const v4u*)(MV + (R0 + row) * 1024 + (h_) * MLDV + ch * 8); } } while (0)
#define P2_CONV(h_, kt_, vt_) do { const int col_ = (isq ? 0 : 512) + (h_) * MLDK + (cgp & 15) * 8;                                       \
        float cw[4][8], cb[8];                                                                                                             \
        _Pragma("unroll") for (int e = 0; e < 8; ++e) { cb[e] = conv_b[col_ + e];                                                          \
            _Pragma("unroll") for (int j = 0; j < 4; ++j) cw[j][e] = conv_w[j * 1024 + col_ + e]; }                                        \
        float u[7][8];                                                                                                                     \
        _Pragma("unroll") for (int i = 0; i < 7; ++i) _Pragma("unroll") for (int e = 0; e < 4; ++e) { u[i][2 * e] = bflo(rawc[i][e]); u[i][2 * e + 1] = bfhi(rawc[i][e]); } \
        _Pragma("unroll") for (int r = 0; r < 4; ++r) { const int t = 4 * rg + r; const float f = isq ? gq[(h_) * 64 + t] : uk[(h_) * 64 + t]; float y[8]; \
            _Pragma("unroll") for (int e = 0; e < 8; ++e) { float a = cb[e];                                                               \
                _Pragma("unroll") for (int j = 0; j < 4; ++j) a += cw[j][e] * u[r + j][e];                                                 \
                y[e] = a * sigmoidf_(a) * f; }                                                                                             \
            v4u o; o.x = pk2(y[0], y[1]); o.y = pk2(y[2], y[3]); o.z = pk2(y[4], y[5]); o.w = pk2(y[6], y[7]);                             \
            *(v4u*)((isq ? QP : KPP) + (R0 + t) * 512 + (h_) * MLDK + (cgp & 15) * 8) = o;                                                 \
            if (!isq) *(LAS v4u*)((kt_) + t * P2_KT_PITCH + (((cgp & 15) ^ ((t >> 3) & 7)) * 8)) = o; }                                                         \
        _Pragma("unroll") for (int i = 0; i < 4; ++i) { const int idx = tid + NTHREADS * i, row = idx >> 5, ch = idx & 31;                 \
            *(LAS v4u*)((vt_) + row * P2_VT_PITCH + ((ch ^ ((row >> 3) & 7)) * 8)) = rawv[i]; } } while (0)
    P2_LOAD(0);
    float a_mi = 0.f, a_mf = 0.f, a_ss = 1.f;
    if (w < 4) { const size_t row = R0 + lane; a_mi = GATES[row * 16 + 8 + w]; a_mf = GATES[row * 16 + 12 + w]; a_ss = SSQX[row]; }
    { const int mr = item * 4 + (w & 3); const bf16* slab = (const bf16*)(F.ws + WS_SLAB);
      if (w < 4) {
        const float* gxq = F.inp[18]; const float* gxk = F.inp[19];
        v4f kv[8]; float ssh[4] = {0.f, 0.f, 0.f, 0.f};
#pragma unroll
        for (int j = 0; j < 8; ++j) { const int col = 4 * (lane + 64 * j); v4f a = (v4f){0.f, 0.f, 0.f, 0.f};
#pragma unroll
            for (int s = 0; s < 4; ++s) { const v2u r2 = *(const v2u*)(slab + ((size_t)s * MROWS + mr) * 4096 + col); a = a + (v4f){bflo(r2.x), bfhi(r2.x), bflo(r2.y), bfhi(r2.y)}; }
            kv[j] = a; ssh[j >> 1] += (a.x * a.x + a.y * a.y) + (a.z * a.z + a.w * a.w); }
        float rk[4];
#pragma unroll
        for (int hh = 0; hh < 4; ++hh) rk[hh] = 1.0f / sqrtf(wave_sum(ssh[hh]) * (1.0f / XD) + EPS);
        unsigned char* KH = F.ws + WS_KHAT + (size_t)mr * DM;
#pragma unroll
        for (int j = 0; j < 8; ++j) { const int col = 4 * (lane + 64 * j), d = col & (XD - 1); const v4f a = *(const v4f*)(gxq + d), g2 = *(const v4f*)(gxk + d); const float r = rk[j >> 1];
            const float r8 = r * KH8_SCALE;
            *(unsigned*)(KH + col) = pg8::pk4_fp8(kv[j].x * r8 * a.x * g2.x, kv[j].y * r8 * a.y * g2.y, kv[j].z * r8 * a.z * g2.z, kv[j].w * r8 * a.w * g2.w); }
      } else {
        unsigned char* VTM = F.ws + WS_VTM; const int bm = mr >> 8, key = mr & 255;
        v4f vv[8];
#pragma unroll
        for (int j = 0; j < 8; ++j) { const int dcol = 4 * (lane + 64 * j); v4f a = (v4f){0.f, 0.f, 0.f, 0.f};
#pragma unroll
            for (int s = 0; s < 4; ++s) { const v2u r2 = *(const v2u*)(slab + ((size_t)s * MROWS + mr) * 4096 + 2048 + dcol); a = a + (v4f){bflo(r2.x), bfhi(r2.x), bflo(r2.y), bfhi(r2.y)}; }
            vv[j] = a; }
#pragma unroll
        for (int j = 0; j < 8; ++j) { const int dcol = 4 * (lane + 64 * j); const v4f a = vv[j];
            const int hh = dcol >> 9, d = dcol & (XD - 1); unsigned char* vp = VTM + ((size_t)(bm * XH + hh) * XD + d) * NMEM + key;
            const unsigned q4 = pg8::pk4_fp8(a.x * V8_SCALE, a.y * V8_SCALE, a.z * V8_SCALE, a.w * V8_SCALE);
            vp[0] = (unsigned char)q4; vp[NMEM] = (unsigned char)(q4 >> 8); vp[2 * NMEM] = (unsigned char)(q4 >> 16); vp[3 * NMEM] = (unsigned char)(q4 >> 24); }
      } }
    if (w < 4) { const float ri = 1.0f / sqrtf(a_ss * (1.0f / DM) + EPS);
        const float mi = a_mi * ri + F.inp[5][w], mf = a_mf * ri + F.inp[6][w];
        const float bcum = wave_incl_scan(logsigmoidf(mf), lane);
        const float g = __expf(bcum), u = __expf(mi - bcum) * 0.08838834764831845f;
        gq[w * 64 + lane] = g; uk[w * 64 + lane] = u;
        if (lane == 63) ((float*)(F.ws + WS_EB))[(size_t)(b * MLH + w) * NCHUNK + c] = g; }
    if (do_norm) { bf16* FQ = (bf16*)(F.ws + WS_FQ); bf16* FK = (bf16*)(F.ws + WS_FK); const int l16 = lane & 15;
      float gqn[8], gkn[8];
#pragma unroll
      for (int e = 0; e < 8; ++e) { gqn[e] = F.inp[9][l16 * 8 + e]; gkn[e] = F.inp[10][l16 * 8 + e]; }
      for (int it0 = w; it0 < 256; it0 += 64) {
          v4u raw[8];
#pragma unroll
          for (int j = 0; j < 8; ++j) { const int seg = (it0 + 8 * j) * 4 + (lane >> 4), row = seg >> 4, hh = seg & 15;
              raw[j] = *(const v4u*)((hh < 8 ? FQ : FK) + (R0 + row) * 1024 + (hh & 7) * FOXD + l16 * 8); }
#pragma unroll
          for (int j = 0; j < 8; ++j) { const int seg = (it0 + 8 * j) * 4 + (lane >> 4), row = seg >> 4, hh = seg & 15;
              bf16* p = (hh < 8 ? FQ : FK) + (R0 + row) * 1024 + (hh & 7) * FOXD + l16 * 8; float v[8];
#pragma unroll
              for (int e = 0; e < 4; ++e) { v[2 * e] = bflo(raw[j][e]); v[2 * e + 1] = bfhi(raw[j][e]); }
              float ss = 0.f;
#pragma unroll
              for (int e = 0; e < 8; ++e) ss += v[e] * v[e];
              ss += __shfl_xor(ss, 1); ss += __shfl_xor(ss, 2); ss += __shfl_xor(ss, 4); ss += __shfl_xor(ss, 8);
              const float ri = 1.0f / sqrtf(ss * (1.0f / FOXD) + EPS);
              v4u o;
#pragma unroll
              for (int e = 0; e < 4; ++e) { const float g0 = hh < 8 ? gqn[2 * e] : gkn[2 * e], g1 = hh < 8 ? gqn[2 * e + 1] : gkn[2 * e + 1]; o[e] = pk2(v[2 * e] * ri * g0, v[2 * e + 1] * ri * g1); }
              *(v4u*)p = o; } } }
    __syncthreads();
    P2_CONV(0, kt, vt);
    __syncthreads();
    for (int h = 0; h < MLH; ++h) {
        LAS bf16* ktc = kt + (h & 1) * P2_BUF_ELEMS; LAS bf16* vtc = vt + (h & 1) * P2_BUF_ELEMS;
        LAS bf16* ktn = kt + ((h + 1) & 1) * P2_BUF_ELEMS; LAS bf16* vtn = vt + ((h + 1) & 1) * P2_BUF_ELEMS;
        if (h + 1 < MLH) P2_LOAD(h + 1);
        const size_t itemh = (size_t)(b * MLH + h) * NCHUNK + c;
        { bf16* KT = (bf16*)((unsigned char*)F.out + WS_KT) + itemh * MLDK * 64;
#pragma unroll
          for (int i = 0; i < 2; ++i) { const int idx = tid + NTHREADS * i, d = idx >> 3, sg = idx & 7; unsigned short e8[8];
#pragma unroll
              for (int e = 0; e < 8; ++e) e8[e] = ktc[(8 * sg + e) * P2_KT_PITCH + (((d >> 3) ^ sg) << 3) + (d & 7)];
              v4u o; o.x = e8[0] | ((unsigned)e8[1] << 16); o.y = e8[2] | ((unsigned)e8[3] << 16); o.z = e8[4] | ((unsigned)e8[5] << 16); o.w = e8[6] | ((unsigned)e8[7] << 16);
              *(v4u*)(KT + d * 64 + 8 * sg) = o; }
          bf16* VT = (bf16*)((unsigned char*)F.out + WS_VT) + itemh * MLDV * 64;
#pragma unroll
          for (int i = 0; i < 4; ++i) { const int idx = tid + NTHREADS * i, dv = idx >> 3, sg = idx & 7; unsigned short e8[8];
#pragma unroll
              for (int e = 0; e < 8; ++e) e8[e] = vtc[(8 * sg + e) * P2_VT_PITCH + (((dv >> 3) ^ sg) << 3) + (dv & 7)];
              v4u o; o.x = e8[0] | ((unsigned)e8[1] << 16); o.y = e8[2] | ((unsigned)e8[3] << 16); o.z = e8[4] | ((unsigned)e8[5] << 16); o.w = e8[6] | ((unsigned)e8[7] << 16);
              *(v4u*)(VT + dv * 64 + 8 * sg) = o; }
          if (tid < MLDK) { float s = 0.f;
#pragma unroll 8
              for (int t = 0; t < 64; ++t) s += bf2f(ktc[t * P2_KT_PITCH + (((tid >> 3) ^ ((t >> 3) & 7)) << 3) + (tid & 7)]);
              ((float*)(F.ws + WS_KSUM))[itemh * MLDK + tid] = s; } }
        if (h + 1 < MLH) P2_CONV(h + 1, ktn, vtn);
        __syncthreads();
    }
#undef P2_LOAD
#undef P2_CONV
    __syncthreads();
}

__device__ __forceinline__ void p3_scan_item(Frame& F, int item) {
    refresh_ids(F);
    if (item < 256) { for (int rep = 0; rep < P3_SCAN_REP; ++rep)
        mls::state_scan(item >> 4, item & 15, (const bf16*)((unsigned char*)F.out + WS_KT), (const bf16*)((unsigned char*)F.out + WS_VT), (const float*)(F.ws + WS_EB), (bf16*)(F.ws + WS_CST), F.lds, F.wave, rep == P3_SCAN_REP - 1); return; }
    const int bh = item - 288, sl = item >= 288 ? 0 : 1;
    if (sl == 0 && F.tid < MLDK) {
        const float* EB = (const float*)(F.ws + WS_EB) + (size_t)bh * NCHUNK; const float* KS = (const float*)(F.ws + WS_KSUM) + (size_t)bh * NCHUNK * MLDK + F.tid;
        float* NS = (float*)(F.ws + WS_NST) + (size_t)bh * NCHUNK * MLDK + F.tid; float n = 0.f;
        float ks[NCHUNK], eb[NCHUNK];
#pragma unroll
        for (int c = 0; c < NCHUNK; ++c) { ks[c] = KS[(size_t)c * MLDK]; eb[c] = EB[c]; }
#pragma unroll
        for (int c = 0; c < NCHUNK; ++c) { NS[(size_t)c * MLDK] = n; n = eb[c] * (n + ks[c]); }
    }
    if (sl == 1) {
        const int seq = item - 256, b = seq >> 3, fh = seq & 7;
        const float* GATES = (const float*)(F.ws + WS_GATES); const float* SSQX = (const float*)(F.ws + WS_CTL + CTL_SSQX); const float fb = F.inp[4][fh];
        const size_t r0 = (size_t)b * SEQ + 8 * F.tid; float lf[8]; float tot = 0.f;
#pragma unroll
        for (int j = 0; j < 8; ++j) { lf[j] = logsigmoidf(GATES[(r0 + j) * 16 + fh] * rinv_of(SSQX, r0 + j) + fb); tot += lf[j]; }
        const float incl = wave_incl_scan(tot, F.lane);
        LAS float* wt = (LAS float*)F.lds;
        __syncthreads();
        if (F.lane == 63) wt[F.wave] = incl;
        __syncthreads();
        float run = incl - tot;
        for (int wv = 0; wv < F.wave; ++wv) run += wt[wv];
        float* C = (float*)(F.ws + WS_CFOX) + (size_t)seq * SEQ + 8 * F.tid;
        float cs[8];
#pragma unroll
        for (int j = 0; j < 8; ++j) { run += lf[j]; cs[j] = run * -11.313708498984761f; C[j] = cs[j]; }
        LAS float* cp0 = wt + 16; LAS float* cend = wt + 32; LAS float* thr = wt + 96;
        if ((F.tid & 31) == 0) cp0[F.tid >> 5] = cs[0];
        if ((F.tid & 7) == 7) cend[F.tid >> 3] = cs[7];
        if (F.wave == 0) { float gq = fmaxf(fabsf(F.inp[9][F.lane]), fabsf(F.inp[9][F.lane + 64])), gk = fmaxf(fabsf(F.inp[10][F.lane]), fabsf(F.inp[10][F.lane + 64]));
#pragma unroll
            for (int o = 1; o < 64; o <<= 1) { gq = fmaxf(gq, __shfl_xor(gq, o)); gk = fmaxf(gk, __shfl_xor(gk, o)); }
            if (F.lane == 0) thr[0] = 2.0f * 11.313708498984761f * gq * gk + 29.0f; }
        __syncthreads();
        if (F.tid < 16) { const int qb = F.tid; const float T = thr[0], c0 = cp0[qb]; int j = 0;
            while (j < 4 * qb && (c0 - cend[j]) * 0.08838834764831845f > T) ++j;
            ((int*)(F.ws + WS_JLO))[seq * 16 + qb] = JLO_DISABLE ? 0 : (j & ~1); }
        __syncthreads();
    }
}
#ifndef MK_PER_PHASE
#define MK_PER_PHASE 0
#endif
#define XB_TMO      128
#define XB_XCNT(j)  (256  + 64 * (j))
#define XB_XSUB(j)  (1280 + 64 * (j))
#define XB_XGEN(j)  (2304 + 64 * (j))
#define XB_TOP      3328
#define XB_TOPGEN   3392
#define XCD_BAR_WORDS 3456
#define XB_SPIN_CAP (1u << 20)
__device__ __forceinline__ unsigned xb_ld(unsigned* p)              { return __hip_atomic_load(p, __ATOMIC_RELAXED, __HIP_MEMORY_SCOPE_AGENT); }
__device__ __forceinline__ unsigned xb_add(unsigned* p, unsigned v) { return __hip_atomic_fetch_add(p, v, __ATOMIC_RELAXED, __HIP_MEMORY_SCOPE_AGENT); }
__device__ __forceinline__ unsigned xb_xcc_id() { return (unsigned)__builtin_amdgcn_s_getreg((3 << 11) | 20) & 0xFu; }
#define XB_SPIN(cond, bar) do { unsigned _sp = 0; while (cond) { __builtin_amdgcn_s_sleep(1); \
    if ((++_sp & 255u) == 0u) { if (xb_ld(&(bar)[XB_TMO])) break; if (_sp > XB_SPIN_CAP) { atomicAdd(&(bar)[XB_TMO], 1u); break; } } } } while (0)
struct XcdBarrier { unsigned* bar; unsigned x; volatile LAS unsigned* st; int wv; };
__device__ __forceinline__ XcdBarrier xcd_barrier_post(unsigned* bar, volatile LAS unsigned* st, int wv) {
    XcdBarrier b; b.bar = bar; b.x = xb_xcc_id(); b.st = st; b.wv = wv;
    if (wv == 0 && lane_id() == 0) (void)xb_add(&bar[XB_XCNT(b.x)], 1u);
    return b;
}
__device__ __forceinline__ void xcd_barrier_complete(unsigned* bar, unsigned x, unsigned& nloc, unsigned& nx) {
    const unsigned G = gridDim.x * gridDim.y * gridDim.z;
    unsigned sum, cnt, mine, sp = 0u;
    for (;;) {
        sum = 0u; cnt = 0u; mine = 0u;
#pragma unroll
        for (unsigned j = 0; j < 16; ++j) { const unsigned c = xb_ld(&bar[XB_XCNT(j)]); sum += c; cnt += (c > 0u) ? 1u : 0u; mine = (j == x) ? c : mine; }
        if (sum == G) break;
        __builtin_amdgcn_s_sleep(1);
        if ((++sp & 255u) == 0u) { if (xb_ld(&bar[XB_TMO])) break; if (sp > XB_SPIN_CAP) { atomicAdd(&bar[XB_TMO], 1u); break; } }
    }
    nloc = mine > 0u ? mine : 1u; nx = cnt > 0u ? cnt : 1u;
}
__device__ __forceinline__ void xcd_barrier(const XcdBarrier& b) {
    asm volatile("s_waitcnt vmcnt(0)" ::: "memory");
    __syncthreads();
    if (b.wv == 0 && lane_id() == 0) {
        unsigned* bar = b.bar;
        __builtin_amdgcn_s_waitcnt(0);
        unsigned nloc = b.st[0], nx = b.st[1];
        if (nloc == 0u) { xcd_barrier_complete(bar, b.x, nloc, nx); b.st[0] = nloc; b.st[1] = nx; }
        const unsigned old = xb_add(&bar[XB_XSUB(b.x)], 1u);
        const unsigned gen = old / nloc;
        if (old + 1u == (gen + 1u) * nloc) {
            __builtin_amdgcn_fence(__ATOMIC_RELEASE, "agent");
            asm volatile("s_waitcnt vmcnt(0)" ::: "memory");
            const unsigned og = xb_add(&bar[XB_TOP], 1u);
            const unsigned tg = og / nx;
            if (og + 1u == (tg + 1u) * nx) xb_add(&bar[XB_TOPGEN], 1u);
            else XB_SPIN(xb_ld(&bar[XB_TOPGEN]) == tg, bar);
            __builtin_amdgcn_fence(__ATOMIC_ACQUIRE, "agent");
            xb_add(&bar[XB_XGEN(b.x)], 1u);
            asm volatile("s_waitcnt vmcnt(0)" ::: "memory");
        } else {
            XB_SPIN(xb_ld(&bar[XB_XGEN(b.x)]) == gen, bar);
            __builtin_amdgcn_fence(__ATOMIC_ACQUIRE, "agent");
            asm volatile("s_waitcnt vmcnt(0)" ::: "memory");
        }
    }
    __syncthreads();
}
constexpr int LDS_MISC_OFF = LDS_BYTES - 256;
#ifndef ML_TWICE
#define ML_TWICE 1
#endif
#ifndef TWICE_P5
#define TWICE_P5 0
#endif
#ifndef TWICE_P6
#define TWICE_P6 0
#endif
#ifndef TWICE_P8
#define TWICE_P8 0
#endif
#ifndef STAGGER_TICKS
#define STAGGER_TICKS 0
#endif
#ifndef P1_WGM
#define P1_WGM 8
#endif
#ifndef P5_WGM
#define P5_WGM 8
#endif
#ifndef P10_WGM
#define P10_WGM 8
#endif
#ifndef MLP_SPLIT
#define MLP_SPLIT 0
#endif
#ifndef P10S_WGM
#define P10S_WGM 4
#endif
#ifndef P11_WGM
#define P11_WGM 8
#endif
#ifndef KREV_P11
#define KREV_P11 1
#endif
#ifndef P4_CV_DEEP
#define P4_CV_DEEP 0
#endif
#ifndef P4_CONV_FIRST
#define P4_CONV_FIRST 0
#endif
#ifndef P4_CVB
#define P4_CVB 2
#endif
#ifndef P4_TWICE
#define P4_TWICE 1
#endif
#ifndef TWICE_P11
#define TWICE_P11 0
#endif
#ifndef TWICE_P10
#define TWICE_P10 0
#endif
#ifndef TWICE_P1
#define TWICE_P1 0
#endif
#ifndef JLO_DISABLE
#define JLO_DISABLE 0
#endif
constexpr int N_PHASES = 12;
struct Args { const float* in[24]; float* out; unsigned char* ws; int ph_lo, ph_hi; };
static_assert(sizeof(Args) == 24 * 8 + 8 + 8 + 8, "Args has no padding");

__global__ void __launch_bounds__(NTHREADS, 2) fwd_kernel(Args args) {
    extern __shared__ __attribute__((aligned(16))) unsigned char lds[];
    Frame F;
    F.lds = (LAS unsigned char*)lds; F.ldsg = lds;
    F.wave = __builtin_amdgcn_readfirstlane((int)(threadIdx.x >> 6)); F.lane = lane_id(); F.tid = F.wave * 64 + F.lane;
    F.G = gridDim.x; { const int bx = blockIdx.x; F.vcu = (F.G % 8 == 0) ? (bx % 8) * (F.G / 8) + bx / 8 : bx; }
    F.inp = (const __attribute__((address_space(4))) cfp_t*)__builtin_amdgcn_kernarg_segment_ptr();
    F.out = args.out; F.ws = args.ws;
    unsigned char* ws = args.ws;
    const int lo = args.ph_lo, hi = args.ph_hi;
    volatile LAS unsigned* MISC = (volatile LAS unsigned*)(F.lds + LDS_MISC_OFF);
    if (F.tid < 64) MISC[F.tid] = 0u;
    __syncthreads();
    XcdBarrier xbar; xbar.bar = (unsigned*)(ws + WS_CTL); xbar.x = 0; xbar.st = nullptr; xbar.wv = F.wave;
    if (hi - lo > 1) xbar = xcd_barrier_post((unsigned*)(ws + WS_CTL), MISC, F.wave);
#ifndef PHASE_MASK
#define PHASE_MASK 0xfff
#endif
#define IN(k) ((((PHASE_MASK) >> (k)) & 1) && lo <= (k) && (k) < hi)
#ifndef DUP_PHASE
#define DUP_PHASE 99
#endif
#define REP(k) for (int rep_ = 0; rep_ < ((k) == DUP_PHASE ? 2 : 1); ++rep_, ((k) == DUP_PHASE && rep_ < 2 ? xcd_barrier(xbar) : (void)0))
#define SEAM(k) do { if (IN(k) && IN((k) + 1)) { xcd_barrier(xbar); } } while (0)
    if (__builtin_expect(lo < 0, 0)) cg::this_grid().sync();
    float* SSQ1 = (float*)(ws + WS_CTL + CTL_SSQ1); float* SSQ2 = (float*)(ws + WS_CTL + CTL_SSQ2); float* SSQQ = (float*)(ws + WS_CTL + CTL_SSQQ);

#ifdef PROBE_PHASE
    unsigned long long pt0 = 0, pt1 = 0, pu0 = 0, pu1 = 0;
#ifndef PROBE_B
#define PROBE_B 99
#endif
#define STAMP(k) do { if ((k) == PROBE_PHASE) pt0 = __builtin_amdgcn_s_memrealtime(); if ((k) == PROBE_PHASE + 1) pt1 = __builtin_amdgcn_s_memrealtime(); \
                      if ((k) == PROBE_B) pu0 = __builtin_amdgcn_s_memrealtime(); if ((k) == PROBE_B + 1) pu1 = __builtin_amdgcn_s_memrealtime(); } while (0)
#else
#define STAMP(k) do {} while (0)
#endif
    STAMP(0);
#ifdef CLK_PHASE
    unsigned long long ck0 = 0, ck1 = 0, cr0 = 0, cr1 = 0;
#define CLKS(k) do { if ((k) == CLK_PHASE) { ck0 = __builtin_amdgcn_s_memtime(); cr0 = __builtin_amdgcn_s_memrealtime(); } if ((k) == CLK_PHASE + 1) { ck1 = __builtin_amdgcn_s_memtime(); cr1 = __builtin_amdgcn_s_memrealtime(); } } while (0)
#else
#define CLKS(k) do {} while (0)
#endif
    CLKS(0);
    if (IN(0)) REP(0) { p0_prologue(F); }
    SEAM(0); STAMP(1); CLKS(1);
    if (IN(1)) REP(1) {
        { pg8::Gemm g{ws, (unsigned)WS_XN, (unsigned)WS_WIN, DM, 64, DM, 0, 128u, 32768u}; pg8::StdOrder S; S.init(MTOK, NPROJ, DM, DM, F.G, (int)blockIdx.x, TWICE_P1, P1_WGM);
          pg8::EpiProj E{(bf16*)(ws + WS_PROJ), F.inp[9], F.inp[10], (const float*)(ws + WS_CTL + CTL_SSQX), (LAS float*)(F.lds + pg8::STAGE_BYTES)};
          pg8::gemm_phase<pg8::EpiProj, pg8::StdOrder, true>(F.lds, g, S, E, F.wave); }
        { pg8::Gemm g{ws, (unsigned)WS_MN, (unsigned)WS_WXKV, DM, DM, 512}; pg8::XkvOrder S{F.G, (int)blockIdx.x};
          pg8::EpiSlab E{(bf16*)(ws + WS_SLAB), 4096, (size_t)MROWS * 4096};
          pg8::gemm_phase<pg8::EpiSlab, pg8::XkvOrder, false>(F.lds, g, S, E, F.wave); }
    }
    SEAM(1); STAMP(2); CLKS(2);
#ifndef P2_TWICE
#define P2_TWICE 1
#endif
    if (IN(2)) REP(2) { for (int item = F.vcu; item < BATCH * NCHUNK * P2_TWICE; item += F.G) p2_prep_item(F, item & 255, false); }
    SEAM(2); STAMP(3); CLKS(3);
#ifndef P3_TWICE
#define P3_TWICE 1
#endif
    if (IN(3)) REP(3) { for (int item = F.vcu; item < 304 * P3_TWICE; item += F.G) p3_scan_item(F, item % 304); }
    SEAM(3); STAMP(4); CLKS(4);
    if (IN(4)) REP(4) {
        {
            const fox::Srd R = __builtin_amdgcn_make_buffer_rsrc((void*)ws, (short)0, (int)WS_END, 0x00020000);
            unsigned* QC = (unsigned*)(ws + WS_CTL + CTL_QCTR); const int* JLO = (const int*)(ws + WS_JLO);
            const float* CF = (const float*)(ws + WS_CFOX); const float* GO = F.inp[11];
            constexpr int CVB = P4_CVB, QCV = (W_ITEMS - W_EARLY) / (8 * CVB), QN = 192 + QCV, NONE = 1 << 20;
            auto mk_item = [&](int g) { const int qx = g / QN, i = g - qx * QN, qb = 15 - (i >> 2), bh = 4 * qx + (i & 3), b = bh >> 3, h = bh & 7;
                fox::Item I; I.rowb = (unsigned)b * SEQ * 2048u + (unsigned)h * (FOXD * 2); I.o = (unsigned)WS_CONCAT + (unsigned)b * SEQ * 4096u + (unsigned)h * (FOXD * 2);
                I.CS = CF + (size_t)bh * SEQ; I.G = GO + h * FOXD; I.P0 = qb * 256; I.jlo = JLO[bh * 16 + qb]; return I; };
            auto is_fox = [&](int g) { return g < NONE && (g % QN) < 64; };
            auto pull = [&]() { if (F.tid == 0) { unsigned qc = MISC[17], left = MISC[18]; int g = NONE;
                    while (left > 0u) { const unsigned i = atomicAdd(QC + qc * 64, 1u); if (i < (unsigned)QN) { g = (int)(qc * QN + i); break; } qc = (qc + 1u) & 7u; --left; }
                    MISC[17] = qc; MISC[18] = left; MISC[16] = (unsigned)g; } };
            if (F.tid == 0) { MISC[17] = xb_xcc_id() & 7u; MISC[18] = 8u; }
            pull();
            __syncthreads();
            int cur = __builtin_amdgcn_readfirstlane((int)MISC[16]);
            __syncthreads();
            bool co_pre = false;
            while (cur < NONE) {
                if (is_fox(cur)) {
                    fox::Item I = mk_item(cur); fox::Seam S;
                    fox::fox_prime(R, I, (char*)lds, S, F.wave);
                    for (;;) {
                        pull();
                        auto next_item = [&](const fox::Item& self, int& nidx) { nidx = __builtin_amdgcn_readfirstlane((int)MISC[16]); return is_fox(nidx) ? mk_item(nidx) : self; };
                        const int nidx = fox::fox_block(R, I, next_item, (char*)lds, S, F.wave);
                        if (!is_fox(nidx)) { cur = nidx; break; }
                        I = mk_item(nidx);
                    }
                    VM_WAIT(); __syncthreads();
                } else if (P4_CONV_FIRST ? (cur % QN < 64 + QCV) : (cur % QN >= 192)) {
                    const int qx = cur / QN, j = cur - qx * QN - (P4_CONV_FIRST ? 64 : 192), first = W_EARLY + (qx * QCV + j) * CVB;
                    pull();
#if P4_CV_DEEP
                    p0_convert<true>(F, first, first + CVB, 1);
#else
                    p0_convert1(F, first, first + CVB);
#endif
                    VM_WAIT(); __syncthreads();
                    cur = __builtin_amdgcn_readfirstlane((int)MISC[16]);
                    __syncthreads();
                } else {
                    const int qx = cur / QN, it = qx * 128 + ((cur - qx * QN) - (P4_CONV_FIRST ? 64 + QCV : 64)), c = it & 63, h = (it >> 6) & 3, b = it >> 8;
                    pull();
                    bool issued = false;
                    auto next_dma = [&]() { const int n = __builtin_amdgcn_readfirstlane((int)MISC[16]);
                        if (n < NONE) { const int ni = n % QN; if (ni >= 64 && ni < 192) { const int it2 = (n / QN) * 128 + (ni - 64);
                            mls::chunk_dma(it2 >> 8, (it2 >> 6) & 3, it2 & 63, (const bf16*)((unsigned char*)F.out + WS_VT), (const bf16*)(ws + WS_CST), F.lds, F.wave); issued = true; } } };
                    mls::chunk_out(b, h, c, (const bf16*)((unsigned char*)F.out + WS_QP), (const bf16*)((unsigned char*)F.out + WS_KPP), (const bf16*)((unsigned char*)F.out + WS_VT), (const bf16*)(ws + WS_CST),
                                   (const float*)(ws + WS_NST), (const bf16*)(ws + WS_MO), F.inp[12], (bf16*)(ws + WS_CONCAT), F.lds, F.wave, co_pre, next_dma);
                    co_pre = issued;
                    cur = __builtin_amdgcn_readfirstlane((int)MISC[16]);
                    asm volatile("s_waitcnt lgkmcnt(0)" ::: "memory"); __builtin_amdgcn_s_barrier(); asm volatile("" ::: "memory");
                }
            }
        }
    }
    SEAM(4); STAMP(5); CLKS(5);
    if (IN(5)) REP(5) {
        pg8::Gemm g{ws, (unsigned)WS_CONCAT, (unsigned)WS_WOUT, DM, 64, DM, 0, 128u, 32768u}; pg8::StdOrder S; S.init(MTOK, DM, DM, DM, F.G, (int)blockIdx.x, TWICE_P5, P5_WGM);
        pg8::EpiResid<false, false> E{(const bf16*)(ws + WS_XN), (bf16*)(ws + WS_X1B), SSQ1, DM, 1.0f, ws + WS_X1Q};
        pg8::gemm_phase<pg8::EpiResid<false, false>, pg8::StdOrder, true>(F.lds, g, S, E, F.wave);
    }
    SEAM(5); STAMP(6); CLKS(6);
    if (IN(6)) REP(6) {
        pg8::Gemm g{ws, (unsigned)WS_X1Q, (unsigned)WS_WXQ, DM / 2, 64, DM / 2, 0, 128u, 32768u}; pg8::StdOrder S; S.init(MTOK, DM, DM / 2, DM / 2, F.G, (int)blockIdx.x, TWICE_P6, P5_WGM);
        pg8::EpiQ E{ws + WS_Q, SSQ1, SSQQ, 1.0f / W8_SCALE};
        pg8::gemm_phase<pg8::EpiQ, pg8::StdOrder, true, true>(F.lds, g, S, E, F.wave);
    }
    SEAM(6); STAMP(7); CLKS(7);
    if (IN(7)) REP(7) {
        pg8::Gemm g{ws, (unsigned)WS_Q, (unsigned)WS_KHAT, DM / 2, DM / 2, XD / 2}; pg8::ScoreOrder S{F.G, (int)blockIdx.x};
        pg8::EpiSoftmax E{ws + WS_P, SSQQ};
        if (F.G >= 256) pg8::gemm_phase<pg8::EpiSoftmax, pg8::ScoreOrder, false, true>(F.lds, g, S, E, F.wave);
        VM_WAIT(); __syncthreads(); __builtin_amdgcn_fence(__ATOMIC_ACQUIRE, "agent"); VM_WAIT(); __syncthreads();
        {
        pg8::Gemm g{ws, (unsigned)WS_P, (unsigned)WS_VTM, 512, NMEM / 2, NMEM / 2}; pg8::PvOrder S{F.G, (int)blockIdx.x, TWICE_P8};
        pg8::EpiStoreFp8 E{ws + WS_CO, DM, CO8_SCALE / (P8_SCALE * V8_SCALE)};
        pg8::gemm_phase<pg8::EpiStoreFp8, pg8::PvOrder, true, true>(F.lds, g, S, E, F.wave);
            }
    }
    STAMP(8); CLKS(8);
    SEAM(8); STAMP(9); CLKS(9);
#ifdef EXTRA_BARS
    for (int eb = 0; eb < EXTRA_BARS; ++eb) xcd_barrier(xbar);
#endif
    if (IN(9)) REP(9) {
        pg8::Gemm g{ws, (unsigned)WS_CO, (unsigned)WS_WXO, DM / 2, 64, DM / 2, 0, 128u, 32768u}; pg8::StdOrder S; S.init(MTOK, DM, DM / 2, DM / 2, F.G, (int)blockIdx.x, 0, P5_WGM);
        pg8::EpiResid<false, false> E{(const bf16*)(ws + WS_X1B), (bf16*)(ws + WS_X2B), SSQ2, DM, 1.0f / (W8_SCALE * CO8_SCALE), nullptr};
        pg8::gemm_phase<pg8::EpiResid<false, false>, pg8::StdOrder, true, true>(F.lds, g, S, E, F.wave);
    }
    SEAM(9); STAMP(10); CLKS(10);
#if MLP_SPLIT
    if (IN(10) && IN(11)) {
        for (int hh = 0; hh < 2; ++hh) {
            const size_t roff = (size_t)hh * (MTOK / 2);
            {
                pg8::Gemm g{ws, (unsigned)(WS_X2B + roff * DM * 2), (unsigned)WS_WUP, DM, 64, DM, 0, 128u, 32768u}; pg8::StdOrder S; S.init(MTOK / 2, DFF, DM, DM, F.G, (int)blockIdx.x, 0, P10S_WGM);
                pg8::EpiUp E{(bf16*)(ws + WS_H), SSQ2 + roff};
                pg8::gemm_phase<pg8::EpiUp, pg8::StdOrder, true>(F.lds, g, S, E, F.wave);
            }
            xcd_barrier(xbar);
            {
                pg8::Gemm g{ws, (unsigned)WS_H, (unsigned)WS_WDN, 64, 64, DFF, KREV_P11, 32768u, 32768u}; pg8::StdOrder S; S.init(MTOK / 2, DM, DFF, DFF, F.G, (int)blockIdx.x, 0, P11_WGM);
                pg8::EpiResid<false, true> E{(const bf16*)(ws + WS_X2B) + roff * DM, F.out + roff * DM, nullptr, DM, 1.0f, nullptr};
                pg8::gemm_phase<pg8::EpiResid<false, true>, pg8::StdOrder, true>(F.lds, g, S, E, F.wave);
            }
            if (hh == 0) xcd_barrier(xbar);
        }
    }
#else
    if (IN(10)) REP(10) {
        if (STAGGER_TICKS > 0 && (blockIdx.x & 8)) { const unsigned long long t0_ = __builtin_amdgcn_s_memrealtime(); while (__builtin_amdgcn_s_memrealtime() - t0_ < (unsigned long long)STAGGER_TICKS) __builtin_amdgcn_s_sleep(8); }
        pg8::Gemm g{ws, (unsigned)WS_X2B, (unsigned)WS_WUP, DM, 64, DM, 0, 128u, 32768u}; pg8::StdOrder S; S.init(MTOK, DFF, DM, DM, F.G, (int)blockIdx.x, TWICE_P10, P10_WGM);
        pg8::EpiUp E{(bf16*)(ws + WS_H), SSQ2};
        pg8::gemm_phase<pg8::EpiUp, pg8::StdOrder, true>(F.lds, g, S, E, F.wave);
    }
    SEAM(10); STAMP(11); CLKS(11);
    if (IN(11)) REP(11) {
        pg8::Gemm g{ws, (unsigned)WS_H, (unsigned)WS_WDN, 64, 64, DFF, KREV_P11, 32768u, 32768u}; pg8::StdOrder S; S.init(MTOK, DM, DFF, DFF, F.G, (int)blockIdx.x, TWICE_P11, P11_WGM);
        pg8::EpiResid<false, true> E{(const bf16*)(ws + WS_X2B), F.out, nullptr, DM, 1.0f, nullptr};
        pg8::gemm_phase<pg8::EpiResid<false, true>, pg8::StdOrder, true>(F.lds, g, S, E, F.wave);
    }
#endif
#ifdef CLK_PHASE
    xcd_barrier(xbar); CLKS(12);
    if (blockIdx.x == 0 && F.tid == 0) F.out[0] += rintf((float)(ck1 - ck0) / (float)(cr1 - cr0));
#endif
#ifdef PROBE_PHASE
    xcd_barrier(xbar); STAMP(12);
    if (blockIdx.x == 0 && F.tid < 64) {
        const float ta = 20.0f * rintf((float)(pt1 - pt0) * 0.01f * 0.05f), tb = 0.8f * rintf((float)(pu1 - pu0) * 0.01f * 0.125f);
        if (F.tid == 0) F.out[0] += ta;
        if (PROBE_B != 99) for (int i = F.tid; i < 10000; i += 64) F.out[64 + i] += tb;
    }
#endif
#undef IN
#undef SEAM
}

extern "C" void kernel_launch(void* const* d_in, const int* in_sizes, int n_in, void* d_out, int out_size, void* d_ws, size_t ws_size, hipStream_t stream) {
    static int grid = 0;
    if (grid == 0) {
        if (n_in != 24 || in_sizes[0] != MTOK * DM || out_size != MTOK * DM || ws_size < WS_END) {
            fprintf(stderr, "kernel_launch: unexpected shapes (n_in %d, in0 %d, out %d, ws %zu; need ws >= %zu); nothing launched\n", n_in, n_in > 0 ? in_sizes[0] : -1, out_size, ws_size, (size_t)WS_END); grid = -1; return; }
        int dev = 0, cus = 0, per_cu = 0;
        if (hipGetDevice(&dev) != hipSuccess || hipDeviceGetAttribute(&cus, hipDeviceAttributeMultiprocessorCount, dev) != hipSuccess) { grid = -1; return; }
        if (hipFuncSetAttribute((const void*)fwd_kernel, hipFuncAttributeMaxDynamicSharedMemorySize, LDS_BYTES) != hipSuccess) { fprintf(stderr, "kernel_launch: hipFuncSetAttribute failed\n"); grid = -1; return; }
        if (hipOccupancyMaxActiveBlocksPerMultiprocessor(&per_cu, (const void*)fwd_kernel, NTHREADS, LDS_BYTES) != hipSuccess || per_cu < 1) { fprintf(stderr, "kernel_launch: occupancy query says %d blocks per CU\n", per_cu); per_cu = 1; }
        (void)hipGetLastError();
        grid = cus;
    }
    if (grid < 0) return;
    (void)hipMemsetAsync((char*)d_ws + WS_CTL, 0, CTL_BYTES, stream);
    Args a{};
    for (int i = 0; i < 24; ++i) a.in[i] = (const float*)d_in[i];
    a.out = (float*)d_out; a.ws = (unsigned char*)d_ws;
#if MK_PER_PHASE
    for (int ph = 0; ph < N_PHASES; ++ph) { a.ph_lo = ph; a.ph_hi = ph + 1;
        hipLaunchKernelGGL(fwd_kernel, dim3(grid), dim3(NTHREADS), LDS_BYTES, stream, a); }
#else
    a.ph_lo = 0; a.ph_hi = N_PHASES;
    void* kargs[] = {&a};
    hipError_t e = hipLaunchCooperativeKernel((const void*)fwd_kernel, dim3(grid), dim3(NTHREADS), kargs, LDS_BYTES, stream);
    if (e != hipSuccess) fprintf(stderr, "kernel_launch: cooperative launch failed: %s (grid %d)\n", hipGetErrorString(e), grid);
#endif
}
```

```cpp
#include <hip/hip_runtime.h>
#include <hip/hip_cooperative_groups.h>
#include <cstdio>
#include <cstdint>
namespace cg = cooperative_groups;

constexpr int BATCH = 4, SEQ = 4096, DM = 2048, MTOK = BATCH * SEQ;
constexpr int NMEM = 256, MROWS = BATCH * NMEM;
constexpr int FOXH = 8, FOXD = 128, MLH = 4, MLDV = 256, MLDK = 128, XH = 4, XD = 512, DFF = 8192;
constexpr int IN_WIDTH = 6160, NPROJ = 6144, NCHUNK = SEQ / 64;
constexpr float EPS = 1e-6f;
constexpr float LOG2E = 1.4426950408889634f;

constexpr size_t MiB = (size_t)1 << 20;
constexpr size_t WS_WIN = 0, WS_WOUT = 24 * MiB, WS_WXQ = 32 * MiB, WS_WXKV = 40 * MiB, WS_WXO = 56 * MiB, WS_WUP = 60 * MiB, WS_WDN = 92 * MiB;
constexpr size_t WS_PROJ = 128 * MiB;
constexpr size_t WS_FQ = 128 * MiB, WS_FK = 160 * MiB, WS_FV = 192 * MiB, WS_MQK = 224 * MiB, WS_MV = 256 * MiB, WS_MO = 288 * MiB;
constexpr size_t WS_XN = 320 * MiB;
constexpr size_t WS_QP = 0 * MiB, WS_KPP = 16 * MiB;
constexpr size_t WS_KT = 32 * MiB;
constexpr size_t WS_VT = 48 * MiB;
constexpr size_t WS_MISC = 464 * MiB;
constexpr size_t WS_CTL = WS_MISC, CTL_BYTES = 2 * MiB;
constexpr size_t CTL_QCTR = 32 * 1024;
constexpr size_t CTL_SSQ1 = 64 * 1024, CTL_SSQ2 = 128 * 1024, CTL_SSQQ = 192 * 1024, CTL_SSQX = 448 * 1024;
constexpr size_t WS_GATES = WS_MISC + 1 * MiB;
constexpr size_t WS_CFOX = WS_MISC + 3 * MiB;
constexpr size_t WS_EB = WS_MISC + 4 * MiB;
constexpr size_t WS_KSUM = WS_MISC + 5 * MiB;
constexpr size_t WS_NST = WS_MISC + 6 * MiB;
constexpr size_t WS_JLO = WS_MISC + 7 * MiB;
constexpr size_t WS_MN = WS_MISC + 8 * MiB;
constexpr size_t WS_KHAT = WS_MISC + 12 * MiB;
constexpr size_t WS_VTM = WS_MISC + 16 * MiB;
constexpr size_t WS_END = 512 * MiB;
constexpr size_t WS_CONCAT = 224 * MiB;
constexpr size_t WS_X1B = 128 * MiB;
constexpr size_t WS_Q = 192 * MiB;
constexpr size_t WS_CO = 256 * MiB;
constexpr size_t WS_P = 320 * MiB;
constexpr size_t WS_X1Q = 288 * MiB;
constexpr size_t WS_X2B = 128 * MiB;
constexpr size_t WS_H = 192 * MiB;
constexpr size_t WS_SLAB = 400 * MiB;
constexpr size_t WS_CST = 400 * MiB;

#ifndef P3_SCAN_REP
#define P3_SCAN_REP 1
#endif
#ifndef JLO_DISABLE
#define JLO_DISABLE 0
#endif
constexpr float W8_SCALE = 64.0f, CO8_SCALE = 8.0f;
constexpr float Q8_SCALE = 16.0f, KH8_SCALE = 16.0f, P8_SCALE = 256.0f, V8_SCALE = 16.0f;
constexpr int WDNPITCH = DFF + 64;
constexpr int HPITCH = DFF + 64;
constexpr int LDS_BYTES = 147456;
constexpr int NTHREADS = 512;

#define GAS __attribute__((address_space(1)))
#define LAS __attribute__((address_space(3)))
typedef unsigned short bf16;
typedef unsigned v4u __attribute__((ext_vector_type(4)));
typedef unsigned v2u __attribute__((ext_vector_type(2)));
typedef float v4f __attribute__((ext_vector_type(4)));
typedef short v8s __attribute__((ext_vector_type(8)));
typedef short v4s __attribute__((ext_vector_type(4)));
#define LDS_WAIT() asm volatile("s_waitcnt lgkmcnt(0)" ::: "memory")
#define VM_WAIT() asm volatile("s_waitcnt vmcnt(0)" ::: "memory")
__device__ __forceinline__ unsigned f2bf(float f) { unsigned u = __builtin_bit_cast(unsigned, f); return (u + 0x7fffu + ((u >> 16) & 1u)) >> 16; }
__device__ __forceinline__ unsigned pk2(float lo, float hi) { return f2bf(lo) | (f2bf(hi) << 16); }
__device__ __forceinline__ float bf2f(unsigned h) { return __builtin_bit_cast(float, h << 16); }
__device__ __forceinline__ float bflo(unsigned w) { return __builtin_bit_cast(float, w << 16); }
__device__ __forceinline__ float bfhi(unsigned w) { return __builtin_bit_cast(float, w & 0xffff0000u); }
__device__ __forceinline__ float wave_sum(float v) {
#pragma unroll
    for (int o = 1; o < 64; o <<= 1) v += __shfl_xor(v, o);
    return v;
}
__device__ __forceinline__ int lane_id() { return (int)__builtin_amdgcn_mbcnt_hi(~0u, __builtin_amdgcn_mbcnt_lo(~0u, 0u)); }
__device__ __forceinline__ int wg_tid(int wv) { int t = wv * 64 + lane_id(); asm volatile("" : "+v"(t)); return t; }
__device__ __forceinline__ float logsigmoidf(float x) { return x >= 0.f ? -log1pf(__expf(-x)) : x - log1pf(__expf(x)); }
__device__ __forceinline__ float sigmoidf_(float x) { return 1.f / (1.f + __expf(-x)); }
__device__ __forceinline__ float rinv_of(const float* ssqx, size_t row) { return 1.0f / sqrtf(ssqx[row] * (1.0f / DM) + EPS); }
#define MK_PER_PHASE 0
namespace pg8 {
#define PG8_LAS __attribute__((address_space(3)))
typedef unsigned short bf16_t;
typedef short bf16x8 __attribute__((ext_vector_type(8)));
typedef float f32x4 __attribute__((ext_vector_type(4)));
typedef float f32x2 __attribute__((ext_vector_type(2)));
typedef unsigned u32x4 __attribute__((ext_vector_type(4)));
typedef unsigned u32x2 __attribute__((ext_vector_type(2)));
constexpr int BM = 256, BK = 64, HALF = 128, HTB = HALF * BK * 2, STAGE_BYTES = 8 * HTB, NXCD = 8, WGM = 8;

__host__ __device__ __forceinline__ int lds_byte(int r, int c) { const int st = (r >> 4) * 2 + (c >> 5), rr = r & 15, cc = c & 31, ob = rr * 64 + cc * 2; return st * 1024 + (ob ^ (((ob >> 9) & 1) << 5)); }
__host__ __device__ __forceinline__ void stage_rc(int b, int& R, int& C) { const int st = b / 1024, sb = b % 1024, swz = sb ^ (((sb >> 9) & 1) << 5); R = (st >> 1) * 16 + swz / 64; C = (st & 1) * 32 + (swz % 64) / 2; }
__host__ __device__ __forceinline__ int perm32(int rho) { const int n = rho >> 4, i = rho & 15; return 8 * (i >> 2) + 4 * n + (i & 3); }

struct Unit { int row0, col0; long aoff, boff; int aux; };
struct Gemm { const void* base; unsigned aoff, boff; int lda, ldb, K; int krev = 0; unsigned ksa = BK * 2, ksb = BK * 2; };

struct StdOrder {
    int nM, nN, nwg, G, c, lda, ldb, rsh, wgm;
    __device__ void init(int M, int N, int lda_, int ldb_, int G_, int c_, int rsh_ = 0, int wgm_ = WGM) { nM = M / BM; nN = N / BM; nwg = nM * nN; G = G_; c = c_; lda = lda_; ldb = ldb_; rsh = rsh_; wgm = wgm_; }
    __device__ bool next(int i, Unit& u) const {
        const long L = (long)(i >> rsh) * G + c; if (L >= nwg) return false;
        int wgid = (int)L; { const int q = nwg / NXCD, r = nwg % NXCD, xcd = wgid % NXCD, off = wgid / NXCD; wgid = (xcd < r ? xcd * (q + 1) : r * (q + 1) + (xcd - r) * q) + off; }
        const int nig = wgm * nN, gid = wgid / nig, fm = gid * wgm, gsz = (nM - fm) < wgm ? (nM - fm) : wgm;
        const int pm = fm + ((wgid % nig) % gsz), pn = (wgid % nig) / gsz;
        u.row0 = pm * BM; u.col0 = pn * BM; u.aoff = (long)pm * BM * lda; u.boff = (long)pn * BM * ldb; u.aux = i & ((1 << rsh) - 1); return true;
    }
};

__device__ __forceinline__ unsigned cvt_pk_bf16(float lo, float hi) { unsigned r; asm volatile("v_cvt_pk_bf16_f32 %0, %1, %2" : "=v"(r) : "v"(lo), "v"(hi)); return r; }

typedef int v8i_t __attribute__((ext_vector_type(8)));
typedef int v4i_t __attribute__((ext_vector_type(4)));
template <class Epi, class Sched, bool ALIGN_EPI, bool FP8 = false>
__device__ __forceinline__ void gemm_phase(PG8_LAS unsigned char* lds, const Gemm g, const Sched& S, const Epi& E, int wv) {
    const int tid = wg_tid(wv), wid = wv, lane = tid & 63, wr = wid >> 2, wc = wid & 3, fr = lane & 15, fq = lane >> 4;
    const int K = g.K, nt = K / BK;
    unsigned voffA, voffB;
    { int R, C; stage_rc(tid * 16, R, C); const int Rb = Epi::PERM ? ((R & ~31) + perm32(R & 31)) : R;
      voffA = (unsigned)(R * g.lda + C) * 2u; voffB = (unsigned)(Rb * g.ldb + C) * 2u; }
    const unsigned pA = 64u * (unsigned)g.lda * 2u, pB = 64u * (unsigned)g.ldb * 2u;
    const unsigned voffA_v = voffA, voffB_v = voffB, voffA_p = pA, voffB_p = pB;
    const unsigned kstepA = g.krev ? 0u - g.ksa : g.ksa, kstepB = g.krev ? 0u - g.ksb : g.ksb, k0A = g.krev ? (unsigned)(nt - 1) * g.ksa : 0u, k0B = g.krev ? (unsigned)(nt - 1) * g.ksb : 0u;
    const unsigned hA = (unsigned)HALF * g.lda * 2, hB = (unsigned)HALF * g.ldb * 2;
    const __amdgpu_buffer_rsrc_t rsrc = __builtin_amdgcn_make_buffer_rsrc((void*)g.base, (short)0, 0x7fffffff, 0x00020000);
    const unsigned ldsw = (unsigned)wid * 1024u;
    const int aoff = lds_byte(wr * 64 + fr, fq * 8), boff = lds_byte(wc * 32 + fr, fq * 8);
#define PG8_SA(b, h) (((b) * 2 + (h)) * HTB)
#define PG8_SB(b, h) ((4 + (b) * 2 + (h)) * HTB)
#define PG8_STAGE(bufoff, gbase, voff) do { _Pragma("unroll") for (int _i = 0; _i < 2; ++_i) \
        __builtin_amdgcn_raw_ptr_buffer_load_lds(rsrc, (PG8_LAS void*)(lds + (bufoff) + ldsw + _i * 8192), 16, voff##_v, (gbase) + _i * voff##_p, 0, 0); } while (0)
#define PG8_LDA(dst, b, h) do { _Pragma("unroll") for (int m = 0; m < 4; ++m) dst[m] = PG8_CAT(*(const PG8_LAS v4i_t*)(lds + PG8_SA(b, h) + aoff + m * 2048), *(const PG8_LAS v4i_t*)(lds + PG8_SA(b, h) + aoff + m * 2048 + 1024)); } while (0)
#define PG8_LDB(dst, b, h) do { _Pragma("unroll") for (int n = 0; n < 2; ++n) dst[n] = PG8_CAT(*(const PG8_LAS v4i_t*)(lds + PG8_SB(b, h) + boff + n * 2048), *(const PG8_LAS v4i_t*)(lds + PG8_SB(b, h) + boff + n * 2048 + 1024)); } while (0)
#define PG8_CAT(x0, x1) __builtin_shufflevector((x0), (x1), 0, 1, 2, 3, 4, 5, 6, 7)
#define PG8_K0(x) __builtin_bit_cast(bf16x8, __builtin_shufflevector((x), (x), 0, 1, 2, 3))
#define PG8_K1(x) __builtin_bit_cast(bf16x8, __builtin_shufflevector((x), (x), 4, 5, 6, 7))
#define PG8_MMA(ai, bj, At, Bt) do { __builtin_amdgcn_s_setprio(1); _Pragma("unroll") for (int m = 0; m < 4; ++m) _Pragma("unroll") for (int n = 0; n < 2; ++n) { \
        if constexpr (FP8) asm volatile("v_mfma_f32_16x16x128_f8f6f4 %0, %1, %2, %0" : "+v"(acc[ai][bj][m][n]) : "v"(Bt[n]), "v"(At[m]));     \
        else { acc[ai][bj][m][n] = __builtin_amdgcn_mfma_f32_16x16x32_bf16(PG8_K0(Bt[n]), PG8_K0(At[m]), acc[ai][bj][m][n], 0, 0, 0); \
               acc[ai][bj][m][n] = __builtin_amdgcn_mfma_f32_16x16x32_bf16(PG8_K1(Bt[n]), PG8_K1(At[m]), acc[ai][bj][m][n], 0, 0, 0); } } \
        __builtin_amdgcn_s_setprio(0); } while (0)
#define PG8_WAIT_V(n) asm volatile("s_waitcnt vmcnt(" #n ")" ::: "memory")
#define PG8_WAIT_L(n) asm volatile("s_waitcnt lgkmcnt(" #n ")" ::: "memory")
#define PG8_BAR __builtin_amdgcn_s_barrier()
#define PG8_SCHED __builtin_amdgcn_sched_barrier(0)
    Unit cur, nxt; int ui = 0;
    if (!S.next(0, cur)) return;
    PG8_LAS float* rsc = (PG8_LAS float*)(lds + 140288); int rs_row0 = -1;
    if constexpr (Epi::ROWSCALE) { if (tid < 256) rsc[tid] = __builtin_amdgcn_rsqf(E.rs_src()[cur.row0 + tid] * (1.0f / 2048.0f) + 1e-6f); rs_row0 = cur.row0; }
    f32x4 acc[2][2][4][2];
#pragma unroll
    for (int a = 0; a < 2; ++a)
#pragma unroll
        for (int b = 0; b < 2; ++b)
#pragma unroll
            for (int m = 0; m < 4; ++m)
#pragma unroll
                for (int n = 0; n < 2; ++n) acc[a][b][m][n] = (f32x4){0.f, 0.f, 0.f, 0.f};
    v8i_t At[4], B0[2], B1[2];
    unsigned cA = g.aoff + (unsigned)cur.aoff * 2u + k0A, cB = g.boff + (unsigned)cur.boff * 2u + k0B;
    PG8_STAGE(PG8_SB(0, 0), cB, voffB); PG8_STAGE(PG8_SB(0, 1), cB + hB, voffB); PG8_STAGE(PG8_SA(0, 0), cA, voffA); PG8_STAGE(PG8_SA(0, 1), cA + hA, voffA);
    if (wr == 1) PG8_BAR;
    PG8_WAIT_V(2); PG8_BAR;
    PG8_STAGE(PG8_SB(1, 0), cB + kstepB, voffB); PG8_STAGE(PG8_SA(1, 0), cA + kstepA, voffA); PG8_STAGE(PG8_SB(1, 1), cB + hB + kstepB, voffB);
    PG8_WAIT_V(6); PG8_BAR;
    for (;;) {
        const bool has_next = S.next(ui + 1, nxt);
        const unsigned nA = has_next ? g.aoff + (unsigned)nxt.aoff * 2u + k0A : cA, nB = has_next ? g.boff + (unsigned)nxt.boff * 2u + k0B : cB;
        for (int t = 0; t < nt; t += 2) {
            const bool last = (t == nt - 2);
            const unsigned a1 = cA + (unsigned)(t + 1) * kstepA;
            const unsigned a2 = last ? nA : cA + (unsigned)(t + 2) * kstepA, b2 = last ? nB : cB + (unsigned)(t + 2) * kstepB;
            const unsigned a3 = a2 + kstepA, b3 = b2 + kstepB;
            PG8_LDB(B0, 0, 0); PG8_LDB(B1, 0, 1); PG8_SCHED; PG8_LDA(At, 0, 0); PG8_STAGE(PG8_SA(1, 1), a1 + hA, voffA);
            PG8_WAIT_V(8); PG8_WAIT_L(0); PG8_BAR; PG8_MMA(0, 0, At, B0); PG8_MMA(0, 1, At, B1); PG8_BAR; PG8_SCHED;
            PG8_LDA(At, 0, 1); PG8_STAGE(PG8_SB(0, 0), b2, voffB); PG8_STAGE(PG8_SB(0, 1), b2 + hB, voffB); PG8_STAGE(PG8_SA(0, 0), a2, voffA);
            PG8_WAIT_V(8); PG8_WAIT_L(0); PG8_BAR; PG8_MMA(1, 0, At, B0); PG8_MMA(1, 1, At, B1); PG8_BAR; PG8_SCHED;
            PG8_LDB(B0, 1, 0); PG8_LDB(B1, 1, 1); PG8_SCHED; PG8_LDA(At, 1, 0); PG8_STAGE(PG8_SA(0, 1), a2 + hA, voffA);
            PG8_WAIT_V(8); PG8_WAIT_L(0); PG8_BAR; PG8_MMA(0, 0, At, B0); PG8_MMA(0, 1, At, B1); PG8_BAR; PG8_SCHED;
            PG8_LDA(At, 1, 1); PG8_STAGE(PG8_SB(1, 0), b3, voffB); PG8_STAGE(PG8_SB(1, 1), b3 + hB, voffB); PG8_STAGE(PG8_SA(1, 0), a3, voffA);
            PG8_WAIT_V(8); PG8_WAIT_L(0); PG8_BAR; PG8_MMA(1, 0, At, B0); PG8_MMA(1, 1, At, B1); PG8_BAR; PG8_SCHED;
        }
        if constexpr (ALIGN_EPI) { if (wr == 0) PG8_BAR; }
        if constexpr (FP8) asm volatile("s_nop 15\n\ts_nop 7" ::: "memory");
        if constexpr (!Epi::AFTER_DRAIN) { E(acc, cur, wr, wc, fr, fq, rsc); }
        if (!has_next) break;
#pragma unroll
        for (int a = 0; a < 2; ++a)
#pragma unroll
            for (int b = 0; b < 2; ++b)
#pragma unroll
                for (int m = 0; m < 4; ++m)
#pragma unroll
                    for (int n = 0; n < 2; ++n) acc[a][b][m][n] = (f32x4){0.f, 0.f, 0.f, 0.f};
        cur = nxt; cA = nA; cB = nB; ++ui;
        if constexpr (Epi::ROWSCALE) { if (cur.row0 != rs_row0) { rsc = (PG8_LAS float*)(lds + (rsc == (PG8_LAS float*)(lds + 140288) ? 141312 : 140288)); if (tid < 256) rsc[tid] = __builtin_amdgcn_rsqf(E.rs_src()[cur.row0 + tid] * (1.0f / 2048.0f) + 1e-6f); rs_row0 = cur.row0; } }
        if constexpr (ALIGN_EPI) { if (wr == 1) PG8_BAR; }
    }
    PG8_WAIT_V(0);
    if constexpr (!ALIGN_EPI) { if (wr == 0) PG8_BAR; }
    PG8_BAR;
    if constexpr (Epi::AFTER_DRAIN) { E.fused(acc, cur, wr, wc, fr, fq, lds, wid, lane); }
#undef PG8_SA
#undef PG8_SB
#undef PG8_STAGE
#undef PG8_LDA
#undef PG8_LDB
#undef PG8_MMA
#undef PG8_CAT
#undef PG8_K0
#undef PG8_K1
#undef PG8_WAIT_V
#undef PG8_WAIT_L
#undef PG8_BAR
#undef PG8_SCHED
}
}
namespace pg8 {
struct XkvOrder {
    int G, c;
    __device__ bool next(int i, Unit& u) const {
        const int L = i * G + c; if (L >= 256) return false;
        const int kq = L & 3, tile = L >> 2, pm = tile & 3, pn = tile >> 2;
        u.row0 = pm * 256; u.col0 = pn * 256; u.aoff = (long)pm * 256 * DM + kq * 512; u.boff = (long)pn * 256 * DM + kq * 512; u.aux = kq; return true;
    }
};
struct QOrder {
    int G, c, rsh;
    __device__ bool next(int i, Unit& u) const {
        if (c >= 256 || (i >> rsh) >= 2) return false;
        const int b = c >> 6, h = (c >> 4) & 3, mt = c & 15, pm = b * 16 + mt, pn = 2 * h + (i >> rsh);
        u.row0 = pm * 256; u.col0 = pn * 256; u.aoff = (long)pm * 256 * (DM / 2); u.boff = (long)pn * 256 * (DM / 2); u.aux = i & ((1 << rsh) - 1); return true;
    }
};
struct ScoreOrder {
    int G, c;
    __device__ bool next(int i, Unit& u) const {
        const int L = i * G + c; if (L >= 256) return false;
        const int b = L >> 6, h = (L >> 4) & 3, mt = L & 15;
        u.row0 = b * SEQ + mt * 256; u.col0 = h * 256; u.aoff = (long)u.row0 * (DM / 2) + h * (XD / 2); u.boff = (long)(b * NMEM) * (DM / 2) + h * (XD / 2); u.aux = h; return true;
    }
};
struct PvOrder {
    int G, c, rsh;
    __device__ bool next(int i, Unit& u) const {
        if (c >= 256 || (i >> rsh) >= 2) return false;
        const int nt = i >> rsh, b = c >> 6, h = (c >> 4) & 3, mt = c & 15;
        u.row0 = b * SEQ + mt * 256; u.col0 = h * XD + nt * 256; u.aoff = (long)u.row0 * 512 + h * 128; u.boff = ((long)(b * XH + h) * XD + nt * 256) * (NMEM / 2); u.aux = 0; return true;
    }
};


#ifndef EPI_FULL_LINES
#define EPI_FULL_LINES 0
#endif
#ifndef EPI_SC1
#define EPI_SC1 0
#endif
__device__ __forceinline__ void st16(void* p, u32x4 v) {
#if EPI_SC1
    asm volatile("global_store_dwordx4 %0, %1, off sc1\n\ts_nop 1" :: "v"(p), "v"(v) : "memory");
#else
    *(u32x4*)p = v;
#endif
}
__device__ __forceinline__ void st16f(void* p, f32x4 v) {
#if EPI_SC1
    asm volatile("global_store_dwordx4 %0, %1, off sc1\n\ts_nop 1" :: "v"(p), "v"(v) : "memory");
#else
    *(f32x4*)p = v;
#endif
}
__device__ __forceinline__ void st8(void* p, u32x2 v) {
#if EPI_SC1
    asm volatile("global_store_dwordx2 %0, %1, off sc1\n\ts_nop 0" :: "v"(p), "v"(v) : "memory");
#else
    *(u32x2*)p = v;
#endif
}

__device__ __forceinline__ float lane_xor8(float x) { return __builtin_bit_cast(float, __builtin_amdgcn_update_dpp(0, __builtin_bit_cast(int, x), 0x128, 0xf, 0xf, false)); }
__device__ __forceinline__ unsigned pk4_fp8(float a, float b, float c, float d) { int w = __builtin_amdgcn_cvt_pk_fp8_f32(a, b, 0, false); w = __builtin_amdgcn_cvt_pk_fp8_f32(c, d, w, true); return (unsigned)w; }
struct EpiStoreBf16 {
    static constexpr bool PERM = true, AFTER_DRAIN = false, ROWSCALE = false;
    bf16_t* O; int ldc; int split_cols; size_t split_stride;
    __device__ __forceinline__ void operator()(const f32x4 (&acc)[2][2][4][2], const Unit& u, int wr, int wc, int fr, int fq, PG8_LAS const float* rsc) const {
        int colt = u.col0; bf16_t* base = O;
        if (split_cols) { const int t = colt / split_cols; base += (size_t)t * split_stride; colt -= t * split_cols; }
        const int row0 = u.row0 + wr * 64 + fr, col0 = colt + wc * 32 + 8 * fq;
#pragma unroll
        for (int ai = 0; ai < 2; ++ai)
#pragma unroll
            for (int m = 0; m < 4; ++m) { bf16_t* rowp = base + (size_t)(row0 + ai * HALF + m * 16) * ldc + col0;
#pragma unroll
                for (int bj = 0; bj < 2; ++bj) { const f32x4 v0 = acc[ai][bj][m][0], v1 = acc[ai][bj][m][1];
                    u32x4 w; w.x = cvt_pk_bf16(v0[0], v0[1]); w.y = cvt_pk_bf16(v0[2], v0[3]); w.z = cvt_pk_bf16(v1[0], v1[1]); w.w = cvt_pk_bf16(v1[2], v1[3]);
                    st16(rowp + bj * HALF, w); } }
    }
};
struct EpiProj {
    static constexpr bool PERM = true, AFTER_DRAIN = false, ROWSCALE = true;
    __device__ __forceinline__ const float* rs_src() const { return ssqx; }
    bf16_t* O; const float* gq; const float* gk; const float* ssqx; PG8_LAS float* red;
    __device__ __forceinline__ void operator()(f32x4 (&acc)[2][2][4][2], const Unit& u, int wr, int wc, int fr, int fq, PG8_LAS const float* rsc) const {
        const int t = u.col0 >> 10, colt = u.col0 & 1023; bf16_t* base = O + (size_t)t * ((size_t)MTOK * 1024);
        const int row0 = u.row0 + wr * 64 + fr, col0 = colt + wc * 32 + 8 * fq;
#pragma unroll
        for (int ai = 0; ai < 2; ++ai)
#pragma unroll
            for (int m = 0; m < 4; ++m) { const float rx = rsc[ai * HALF + wr * 64 + m * 16 + fr];
#pragma unroll
                for (int bj = 0; bj < 2; ++bj) { acc[ai][bj][m][0] = acc[ai][bj][m][0] * rx; acc[ai][bj][m][1] = acc[ai][bj][m][1] * rx; } }
        if (u.col0 < 2048) {
            const float* g = (t == 0 ? gq : gk) + wc * 32 + 8 * fq; const f32x4 g0 = *(const f32x4*)g, g1 = *(const f32x4*)(g + 4);
#pragma unroll
            for (int ai = 0; ai < 2; ++ai)
#pragma unroll
                for (int m = 0; m < 4; ++m) { const int rl = ai * HALF + wr * 64 + m * 16 + fr;
#pragma unroll
                    for (int bj = 0; bj < 2; ++bj) { const f32x4 v0 = acc[ai][bj][m][0], v1 = acc[ai][bj][m][1];
                        float s = (v0[0] * v0[0] + v0[1] * v0[1]) + (v0[2] * v0[2] + v0[3] * v0[3]) + (v1[0] * v1[0] + v1[1] * v1[1]) + (v1[2] * v1[2] + v1[3] * v1[3]);
                        s += __shfl_xor(s, 16); s += __shfl_xor(s, 32);
                        if (fq == 0) red[(rl * 2 + bj) * 4 + wc] = s; } }
            asm volatile("s_waitcnt lgkmcnt(0)" ::: "memory"); __builtin_amdgcn_s_barrier(); asm volatile("" ::: "memory");
#pragma unroll
            for (int ai = 0; ai < 2; ++ai)
#pragma unroll
                for (int m = 0; m < 4; ++m) { const int rl = ai * HALF + wr * 64 + m * 16 + fr;
#pragma unroll
                    for (int bj = 0; bj < 2; ++bj) { const f32x4 r4 = *(const PG8_LAS f32x4*)(red + (rl * 2 + bj) * 4);
                        const float ri = __builtin_amdgcn_rsqf(((r4[0] + r4[1]) + (r4[2] + r4[3])) * (1.0f / FOXD) + EPS);
                        acc[ai][bj][m][0] = acc[ai][bj][m][0] * ri * g0; acc[ai][bj][m][1] = acc[ai][bj][m][1] * ri * g1; } }
        }
#pragma unroll
        for (int ai = 0; ai < 2; ++ai)
#pragma unroll
            for (int m = 0; m < 4; ++m) { bf16_t* rowp = base + (size_t)(row0 + ai * HALF + m * 16) * 1024 + col0;
#pragma unroll
                for (int bj = 0; bj < 2; ++bj) { const f32x4 v0 = acc[ai][bj][m][0], v1 = acc[ai][bj][m][1];
                    u32x4 w; w.x = cvt_pk_bf16(v0[0], v0[1]); w.y = cvt_pk_bf16(v0[2], v0[3]); w.z = cvt_pk_bf16(v1[0], v1[1]); w.w = cvt_pk_bf16(v1[2], v1[3]);
                    st16(rowp + bj * HALF, w); } }
    }
};
struct EpiStoreFp8 {
    static constexpr bool PERM = true, AFTER_DRAIN = false, ROWSCALE = false;
    unsigned char* O8; int ldc; float scale;
    __device__ __forceinline__ void operator()(const f32x4 (&acc)[2][2][4][2], const Unit& u, int wr, int wc, int fr, int fq, PG8_LAS const float* rsc) const {
        const int row0 = u.row0 + wr * 64 + fr, col0 = u.col0 + wc * 32 + 8 * fq;
#pragma unroll
        for (int ai = 0; ai < 2; ++ai)
#pragma unroll
            for (int m = 0; m < 4; ++m) { unsigned char* rowp = O8 + (size_t)(row0 + ai * HALF + m * 16) * ldc + col0;
#pragma unroll
                for (int bj = 0; bj < 2; ++bj) { const f32x4 v0 = acc[ai][bj][m][0] * scale, v1 = acc[ai][bj][m][1] * scale;
                    u32x2 w; w.x = pk4_fp8(v0[0], v0[1], v0[2], v0[3]); w.y = pk4_fp8(v1[0], v1[1], v1[2], v1[3]);
                    st8(rowp + bj * HALF, w); } }
    }
};
struct EpiSlab {
    static constexpr bool PERM = true, AFTER_DRAIN = false, ROWSCALE = false;
    bf16_t* slab; int ldc; size_t slab_stride;
    __device__ __forceinline__ void operator()(const f32x4 (&acc)[2][2][4][2], const Unit& u, int wr, int wc, int fr, int fq, PG8_LAS const float* rsc) const {
        bf16_t* base = slab + (size_t)u.aux * slab_stride; const int col0 = u.col0 + wc * 32 + 8 * fq;
#pragma unroll
        for (int ai = 0; ai < 2; ++ai)
#pragma unroll
            for (int m = 0; m < 4; ++m) { bf16_t* rowp = base + (size_t)(u.row0 + ai * HALF + wr * 64 + m * 16 + fr) * ldc + col0;
#pragma unroll
                for (int bj = 0; bj < 2; ++bj) { const f32x4 v0 = acc[ai][bj][m][0], v1 = acc[ai][bj][m][1];
                    u32x4 w; w.x = cvt_pk_bf16(v0[0], v0[1]); w.y = cvt_pk_bf16(v0[2], v0[3]); w.z = cvt_pk_bf16(v1[0], v1[1]); w.w = cvt_pk_bf16(v1[2], v1[3]);
                    st16(rowp + bj * HALF, w); } }
    }
};
template <bool BASEF, bool OUTF>
struct EpiResid {
    static constexpr bool PERM = true, AFTER_DRAIN = false, ROWSCALE = false;
    const void* base; void* out; float* ssq; int ldc; float ascale; unsigned char* out8;
    __device__ __forceinline__ void operator()(const f32x4 (&acc)[2][2][4][2], const Unit& u, int wr, int wc, int fr, int fq, PG8_LAS const float* rsc) const {
        const int col0 = u.col0 + wc * 32 + 8 * fq;
#ifdef EPIRES_SKIP_DUP
        if (u.aux != 0) return;
#endif
        float ssum[2][4];
        if constexpr (!BASEF) {
            u32x4 raw[2][2][2];
#define ER_LOADQ(q, b) do { _Pragma("unroll") for (int mi = 0; mi < 2; ++mi) { const size_t off_ = (size_t)(u.row0 + ((q) >> 1) * HALF + wr * 64 + (2 * ((q) & 1) + mi) * 16 + fr) * ldc + col0;   \
                _Pragma("unroll") for (int bj = 0; bj < 2; ++bj) raw[b][mi][bj] = *(const u32x4*)((const bf16_t*)base + off_ + bj * HALF); } } while (0)
            ER_LOADQ(0, 0); ER_LOADQ(1, 1);
#pragma unroll
            for (int q = 0; q < 4; ++q) { const int ai = q >> 1, b = q & 1;
#pragma unroll
                for (int mi = 0; mi < 2; ++mi) { const int m = 2 * (q & 1) + mi; const size_t off = (size_t)(u.row0 + ai * HALF + wr * 64 + m * 16 + fr) * ldc + col0; float s = 0.f;
#pragma unroll
                    for (int bj = 0; bj < 2; ++bj) { const u32x4 w = raw[b][mi][bj];
                        const f32x4 b0 = (f32x4){__builtin_bit_cast(float, w.x << 16), __builtin_bit_cast(float, w.x & 0xffff0000u), __builtin_bit_cast(float, w.y << 16), __builtin_bit_cast(float, w.y & 0xffff0000u)};
                        const f32x4 b1 = (f32x4){__builtin_bit_cast(float, w.z << 16), __builtin_bit_cast(float, w.z & 0xffff0000u), __builtin_bit_cast(float, w.w << 16), __builtin_bit_cast(float, w.w & 0xffff0000u)};
                        const f32x4 v0 = b0 + acc[ai][bj][m][0] * ascale, v1 = b1 + acc[ai][bj][m][1] * ascale;
                        if (out8) { u32x2 w8; w8.x = pk4_fp8(v0[0], v0[1], v0[2], v0[3]); w8.y = pk4_fp8(v1[0], v1[1], v1[2], v1[3]); st8(out8 + off + bj * HALF, w8); }
                        if constexpr (OUTF) { st16f((float*)out + off + bj * HALF, v0); st16f((float*)out + off + bj * HALF + 4, v1); }
                        else { u32x4 wo; wo.x = cvt_pk_bf16(v0[0], v0[1]); wo.y = cvt_pk_bf16(v0[2], v0[3]); wo.z = cvt_pk_bf16(v1[0], v1[1]); wo.w = cvt_pk_bf16(v1[2], v1[3]);
                            st16((bf16_t*)out + off + bj * HALF, wo); }
                        s += (v0[0] * v0[0] + v0[1] * v0[1]) + (v0[2] * v0[2] + v0[3] * v0[3]) + (v1[0] * v1[0] + v1[1] * v1[1]) + (v1[2] * v1[2] + v1[3] * v1[3]); }
                    s += __shfl_xor(s, 16); s += __shfl_xor(s, 32); ssum[ai][m] = s; }
                if (q + 2 < 4) { if (q == 0) ER_LOADQ(2, 0); else ER_LOADQ(3, 1); } }
#undef ER_LOADQ
        } else {
#pragma unroll
        for (int ai = 0; ai < 2; ++ai) {
            f32x4 bv[4][2][2];
#pragma unroll
            for (int m = 0; m < 4; ++m) { const size_t off = (size_t)(u.row0 + ai * HALF + wr * 64 + m * 16 + fr) * ldc + col0;
#pragma unroll
                for (int bj = 0; bj < 2; ++bj) {
                    if constexpr (BASEF) { bv[m][bj][0] = *(const f32x4*)((const float*)base + off + bj * HALF); bv[m][bj][1] = *(const f32x4*)((const float*)base + off + bj * HALF + 4); }
                    else { const u32x4 w = *(const u32x4*)((const bf16_t*)base + off + bj * HALF);
                        bv[m][bj][0] = (f32x4){__builtin_bit_cast(float, w.x << 16), __builtin_bit_cast(float, w.x & 0xffff0000u), __builtin_bit_cast(float, w.y << 16), __builtin_bit_cast(float, w.y & 0xffff0000u)};
                        bv[m][bj][1] = (f32x4){__builtin_bit_cast(float, w.z << 16), __builtin_bit_cast(float, w.z & 0xffff0000u), __builtin_bit_cast(float, w.w << 16), __builtin_bit_cast(float, w.w & 0xffff0000u)}; } } }
#pragma unroll
            for (int m = 0; m < 4; ++m) { const size_t off = (size_t)(u.row0 + ai * HALF + wr * 64 + m * 16 + fr) * ldc + col0; float s = 0.f;
#pragma unroll
                for (int bj = 0; bj < 2; ++bj) { const f32x4 v0 = bv[m][bj][0] + acc[ai][bj][m][0] * ascale, v1 = bv[m][bj][1] + acc[ai][bj][m][1] * ascale;
                    if (out8) { u32x2 w8; w8.x = pk4_fp8(v0[0], v0[1], v0[2], v0[3]); w8.y = pk4_fp8(v1[0], v1[1], v1[2], v1[3]); st8(out8 + off + bj * HALF, w8); }
                    if constexpr (OUTF) {
#if EPI_FULL_LINES
                        const bool hi = (fr & 8) != 0;
                        const f32x4 rcv = (f32x4){lane_xor8(hi ? v0[0] : v1[0]), lane_xor8(hi ? v0[1] : v1[1]), lane_xor8(hi ? v0[2] : v1[2]), lane_xor8(hi ? v0[3] : v1[3])};
                        const f32x4 sa = hi ? rcv : v0, sb = hi ? v1 : rcv;
                        float* pa = (float*)out + off + bj * HALF + (hi ? 4 - 8 * ldc : 0);
                        st16f(pa, sa); st16f(pa + 8 * ldc, sb);
#else
                        st16f((float*)out + off + bj * HALF, v0); st16f((float*)out + off + bj * HALF + 4, v1);
#endif
                    }
                    else { u32x4 w; w.x = cvt_pk_bf16(v0[0], v0[1]); w.y = cvt_pk_bf16(v0[2], v0[3]); w.z = cvt_pk_bf16(v1[0], v1[1]); w.w = cvt_pk_bf16(v1[2], v1[3]);
                        st16((bf16_t*)out + off + bj * HALF, w); }
                    s += (v0[0] * v0[0] + v0[1] * v0[1]) + (v0[2] * v0[2] + v0[3] * v0[3]) + (v1[0] * v1[0] + v1[1] * v1[1]) + (v1[2] * v1[2] + v1[3] * v1[3]); }
                s += __shfl_xor(s, 16); s += __shfl_xor(s, 32); ssum[ai][m] = s; } }
        }
        if (ssq && u.aux == 0) {
#pragma unroll
            for (int ai = 0; ai < 2; ++ai) { const float v = fq == 0 ? ssum[ai][0] : fq == 1 ? ssum[ai][1] : fq == 2 ? ssum[ai][2] : ssum[ai][3];
                atomicAdd(ssq + u.row0 + ai * HALF + wr * 64 + fq * 16 + fr, v); }
        }
    }
};
struct EpiQ {
    static constexpr bool PERM = true, AFTER_DRAIN = false, ROWSCALE = true;
    __device__ __forceinline__ const float* rs_src() const { return ssq_in; }
    unsigned char* O; const float* ssq_in; float* ssq_out; float oscale;
    __device__ __forceinline__ void operator()(const f32x4 (&acc)[2][2][4][2], const Unit& u, int wr, int wc, int fr, int fq, PG8_LAS const float* rsc) const {
        const int col0 = u.col0 + wc * 32 + 8 * fq; float* so = ssq_out + (size_t)(u.col0 / XD) * MTOK;
        float ssum[2][4];
#pragma unroll
        for (int ai = 0; ai < 2; ++ai)
#pragma unroll
            for (int m = 0; m < 4; ++m) { const int row = u.row0 + ai * HALF + wr * 64 + m * 16 + fr; const float ri = rsc[ai * HALF + wr * 64 + m * 16 + fr] * oscale;
                unsigned char* rowp = O + (size_t)row * DM + col0; float s = 0.f;
#pragma unroll
                for (int bj = 0; bj < 2; ++bj) { const f32x4 v0 = acc[ai][bj][m][0] * ri, v1 = acc[ai][bj][m][1] * ri;
                    u32x2 w; w.x = pk4_fp8(v0[0] * Q8_SCALE, v0[1] * Q8_SCALE, v0[2] * Q8_SCALE, v0[3] * Q8_SCALE); w.y = pk4_fp8(v1[0] * Q8_SCALE, v1[1] * Q8_SCALE, v1[2] * Q8_SCALE, v1[3] * Q8_SCALE);
                    st8(rowp + bj * HALF, w);
                    s += (v0[0] * v0[0] + v0[1] * v0[1]) + (v0[2] * v0[2] + v0[3] * v0[3]) + (v1[0] * v1[0] + v1[1] * v1[1]) + (v1[2] * v1[2] + v1[3] * v1[3]); }
                s += __shfl_xor(s, 16); s += __shfl_xor(s, 32); ssum[ai][m] = s; }
        if (u.aux == 0)
#pragma unroll
        for (int ai = 0; ai < 2; ++ai) { const float v = fq == 0 ? ssum[ai][0] : fq == 1 ? ssum[ai][1] : fq == 2 ? ssum[ai][2] : ssum[ai][3];
            atomicAdd(so + u.row0 + ai * HALF + wr * 64 + fq * 16 + fr, v); }
    }
};
struct EpiUp {
    static constexpr bool PERM = true, AFTER_DRAIN = false, ROWSCALE = true;
    __device__ __forceinline__ const float* rs_src() const { return ssq_in; }
    bf16_t* O; const float* ssq_in;
    __device__ __forceinline__ void operator()(const f32x4 (&acc)[2][2][4][2], const Unit& u, int wr, int wc, int fr, int fq, PG8_LAS const float* rsc) const {
        const int col0 = u.col0 + wc * 32 + 8 * fq;
#ifdef EPIUP_SKIP_DUP
        if (u.aux != 0) return;
#endif
#pragma unroll
        for (int ai = 0; ai < 2; ++ai)
#pragma unroll
            for (int m = 0; m < 4; ++m) { const int row = u.row0 + ai * HALF + wr * 64 + m * 16 + fr; const float ri = rsc[ai * HALF + wr * 64 + m * 16 + fr];
                bf16_t* rowp = O + (size_t)(u.row0 >> 8) * (256 * DFF) + (size_t)((u.col0 >> 6) + (wc >> 1)) * (256 * 64) + (row & 255) * 64 + (wc & 1) * 32 + 8 * fq;
#pragma unroll
                for (int bj = 0; bj < 2; ++bj) { f32x4 v0 = acc[ai][bj][m][0] * ri, v1 = acc[ai][bj][m][1] * ri;
#pragma unroll
                    for (int e = 0; e < 4; ++e) { const float a = fmaxf(v0[e], 0.f), b = fmaxf(v1[e], 0.f); v0[e] = a * a; v1[e] = b * b; }
                    u32x4 w; w.x = cvt_pk_bf16(v0[0], v0[1]); w.y = cvt_pk_bf16(v0[2], v0[3]); w.z = cvt_pk_bf16(v1[0], v1[1]); w.w = cvt_pk_bf16(v1[2], v1[3]);
                    st16(rowp + bj * (2 * 256 * 64), w); } }
    }
};
struct EpiSoftmax {
    static constexpr bool PERM = true, AFTER_DRAIN = true, ROWSCALE = false;
    unsigned char* P; const float* ssqq;
    __device__ __forceinline__ void fused(f32x4 (&acc)[2][2][4][2], const Unit& u, int wr, int wc, int fr, int fq, PG8_LAS unsigned char* lds, int wid, int lane) const {
        PG8_LAS float* RM = (PG8_LAS float*)lds;
        PG8_LAS float* RS = (PG8_LAS float*)(lds + 4096);
        const float* sq = ssqq + (size_t)u.aux * MTOK;
        float mx[2][4];
#pragma unroll
        for (int ai = 0; ai < 2; ++ai)
#pragma unroll
            for (int m = 0; m < 4; ++m) { const int rl = ai * HALF + wr * 64 + m * 16 + fr; const int row = u.row0 + rl;
                const float sc = __builtin_amdgcn_rsqf(sq[row] * (1.0f / XD) + EPS) * (0.044194173824159216f * LOG2E / (Q8_SCALE * KH8_SCALE));
                float mxx = -3.0e38f;
#pragma unroll
                for (int bj = 0; bj < 2; ++bj)
#pragma unroll
                    for (int n = 0; n < 2; ++n) { f32x4 v = acc[ai][bj][m][n] * sc; acc[ai][bj][m][n] = v; mxx = fmaxf(mxx, fmaxf(fmaxf(v[0], v[1]), fmaxf(v[2], v[3]))); }
                mxx = fmaxf(mxx, __shfl_xor(mxx, 16)); mxx = fmaxf(mxx, __shfl_xor(mxx, 32));
                if (fq == 0) RM[rl * 4 + wc] = mxx; }
        asm volatile("s_waitcnt lgkmcnt(0)" ::: "memory"); __builtin_amdgcn_s_barrier(); asm volatile("" ::: "memory");
#pragma unroll
        for (int ai = 0; ai < 2; ++ai)
#pragma unroll
            for (int m = 0; m < 4; ++m) { const int rl = ai * HALF + wr * 64 + m * 16 + fr;
                const f32x4 r4 = *(const PG8_LAS f32x4*)(RM + rl * 4); const float mxx = fmaxf(fmaxf(r4[0], r4[1]), fmaxf(r4[2], r4[3])); mx[ai][m] = mxx; float s = 0.f;
#pragma unroll
                for (int bj = 0; bj < 2; ++bj)
#pragma unroll
                    for (int n = 0; n < 2; ++n) { f32x4 v = acc[ai][bj][m][n];
#pragma unroll
                        for (int e = 0; e < 4; ++e) { v[e] = __builtin_amdgcn_exp2f(v[e] - mxx); s += v[e]; }
                        acc[ai][bj][m][n] = v; }
                s += __shfl_xor(s, 16); s += __shfl_xor(s, 32);
                if (fq == 0) RS[rl * 4 + wc] = s; }
        asm volatile("s_waitcnt lgkmcnt(0)" ::: "memory"); __builtin_amdgcn_s_barrier(); asm volatile("" ::: "memory");
        const int col0 = u.col0 + wc * 32 + 8 * fq;
#pragma unroll
        for (int ai = 0; ai < 2; ++ai)
#pragma unroll
            for (int m = 0; m < 4; ++m) { const int rl = ai * HALF + wr * 64 + m * 16 + fr;
                const f32x4 r4 = *(const PG8_LAS f32x4*)(RS + rl * 4); const float inv = P8_SCALE / ((r4[0] + r4[1]) + (r4[2] + r4[3]));
                unsigned char* rowp = P + (size_t)(u.row0 + rl) * 1024 + col0;
#pragma unroll
                for (int bj = 0; bj < 2; ++bj) { const f32x4 v0 = acc[ai][bj][m][0] * inv, v1 = acc[ai][bj][m][1] * inv;
                    u32x2 w; w.x = pk4_fp8(v0[0], v0[1], v0[2], v0[3]); w.y = pk4_fp8(v1[0], v1[1], v1[2], v1[3]);
                    st8(rowp + bj * HALF, w); } }
        (void)mx; (void)wid; (void)lane;
    }
};
}
namespace fox {
typedef short bf16x8 __attribute__((ext_vector_type(8)));
typedef short s16x4 __attribute__((ext_vector_type(4)));
typedef float f32x16 __attribute__((ext_vector_type(16)));
typedef float f32x4 __attribute__((ext_vector_type(4)));
typedef unsigned u32x4 __attribute__((ext_vector_type(4)));
constexpr int D = 128, PITCH = 1024, OPITCH = 2048;
constexpr int NW = 8, QBLK = 32, KVBLK = 64, QB = NW * QBLK;
constexpr int SHM_V = KVBLK * D * 2, SHM_K = KVBLK * D * 2;
constexpr int LDS_BIAS = 0, LDS_WS = 512, LDS_V = 4096, LDS_K = LDS_V + 2 * SHM_V, LDS_BYTES = LDS_K + 2 * SHM_K;
constexpr float SCALE = 0.08838834764831845f, C2 = LOG2E * SCALE, THR = 8.f;

#define KSWZ(row, colB) ((row) * 256 + ((colB) ^ (((row) & 7) << 4)))
#define SBAR() __builtin_amdgcn_sched_barrier(0)
__device__ __forceinline__ int v_st(int k, int c) { const int kk = (k & ~0xC) | ((k & 4) << 1) | ((k & 8) >> 1); return ((kk >> 3) * 4 + (c >> 5)) * 512 + ((kk & 7) * 32 + (c & 31)) * 2; }
__device__ __forceinline__ int v_rd_base(int lane) { return ((lane & 3) << 3) | (((lane >> 2) & 3) << 6) | (((lane >> 4) & 1) << 5) | (((lane >> 5) & 1) << 8); }
constexpr int v_rd_off(int d0, int ks, int half) { return d0 * 512 + ks * 4096 + half * 2048; }
__device__ __forceinline__ int crow(int r, int hi) { return (r & 3) + 8 * (r >> 2) + 4 * hi; }
__device__ __forceinline__ unsigned cvtpk(float lo, float hi) { unsigned r; asm volatile("v_cvt_pk_bf16_f32 %0, %1, %2" : "=v"(r) : "v"(lo), "v"(hi)); return r; }
template <int CTRL> __device__ __forceinline__ float dppf(float x) { return __builtin_bit_cast(float, __builtin_amdgcn_update_dpp(0, __builtin_bit_cast(int, x), CTRL, 0xf, 0xf, false)); }
__device__ __forceinline__ bf16x8 load8(const bf16* p) { return *reinterpret_cast<const bf16x8*>(p); }

__device__ __forceinline__ void mask_tile(f32x16& p0, f32x16& p1, int dq) {
    const float NEG = -__builtin_inff();
#pragma unroll
    for (int r = 0; r < 16; ++r) { const int c = (r & 3) + 8 * (r >> 2);
        if (dq - c < 0) p0[r] = NEG;
        if (dq - c - 32 < 0) p1[r] = NEG; }
}
__device__ __forceinline__ void partialSM(f32x16& p0, f32x16& p1, float& m_reg, float& mn, float& alpha) {
    float pmax = p0[0];
#pragma unroll
    for (int r = 1; r < 16; ++r) pmax = fmaxf(pmax, p0[r]);
#pragma unroll
    for (int r = 0; r < 16; ++r) pmax = fmaxf(pmax, p1[r]);
    { auto rr = __builtin_amdgcn_permlane32_swap(__float_as_uint(pmax), __float_as_uint(pmax), false, false);
      pmax = fmaxf(__uint_as_float(rr[0]), __uint_as_float(rr[1])); }
    if (__builtin_expect(__all((pmax - m_reg) * SCALE <= THR), 1)) { mn = m_reg; alpha = 1.f; }
    else { mn = fmaxf(m_reg, pmax); alpha = __builtin_amdgcn_exp2f((m_reg - mn) * C2); m_reg = mn; }
    const float mnL = -mn * C2;
#pragma unroll
    for (int r = 0; r < 16; ++r) p0[r] = fmaf(p0[r], C2, mnL);
#pragma unroll
    for (int r = 0; r < 16; ++r) p1[r] = fmaf(p1[r], C2, mnL);
#pragma unroll
    for (int r = 0; r < 16; ++r) p0[r] = __builtin_amdgcn_exp2f(p0[r]);
}
__device__ __forceinline__ void finishSM(f32x16& p0, f32x16& p1, float alpha, float& l_reg, bf16x8& pa0, bf16x8& pa1, bf16x8& pa2, bf16x8& pa3) {
#pragma unroll
    for (int r = 0; r < 16; ++r) p1[r] = __builtin_amdgcn_exp2f(p1[r]);
    float ps = 0;
#pragma unroll
    for (int r = 0; r < 16; ++r) ps += p0[r];
#pragma unroll
    for (int r = 0; r < 16; ++r) ps += p1[r];
    { auto rr = __builtin_amdgcn_permlane32_swap(__float_as_uint(ps), __float_as_uint(ps), false, false);
      ps = __uint_as_float(rr[0]) + __uint_as_float(rr[1]); }
    l_reg = l_reg * alpha + ps;
#define PK4(P, B_, OUT) do { unsigned a0 = cvtpk(P[B_+0], P[B_+1]), a1 = cvtpk(P[B_+2], P[B_+3]);                          \
        unsigned b0 = cvtpk(P[B_+4], P[B_+5]), b1 = cvtpk(P[B_+6], P[B_+7]);                                             \
        auto r0 = __builtin_amdgcn_permlane32_swap(a0, b0, false, false); auto r1 = __builtin_amdgcn_permlane32_swap(a1, b1, false, false); \
        u32x4 w = {r0[0], r1[0], r0[1], r1[1]}; OUT = *reinterpret_cast<bf16x8*>(&w); } while (0)
    PK4(p0, 0, pa0); PK4(p0, 8, pa1); PK4(p1, 0, pa2); PK4(p1, 8, pa3);
#undef PK4
}
template <int KB>
__device__ __forceinline__ void qkt(f32x16& p0, f32x16& p1, const char* K_lds, const float* bl, int r32, int hi, const bf16x8* qr) {
#pragma unroll
    for (int g = 0; g < 4; ++g) { const f32x4 b0 = *(const f32x4*)(bl + KB * 64 + 8 * g + 4 * hi), b1 = *(const f32x4*)(bl + KB * 64 + 32 + 8 * g + 4 * hi);
#pragma unroll
        for (int i = 0; i < 4; ++i) { p0[4 * g + i] = b0[i]; p1[4 * g + i] = b1[i]; } }
    const char* kb[4];
#pragma unroll
    for (int dd = 0; dd < 4; ++dd) kb[dd] = K_lds + KB * SHM_K + KSWZ(r32, (dd * 16 + hi * 8) * 2);
#pragma unroll
    for (int d0 = 0; d0 < 8; ++d0) { const char* a = kb[d0 & 3] + (d0 >> 2) * 128;
        bf16x8 b0 = *reinterpret_cast<const bf16x8*>(a);
        bf16x8 b1 = *reinterpret_cast<const bf16x8*>(a + 32 * 256);
        const bf16x8 qf = qr[d0];
        p0 = __builtin_amdgcn_mfma_f32_32x32x16_bf16(b0, qf, p0, 0, 0, 0);
        p1 = __builtin_amdgcn_mfma_f32_32x32x16_bf16(b1, qf, p1, 0, 0, 0); }
}
template <int VB>
__device__ __forceinline__ void pv_tile(f32x16* o, int vb0, bf16x8 pa0, bf16x8 pa1, bf16x8 pa2, bf16x8 pa3) {
#define TRRD(dst, off) asm volatile("ds_read_b64_tr_b16 %0, %1 offset:%2" : "=&v"(dst) : "v"(vb0), "i"(off) : "memory")
#define PV_D0(d0) do { s16x4 l0, l1, l2, l3, h0, h1, h2, h3; constexpr int b_ = VB * SHM_V + v_rd_off(d0, 0, 0); \
        TRRD(l0, b_); TRRD(h0, b_ + 2048); TRRD(l1, b_ + 4096); TRRD(h1, b_ + 6144); TRRD(l2, b_ + 8192); TRRD(h2, b_ + 10240); TRRD(l3, b_ + 12288); TRRD(h3, b_ + 14336); \
        asm volatile("s_waitcnt lgkmcnt(0)" ::: "memory"); SBAR();   \
        o[d0] = __builtin_amdgcn_mfma_f32_32x32x16_bf16(pa0, (bf16x8){l0[0], l0[1], l0[2], l0[3], h0[0], h0[1], h0[2], h0[3]}, o[d0], 0, 0, 0);   \
        o[d0] = __builtin_amdgcn_mfma_f32_32x32x16_bf16(pa1, (bf16x8){l1[0], l1[1], l1[2], l1[3], h1[0], h1[1], h1[2], h1[3]}, o[d0], 0, 0, 0);   \
        o[d0] = __builtin_amdgcn_mfma_f32_32x32x16_bf16(pa2, (bf16x8){l2[0], l2[1], l2[2], l2[3], h2[0], h2[1], h2[2], h2[3]}, o[d0], 0, 0, 0);   \
        o[d0] = __builtin_amdgcn_mfma_f32_32x32x16_bf16(pa3, (bf16x8){l3[0], l3[1], l3[2], l3[3], h3[0], h3[1], h3[2], h3[3]}, o[d0], 0, 0, 0); } while (0)
    PV_D0(0); PV_D0(1); PV_D0(2); PV_D0(3);
#undef PV_D0
#undef TRRD
}

struct Item { unsigned rowb, o; const float* CS; const float* G; int P0, jlo; };
struct Seam { bf16x8 qr[8]; bf16x8 st_v0, st_v1, st_k0, st_k1; };
typedef __amdgpu_buffer_rsrc_t Srd;
#define BL8(rs, vo, so) __builtin_bit_cast(bf16x8, __builtin_amdgcn_raw_buffer_load_b128((rs), (vo), (so), 0))
#define VMW() asm volatile("s_waitcnt vmcnt(0)" ::: "memory")
#define VMWN(n) asm volatile("s_waitcnt vmcnt(%0)" :: "i"(n) : "memory")
#define SLOAD_H(H, k0, bb) do { const unsigned so_ = (unsigned)(k0) * (PITCH * 2);                                               \
                         S.st_v0 = BL8(R, kvoff, (unsigned)WS_FV + (H).rowb + so_); S.st_v1 = BL8(R, kvoff, (unsigned)WS_FV + (H).rowb + so_ + 32 * PITCH * 2);   \
                         S.st_k0 = BL8(R, kvoff, (unsigned)WS_FK + (H).rowb + so_); S.st_k1 = BL8(R, kvoff, (unsigned)WS_FK + (H).rowb + so_ + 32 * PITCH * 2);   \
                         if (wid == 0) __builtin_amdgcn_global_load_lds((const unsigned*)((H).CS + (k0)) + lane, (__attribute__((address_space(3))) unsigned*)(B3 + (bb) * 64), 4, 0, 0); } while (0)
#define QLOAD(H) do { const unsigned so_ = (unsigned)((H).P0 + wid * QBLK) * (PITCH * 2);                                   \
        _Pragma("unroll") for (int d0 = 0; d0 < 8; ++d0) S.qr[d0] = BL8(R, qoff + d0 * 32, (unsigned)WS_FQ + (H).rowb + so_); } while (0)
#define SWRITE_HK(bf) do { *(bf16x8*)(K_lds + (bf) * SHM_K + kws) = S.st_k0; *(bf16x8*)(K_lds + (bf) * SHM_K + kws + 32 * 256) = S.st_k1; } while (0)
#define SWRITE_HV(bf) do { *(bf16x8*)(V_lds + (bf) * SHM_V + vst0) = S.st_v0; *(bf16x8*)(V_lds + (bf) * SHM_V + vst1) = S.st_v1; } while (0)
#define SWRITE_H(bf) do { SWRITE_HV(bf); SWRITE_HK(bf); } while (0)

__device__ __forceinline__ void fox_prime(const Srd R, const Item& H, char* lds, Seam& S, int wv) {
    const int tid = wg_tid(wv), wid = wv, lane = tid & 63, r32 = lane & 31, hi = lane >> 5;
    const int sr = tid >> 4, sc = (tid & 15) * 8, kws = KSWZ(sr, sc * 2); char* K_lds = lds + LDS_K; float* B_lds = (float*)(lds + LDS_BIAS);
    const unsigned kvoff = (unsigned)(sr * PITCH + sc) * 2u, qoff = (unsigned)(r32 * PITCH + hi * 8) * 2u;
    __attribute__((address_space(3))) float* B3 = (__attribute__((address_space(3))) float*)B_lds;
    QLOAD(H);
    SLOAD_H(H, H.jlo * KVBLK, 0); VMW(); SWRITE_HK(0);
    __syncthreads();
}
template <class NextFn>
__device__ __forceinline__ int fox_block(const Srd R, const Item& H, const NextFn& next_item, char* lds, Seam& S, int wv) {
    const int P0 = H.P0;
    const int tid = wg_tid(wv), wid = wv, lane = tid & 63, r32 = lane & 31, hi = lane >> 5;
    const int NT = P0 / KVBLK + 4 - H.jlo;
    const int qlo = P0 + wid * QBLK, qm = qlo + r32 - 4 * hi;
    char* V_lds = lds + LDS_V; char* K_lds = lds + LDS_K; float* B_lds = (float*)(lds + LDS_BIAS);
    float* ws = (float*)(lds + LDS_WS) + wid * 64; float* li_l = ws, * al_l = ws + 32;
    float m_reg = -1e30f, l_reg = 0; f32x16 o[4] = {};
    const int sr = tid >> 4, sc = (tid & 15) * 8, vst0 = v_st(sr, sc), vst1 = v_st(32 + sr, sc), kws = KSWZ(sr, sc * 2);
    const int vb0 = (int)(uintptr_t)V_lds + v_rd_base(lane);
    const unsigned kvoff = (unsigned)(sr * PITCH + sc) * 2u, qoff = (unsigned)(r32 * PITCH + hi * 8) * 2u;
    __attribute__((address_space(3))) float* B3 = (__attribute__((address_space(3))) float*)B_lds;
#define RESC(a) do { if (__any((a) < 1.f)) { if (hi == 0) al_l[r32] = (a); asm volatile("s_waitcnt lgkmcnt(0)" ::: "memory");              \
                     for (int d_ = 0; d_ < 4; ++d_) for (int r = 0; r < 16; ++r) o[d_][r] *= al_l[crow(r, hi)]; } } while (0)
#define KBASE(t) ((H.jlo + (t)) * KVBLK)
#define MASKT(P0_, P1_, t) do { const int kb_ = KBASE(t); if (kb_ + KVBLK - 1 > qlo) mask_tile(P0_, P1_, qm - kb_); } while (0)
    f32x16 pA0, pA1, pB0, pB1; float mnA, mnB, alA, alB; bf16x8 pa0, pa1, pa2, pa3;
    SWRITE_HV(0); SBAR();
    SLOAD_H(H, KBASE(1), 1);
    SBAR(); qkt<0>(pA0, pA1, K_lds, B_lds, r32, hi, S.qr);
    MASKT(pA0, pA1, 0); partialSM(pA0, pA1, m_reg, mnA, alA);
    VMW(); SWRITE_H(1);
    __syncthreads();
#define HALF_STEP(PX0, PX1, mnX, alX, PY0, PY1, alY, t, KB, VB, SB) do {                                                      \
        SBAR(); qkt<KB>(PX0, PX1, K_lds, B_lds, r32, hi, S.qr);                                                                 \
        finishSM(PY0, PY1, alY, l_reg, pa0, pa1, pa2, pa3); SBAR();                                                           \
        if ((t) + 1 < NT) { SLOAD_H(H, KBASE((t) + 1), SB); SBAR(); }                                                                \
        pv_tile<VB>(o, vb0, pa0, pa1, pa2, pa3); MASKT(PX0, PX1, (t)); partialSM(PX0, PX1, m_reg, mnX, alX);                  \
        __syncthreads();                                                                                                      \
        if ((t) + 1 < NT) { VMW(); SWRITE_H(SB); }                                                                      \
        RESC(alX); __syncthreads(); } while (0)
    for (int t = 1; t + 1 < NT; t += 2) {
        HALF_STEP(pB0, pB1, mnB, alB, pA0, pA1, alA, t, 1, 0, 0);
        HALF_STEP(pA0, pA1, mnA, alA, pB0, pB1, alB, t + 1, 0, 1, 1);
    }
    SBAR(); qkt<1>(pB0, pB1, K_lds, B_lds, r32, hi, S.qr); SBAR();
    int nidx; const Item N = next_item(H, nidx);
    SLOAD_H(N, N.jlo * KVBLK, 0); SBAR();
    QLOAD(N);
    SBAR();
    finishSM(pA0, pA1, alA, l_reg, pa0, pa1, pa2, pa3); SBAR();
    pv_tile<0>(o, vb0, pa0, pa1, pa2, pa3);
    MASKT(pB0, pB1, NT - 1); partialSM(pB0, pB1, m_reg, mnB, alB); __syncthreads(); RESC(alB);
    finishSM(pB0, pB1, alB, l_reg, pa0, pa1, pa2, pa3); SBAR(); pv_tile<1>(o, vb0, pa0, pa1, pa2, pa3);
    SBAR(); VMWN(8); SWRITE_HK(0); SBAR();
    if (hi == 0) li_l[r32] = l_reg; asm volatile("s_waitcnt lgkmcnt(0)" ::: "memory");
    float gn[4];
#pragma unroll
    for (int d0 = 0; d0 < 4; ++d0) gn[d0] = H.G[d0 * 32 + r32];
    const unsigned ovoff2 = (unsigned)(4 * hi * OPITCH + (r32 & ~1)) * 2u + ((r32 & 1) ? 64u : 0u);
#pragma unroll
    for (int r = 0; r < 16; ++r) { const float rli = __builtin_amdgcn_rcpf(li_l[crow(r, hi)]); float ss = 0.f;
#pragma unroll
        for (int d0 = 0; d0 < 4; ++d0) { o[d0][r] *= rli; ss += o[d0][r] * o[d0][r]; }
        ss += dppf<0xB1>(ss); ss += dppf<0x4E>(ss); ss += dppf<0x141>(ss); ss += dppf<0x140>(ss);
        ss += __builtin_bit_cast(float, __builtin_amdgcn_ds_swizzle(__builtin_bit_cast(int, ss), 0x401F));
        const float rs = __builtin_amdgcn_rsqf(ss * (1.0f / D) + EPS);
        const unsigned so_ = (unsigned)(P0 + wid * QBLK + (r & 3) + 8 * (r >> 2)) * (OPITCH * 2);
        const bool odd = (r32 & 1) != 0;
#pragma unroll
        for (int dp = 0; dp < 2; ++dp) { const float va = o[2 * dp][r] * rs * gn[2 * dp], vb = o[2 * dp + 1][r] * rs * gn[2 * dp + 1];
            const float rcv = dppf<0xB1>(odd ? va : vb);
            const unsigned w = odd ? cvtpk(rcv, vb) : cvtpk(va, rcv);
            __builtin_amdgcn_raw_buffer_store_b32(w, R, ovoff2 + dp * 128, H.o + so_, 0); } }
    __syncthreads();
    return nidx;
#undef RESC
#undef KBASE
#undef MASKT
#undef HALF_STEP
}
#undef BL8
#undef QLOAD
#undef VMW
#undef VMWN
#undef SLOAD_H
#undef SWRITE_HK
#undef SWRITE_HV
#undef SWRITE_H
#undef KSWZ
#undef SBAR
}
namespace mls {
typedef short bf16x8 __attribute__((ext_vector_type(8)));
typedef short bf16x4 __attribute__((ext_vector_type(4)));
typedef float f32x4 __attribute__((ext_vector_type(4)));
#define MFMA16(a, b, c) __builtin_amdgcn_mfma_f32_16x16x32_bf16((a), (b), (c), 0, 0, 0)

constexpr int CO_CST = 0, CO_VT = 65536, CO_XCH = 98304, CO_LDS_BYTES = CO_XCH + 512;
__device__ __forceinline__ void chunk_out(int b, int h, int c, const bf16* QP, const bf16* KPP, const bf16* VT, const bf16* CST, const float* NST,
                                          const bf16* MO, const float* gain, bf16* concat, __attribute__((address_space(3))) unsigned char* lds, int wv) {
    typedef __attribute__((address_space(3))) unsigned char* lptr;
    const int tid = wg_tid(wv), w = wv, lane = tid & 63, i16 = lane & 15, q = lane >> 4;
    const int tq = w & 3, dvh = w >> 2;
    const size_t R0 = (size_t)b * SEQ + (size_t)c * 64;
    const size_t item = ((size_t)(b * MLH + h) * NCHUNK + c);
    { const bf16* cs = CST + item * MLDV * MLDK; const bf16* vs = VT + item * MLDV * 64;
#pragma unroll
      for (int j = 0; j < 8; ++j) { const int p = w + 8 * j, row = 4 * p + (lane >> 4), lc = (lane & 15) ^ (row & 15);
          __builtin_amdgcn_global_load_lds((const unsigned*)(cs + row * MLDK + lc * 8), (__attribute__((address_space(3))) unsigned*)(lds + CO_CST + p * 1024), 16, 0, 0); }
#pragma unroll
      for (int j = 0; j < 4; ++j) { const int p = w + 8 * j, row = 8 * p + (lane >> 3), lc = (lane & 7) ^ ((row >> 1) & 7);
          __builtin_amdgcn_global_load_lds((const unsigned*)(vs + row * 64 + lc * 8), (__attribute__((address_space(3))) unsigned*)(lds + CO_VT + p * 1024), 16, 0, 0); } }
    const size_t row = R0 + 16 * tq + i16;
    const bf16* qrow = QP + row * 512 + h * MLDK + 8 * q;
    bf16x8 qf[4];
#pragma unroll
    for (int ks = 0; ks < 4; ++ks) qf[ks] = *(const bf16x8*)(qrow + 32 * ks);
    f32x4 st[4];
#pragma unroll
    for (int stile = 0; stile < 4; ++stile) {
        st[stile] = (f32x4){0.f, 0.f, 0.f, 0.f};
        if (stile <= tq) {
            const bf16* krow = KPP + (R0 + 16 * stile + i16) * 512 + h * MLDK + 8 * q;
            bf16x8 kf[4];
#pragma unroll
            for (int ks = 0; ks < 4; ++ks) kf[ks] = *(const bf16x8*)(krow + 32 * ks);
#pragma unroll
            for (int ks = 0; ks < 4; ++ks) st[stile] = MFMA16(kf[ks], qf[ks], st[stile]);
            if (stile == tq) {
#pragma unroll
                for (int r = 0; r < 4; ++r) if (4 * q + r > i16) st[stile][r] = 0.f;
            }
        }
    }
    float den = 0.f;
#pragma unroll
    for (int stile = 0; stile < 4; ++stile) den += (st[stile][0] + st[stile][1]) + (st[stile][2] + st[stile][3]);
    { const float* nrow = NST + item * MLDK + 8 * q;
#pragma unroll
      for (int ks = 0; ks < 4; ++ks) { const f32x4 n0 = *(const f32x4*)(nrow + 32 * ks), n1 = *(const f32x4*)(nrow + 32 * ks + 4);
          const v4u qq = __builtin_bit_cast(v4u, qf[ks]);
          den += bflo(qq[0]) * n0[0] + bfhi(qq[0]) * n0[1] + bflo(qq[1]) * n0[2] + bfhi(qq[1]) * n0[3]
               + bflo(qq[2]) * n1[0] + bfhi(qq[2]) * n1[1] + bflo(qq[3]) * n1[2] + bfhi(qq[3]) * n1[3]; } }
    den += __shfl_xor(den, 16); den += __shfl_xor(den, 32);
    const int dv0 = h * MLDV + dvh * 128 + 4 * q;
    v2u mo2[8];
#pragma unroll
    for (int dt = 0; dt < 8; ++dt) mo2[dt] = *(const v2u*)(MO + row * 1024 + dv0 + 16 * dt);
    bf16x8 pf[2];
#pragma unroll
    for (int p = 0; p < 2; ++p) { v4u wv; wv[0] = pg8::cvt_pk_bf16(st[2 * p][0], st[2 * p][1]); wv[1] = pg8::cvt_pk_bf16(st[2 * p][2], st[2 * p][3]);
        wv[2] = pg8::cvt_pk_bf16(st[2 * p + 1][0], st[2 * p + 1][1]); wv[3] = pg8::cvt_pk_bf16(st[2 * p + 1][2], st[2 * p + 1][3]); pf[p] = __builtin_bit_cast(bf16x8, wv); }
    const int npair = (tq >> 1) + 1;
    asm volatile("s_waitcnt vmcnt(0)" ::: "memory");
    __syncthreads();
    f32x4 num[8];
    const lptr cb = lds + CO_CST + (dvh * 128 + i16) * 256, vb = lds + CO_VT + (dvh * 128 + i16) * 128 + (q & 1) * 8;
    const int vsw = i16 >> 1;
#pragma unroll
    for (int dt = 0; dt < 8; ++dt) {
        f32x4 a = (f32x4){0.f, 0.f, 0.f, 0.f};
#pragma unroll
        for (int p = 0; p < 2; ++p) if (p < npair) {
            const v2u lo = *(const __attribute__((address_space(3))) v2u*)(vb + dt * 16 * 128 + (((4 * p + (q >> 1)) ^ vsw) * 16));
            const v2u hi2 = *(const __attribute__((address_space(3))) v2u*)(vb + dt * 16 * 128 + (((4 * p + 2 + (q >> 1)) ^ vsw) * 16));
            const v4u vv = {lo[0], lo[1], hi2[0], hi2[1]};
            a = MFMA16(__builtin_bit_cast(bf16x8, vv), pf[p], a); }
#pragma unroll
        for (int ks = 0; ks < 4; ++ks) { const bf16x8 cf = *(const __attribute__((address_space(3))) bf16x8*)(cb + dt * 16 * 256 + (((4 * ks + q) ^ i16) * 16)); a = MFMA16(cf, qf[ks], a); }
        num[dt] = a;
    }
    const float rden = 1.0f / fmaxf(fabsf(den), 1.0f);
    float ss = 0.f;
#pragma unroll
    for (int dt = 0; dt < 8; ++dt) { num[dt] = num[dt] * rden; ss += (num[dt][0] * num[dt][0] + num[dt][1] * num[dt][1]) + (num[dt][2] * num[dt][2] + num[dt][3] * num[dt][3]); }
    ss += __shfl_xor(ss, 16); ss += __shfl_xor(ss, 32);
    __attribute__((address_space(3))) float* xch = (__attribute__((address_space(3))) float*)(lds + CO_XCH);
    if (q == 0) xch[w * 16 + i16] = ss;
    __syncthreads();
    const float tot = ss + xch[(w ^ 4) * 16 + i16];
    const float rn = __builtin_amdgcn_rsqf(tot * (1.0f / MLDV) + EPS);
#pragma unroll
    for (int dt = 0; dt < 8; ++dt) { const int dv = dv0 + 16 * dt;
        const f32x4 g4 = *(const f32x4*)(gain + dv);
        const float o0 = num[dt][0] * rn * g4[0] * sigmoidf_(bflo(mo2[dt][0])), o1 = num[dt][1] * rn * g4[1] * sigmoidf_(bfhi(mo2[dt][0]));
        const float o2 = num[dt][2] * rn * g4[2] * sigmoidf_(bflo(mo2[dt][1])), o3 = num[dt][3] * rn * g4[3] * sigmoidf_(bfhi(mo2[dt][1]));
        v2u ov; ov[0] = pg8::cvt_pk_bf16(o0, o1); ov[1] = pg8::cvt_pk_bf16(o2, o3);
        *(v2u*)(concat + row * 2048 + 1024 + dv) = ov; }
    __syncthreads();
}

constexpr int SS_NS = 6, SS_SLOT = 12288, SS_STG = SS_NS * SS_SLOT, SS_STG_PITCH = 144, SS_STG_BYTES = 32 * SS_STG_PITCH;
__device__ __forceinline__ void state_scan(int bh, int sl, const bf16* KT, const bf16* VT, const float* EB, bf16* CST, __attribute__((address_space(3))) unsigned char* lds, int wv, bool do_store = true) {
    typedef __attribute__((address_space(3))) unsigned char* lptr;
    const int tid = wg_tid(wv), w = wv, lane = tid & 63, i16 = lane & 15, q = lane >> 4;
    const int dvs = sl >> 1, dkh = sl & 1;
    const size_t it0 = (size_t)bh * NCHUNK;
    const bf16* kt0 = KT + (it0 * MLDK + 64 * dkh) * 64; const bf16* vt0 = VT + (it0 * MLDV + 32 * dvs) * 64;
    const float ebv = EB[it0 + lane];
    const int prow = lane >> 3, pcol = lane & 7;
    const int p0 = w, p1 = w + 6;
    const int r0 = 8 * p0 + prow, r1 = 8 * (p1 & 7) + prow;
    const unsigned src0 = (unsigned)(r0 * 64 + ((pcol ^ ((r0 >> 1) & 7)) * 8));
    const unsigned src1 = (unsigned)(r1 * 64 + ((pcol ^ ((r1 >> 1) & 7)) * 8));
    const bool p1v = p1 >= 8;
    const bf16* s1base = p1v ? vt0 : kt0; const size_t s1stride = p1v ? (size_t)MLDV * 64 : (size_t)MLDK * 64; const unsigned d1 = p1v ? 8192u + (unsigned)(p1 - 8) * 1024u : (unsigned)p1 * 1024u;
#define SS_DMA(cc, slot) do { const lptr sb_ = lds + (slot) * SS_SLOT;                                                                                        \
        __builtin_amdgcn_global_load_lds((const unsigned*)(kt0 + (size_t)(cc) * MLDK * 64 + src0), (__attribute__((address_space(3))) unsigned*)(sb_ + p0 * 1024), 16, 0, 0);   \
        __builtin_amdgcn_global_load_lds((const unsigned*)(s1base + (size_t)(cc) * s1stride + src1), (__attribute__((address_space(3))) unsigned*)(sb_ + d1), 16, 0, 0); } while (0)
    if (w < 6) {
#pragma unroll
        for (int j = 0; j < SS_NS - 1; ++j) SS_DMA(j, j); }
    f32x4 acc = (f32x4){0.f, 0.f, 0.f, 0.f};
    const int swz = (i16 >> 1) & 7;
    const unsigned aoff = (unsigned)((16 * (w & 3) + i16) * 128), boff = (unsigned)(8192 + (16 * (w >> 2) + i16) * 128);
    const unsigned stw = (unsigned)(SS_STG + (16 * (w >> 2) + i16) * SS_STG_PITCH + (16 * (w & 3) + 4 * q) * 2);
    const int wrow = 16 * (w & 1) + (lane >> 3);
    const unsigned strd = (unsigned)(SS_STG + wrow * SS_STG_PITCH + (lane & 7) * 16);
    bf16* cs = CST + (it0 * MLDV + 32 * dvs + wrow) * MLDK + 64 * dkh + 8 * (lane & 7);
    int slot = 0;
    for (int c = 0; c < NCHUNK; ++c) {
        if (w < 6) asm volatile("s_waitcnt vmcnt(8)" ::: "memory");
        asm volatile("s_waitcnt lgkmcnt(0)" ::: "memory");
        __builtin_amdgcn_s_barrier();
        asm volatile("" ::: "memory");
        if (w < 6) { const int cn = c + SS_NS - 1 < NCHUNK ? c + SS_NS - 1 : NCHUNK - 1; const int sn = slot == 0 ? SS_NS - 1 : slot - 1; SS_DMA(cn, sn); }
        else if (c > 0 && do_store) { const lptr sg = lds + ((c - 1) & 1) * SS_STG_BYTES + strd;
            const v4u s0 = *(const __attribute__((address_space(3))) v4u*)sg, s1 = *(const __attribute__((address_space(3))) v4u*)(sg + 8 * SS_STG_PITCH);
            bf16* cd = cs + (size_t)(c - 1) * MLDV * MLDK; *(v4u*)cd = s0; *(v4u*)(cd + 8 * MLDK) = s1; }
        const lptr sb = lds + slot * SS_SLOT;
        const bf16x8 a0 = *(const __attribute__((address_space(3))) bf16x8*)(sb + aoff + ((q ^ swz) * 16)), a1 = *(const __attribute__((address_space(3))) bf16x8*)(sb + aoff + (((4 + q) ^ swz) * 16));
        const bf16x8 b0 = *(const __attribute__((address_space(3))) bf16x8*)(sb + boff + ((q ^ swz) * 16)), b1 = *(const __attribute__((address_space(3))) bf16x8*)(sb + boff + (((4 + q) ^ swz) * 16));
        v2u ov; ov[0] = pg8::cvt_pk_bf16(acc[0], acc[1]); ov[1] = pg8::cvt_pk_bf16(acc[2], acc[3]);
        if (do_store) *(__attribute__((address_space(3))) v2u*)(lds + (c & 1) * SS_STG_BYTES + stw) = ov; else asm volatile("" :: "v"(ov));
        acc = MFMA16(a0, b0, acc); acc = MFMA16(a1, b1, acc);
        const float e = __builtin_bit_cast(float, __builtin_amdgcn_readlane(__builtin_bit_cast(int, ebv), c));
        acc = acc * e;
        slot = slot == SS_NS - 1 ? 0 : slot + 1;
    }
    asm volatile("s_waitcnt lgkmcnt(0)" ::: "memory");
    __builtin_amdgcn_s_barrier();
    asm volatile("" ::: "memory");
    if (w >= 6 && do_store) { const lptr sg = lds + ((NCHUNK - 1) & 1) * SS_STG_BYTES + strd;
        const v4u s0 = *(const __attribute__((address_space(3))) v4u*)sg, s1 = *(const __attribute__((address_space(3))) v4u*)(sg + 8 * SS_STG_PITCH);
        bf16* cd = cs + (size_t)(NCHUNK - 1) * MLDV * MLDK; *(v4u*)cd = s0; *(v4u*)(cd + 8 * MLDK) = s1; }
    asm volatile("s_waitcnt vmcnt(0) lgkmcnt(0)" ::: "memory");
    __builtin_amdgcn_s_barrier();
#undef SS_DMA
}
#undef MFMA16
}
typedef const float* cfp_t;
struct Frame {
    LAS unsigned char* lds; unsigned char* ldsg;
    int tid, lane, wave, vcu, G;
    const __attribute__((address_space(4))) cfp_t* inp; float* out; unsigned char* ws;
};
__device__ __forceinline__ void refresh_ids(Frame& F) { F.tid = wg_tid(F.wave); F.lane = F.tid & 63; }
__device__ __forceinline__ float wave_incl_scan(float v, int lane) {
#pragma unroll
    for (int o = 1; o < 64; o <<= 1) { const float t = __shfl_up(v, o); if (lane >= o) v += t; }
    return v;
}

#ifndef W_NT_LOAD
#define W_NT_LOAD 1
#endif
#ifndef W_NT_STORE
#define W_NT_STORE 0
#endif
#if W_NT_STORE
#define W_ST(p, v) __builtin_nontemporal_store((v), (p))
#else
#define W_ST(p, v) (*(p) = (v))
#endif
#ifndef P0_T_TWICE
#define P0_T_TWICE 1
#endif
struct TItem { const float* W; const float* gk; unsigned char* dst; float scale; int ldw, K, k0, n0d, n0s, mode; };
__device__ __forceinline__ TItem p0_titem(Frame& F, int r) {
    TItem I; I.gk = nullptr; I.scale = 1.0f; I.mode = 0; I.K = DM; int kt, nb;
    if (r < 768) { kt = r / 24; nb = r % 24; const int grpc = nb >> 2; I.W = F.inp[3]; I.ldw = IN_WIDTH; I.gk = F.inp[2]; I.dst = F.ws + WS_WIN; I.n0s = 256 * nb + (grpc < 3 ? 0 : (grpc < 5 ? 8 : 16)); }
    else if ((r -= 768) < 512) { kt = r >> 4; nb = r & 15; I.W = F.inp[17]; I.ldw = 2 * DM; I.dst = F.ws + WS_WXKV; I.n0s = 256 * nb; I.mode = 1; }
    else if ((r -= 512) < 256) { kt = r >> 3; nb = r & 7; I.W = F.inp[13]; I.ldw = DM; I.dst = F.ws + WS_WOUT; I.n0s = 256 * nb; }
    else if ((r -= 256) < 256) { kt = r >> 3; nb = r & 7; I.W = F.inp[16]; I.ldw = DM; I.gk = F.inp[14]; I.scale = W8_SCALE; I.dst = F.ws + WS_WXQ; I.n0s = 256 * nb; I.mode = 2; }
    else if ((r -= 256) < 256) { kt = r >> 3; nb = r & 7; I.W = F.inp[20]; I.ldw = DM; I.scale = W8_SCALE; I.dst = F.ws + WS_WXO; I.n0s = 256 * nb; I.mode = 2; }
    else if ((r -= 256) < 1024) { kt = r >> 5; nb = r & 31; I.W = F.inp[22]; I.ldw = DFF; I.gk = F.inp[21]; I.dst = F.ws + WS_WUP; I.n0s = 256 * nb; }
    else { r -= 1024; kt = r >> 3; nb = r & 7; I.W = F.inp[23]; I.ldw = DM; I.K = DFF; I.dst = F.ws + WS_WDN; I.n0s = 256 * nb; }
    I.k0 = 64 * kt; I.n0d = 256 * nb; return I;
}
__device__ __forceinline__ void p0_tload(const TItem& I, v4f (&v)[8], int wave, int lane) {
#pragma unroll
    for (int j = 0; j < 8; ++j) { const v4f* src = (const v4f*)(I.W + (size_t)(I.k0 + wave + 8 * j) * I.ldw + I.n0s + 4 * lane);
#if W_NT_LOAD
        v[j] = __builtin_nontemporal_load(src);
#else
        v[j] = *src;
#endif
    }
}
__device__ __forceinline__ void p0_tstage(const TItem& I, const v4f (&v)[8], LAS float* tile, int wave, int lane) {
#pragma unroll
    for (int j = 0; j < 8; ++j) { const int row = wave + 8 * j; const float g = (I.gk ? I.gk[I.k0 + row] : 1.0f) * I.scale;
        *(LAS v4f*)(tile + row * 256 + ((4 * lane) ^ (8 * ((row >> 3) & 7)))) = v[j] * g; }
}
__device__ __forceinline__ void p0_tstore(const TItem& I, const LAS float* tile, int wave, int lane) {
    const int nl = lane >> 3, kg = lane & 7;
#pragma unroll
    for (int i = 0; i < 4; ++i) { const int n = 8 * (wave + 8 * i) + nl; const LAS float* s = tile + (8 * kg) * 256 + (n ^ (8 * kg));
        const float e0 = s[0], e1 = s[256], e2 = s[512], e3 = s[768], e4 = s[1024], e5 = s[1280], e6 = s[1536], e7 = s[1792];
        if (I.mode == 2) { v2u o; o.x = pg8::pk4_fp8(e0, e1, e2, e3); o.y = pg8::pk4_fp8(e4, e5, e6, e7);
            W_ST((GAS v2u*)(I.dst + (size_t)I.n0d * I.K + (size_t)(I.k0 >> 7) * 32768 + n * 128 + (I.k0 & 127) + 8 * kg), o); }
        else { v4u o; o.x = pk2(e0, e1); o.y = pk2(e2, e3); o.z = pk2(e4, e5); o.w = pk2(e6, e7);
            if (I.mode == 0) W_ST((GAS v4u*)((bf16*)I.dst + (size_t)I.n0d * I.K + (size_t)(I.k0 >> 6) * 16384 + n * 64 + 8 * kg), o);
            else W_ST((GAS v4u*)((bf16*)I.dst + (size_t)(I.n0d + n) * I.K + I.k0 + 8 * kg), o); } }
}
#ifndef W_LATE_IN_P4
#define W_LATE_IN_P4 1
#endif
constexpr int W_ITEMS = 4096, W_EARLY = W_LATE_IN_P4 ? 1280 : 4096;
template <bool OPAQUE_LANE = false>
__device__ __forceinline__ void p0_convert(Frame& F, int first, int end, int stride) {
    const int lane_ = OPAQUE_LANE ? (wg_tid(F.wave) & 63) : F.lane;
    v4f ta[8], tb8[8]; int it = first;
    if (it < end) p0_tload(p0_titem(F, it), ta, F.wave, lane_);
    if (it + stride < end) p0_tload(p0_titem(F, it + stride), tb8, F.wave, lane_);
    LAS float* tile0 = (LAS float*)F.lds; LAS float* tile1 = (LAS float*)(F.lds + 65536);
    for (; it < end; it += 2 * stride) {
        p0_tstage(p0_titem(F, it), ta, tile0, F.wave, lane_);
        __syncthreads();
        if (it + 2 * stride < end) p0_tload(p0_titem(F, it + 2 * stride), ta, F.wave, lane_);
        p0_tstore(p0_titem(F, it), tile0, F.wave, lane_);
        if (it + stride < end) {
            p0_tstage(p0_titem(F, it + stride), tb8, tile1, F.wave, lane_);
            __syncthreads();
            if (it + 3 * stride < end) p0_tload(p0_titem(F, it + 3 * stride), tb8, F.wave, lane_);
            p0_tstore(p0_titem(F, it + stride), tile1, F.wave, lane_); }
    }
}
__device__ __forceinline__ void p0_convert1(Frame& F, int first, int end) {
    const int lane = wg_tid(F.wave) & 63;
    v4f ta[8]; int tb = 0;
    p0_tload(p0_titem(F, first), ta, F.wave, lane);
    for (int it = first; it < end; ++it) {
        LAS float* tile = (LAS float*)(F.lds + tb * 65536);
        p0_tstage(p0_titem(F, it), ta, tile, F.wave, lane);
        __syncthreads();
        if (it + 1 < end) p0_tload(p0_titem(F, it + 1), ta, F.wave, lane);
        p0_tstore(p0_titem(F, it), tile, F.wave, lane);
        tb ^= 1;
    }
}
__device__ __forceinline__ float rms_row_to_bf16(const float* xrow, const float* g, bf16* orow, int lane) {
    const GAS v4f* xr = (const GAS v4f*)xrow + lane; const GAS v4f* gr = (const GAS v4f*)g + lane;
    v4f v[8]; float s = 0.f;
#pragma unroll
    for (int j = 0; j < 8; ++j) { v[j] = xr[64 * j]; s += (v[j].x * v[j].x + v[j].y * v[j].y) + (v[j].z * v[j].z + v[j].w * v[j].w); }
    const float rinv = 1.0f / sqrtf(wave_sum(s) * (1.f / DM) + EPS);
    GAS v2u* o8 = (GAS v2u*)orow + lane;
#pragma unroll
    for (int j = 0; j < 8; ++j) { const v4f gg = gr[64 * j]; v2u w; w.x = pk2(v[j].x * rinv * gg.x, v[j].y * rinv * gg.y); w.y = pk2(v[j].z * rinv * gg.z, v[j].w * rinv * gg.w); o8[64 * j] = w; }
    return rinv;
}
__device__ __forceinline__ void p0_prologue(Frame& F) {
    refresh_ids(F);
    const float* x = F.inp[0]; const float* mem = F.inp[1]; const float* mixer_norm = F.inp[2]; const float* w_in = F.inp[3];
    const int gw = F.vcu * 8 + F.wave, NGW = F.G * 8;
    LAS float* WgL = (LAS float*)F.lds; const int khw = F.vcu & 1;
#pragma unroll 8
    for (int idx = F.tid; idx < 16384; idx += NTHREADS) { const int e = idx & 7, ln = (idx >> 3) & 63, sp = idx >> 9, gate = ln & 15, q = ln >> 4, k = 1024 * khw + 32 * sp + 8 * q + e;
        const int col = gate < 8 ? 3072 + gate : 5128 + (gate - 8);
        WgL[idx] = w_in[(size_t)k * IN_WIDTH + col] * mixer_norm[k]; }
    __syncthreads();
    { float* gates = (float*)(F.ws + WS_GATES); float* ssqx = (float*)(F.ws + WS_CTL + CTL_SSQX); bf16* XG = (bf16*)(F.ws + WS_XN);
      const int i16 = F.lane & 15, q = F.lane >> 4;
      for (int grp = (F.vcu >> 1) * 8 + F.wave; grp < MTOK / 16; grp += (F.G >> 1) * 8) { const int kh = khw; const size_t row = (size_t)grp * 16 + i16;
          const float* xr = x + row * DM + kh * 1024 + 8 * q; bf16* xo = XG + row * DM + kh * 1024 + 8 * q;
          const LAS float* wp = WgL + F.lane * 8;
          v4f acc = (v4f){0.f, 0.f, 0.f, 0.f}; float ss = 0.f;
#pragma unroll 1
          for (int s0 = 0; s0 < 32; s0 += 8, wp += 8 * 512, xr += 8 * 32, xo += 8 * 32) { v4f xb[8][2];
#pragma unroll
              for (int j = 0; j < 8; ++j) { xb[j][0] = *(const v4f*)(xr + 32 * j); xb[j][1] = *(const v4f*)(xr + 32 * j + 4); }
#pragma unroll
              for (int j = 0; j < 8; ++j) { const v4f x0 = xb[j][0], x1 = xb[j][1];
                  const v4f w0 = *(const LAS v4f*)(wp + j * 512), w1 = *(const LAS v4f*)(wp + j * 512 + 4);
                  ss += (x0.x * x0.x + x0.y * x0.y) + (x0.z * x0.z + x0.w * x0.w) + (x1.x * x1.x + x1.y * x1.y) + (x1.z * x1.z + x1.w * x1.w);
                  v4u o; o.x = pk2(x0.x, x0.y); o.y = pk2(x0.z, x0.w); o.z = pk2(x1.x, x1.y); o.w = pk2(x1.z, x1.w);
                  *(v4u*)(xo + 32 * j) = o;
                  acc = __builtin_amdgcn_mfma_f32_16x16x4f32(x0.x, w0.x, acc, 0, 0, 0); acc = __builtin_amdgcn_mfma_f32_16x16x4f32(x0.y, w0.y, acc, 0, 0, 0);
                  acc = __builtin_amdgcn_mfma_f32_16x16x4f32(x0.z, w0.z, acc, 0, 0, 0); acc = __builtin_amdgcn_mfma_f32_16x16x4f32(x0.w, w0.w, acc, 0, 0, 0);
                  acc = __builtin_amdgcn_mfma_f32_16x16x4f32(x1.x, w1.x, acc, 0, 0, 0); acc = __builtin_amdgcn_mfma_f32_16x16x4f32(x1.y, w1.y, acc, 0, 0, 0);
                  acc = __builtin_amdgcn_mfma_f32_16x16x4f32(x1.z, w1.z, acc, 0, 0, 0); acc = __builtin_amdgcn_mfma_f32_16x16x4f32(x1.w, w1.w, acc, 0, 0, 0); } }
          ss += __shfl_xor(ss, 16); ss += __shfl_xor(ss, 32);
          if (q == 0) atomicAdd(ssqx + row, ss);
#pragma unroll
          for (int r = 0; r < 4; ++r) atomicAdd(gates + ((size_t)grp * 16 + 4 * q + r) * 16 + i16, acc[r]);
      } }
    { bf16* MN = (bf16*)(F.ws + WS_MN);
      for (int m = gw; m < MROWS; m += NGW) (void)rms_row_to_bf16(mem + (size_t)m * DM, F.inp[15], MN + (size_t)m * DM, F.lane); }
    __syncthreads();
    p0_convert(F, F.vcu, W_EARLY, F.G);
}

constexpr int P2_KT_OFF = 4096, P2_KT_PITCH = 128, P2_VT_OFF = P2_KT_OFF + 64 * P2_KT_PITCH * 2, P2_VT_PITCH = 256;
constexpr int P2_BUF_ELEMS = (64 * P2_KT_PITCH + 64 * P2_VT_PITCH);
__device__ __forceinline__ void p2_prep_item(Frame& F, int item, bool do_norm = true) {
    refresh_ids(F);
    const int b = item >> 6, c = item & 63; const size_t R0 = (size_t)b * SEQ + (size_t)c * 64;
    const int tid = F.tid, lane = F.lane, w = F.wave;
    LAS float* gq = (LAS float*)F.lds; LAS float* uk = gq + 256;
    LAS bf16* kt = (LAS bf16*)(F.lds + P2_KT_OFF); LAS bf16* vt = (LAS bf16*)(F.lds + P2_VT_OFF);
    const float* GATES = (const float*)(F.ws + WS_GATES); const float* SSQX = (const float*)(F.ws + WS_CTL + CTL_SSQX);
    const bf16* MQK = (const bf16*)(F.ws + WS_MQK); const bf16* MV = (const bf16*)(F.ws + WS_MV);
    bf16* QP = (bf16*)((unsigned char*)F.out + WS_QP); bf16* KPP = (bf16*)((unsigned char*)F.out + WS_KPP);
    const float* conv_w = F.inp[7]; const float* conv_b = F.inp[8];
    const int cgp = tid & 31, rg = tid >> 5; const bool isq = cgp < 16;
    v4u rawc[7], rawv[4];
#define P2_LOAD(h_) do { const int col_ = (isq ? 0 : 512) + (h_) * MLDK + (cgp & 15) * 8;                                              \
        _Pragma("unroll") for (int i = 0; i < 7; ++i) { const int pos = c * 64 + 4 * rg - 3 + i;                                           \
            rawc[i] = (v4u){0u, 0u, 0u, 0u}; if (pos >= 0) rawc[i] = *(const v4u*)(MQK + ((size_t)b * SEQ + pos) * 1024 + col_); }            \
        _Pragma("unroll") for (int i = 0; i < 4; ++i) { const int idx = tid + NTHREADS * i, row = idx >> 5, ch = idx & 31;                 \
            rawv[i] = *(const v4u*)(MV + (R0 + row) * 1024 + (h_) * MLDV + ch * 8); } } while (0)
#define P2_CONV(h_, kt_, vt_) do { const int col_ = (isq ? 0 : 512) + (h_) * MLDK + (cgp & 15) * 8;                                       \
        float cw[4][8], cb[8];                                                                                                             \
        _Pragma("unroll") for (int e = 0; e < 8; ++e) { cb[e] = conv_b[col_ + e];                                                          \
            _Pragma("unroll") for (int j = 0; j < 4; ++j) cw[j][e] = conv_w[j * 1024 + col_ + e]; }                                        \
        float u[7][8];                                                                                                                     \
        _Pragma("unroll") for (int i = 0; i < 7; ++i) _Pragma("unroll") for (int e = 0; e < 4; ++e) { u[i][2 * e] = bflo(rawc[i][e]); u[i][2 * e + 1] = bfhi(rawc[i][e]); } \
        _Pragma("unroll") for (int r = 0; r < 4; ++r) { const int t = 4 * rg + r; const float f = isq ? gq[(h_) * 64 + t] : uk[(h_) * 64 + t]; float y[8]; \
            _Pragma("unroll") for (int e = 0; e < 8; ++e) { float a = cb[e];                                                               \
                _Pragma("unroll") for (int j = 0; j < 4; ++j) a += cw[j][e] * u[r + j][e];                                                 \
                y[e] = a * sigmoidf_(a) * f; }                                                                                             \
            v4u o; o.x = pk2(y[0], y[1]); o.y = pk2(y[2], y[3]); o.z = pk2(y[4], y[5]); o.w = pk2(y[6], y[7]);                             \
            *(v4u*)((isq ? QP : KPP) + (R0 + t) * 512 + (h_) * MLDK + (cgp & 15) * 8) = o;                                                 \
            if (!isq) *(LAS v4u*)((kt_) + t * P2_KT_PITCH + (((cgp & 15) ^ ((t >> 3) & 7)) * 8)) = o; }                                                         \
        _Pragma("unroll") for (int i = 0; i < 4; ++i) { const int idx = tid + NTHREADS * i, row = idx >> 5, ch = idx & 31;                 \
            *(LAS v4u*)((vt_) + row * P2_VT_PITCH + ((ch ^ ((row >> 3) & 7)) * 8)) = rawv[i]; } } while (0)
    P2_LOAD(0);
    float a_mi = 0.f, a_mf = 0.f, a_ss = 1.f;
    if (w < 4) { const size_t row = R0 + lane; a_mi = GATES[row * 16 + 8 + w]; a_mf = GATES[row * 16 + 12 + w]; a_ss = SSQX[row]; }
    { const int mr = item * 4 + (w & 3); const bf16* slab = (const bf16*)(F.ws + WS_SLAB);
      if (w < 4) {
        const float* gxq = F.inp[18]; const float* gxk = F.inp[19];
        v4f kv[8]; float ssh[4] = {0.f, 0.f, 0.f, 0.f};
#pragma unroll
        for (int j = 0; j < 8; ++j) { const int col = 4 * (lane + 64 * j); v4f a = (v4f){0.f, 0.f, 0.f, 0.f};
#pragma unroll
            for (int s = 0; s < 4; ++s) { const v2u r2 = *(const v2u*)(slab + ((size_t)s * MROWS + mr) * 4096 + col); a = a + (v4f){bflo(r2.x), bfhi(r2.x), bflo(r2.y), bfhi(r2.y)}; }
            kv[j] = a; ssh[j >> 1] += (a.x * a.x + a.y * a.y) + (a.z * a.z + a.w * a.w); }
        float rk[4];
#pragma unroll
        for (int hh = 0; hh < 4; ++hh) rk[hh] = 1.0f / sqrtf(wave_sum(ssh[hh]) * (1.0f / XD) + EPS);
        unsigned char* KH = F.ws + WS_KHAT + (size_t)mr * DM;
#pragma unroll
        for (int j = 0; j < 8; ++j) { const int col = 4 * (lane + 64 * j), d = col & (XD - 1); const v4f a = *(const v4f*)(gxq + d), g2 = *(const v4f*)(gxk + d); const float r = rk[j >> 1];
            const float r8 = r * KH8_SCALE;
            *(unsigned*)(KH + col) = pg8::pk4_fp8(kv[j].x * r8 * a.x * g2.x, kv[j].y * r8 * a.y * g2.y, kv[j].z * r8 * a.z * g2.z, kv[j].w * r8 * a.w * g2.w); }
      } else {
        unsigned char* VTM = F.ws + WS_VTM; const int bm = mr >> 8, key = mr & 255;
        v4f vv[8];
#pragma unroll
        for (int j = 0; j < 8; ++j) { const int dcol = 4 * (lane + 64 * j); v4f a = (v4f){0.f, 0.f, 0.f, 0.f};
#pragma unroll
            for (int s = 0; s < 4; ++s) { const v2u r2 = *(const v2u*)(slab + ((size_t)s * MROWS + mr) * 4096 + 2048 + dcol); a = a + (v4f){bflo(r2.x), bfhi(r2.x), bflo(r2.y), bfhi(r2.y)}; }
            vv[j] = a; }
#pragma unroll
        for (int j = 0; j < 8; ++j) { const int dcol = 4 * (lane + 64 * j); const v4f a = vv[j];
            const int hh = dcol >> 9, d = dcol & (XD - 1); unsigned char* vp = VTM + ((size_t)(bm * XH + hh) * XD + d) * NMEM + key;
            const unsigned q4 = pg8::pk4_fp8(a.x * V8_SCALE, a.y * V8_SCALE, a.z * V8_SCALE, a.w * V8_SCALE);
            vp[0] = (unsigned char)q4; vp[NMEM] = (unsigned char)(q4 >> 8); vp[2 * NMEM] = (unsigned char)(q4 >> 16); vp[3 * NMEM] = (unsigned char)(q4 >> 24); }
      } }
    if (w < 4) { const float ri = 1.0f / sqrtf(a_ss * (1.0f / DM) + EPS);
        const float mi = a_mi * ri + F.inp[5][w], mf = a_mf * ri + F.inp[6][w];
        const float bcum = wave_incl_scan(logsigmoidf(mf), lane);
        const float g = __expf(bcum), u = __expf(mi - bcum) * 0.08838834764831845f;
        gq[w * 64 + lane] = g; uk[w * 64 + lane] = u;
        if (lane == 63) ((float*)(F.ws + WS_EB))[(size_t)(b * MLH + w) * NCHUNK + c] = g; }
    if (do_norm) { bf16* FQ = (bf16*)(F.ws + WS_FQ); bf16* FK = (bf16*)(F.ws + WS_FK); const int l16 = lane & 15;
      float gqn[8], gkn[8];
#pragma unroll
      for (int e = 0; e < 8; ++e) { gqn[e] = F.inp[9][l16 * 8 + e]; gkn[e] = F.inp[10][l16 * 8 + e]; }
      for (int it0 = w; it0 < 256; it0 += 64) {
          v4u raw[8];
#pragma unroll
          for (int j = 0; j < 8; ++j) { const int seg = (it0 + 8 * j) * 4 + (lane >> 4), row = seg >> 4, hh = seg & 15;
              raw[j] = *(const v4u*)((hh < 8 ? FQ : FK) + (R0 + row) * 1024 + (hh & 7) * FOXD + l16 * 8); }
#pragma unroll
          for (int j = 0; j < 8; ++j) { const int seg = (it0 + 8 * j) * 4 + (lane >> 4), row = seg >> 4, hh = seg & 15;
              bf16* p = (hh < 8 ? FQ : FK) + (R0 + row) * 1024 + (hh & 7) * FOXD + l16 * 8; float v[8];
#pragma unroll
              for (int e = 0; e < 4; ++e) { v[2 * e] = bflo(raw[j][e]); v[2 * e + 1] = bfhi(raw[j][e]); }
              float ss = 0.f;
#pragma unroll
              for (int e = 0; e < 8; ++e) ss += v[e] * v[e];
              ss += __shfl_xor(ss, 1); ss += __shfl_xor(ss, 2); ss += __shfl_xor(ss, 4); ss += __shfl_xor(ss, 8);
              const float ri = 1.0f / sqrtf(ss * (1.0f / FOXD) + EPS);
              v4u o;
#pragma unroll
              for (int e = 0; e < 4; ++e) { const float g0 = hh < 8 ? gqn[2 * e] : gkn[2 * e], g1 = hh < 8 ? gqn[2 * e + 1] : gkn[2 * e + 1]; o[e] = pk2(v[2 * e] * ri * g0, v[2 * e + 1] * ri * g1); }
              *(v4u*)p = o; } } }
    __syncthreads();
    P2_CONV(0, kt, vt);
    __syncthreads();
    for (int h = 0; h < MLH; ++h) {
        LAS bf16* ktc = kt + (h & 1) * P2_BUF_ELEMS; LAS bf16* vtc = vt + (h & 1) * P2_BUF_ELEMS;
        LAS bf16* ktn = kt + ((h + 1) & 1) * P2_BUF_ELEMS; LAS bf16* vtn = vt + ((h + 1) & 1) * P2_BUF_ELEMS;
        if (h + 1 < MLH) P2_LOAD(h + 1);
        const size_t itemh = (size_t)(b * MLH + h) * NCHUNK + c;
        { bf16* KT = (bf16*)((unsigned char*)F.out + WS_KT) + itemh * MLDK * 64;
#pragma unroll
          for (int i = 0; i < 2; ++i) { const int idx = tid + NTHREADS * i, d = idx >> 3, sg = idx & 7; unsigned short e8[8];
#pragma unroll
              for (int e = 0; e < 8; ++e) e8[e] = ktc[(8 * sg + e) * P2_KT_PITCH + (((d >> 3) ^ sg) << 3) + (d & 7)];
              v4u o; o.x = e8[0] | ((unsigned)e8[1] << 16); o.y = e8[2] | ((unsigned)e8[3] << 16); o.z = e8[4] | ((unsigned)e8[5] << 16); o.w = e8[6] | ((unsigned)e8[7] << 16);
              *(v4u*)(KT + d * 64 + 8 * sg) = o; }
          bf16* VT = (bf16*)((unsigned char*)F.out + WS_VT) + itemh * MLDV * 64;
#pragma unroll
          for (int i = 0; i < 4; ++i) { const int idx = tid + NTHREADS * i, dv = idx >> 3, sg = idx & 7; unsigned short e8[8];
#pragma unroll
              for (int e = 0; e < 8; ++e) e8[e] = vtc[(8 * sg + e) * P2_VT_PITCH + (((dv >> 3) ^ sg) << 3) + (dv & 7)];
              v4u o; o.x = e8[0] | ((unsigned)e8[1] << 16); o.y = e8[2] | ((unsigned)e8[3] << 16); o.z = e8[4] | ((unsigned)e8[5] << 16); o.w = e8[6] | ((unsigned)e8[7] << 16);
              *(v4u*)(VT + dv * 64 + 8 * sg) = o; }
          if (tid < MLDK) { float s = 0.f;
#pragma unroll 8
              for (int t = 0; t < 64; ++t) s += bf2f(ktc[t * P2_KT_PITCH + (((tid >> 3) ^ ((t >> 3) & 7)) << 3) + (tid & 7)]);
              ((float*)(F.ws + WS_KSUM))[itemh * MLDK + tid] = s; } }
        if (h + 1 < MLH) P2_CONV(h + 1, ktn, vtn);
        __syncthreads();
    }
#undef P2_LOAD
#undef P2_CONV
    __syncthreads();
}

__device__ __forceinline__ void p3_scan_item(Frame& F, int item) {
    refresh_ids(F);
    if (item < 256) { for (int rep = 0; rep < P3_SCAN_REP; ++rep)
        mls::state_scan(item >> 4, item & 15, (const bf16*)((unsigned char*)F.out + WS_KT), (const bf16*)((unsigned char*)F.out + WS_VT), (const float*)(F.ws + WS_EB), (bf16*)(F.ws + WS_CST), F.lds, F.wave, rep == P3_SCAN_REP - 1); return; }
    const int bh = item - 288, sl = item >= 288 ? 0 : 1;
    if (sl == 0 && F.tid < MLDK) {
        const float* EB = (const float*)(F.ws + WS_EB) + (size_t)bh * NCHUNK; const float* KS = (const float*)(F.ws + WS_KSUM) + (size_t)bh * NCHUNK * MLDK + F.tid;
        float* NS = (float*)(F.ws + WS_NST) + (size_t)bh * NCHUNK * MLDK + F.tid; float n = 0.f;
        float ks[NCHUNK], eb[NCHUNK];
#pragma unroll
        for (int c = 0; c < NCHUNK; ++c) { ks[c] = KS[(size_t)c * MLDK]; eb[c] = EB[c]; }
#pragma unroll
        for (int c = 0; c < NCHUNK; ++c) { NS[(size_t)c * MLDK] = n; n = eb[c] * (n + ks[c]); }
    }
    if (sl == 1) {
        const int seq = item - 256, b = seq >> 3, fh = seq & 7;
        const float* GATES = (const float*)(F.ws + WS_GATES); const float* SSQX = (const float*)(F.ws + WS_CTL + CTL_SSQX); const float fb = F.inp[4][fh];
        const size_t r0 = (size_t)b * SEQ + 8 * F.tid; float lf[8]; float tot = 0.f;
#pragma unroll
        for (int j = 0; j < 8; ++j) { lf[j] = logsigmoidf(GATES[(r0 + j) * 16 + fh] * rinv_of(SSQX, r0 + j) + fb); tot += lf[j]; }
        const float incl = wave_incl_scan(tot, F.lane);
        LAS float* wt = (LAS float*)F.lds;
        __syncthreads();
        if (F.lane == 63) wt[F.wave] = incl;
        __syncthreads();
        float run = incl - tot;
        for (int wv = 0; wv < F.wave; ++wv) run += wt[wv];
        float* C = (float*)(F.ws + WS_CFOX) + (size_t)seq * SEQ + 8 * F.tid;
        float cs[8];
#pragma unroll
        for (int j = 0; j < 8; ++j) { run += lf[j]; cs[j] = run * -11.313708498984761f; C[j] = cs[j]; }
        LAS float* cp0 = wt + 16; LAS float* cend = wt + 32; LAS float* thr = wt + 96;
        if ((F.tid & 31) == 0) cp0[F.tid >> 5] = cs[0];
        if ((F.tid & 7) == 7) cend[F.tid >> 3] = cs[7];
        if (F.wave == 0) { float gq = fmaxf(fabsf(F.inp[9][F.lane]), fabsf(F.inp[9][F.lane + 64])), gk = fmaxf(fabsf(F.inp[10][F.lane]), fabsf(F.inp[10][F.lane + 64]));
#pragma unroll
            for (int o = 1; o < 64; o <<= 1) { gq = fmaxf(gq, __shfl_xor(gq, o)); gk = fmaxf(gk, __shfl_xor(gk, o)); }
            if (F.lane == 0) thr[0] = 2.0f * 11.313708498984761f * gq * gk + 29.0f; }
        __syncthreads();
        if (F.tid < 16) { const int qb = F.tid; const float T = thr[0], c0 = cp0[qb]; int j = 0;
            while (j < 4 * qb && (c0 - cend[j]) * 0.08838834764831845f > T) ++j;
            ((int*)(F.ws + WS_JLO))[seq * 16 + qb] = JLO_DISABLE ? 0 : (j & ~1); }
        __syncthreads();
    }
}
#ifndef MK_PER_PHASE
#define MK_PER_PHASE 0
#endif
#define XB_TMO      128
#define XB_XCNT(j)  (256  + 64 * (j))
#define XB_XSUB(j)  (1280 + 64 * (j))
#define XB_XGEN(j)  (2304 + 64 * (j))
#define XB_TOP      3328
#define XB_TOPGEN   3392
#define XCD_BAR_WORDS 3456
#define XB_SPIN_CAP (1u << 20)
__device__ __forceinline__ unsigned xb_ld(unsigned* p)              { return __hip_atomic_load(p, __ATOMIC_RELAXED, __HIP_MEMORY_SCOPE_AGENT); }
__device__ __forceinline__ unsigned xb_add(unsigned* p, unsigned v) { return __hip_atomic_fetch_add(p, v, __ATOMIC_RELAXED, __HIP_MEMORY_SCOPE_AGENT); }
__device__ __forceinline__ unsigned xb_xcc_id() { return (unsigned)__builtin_amdgcn_s_getreg((3 << 11) | 20) & 0xFu; }
#define XB_SPIN(cond, bar) do { unsigned _sp = 0; while (cond) { __builtin_amdgcn_s_sleep(1); \
    if ((++_sp & 255u) == 0u) { if (xb_ld(&(bar)[XB_TMO])) break; if (_sp > XB_SPIN_CAP) { atomicAdd(&(bar)[XB_TMO], 1u); break; } } } } while (0)
struct XcdBarrier { unsigned* bar; unsigned x; volatile LAS unsigned* st; int wv; };
__device__ __forceinline__ XcdBarrier xcd_barrier_post(unsigned* bar, volatile LAS unsigned* st, int wv) {
    XcdBarrier b; b.bar = bar; b.x = xb_xcc_id(); b.st = st; b.wv = wv;
    if (wv == 0 && lane_id() == 0) (void)xb_add(&bar[XB_XCNT(b.x)], 1u);
    return b;
}
__device__ __forceinline__ void xcd_barrier_complete(unsigned* bar, unsigned x, unsigned& nloc, unsigned& nx) {
    const unsigned G = gridDim.x * gridDim.y * gridDim.z;
    unsigned sum, cnt, mine, sp = 0u;
    for (;;) {
        sum = 0u; cnt = 0u; mine = 0u;
#pragma unroll
        for (unsigned j = 0; j < 16; ++j) { const unsigned c = xb_ld(&bar[XB_XCNT(j)]); sum += c; cnt += (c > 0u) ? 1u : 0u; mine = (j == x) ? c : mine; }
        if (sum == G) break;
        __builtin_amdgcn_s_sleep(1);
        if ((++sp & 255u) == 0u) { if (xb_ld(&bar[XB_TMO])) break; if (sp > XB_SPIN_CAP) { atomicAdd(&bar[XB_TMO], 1u); break; } }
    }
    nloc = mine > 0u ? mine : 1u; nx = cnt > 0u ? cnt : 1u;
}
__device__ __forceinline__ void xcd_barrier(const XcdBarrier& b) {
    asm volatile("s_waitcnt vmcnt(0)" ::: "memory");
    __syncthreads();
    if (b.wv == 0 && lane_id() == 0) {
        unsigned* bar = b.bar;
        __builtin_amdgcn_s_waitcnt(0);
        unsigned nloc = b.st[0], nx = b.st[1];
        if (nloc == 0u) { xcd_barrier_complete(bar, b.x, nloc, nx); b.st[0] = nloc; b.st[1] = nx; }
        const unsigned old = xb_add(&bar[XB_XSUB(b.x)], 1u);
        const unsigned gen = old / nloc;
        if (old + 1u == (gen + 1u) * nloc) {
            __builtin_amdgcn_fence(__ATOMIC_RELEASE, "agent");
            asm volatile("s_waitcnt vmcnt(0)" ::: "memory");
            const unsigned og = xb_add(&bar[XB_TOP], 1u);
            const unsigned tg = og / nx;
            if (og + 1u == (tg + 1u) * nx) xb_add(&bar[XB_TOPGEN], 1u);
            else XB_SPIN(xb_ld(&bar[XB_TOPGEN]) == tg, bar);
            __builtin_amdgcn_fence(__ATOMIC_ACQUIRE, "agent");
            xb_add(&bar[XB_XGEN(b.x)], 1u);
            asm volatile("s_waitcnt vmcnt(0)" ::: "memory");
        } else {
            XB_SPIN(xb_ld(&bar[XB_XGEN(b.x)]) == gen, bar);
            __builtin_amdgcn_fence(__ATOMIC_ACQUIRE, "agent");
            asm volatile("s_waitcnt vmcnt(0)" ::: "memory");
        }
    }
    __syncthreads();
}
constexpr int LDS_MISC_OFF = LDS_BYTES - 256;
#ifndef ML_TWICE
#define ML_TWICE 1
#endif
#ifndef TWICE_P5
#define TWICE_P5 0
#endif
#ifndef TWICE_P6
#define TWICE_P6 0
#endif
#ifndef TWICE_P8
#define TWICE_P8 0
#endif
#ifndef STAGGER_TICKS
#define STAGGER_TICKS 0
#endif
#ifndef P1_WGM
#define P1_WGM 8
#endif
#ifndef P5_WGM
#define P5_WGM 8
#endif
#ifndef P10_WGM
#define P10_WGM 8
#endif
#ifndef MLP_SPLIT
#define MLP_SPLIT 0
#endif
#ifndef P10S_WGM
#define P10S_WGM 4
#endif
#ifndef P11_WGM
#define P11_WGM 8
#endif
#ifndef KREV_P11
#define KREV_P11 1
#endif
#ifndef P4_CV_DEEP
#define P4_CV_DEEP 0
#endif
#ifndef P4_CONV_FIRST
#define P4_CONV_FIRST 0
#endif
#ifndef P4_CVB
#define P4_CVB 2
#endif
#ifndef P4_TWICE
#define P4_TWICE 1
#endif
#ifndef TWICE_P11
#define TWICE_P11 0
#endif
#ifndef TWICE_P10
#define TWICE_P10 0
#endif
#ifndef TWICE_P1
#define TWICE_P1 0
#endif
#ifndef JLO_DISABLE
#define JLO_DISABLE 0
#endif
constexpr int N_PHASES = 12;
struct Args { const float* in[24]; float* out; unsigned char* ws; int ph_lo, ph_hi; };
static_assert(sizeof(Args) == 24 * 8 + 8 + 8 + 8, "Args has no padding");

__global__ void __launch_bounds__(NTHREADS, 2) fwd_kernel(Args args) {
    extern __shared__ __attribute__((aligned(16))) unsigned char lds[];
    Frame F;
    F.lds = (LAS unsigned char*)lds; F.ldsg = lds;
    F.wave = __builtin_amdgcn_readfirstlane((int)(threadIdx.x >> 6)); F.lane = lane_id(); F.tid = F.wave * 64 + F.lane;
    F.G = gridDim.x; { const int bx = blockIdx.x; F.vcu = (F.G % 8 == 0) ? (bx % 8) * (F.G / 8) + bx / 8 : bx; }
    F.inp = (const __attribute__((address_space(4))) cfp_t*)__builtin_amdgcn_kernarg_segment_ptr();
    F.out = args.out; F.ws = args.ws;
    unsigned char* ws = args.ws;
    const int lo = args.ph_lo, hi = args.ph_hi;
    volatile LAS unsigned* MISC = (volatile LAS unsigned*)(F.lds + LDS_MISC_OFF);
    if (F.tid < 64) MISC[F.tid] = 0u;
    __syncthreads();
    XcdBarrier xbar; xbar.bar = (unsigned*)(ws + WS_CTL); xbar.x = 0; xbar.st = nullptr; xbar.wv = F.wave;
    if (hi - lo > 1) xbar = xcd_barrier_post((unsigned*)(ws + WS_CTL), MISC, F.wave);
#ifndef PHASE_MASK
#define PHASE_MASK 0xfff
#endif
#define IN(k) ((((PHASE_MASK) >> (k)) & 1) && lo <= (k) && (k) < hi)
#ifndef DUP_PHASE
#define DUP_PHASE 99
#endif
#define REP(k) for (int rep_ = 0; rep_ < ((k) == DUP_PHASE ? 2 : 1); ++rep_, ((k) == DUP_PHASE && rep_ < 2 ? xcd_barrier(xbar) : (void)0))
#define SEAM(k) do { if (IN(k) && IN((k) + 1)) { xcd_barrier(xbar); } } while (0)
    if (__builtin_expect(lo < 0, 0)) cg::this_grid().sync();
    float* SSQ1 = (float*)(ws + WS_CTL + CTL_SSQ1); float* SSQ2 = (float*)(ws + WS_CTL + CTL_SSQ2); float* SSQQ = (float*)(ws + WS_CTL + CTL_SSQQ);

#ifdef PROBE_PHASE
    unsigned long long pt0 = 0, pt1 = 0, pu0 = 0, pu1 = 0;
#ifndef PROBE_B
#define PROBE_B 99
#endif
#define STAMP(k) do { if ((k) == PROBE_PHASE) pt0 = __builtin_amdgcn_s_memrealtime(); if ((k) == PROBE_PHASE + 1) pt1 = __builtin_amdgcn_s_memrealtime(); \
                      if ((k) == PROBE_B) pu0 = __builtin_amdgcn_s_memrealtime(); if ((k) == PROBE_B + 1) pu1 = __builtin_amdgcn_s_memrealtime(); } while (0)
#else
#define STAMP(k) do {} while (0)
#endif
    STAMP(0);
#ifdef CLK_PHASE
    unsigned long long ck0 = 0, ck1 = 0, cr0 = 0, cr1 = 0;
#define CLKS(k) do { if ((k) == CLK_PHASE) { ck0 = __builtin_amdgcn_s_memtime(); cr0 = __builtin_amdgcn_s_memrealtime(); } if ((k) == CLK_PHASE + 1) { ck1 = __builtin_amdgcn_s_memtime(); cr1 = __builtin_amdgcn_s_memrealtime(); } } while (0)
#else
#define CLKS(k) do {} while (0)
#endif
    CLKS(0);
    if (IN(0)) REP(0) { p0_prologue(F); }
    SEAM(0); STAMP(1); CLKS(1);
    if (IN(1)) REP(1) {
        { pg8::Gemm g{ws, (unsigned)WS_XN, (unsigned)WS_WIN, DM, 64, DM, 0, 128u, 32768u}; pg8::StdOrder S; S.init(MTOK, NPROJ, DM, DM, F.G, (int)blockIdx.x, TWICE_P1, P1_WGM);
          pg8::EpiProj E{(bf16*)(ws + WS_PROJ), F.inp[9], F.inp[10], (const float*)(ws + WS_CTL + CTL_SSQX), (LAS float*)(F.lds + pg8::STAGE_BYTES)};
          pg8::gemm_phase<pg8::EpiProj, pg8::StdOrder, true>(F.lds, g, S, E, F.wave); }
        { pg8::Gemm g{ws, (unsigned)WS_MN, (unsigned)WS_WXKV, DM, DM, 512}; pg8::XkvOrder S{F.G, (int)blockIdx.x};
          pg8::EpiSlab E{(bf16*)(ws + WS_SLAB), 4096, (size_t)MROWS * 4096};
          pg8::gemm_phase<pg8::EpiSlab, pg8::XkvOrder, false>(F.lds, g, S, E, F.wave); }
    }
    SEAM(1); STAMP(2); CLKS(2);
#ifndef P2_TWICE
#define P2_TWICE 1
#endif
    if (IN(2)) REP(2) { for (int item = F.vcu; item < BATCH * NCHUNK * P2_TWICE; item += F.G) p2_prep_item(F, item & 255, false); }
    SEAM(2); STAMP(3); CLKS(3);
#ifndef P3_TWICE
#define P3_TWICE 1
#endif
    if (IN(3)) REP(3) { for (int item = F.vcu; item < 304 * P3_TWICE; item += F.G) p3_scan_item(F, item % 304); }
    SEAM(3); STAMP(4); CLKS(4);
    if (IN(4)) REP(4) {
        {
            const fox::Srd R = __builtin_amdgcn_make_buffer_rsrc((void*)ws, (short)0, (int)WS_END, 0x00020000);
            unsigned* QC = (unsigned*)(ws + WS_CTL + CTL_QCTR); const int* JLO = (const int*)(ws + WS_JLO);
            const float* CF = (const float*)(ws + WS_CFOX); const float* GO = F.inp[11];
            constexpr int CVB = P4_CVB, QCV = (W_ITEMS - W_EARLY) / (8 * CVB), QN = 192 + QCV, NONE = 1 << 20;
            auto mk_item = [&](int g) { const int qx = g / QN, i = g - qx * QN, qb = 15 - (i >> 2), bh = 4 * qx + (i & 3), b = bh >> 3, h = bh & 7;
                fox::Item I; I.rowb = (unsigned)b * SEQ * 2048u + (unsigned)h * (FOXD * 2); I.o = (unsigned)WS_CONCAT + (unsigned)b * SEQ * 4096u + (unsigned)h * (FOXD * 2);
                I.CS = CF + (size_t)bh * SEQ; I.G = GO + h * FOXD; I.P0 = qb * 256; I.jlo = JLO[bh * 16 + qb]; return I; };
            auto is_fox = [&](int g) { return g < NONE && (g % QN) < 64; };
            auto pull = [&]() { if (F.tid == 0) { unsigned qc = MISC[17], left = MISC[18]; int g = NONE;
                    while (left > 0u) { const unsigned i = atomicAdd(QC + qc * 64, 1u); if (i < (unsigned)QN) { g = (int)(qc * QN + i); break; } qc = (qc + 1u) & 7u; --left; }
                    MISC[17] = qc; MISC[18] = left; MISC[16] = (unsigned)g; } };
            if (F.tid == 0) { MISC[17] = xb_xcc_id() & 7u; MISC[18] = 8u; }
            pull();
            __syncthreads();
            int cur = __builtin_amdgcn_readfirstlane((int)MISC[16]);
            __syncthreads();
            while (cur < NONE) {
                if (is_fox(cur)) {
                    fox::Item I = mk_item(cur); fox::Seam S;
                    fox::fox_prime(R, I, (char*)lds, S, F.wave);
                    for (;;) {
                        pull();
                        auto next_item = [&](const fox::Item& self, int& nidx) { nidx = __builtin_amdgcn_readfirstlane((int)MISC[16]); return is_fox(nidx) ? mk_item(nidx) : self; };
                        const int nidx = fox::fox_block(R, I, next_item, (char*)lds, S, F.wave);
                        if (!is_fox(nidx)) { cur = nidx; break; }
                        I = mk_item(nidx);
                    }
                    VM_WAIT(); __syncthreads();
                } else if (P4_CONV_FIRST ? (cur % QN < 64 + QCV) : (cur % QN >= 192)) {
                    const int qx = cur / QN, j = cur - qx * QN - (P4_CONV_FIRST ? 64 : 192), first = W_EARLY + (qx * QCV + j) * CVB;
                    pull();
#if P4_CV_DEEP
                    p0_convert<true>(F, first, first + CVB, 1);
#else
                    p0_convert1(F, first, first + CVB);
#endif
                    VM_WAIT(); __syncthreads();
                    cur = __builtin_amdgcn_readfirstlane((int)MISC[16]);
                    __syncthreads();
                } else {
                    const int qx = cur / QN, it = qx * 128 + ((cur - qx * QN) - (P4_CONV_FIRST ? 64 + QCV : 64)), c = it & 63, h = (it >> 6) & 3, b = it >> 8;
                    pull();
                    mls::chunk_out(b, h, c, (const bf16*)((unsigned char*)F.out + WS_QP), (const bf16*)((unsigned char*)F.out + WS_KPP), (const bf16*)((unsigned char*)F.out + WS_VT), (const bf16*)(ws + WS_CST),
                                   (const float*)(ws + WS_NST), (const bf16*)(ws + WS_MO), F.inp[12], (bf16*)(ws + WS_CONCAT), F.lds, F.wave);
                    cur = __builtin_amdgcn_readfirstlane((int)MISC[16]);
                    __syncthreads();
                }
            }
        }
    }
    SEAM(4); STAMP(5); CLKS(5);
    if (IN(5)) REP(5) {
        pg8::Gemm g{ws, (unsigned)WS_CONCAT, (unsigned)WS_WOUT, DM, 64, DM, 0, 128u, 32768u}; pg8::StdOrder S; S.init(MTOK, DM, DM, DM, F.G, (int)blockIdx.x, TWICE_P5, P5_WGM);
        pg8::EpiResid<false, false> E{(const bf16*)(ws + WS_XN), (bf16*)(ws + WS_X1B), SSQ1, DM, 1.0f, ws + WS_X1Q};
        pg8::gemm_phase<pg8::EpiResid<false, false>, pg8::StdOrder, true>(F.lds, g, S, E, F.wave);
    }
    SEAM(5); STAMP(6); CLKS(6);
    if (IN(6)) REP(6) {
        pg8::Gemm g{ws, (unsigned)WS_X1Q, (unsigned)WS_WXQ, DM / 2, 64, DM / 2, 0, 128u, 32768u}; pg8::StdOrder S; S.init(MTOK, DM, DM / 2, DM / 2, F.G, (int)blockIdx.x, TWICE_P6, P5_WGM);
        pg8::EpiQ E{ws + WS_Q, SSQ1, SSQQ, 1.0f / W8_SCALE};
        pg8::gemm_phase<pg8::EpiQ, pg8::StdOrder, true, true>(F.lds, g, S, E, F.wave);
    }
    SEAM(6); STAMP(7); CLKS(7);
    if (IN(7)) REP(7) {
        pg8::Gemm g{ws, (unsigned)WS_Q, (unsigned)WS_KHAT, DM / 2, DM / 2, XD / 2}; pg8::ScoreOrder S{F.G, (int)blockIdx.x};
        pg8::EpiSoftmax E{ws + WS_P, SSQQ};
        if (F.G >= 256) pg8::gemm_phase<pg8::EpiSoftmax, pg8::ScoreOrder, false, true>(F.lds, g, S, E, F.wave);
        VM_WAIT(); __syncthreads(); __builtin_amdgcn_fence(__ATOMIC_ACQUIRE, "agent"); VM_WAIT(); __syncthreads();
        {
        pg8::Gemm g{ws, (unsigned)WS_P, (unsigned)WS_VTM, 512, NMEM / 2, NMEM / 2}; pg8::PvOrder S{F.G, (int)blockIdx.x, TWICE_P8};
        pg8::EpiStoreFp8 E{ws + WS_CO, DM, CO8_SCALE / (P8_SCALE * V8_SCALE)};
        pg8::gemm_phase<pg8::EpiStoreFp8, pg8::PvOrder, true, true>(F.lds, g, S, E, F.wave);
            }
    }
    STAMP(8); CLKS(8);
    SEAM(8); STAMP(9); CLKS(9);
#ifdef EXTRA_BARS
    for (int eb = 0; eb < EXTRA_BARS; ++eb) xcd_barrier(xbar);
#endif
    if (IN(9)) REP(9) {
        pg8::Gemm g{ws, (unsigned)WS_CO, (unsigned)WS_WXO, DM / 2, 64, DM / 2, 0, 128u, 32768u}; pg8::StdOrder S; S.init(MTOK, DM, DM / 2, DM / 2, F.G, (int)blockIdx.x, 0, P5_WGM);
        pg8::EpiResid<false, false> E{(const bf16*)(ws + WS_X1B), (bf16*)(ws + WS_X2B), SSQ2, DM, 1.0f / (W8_SCALE * CO8_SCALE), nullptr};
        pg8::gemm_phase<pg8::EpiResid<false, false>, pg8::StdOrder, true, true>(F.lds, g, S, E, F.wave);
    }
    SEAM(9); STAMP(10); CLKS(10);
#if MLP_SPLIT
    if (IN(10) && IN(11)) {
        for (int hh = 0; hh < 2; ++hh) {
            const size_t roff = (size_t)hh * (MTOK / 2);
            {
                pg8::Gemm g{ws, (unsigned)(WS_X2B + roff * DM * 2), (unsigned)WS_WUP, DM, 64, DM, 0, 128u, 32768u}; pg8::StdOrder S; S.init(MTOK / 2, DFF, DM, DM, F.G, (int)blockIdx.x, 0, P10S_WGM);
                pg8::EpiUp E{(bf16*)(ws + WS_H), SSQ2 + roff};
                pg8::gemm_phase<pg8::EpiUp, pg8::StdOrder, true>(F.lds, g, S, E, F.wave);
            }
            xcd_barrier(xbar);
            {
                pg8::Gemm g{ws, (unsigned)WS_H, (unsigned)WS_WDN, 64, 64, DFF, KREV_P11, 32768u, 32768u}; pg8::StdOrder S; S.init(MTOK / 2, DM, DFF, DFF, F.G, (int)blockIdx.x, 0, P11_WGM);
                pg8::EpiResid<false, true> E{(const bf16*)(ws + WS_X2B) + roff * DM, F.out + roff * DM, nullptr, DM, 1.0f, nullptr};
                pg8::gemm_phase<pg8::EpiResid<false, true>, pg8::StdOrder, true>(F.lds, g, S, E, F.wave);
            }
            if (hh == 0) xcd_barrier(xbar);
        }
    }
#else
    if (IN(10)) REP(10) {
        if (STAGGER_TICKS > 0 && (blockIdx.x & 8)) { const unsigned long long t0_ = __builtin_amdgcn_s_memrealtime(); while (__builtin_amdgcn_s_memrealtime() - t0_ < (unsigned long long)STAGGER_TICKS) __builtin_amdgcn_s_sleep(8); }
        pg8::Gemm g{ws, (unsigned)WS_X2B, (unsigned)WS_WUP, DM, 64, DM, 0, 128u, 32768u}; pg8::StdOrder S; S.init(MTOK, DFF, DM, DM, F.G, (int)blockIdx.x, TWICE_P10, P10_WGM);
        pg8::EpiUp E{(bf16*)(ws + WS_H), SSQ2};
        pg8::gemm_phase<pg8::EpiUp, pg8::StdOrder, true>(F.lds, g, S, E, F.wave);
    }
    SEAM(10); STAMP(11); CLKS(11);
    if (IN(11)) REP(11) {
        pg8::Gemm g{ws, (unsigned)WS_H, (unsigned)WS_WDN, 64, 64, DFF, KREV_P11, 32768u, 32768u}; pg8::StdOrder S; S.init(MTOK, DM, DFF, DFF, F.G, (int)blockIdx.x, TWICE_P11, P11_WGM);
        pg8::EpiResid<false, true> E{(const bf16*)(ws + WS_X2B), F.out, nullptr, DM, 1.0f, nullptr};
        pg8::gemm_phase<pg8::EpiResid<false, true>, pg8::StdOrder, true>(F.lds, g, S, E, F.wave);
    }
#endif
#ifdef CLK_PHASE
    xcd_barrier(xbar); CLKS(12);
    if (blockIdx.x == 0 && F.tid == 0) F.out[0] += rintf((float)(ck1 - ck0) / (float)(cr1 - cr0));
#endif
#ifdef PROBE_PHASE
    xcd_barrier(xbar); STAMP(12);
    if (blockIdx.x == 0 && F.tid < 64) {
        const float ta = 20.0f * rintf((float)(pt1 - pt0) * 0.01f * 0.05f), tb = 0.8f * rintf((float)(pu1 - pu0) * 0.01f * 0.125f);
        if (F.tid == 0) F.out[0] += ta;
        if (PROBE_B != 99) for (int i = F.tid; i < 10000; i += 64) F.out[64 + i] += tb;
    }
#endif
#undef IN
#undef SEAM
}

extern "C" void kernel_launch(void* const* d_in, const int* in_sizes, int n_in, void* d_out, int out_size, void* d_ws, size_t ws_size, hipStream_t stream) {
    static int grid = 0;
    if (grid == 0) {
        if (n_in != 24 || in_sizes[0] != MTOK * DM || out_size != MTOK * DM || ws_size < WS_END) {
            fprintf(stderr, "kernel_launch: unexpected shapes (n_in %d, in0 %d, out %d, ws %zu; need ws >= %zu); nothing launched\n", n_in, n_in > 0 ? in_sizes[0] : -1, out_size, ws_size, (size_t)WS_END); grid = -1; return; }
        int dev = 0, cus = 0, per_cu = 0;
        if (hipGetDevice(&dev) != hipSuccess || hipDeviceGetAttribute(&cus, hipDeviceAttributeMultiprocessorCount, dev) != hipSuccess) { grid = -1; return; }
        if (hipFuncSetAttribute((const void*)fwd_kernel, hipFuncAttributeMaxDynamicSharedMemorySize, LDS_BYTES) != hipSuccess) { fprintf(stderr, "kernel_launch: hipFuncSetAttribute failed\n"); grid = -1; return; }
        if (hipOccupancyMaxActiveBlocksPerMultiprocessor(&per_cu, (const void*)fwd_kernel, NTHREADS, LDS_BYTES) != hipSuccess || per_cu < 1) { fprintf(stderr, "kernel_launch: occupancy query says %d blocks per CU\n", per_cu); per_cu = 1; }
        (void)hipGetLastError();
        grid = cus;
    }
    if (grid < 0) return;
    (void)hipMemsetAsync((char*)d_ws + WS_CTL, 0, CTL_BYTES, stream);
    Args a{};
    for (int i = 0; i < 24; ++i) a.in[i] = (const float*)d_in[i];
    a.out = (float*)d_out; a.ws = (unsigned char*)d_ws;
#if MK_PER_PHASE
    for (int ph = 0; ph < N_PHASES; ++ph) { a.ph_lo = ph; a.ph_hi = ph + 1;
        hipLaunchKernelGGL(fwd_kernel, dim3(grid), dim3(NTHREADS), LDS_BYTES, stream, a); }
#else
    a.ph_lo = 0; a.ph_hi = N_PHASES;
    void* kargs[] = {&a};
    hipError_t e = hipLaunchCooperativeKernel((const void*)fwd_kernel, dim3(grid), dim3(NTHREADS), kargs, LDS_BYTES, stream);
    if (e != hipSuccess) fprintf(stderr, "kernel_launch: cooperative launch failed: %s (grid %d)\n", hipGetErrorString(e), grid);
#endif
}
```

```cpp
#include <hip/hip_runtime.h>
#include <hip/hip_cooperative_groups.h>
#include <cstdio>
#include <cstdint>
namespace cg = cooperative_groups;

constexpr int BATCH = 4, SEQ = 4096, DM = 2048, MTOK = BATCH * SEQ;
constexpr int NMEM = 256, MROWS = BATCH * NMEM;
constexpr int FOXH = 8, FOXD = 128, MLH = 4, MLDV = 256, MLDK = 128, XH = 4, XD = 512, DFF = 8192;
constexpr int IN_WIDTH = 6160, NPROJ = 6144, NCHUNK = SEQ / 64;
constexpr float EPS = 1e-6f;
constexpr float LOG2E = 1.4426950408889634f;

constexpr size_t MiB = (size_t)1 << 20;
constexpr size_t WS_WIN = 0, WS_WOUT = 24 * MiB, WS_WXQ = 32 * MiB, WS_WXKV = 40 * MiB, WS_WXO = 56 * MiB, WS_WUP = 60 * MiB, WS_WDN = 92 * MiB;
constexpr size_t WS_PROJ = 128 * MiB;
constexpr size_t WS_FQ = 128 * MiB, WS_FK = 160 * MiB, WS_FV = 192 * MiB, WS_MQK = 224 * MiB, WS_MV = 256 * MiB, WS_MO = 288 * MiB;
constexpr size_t WS_XN = 320 * MiB;
constexpr size_t WS_QP = 0 * MiB, WS_KPP = 16 * MiB;
constexpr size_t WS_KT = 32 * MiB;
constexpr size_t WS_VT = 48 * MiB;
constexpr size_t WS_MISC = 464 * MiB;
constexpr size_t WS_CTL = WS_MISC, CTL_BYTES = 2 * MiB;
constexpr size_t CTL_QCTR = 32 * 1024;
constexpr size_t CTL_SSQ1 = 64 * 1024, CTL_SSQ2 = 128 * 1024, CTL_SSQQ = 192 * 1024, CTL_SSQX = 448 * 1024;
constexpr size_t WS_GATES = WS_MISC + 1 * MiB;
constexpr size_t WS_CFOX = WS_MISC + 3 * MiB;
constexpr size_t WS_EB = WS_MISC + 4 * MiB;
constexpr size_t WS_KSUM = WS_MISC + 5 * MiB;
constexpr size_t WS_NST = WS_MISC + 6 * MiB;
constexpr size_t WS_JLO = WS_MISC + 7 * MiB;
constexpr size_t WS_MN = WS_MISC + 8 * MiB;
constexpr size_t WS_KHAT = WS_MISC + 12 * MiB;
constexpr size_t WS_VTM = WS_MISC + 16 * MiB;
constexpr size_t WS_END = 512 * MiB;
constexpr size_t WS_CONCAT = 224 * MiB;
constexpr size_t WS_X1B = 128 * MiB;
constexpr size_t WS_Q = 192 * MiB;
constexpr size_t WS_CO = 256 * MiB;
constexpr size_t WS_P = 320 * MiB;
constexpr size_t WS_X1Q = 288 * MiB;
constexpr size_t WS_X2B = 128 * MiB;
constexpr size_t WS_H = 192 * MiB;
constexpr size_t WS_SLAB = 400 * MiB;
constexpr size_t WS_CST = 400 * MiB;

#ifndef P3_SCAN_REP
#define P3_SCAN_REP 1
#endif
#ifndef JLO_DISABLE
#define JLO_DISABLE 0
#endif
constexpr float W8_SCALE = 64.0f, CO8_SCALE = 8.0f;
constexpr float Q8_SCALE = 16.0f, KH8_SCALE = 16.0f, P8_SCALE = 256.0f, V8_SCALE = 16.0f;
constexpr int WDNPITCH = DFF + 64;
constexpr int HPITCH = DFF + 64;
constexpr int LDS_BYTES = 147456;
constexpr int NTHREADS = 512;

#define GAS __attribute__((address_space(1)))
#define LAS __attribute__((address_space(3)))
typedef unsigned short bf16;
typedef unsigned v4u __attribute__((ext_vector_type(4)));
typedef unsigned v2u __attribute__((ext_vector_type(2)));
typedef float v4f __attribute__((ext_vector_type(4)));
typedef short v8s __attribute__((ext_vector_type(8)));
typedef short v4s __attribute__((ext_vector_type(4)));
#define LDS_WAIT() asm volatile("s_waitcnt lgkmcnt(0)" ::: "memory")
#define VM_WAIT() asm volatile("s_waitcnt vmcnt(0)" ::: "memory")
__device__ __forceinline__ unsigned f2bf(float f) { unsigned u = __builtin_bit_cast(unsigned, f); return (u + 0x7fffu + ((u >> 16) & 1u)) >> 16; }
__device__ __forceinline__ unsigned pk2(float lo, float hi) { return f2bf(lo) | (f2bf(hi) << 16); }
__device__ __forceinline__ float bf2f(unsigned h) { return __builtin_bit_cast(float, h << 16); }
__device__ __forceinline__ float bflo(unsigned w) { return __builtin_bit_cast(float, w << 16); }
__device__ __forceinline__ float bfhi(unsigned w) { return __builtin_bit_cast(float, w & 0xffff0000u); }
__device__ __forceinline__ float wave_sum(float v) {
#pragma unroll
    for (int o = 1; o < 64; o <<= 1) v += __shfl_xor(v, o);
    return v;
}
__device__ __forceinline__ int lane_id() { return (int)__builtin_amdgcn_mbcnt_hi(~0u, __builtin_amdgcn_mbcnt_lo(~0u, 0u)); }
__device__ __forceinline__ int wg_tid(int wv) { int t = wv * 64 + lane_id(); asm volatile("" : "+v"(t)); return t; }
__device__ __forceinline__ float logsigmoidf(float x) { return x >= 0.f ? -log1pf(__expf(-x)) : x - log1pf(__expf(x)); }
__device__ __forceinline__ float sigmoidf_(float x) { return 1.f / (1.f + __expf(-x)); }
__device__ __forceinline__ float rinv_of(const float* ssqx, size_t row) { return 1.0f / sqrtf(ssqx[row] * (1.0f / DM) + EPS); }
#define MK_PER_PHASE 0
namespace pg8 {
#define PG8_LAS __attribute__((address_space(3)))
typedef unsigned short bf16_t;
typedef short bf16x8 __attribute__((ext_vector_type(8)));
typedef float f32x4 __attribute__((ext_vector_type(4)));
typedef float f32x2 __attribute__((ext_vector_type(2)));
typedef unsigned u32x4 __attribute__((ext_vector_type(4)));
typedef unsigned u32x2 __attribute__((ext_vector_type(2)));
constexpr int BM = 256, BK = 64, HALF = 128, HTB = HALF * BK * 2, STAGE_BYTES = 8 * HTB, NXCD = 8, WGM = 8;

__host__ __device__ __forceinline__ int lds_byte(int r, int c) { const int st = (r >> 4) * 2 + (c >> 5), rr = r & 15, cc = c & 31, ob = rr * 64 + cc * 2; return st * 1024 + (ob ^ (((ob >> 9) & 1) << 5)); }
__host__ __device__ __forceinline__ void stage_rc(int b, int& R, int& C) { const int st = b / 1024, sb = b % 1024, swz = sb ^ (((sb >> 9) & 1) << 5); R = (st >> 1) * 16 + swz / 64; C = (st & 1) * 32 + (swz % 64) / 2; }
__host__ __device__ __forceinline__ int perm32(int rho) { const int n = rho >> 4, i = rho & 15; return 8 * (i >> 2) + 4 * n + (i & 3); }

struct Unit { int row0, col0; long aoff, boff; int aux; };
struct Gemm { const void* base; unsigned aoff, boff; int lda, ldb, K; int krev = 0; unsigned ksa = BK * 2, ksb = BK * 2; };

struct StdOrder {
    int nM, nN, nwg, G, c, lda, ldb, rsh, wgm;
    __device__ void init(int M, int N, int lda_, int ldb_, int G_, int c_, int rsh_ = 0, int wgm_ = WGM) { nM = M / BM; nN = N / BM; nwg = nM * nN; G = G_; c = c_; lda = lda_; ldb = ldb_; rsh = rsh_; wgm = wgm_; }
    __device__ bool next(int i, Unit& u) const {
        const long L = (long)(i >> rsh) * G + c; if (L >= nwg) return false;
        int wgid = (int)L; { const int q = nwg / NXCD, r = nwg % NXCD, xcd = wgid % NXCD, off = wgid / NXCD; wgid = (xcd < r ? xcd * (q + 1) : r * (q + 1) + (xcd - r) * q) + off; }
        const int nig = wgm * nN, gid = wgid / nig, fm = gid * wgm, gsz = (nM - fm) < wgm ? (nM - fm) : wgm;
        const int pm = fm + ((wgid % nig) % gsz), pn = (wgid % nig) / gsz;
        u.row0 = pm * BM; u.col0 = pn * BM; u.aoff = (long)pm * BM * lda; u.boff = (long)pn * BM * ldb; u.aux = i & ((1 << rsh) - 1); return true;
    }
};

__device__ __forceinline__ unsigned cvt_pk_bf16(float lo, float hi) { unsigned r; asm volatile("v_cvt_pk_bf16_f32 %0, %1, %2" : "=v"(r) : "v"(lo), "v"(hi)); return r; }

typedef int v8i_t __attribute__((ext_vector_type(8)));
typedef int v4i_t __attribute__((ext_vector_type(4)));
template <class Epi, class Sched, bool ALIGN_EPI, bool FP8 = false>
__device__ __forceinline__ void gemm_phase(PG8_LAS unsigned char* lds, const Gemm g, const Sched& S, const Epi& E, int wv) {
    const int tid = wg_tid(wv), wid = wv, lane = tid & 63, wr = wid >> 2, wc = wid & 3, fr = lane & 15, fq = lane >> 4;
    const int K = g.K, nt = K / BK;
    unsigned voffA, voffB;
    { int R, C; stage_rc(tid * 16, R, C); const int Rb = Epi::PERM ? ((R & ~31) + perm32(R & 31)) : R;
      voffA = (unsigned)(R * g.lda + C) * 2u; voffB = (unsigned)(Rb * g.ldb + C) * 2u; }
    const unsigned pA = 64u * (unsigned)g.lda * 2u, pB = 64u * (unsigned)g.ldb * 2u;
    const unsigned voffA_v = voffA, voffB_v = voffB, voffA_p = pA, voffB_p = pB;
    const unsigned kstepA = g.krev ? 0u - g.ksa : g.ksa, kstepB = g.krev ? 0u - g.ksb : g.ksb, k0A = g.krev ? (unsigned)(nt - 1) * g.ksa : 0u, k0B = g.krev ? (unsigned)(nt - 1) * g.ksb : 0u;
    const unsigned hA = (unsigned)HALF * g.lda * 2, hB = (unsigned)HALF * g.ldb * 2;
    const __amdgpu_buffer_rsrc_t rsrc = __builtin_amdgcn_make_buffer_rsrc((void*)g.base, (short)0, 0x7fffffff, 0x00020000);
    const unsigned ldsw = (unsigned)wid * 1024u;
    const int aoff = lds_byte(wr * 64 + fr, fq * 8), boff = lds_byte(wc * 32 + fr, fq * 8);
#define PG8_SA(b, h) (((b) * 2 + (h)) * HTB)
#define PG8_SB(b, h) ((4 + (b) * 2 + (h)) * HTB)
#define PG8_STAGE(bufoff, gbase, voff) do { _Pragma("unroll") for (int _i = 0; _i < 2; ++_i) \
        __builtin_amdgcn_raw_ptr_buffer_load_lds(rsrc, (PG8_LAS void*)(lds + (bufoff) + ldsw + _i * 8192), 16, voff##_v, (gbase) + _i * voff##_p, 0, 0); } while (0)
#define PG8_LDA(dst, b, h) do { _Pragma("unroll") for (int m = 0; m < 4; ++m) dst[m] = PG8_CAT(*(const PG8_LAS v4i_t*)(lds + PG8_SA(b, h) + aoff + m * 2048), *(const PG8_LAS v4i_t*)(lds + PG8_SA(b, h) + aoff + m * 2048 + 1024)); } while (0)
#define PG8_LDB(dst, b, h) do { _Pragma("unroll") for (int n = 0; n < 2; ++n) dst[n] = PG8_CAT(*(const PG8_LAS v4i_t*)(lds + PG8_SB(b, h) + boff + n * 2048), *(const PG8_LAS v4i_t*)(lds + PG8_SB(b, h) + boff + n * 2048 + 1024)); } while (0)
#define PG8_CAT(x0, x1) __builtin_shufflevector((x0), (x1), 0, 1, 2, 3, 4, 5, 6, 7)
#define PG8_K0(x) __builtin_bit_cast(bf16x8, __builtin_shufflevector((x), (x), 0, 1, 2, 3))
#define PG8_K1(x) __builtin_bit_cast(bf16x8, __builtin_shufflevector((x), (x), 4, 5, 6, 7))
#define PG8_MMA(ai, bj, At, Bt) do { __builtin_amdgcn_s_setprio(1); _Pragma("unroll") for (int m = 0; m < 4; ++m) _Pragma("unroll") for (int n = 0; n < 2; ++n) { \
        if constexpr (FP8) asm volatile("v_mfma_f32_16x16x128_f8f6f4 %0, %1, %2, %0" : "+v"(acc[ai][bj][m][n]) : "v"(Bt[n]), "v"(At[m]));     \
        else { acc[ai][bj][m][n] = __builtin_amdgcn_mfma_f32_16x16x32_bf16(PG8_K0(Bt[n]), PG8_K0(At[m]), acc[ai][bj][m][n], 0, 0, 0); \
               acc[ai][bj][m][n] = __builtin_amdgcn_mfma_f32_16x16x32_bf16(PG8_K1(Bt[n]), PG8_K1(At[m]), acc[ai][bj][m][n], 0, 0, 0); } } \
        __builtin_amdgcn_s_setprio(0); } while (0)
#define PG8_WAIT_V(n) asm volatile("s_waitcnt vmcnt(" #n ")" ::: "memory")
#define PG8_WAIT_L(n) asm volatile("s_waitcnt lgkmcnt(" #n ")" ::: "memory")
#define PG8_BAR __builtin_amdgcn_s_barrier()
#define PG8_SCHED __builtin_amdgcn_sched_barrier(0)
    Unit cur, nxt; int ui = 0;
    if (!S.next(0, cur)) return;
    PG8_LAS float* rsc = (PG8_LAS float*)(lds + 140288); int rs_row0 = -1;
    if constexpr (Epi::ROWSCALE) { if (tid < 256) rsc[tid] = __builtin_amdgcn_rsqf(E.rs_src()[cur.row0 + tid] * (1.0f / 2048.0f) + 1e-6f); rs_row0 = cur.row0; }
    f32x4 acc[2][2][4][2];
#pragma unroll
    for (int a = 0; a < 2; ++a)
#pragma unroll
        for (int b = 0; b < 2; ++b)
#pragma unroll
            for (int m = 0; m < 4; ++m)
#pragma unroll
                for (int n = 0; n < 2; ++n) acc[a][b][m][n] = (f32x4){0.f, 0.f, 0.f, 0.f};
    v8i_t At[4], B0[2], B1[2];
    unsigned cA = g.aoff + (unsigned)cur.aoff * 2u + k0A, cB = g.boff + (unsigned)cur.boff * 2u + k0B;
    PG8_STAGE(PG8_SB(0, 0), cB, voffB); PG8_STAGE(PG8_SB(0, 1), cB + hB, voffB); PG8_STAGE(PG8_SA(0, 0), cA, voffA); PG8_STAGE(PG8_SA(0, 1), cA + hA, voffA);
    if (wr == 1) PG8_BAR;
    PG8_WAIT_V(2); PG8_BAR;
    PG8_STAGE(PG8_SB(1, 0), cB + kstepB, voffB); PG8_STAGE(PG8_SA(1, 0), cA + kstepA, voffA); PG8_STAGE(PG8_SB(1, 1), cB + hB + kstepB, voffB);
    PG8_WAIT_V(6); PG8_BAR;
    for (;;) {
        const bool has_next = S.next(ui + 1, nxt);
        const unsigned nA = has_next ? g.aoff + (unsigned)nxt.aoff * 2u + k0A : cA, nB = has_next ? g.boff + (unsigned)nxt.boff * 2u + k0B : cB;
        for (int t = 0; t < nt; t += 2) {
            const bool last = (t == nt - 2);
            const unsigned a1 = cA + (unsigned)(t + 1) * kstepA;
            const unsigned a2 = last ? nA : cA + (unsigned)(t + 2) * kstepA, b2 = last ? nB : cB + (unsigned)(t + 2) * kstepB;
            const unsigned a3 = a2 + kstepA, b3 = b2 + kstepB;
            PG8_LDB(B0, 0, 0); PG8_LDB(B1, 0, 1); PG8_SCHED; PG8_LDA(At, 0, 0); PG8_STAGE(PG8_SA(1, 1), a1 + hA, voffA);
            PG8_WAIT_V(8); PG8_WAIT_L(0); PG8_BAR; PG8_MMA(0, 0, At, B0); PG8_MMA(0, 1, At, B1); PG8_BAR; PG8_SCHED;
            PG8_LDA(At, 0, 1); PG8_STAGE(PG8_SB(0, 0), b2, voffB); PG8_STAGE(PG8_SB(0, 1), b2 + hB, voffB); PG8_STAGE(PG8_SA(0, 0), a2, voffA);
            PG8_WAIT_V(8); PG8_WAIT_L(0); PG8_BAR; PG8_MMA(1, 0, At, B0); PG8_MMA(1, 1, At, B1); PG8_BAR; PG8_SCHED;
            PG8_LDB(B0, 1, 0); PG8_LDB(B1, 1, 1); PG8_SCHED; PG8_LDA(At, 1, 0); PG8_STAGE(PG8_SA(0, 1), a2 + hA, voffA);
            PG8_WAIT_V(8); PG8_WAIT_L(0); PG8_BAR; PG8_MMA(0, 0, At, B0); PG8_MMA(0, 1, At, B1); PG8_BAR; PG8_SCHED;
            PG8_LDA(At, 1, 1); PG8_STAGE(PG8_SB(1, 0), b3, voffB); PG8_STAGE(PG8_SB(1, 1), b3 + hB, voffB); PG8_STAGE(PG8_SA(1, 0), a3, voffA);
            PG8_WAIT_V(8); PG8_WAIT_L(0); PG8_BAR; PG8_MMA(1, 0, At, B0); PG8_MMA(1, 1, At, B1); PG8_BAR; PG8_SCHED;
        }
        if constexpr (ALIGN_EPI) { if (wr == 0) PG8_BAR; }
        if constexpr (FP8) asm volatile("s_nop 15\n\ts_nop 7" ::: "memory");
        if constexpr (!Epi::AFTER_DRAIN) { E(acc, cur, wr, wc, fr, fq, rsc); }
        if (!has_next) break;
#pragma unroll
        for (int a = 0; a < 2; ++a)
#pragma unroll
            for (int b = 0; b < 2; ++b)
#pragma unroll
                for (int m = 0; m < 4; ++m)
#pragma unroll
                    for (int n = 0; n < 2; ++n) acc[a][b][m][n] = (f32x4){0.f, 0.f, 0.f, 0.f};
        cur = nxt; cA = nA; cB = nB; ++ui;
        if constexpr (Epi::ROWSCALE) { if (cur.row0 != rs_row0) { rsc = (PG8_LAS float*)(lds + (rsc == (PG8_LAS float*)(lds + 140288) ? 141312 : 140288)); if (tid < 256) rsc[tid] = __builtin_amdgcn_rsqf(E.rs_src()[cur.row0 + tid] * (1.0f / 2048.0f) + 1e-6f); rs_row0 = cur.row0; } }
        if constexpr (ALIGN_EPI) { if (wr == 1) PG8_BAR; }
    }
    PG8_WAIT_V(0);
    if constexpr (!ALIGN_EPI) { if (wr == 0) PG8_BAR; }
    PG8_BAR;
    if constexpr (Epi::AFTER_DRAIN) { E.fused(acc, cur, wr, wc, fr, fq, lds, wid, lane); }
#undef PG8_SA
#undef PG8_SB
#undef PG8_STAGE
#undef PG8_LDA
#undef PG8_LDB
#undef PG8_MMA
#undef PG8_CAT
#undef PG8_K0
#undef PG8_K1
#undef PG8_WAIT_V
#undef PG8_WAIT_L
#undef PG8_BAR
#undef PG8_SCHED
}
}
namespace pg8 {
struct XkvOrder {
    int G, c;
    __device__ bool next(int i, Unit& u) const {
        const int L = i * G + c; if (L >= 256) return false;
        const int kq = L & 3, tile = L >> 2, pm = tile & 3, pn = tile >> 2;
        u.row0 = pm * 256; u.col0 = pn * 256; u.aoff = (long)pm * 256 * DM + kq * 512; u.boff = (long)pn * 256 * DM + kq * 512; u.aux = kq; return true;
    }
};
struct QOrder {
    int G, c, rsh;
    __device__ bool next(int i, Unit& u) const {
        if (c >= 256 || (i >> rsh) >= 2) return false;
        const int b = c >> 6, h = (c >> 4) & 3, mt = c & 15, pm = b * 16 + mt, pn = 2 * h + (i >> rsh);
        u.row0 = pm * 256; u.col0 = pn * 256; u.aoff = (long)pm * 256 * (DM / 2); u.boff = (long)pn * 256 * (DM / 2); u.aux = i & ((1 << rsh) - 1); return true;
    }
};
struct ScoreOrder {
    int G, c;
    __device__ bool next(int i, Unit& u) const {
        const int L = i * G + c; if (L >= 256) return false;
        const int b = L >> 6, h = (L >> 4) & 3, mt = L & 15;
        u.row0 = b * SEQ + mt * 256; u.col0 = h * 256; u.aoff = (long)u.row0 * (DM / 2) + h * (XD / 2); u.boff = (long)(b * NMEM) * (DM / 2) + h * (XD / 2); u.aux = h; return true;
    }
};
struct PvOrder {
    int G, c, rsh;
    __device__ bool next(int i, Unit& u) const {
        if (c >= 256 || (i >> rsh) >= 2) return false;
        const int nt = i >> rsh, b = c >> 6, h = (c >> 4) & 3, mt = c & 15;
        u.row0 = b * SEQ + mt * 256; u.col0 = h * XD + nt * 256; u.aoff = (long)u.row0 * 512 + h * 128; u.boff = ((long)(b * XH + h) * XD + nt * 256) * (NMEM / 2); u.aux = 0; return true;
    }
};


#ifndef EPI_FULL_LINES
#define EPI_FULL_LINES 0
#endif
#ifndef EPI_SC1
#define EPI_SC1 0
#endif
__device__ __forceinline__ void st16(void* p, u32x4 v) {
#if EPI_SC1
    asm volatile("global_store_dwordx4 %0, %1, off sc1\n\ts_nop 1" :: "v"(p), "v"(v) : "memory");
#else
    *(u32x4*)p = v;
#endif
}
__device__ __forceinline__ void st16f(void* p, f32x4 v) {
#if EPI_SC1
    asm volatile("global_store_dwordx4 %0, %1, off sc1\n\ts_nop 1" :: "v"(p), "v"(v) : "memory");
#else
    *(f32x4*)p = v;
#endif
}
__device__ __forceinline__ void st8(void* p, u32x2 v) {
#if EPI_SC1
    asm volatile("global_store_dwordx2 %0, %1, off sc1\n\ts_nop 0" :: "v"(p), "v"(v) : "memory");
#else
    *(u32x2*)p = v;
#endif
}

__device__ __forceinline__ float lane_xor8(float x) { return __builtin_bit_cast(float, __builtin_amdgcn_update_dpp(0, __builtin_bit_cast(int, x), 0x128, 0xf, 0xf, false)); }
__device__ __forceinline__ unsigned pk4_fp8(float a, float b, float c, float d) { int w = __builtin_amdgcn_cvt_pk_fp8_f32(a, b, 0, false); w = __builtin_amdgcn_cvt_pk_fp8_f32(c, d, w, true); return (unsigned)w; }
struct EpiStoreBf16 {
    static constexpr bool PERM = true, AFTER_DRAIN = false, ROWSCALE = false;
    bf16_t* O; int ldc; int split_cols; size_t split_stride;
    __device__ __forceinline__ void operator()(const f32x4 (&acc)[2][2][4][2], const Unit& u, int wr, int wc, int fr, int fq, PG8_LAS const float* rsc) const {
        int colt = u.col0; bf16_t* base = O;
        if (split_cols) { const int t = colt / split_cols; base += (size_t)t * split_stride; colt -= t * split_cols; }
        const int row0 = u.row0 + wr * 64 + fr, col0 = colt + wc * 32 + 8 * fq;
#pragma unroll
        for (int ai = 0; ai < 2; ++ai)
#pragma unroll
            for (int m = 0; m < 4; ++m) { bf16_t* rowp = base + (size_t)(row0 + ai * HALF + m * 16) * ldc + col0;
#pragma unroll
                for (int bj = 0; bj < 2; ++bj) { const f32x4 v0 = acc[ai][bj][m][0], v1 = acc[ai][bj][m][1];
                    u32x4 w; w.x = cvt_pk_bf16(v0[0], v0[1]); w.y = cvt_pk_bf16(v0[2], v0[3]); w.z = cvt_pk_bf16(v1[0], v1[1]); w.w = cvt_pk_bf16(v1[2], v1[3]);
                    st16(rowp + bj * HALF, w); } }
    }
};
struct EpiProj {
    static constexpr bool PERM = true, AFTER_DRAIN = false, ROWSCALE = true;
    __device__ __forceinline__ const float* rs_src() const { return ssqx; }
    bf16_t* O; const float* gq; const float* gk; const float* ssqx; PG8_LAS float* red;
    __device__ __forceinline__ void operator()(f32x4 (&acc)[2][2][4][2], const Unit& u, int wr, int wc, int fr, int fq, PG8_LAS const float* rsc) const {
        const int t = u.col0 >> 10, colt = u.col0 & 1023; bf16_t* base = O + (size_t)t * ((size_t)MTOK * 1024);
        const int row0 = u.row0 + wr * 64 + fr, col0 = colt + wc * 32 + 8 * fq;
#pragma unroll
        for (int ai = 0; ai < 2; ++ai)
#pragma unroll
            for (int m = 0; m < 4; ++m) { const float rx = rsc[ai * HALF + wr * 64 + m * 16 + fr];
#pragma unroll
                for (int bj = 0; bj < 2; ++bj) { acc[ai][bj][m][0] = acc[ai][bj][m][0] * rx; acc[ai][bj][m][1] = acc[ai][bj][m][1] * rx; } }
        if (u.col0 < 2048) {
            const float* g = (t == 0 ? gq : gk) + wc * 32 + 8 * fq; const f32x4 g0 = *(const f32x4*)g, g1 = *(const f32x4*)(g + 4);
#pragma unroll
            for (int ai = 0; ai < 2; ++ai)
#pragma unroll
                for (int m = 0; m < 4; ++m) { const int rl = ai * HALF + wr * 64 + m * 16 + fr;
#pragma unroll
                    for (int bj = 0; bj < 2; ++bj) { const f32x4 v0 = acc[ai][bj][m][0], v1 = acc[ai][bj][m][1];
                        float s = (v0[0] * v0[0] + v0[1] * v0[1]) + (v0[2] * v0[2] + v0[3] * v0[3]) + (v1[0] * v1[0] + v1[1] * v1[1]) + (v1[2] * v1[2] + v1[3] * v1[3]);
                        s += __shfl_xor(s, 16); s += __shfl_xor(s, 32);
                        if (fq == 0) red[(rl * 2 + bj) * 4 + wc] = s; } }
            asm volatile("s_waitcnt lgkmcnt(0)" ::: "memory"); __builtin_amdgcn_s_barrier(); asm volatile("" ::: "memory");
#pragma unroll
            for (int ai = 0; ai < 2; ++ai)
#pragma unroll
                for (int m = 0; m < 4; ++m) { const int rl = ai * HALF + wr * 64 + m * 16 + fr;
#pragma unroll
                    for (int bj = 0; bj < 2; ++bj) { const f32x4 r4 = *(const PG8_LAS f32x4*)(red + (rl * 2 + bj) * 4);
                        const float ri = __builtin_amdgcn_rsqf(((r4[0] + r4[1]) + (r4[2] + r4[3])) * (1.0f / FOXD) + EPS);
                        acc[ai][bj][m][0] = acc[ai][bj][m][0] * ri * g0; acc[ai][bj][m][1] = acc[ai][bj][m][1] * ri * g1; } }
        }
#pragma unroll
        for (int ai = 0; ai < 2; ++ai)
#pragma unroll
            for (int m = 0; m < 4; ++m) { bf16_t* rowp = base + (size_t)(row0 + ai * HALF + m * 16) * 1024 + col0;
#pragma unroll
                for (int bj = 0; bj < 2; ++bj) { const f32x4 v0 = acc[ai][bj][m][0], v1 = acc[ai][bj][m][1];
                    u32x4 w; w.x = cvt_pk_bf16(v0[0], v0[1]); w.y = cvt_pk_bf16(v0[2], v0[3]); w.z = cvt_pk_bf16(v1[0], v1[1]); w.w = cvt_pk_bf16(v1[2], v1[3]);
                    st16(rowp + bj * HALF, w); } }
    }
};
struct EpiStoreFp8 {
    static constexpr bool PERM = true, AFTER_DRAIN = false, ROWSCALE = false;
    unsigned char* O8; int ldc; float scale;
    __device__ __forceinline__ void operator()(const f32x4 (&acc)[2][2][4][2], const Unit& u, int wr, int wc, int fr, int fq, PG8_LAS const float* rsc) const {
        const int row0 = u.row0 + wr * 64 + fr, col0 = u.col0 + wc * 32 + 8 * fq;
#pragma unroll
        for (int ai = 0; ai < 2; ++ai)
#pragma unroll
            for (int m = 0; m < 4; ++m) { unsigned char* rowp = O8 + (size_t)(row0 + ai * HALF + m * 16) * ldc + col0;
#pragma unroll
                for (int bj = 0; bj < 2; ++bj) { const f32x4 v0 = acc[ai][bj][m][0] * scale, v1 = acc[ai][bj][m][1] * scale;
                    u32x2 w; w.x = pk4_fp8(v0[0], v0[1], v0[2], v0[3]); w.y = pk4_fp8(v1[0], v1[1], v1[2], v1[3]);
                    st8(rowp + bj * HALF, w); } }
    }
};
struct EpiSlab {
    static constexpr bool PERM = true, AFTER_DRAIN = false, ROWSCALE = false;
    bf16_t* slab; int ldc; size_t slab_stride;
    __device__ __forceinline__ void operator()(const f32x4 (&acc)[2][2][4][2], const Unit& u, int wr, int wc, int fr, int fq, PG8_LAS const float* rsc) const {
        bf16_t* base = slab + (size_t)u.aux * slab_stride; const int col0 = u.col0 + wc * 32 + 8 * fq;
#pragma unroll
        for (int ai = 0; ai < 2; ++ai)
#pragma unroll
            for (int m = 0; m < 4; ++m) { bf16_t* rowp = base + (size_t)(u.row0 + ai * HALF + wr * 64 + m * 16 + fr) * ldc + col0;
#pragma unroll
                for (int bj = 0; bj < 2; ++bj) { const f32x4 v0 = acc[ai][bj][m][0], v1 = acc[ai][bj][m][1];
                    u32x4 w; w.x = cvt_pk_bf16(v0[0], v0[1]); w.y = cvt_pk_bf16(v0[2], v0[3]); w.z = cvt_pk_bf16(v1[0], v1[1]); w.w = cvt_pk_bf16(v1[2], v1[3]);
                    st16(rowp + bj * HALF, w); } }
    }
};
template <bool BASEF, bool OUTF>
struct EpiResid {
    static constexpr bool PERM = true, AFTER_DRAIN = false, ROWSCALE = false;
    const void* base; void* out; float* ssq; int ldc; float ascale; unsigned char* out8;
    __device__ __forceinline__ void operator()(const f32x4 (&acc)[2][2][4][2], const Unit& u, int wr, int wc, int fr, int fq, PG8_LAS const float* rsc) const {
        const int col0 = u.col0 + wc * 32 + 8 * fq;
#ifdef EPIRES_SKIP_DUP
        if (u.aux != 0) return;
#endif
        float ssum[2][4];
        if constexpr (!BASEF) {
            u32x4 raw[2][2][2];
#define ER_LOADQ(q, b) do { _Pragma("unroll") for (int mi = 0; mi < 2; ++mi) { const size_t off_ = (size_t)(u.row0 + ((q) >> 1) * HALF + wr * 64 + (2 * ((q) & 1) + mi) * 16 + fr) * ldc + col0;   \
                _Pragma("unroll") for (int bj = 0; bj < 2; ++bj) raw[b][mi][bj] = *(const u32x4*)((const bf16_t*)base + off_ + bj * HALF); } } while (0)
            ER_LOADQ(0, 0); ER_LOADQ(1, 1);
#pragma unroll
            for (int q = 0; q < 4; ++q) { const int ai = q >> 1, b = q & 1;
#pragma unroll
                for (int mi = 0; mi < 2; ++mi) { const int m = 2 * (q & 1) + mi; const size_t off = (size_t)(u.row0 + ai * HALF + wr * 64 + m * 16 + fr) * ldc + col0; float s = 0.f;
#pragma unroll
                    for (int bj = 0; bj < 2; ++bj) { const u32x4 w = raw[b][mi][bj];
                        const f32x4 b0 = (f32x4){__builtin_bit_cast(float, w.x << 16), __builtin_bit_cast(float, w.x & 0xffff0000u), __builtin_bit_cast(float, w.y << 16), __builtin_bit_cast(float, w.y & 0xffff0000u)};
                        const f32x4 b1 = (f32x4){__builtin_bit_cast(float, w.z << 16), __builtin_bit_cast(float, w.z & 0xffff0000u), __builtin_bit_cast(float, w.w << 16), __builtin_bit_cast(float, w.w & 0xffff0000u)};
                        const f32x4 v0 = b0 + acc[ai][bj][m][0] * ascale, v1 = b1 + acc[ai][bj][m][1] * ascale;
                        if (out8) { u32x2 w8; w8.x = pk4_fp8(v0[0], v0[1], v0[2], v0[3]); w8.y = pk4_fp8(v1[0], v1[1], v1[2], v1[3]); st8(out8 + off + bj * HALF, w8); }
                        if constexpr (OUTF) { st16f((float*)out + off + bj * HALF, v0); st16f((float*)out + off + bj * HALF + 4, v1); }
                        else { u32x4 wo; wo.x = cvt_pk_bf16(v0[0], v0[1]); wo.y = cvt_pk_bf16(v0[2], v0[3]); wo.z = cvt_pk_bf16(v1[0], v1[1]); wo.w = cvt_pk_bf16(v1[2], v1[3]);
                            st16((bf16_t*)out + off + bj * HALF, wo); }
                        s += (v0[0] * v0[0] + v0[1] * v0[1]) + (v0[2] * v0[2] + v0[3] * v0[3]) + (v1[0] * v1[0] + v1[1] * v1[1]) + (v1[2] * v1[2] + v1[3] * v1[3]); }
                    s += __shfl_xor(s, 16); s += __shfl_xor(s, 32); ssum[ai][m] = s; }
                if (q + 2 < 4) { if (q == 0) ER_LOADQ(2, 0); else ER_LOADQ(3, 1); } }
#undef ER_LOADQ
        } else {
#pragma unroll
        for (int ai = 0; ai < 2; ++ai) {
            f32x4 bv[4][2][2];
#pragma unroll
            for (int m = 0; m < 4; ++m) { const size_t off = (size_t)(u.row0 + ai * HALF + wr * 64 + m * 16 + fr) * ldc + col0;
#pragma unroll
                for (int bj = 0; bj < 2; ++bj) {
                    if constexpr (BASEF) { bv[m][bj][0] = *(const f32x4*)((const float*)base + off + bj * HALF); bv[m][bj][1] = *(const f32x4*)((const float*)base + off + bj * HALF + 4); }
                    else { const u32x4 w = *(const u32x4*)((const bf16_t*)base + off + bj * HALF);
                        bv[m][bj][0] = (f32x4){__builtin_bit_cast(float, w.x << 16), __builtin_bit_cast(float, w.x & 0xffff0000u), __builtin_bit_cast(float, w.y << 16), __builtin_bit_cast(float, w.y & 0xffff0000u)};
                        bv[m][bj][1] = (f32x4){__builtin_bit_cast(float, w.z << 16), __builtin_bit_cast(float, w.z & 0xffff0000u), __builtin_bit_cast(float, w.w << 16), __builtin_bit_cast(float, w.w & 0xffff0000u)}; } } }
#pragma unroll
            for (int m = 0; m < 4; ++m) { const size_t off = (size_t)(u.row0 + ai * HALF + wr * 64 + m * 16 + fr) * ldc + col0; float s = 0.f;
#pragma unroll
                for (int bj = 0; bj < 2; ++bj) { const f32x4 v0 = bv[m][bj][0] + acc[ai][bj][m][0] * ascale, v1 = bv[m][bj][1] + acc[ai][bj][m][1] * ascale;
                    if (out8) { u32x2 w8; w8.x = pk4_fp8(v0[0], v0[1], v0[2], v0[3]); w8.y = pk4_fp8(v1[0], v1[1], v1[2], v1[3]); st8(out8 + off + bj * HALF, w8); }
                    if constexpr (OUTF) {
#if EPI_FULL_LINES
                        const bool hi = (fr & 8) != 0;
                        const f32x4 rcv = (f32x4){lane_xor8(hi ? v0[0] : v1[0]), lane_xor8(hi ? v0[1] : v1[1]), lane_xor8(hi ? v0[2] : v1[2]), lane_xor8(hi ? v0[3] : v1[3])};
                        const f32x4 sa = hi ? rcv : v0, sb = hi ? v1 : rcv;
                        float* pa = (float*)out + off + bj * HALF + (hi ? 4 - 8 * ldc : 0);
                        st16f(pa, sa); st16f(pa + 8 * ldc, sb);
#else
                        st16f((float*)out + off + bj * HALF, v0); st16f((float*)out + off + bj * HALF + 4, v1);
#endif
                    }
                    else { u32x4 w; w.x = cvt_pk_bf16(v0[0], v0[1]); w.y = cvt_pk_bf16(v0[2], v0[3]); w.z = cvt_pk_bf16(v1[0], v1[1]); w.w = cvt_pk_bf16(v1[2], v1[3]);
                        st16((bf16_t*)out + off + bj * HALF, w); }
                    s += (v0[0] * v0[0] + v0[1] * v0[1]) + (v0[2] * v0[2] + v0[3] * v0[3]) + (v1[0] * v1[0] + v1[1] * v1[1]) + (v1[2] * v1[2] + v1[3] * v1[3]); }
                s += __shfl_xor(s, 16); s += __shfl_xor(s, 32); ssum[ai][m] = s; } }
        }
        if (ssq && u.aux == 0) {
#pragma unroll
            for (int ai = 0; ai < 2; ++ai) { const float v = fq == 0 ? ssum[ai][0] : fq == 1 ? ssum[ai][1] : fq == 2 ? ssum[ai][2] : ssum[ai][3];
                atomicAdd(ssq + u.row0 + ai * HALF + wr * 64 + fq * 16 + fr, v); }
        }
    }
};
struct EpiQ {
    static constexpr bool PERM = true, AFTER_DRAIN = false, ROWSCALE = true;
    __device__ __forceinline__ const float* rs_src() const { return ssq_in; }
    unsigned char* O; const float* ssq_in; float* ssq_out; float oscale;
    __device__ __forceinline__ void operator()(const f32x4 (&acc)[2][2][4][2], const Unit& u, int wr, int wc, int fr, int fq, PG8_LAS const float* rsc) const {
        const int col0 = u.col0 + wc * 32 + 8 * fq; float* so = ssq_out + (size_t)(u.col0 / XD) * MTOK;
        float ssum[2][4];
#pragma unroll
        for (int ai = 0; ai < 2; ++ai)
#pragma unroll
            for (int m = 0; m < 4; ++m) { const int row = u.row0 + ai * HALF + wr * 64 + m * 16 + fr; const float ri = rsc[ai * HALF + wr * 64 + m * 16 + fr] * oscale;
                unsigned char* rowp = O + (size_t)row * DM + col0; float s = 0.f;
#pragma unroll
                for (int bj = 0; bj < 2; ++bj) { const f32x4 v0 = acc[ai][bj][m][0] * ri, v1 = acc[ai][bj][m][1] * ri;
                    u32x2 w; w.x = pk4_fp8(v0[0] * Q8_SCALE, v0[1] * Q8_SCALE, v0[2] * Q8_SCALE, v0[3] * Q8_SCALE); w.y = pk4_fp8(v1[0] * Q8_SCALE, v1[1] * Q8_SCALE, v1[2] * Q8_SCALE, v1[3] * Q8_SCALE);
                    st8(rowp + bj * HALF, w);
                    s += (v0[0] * v0[0] + v0[1] * v0[1]) + (v0[2] * v0[2] + v0[3] * v0[3]) + (v1[0] * v1[0] + v1[1] * v1[1]) + (v1[2] * v1[2] + v1[3] * v1[3]); }
                s += __shfl_xor(s, 16); s += __shfl_xor(s, 32); ssum[ai][m] = s; }
        if (u.aux == 0)
#pragma unroll
        for (int ai = 0; ai < 2; ++ai) { const float v = fq == 0 ? ssum[ai][0] : fq == 1 ? ssum[ai][1] : fq == 2 ? ssum[ai][2] : ssum[ai][3];
            atomicAdd(so + u.row0 + ai * HALF + wr * 64 + fq * 16 + fr, v); }
    }
};
struct EpiUp {
    static constexpr bool PERM = true, AFTER_DRAIN = false, ROWSCALE = true;
    __device__ __forceinline__ const float* rs_src() const { return ssq_in; }
    bf16_t* O; const float* ssq_in;
    __device__ __forceinline__ void operator()(const f32x4 (&acc)[2][2][4][2], const Unit& u, int wr, int wc, int fr, int fq, PG8_LAS const float* rsc) const {
        const int col0 = u.col0 + wc * 32 + 8 * fq;
#ifdef EPIUP_SKIP_DUP
        if (u.aux != 0) return;
#endif
#pragma unroll
        for (int ai = 0; ai < 2; ++ai)
#pragma unroll
            for (int m = 0; m < 4; ++m) { const int row = u.row0 + ai * HALF + wr * 64 + m * 16 + fr; const float ri = rsc[ai * HALF + wr * 64 + m * 16 + fr];
                bf16_t* rowp = O + (size_t)(u.row0 >> 8) * (256 * DFF) + (size_t)((u.col0 >> 6) + (wc >> 1)) * (256 * 64) + (row & 255) * 64 + (wc & 1) * 32 + 8 * fq;
#pragma unroll
                for (int bj = 0; bj < 2; ++bj) { f32x4 v0 = acc[ai][bj][m][0] * ri, v1 = acc[ai][bj][m][1] * ri;
#pragma unroll
                    for (int e = 0; e < 4; ++e) { const float a = fmaxf(v0[e], 0.f), b = fmaxf(v1[e], 0.f); v0[e] = a * a; v1[e] = b * b; }
                    u32x4 w; w.x = cvt_pk_bf16(v0[0], v0[1]); w.y = cvt_pk_bf16(v0[2], v0[3]); w.z = cvt_pk_bf16(v1[0], v1[1]); w.w = cvt_pk_bf16(v1[2], v1[3]);
                    st16(rowp + bj * (2 * 256 * 64), w); } }
    }
};
struct EpiSoftmax {
    static constexpr bool PERM = true, AFTER_DRAIN = true, ROWSCALE = false;
    unsigned char* P; const float* ssqq;
    __device__ __forceinline__ void fused(f32x4 (&acc)[2][2][4][2], const Unit& u, int wr, int wc, int fr, int fq, PG8_LAS unsigned char* lds, int wid, int lane) const {
        PG8_LAS float* RM = (PG8_LAS float*)lds;
        PG8_LAS float* RS = (PG8_LAS float*)(lds + 4096);
        const float* sq = ssqq + (size_t)u.aux * MTOK;
        float mx[2][4];
#pragma unroll
        for (int ai = 0; ai < 2; ++ai)
#pragma unroll
            for (int m = 0; m < 4; ++m) { const int rl = ai * HALF + wr * 64 + m * 16 + fr; const int row = u.row0 + rl;
                const float sc = __builtin_amdgcn_rsqf(sq[row] * (1.0f / XD) + EPS) * (0.044194173824159216f * LOG2E / (Q8_SCALE * KH8_SCALE));
                float mxx = -3.0e38f;
#pragma unroll
                for (int bj = 0; bj < 2; ++bj)
#pragma unroll
                    for (int n = 0; n < 2; ++n) { f32x4 v = acc[ai][bj][m][n] * sc; acc[ai][bj][m][n] = v; mxx = fmaxf(mxx, fmaxf(fmaxf(v[0], v[1]), fmaxf(v[2], v[3]))); }
                mxx = fmaxf(mxx, __shfl_xor(mxx, 16)); mxx = fmaxf(mxx, __shfl_xor(mxx, 32));
                if (fq == 0) RM[rl * 4 + wc] = mxx; }
        asm volatile("s_waitcnt lgkmcnt(0)" ::: "memory"); __builtin_amdgcn_s_barrier(); asm volatile("" ::: "memory");
#pragma unroll
        for (int ai = 0; ai < 2; ++ai)
#pragma unroll
            for (int m = 0; m < 4; ++m) { const int rl = ai * HALF + wr * 64 + m * 16 + fr;
                const f32x4 r4 = *(const PG8_LAS f32x4*)(RM + rl * 4); const float mxx = fmaxf(fmaxf(r4[0], r4[1]), fmaxf(r4[2], r4[3])); mx[ai][m] = mxx; float s = 0.f;
#pragma unroll
                for (int bj = 0; bj < 2; ++bj)
#pragma unroll
                    for (int n = 0; n < 2; ++n) { f32x4 v = acc[ai][bj][m][n];
#pragma unroll
                        for (int e = 0; e < 4; ++e) { v[e] = __builtin_amdgcn_exp2f(v[e] - mxx); s += v[e]; }
                        acc[ai][bj][m][n] = v; }
                s += __shfl_xor(s, 16); s += __shfl_xor(s, 32);
                if (fq == 0) RS[rl * 4 + wc] = s; }
        asm volatile("s_waitcnt lgkmcnt(0)" ::: "memory"); __builtin_amdgcn_s_barrier(); asm volatile("" ::: "memory");
        const int col0 = u.col0 + wc * 32 + 8 * fq;
#pragma unroll
        for (int ai = 0; ai < 2; ++ai)
#pragma unroll
            for (int m = 0; m < 4; ++m) { const int rl = ai * HALF + wr * 64 + m * 16 + fr;
                const f32x4 r4 = *(const PG8_LAS f32x4*)(RS + rl * 4); const float inv = P8_SCALE / ((r4[0] + r4[1]) + (r4[2] + r4[3]));
                unsigned char* rowp = P + (size_t)(u.row0 + rl) * 1024 + col0;
#pragma unroll
                for (int bj = 0; bj < 2; ++bj) { const f32x4 v0 = acc[ai][bj][m][0] * inv, v1 = acc[ai][bj][m][1] * inv;
                    u32x2 w; w.x = pk4_fp8(v0[0], v0[1], v0[2], v0[3]); w.y = pk4_fp8(v1[0], v1[1], v1[2], v1[3]);
                    st8(rowp + bj * HALF, w); } }
        (void)mx; (void)wid; (void)lane;
    }
};
}
namespace fox {
typedef short bf16x8 __attribute__((ext_vector_type(8)));
typedef short s16x4 __attribute__((ext_vector_type(4)));
typedef float f32x16 __attribute__((ext_vector_type(16)));
typedef float f32x4 __attribute__((ext_vector_type(4)));
typedef unsigned u32x4 __attribute__((ext_vector_type(4)));
constexpr int D = 128, PITCH = 1024, OPITCH = 2048;
constexpr int NW = 8, QBLK = 32, KVBLK = 64, QB = NW * QBLK;
constexpr int SHM_V = KVBLK * D * 2, SHM_K = KVBLK * D * 2;
constexpr int LDS_BIAS = 0, LDS_WS = 512, LDS_V = 4096, LDS_K = LDS_V + 2 * SHM_V, LDS_BYTES = LDS_K + 2 * SHM_K;
constexpr float SCALE = 0.08838834764831845f, C2 = LOG2E * SCALE, THR = 8.f;

#define KSWZ(row, colB) ((row) * 256 + ((colB) ^ (((row) & 7) << 4)))
#define SBAR() __builtin_amdgcn_sched_barrier(0)
__device__ __forceinline__ int v_st(int k, int c) { const int kk = (k & ~0xC) | ((k & 4) << 1) | ((k & 8) >> 1); return ((kk >> 3) * 4 + (c >> 5)) * 512 + ((kk & 7) * 32 + (c & 31)) * 2; }
__device__ __forceinline__ int v_rd_base(int lane) { return ((lane & 3) << 3) | (((lane >> 2) & 3) << 6) | (((lane >> 4) & 1) << 5) | (((lane >> 5) & 1) << 8); }
constexpr int v_rd_off(int d0, int ks, int half) { return d0 * 512 + ks * 4096 + half * 2048; }
__device__ __forceinline__ int crow(int r, int hi) { return (r & 3) + 8 * (r >> 2) + 4 * hi; }
__device__ __forceinline__ unsigned cvtpk(float lo, float hi) { unsigned r; asm volatile("v_cvt_pk_bf16_f32 %0, %1, %2" : "=v"(r) : "v"(lo), "v"(hi)); return r; }
template <int CTRL> __device__ __forceinline__ float dppf(float x) { return __builtin_bit_cast(float, __builtin_amdgcn_update_dpp(0, __builtin_bit_cast(int, x), CTRL, 0xf, 0xf, false)); }
__device__ __forceinline__ bf16x8 load8(const bf16* p) { return *reinterpret_cast<const bf16x8*>(p); }

__device__ __forceinline__ void mask_tile(f32x16& p0, f32x16& p1, int dq) {
    const float NEG = -__builtin_inff();
#pragma unroll
    for (int r = 0; r < 16; ++r) { const int c = (r & 3) + 8 * (r >> 2);
        if (dq - c < 0) p0[r] = NEG;
        if (dq - c - 32 < 0) p1[r] = NEG; }
}
__device__ __forceinline__ void partialSM(f32x16& p0, f32x16& p1, float& m_reg, float& mn, float& alpha) {
    float pmax = p0[0];
#pragma unroll
    for (int r = 1; r < 16; ++r) pmax = fmaxf(pmax, p0[r]);
#pragma unroll
    for (int r = 0; r < 16; ++r) pmax = fmaxf(pmax, p1[r]);
    { auto rr = __builtin_amdgcn_permlane32_swap(__float_as_uint(pmax), __float_as_uint(pmax), false, false);
      pmax = fmaxf(__uint_as_float(rr[0]), __uint_as_float(rr[1])); }
    if (__builtin_expect(__all((pmax - m_reg) * SCALE <= THR), 1)) { mn = m_reg; alpha = 1.f; }
    else { mn = fmaxf(m_reg, pmax); alpha = __builtin_amdgcn_exp2f((m_reg - mn) * C2); m_reg = mn; }
    const float mnL = -mn * C2;
#pragma unroll
    for (int r = 0; r < 16; ++r) p0[r] = fmaf(p0[r], C2, mnL);
#pragma unroll
    for (int r = 0; r < 16; ++r) p1[r] = fmaf(p1[r], C2, mnL);
#pragma unroll
    for (int r = 0; r < 16; ++r) p0[r] = __builtin_amdgcn_exp2f(p0[r]);
}
__device__ __forceinline__ void finishSM(f32x16& p0, f32x16& p1, float alpha, float& l_reg, bf16x8& pa0, bf16x8& pa1, bf16x8& pa2, bf16x8& pa3) {
#pragma unroll
    for (int r = 0; r < 16; ++r) p1[r] = __builtin_amdgcn_exp2f(p1[r]);
    float ps = 0;
#pragma unroll
    for (int r = 0; r < 16; ++r) ps += p0[r];
#pragma unroll
    for (int r = 0; r < 16; ++r) ps += p1[r];
    { auto rr = __builtin_amdgcn_permlane32_swap(__float_as_uint(ps), __float_as_uint(ps), false, false);
      ps = __uint_as_float(rr[0]) + __uint_as_float(rr[1]); }
    l_reg = l_reg * alpha + ps;
#define PK4(P, B_, OUT) do { unsigned a0 = cvtpk(P[B_+0], P[B_+1]), a1 = cvtpk(P[B_+2], P[B_+3]);                          \
        unsigned b0 = cvtpk(P[B_+4], P[B_+5]), b1 = cvtpk(P[B_+6], P[B_+7]);                                             \
        auto r0 = __builtin_amdgcn_permlane32_swap(a0, b0, false, false); auto r1 = __builtin_amdgcn_permlane32_swap(a1, b1, false, false); \
        u32x4 w = {r0[0], r1[0], r0[1], r1[1]}; OUT = *reinterpret_cast<bf16x8*>(&w); } while (0)
    PK4(p0, 0, pa0); PK4(p0, 8, pa1); PK4(p1, 0, pa2); PK4(p1, 8, pa3);
#undef PK4
}
template <int KB>
__device__ __forceinline__ void qkt(f32x16& p0, f32x16& p1, const char* K_lds, const float* bl, int r32, int hi, const bf16x8* qr) {
#pragma unroll
    for (int g = 0; g < 4; ++g) { const f32x4 b0 = *(const f32x4*)(bl + KB * 64 + 8 * g + 4 * hi), b1 = *(const f32x4*)(bl + KB * 64 + 32 + 8 * g + 4 * hi);
#pragma unroll
        for (int i = 0; i < 4; ++i) { p0[4 * g + i] = b0[i]; p1[4 * g + i] = b1[i]; } }
    const char* kb[4];
#pragma unroll
    for (int dd = 0; dd < 4; ++dd) kb[dd] = K_lds + KB * SHM_K + KSWZ(r32, (dd * 16 + hi * 8) * 2);
#pragma unroll
    for (int d0 = 0; d0 < 8; ++d0) { const char* a = kb[d0 & 3] + (d0 >> 2) * 128;
        bf16x8 b0 = *reinterpret_cast<const bf16x8*>(a);
        bf16x8 b1 = *reinterpret_cast<const bf16x8*>(a + 32 * 256);
        const bf16x8 qf = qr[d0];
        p0 = __builtin_amdgcn_mfma_f32_32x32x16_bf16(b0, qf, p0, 0, 0, 0);
        p1 = __builtin_amdgcn_mfma_f32_32x32x16_bf16(b1, qf, p1, 0, 0, 0); }
}
template <int VB>
__device__ __forceinline__ void pv_tile(f32x16* o, int vb0, bf16x8 pa0, bf16x8 pa1, bf16x8 pa2, bf16x8 pa3) {
#define TRRD(dst, off) asm volatile("ds_read_b64_tr_b16 %0, %1 offset:%2" : "=&v"(dst) : "v"(vb0), "i"(off) : "memory")
#define PV_D0(d0) do { s16x4 l0, l1, l2, l3, h0, h1, h2, h3; constexpr int b_ = VB * SHM_V + v_rd_off(d0, 0, 0); \
        TRRD(l0, b_); TRRD(h0, b_ + 2048); TRRD(l1, b_ + 4096); TRRD(h1, b_ + 6144); TRRD(l2, b_ + 8192); TRRD(h2, b_ + 10240); TRRD(l3, b_ + 12288); TRRD(h3, b_ + 14336); \
        asm volatile("s_waitcnt lgkmcnt(0)" ::: "memory"); SBAR();   \
        o[d0] = __builtin_amdgcn_mfma_f32_32x32x16_bf16(pa0, (bf16x8){l0[0], l0[1], l0[2], l0[3], h0[0], h0[1], h0[2], h0[3]}, o[d0], 0, 0, 0);   \
        o[d0] = __builtin_amdgcn_mfma_f32_32x32x16_bf16(pa1, (bf16x8){l1[0], l1[1], l1[2], l1[3], h1[0], h1[1], h1[2], h1[3]}, o[d0], 0, 0, 0);   \
        o[d0] = __builtin_amdgcn_mfma_f32_32x32x16_bf16(pa2, (bf16x8){l2[0], l2[1], l2[2], l2[3], h2[0], h2[1], h2[2], h2[3]}, o[d0], 0, 0, 0);   \
        o[d0] = __builtin_amdgcn_mfma_f32_32x32x16_bf16(pa3, (bf16x8){l3[0], l3[1], l3[2], l3[3], h3[0], h3[1], h3[2], h3[3]}, o[d0], 0, 0, 0); } while (0)
    PV_D0(0); PV_D0(1); PV_D0(2); PV_D0(3);
#undef PV_D0
#undef TRRD
}

struct Item { unsigned rowb, o; const float* CS; const float* G; int P0, jlo; };
struct Seam { bf16x8 qr[8]; bf16x8 st_v0, st_v1, st_k0, st_k1; };
typedef __amdgpu_buffer_rsrc_t Srd;
#define BL8(rs, vo, so) __builtin_bit_cast(bf16x8, __builtin_amdgcn_raw_buffer_load_b128((rs), (vo), (so), 0))
#define VMW() asm volatile("s_waitcnt vmcnt(0)" ::: "memory")
#define VMWN(n) asm volatile("s_waitcnt vmcnt(%0)" :: "i"(n) : "memory")
#define SLOAD_H(H, k0, bb) do { const unsigned so_ = (unsigned)(k0) * (PITCH * 2);                                               \
                         S.st_v0 = BL8(R, kvoff, (unsigned)WS_FV + (H).rowb + so_); S.st_v1 = BL8(R, kvoff, (unsigned)WS_FV + (H).rowb + so_ + 32 * PITCH * 2);   \
                         S.st_k0 = BL8(R, kvoff, (unsigned)WS_FK + (H).rowb + so_); S.st_k1 = BL8(R, kvoff, (unsigned)WS_FK + (H).rowb + so_ + 32 * PITCH * 2);   \
                         if (wid == 0) __builtin_amdgcn_global_load_lds((const unsigned*)((H).CS + (k0)) + lane, (__attribute__((address_space(3))) unsigned*)(B3 + (bb) * 64), 4, 0, 0); } while (0)
#define QLOAD(H) do { const unsigned so_ = (unsigned)((H).P0 + wid * QBLK) * (PITCH * 2);                                   \
        _Pragma("unroll") for (int d0 = 0; d0 < 8; ++d0) S.qr[d0] = BL8(R, qoff + d0 * 32, (unsigned)WS_FQ + (H).rowb + so_); } while (0)
#define SWRITE_HK(bf) do { *(bf16x8*)(K_lds + (bf) * SHM_K + kws) = S.st_k0; *(bf16x8*)(K_lds + (bf) * SHM_K + kws + 32 * 256) = S.st_k1; } while (0)
#define SWRITE_HV(bf) do { *(bf16x8*)(V_lds + (bf) * SHM_V + vst0) = S.st_v0; *(bf16x8*)(V_lds + (bf) * SHM_V + vst1) = S.st_v1; } while (0)
#define SWRITE_H(bf) do { SWRITE_HV(bf); SWRITE_HK(bf); } while (0)

__device__ __forceinline__ void fox_prime(const Srd R, const Item& H, char* lds, Seam& S, int wv) {
    const int tid = wg_tid(wv), wid = wv, lane = tid & 63, r32 = lane & 31, hi = lane >> 5;
    const int sr = tid >> 4, sc = (tid & 15) * 8, kws = KSWZ(sr, sc * 2); char* K_lds = lds + LDS_K; float* B_lds = (float*)(lds + LDS_BIAS);
    const unsigned kvoff = (unsigned)(sr * PITCH + sc) * 2u, qoff = (unsigned)(r32 * PITCH + hi * 8) * 2u;
    __attribute__((address_space(3))) float* B3 = (__attribute__((address_space(3))) float*)B_lds;
    QLOAD(H);
    SLOAD_H(H, H.jlo * KVBLK, 0); VMW(); SWRITE_HK(0);
    __syncthreads();
}
template <class NextFn>
__device__ __forceinline__ int fox_block(const Srd R, const Item& H, const NextFn& next_item, char* lds, Seam& S, int wv) {
    const int P0 = H.P0;
    const int tid = wg_tid(wv), wid = wv, lane = tid & 63, r32 = lane & 31, hi = lane >> 5;
    const int NT = P0 / KVBLK + 4 - H.jlo;
    const int qlo = P0 + wid * QBLK, qm = qlo + r32 - 4 * hi;
    char* V_lds = lds + LDS_V; char* K_lds = lds + LDS_K; float* B_lds = (float*)(lds + LDS_BIAS);
    float* ws = (float*)(lds + LDS_WS) + wid * 64; float* li_l = ws, * al_l = ws + 32;
    float m_reg = -1e30f, l_reg = 0; f32x16 o[4] = {};
    const int sr = tid >> 4, sc = (tid & 15) * 8, vst0 = v_st(sr, sc), vst1 = v_st(32 + sr, sc), kws = KSWZ(sr, sc * 2);
    const int vb0 = (int)(uintptr_t)V_lds + v_rd_base(lane);
    const unsigned kvoff = (unsigned)(sr * PITCH + sc) * 2u, qoff = (unsigned)(r32 * PITCH + hi * 8) * 2u;
    __attribute__((address_space(3))) float* B3 = (__attribute__((address_space(3))) float*)B_lds;
#define RESC(a) do { if (__any((a) < 1.f)) { if (hi == 0) al_l[r32] = (a); asm volatile("s_waitcnt lgkmcnt(0)" ::: "memory");              \
                     for (int d_ = 0; d_ < 4; ++d_) for (int r = 0; r < 16; ++r) o[d_][r] *= al_l[crow(r, hi)]; } } while (0)
#define KBASE(t) ((H.jlo + (t)) * KVBLK)
#define MASKT(P0_, P1_, t) do { const int kb_ = KBASE(t); if (kb_ + KVBLK - 1 > qlo) mask_tile(P0_, P1_, qm - kb_); } while (0)
    f32x16 pA0, pA1, pB0, pB1; float mnA, mnB, alA, alB; bf16x8 pa0, pa1, pa2, pa3;
    SWRITE_HV(0); SBAR();
    SLOAD_H(H, KBASE(1), 1);
    SBAR(); qkt<0>(pA0, pA1, K_lds, B_lds, r32, hi, S.qr);
    MASKT(pA0, pA1, 0); partialSM(pA0, pA1, m_reg, mnA, alA);
    VMW(); SWRITE_H(1);
    __syncthreads();
#define HALF_STEP(PX0, PX1, mnX, alX, PY0, PY1, alY, t, KB, VB, SB) do {                                                      \
        SBAR(); qkt<KB>(PX0, PX1, K_lds, B_lds, r32, hi, S.qr);                                                                 \
        finishSM(PY0, PY1, alY, l_reg, pa0, pa1, pa2, pa3); SBAR();                                                           \
        if ((t) + 1 < NT) { SLOAD_H(H, KBASE((t) + 1), SB); SBAR(); }                                                                \
        pv_tile<VB>(o, vb0, pa0, pa1, pa2, pa3); MASKT(PX0, PX1, (t)); partialSM(PX0, PX1, m_reg, mnX, alX);                  \
        __syncthreads();                                                                                                      \
        if ((t) + 1 < NT) { VMW(); SWRITE_H(SB); }                                                                      \
        RESC(alX); __syncthreads(); } while (0)
    for (int t = 1; t + 1 < NT; t += 2) {
        HALF_STEP(pB0, pB1, mnB, alB, pA0, pA1, alA, t, 1, 0, 0);
        HALF_STEP(pA0, pA1, mnA, alA, pB0, pB1, alB, t + 1, 0, 1, 1);
    }
    SBAR(); qkt<1>(pB0, pB1, K_lds, B_lds, r32, hi, S.qr); SBAR();
    int nidx; const Item N = next_item(H, nidx);
    SLOAD_H(N, N.jlo * KVBLK, 0); SBAR();
    QLOAD(N);
    SBAR();
    finishSM(pA0, pA1, alA, l_reg, pa0, pa1, pa2, pa3); SBAR();
    pv_tile<0>(o, vb0, pa0, pa1, pa2, pa3);
    MASKT(pB0, pB1, NT - 1); partialSM(pB0, pB1, m_reg, mnB, alB); __syncthreads(); RESC(alB);
    finishSM(pB0, pB1, alB, l_reg, pa0, pa1, pa2, pa3); SBAR(); pv_tile<1>(o, vb0, pa0, pa1, pa2, pa3);
    SBAR(); VMWN(8); SWRITE_HK(0); SBAR();
    if (hi == 0) li_l[r32] = l_reg; asm volatile("s_waitcnt lgkmcnt(0)" ::: "memory");
    float gn[4];
#pragma unroll
    for (int d0 = 0; d0 < 4; ++d0) gn[d0] = H.G[d0 * 32 + r32];
    const unsigned ovoff2 = (unsigned)(4 * hi * OPITCH + (r32 & ~1)) * 2u + ((r32 & 1) ? 64u : 0u);
#pragma unroll
    for (int r = 0; r < 16; ++r) { const float rli = __builtin_amdgcn_rcpf(li_l[crow(r, hi)]); float ss = 0.f;
#pragma unroll
        for (int d0 = 0; d0 < 4; ++d0) { o[d0][r] *= rli; ss += o[d0][r] * o[d0][r]; }
        ss += dppf<0xB1>(ss); ss += dppf<0x4E>(ss); ss += dppf<0x141>(ss); ss += dppf<0x140>(ss);
        ss += __builtin_bit_cast(float, __builtin_amdgcn_ds_swizzle(__builtin_bit_cast(int, ss), 0x401F));
        const float rs = __builtin_amdgcn_rsqf(ss * (1.0f / D) + EPS);
        const unsigned so_ = (unsigned)(P0 + wid * QBLK + (r & 3) + 8 * (r >> 2)) * (OPITCH * 2);
        const bool odd = (r32 & 1) != 0;
#pragma unroll
        for (int dp = 0; dp < 2; ++dp) { const float va = o[2 * dp][r] * rs * gn[2 * dp], vb = o[2 * dp + 1][r] * rs * gn[2 * dp + 1];
            const float rcv = dppf<0xB1>(odd ? va : vb);
            const unsigned w = odd ? cvtpk(rcv, vb) : cvtpk(va, rcv);
            __builtin_amdgcn_raw_buffer_store_b32(w, R, ovoff2 + dp * 128, H.o + so_, 0); } }
    __syncthreads();
    return nidx;
#undef RESC
#undef KBASE
#undef MASKT
#undef HALF_STEP
}
#undef BL8
#undef QLOAD
#undef VMW
#undef VMWN
#undef SLOAD_H
#undef SWRITE_HK
#undef SWRITE_HV
#undef SWRITE_H
#undef KSWZ
#undef SBAR
}
namespace mls {
typedef short bf16x8 __attribute__((ext_vector_type(8)));
typedef short bf16x4 __attribute__((ext_vector_type(4)));
typedef float f32x4 __attribute__((ext_vector_type(4)));
#define MFMA16(a, b, c) __builtin_amdgcn_mfma_f32_16x16x32_bf16((a), (b), (c), 0, 0, 0)

constexpr int CO_CST = 0, CO_VT = 65536, CO_XCH = 98304, CO_LDS_BYTES = CO_XCH + 512;
__device__ __forceinline__ void chunk_out(int b, int h, int c, const bf16* QP, const bf16* KPP, const bf16* VT, const bf16* CST, const float* NST,
                                          const bf16* MO, const float* gain, bf16* concat, __attribute__((address_space(3))) unsigned char* lds, int wv) {
    typedef __attribute__((address_space(3))) unsigned char* lptr;
    const int tid = wg_tid(wv), w = wv, lane = tid & 63, i16 = lane & 15, q = lane >> 4;
    const int tq = w & 3, dvh = w >> 2;
    const size_t R0 = (size_t)b * SEQ + (size_t)c * 64;
    const size_t item = ((size_t)(b * MLH + h) * NCHUNK + c);
    { const bf16* cs = CST + item * MLDV * MLDK; const bf16* vs = VT + item * MLDV * 64;
#pragma unroll
      for (int j = 0; j < 8; ++j) { const int p = w + 8 * j, row = 4 * p + (lane >> 4), lc = (lane & 15) ^ (row & 15);
          __builtin_amdgcn_global_load_lds((const unsigned*)(cs + row * MLDK + lc * 8), (__attribute__((address_space(3))) unsigned*)(lds + CO_CST + p * 1024), 16, 0, 0); }
#pragma unroll
      for (int j = 0; j < 4; ++j) { const int p = w + 8 * j, row = 8 * p + (lane >> 3), lc = (lane & 7) ^ ((row >> 1) & 7);
          __builtin_amdgcn_global_load_lds((const unsigned*)(vs + row * 64 + lc * 8), (__attribute__((address_space(3))) unsigned*)(lds + CO_VT + p * 1024), 16, 0, 0); } }
    const size_t row = R0 + 16 * tq + i16;
    const bf16* qrow = QP + row * 512 + h * MLDK + 8 * q;
    bf16x8 qf[4];
#pragma unroll
    for (int ks = 0; ks < 4; ++ks) qf[ks] = *(const bf16x8*)(qrow + 32 * ks);
    f32x4 st[4];
#pragma unroll
    for (int stile = 0; stile < 4; ++stile) {
        st[stile] = (f32x4){0.f, 0.f, 0.f, 0.f};
        if (stile <= tq) {
            const bf16* krow = KPP + (R0 + 16 * stile + i16) * 512 + h * MLDK + 8 * q;
            bf16x8 kf[4];
#pragma unroll
            for (int ks = 0; ks < 4; ++ks) kf[ks] = *(const bf16x8*)(krow + 32 * ks);
#pragma unroll
            for (int ks = 0; ks < 4; ++ks) st[stile] = MFMA16(kf[ks], qf[ks], st[stile]);
            if (stile == tq) {
#pragma unroll
                for (int r = 0; r < 4; ++r) if (4 * q + r > i16) st[stile][r] = 0.f;
            }
        }
    }
    float den = 0.f;
#pragma unroll
    for (int stile = 0; stile < 4; ++stile) den += (st[stile][0] + st[stile][1]) + (st[stile][2] + st[stile][3]);
    { const float* nrow = NST + item * MLDK + 8 * q;
#pragma unroll
      for (int ks = 0; ks < 4; ++ks) { const f32x4 n0 = *(const f32x4*)(nrow + 32 * ks), n1 = *(const f32x4*)(nrow + 32 * ks + 4);
          const v4u qq = __builtin_bit_cast(v4u, qf[ks]);
          den += bflo(qq[0]) * n0[0] + bfhi(qq[0]) * n0[1] + bflo(qq[1]) * n0[2] + bfhi(qq[1]) * n0[3]
               + bflo(qq[2]) * n1[0] + bfhi(qq[2]) * n1[1] + bflo(qq[3]) * n1[2] + bfhi(qq[3]) * n1[3]; } }
    den += __shfl_xor(den, 16); den += __shfl_xor(den, 32);
    const int dv0 = h * MLDV + dvh * 128 + 4 * q;
    v2u mo2[8];
#pragma unroll
    for (int dt = 0; dt < 8; ++dt) mo2[dt] = *(const v2u*)(MO + row * 1024 + dv0 + 16 * dt);
    bf16x8 pf[2];
#pragma unroll
    for (int p = 0; p < 2; ++p) { v4u wv; wv[0] = pg8::cvt_pk_bf16(st[2 * p][0], st[2 * p][1]); wv[1] = pg8::cvt_pk_bf16(st[2 * p][2], st[2 * p][3]);
        wv[2] = pg8::cvt_pk_bf16(st[2 * p + 1][0], st[2 * p + 1][1]); wv[3] = pg8::cvt_pk_bf16(st[2 * p + 1][2], st[2 * p + 1][3]); pf[p] = __builtin_bit_cast(bf16x8, wv); }
    const int npair = (tq >> 1) + 1;
    asm volatile("s_waitcnt vmcnt(0)" ::: "memory");
    __syncthreads();
    f32x4 num[8];
    const lptr cb = lds + CO_CST + (dvh * 128 + i16) * 256, vb = lds + CO_VT + (dvh * 128 + i16) * 128 + (q & 1) * 8;
    const int vsw = i16 >> 1;
#pragma unroll
    for (int dt = 0; dt < 8; ++dt) {
        f32x4 a = (f32x4){0.f, 0.f, 0.f, 0.f};
#pragma unroll
        for (int p = 0; p < 2; ++p) if (p < npair) {
            const v2u lo = *(const __attribute__((address_space(3))) v2u*)(vb + dt * 16 * 128 + (((4 * p + (q >> 1)) ^ vsw) * 16));
            const v2u hi2 = *(const __attribute__((address_space(3))) v2u*)(vb + dt * 16 * 128 + (((4 * p + 2 + (q >> 1)) ^ vsw) * 16));
            const v4u vv = {lo[0], lo[1], hi2[0], hi2[1]};
            a = MFMA16(__builtin_bit_cast(bf16x8, vv), pf[p], a); }
#pragma unroll
        for (int ks = 0; ks < 4; ++ks) { const bf16x8 cf = *(const __attribute__((address_space(3))) bf16x8*)(cb + dt * 16 * 256 + (((4 * ks + q) ^ i16) * 16)); a = MFMA16(cf, qf[ks], a); }
        num[dt] = a;
    }
    const float rden = 1.0f / fmaxf(fabsf(den), 1.0f);
    float ss = 0.f;
#pragma unroll
    for (int dt = 0; dt < 8; ++dt) { num[dt] = num[dt] * rden; ss += (num[dt][0] * num[dt][0] + num[dt][1] * num[dt][1]) + (num[dt][2] * num[dt][2] + num[dt][3] * num[dt][3]); }
    ss += __shfl_xor(ss, 16); ss += __shfl_xor(ss, 32);
    __attribute__((address_space(3))) float* xch = (__attribute__((address_space(3))) float*)(lds + CO_XCH);
    if (q == 0) xch[w * 16 + i16] = ss;
    __syncthreads();
    const float tot = ss + xch[(w ^ 4) * 16 + i16];
    const float rn = __builtin_amdgcn_rsqf(tot * (1.0f / MLDV) + EPS);
#pragma unroll
    for (int dt = 0; dt < 8; ++dt) { const int dv = dv0 + 16 * dt;
        const f32x4 g4 = *(const f32x4*)(gain + dv);
        const float o0 = num[dt][0] * rn * g4[0] * sigmoidf_(bflo(mo2[dt][0])), o1 = num[dt][1] * rn * g4[1] * sigmoidf_(bfhi(mo2[dt][0]));
        const float o2 = num[dt][2] * rn * g4[2] * sigmoidf_(bflo(mo2[dt][1])), o3 = num[dt][3] * rn * g4[3] * sigmoidf_(bfhi(mo2[dt][1]));
        v2u ov; ov[0] = pg8::cvt_pk_bf16(o0, o1); ov[1] = pg8::cvt_pk_bf16(o2, o3);
        *(v2u*)(concat + row * 2048 + 1024 + dv) = ov; }
    __syncthreads();
}

constexpr int SS_NS = 6, SS_SLOT = 12288, SS_STG = SS_NS * SS_SLOT, SS_STG_PITCH = 144, SS_STG_BYTES = 32 * SS_STG_PITCH;
__device__ __forceinline__ void state_scan(int bh, int sl, const bf16* KT, const bf16* VT, const float* EB, bf16* CST, __attribute__((address_space(3))) unsigned char* lds, int wv, bool do_store = true) {
    typedef __attribute__((address_space(3))) unsigned char* lptr;
    const int tid = wg_tid(wv), w = wv, lane = tid & 63, i16 = lane & 15, q = lane >> 4;
    const int dvs = sl >> 1, dkh = sl & 1;
    const size_t it0 = (size_t)bh * NCHUNK;
    const bf16* kt0 = KT + (it0 * MLDK + 64 * dkh) * 64; const bf16* vt0 = VT + (it0 * MLDV + 32 * dvs) * 64;
    const float ebv = EB[it0 + lane];
    const int prow = lane >> 3, pcol = lane & 7;
    const int p0 = w, p1 = w + 6;
    const int r0 = 8 * p0 + prow, r1 = 8 * (p1 & 7) + prow;
    const unsigned src0 = (unsigned)(r0 * 64 + ((pcol ^ ((r0 >> 1) & 7)) * 8));
    const unsigned src1 = (unsigned)(r1 * 64 + ((pcol ^ ((r1 >> 1) & 7)) * 8));
    const bool p1v = p1 >= 8;
    const bf16* s1base = p1v ? vt0 : kt0; const size_t s1stride = p1v ? (size_t)MLDV * 64 : (size_t)MLDK * 64; const unsigned d1 = p1v ? 8192u + (unsigned)(p1 - 8) * 1024u : (unsigned)p1 * 1024u;
#define SS_DMA(cc, slot) do { const lptr sb_ = lds + (slot) * SS_SLOT;                                                                                        \
        __builtin_amdgcn_global_load_lds((const unsigned*)(kt0 + (size_t)(cc) * MLDK * 64 + src0), (__attribute__((address_space(3))) unsigned*)(sb_ + p0 * 1024), 16, 0, 0);   \
        __builtin_amdgcn_global_load_lds((const unsigned*)(s1base + (size_t)(cc) * s1stride + src1), (__attribute__((address_space(3))) unsigned*)(sb_ + d1), 16, 0, 0); } while (0)
    if (w < 6) {
#pragma unroll
        for (int j = 0; j < SS_NS - 1; ++j) SS_DMA(j, j); }
    f32x4 acc = (f32x4){0.f, 0.f, 0.f, 0.f};
    const int swz = (i16 >> 1) & 7;
    const unsigned aoff = (unsigned)((16 * (w & 3) + i16) * 128), boff = (unsigned)(8192 + (16 * (w >> 2) + i16) * 128);
    const unsigned stw = (unsigned)(SS_STG + (16 * (w >> 2) + i16) * SS_STG_PITCH + (16 * (w & 3) + 4 * q) * 2);
    const int wrow = 16 * (w & 1) + (lane >> 3);
    const unsigned strd = (unsigned)(SS_STG + wrow * SS_STG_PITCH + (lane & 7) * 16);
    bf16* cs = CST + (it0 * MLDV + 32 * dvs + wrow) * MLDK + 64 * dkh + 8 * (lane & 7);
    int slot = 0;
    for (int c = 0; c < NCHUNK; ++c) {
        if (w < 6) asm volatile("s_waitcnt vmcnt(8)" ::: "memory");
        asm volatile("s_waitcnt lgkmcnt(0)" ::: "memory");
        __builtin_amdgcn_s_barrier();
        asm volatile("" ::: "memory");
        if (w < 6) { const int cn = c + SS_NS - 1 < NCHUNK ? c + SS_NS - 1 : NCHUNK - 1; const int sn = slot == 0 ? SS_NS - 1 : slot - 1; SS_DMA(cn, sn); }
        else if (c > 0 && do_store) { const lptr sg = lds + ((c - 1) & 1) * SS_STG_BYTES + strd;
            const v4u s0 = *(const __attribute__((address_space(3))) v4u*)sg, s1 = *(const __attribute__((address_space(3))) v4u*)(sg + 8 * SS_STG_PITCH);
            bf16* cd = cs + (size_t)(c - 1) * MLDV * MLDK; *(v4u*)cd = s0; *(v4u*)(cd + 8 * MLDK) = s1; }
        const lptr sb = lds + slot * SS_SLOT;
        const bf16x8 a0 = *(const __attribute__((address_space(3))) bf16x8*)(sb + aoff + ((q ^ swz) * 16)), a1 = *(const __attribute__((address_space(3))) bf16x8*)(sb + aoff + (((4 + q) ^ swz) * 16));
        const bf16x8 b0 = *(const __attribute__((address_space(3))) bf16x8*)(sb + boff + ((q ^ swz) * 16)), b1 = *(const __attribute__((address_space(3))) bf16x8*)(sb + boff + (((4 + q) ^ swz) * 16));
        v2u ov; ov[0] = pg8::cvt_pk_bf16(acc[0], acc[1]); ov[1] = pg8::cvt_pk_bf16(acc[2], acc[3]);
        if (do_store) *(__attribute__((address_space(3))) v2u*)(lds + (c & 1) * SS_STG_BYTES + stw) = ov; else asm volatile("" :: "v"(ov));
        acc = MFMA16(a0, b0, acc); acc = MFMA16(a1, b1, acc);
        const float e = __builtin_bit_cast(float, __builtin_amdgcn_readlane(__builtin_bit_cast(int, ebv), c));
        acc = acc * e;
        slot = slot == SS_NS - 1 ? 0 : slot + 1;
    }
    asm volatile("s_waitcnt lgkmcnt(0)" ::: "memory");
    __builtin_amdgcn_s_barrier();
    asm volatile("" ::: "memory");
    if (w >= 6 && do_store) { const lptr sg = lds + ((NCHUNK - 1) & 1) * SS_STG_BYTES + strd;
        const v4u s0 = *(const __attribute__((address_space(3))) v4u*)sg, s1 = *(const __attribute__((address_space(3))) v4u*)(sg + 8 * SS_STG_PITCH);
        bf16* cd = cs + (size_t)(NCHUNK - 1) * MLDV * MLDK; *(v4u*)cd = s0; *(v4u*)(cd + 8 * MLDK) = s1; }
    asm volatile("s_waitcnt vmcnt(0) lgkmcnt(0)" ::: "memory");
    __builtin_amdgcn_s_barrier();
#undef SS_DMA
}
#undef MFMA16
}
typedef const float* cfp_t;
struct Frame {
    LAS unsigned char* lds; unsigned char* ldsg;
    int tid, lane, wave, vcu, G;
    const __attribute__((address_space(4))) cfp_t* inp; float* out; unsigned char* ws;
};
__device__ __forceinline__ void refresh_ids(Frame& F) { F.tid = wg_tid(F.wave); F.lane = F.tid & 63; }
__device__ __forceinline__ float wave_incl_scan(float v, int lane) {
#pragma unroll
    for (int o = 1; o < 64; o <<= 1) { const float t = __shfl_up(v, o); if (lane >= o) v += t; }
    return v;
}

#ifndef X_NT_LOAD
#define X_NT_LOAD 1
#endif
#if X_NT_LOAD
#define NT_LD(p) __builtin_nontemporal_load(p)
#else
#define NT_LD(p) (*(p))
#endif
#ifndef W_NT_LOAD
#define W_NT_LOAD 1
#endif
#ifndef W_NT_STORE
#define W_NT_STORE 0
#endif
#if W_NT_STORE
#define W_ST(p, v) __builtin_nontemporal_store((v), (p))
#else
#define W_ST(p, v) (*(p) = (v))
#endif
#ifndef P0_T_TWICE
#define P0_T_TWICE 1
#endif
struct TItem { const float* W; const float* gk; unsigned char* dst; float scale; int ldw, K, k0, n0d, n0s, mode; };
__device__ __forceinline__ TItem p0_titem(Frame& F, int r) {
    TItem I; I.gk = nullptr; I.scale = 1.0f; I.mode = 0; I.K = DM; int kt, nb;
    if (r < 768) { kt = r / 24; nb = r % 24; const int grpc = nb >> 2; I.W = F.inp[3]; I.ldw = IN_WIDTH; I.gk = F.inp[2]; I.dst = F.ws + WS_WIN; I.n0s = 256 * nb + (grpc < 3 ? 0 : (grpc < 5 ? 8 : 16)); }
    else if ((r -= 768) < 512) { kt = r >> 4; nb = r & 15; I.W = F.inp[17]; I.ldw = 2 * DM; I.dst = F.ws + WS_WXKV; I.n0s = 256 * nb; I.mode = 1; }
    else if ((r -= 512) < 256) { kt = r >> 3; nb = r & 7; I.W = F.inp[13]; I.ldw = DM; I.dst = F.ws + WS_WOUT; I.n0s = 256 * nb; }
    else if ((r -= 256) < 256) { kt = r >> 3; nb = r & 7; I.W = F.inp[16]; I.ldw = DM; I.gk = F.inp[14]; I.scale = W8_SCALE; I.dst = F.ws + WS_WXQ; I.n0s = 256 * nb; I.mode = 2; }
    else if ((r -= 256) < 256) { kt = r >> 3; nb = r & 7; I.W = F.inp[20]; I.ldw = DM; I.scale = W8_SCALE; I.dst = F.ws + WS_WXO; I.n0s = 256 * nb; I.mode = 2; }
    else if ((r -= 256) < 1024) { kt = r >> 5; nb = r & 31; I.W = F.inp[22]; I.ldw = DFF; I.gk = F.inp[21]; I.dst = F.ws + WS_WUP; I.n0s = 256 * nb; }
    else { r -= 1024; kt = r >> 3; nb = r & 7; I.W = F.inp[23]; I.ldw = DM; I.K = DFF; I.dst = F.ws + WS_WDN; I.n0s = 256 * nb; }
    I.k0 = 64 * kt; I.n0d = 256 * nb; return I;
}
__device__ __forceinline__ void p0_tload(const TItem& I, v4f (&v)[8], int wave, int lane) {
#pragma unroll
    for (int j = 0; j < 8; ++j) { const v4f* src = (const v4f*)(I.W + (size_t)(I.k0 + wave + 8 * j) * I.ldw + I.n0s + 4 * lane);
#if W_NT_LOAD
        v[j] = __builtin_nontemporal_load(src);
#else
        v[j] = *src;
#endif
    }
}
__device__ __forceinline__ void p0_tstage(const TItem& I, const v4f (&v)[8], LAS float* tile, int wave, int lane) {
#pragma unroll
    for (int j = 0; j < 8; ++j) { const int row = wave + 8 * j; const float g = (I.gk ? I.gk[I.k0 + row] : 1.0f) * I.scale;
        *(LAS v4f*)(tile + row * 256 + ((4 * lane) ^ (8 * ((row >> 3) & 7)))) = v[j] * g; }
}
__device__ __forceinline__ void p0_tstore(const TItem& I, const LAS float* tile, int wave, int lane) {
    const int nl = lane >> 3, kg = lane & 7;
#pragma unroll
    for (int i = 0; i < 4; ++i) { const int n = 8 * (wave + 8 * i) + nl; const LAS float* s = tile + (8 * kg) * 256 + (n ^ (8 * kg));
        const float e0 = s[0], e1 = s[256], e2 = s[512], e3 = s[768], e4 = s[1024], e5 = s[1280], e6 = s[1536], e7 = s[1792];
        if (I.mode == 2) { v2u o; o.x = pg8::pk4_fp8(e0, e1, e2, e3); o.y = pg8::pk4_fp8(e4, e5, e6, e7);
            W_ST((GAS v2u*)(I.dst + (size_t)I.n0d * I.K + (size_t)(I.k0 >> 7) * 32768 + n * 128 + (I.k0 & 127) + 8 * kg), o); }
        else { v4u o; o.x = pk2(e0, e1); o.y = pk2(e2, e3); o.z = pk2(e4, e5); o.w = pk2(e6, e7);
            if (I.mode == 0) W_ST((GAS v4u*)((bf16*)I.dst + (size_t)I.n0d * I.K + (size_t)(I.k0 >> 6) * 16384 + n * 64 + 8 * kg), o);
            else W_ST((GAS v4u*)((bf16*)I.dst + (size_t)(I.n0d + n) * I.K + I.k0 + 8 * kg), o); } }
}
#ifndef W_LATE_IN_P4
#define W_LATE_IN_P4 1
#endif
constexpr int W_ITEMS = 4096, W_EARLY = W_LATE_IN_P4 ? 1280 : 4096;
template <bool OPAQUE_LANE = false>
__device__ __forceinline__ void p0_convert(Frame& F, int first, int end, int stride) {
    const int lane_ = OPAQUE_LANE ? (wg_tid(F.wave) & 63) : F.lane;
    v4f ta[8], tb8[8]; int it = first;
    if (it < end) p0_tload(p0_titem(F, it), ta, F.wave, lane_);
    if (it + stride < end) p0_tload(p0_titem(F, it + stride), tb8, F.wave, lane_);
    LAS float* tile0 = (LAS float*)F.lds; LAS float* tile1 = (LAS float*)(F.lds + 65536);
    for (; it < end; it += 2 * stride) {
        p0_tstage(p0_titem(F, it), ta, tile0, F.wave, lane_);
        __syncthreads();
        if (it + 2 * stride < end) p0_tload(p0_titem(F, it + 2 * stride), ta, F.wave, lane_);
        p0_tstore(p0_titem(F, it), tile0, F.wave, lane_);
        if (it + stride < end) {
            p0_tstage(p0_titem(F, it + stride), tb8, tile1, F.wave, lane_);
            __syncthreads();
            if (it + 3 * stride < end) p0_tload(p0_titem(F, it + 3 * stride), tb8, F.wave, lane_);
            p0_tstore(p0_titem(F, it + stride), tile1, F.wave, lane_); }
    }
}
__device__ __forceinline__ void p0_convert1(Frame& F, int first, int end) {
    const int lane = wg_tid(F.wave) & 63;
    v4f ta[8]; int tb = 0;
    p0_tload(p0_titem(F, first), ta, F.wave, lane);
    for (int it = first; it < end; ++it) {
        LAS float* tile = (LAS float*)(F.lds + tb * 65536);
        p0_tstage(p0_titem(F, it), ta, tile, F.wave, lane);
        __syncthreads();
        if (it + 1 < end) p0_tload(p0_titem(F, it + 1), ta, F.wave, lane);
        p0_tstore(p0_titem(F, it), tile, F.wave, lane);
        tb ^= 1;
    }
}
__device__ __forceinline__ float rms_row_to_bf16(const float* xrow, const float* g, bf16* orow, int lane) {
    const GAS v4f* xr = (const GAS v4f*)xrow + lane; const GAS v4f* gr = (const GAS v4f*)g + lane;
    v4f v[8]; float s = 0.f;
#pragma unroll
    for (int j = 0; j < 8; ++j) { v[j] = xr[64 * j]; s += (v[j].x * v[j].x + v[j].y * v[j].y) + (v[j].z * v[j].z + v[j].w * v[j].w); }
    const float rinv = 1.0f / sqrtf(wave_sum(s) * (1.f / DM) + EPS);
    GAS v2u* o8 = (GAS v2u*)orow + lane;
#pragma unroll
    for (int j = 0; j < 8; ++j) { const v4f gg = gr[64 * j]; v2u w; w.x = pk2(v[j].x * rinv * gg.x, v[j].y * rinv * gg.y); w.y = pk2(v[j].z * rinv * gg.z, v[j].w * rinv * gg.w); o8[64 * j] = w; }
    return rinv;
}
__device__ __forceinline__ void p0_prologue(Frame& F) {
    refresh_ids(F);
    const float* x = F.inp[0]; const float* mem = F.inp[1]; const float* mixer_norm = F.inp[2]; const float* w_in = F.inp[3];
    const int gw = F.vcu * 8 + F.wave, NGW = F.G * 8;
    LAS float* WgL = (LAS float*)F.lds; const int khw = F.vcu & 1;
#pragma unroll 8
    for (int idx = F.tid; idx < 16384; idx += NTHREADS) { const int e = idx & 7, ln = (idx >> 3) & 63, sp = idx >> 9, gate = ln & 15, q = ln >> 4, k = 1024 * khw + 32 * sp + 8 * q + e;
        const int col = gate < 8 ? 3072 + gate : 5128 + (gate - 8);
        WgL[idx] = w_in[(size_t)k * IN_WIDTH + col] * mixer_norm[k]; }
    __syncthreads();
    { float* gates = (float*)(F.ws + WS_GATES); float* ssqx = (float*)(F.ws + WS_CTL + CTL_SSQX); bf16* XG = (bf16*)(F.ws + WS_XN);
      const int i16 = F.lane & 15, q = F.lane >> 4;
      for (int grp = (F.vcu >> 1) * 8 + F.wave; grp < MTOK / 16; grp += (F.G >> 1) * 8) { const int kh = khw; const size_t row = (size_t)grp * 16 + i16;
          const float* xr = x + row * DM + kh * 1024 + 8 * q; bf16* xo = XG + row * DM + kh * 1024 + 8 * q;
          const LAS float* wp = WgL + F.lane * 8;
          v4f acc = (v4f){0.f, 0.f, 0.f, 0.f}; float ss = 0.f;
#pragma unroll 1
          for (int s0 = 0; s0 < 32; s0 += 8, wp += 8 * 512, xr += 8 * 32, xo += 8 * 32) { v4f xb[8][2];
#pragma unroll
              for (int j = 0; j < 8; ++j) { xb[j][0] = NT_LD((const v4f*)(xr + 32 * j)); xb[j][1] = NT_LD((const v4f*)(xr + 32 * j + 4)); }
#pragma unroll
              for (int j = 0; j < 8; ++j) { const v4f x0 = xb[j][0], x1 = xb[j][1];
                  const v4f w0 = *(const LAS v4f*)(wp + j * 512), w1 = *(const LAS v4f*)(wp + j * 512 + 4);
                  ss += (x0.x * x0.x + x0.y * x0.y) + (x0.z * x0.z + x0.w * x0.w) + (x1.x * x1.x + x1.y * x1.y) + (x1.z * x1.z + x1.w * x1.w);
                  v4u o; o.x = pk2(x0.x, x0.y); o.y = pk2(x0.z, x0.w); o.z = pk2(x1.x, x1.y); o.w = pk2(x1.z, x1.w);
                  *(v4u*)(xo + 32 * j) = o;
                  acc = __builtin_amdgcn_mfma_f32_16x16x4f32(x0.x, w0.x, acc, 0, 0, 0); acc = __builtin_amdgcn_mfma_f32_16x16x4f32(x0.y, w0.y, acc, 0, 0, 0);
                  acc = __builtin_amdgcn_mfma_f32_16x16x4f32(x0.z, w0.z, acc, 0, 0, 0); acc = __builtin_amdgcn_mfma_f32_16x16x4f32(x0.w, w0.w, acc, 0, 0, 0);
                  acc = __builtin_amdgcn_mfma_f32_16x16x4f32(x1.x, w1.x, acc, 0, 0, 0); acc = __builtin_amdgcn_mfma_f32_16x16x4f32(x1.y, w1.y, acc, 0, 0, 0);
                  acc = __builtin_amdgcn_mfma_f32_16x16x4f32(x1.z, w1.z, acc, 0, 0, 0); acc = __builtin_amdgcn_mfma_f32_16x16x4f32(x1.w, w1.w, acc, 0, 0, 0); } }
          ss += __shfl_xor(ss, 16); ss += __shfl_xor(ss, 32);
          if (q == 0) atomicAdd(ssqx + row, ss);
#pragma unroll
          for (int r = 0; r < 4; ++r) atomicAdd(gates + ((size_t)grp * 16 + 4 * q + r) * 16 + i16, acc[r]);
      } }
    { bf16* MN = (bf16*)(F.ws + WS_MN);
      for (int m = gw; m < MROWS; m += NGW) (void)rms_row_to_bf16(mem + (size_t)m * DM, F.inp[15], MN + (size_t)m * DM, F.lane); }
    __syncthreads();
    p0_convert(F, F.vcu, W_EARLY, F.G);
}

constexpr int P2_KT_OFF = 4096, P2_KT_PITCH = 128, P2_VT_OFF = P2_KT_OFF + 64 * P2_KT_PITCH * 2, P2_VT_PITCH = 256;
constexpr int P2_BUF_ELEMS = (64 * P2_KT_PITCH + 64 * P2_VT_PITCH);
__device__ __forceinline__ void p2_prep_item(Frame& F, int item, bool do_norm = true) {
    refresh_ids(F);
    const int b = item >> 6, c = item & 63; const size_t R0 = (size_t)b * SEQ + (size_t)c * 64;
    const int tid = F.tid, lane = F.lane, w = F.wave;
    LAS float* gq = (LAS float*)F.lds; LAS float* uk = gq + 256;
    LAS bf16* kt = (LAS bf16*)(F.lds + P2_KT_OFF); LAS bf16* vt = (LAS bf16*)(F.lds + P2_VT_OFF);
    const float* GATES = (const float*)(F.ws + WS_GATES); const float* SSQX = (const float*)(F.ws + WS_CTL + CTL_SSQX);
    const bf16* MQK = (const bf16*)(F.ws + WS_MQK); const bf16* MV = (const bf16*)(F.ws + WS_MV);
    bf16* QP = (bf16*)((unsigned char*)F.out + WS_QP); bf16* KPP = (bf16*)((unsigned char*)F.out + WS_KPP);
    const float* conv_w = F.inp[7]; const float* conv_b = F.inp[8];
    const int cgp = tid & 31, rg = tid >> 5; const bool isq = cgp < 16;
    v4u rawc[7], rawv[4];
#define P2_LOAD(h_) do { const int col_ = (isq ? 0 : 512) + (h_) * MLDK + (cgp & 15) * 8;                                              \
        _Pragma("unroll") for (int i = 0; i < 7; ++i) { const int pos = c * 64 + 4 * rg - 3 + i;                                           \
            rawc[i] = (v4u){0u, 0u, 0u, 0u}; if (pos >= 0) rawc[i] = NT_LD((const v4u*)(MQK + ((size_t)b * SEQ + pos) * 1024 + col_)); }            \
        _Pragma("unroll") for (int i = 0; i < 4; ++i) { const int idx = tid + NTHREADS * i, row = idx >> 5, ch = idx & 31;                 \
            rawv[i] = NT_LD((const v4u*)(MV + (R0 + row) * 1024 + (h_) * MLDV + ch * 8)); } } while (0)
#define P2_CONV(h_, kt_, vt_) do { const int col_ = (isq ? 0 : 512) + (h_) * MLDK + (cgp & 15) * 8;                                       \
        float cw[4][8], cb[8];                                                                                                             \
        _Pragma("unroll") for (int e = 0; e < 8; ++e) { cb[e] = conv_b[col_ + e];                                                          \
            _Pragma("unroll") for (int j = 0; j < 4; ++j) cw[j][e] = conv_w[j * 1024 + col_ + e]; }                                        \
        float u[7][8];                                                                                                                     \
        _Pragma("unroll") for (int i = 0; i < 7; ++i) _Pragma("unroll") for (int e = 0; e < 4; ++e) { u[i][2 * e] = bflo(rawc[i][e]); u[i][2 * e + 1] = bfhi(rawc[i][e]); } \
        _Pragma("unroll") for (int r = 0; r < 4; ++r) { const int t = 4 * rg + r; const float f = isq ? gq[(h_) * 64 + t] : uk[(h_) * 64 + t]; float y[8]; \
            _Pragma("unroll") for (int e = 0; e < 8; ++e) { float a = cb[e];                                                               \
                _Pragma("unroll") for (int j = 0; j < 4; ++j) a += cw[j][e] * u[r + j][e];                                                 \
                y[e] = a * sigmoidf_(a) * f; }                                                                                             \
            v4u o; o.x = pk2(y[0], y[1]); o.y = pk2(y[2], y[3]); o.z = pk2(y[4], y[5]); o.w = pk2(y[6], y[7]);                             \
            *(v4u*)((isq ? QP : KPP) + (R0 + t) * 512 + (h_) * MLDK + (cgp & 15) * 8) = o;                                                 \
            if (!isq) *(LAS v4u*)((kt_) + t * P2_KT_PITCH + (((cgp & 15) ^ ((t >> 3) & 7)) * 8)) = o; }                                                         \
        _Pragma("unroll") for (int i = 0; i < 4; ++i) { const int idx = tid + NTHREADS * i, row = idx >> 5, ch = idx & 31;                 \
            *(LAS v4u*)((vt_) + row * P2_VT_PITCH + ((ch ^ ((row >> 3) & 7)) * 8)) = rawv[i]; } } while (0)
    P2_LOAD(0);
    float a_mi = 0.f, a_mf = 0.f, a_ss = 1.f;
    if (w < 4) { const size_t row = R0 + lane; a_mi = GATES[row * 16 + 8 + w]; a_mf = GATES[row * 16 + 12 + w]; a_ss = SSQX[row]; }
    { const int mr = item * 4 + (w & 3); const bf16* slab = (const bf16*)(F.ws + WS_SLAB);
      if (w < 4) {
        const float* gxq = F.inp[18]; const float* gxk = F.inp[19];
        v4f kv[8]; float ssh[4] = {0.f, 0.f, 0.f, 0.f};
#pragma unroll
        for (int j = 0; j < 8; ++j) { const int col = 4 * (lane + 64 * j); v4f a = (v4f){0.f, 0.f, 0.f, 0.f};
#pragma unroll
            for (int s = 0; s < 4; ++s) { const v2u r2 = *(const v2u*)(slab + ((size_t)s * MROWS + mr) * 4096 + col); a = a + (v4f){bflo(r2.x), bfhi(r2.x), bflo(r2.y), bfhi(r2.y)}; }
            kv[j] = a; ssh[j >> 1] += (a.x * a.x + a.y * a.y) + (a.z * a.z + a.w * a.w); }
        float rk[4];
#pragma unroll
        for (int hh = 0; hh < 4; ++hh) rk[hh] = 1.0f / sqrtf(wave_sum(ssh[hh]) * (1.0f / XD) + EPS);
        unsigned char* KH = F.ws + WS_KHAT + (size_t)mr * DM;
#pragma unroll
        for (int j = 0; j < 8; ++j) { const int col = 4 * (lane + 64 * j), d = col & (XD - 1); const v4f a = *(const v4f*)(gxq + d), g2 = *(const v4f*)(gxk + d); const float r = rk[j >> 1];
            const float r8 = r * KH8_SCALE;
            *(unsigned*)(KH + col) = pg8::pk4_fp8(kv[j].x * r8 * a.x * g2.x, kv[j].y * r8 * a.y * g2.y, kv[j].z * r8 * a.z * g2.z, kv[j].w * r8 * a.w * g2.w); }
      } else {
        unsigned char* VTM = F.ws + WS_VTM; const int bm = mr >> 8, key = mr & 255;
        v4f vv[8];
#pragma unroll
        for (int j = 0; j < 8; ++j) { const int dcol = 4 * (lane + 64 * j); v4f a = (v4f){0.f, 0.f, 0.f, 0.f};
#pragma unroll
            for (int s = 0; s < 4; ++s) { const v2u r2 = *(const v2u*)(slab + ((size_t)s * MROWS + mr) * 4096 + 2048 + dcol); a = a + (v4f){bflo(r2.x), bfhi(r2.x), bflo(r2.y), bfhi(r2.y)}; }
            vv[j] = a; }
#pragma unroll
        for (int j = 0; j < 8; ++j) { const int dcol = 4 * (lane + 64 * j); const v4f a = vv[j];
            const int hh = dcol >> 9, d = dcol & (XD - 1); unsigned char* vp = VTM + ((size_t)(bm * XH + hh) * XD + d) * NMEM + key;
            const unsigned q4 = pg8::pk4_fp8(a.x * V8_SCALE, a.y * V8_SCALE, a.z * V8_SCALE, a.w * V8_SCALE);
            vp[0] = (unsigned char)q4; vp[NMEM] = (unsigned char)(q4 >> 8); vp[2 * NMEM] = (unsigned char)(q4 >> 16); vp[3 * NMEM] = (unsigned char)(q4 >> 24); }
      } }
    if (w < 4) { const float ri = 1.0f / sqrtf(a_ss * (1.0f / DM) + EPS);
        const float mi = a_mi * ri + F.inp[5][w], mf = a_mf * ri + F.inp[6][w];
        const float bcum = wave_incl_scan(logsigmoidf(mf), lane);
        const float g = __expf(bcum), u = __expf(mi - bcum) * 0.08838834764831845f;
        gq[w * 64 + lane] = g; uk[w * 64 + lane] = u;
        if (lane == 63) ((float*)(F.ws + WS_EB))[(size_t)(b * MLH + w) * NCHUNK + c] = g; }
    if (do_norm) { bf16* FQ = (bf16*)(F.ws + WS_FQ); bf16* FK = (bf16*)(F.ws + WS_FK); const int l16 = lane & 15;
      float gqn[8], gkn[8];
#pragma unroll
      for (int e = 0; e < 8; ++e) { gqn[e] = F.inp[9][l16 * 8 + e]; gkn[e] = F.inp[10][l16 * 8 + e]; }
      for (int it0 = w; it0 < 256; it0 += 64) {
          v4u raw[8];
#pragma unroll
          for (int j = 0; j < 8; ++j) { const int seg = (it0 + 8 * j) * 4 + (lane >> 4), row = seg >> 4, hh = seg & 15;
              raw[j] = *(const v4u*)((hh < 8 ? FQ : FK) + (R0 + row) * 1024 + (hh & 7) * FOXD + l16 * 8); }
#pragma unroll
          for (int j = 0; j < 8; ++j) { const int seg = (it0 + 8 * j) * 4 + (lane >> 4), row = seg >> 4, hh = seg & 15;
              bf16* p = (hh < 8 ? FQ : FK) + (R0 + row) * 1024 + (hh & 7) * FOXD + l16 * 8; float v[8];
#pragma unroll
              for (int e = 0; e < 4; ++e) { v[2 * e] = bflo(raw[j][e]); v[2 * e + 1] = bfhi(raw[j][e]); }
              float ss = 0.f;
#pragma unroll
              for (int e = 0; e < 8; ++e) ss += v[e] * v[e];
              ss += __shfl_xor(ss, 1); ss += __shfl_xor(ss, 2); ss += __shfl_xor(ss, 4); ss += __shfl_xor(ss, 8);
              const float ri = 1.0f / sqrtf(ss * (1.0f / FOXD) + EPS);
              v4u o;
#pragma unroll
              for (int e = 0; e < 4; ++e) { const float g0 = hh < 8 ? gqn[2 * e] : gkn[2 * e], g1 = hh < 8 ? gqn[2 * e + 1] : gkn[2 * e + 1]; o[e] = pk2(v[2 * e] * ri * g0, v[2 * e + 1] * ri * g1); }
              *(v4u*)p = o; } } }
    __syncthreads();
    P2_CONV(0, kt, vt);
    __syncthreads();
    for (int h = 0; h < MLH; ++h) {
        LAS bf16* ktc = kt + (h & 1) * P2_BUF_ELEMS; LAS bf16* vtc = vt + (h & 1) * P2_BUF_ELEMS;
        LAS bf16* ktn = kt + ((h + 1) & 1) * P2_BUF_ELEMS; LAS bf16* vtn = vt + ((h + 1) & 1) * P2_BUF_ELEMS;
        if (h + 1 < MLH) P2_LOAD(h + 1);
        const size_t itemh = (size_t)(b * MLH + h) * NCHUNK + c;
        { bf16* KT = (bf16*)((unsigned char*)F.out + WS_KT) + itemh * MLDK * 64;
#pragma unroll
          for (int i = 0; i < 2; ++i) { const int idx = tid + NTHREADS * i, d = idx >> 3, sg = idx & 7; unsigned short e8[8];
#pragma unroll
              for (int e = 0; e < 8; ++e) e8[e] = ktc[(8 * sg + e) * P2_KT_PITCH + (((d >> 3) ^ sg) << 3) + (d & 7)];
              v4u o; o.x = e8[0] | ((unsigned)e8[1] << 16); o.y = e8[2] | ((unsigned)e8[3] << 16); o.z = e8[4] | ((unsigned)e8[5] << 16); o.w = e8[6] | ((unsigned)e8[7] << 16);
              *(v4u*)(KT + d * 64 + 8 * sg) = o; }
          bf16* VT = (bf16*)((unsigned char*)F.out + WS_VT) + itemh * MLDV * 64;
#pragma unroll
          for (int i = 0; i < 4; ++i) { const int idx = tid + NTHREADS * i, dv = idx >> 3, sg = idx & 7; unsigned short e8[8];
#pragma unroll
              for (int e = 0; e < 8; ++e) e8[e] = vtc[(8 * sg + e) * P2_VT_PITCH + (((dv >> 3) ^ sg) << 3) + (dv & 7)];
              v4u o; o.x = e8[0] | ((unsigned)e8[1] << 16); o.y = e8[2] | ((unsigned)e8[3] << 16); o.z = e8[4] | ((unsigned)e8[5] << 16); o.w = e8[6] | ((unsigned)e8[7] << 16);
              *(v4u*)(VT + dv * 64 + 8 * sg) = o; }
          if (tid < MLDK) { float s = 0.f;
#pragma unroll 8
              for (int t = 0; t < 64; ++t) s += bf2f(ktc[t * P2_KT_PITCH + (((tid >> 3) ^ ((t >> 3) & 7)) << 3) + (tid & 7)]);
              ((float*)(F.ws + WS_KSUM))[itemh * MLDK + tid] = s; } }
        if (h + 1 < MLH) P2_CONV(h + 1, ktn, vtn);
        __syncthreads();
    }
#undef P2_LOAD
#undef P2_CONV
    __syncthreads();
}

__device__ __forceinline__ void p3_scan_item(Frame& F, int item) {
    refresh_ids(F);
    if (item < 256) { for (int rep = 0; rep < P3_SCAN_REP; ++rep)
        mls::state_scan(item >> 4, item & 15, (const bf16*)((unsigned char*)F.out + WS_KT), (const bf16*)((unsigned char*)F.out + WS_VT), (const float*)(F.ws + WS_EB), (bf16*)(F.ws + WS_CST), F.lds, F.wave, rep == P3_SCAN_REP - 1); return; }
    const int bh = item - 288, sl = item >= 288 ? 0 : 1;
    if (sl == 0 && F.tid < MLDK) {
        const float* EB = (const float*)(F.ws + WS_EB) + (size_t)bh * NCHUNK; const float* KS = (const float*)(F.ws + WS_KSUM) + (size_t)bh * NCHUNK * MLDK + F.tid;
        float* NS = (float*)(F.ws + WS_NST) + (size_t)bh * NCHUNK * MLDK + F.tid; float n = 0.f;
        float ks[NCHUNK], eb[NCHUNK];
#pragma unroll
        for (int c = 0; c < NCHUNK; ++c) { ks[c] = KS[(size_t)c * MLDK]; eb[c] = EB[c]; }
#pragma unroll
        for (int c = 0; c < NCHUNK; ++c) { NS[(size_t)c * MLDK] = n; n = eb[c] * (n + ks[c]); }
    }
    if (sl == 1) {
        const int seq = item - 256, b = seq >> 3, fh = seq & 7;
        const float* GATES = (const float*)(F.ws + WS_GATES); const float* SSQX = (const float*)(F.ws + WS_CTL + CTL_SSQX); const float fb = F.inp[4][fh];
        const size_t r0 = (size_t)b * SEQ + 8 * F.tid; float lf[8]; float tot = 0.f;
#pragma unroll
        for (int j = 0; j < 8; ++j) { lf[j] = logsigmoidf(GATES[(r0 + j) * 16 + fh] * rinv_of(SSQX, r0 + j) + fb); tot += lf[j]; }
        const float incl = wave_incl_scan(tot, F.lane);
        LAS float* wt = (LAS float*)F.lds;
        __syncthreads();
        if (F.lane == 63) wt[F.wave] = incl;
        __syncthreads();
        float run = incl - tot;
        for (int wv = 0; wv < F.wave; ++wv) run += wt[wv];
        float* C = (float*)(F.ws + WS_CFOX) + (size_t)seq * SEQ + 8 * F.tid;
        float cs[8];
#pragma unroll
        for (int j = 0; j < 8; ++j) { run += lf[j]; cs[j] = run * -11.313708498984761f; C[j] = cs[j]; }
        LAS float* cp0 = wt + 16; LAS float* cend = wt + 32; LAS float* thr = wt + 96;
        if ((F.tid & 31) == 0) cp0[F.tid >> 5] = cs[0];
        if ((F.tid & 7) == 7) cend[F.tid >> 3] = cs[7];
        if (F.wave == 0) { float gq = fmaxf(fabsf(F.inp[9][F.lane]), fabsf(F.inp[9][F.lane + 64])), gk = fmaxf(fabsf(F.inp[10][F.lane]), fabsf(F.inp[10][F.lane + 64]));
#pragma unroll
            for (int o = 1; o < 64; o <<= 1) { gq = fmaxf(gq, __shfl_xor(gq, o)); gk = fmaxf(gk, __shfl_xor(gk, o)); }
            if (F.lane == 0) thr[0] = 2.0f * 11.313708498984761f * gq * gk + 29.0f; }
        __syncthreads();
        if (F.tid < 16) { const int qb = F.tid; const float T = thr[0], c0 = cp0[qb]; int j = 0;
            while (j < 4 * qb && (c0 - cend[j]) * 0.08838834764831845f > T) ++j;
            ((int*)(F.ws + WS_JLO))[seq * 16 + qb] = JLO_DISABLE ? 0 : (j & ~1); }
        __syncthreads();
    }
}
#ifndef MK_PER_PHASE
#define MK_PER_PHASE 0
#endif
#define XB_TMO      128
#define XB_XCNT(j)  (256  + 64 * (j))
#define XB_XSUB(j)  (1280 + 64 * (j))
#define XB_XGEN(j)  (2304 + 64 * (j))
#define XB_TOP      3328
#define XB_TOPGEN   3392
#define XCD_BAR_WORDS 3456
#define XB_SPIN_CAP (1u << 20)
__device__ __forceinline__ unsigned xb_ld(unsigned* p)              { return __hip_atomic_load(p, __ATOMIC_RELAXED, __HIP_MEMORY_SCOPE_AGENT); }
__device__ __forceinline__ unsigned xb_add(unsigned* p, unsigned v) { return __hip_atomic_fetch_add(p, v, __ATOMIC_RELAXED, __HIP_MEMORY_SCOPE_AGENT); }
__device__ __forceinline__ unsigned xb_xcc_id() { return (unsigned)__builtin_amdgcn_s_getreg((3 << 11) | 20) & 0xFu; }
#define XB_SPIN(cond, bar) do { unsigned _sp = 0; while (cond) { __builtin_amdgcn_s_sleep(1); \
    if ((++_sp & 255u) == 0u) { if (xb_ld(&(bar)[XB_TMO])) break; if (_sp > XB_SPIN_CAP) { atomicAdd(&(bar)[XB_TMO], 1u); break; } } } } while (0)
struct XcdBarrier { unsigned* bar; unsigned x; volatile LAS unsigned* st; int wv; };
__device__ __forceinline__ XcdBarrier xcd_barrier_post(unsigned* bar, volatile LAS unsigned* st, int wv) {
    XcdBarrier b; b.bar = bar; b.x = xb_xcc_id(); b.st = st; b.wv = wv;
    if (wv == 0 && lane_id() == 0) (void)xb_add(&bar[XB_XCNT(b.x)], 1u);
    return b;
}
__device__ __forceinline__ void xcd_barrier_complete(unsigned* bar, unsigned x, unsigned& nloc, unsigned& nx) {
    const unsigned G = gridDim.x * gridDim.y * gridDim.z;
    unsigned sum, cnt, mine, sp = 0u;
    for (;;) {
        sum = 0u; cnt = 0u; mine = 0u;
#pragma unroll
        for (unsigned j = 0; j < 16; ++j) { const unsigned c = xb_ld(&bar[XB_XCNT(j)]); sum += c; cnt += (c > 0u) ? 1u : 0u; mine = (j == x) ? c : mine; }
        if (sum == G) break;
        __builtin_amdgcn_s_sleep(1);
        if ((++sp & 255u) == 0u) { if (xb_ld(&bar[XB_TMO])) break; if (sp > XB_SPIN_CAP) { atomicAdd(&bar[XB_TMO], 1u); break; } }
    }
    nloc = mine > 0u ? mine : 1u; nx = cnt > 0u ? cnt : 1u;
}
__device__ __forceinline__ void xcd_barrier(const XcdBarrier& b) {
    asm volatile("s_waitcnt vmcnt(0)" ::: "memory");
    __syncthreads();
    if (b.wv == 0 && lane_id() == 0) {
        unsigned* bar = b.bar;
        __builtin_amdgcn_s_waitcnt(0);
        unsigned nloc = b.st[0], nx = b.st[1];
        if (nloc == 0u) { xcd_barrier_complete(bar, b.x, nloc, nx); b.st[0] = nloc; b.st[1] = nx; }
        const unsigned old = xb_add(&bar[XB_XSUB(b.x)], 1u);
        const unsigned gen = old / nloc;
        if (old + 1u == (gen + 1u) * nloc) {
            __builtin_amdgcn_fence(__ATOMIC_RELEASE, "agent");
            asm volatile("s_waitcnt vmcnt(0)" ::: "memory");
            const unsigned og = xb_add(&bar[XB_TOP], 1u);
            const unsigned tg = og / nx;
            if (og + 1u == (tg + 1u) * nx) xb_add(&bar[XB_TOPGEN], 1u);
            else XB_SPIN(xb_ld(&bar[XB_TOPGEN]) == tg, bar);
            __builtin_amdgcn_fence(__ATOMIC_ACQUIRE, "agent");
            xb_add(&bar[XB_XGEN(b.x)], 1u);
            asm volatile("s_waitcnt vmcnt(0)" ::: "memory");
        } else {
            XB_SPIN(xb_ld(&bar[XB_XGEN(b.x)]) == gen, bar);
            __builtin_amdgcn_fence(__ATOMIC_ACQUIRE, "agent");
            asm volatile("s_waitcnt vmcnt(0)" ::: "memory");
        }
    }
    __syncthreads();
}
constexpr int LDS_MISC_OFF = LDS_BYTES - 256;
#ifndef ML_TWICE
#define ML_TWICE 1
#endif
#ifndef TWICE_P5
#define TWICE_P5 0
#endif
#ifndef TWICE_P6
#define TWICE_P6 0
#endif
#ifndef TWICE_P8
#define TWICE_P8 0
#endif
#ifndef STAGGER_TICKS
#define STAGGER_TICKS 0
#endif
#ifndef P1_WGM
#define P1_WGM 8
#endif
#ifndef P5_WGM
#define P5_WGM 8
#endif
#ifndef P10_WGM
#define P10_WGM 8
#endif
#ifndef MLP_SPLIT
#define MLP_SPLIT 0
#endif
#ifndef P10S_WGM
#define P10S_WGM 4
#endif
#ifndef P11_WGM
#define P11_WGM 8
#endif
#ifndef KREV_P11
#define KREV_P11 1
#endif
#ifndef P4_CV_DEEP
#define P4_CV_DEEP 0
#endif
#ifndef P4_CONV_FIRST
#define P4_CONV_FIRST 0
#endif
#ifndef P4_CVB
#define P4_CVB 2
#endif
#ifndef P4_TWICE
#define P4_TWICE 1
#endif
#ifndef TWICE_P11
#define TWICE_P11 0
#endif
#ifndef TWICE_P10
#define TWICE_P10 0
#endif
#ifndef TWICE_P1
#define TWICE_P1 0
#endif
#ifndef JLO_DISABLE
#define JLO_DISABLE 0
#endif
constexpr int N_PHASES = 12;
struct Args { const float* in[24]; float* out; unsigned char* ws; int ph_lo, ph_hi; };
static_assert(sizeof(Args) == 24 * 8 + 8 + 8 + 8, "Args has no padding");

__global__ void __launch_bounds__(NTHREADS, 2) fwd_kernel(Args args) {
    extern __shared__ __attribute__((aligned(16))) unsigned char lds[];
    Frame F;
    F.lds = (LAS unsigned char*)lds; F.ldsg = lds;
    F.wave = __builtin_amdgcn_readfirstlane((int)(threadIdx.x >> 6)); F.lane = lane_id(); F.tid = F.wave * 64 + F.lane;
    F.G = gridDim.x; { const int bx = blockIdx.x; F.vcu = (F.G % 8 == 0) ? (bx % 8) * (F.G / 8) + bx / 8 : bx; }
    F.inp = (const __attribute__((address_space(4))) cfp_t*)__builtin_amdgcn_kernarg_segment_ptr();
    F.out = args.out; F.ws = args.ws;
    unsigned char* ws = args.ws;
    const int lo = args.ph_lo, hi = args.ph_hi;
    volatile LAS unsigned* MISC = (volatile LAS unsigned*)(F.lds + LDS_MISC_OFF);
    if (F.tid < 64) MISC[F.tid] = 0u;
    __syncthreads();
    XcdBarrier xbar; xbar.bar = (unsigned*)(ws + WS_CTL); xbar.x = 0; xbar.st = nullptr; xbar.wv = F.wave;
    if (hi - lo > 1) xbar = xcd_barrier_post((unsigned*)(ws + WS_CTL), MISC, F.wave);
#ifndef PHASE_MASK
#define PHASE_MASK 0xfff
#endif
#define IN(k) ((((PHASE_MASK) >> (k)) & 1) && lo <= (k) && (k) < hi)
#ifndef DUP_PHASE
#define DUP_PHASE 99
#endif
#define REP(k) for (int rep_ = 0; rep_ < ((k) == DUP_PHASE ? 2 : 1); ++rep_, ((k) == DUP_PHASE && rep_ < 2 ? xcd_barrier(xbar) : (void)0))
#define SEAM(k) do { if (IN(k) && IN((k) + 1)) { xcd_barrier(xbar); } } while (0)
    if (__builtin_expect(lo < 0, 0)) cg::this_grid().sync();
    float* SSQ1 = (float*)(ws + WS_CTL + CTL_SSQ1); float* SSQ2 = (float*)(ws + WS_CTL + CTL_SSQ2); float* SSQQ = (float*)(ws + WS_CTL + CTL_SSQQ);

#ifdef PROBE_PHASE
    unsigned long long pt0 = 0, pt1 = 0, pu0 = 0, pu1 = 0;
#ifndef PROBE_B
#define PROBE_B 99
#endif
#define STAMP(k) do { if ((k) == PROBE_PHASE) pt0 = __builtin_amdgcn_s_memrealtime(); if ((k) == PROBE_PHASE + 1) pt1 = __builtin_amdgcn_s_memrealtime(); \
                      if ((k) == PROBE_B) pu0 = __builtin_amdgcn_s_memrealtime(); if ((k) == PROBE_B + 1) pu1 = __builtin_amdgcn_s_memrealtime(); } while (0)
#else
#define STAMP(k) do {} while (0)
#endif
    STAMP(0);
#ifdef CLK_PHASE
    unsigned long long ck0 = 0, ck1 = 0, cr0 = 0, cr1 = 0;
#define CLKS(k) do { if ((k) == CLK_PHASE) { ck0 = __builtin_amdgcn_s_memtime(); cr0 = __builtin_amdgcn_s_memrealtime(); } if ((k) == CLK_PHASE + 1) { ck1 = __builtin_amdgcn_s_memtime(); cr1 = __builtin_amdgcn_s_memrealtime(); } } while (0)
#else
#define CLKS(k) do {} while (0)
#endif
    CLKS(0);
    if (IN(0)) REP(0) { p0_prologue(F); }
    SEAM(0); STAMP(1); CLKS(1);
    if (IN(1)) REP(1) {
        { pg8::Gemm g{ws, (unsigned)WS_XN, (unsigned)WS_WIN, DM, 64, DM, 0, 128u, 32768u}; pg8::StdOrder S; S.init(MTOK, NPROJ, DM, DM, F.G, (int)blockIdx.x, TWICE_P1, P1_WGM);
          pg8::EpiProj E{(bf16*)(ws + WS_PROJ), F.inp[9], F.inp[10], (const float*)(ws + WS_CTL + CTL_SSQX), (LAS float*)(F.lds + pg8::STAGE_BYTES)};
          pg8::gemm_phase<pg8::EpiProj, pg8::StdOrder, true>(F.lds, g, S, E, F.wave); }
        { pg8::Gemm g{ws, (unsigned)WS_MN, (unsigned)WS_WXKV, DM, DM, 512}; pg8::XkvOrder S{F.G, (int)blockIdx.x};
          pg8::EpiSlab E{(bf16*)(ws + WS_SLAB), 4096, (size_t)MROWS * 4096};
          pg8::gemm_phase<pg8::EpiSlab, pg8::XkvOrder, false>(F.lds, g, S, E, F.wave); }
    }
    SEAM(1); STAMP(2); CLKS(2);
#ifndef P2_TWICE
#define P2_TWICE 1
#endif
    if (IN(2)) REP(2) { for (int item = F.vcu; item < BATCH * NCHUNK * P2_TWICE; item += F.G) p2_prep_item(F, item & 255, false); }
    SEAM(2); STAMP(3); CLKS(3);
#ifndef P3_TWICE
#define P3_TWICE 1
#endif
    if (IN(3)) REP(3) { for (int item = F.vcu; item < 304 * P3_TWICE; item += F.G) p3_scan_item(F, item % 304); }
    SEAM(3); STAMP(4); CLKS(4);
    if (IN(4)) REP(4) {
        {
            const fox::Srd R = __builtin_amdgcn_make_buffer_rsrc((void*)ws, (short)0, (int)WS_END, 0x00020000);
            unsigned* QC = (unsigned*)(ws + WS_CTL + CTL_QCTR); const int* JLO = (const int*)(ws + WS_JLO);
            const float* CF = (const float*)(ws + WS_CFOX); const float* GO = F.inp[11];
            constexpr int CVB = P4_CVB, QCV = (W_ITEMS - W_EARLY) / (8 * CVB), QN = 192 + QCV, NONE = 1 << 20;
            auto mk_item = [&](int g) { const int qx = g / QN, i = g - qx * QN, qb = 15 - (i >> 2), bh = 4 * qx + (i & 3), b = bh >> 3, h = bh & 7;
                fox::Item I; I.rowb = (unsigned)b * SEQ * 2048u + (unsigned)h * (FOXD * 2); I.o = (unsigned)WS_CONCAT + (unsigned)b * SEQ * 4096u + (unsigned)h * (FOXD * 2);
                I.CS = CF + (size_t)bh * SEQ; I.G = GO + h * FOXD; I.P0 = qb * 256; I.jlo = JLO[bh * 16 + qb]; return I; };
            auto is_fox = [&](int g) { return g < NONE && (g % QN) < 64; };
            auto pull = [&]() { if (F.tid == 0) { unsigned qc = MISC[17], left = MISC[18]; int g = NONE;
                    while (left > 0u) { const unsigned i = atomicAdd(QC + qc * 64, 1u); if (i < (unsigned)QN) { g = (int)(qc * QN + i); break; } qc = (qc + 1u) & 7u; --left; }
                    MISC[17] = qc; MISC[18] = left; MISC[16] = (unsigned)g; } };
            if (F.tid == 0) { MISC[17] = xb_xcc_id() & 7u; MISC[18] = 8u; }
            pull();
            __syncthreads();
            int cur = __builtin_amdgcn_readfirstlane((int)MISC[16]);
            __syncthreads();
            while (cur < NONE) {
                if (is_fox(cur)) {
                    fox::Item I = mk_item(cur); fox::Seam S;
                    fox::fox_prime(R, I, (char*)lds, S, F.wave);
                    for (;;) {
                        pull();
                        auto next_item = [&](const fox::Item& self, int& nidx) { nidx = __builtin_amdgcn_readfirstlane((int)MISC[16]); return is_fox(nidx) ? mk_item(nidx) : self; };
                        const int nidx = fox::fox_block(R, I, next_item, (char*)lds, S, F.wave);
                        if (!is_fox(nidx)) { cur = nidx; break; }
                        I = mk_item(nidx);
                    }
                    VM_WAIT(); __syncthreads();
                } else if (P4_CONV_FIRST ? (cur % QN < 64 + QCV) : (cur % QN >= 192)) {
                    const int qx = cur / QN, j = cur - qx * QN - (P4_CONV_FIRST ? 64 : 192), first = W_EARLY + (qx * QCV + j) * CVB;
                    pull();
#if P4_CV_DEEP
                    p0_convert<true>(F, first, first + CVB, 1);
#else
                    p0_convert1(F, first, first + CVB);
#endif
                    VM_WAIT(); __syncthreads();
                    cur = __builtin_amdgcn_readfirstlane((int)MISC[16]);
                    __syncthreads();
                } else {
                    const int qx = cur / QN, it = qx * 128 + ((cur - qx * QN) - (P4_CONV_FIRST ? 64 + QCV : 64)), c = it & 63, h = (it >> 6) & 3, b = it >> 8;
                    pull();
                    mls::chunk_out(b, h, c, (const bf16*)((unsigned char*)F.out + WS_QP), (const bf16*)((unsigned char*)F.out + WS_KPP), (const bf16*)((unsigned char*)F.out + WS_VT), (const bf16*)(ws + WS_CST),
                                   (const float*)(ws + WS_NST), (const bf16*)(ws + WS_MO), F.inp[12], (bf16*)(ws + WS_CONCAT), F.lds, F.wave);
                    cur = __builtin_amdgcn_readfirstlane((int)MISC[16]);
                    __syncthreads();
                }
            }
        }
    }
    SEAM(4); STAMP(5); CLKS(5);
    if (IN(5)) REP(5) {
        pg8::Gemm g{ws, (unsigned)WS_CONCAT, (unsigned)WS_WOUT, DM, 64, DM, 0, 128u, 32768u}; pg8::StdOrder S; S.init(MTOK, DM, DM, DM, F.G, (int)blockIdx.x, TWICE_P5, P5_WGM);
        pg8::EpiResid<false, false> E{(const bf16*)(ws + WS_XN), (bf16*)(ws + WS_X1B), SSQ1, DM, 1.0f, ws + WS_X1Q};
        pg8::gemm_phase<pg8::EpiResid<false, false>, pg8::StdOrder, true>(F.lds, g, S, E, F.wave);
    }
    SEAM(5); STAMP(6); CLKS(6);
    if (IN(6)) REP(6) {
        pg8::Gemm g{ws, (unsigned)WS_X1Q, (unsigned)WS_WXQ, DM / 2, 64, DM / 2, 0, 128u, 32768u}; pg8::StdOrder S; S.init(MTOK, DM, DM / 2, DM / 2, F.G, (int)blockIdx.x, TWICE_P6, P5_WGM);
        pg8::EpiQ E{ws + WS_Q, SSQ1, SSQQ, 1.0f / W8_SCALE};
        pg8::gemm_phase<pg8::EpiQ, pg8::StdOrder, true, true>(F.lds, g, S, E, F.wave);
    }
    SEAM(6); STAMP(7); CLKS(7);
    if (IN(7)) REP(7) {
        pg8::Gemm g{ws, (unsigned)WS_Q, (unsigned)WS_KHAT, DM / 2, DM / 2, XD / 2}; pg8::ScoreOrder S{F.G, (int)blockIdx.x};
        pg8::EpiSoftmax E{ws + WS_P, SSQQ};
        if (F.G >= 256) pg8::gemm_phase<pg8::EpiSoftmax, pg8::ScoreOrder, false, true>(F.lds, g, S, E, F.wave);
        VM_WAIT(); __syncthreads(); __builtin_amdgcn_fence(__ATOMIC_ACQUIRE, "agent"); VM_WAIT(); __syncthreads();
        {
        pg8::Gemm g{ws, (unsigned)WS_P, (unsigned)WS_VTM, 512, NMEM / 2, NMEM / 2}; pg8::PvOrder S{F.G, (int)blockIdx.x, TWICE_P8};
        pg8::EpiStoreFp8 E{ws + WS_CO, DM, CO8_SCALE / (P8_SCALE * V8_SCALE)};
        pg8::gemm_phase<pg8::EpiStoreFp8, pg8::PvOrder, true, true>(F.lds, g, S, E, F.wave);
            }
    }
    STAMP(8); CLKS(8);
    SEAM(8); STAMP(9); CLKS(9);
#ifdef EXTRA_BARS
    for (int eb = 0; eb < EXTRA_BARS; ++eb) xcd_barrier(xbar);
#endif
    if (IN(9)) REP(9) {
        pg8::Gemm g{ws, (unsigned)WS_CO, (unsigned)WS_WXO, DM / 2, 64, DM / 2, 0, 128u, 32768u}; pg8::StdOrder S; S.init(MTOK, DM, DM / 2, DM / 2, F.G, (int)blockIdx.x, 0, P5_WGM);
        pg8::EpiResid<false, false> E{(const bf16*)(ws + WS_X1B), (bf16*)(ws + WS_X2B), SSQ2, DM, 1.0f / (W8_SCALE * CO8_SCALE), nullptr};
        pg8::gemm_phase<pg8::EpiResid<false, false>, pg8::StdOrder, true, true>(F.lds, g, S, E, F.wave);
    }
    SEAM(9); STAMP(10); CLKS(10);
#if MLP_SPLIT
    if (IN(10) && IN(11)) {
        for (int hh = 0; hh < 2; ++hh) {
            const size_t roff = (size_t)hh * (MTOK / 2);
            {
                pg8::Gemm g{ws, (unsigned)(WS_X2B + roff * DM * 2), (unsigned)WS_WUP, DM, 64, DM, 0, 128u, 32768u}; pg8::StdOrder S; S.init(MTOK / 2, DFF, DM, DM, F.G, (int)blockIdx.x, 0, P10S_WGM);
                pg8::EpiUp E{(bf16*)(ws + WS_H), SSQ2 + roff};
                pg8::gemm_phase<pg8::EpiUp, pg8::StdOrder, true>(F.lds, g, S, E, F.wave);
            }
            xcd_barrier(xbar);
            {
                pg8::Gemm g{ws, (unsigned)WS_H, (unsigned)WS_WDN, 64, 64, DFF, KREV_P11, 32768u, 32768u}; pg8::StdOrder S; S.init(MTOK / 2, DM, DFF, DFF, F.G, (int)blockIdx.x, 0, P11_WGM);
                pg8::EpiResid<false, true> E{(const bf16*)(ws + WS_X2B) + roff * DM, F.out + roff * DM, nullptr, DM, 1.0f, nullptr};
                pg8::gemm_phase<pg8::EpiResid<false, true>, pg8::StdOrder, true>(F.lds, g, S, E, F.wave);
            }
            if (hh == 0) xcd_barrier(xbar);
        }
    }
#else
    if (IN(10)) REP(10) {
        if (STAGGER_TICKS > 0 && (blockIdx.x & 8)) { const unsigned long long t0_ = __builtin_amdgcn_s_memrealtime(); while (__builtin_amdgcn_s_memrealtime() - t0_ < (unsigned long long)STAGGER_TICKS) __builtin_amdgcn_s_sleep(8); }
        pg8::Gemm g{ws, (unsigned)WS_X2B, (unsigned)WS_WUP, DM, 64, DM, 0, 128u, 32768u}; pg8::StdOrder S; S.init(MTOK, DFF, DM, DM, F.G, (int)blockIdx.x, TWICE_P10, P10_WGM);
        pg8::EpiUp E{(bf16*)(ws + WS_H), SSQ2};
        pg8::gemm_phase<pg8::EpiUp, pg8::StdOrder, true>(F.lds, g, S, E, F.wave);
    }
    SEAM(10); STAMP(11); CLKS(11);
    if (IN(11)) REP(11) {
        pg8::Gemm g{ws, (unsigned)WS_H, (unsigned)WS_WDN, 64, 64, DFF, KREV_P11, 32768u, 32768u}; pg8::StdOrder S; S.init(MTOK, DM, DFF, DFF, F.G, (int)blockIdx.x, TWICE_P11, P11_WGM);
        pg8::EpiResid<false, true> E{(const bf16*)(ws + WS_X2B), F.out, nullptr, DM, 1.0f, nullptr};
        pg8::gemm_phase<pg8::EpiResid<false, true>, pg8::StdOrder, true>(F.lds, g, S, E, F.wave);
    }
#endif
#ifdef CLK_PHASE
    xcd_barrier(xbar); CLKS(12);
    if (blockIdx.x == 0 && F.tid == 0) F.out[0] += rintf((float)(ck1 - ck0) / (float)(cr1 - cr0));
#endif
#ifdef PROBE_PHASE
    xcd_barrier(xbar); STAMP(12);
    if (blockIdx.x == 0 && F.tid < 64) {
        const float ta = 20.0f * rintf((float)(pt1 - pt0) * 0.01f * 0.05f), tb = 0.8f * rintf((float)(pu1 - pu0) * 0.01f * 0.125f);
        if (F.tid == 0) F.out[0] += ta;
        if (PROBE_B != 99) for (int i = F.tid; i < 10000; i += 64) F.out[64 + i] += tb;
    }
#endif
#undef IN
#undef SEAM
}

extern "C" void kernel_launch(void* const* d_in, const int* in_sizes, int n_in, void* d_out, int out_size, void* d_ws, size_t ws_size, hipStream_t stream) {
    static int grid = 0;
    if (grid == 0) {
        if (n_in != 24 || in_sizes[0] != MTOK * DM || out_size != MTOK * DM || ws_size < WS_END) {
            fprintf(stderr, "kernel_launch: unexpected shapes (n_in %d, in0 %d, out %d, ws %zu; need ws >= %zu); nothing launched\n", n_in, n_in > 0 ? in_sizes[0] : -1, out_size, ws_size, (size_t)WS_END); grid = -1; return; }
        int dev = 0, cus = 0, per_cu = 0;
        if (hipGetDevice(&dev) != hipSuccess || hipDeviceGetAttribute(&cus, hipDeviceAttributeMultiprocessorCount, dev) != hipSuccess) { grid = -1; return; }
        if (hipFuncSetAttribute((const void*)fwd_kernel, hipFuncAttributeMaxDynamicSharedMemorySize, LDS_BYTES) != hipSuccess) { fprintf(stderr, "kernel_launch: hipFuncSetAttribute failed\n"); grid = -1; return; }
        if (hipOccupancyMaxActiveBlocksPerMultiprocessor(&per_cu, (const void*)fwd_kernel, NTHREADS, LDS_BYTES) != hipSuccess || per_cu < 1) { fprintf(stderr, "kernel_launch: occupancy query says %d blocks per CU\n", per_cu); per_cu = 1; }
        (void)hipGetLastError();
        grid = cus;
    }
    if (grid < 0) return;
    (void)hipMemsetAsync((char*)d_ws + WS_CTL, 0, CTL_BYTES, stream);
    Args a{};
    for (int i = 0; i < 24; ++i) a.in[i] = (const float*)d_in[i];
    a.out = (float*)d_out; a.ws = (unsigned char*)d_ws;
#if MK_PER_PHASE
    for (int ph = 0; ph < N_PHASES; ++ph) { a.ph_lo = ph; a.ph_hi = ph + 1;
        hipLaunchKernelGGL(fwd_kernel, dim3(grid), dim3(NTHREADS), LDS_BYTES, stream, a); }
#else
    a.ph_lo = 0; a.ph_hi = N_PHASES;
    void* kargs[] = {&a};
    hipError_t e = hipLaunchCooperativeKernel((const void*)fwd_kernel, dim3(grid), dim3(NTHREADS), kargs, LDS_BYTES, stream);
    if (e != hipSuccess) fprintf(stderr, "kernel_launch: cooperative launch failed: %s (grid %d)\n", hipGetErrorString(e), grid);
#endif
}
```
